# Optimizing an MI355X kernel written in HIP

```python
import jax, jax.numpy as jnp
from jax import lax
import numpy as np

D_MODEL = 1024
BATCH = 2
SEQ = 16384
DEPTH = 1

ATT_HEADS = 8
ATT_KV_HEADS = 2
ATT_HEAD_DIM = 64
WINDOW = 128
ATT_BLOCK = 128
ROPE_THETA = 10000.0
MLSTM_HEADS = 4
MLSTM_HEAD_DIM = 128
MLSTM_CHUNK = 128
CONV_WIDTH = 4
ATT_Q_W = ATT_HEADS * ATT_HEAD_DIM
ATT_KV_W = ATT_KV_HEADS * ATT_HEAD_DIM
MLSTM_W = MLSTM_HEADS * MLSTM_HEAD_DIM
N_BRANCHES = 2
IN_SPLITS = (ATT_Q_W, ATT_KV_W, ATT_KV_W, MLSTM_W, MLSTM_W, MLSTM_W, MLSTM_W,
             MLSTM_HEADS, MLSTM_HEADS, D_MODEL, D_MODEL)
IN_PROJ_W = sum(IN_SPLITS)
PEER_HEADS = 8
PEER_N_KEYS = 128
PEER_N_EXPERTS = PEER_N_KEYS * PEER_N_KEYS
PEER_QUERY_DIM = 256
PEER_HALF = PEER_QUERY_DIM // 2
PEER_TOPK = 16
PEER_BLOCK = 128
EPS = 1e-6

kernel_name = 'hybrid_swa_mlstm_peer_adaln'

F32 = jnp.float32


def rmsnorm(x, w):
    xf = x.astype(F32)
    y = xf * lax.rsqrt(jnp.mean(xf * xf, axis=-1, keepdims=True) + EPS)
    return (y * w.astype(F32)).astype(x.dtype)


def split_cols(t, sizes):
    offs, acc = [], 0
    for s_ in sizes[:-1]:
        acc += s_
        offs.append(acc)
    return jnp.split(t, offs, axis=-1)


def rope(x):
    s, hd = x.shape[1], x.shape[-1]
    half = hd // 2
    inv_freq = ROPE_THETA ** (-jnp.arange(half, dtype=F32) * 2.0 / hd)
    ang = jnp.arange(s, dtype=F32)[:, None] * inv_freq[None, :]
    cos, sin = jnp.cos(ang)[:, None, :], jnp.sin(ang)[:, None, :]
    xf = x.astype(F32)
    x1, x2 = xf[..., :half], xf[..., half:]
    return jnp.concatenate([x1 * cos - x2 * sin, x2 * cos + x1 * sin], axis=-1)


def sliding_window_attention(q, k, v, sinks):
    b, s, _, hd = q.shape
    nb = s // ATT_BLOCK
    g = ATT_HEADS // ATT_KV_HEADS
    qb = q.astype(F32).reshape(b, nb, ATT_BLOCK, ATT_KV_HEADS, g, hd)
    kb = k.astype(F32).reshape(b, nb, ATT_BLOCK, ATT_KV_HEADS, hd)
    vb = v.astype(F32).reshape(b, nb, ATT_BLOCK, ATT_KV_HEADS, hd)

    def with_prev(t):
        prev = jnp.pad(t, ((0, 0), (1, 0), (0, 0), (0, 0), (0, 0)))[:, :-1]
        return jnp.concatenate([prev, t], axis=2)

    kk, vv = with_prev(kb), with_prev(vb)
    scores = jnp.einsum('bnqhgd,bnkhd->bnhgqk', qb, kk) * (hd ** -0.5)
    qi = jnp.arange(ATT_BLOCK)[:, None]
    ki = jnp.arange(2 * ATT_BLOCK)[None, :]
    rel = qi + ATT_BLOCK - ki
    key_pos = jnp.arange(nb)[:, None, None] * ATT_BLOCK - ATT_BLOCK + ki[None]
    mask = (rel >= 0) & (rel < WINDOW) & (key_pos >= 0)
    scores = jnp.where(mask[None, :, None, None], scores, -jnp.inf)
    sink = sinks.astype(F32).reshape(1, 1, ATT_KV_HEADS, g, 1)
    m = jnp.maximum(scores.max(-1), sink)
    p = jnp.exp(scores - m[..., None])
    denom = p.sum(-1) + jnp.exp(sink - m)
    p = p / denom[..., None]
    out = jnp.einsum('bnhgqk,bnkhd->bnqhgd', p, vv)
    return out.reshape(b, s, ATT_HEADS * hd)


def causal_depthwise_conv(x, w):
    ch = x.shape[-1]
    return lax.conv_general_dilated(
        x, w[:, None, :].astype(x.dtype), window_strides=(1,),
        padding=[(CONV_WIDTH - 1, 0)], dimension_numbers=('NWC', 'WIO', 'NWC'),
        feature_group_count=ch)


def mlstm_chunkwise(q, k, v, i_pre, f_pre):
    b, s, h, d = q.shape
    L = MLSTM_CHUNK
    nc = s // L

    def to_chunks(t):
        t = t.astype(F32).reshape((b, nc, L, h) + t.shape[3:])
        return jnp.moveaxis(t, 3, 1)

    qc, kc, vc = to_chunks(q), to_chunks(k) * (d ** -0.5), to_chunks(v)
    ic = to_chunks(i_pre)
    lf = jax.nn.log_sigmoid(to_chunks(f_pre))
    bcum = jnp.cumsum(lf, axis=-1)
    g_tot = bcum[..., -1]
    a = g_tot[..., None] - bcum + ic

    def step(carry, xs):
        C, n, m = carry
        k_c, v_c, a_c, g_c = xs
        m_new = jnp.maximum(g_c + m, a_c.max(-1))
        decay = jnp.exp(g_c + m - m_new)
        wk = jnp.exp(a_c - m_new[..., None])[..., None] * k_c
        C_new = decay[..., None, None] * C + jnp.einsum('bhld,bhle->bhde', wk, v_c)
        n_new = decay[..., None] * n + wk.sum(axis=2)
        return (C_new, n_new, m_new), (C, n, m)

    init = (jnp.zeros((b, h, d, d), F32), jnp.zeros((b, h, d), F32), jnp.zeros((b, h), F32))
    xs = (jnp.moveaxis(kc, 2, 0), jnp.moveaxis(vc, 2, 0),
          jnp.moveaxis(a, 2, 0), jnp.moveaxis(g_tot, 2, 0))
    _, (C_st, n_st, m_st) = lax.scan(step, init, xs)
    C_st = jnp.moveaxis(C_st, 0, 2)
    n_st = jnp.moveaxis(n_st, 0, 2)
    m_st = jnp.moveaxis(m_st, 0, 2)

    causal = jnp.tril(jnp.ones((L, L), dtype=bool))
    D = bcum[..., :, None] - bcum[..., None, :] + ic[..., None, :]
    D = jnp.where(causal, D, -jnp.inf)
    m_inter = bcum + m_st[..., None]
    m_out = jnp.maximum(m_inter, D.max(-1))
    w_intra = jnp.exp(D - m_out[..., None]) * jnp.einsum('bhcld,bhcsd->bhcls', qc, kc)
    w_inter = jnp.exp(m_inter - m_out)
    num = (jnp.einsum('bhcls,bhcsd->bhcld', w_intra, vc)
           + w_inter[..., None] * jnp.einsum('bhcld,bhcde->bhcle', qc, C_st))
    den = w_intra.sum(-1) + w_inter * jnp.einsum('bhcld,bhcd->bhcl', qc, n_st)
    hid = num / jnp.maximum(jnp.abs(den), jnp.exp(-m_out))[..., None]
    return jnp.moveaxis(hid, 1, 3).reshape(b, s, h, d)


def token_mixer(u, w_in, conv_w, att_sinks, i_bias, f_bias, mlstm_norm_w,
                w_att_branch, w_mlstm_branch, w_out):
    b, s, _ = u.shape
    proj = u @ w_in
    aq, ak, av, mq, mk, mv, mo, mi, mf, ga, gm = split_cols(proj, IN_SPLITS)
    aq = rope(aq.reshape(b, s, ATT_HEADS, ATT_HEAD_DIM))
    ak = rope(ak.reshape(b, s, ATT_KV_HEADS, ATT_HEAD_DIM))
    av = av.reshape(b, s, ATT_KV_HEADS, ATT_HEAD_DIM)
    att = sliding_window_attention(aq, ak, av, att_sinks).astype(u.dtype)
    mqk = jax.nn.silu(causal_depthwise_conv(jnp.concatenate([mq, mk], axis=-1), conv_w))
    mq, mk = jnp.split(mqk, 2, axis=-1)
    shp = (b, s, MLSTM_HEADS, MLSTM_HEAD_DIM)
    hid = mlstm_chunkwise(mq.reshape(shp), mk.reshape(shp), mv.reshape(shp),
                          mi.astype(F32) + i_bias.astype(F32), mf.astype(F32) + f_bias.astype(F32))
    hid = jax.nn.sigmoid(mo.astype(F32)).reshape(shp) * hid
    hid = hid * lax.rsqrt(jnp.mean(hid * hid, axis=-1, keepdims=True) + EPS)
    mls = (hid.reshape(b, s, MLSTM_W) * mlstm_norm_w.astype(F32)).astype(u.dtype)
    merged = jax.nn.sigmoid(ga) * (att @ w_att_branch) + jax.nn.sigmoid(gm) * (mls @ w_mlstm_branch)
    return merged @ w_out


def peer_ffn(u, w_query, sub_keys, exp_u, exp_v):
    b, s, d = u.shape
    tokens = u.reshape(-1, PEER_BLOCK, d)

    def block(xb):
        t = xb.shape[0]
        qy = (xb @ w_query).reshape(t, PEER_HEADS, 2, PEER_HALF).astype(F32)
        scores = jnp.einsum('thpd,pnd->thpn', qy, sub_keys.astype(F32))
        top_s, top_i = lax.top_k(scores, PEER_TOPK)
        cand_s = top_s[:, :, 0, :, None] + top_s[:, :, 1, None, :]
        cand_i = top_i[:, :, 0, :, None] * PEER_N_KEYS + top_i[:, :, 1, None, :]
        kk = PEER_TOPK * PEER_TOPK
        best_s, best_j = lax.top_k(cand_s.reshape(t, PEER_HEADS, kk), PEER_TOPK)
        idx = jnp.take_along_axis(cand_i.reshape(t, PEER_HEADS, kk), best_j, axis=-1)
        gate = jax.nn.softmax(best_s, axis=-1)
        u_sel = jnp.take(exp_u, idx, axis=0)
        v_sel = jnp.take(exp_v, idx, axis=0)
        act = jax.nn.gelu(jnp.einsum('td,thkd->thk', xb, u_sel).astype(F32), approximate=False)
        return jnp.einsum('thk,thkd->td', (gate * act).astype(xb.dtype), v_sel)

    return lax.map(block, tokens).reshape(b, s, d)


def setup_inputs(seed: int = 0) -> dict:
    key = jax.random.key(seed)
    ks = jax.random.split(key, 24)

    def nrm(k, shape, scale):
        return jax.random.normal(k, shape, F32) * scale

    return {
        'x': nrm(ks[0], (BATCH, SEQ, D_MODEL), 1.0),
        'c': nrm(ks[1], (BATCH, D_MODEL), 1.0),
        'w_ada': nrm(ks[2], (DEPTH, D_MODEL, 6 * D_MODEL), 0.5 * D_MODEL ** -0.5),
        'b_ada': nrm(ks[3], (DEPTH, 6 * D_MODEL), 0.02),
        'norm1_w': 1.0 + nrm(ks[4], (DEPTH, D_MODEL), 0.02),
        'w_in': nrm(ks[5], (DEPTH, D_MODEL, IN_PROJ_W), D_MODEL ** -0.5),
        'conv_w': nrm(ks[6], (DEPTH, CONV_WIDTH, 2 * MLSTM_W), CONV_WIDTH ** -0.5),
        'att_sinks': nrm(ks[7], (DEPTH, ATT_HEADS), 1.0),
        'i_bias': nrm(ks[8], (DEPTH, MLSTM_HEADS), 0.1),
        'f_bias': jnp.linspace(3.0, 6.0, MLSTM_HEADS, dtype=F32)[None, :]
                  + nrm(ks[9], (DEPTH, MLSTM_HEADS), 0.1),
        'mlstm_norm_w': 1.0 + nrm(ks[10], (DEPTH, MLSTM_W), 0.02),
        'w_att_branch': nrm(ks[11], (DEPTH, ATT_Q_W, D_MODEL), ATT_Q_W ** -0.5),
        'w_mlstm_branch': nrm(ks[12], (DEPTH, MLSTM_W, D_MODEL), MLSTM_W ** -0.5),
        'w_out': nrm(ks[13], (DEPTH, D_MODEL, D_MODEL), D_MODEL ** -0.5),
        'norm2_w': 1.0 + nrm(ks[14], (DEPTH, D_MODEL), 0.02),
        'peer_w_query': nrm(ks[15], (DEPTH, D_MODEL, PEER_HEADS * PEER_QUERY_DIM), D_MODEL ** -0.5),
        'peer_sub_keys': nrm(ks[16], (DEPTH, 2, PEER_N_KEYS, PEER_HALF), PEER_HALF ** -0.5),
        'peer_u': nrm(ks[17], (DEPTH, PEER_N_EXPERTS, D_MODEL), D_MODEL ** -0.5),
        'peer_v': nrm(ks[18], (DEPTH, PEER_N_EXPERTS, D_MODEL), PEER_HEADS ** -0.5),
        'norm_f_w': 1.0 + nrm(ks[19], (D_MODEL,), 0.02),
    }


def reference(x, c, w_ada, b_ada, norm1_w, w_in, conv_w, att_sinks, i_bias, f_bias,
              mlstm_norm_w, w_att_branch, w_mlstm_branch, w_out, norm2_w,
              peer_w_query, peer_sub_keys, peer_u, peer_v, norm_f_w):
    h = x
    c_act = jax.nn.silu(c)
    for l in range(DEPTH):
        mod = (c_act @ w_ada[l] + b_ada[l])[:, None, :]
        sh1, sc1, g1, sh2, sc2, g2 = jnp.split(mod, 6, axis=-1)
        u = rmsnorm(h, norm1_w[l]) * (1 + sc1) + sh1
        h = h + g1 * token_mixer(u, w_in[l], conv_w[l], att_sinks[l], i_bias[l], f_bias[l],
                                 mlstm_norm_w[l], w_att_branch[l], w_mlstm_branch[l], w_out[l])
        u2 = rmsnorm(h, norm2_w[l]) * (1 + sc2) + sh2
        h = h + g2 * peer_ffn(u2, peer_w_query[l], peer_sub_keys[l], peer_u[l], peer_v[l])
    return rmsnorm(h, norm_f_w)
```

```cpp
#include <hip/hip_runtime.h>
#include <stdint.h>
#include <stdio.h>

#define DEV __device__ __forceinline__
typedef unsigned short bf16_t;
typedef short bf16x8 __attribute__((ext_vector_type(8)));
typedef float f32x4 __attribute__((ext_vector_type(4)));
typedef unsigned u32x4 __attribute__((ext_vector_type(4)));
typedef unsigned u32x2 __attribute__((ext_vector_type(2)));

constexpr int BATCH = 2, SEQ = 16384, M = BATCH * SEQ, D = 1024;
constexpr int NTH = 512, NW = 8;
constexpr int LPA = 768, LPM = 2048, LPG = 2048;

struct Params {
    const float *x, *c, *w_ada, *b_ada, *norm1_w, *w_in, *conv_w, *sinks, *i_bias, *f_bias, *mnorm_w, *w_a, *w_b, *w_out, *norm2_w, *w_q, *sub_keys, *peer_u, *peer_v, *normf_w;
    float* out; unsigned char* ws;
};

constexpr size_t MiB = 1u << 20;
constexpr size_t WS_MOD = 1 * MiB;
constexpr size_t WS_IPRE = 2 * MiB;
constexpr size_t WS_FPRE = 2 * MiB + 512 * 1024;
constexpr size_t WS_CHG = 3 * MiB;
constexpr size_t WS_NLOC = 4 * MiB;
constexpr size_t WS_NST = 4 * MiB + 512 * 1024;
constexpr size_t WS_ROPE = 5 * MiB;
constexpr size_t WS_WIN = 10 * MiB;
constexpr size_t WS_WA = 20 * MiB;
constexpr size_t WS_WB = 21 * MiB;
constexpr size_t WS_WOUT = 22 * MiB;
constexpr size_t WS_WQ = 24 * MiB;
constexpr size_t WS_SK = 28 * MiB;
constexpr size_t WS_TU = 32 * MiB;
constexpr size_t WS_TV = 64 * MiB;
constexpr size_t WS_UB = 96 * MiB;
constexpr size_t WS_PA = 160 * MiB;
constexpr size_t WS_PM = 208 * MiB;
constexpr size_t WS_PG = 336 * MiB;
constexpr size_t WS_CST = 464 * MiB;
constexpr size_t WS_END = 496 * MiB;

DEV unsigned f2bf(float f) { unsigned u = __float_as_uint(f); return (u + 0x7fffu + ((u >> 16) & 1u)) >> 16; }
DEV unsigned pk2(float lo, float hi) { return f2bf(lo) | (f2bf(hi) << 16); }
DEV float bflo(unsigned u) { return __uint_as_float(u << 16); }
DEV float bfhi(unsigned u) { return __uint_as_float(u & 0xffff0000u); }
DEV float bf2f(bf16_t h) { return __uint_as_float(((unsigned)h) << 16); }
DEV float wave_sum(float v) {
#pragma unroll
    for (int o = 32; o > 0; o >>= 1) v += __shfl_xor(v, o);
    return v;
}
DEV float wave_max(float v) {
#pragma unroll
    for (int o = 32; o > 0; o >>= 1) v = fmaxf(v, __shfl_xor(v, o));
    return v;
}
DEV float sigmoidf_(float v) { return 1.f / (1.f + __expf(-v)); }
DEV f32x4 mfma16(bf16x8 a, bf16x8 b, f32x4 c) { return __builtin_amdgcn_mfma_f32_16x16x32_bf16(a, b, c, 0, 0, 0); }
DEV void wave_lds_sync() { __builtin_amdgcn_fence(__ATOMIC_ACQ_REL, "wavefront"); __builtin_amdgcn_wave_barrier(); }

DEV void transpose_item(const float* W, int ldw, int k0, int nsrc0, bf16_t* WT, int ldt, int ndst0, float* scr, int lane) {
#pragma unroll 8
    for (int i = 0; i < 32; ++i) { const int kk = 2 * i + (lane >> 5); scr[kk * 33 + (lane & 31)] = W[(size_t)(k0 + kk) * ldw + nsrc0 + (lane & 31)]; }
    wave_lds_sync();
    const int c = lane & 7;
#pragma unroll
    for (int j = 0; j < 4; ++j) {
        const int n = (lane >> 3) + 8 * j; const float* s = scr + (8 * c) * 33 + n;
        u32x4 o; o.x = pk2(s[0 * 33], s[1 * 33]); o.y = pk2(s[2 * 33], s[3 * 33]); o.z = pk2(s[4 * 33], s[5 * 33]); o.w = pk2(s[6 * 33], s[7 * 33]);
        *(u32x4*)(WT + (size_t)(ndst0 + n) * ldt + k0 + 8 * c) = o;
    }
    wave_lds_sync();
}

DEV void stage_prep(const Params& p, char* lds, int vb, int nvb) {
    const int tid = threadIdx.x, lane = tid & 63, wave = __builtin_amdgcn_readfirstlane(tid >> 6);
    float* mod = (float*)(p.ws + WS_MOD);
    float* s_act = (float*)lds;
    float* s_red = (float*)(lds + 8192);
    for (int i = tid; i < 2048; i += NTH) { const float v = p.c[i]; s_act[i] = v / (1.f + expf(-v)); }
    __syncthreads();
    for (int item = vb; item < 192; item += nvb) {
        const int kg = tid >> 5, cl = tid & 31, col = item * 32 + cl;
        float s0 = 0.f, s1 = 0.f;
        for (int k = kg; k < 1024; k += 16) { const float w = p.w_ada[(size_t)k * 6144 + col]; s0 += s_act[k] * w; s1 += s_act[1024 + k] * w; }
        s_red[(kg * 32 + cl) * 2] = s0; s_red[(kg * 32 + cl) * 2 + 1] = s1;
        __syncthreads();
        if (tid < 64) { const int b = tid >> 5, c2 = tid & 31; float s = 0.f; for (int g = 0; g < 16; ++g) s += s_red[(g * 32 + c2) * 2 + b]; mod[b * 6144 + item * 32 + c2] = s + p.b_ada[item * 32 + c2]; }
        __syncthreads();
    }
    float* scr = (float*)(lds + 16384 + wave * 8448);
    const int gw = vb * NW + wave, ngw = nvb * NW;
    bf16_t* Wt_in = (bf16_t*)(p.ws + WS_WIN); bf16_t* Wt_a = (bf16_t*)(p.ws + WS_WA); bf16_t* Wt_b = (bf16_t*)(p.ws + WS_WB);
    bf16_t* Wt_out = (bf16_t*)(p.ws + WS_WOUT); bf16_t* Wt_q = (bf16_t*)(p.ws + WS_WQ);
    for (int it = gw; it < 4480; it += ngw) {
        int r = it;
        if (r < 2432) { const int kb = r / 152, nb = r % 152; transpose_item(p.w_in, 4872, kb * 64, nb * 32 + (nb >= 88 ? 8 : 0), Wt_in, 1024, nb * 32, scr, lane); continue; } r -= 2432;
        if (r < 256) { const int kb = r / 32, nb = r % 32; transpose_item(p.w_a, 1024, kb * 64, nb * 32, Wt_a, 512, nb * 32, scr, lane); continue; } r -= 256;
        if (r < 256) { const int kb = r / 32, nb = r % 32; transpose_item(p.w_b, 1024, kb * 64, nb * 32, Wt_b, 512, nb * 32, scr, lane); continue; } r -= 256;
        if (r < 512) { const int kb = r / 32, nb = r % 32; transpose_item(p.w_out, 1024, kb * 64, nb * 32, Wt_out, 1024, nb * 32, scr, lane); continue; } r -= 512;
        { const int kb = r / 64, nb = r % 64; transpose_item(p.w_q, 2048, kb * 64, nb * 32, Wt_q, 1024, nb * 32, scr, lane); }
    }
    const size_t gt = (size_t)vb * NTH + tid, ngt = (size_t)nvb * NTH;
    for (size_t g = gt; g < 2 * 2097152 + 4096; g += ngt) {
        const float* src; bf16_t* dst; size_t o;
        if (g < 2097152) { src = p.peer_u; dst = (bf16_t*)(p.ws + WS_TU); o = g; }
        else if (g < 4194304) { src = p.peer_v; dst = (bf16_t*)(p.ws + WS_TV); o = g - 2097152; }
        else { src = p.sub_keys; dst = (bf16_t*)(p.ws + WS_SK); o = g - 4194304; }
        const float4 a = ((const float4*)src)[2 * o], b = ((const float4*)src)[2 * o + 1];
        u32x4 w; w.x = pk2(a.x, a.y); w.y = pk2(a.z, a.w); w.z = pk2(b.x, b.y); w.w = pk2(b.z, b.w);
        ((u32x4*)dst)[o] = w;
    }
    float2* rope = (float2*)(p.ws + WS_ROPE);
    for (size_t e = gt; e < 16384 * 32; e += ngt) {
        const int pos = (int)(e >> 5), i = (int)(e & 31);
        const float inv = (float)exp2(-(double)i * (13.287712379549449 / 32.0));
        const float ang = (float)pos * inv;
        const double a = (double)ang; const double n = rint(a * 0.15915494309189535); const double r = a - n * 6.283185307179586;
        float s, c; sincosf((float)r, &s, &c);
        rope[e] = make_float2(c, s);
    }
}

DEV void stage_norm1(const Params& p, char* lds, int vb, int nvb) {
    const int tid = threadIdx.x, lane = tid & 63, wave = __builtin_amdgcn_readfirstlane(tid >> 6);
    float* wg = (float*)lds;
    for (int i = tid; i < 8192; i += NTH) { const int cc = i >> 10, k = i & 1023; wg[i] = p.w_in[(size_t)k * 4872 + 2816 + cc]; }
    __syncthreads();
    const float* mod = (const float*)(p.ws + WS_MOD);
    bf16_t* ub = (bf16_t*)(p.ws + WS_UB);
    float* ipre = (float*)(p.ws + WS_IPRE); float* fpre = (float*)(p.ws + WS_FPRE);
    for (int m = vb * NW + wave; m < M; m += nvb * NW) {
        const int b = m >= SEQ ? 1 : 0;
        const float4* xr = (const float4*)(p.x + (size_t)m * D);
        float4 v[4]; float ss = 0.f;
#pragma unroll
        for (int j = 0; j < 4; ++j) { v[j] = xr[lane + 64 * j]; ss += v[j].x * v[j].x + v[j].y * v[j].y + v[j].z * v[j].z + v[j].w * v[j].w; }
        ss = wave_sum(ss);
        const float rstd = rsqrtf(ss * (1.f / 1024.f) + 1e-6f);
        float ga[8];
#pragma unroll
        for (int cc = 0; cc < 8; ++cc) ga[cc] = 0.f;
#pragma unroll
        for (int j = 0; j < 4; ++j) {
            const int col = 4 * (lane + 64 * j);
            const float4 w1 = *(const float4*)(p.norm1_w + col), sc = *(const float4*)(mod + b * 6144 + 1024 + col), sh = *(const float4*)(mod + b * 6144 + col);
            float4 u;
            u.x = v[j].x * rstd * w1.x * (1.f + sc.x) + sh.x; u.y = v[j].y * rstd * w1.y * (1.f + sc.y) + sh.y;
            u.z = v[j].z * rstd * w1.z * (1.f + sc.z) + sh.z; u.w = v[j].w * rstd * w1.w * (1.f + sc.w) + sh.w;
            u32x2 o; o.x = pk2(u.x, u.y); o.y = pk2(u.z, u.w);
            *(u32x2*)(ub + (size_t)m * D + col) = o;
#pragma unroll
            for (int cc = 0; cc < 8; ++cc) { const float4 g = *(const float4*)(wg + cc * 1024 + col); ga[cc] += u.x * g.x + u.y * g.y + u.z * g.z + u.w * g.w; }
        }
#pragma unroll
        for (int cc = 0; cc < 8; ++cc) ga[cc] = wave_sum(ga[cc]);
        if (lane == 0) {
#pragma unroll
            for (int h = 0; h < 4; ++h) { ipre[(size_t)m * 4 + h] = ga[h] + p.i_bias[h]; fpre[(size_t)m * 4 + h] = ga[4 + h] + p.f_bias[h]; }
        }
    }
}

struct GemmOp { const bf16_t* A; int lda; const bf16_t* Bt; int ldb; int K; };

DEV void gemm_tile(f32x4 (&acc)[4][2], const GemmOp& g, int m0, int n0, char* lds) {
    const int tid = threadIdx.x, lane = tid & 63, wid = __builtin_amdgcn_readfirstlane(tid >> 6), wm = wid >> 2, wn = wid & 3, fr = lane & 15, fq = lane >> 4;
    const int sr = tid >> 3, sc = tid & 7;
    const bf16_t* ga = g.A + (size_t)(m0 + sr) * g.lda + sc * 8;
    const bf16_t* gb = g.Bt + (size_t)(n0 + sr) * g.ldb + sc * 8;
    const size_t a64 = (size_t)64 * g.lda, b64 = (size_t)64 * g.ldb;
    const int so = sr * 128 + ((sc ^ (sr & 7)) << 4);
    const int nk = g.K >> 6;
    u32x4 ra0 = *(const u32x4*)ga, ra1 = *(const u32x4*)(ga + a64), rb0 = *(const u32x4*)gb, rb1 = *(const u32x4*)(gb + b64);
    *(u32x4*)(lds + so) = ra0; *(u32x4*)(lds + so + 8192) = ra1; *(u32x4*)(lds + 32768 + so) = rb0; *(u32x4*)(lds + 32768 + so + 8192) = rb1;
    __syncthreads();
    const int aoff = (wm * 64 + fr) * 128, boff = 32768 + (wn * 32 + fr) * 128, sw = fr & 7;
    for (int kt = 0; kt < nk; ++kt) {
        const int cur = (kt & 1) * 16384;
        if (kt + 1 < nk) { ga += 64; gb += 64; ra0 = *(const u32x4*)ga; ra1 = *(const u32x4*)(ga + a64); rb0 = *(const u32x4*)gb; rb1 = *(const u32x4*)(gb + b64); }
#pragma unroll
        for (int ks = 0; ks < 2; ++ks) {
            const int ch = ((fq + 4 * ks) ^ sw) << 4;
            bf16x8 af[4], bfr[2];
#pragma unroll
            for (int mi = 0; mi < 4; ++mi) af[mi] = *(const bf16x8*)(lds + cur + aoff + mi * 2048 + ch);
#pragma unroll
            for (int ni = 0; ni < 2; ++ni) bfr[ni] = *(const bf16x8*)(lds + cur + boff + ni * 2048 + ch);
#pragma unroll
            for (int mi = 0; mi < 4; ++mi)
#pragma unroll
                for (int ni = 0; ni < 2; ++ni) acc[mi][ni] = mfma16(bfr[ni], af[mi], acc[mi][ni]);
        }
        if (kt + 1 < nk) {
            const int nxt = cur ^ 16384;
            *(u32x4*)(lds + nxt + so) = ra0; *(u32x4*)(lds + nxt + so + 8192) = ra1; *(u32x4*)(lds + 32768 + nxt + so) = rb0; *(u32x4*)(lds + 32768 + nxt + so + 8192) = rb1;
        }
        __syncthreads();
    }
}
#define GEMM_EPI_LOOP(...) { const int tid_ = threadIdx.x, lane_ = tid_ & 63, wid_ = tid_ >> 6, wm_ = wid_ >> 2, wn_ = wid_ & 3, fr_ = lane_ & 15, fq_ = lane_ >> 4; \
    _Pragma("unroll") for (int mi = 0; mi < 4; ++mi) _Pragma("unroll") for (int ni = 0; ni < 2; ++ni) { const int m = m0 + wm_ * 64 + mi * 16 + fr_, n = n0 + wn_ * 32 + ni * 16 + fq_ * 4; __VA_ARGS__ } }

DEV void stage_gemm_in(const Params& p, char* lds, int vb, int nvb) {
    GemmOp g{(const bf16_t*)(p.ws + WS_UB), 1024, (const bf16_t*)(p.ws + WS_WIN), 1024, 1024};
    bf16_t* PA = (bf16_t*)(p.ws + WS_PA); bf16_t* PM = (bf16_t*)(p.ws + WS_PM); bf16_t* PG = (bf16_t*)(p.ws + WS_PG);
    const int tn = 38, tiles = 256 * tn;
    for (int t = vb; t < tiles; t += nvb) {
        const int m0 = (t / tn) * 128, n0 = (t % tn) * 128;
        f32x4 acc[4][2];
#pragma unroll
        for (int i = 0; i < 4; ++i) { acc[i][0] = (f32x4){0.f, 0.f, 0.f, 0.f}; acc[i][1] = (f32x4){0.f, 0.f, 0.f, 0.f}; }
        gemm_tile(acc, g, m0, n0, lds);
        bf16_t* dst; int ld, nb;
        if (n0 < 768) { dst = PA; ld = LPA; nb = n0; } else if (n0 < 2816) { dst = PM; ld = LPM; nb = n0 - 768; } else { dst = PG; ld = LPG; nb = n0 - 2816; }
        GEMM_EPI_LOOP({ const f32x4 v = acc[mi][ni]; u32x2 o; o.x = pk2(v[0], v[1]); o.y = pk2(v[2], v[3]); *(u32x2*)(dst + (size_t)m * ld + (n - n0 + nb)) = o; })
    }
}

DEV void stage_gemm_merge(const Params& p, char* lds, int vb, int nvb) {
    GemmOp g1{(const bf16_t*)(p.ws + WS_PA), LPA, (const bf16_t*)(p.ws + WS_WA), 512, 512};
    GemmOp g2{(const bf16_t*)(p.ws + WS_PM) + 1536, LPM, (const bf16_t*)(p.ws + WS_WB), 512, 512};
    const bf16_t* PG = (const bf16_t*)(p.ws + WS_PG); bf16_t* MG = (bf16_t*)(p.ws + WS_UB);
    const int tn = 8, tiles = 256 * tn;
    for (int t = vb; t < tiles; t += nvb) {
        const int m0 = (t / tn) * 128, n0 = (t % tn) * 128;
        f32x4 acc[4][2], acc2[4][2];
#pragma unroll
        for (int i = 0; i < 4; ++i) { acc[i][0] = (f32x4){0.f, 0.f, 0.f, 0.f}; acc[i][1] = acc[i][0]; acc2[i][0] = acc[i][0]; acc2[i][1] = acc[i][0]; }
        gemm_tile(acc, g1, m0, n0, lds);
        gemm_tile(acc2, g2, m0, n0, lds);
        GEMM_EPI_LOOP({ const f32x4 v1 = acc[mi][ni], v2 = acc2[mi][ni];
            const u32x2 a = *(const u32x2*)(PG + (size_t)m * LPG + n), b = *(const u32x2*)(PG + (size_t)m * LPG + 1024 + n);
            const float r0 = sigmoidf_(bflo(a.x)) * v1[0] + sigmoidf_(bflo(b.x)) * v2[0], r1 = sigmoidf_(bfhi(a.x)) * v1[1] + sigmoidf_(bfhi(b.x)) * v2[1];
            const float r2 = sigmoidf_(bflo(a.y)) * v1[2] + sigmoidf_(bflo(b.y)) * v2[2], r3 = sigmoidf_(bfhi(a.y)) * v1[3] + sigmoidf_(bfhi(b.y)) * v2[3];
            u32x2 o; o.x = pk2(r0, r1); o.y = pk2(r2, r3); *(u32x2*)(MG + (size_t)m * 1024 + n) = o; })
    }
}

DEV void stage_gemm_out(const Params& p, char* lds, int vb, int nvb) {
    GemmOp g{(const bf16_t*)(p.ws + WS_UB), 1024, (const bf16_t*)(p.ws + WS_WOUT), 1024, 1024};
    const float* mod = (const float*)(p.ws + WS_MOD);
    const int tn = 8, tiles = 256 * tn;
    for (int t = vb; t < tiles; t += nvb) {
        const int m0 = (t / tn) * 128, n0 = (t % tn) * 128;
        f32x4 acc[4][2];
#pragma unroll
        for (int i = 0; i < 4; ++i) { acc[i][0] = (f32x4){0.f, 0.f, 0.f, 0.f}; acc[i][1] = acc[i][0]; }
        gemm_tile(acc, g, m0, n0, lds);
        const int b = m0 >= SEQ ? 1 : 0;
        GEMM_EPI_LOOP({ const f32x4 v = acc[mi][ni]; const f32x4 xv = *(const f32x4*)(p.x + (size_t)m * D + n); const f32x4 gv = *(const f32x4*)(mod + b * 6144 + 2048 + n);
            *(f32x4*)(p.out + (size_t)m * D + n) = xv + gv * v; })
    }
}

DEV void stage_gemm_q(const Params& p, char* lds, int vb, int nvb) {
    GemmOp g{(const bf16_t*)(p.ws + WS_PG), 1024, (const bf16_t*)(p.ws + WS_WQ), 1024, 1024};
    bf16_t* QY = (bf16_t*)(p.ws + WS_PM);
    const int tn = 16, tiles = 256 * tn;
    for (int t = vb; t < tiles; t += nvb) {
        const int m0 = (t / tn) * 128, n0 = (t % tn) * 128;
        f32x4 acc[4][2];
#pragma unroll
        for (int i = 0; i < 4; ++i) { acc[i][0] = (f32x4){0.f, 0.f, 0.f, 0.f}; acc[i][1] = acc[i][0]; }
        gemm_tile(acc, g, m0, n0, lds);
        GEMM_EPI_LOOP({ const f32x4 v = acc[mi][ni]; u32x2 o; o.x = pk2(v[0], v[1]); o.y = pk2(v[2], v[3]); *(u32x2*)(QY + (size_t)m * 2048 + n) = o; })
    }
}

DEV void rope8(u32x4 x1, u32x4 x2, const float4* rp, float scale, u32x4& o1, u32x4& o2) {
#pragma unroll
    for (int w = 0; w < 4; ++w) {
        const float4 cs = rp[w];
        const float a0 = bflo(x1[w]), a1 = bfhi(x1[w]), b0 = bflo(x2[w]), b1 = bfhi(x2[w]);
        o1[w] = pk2((a0 * cs.x - b0 * cs.y) * scale, (a1 * cs.z - b1 * cs.w) * scale);
        o2[w] = pk2((b0 * cs.x + a0 * cs.y) * scale, (b1 * cs.z + a1 * cs.w) * scale);
    }
}

DEV void stage_attn(const Params& p, char* lds, int vb, int nvb) {
    const int tid = threadIdx.x, lane = tid & 63, wave = __builtin_amdgcn_readfirstlane(tid >> 6), fr = lane & 15, fq = lane >> 4;
    char* Ks = lds;
    char* VT = lds + 32768;
    char* Qs = lds + 70656;
    char* Ps = lds + 87040;
    bf16_t* PA = (bf16_t*)(p.ws + WS_PA);
    const float2* rope = (const float2*)(p.ws + WS_ROPE);
    for (int unit = vb; unit < 512; unit += nvb) {
        const int kvh = unit & 1, n = (unit >> 1) & 127, b = unit >> 8;
        __syncthreads();
        for (int task = tid; task < 1024; task += NTH) {
            const int ki = task >> 2, cp = task & 3, pos = 128 * (n - 1) + ki;
            u32x4 o1 = {0u, 0u, 0u, 0u}, o2 = {0u, 0u, 0u, 0u};
            if (pos >= 0) {
                const bf16_t* src = PA + (size_t)(b * SEQ + pos) * LPA + 512 + kvh * 64 + cp * 8;
                const u32x4 x1 = *(const u32x4*)src, x2 = *(const u32x4*)(src + 32);
                rope8(x1, x2, (const float4*)(rope + (size_t)pos * 32 + cp * 8), 1.0f, o1, o2);
            }
            const int sw = ki & 7;
            *(u32x4*)(Ks + ki * 128 + ((cp ^ sw) << 4)) = o1;
            *(u32x4*)(Ks + ki * 128 + (((cp + 4) ^ sw) << 4)) = o2;
        }
        for (int task = tid; task < 2048; task += NTH) {
            const int ki = task >> 3, c = task & 7, pos = 128 * (n - 1) + ki;
            u32x4 x = {0u, 0u, 0u, 0u};
            if (pos >= 0) x = *(const u32x4*)(PA + (size_t)(b * SEQ + pos) * LPA + 640 + kvh * 64 + c * 8);
#pragma unroll
            for (int e = 0; e < 8; ++e) *(bf16_t*)(VT + (c * 8 + e) * 592 + ki * 2) = (bf16_t)((e & 1) ? (x[e >> 1] >> 16) : (x[e >> 1] & 0xffffu));
        }
        for (int i = tid; i < 64 * 40; i += NTH) { const int d = i / 40, kk = 256 + i % 40; *(bf16_t*)(VT + d * 592 + kk * 2) = 0; }
        for (int i = tid; i < 2048; i += NTH) { const int w = i >> 8, r = (i >> 4) & 15, kk = 144 + (i & 15); *(bf16_t*)(Ps + w * 5376 + r * 336 + kk * 2) = 0; }
        for (int j = 0; j < 4; ++j) {
            const int hq = kvh * 4 + j;
            {
                const int qi = tid >> 2, cp = tid & 3, pos = 128 * n + qi;
                const bf16_t* src = PA + (size_t)(b * SEQ + pos) * LPA + hq * 64 + cp * 8;
                const u32x4 x1 = *(const u32x4*)src, x2 = *(const u32x4*)(src + 32);
                u32x4 o1, o2;
                rope8(x1, x2, (const float4*)(rope + (size_t)pos * 32 + cp * 8), 0.125f, o1, o2);
                const int sw = qi & 7;
                *(u32x4*)(Qs + qi * 128 + ((cp ^ sw) << 4)) = o1;
                *(u32x4*)(Qs + qi * 128 + (((cp + 4) ^ sw) << 4)) = o2;
            }
            __syncthreads();
            f32x4 s[9];
            const int sw = fr & 7;
            bf16x8 qf[2];
#pragma unroll
            for (int ks = 0; ks < 2; ++ks) qf[ks] = *(const bf16x8*)(Qs + (16 * wave + fr) * 128 + (((fq + 4 * ks) ^ sw) << 4));
#pragma unroll
            for (int t = 0; t < 9; ++t) {
                s[t] = (f32x4){0.f, 0.f, 0.f, 0.f};
#pragma unroll
                for (int ks = 0; ks < 2; ++ks) { const bf16x8 kf = *(const bf16x8*)(Ks + (16 * (wave + t) + fr) * 128 + (((fq + 4 * ks) ^ sw) << 4)); s[t] = mfma16(kf, qf[ks], s[t]); }
            }
            const float sink = p.sinks[hq];
            float mx = sink;
#pragma unroll
            for (int t = 0; t < 9; ++t)
#pragma unroll
                for (int r = 0; r < 4; ++r) {
                    const int dd = 16 * t + 4 * fq + r - fr, ki = 16 * (wave + t) + 4 * fq + r;
                    const bool ok = (dd >= 1) && (dd <= 128) && (n > 0 || ki >= 128);
                    const float v = ok ? s[t][r] : -INFINITY;
                    s[t][r] = v; mx = fmaxf(mx, v);
                }
            mx = fmaxf(mx, __shfl_xor(mx, 16)); mx = fmaxf(mx, __shfl_xor(mx, 32));
            float sum = 0.f;
#pragma unroll
            for (int t = 0; t < 9; ++t)
#pragma unroll
                for (int r = 0; r < 4; ++r) { const float pv = __expf(s[t][r] - mx); s[t][r] = pv; sum += pv; }
            sum += __shfl_xor(sum, 16); sum += __shfl_xor(sum, 32);
            const float inv = 1.f / (sum + __expf(sink - mx));
            char* Pw = Ps + wave * 5376 + fr * 336;
#pragma unroll
            for (int t = 0; t < 9; ++t) { u32x2 o; o.x = pk2(s[t][0], s[t][1]); o.y = pk2(s[t][2], s[t][3]); *(u32x2*)(Pw + (16 * t + 4 * fq) * 2) = o; }
            __syncthreads();
            f32x4 o[4];
#pragma unroll
            for (int di = 0; di < 4; ++di) o[di] = (f32x4){0.f, 0.f, 0.f, 0.f};
#pragma unroll
            for (int ks = 0; ks < 5; ++ks) {
                const bf16x8 pf = *(const bf16x8*)(Pw + (32 * ks + 8 * fq) * 2);
#pragma unroll
                for (int di = 0; di < 4; ++di) { const bf16x8 vf = *(const bf16x8*)(VT + (16 * di + fr) * 592 + (16 * wave + 32 * ks + 8 * fq) * 2); o[di] = mfma16(vf, pf, o[di]); }
            }
            bf16_t* dst = PA + (size_t)(b * SEQ + 128 * n + 16 * wave + fr) * LPA + hq * 64 + 4 * fq;
#pragma unroll
            for (int di = 0; di < 4; ++di) { u32x2 w; w.x = pk2(o[di][0] * inv, o[di][1] * inv); w.y = pk2(o[di][2] * inv, o[di][3] * inv); *(u32x2*)(dst + 16 * di) = w; }
            __syncthreads();
        }
    }
}

DEV float logsigf(float x) { return fminf(x, 0.f) - log1pf(expf(-fabsf(x))); }

DEV void chunk_gates(const float* ipre, const float* fpre, int rowbase, int h, float* gs, int lane) {
    const int l0 = 2 * lane;
    const float i0 = ipre[(size_t)(rowbase + l0) * 4 + h], i1 = ipre[(size_t)(rowbase + l0 + 1) * 4 + h];
    const float lf0 = logsigf(fpre[(size_t)(rowbase + l0) * 4 + h]), lf1 = logsigf(fpre[(size_t)(rowbase + l0 + 1) * 4 + h]);
    const float pair = lf0 + lf1;
    float sc = pair;
#pragma unroll
    for (int o = 1; o < 64; o <<= 1) { const float t = __shfl_up(sc, o); if (lane >= o) sc += t; }
    const float b0 = (sc - pair) + lf0, b1 = b0 + lf1;
    const float g = __shfl(sc, 63);
    const float a0 = g - b0 + i0, a1 = g - b1 + i1;
    const float mloc = wave_max(fmaxf(a0, a1));
    const float ib0 = i0 - b0, ib1 = i1 - b1;
    float scm = fmaxf(ib0, ib1);
#pragma unroll
    for (int o = 1; o < 64; o <<= 1) { const float t = __shfl_up(scm, o); if (lane >= o) scm = fmaxf(scm, t); }
    float ex = __shfl_up(scm, 1); if (lane == 0) ex = -INFINITY;
    const float pm0 = fmaxf(ex, ib0), pm1 = fmaxf(pm0, ib1);
    gs[l0] = b0; gs[l0 + 1] = b1; gs[128 + l0] = ib0; gs[128 + l0 + 1] = ib1; gs[256 + l0] = a0; gs[256 + l0 + 1] = a1; gs[384 + l0] = pm0; gs[384 + l0 + 1] = pm1;
    if (lane == 0) { gs[512] = g; gs[513] = mloc; }
}

DEV void conv8(const bf16_t* PM, const float* cw, int b, int t, int pmcol, int cch, float (&out)[8]) {
#pragma unroll
    for (int e = 0; e < 8; ++e) out[e] = 0.f;
#pragma unroll
    for (int j = 0; j < 4; ++j) {
        const int tt = t - 3 + j;
        if (tt >= 0) {
            const u32x4 x = *(const u32x4*)(PM + (size_t)(b * SEQ + tt) * LPM + pmcol);
            const float4 w0 = *(const float4*)(cw + j * 1024 + cch), w1 = *(const float4*)(cw + j * 1024 + cch + 4);
            out[0] += bflo(x[0]) * w0.x; out[1] += bfhi(x[0]) * w0.y; out[2] += bflo(x[1]) * w0.z; out[3] += bfhi(x[1]) * w0.w;
            out[4] += bflo(x[2]) * w1.x; out[5] += bfhi(x[2]) * w1.y; out[6] += bflo(x[3]) * w1.z; out[7] += bfhi(x[3]) * w1.w;
        }
    }
}
DEV float siluf_(float y) { return y / (1.f + __expf(-y)); }

DEV void stage_mstate(const Params& p, char* lds, int vb, int nvb) {
    const int tid = threadIdx.x, lane = tid & 63, wave = __builtin_amdgcn_readfirstlane(tid >> 6), fr = lane & 15, fq = lane >> 4;
    char* KT = lds;
    char* VT = lds + 34816;
    float* gs = (float*)(lds + 69632);
    const bf16_t* PM = (const bf16_t*)(p.ws + WS_PM);
    const float* ipre = (const float*)(p.ws + WS_IPRE); const float* fpre = (const float*)(p.ws + WS_FPRE);
    float* UT = (float*)(p.ws + WS_UB); float* NLOC = (float*)(p.ws + WS_NLOC);
    float* G = (float*)(p.ws + WS_CHG); float* MLOC = G + 1024;
    for (int unit = vb; unit < 1024; unit += nvb) {
        const int c = unit & 127, h = (unit >> 7) & 3, b = unit >> 9;
        const int rowbase = b * SEQ + c * 128;
        __syncthreads();
        if (wave == 0) chunk_gates(ipre, fpre, rowbase, h, gs, lane);
        __syncthreads();
        const float mloc = gs[513];
        for (int task = tid; task < 2048; task += NTH) {
            const int l = task >> 4, ch = task & 15;
            float v8[8]; conv8(PM, p.conv_w, b, c * 128 + l, 512 + h * 128 + ch * 8, 512 + h * 128 + ch * 8, v8);
            const float wgt = __expf(gs[256 + l] - mloc) * 0.08838834764831845f;
#pragma unroll
            for (int e = 0; e < 8; ++e) *(bf16_t*)(KT + (ch * 8 + e) * 272 + l * 2) = (bf16_t)f2bf(siluf_(v8[e]) * wgt);
        }
        for (int task = tid; task < 2048; task += NTH) {
            const int l = task >> 4, ch = task & 15;
            const u32x4 x = *(const u32x4*)(PM + (size_t)(rowbase + l) * LPM + 1024 + h * 128 + ch * 8);
#pragma unroll
            for (int e = 0; e < 8; ++e) *(bf16_t*)(VT + (ch * 8 + e) * 272 + l * 2) = (bf16_t)((e & 1) ? (x[e >> 1] >> 16) : (x[e >> 1] & 0xffffu));
        }
        __syncthreads();
        f32x4 acc[8];
#pragma unroll
        for (int t = 0; t < 8; ++t) acc[t] = (f32x4){0.f, 0.f, 0.f, 0.f};
#pragma unroll
        for (int ks = 0; ks < 4; ++ks) {
            const bf16x8 vf = *(const bf16x8*)(VT + (16 * wave + fr) * 272 + (32 * ks + 8 * fq) * 2);
#pragma unroll
            for (int t = 0; t < 8; ++t) { const bf16x8 kf = *(const bf16x8*)(KT + (16 * t + fr) * 272 + (32 * ks + 8 * fq) * 2); acc[t] = mfma16(kf, vf, acc[t]); }
        }
        float* UTu = UT + (size_t)unit * 16384 + (16 * wave + fr) * 128 + 4 * fq;
#pragma unroll
        for (int t = 0; t < 8; ++t) *(f32x4*)(UTu + 16 * t) = acc[t];
        if (tid < 128) { float s = 0.f; for (int l = 0; l < 128; ++l) s += bf2f(*(const bf16_t*)(KT + tid * 272 + l * 2)); NLOC[unit * 128 + tid] = s; }
        if (tid == 0) { G[unit] = gs[512]; MLOC[unit] = mloc; }
    }
}

DEV void stage_mscan(const Params& p, char* lds, int vb, int nvb) {
    const int tid = threadIdx.x;
    float* s_dec = (float*)lds; float* s_scl = s_dec + 128;
    const float* UT = (const float*)(p.ws + WS_UB); const float* NLOC = (const float*)(p.ws + WS_NLOC);
    const float* G = (const float*)(p.ws + WS_CHG); const float* MLOC = G + 1024; float* MST = (float*)(p.ws + WS_CHG) + 2048;
    bf16_t* CST = (bf16_t*)(p.ws + WS_CST); float* NST = (float*)(p.ws + WS_NST);
    for (int item = vb; item < 256; item += nvb) {
        const int bh = item >> 5, part = item & 31;
        __syncthreads();
        if (tid == 0) {
            float m = 0.f;
            for (int c = 0; c < 128; ++c) { const int u = bh * 128 + c; const float g = G[u], ml = MLOC[u]; const float mn = fmaxf(g + m, ml); s_dec[c] = expf(g + m - mn); s_scl[c] = expf(ml - mn); if (part == 0) MST[u] = m; m = mn; }
        }
        __syncthreads();
        const int e = part * 512 + tid;
        float C = 0.f;
        const float* up = UT + (size_t)bh * 128 * 16384 + e; bf16_t* cp = CST + (size_t)bh * 128 * 16384 + e;
        for (int c = 0; c < 128; c += 8) {
            float uu[8];
#pragma unroll
            for (int i = 0; i < 8; ++i) uu[i] = up[(size_t)(c + i) * 16384];
#pragma unroll
            for (int i = 0; i < 8; ++i) { cp[(size_t)(c + i) * 16384] = (bf16_t)f2bf(C); C = s_dec[c + i] * C + s_scl[c + i] * uu[i]; }
        }
        if (part == 0 && tid < 128) { float nn = 0.f; for (int c = 0; c < 128; ++c) { NST[(bh * 128 + c) * 128 + tid] = nn; nn = s_dec[c] * nn + s_scl[c] * NLOC[(bh * 128 + c) * 128 + tid]; } }
    }
}

DEV void stage_mout(const Params& p, char* lds, int vb, int nvb) {
    const int tid = threadIdx.x, lane = tid & 63, wave = __builtin_amdgcn_readfirstlane(tid >> 6), fr = lane & 15, fq = lane >> 4;
    char* Qs = lds; char* Ks = lds + 34816; char* VT = lds + 69632; char* CT = lds + 104448;
    float* gs = (float*)(lds + 139264); float* s_nst = gs + 520; float* s_mo = gs + 648; float* s_wi = gs + 776;
    bf16_t* PM = (bf16_t*)(p.ws + WS_PM);
    const float* ipre = (const float*)(p.ws + WS_IPRE); const float* fpre = (const float*)(p.ws + WS_FPRE);
    const float* MST = (const float*)(p.ws + WS_CHG) + 2048; const float* NST = (const float*)(p.ws + WS_NST);
    const bf16_t* CST = (const bf16_t*)(p.ws + WS_CST);
    for (int unit = vb; unit < 1024; unit += nvb) {
        const int c = unit & 127, h = (unit >> 7) & 3, b = unit >> 9;
        const int rowbase = b * SEQ + c * 128;
        __syncthreads();
        if (wave == 0) chunk_gates(ipre, fpre, rowbase, h, gs, lane);
        for (int task = tid; task < 2048; task += NTH) {
            const int l = task >> 4, ch = task & 15;
            float v8[8]; u32x4 o;
            conv8(PM, p.conv_w, b, c * 128 + l, h * 128 + ch * 8, h * 128 + ch * 8, v8);
            o.x = pk2(siluf_(v8[0]), siluf_(v8[1])); o.y = pk2(siluf_(v8[2]), siluf_(v8[3])); o.z = pk2(siluf_(v8[4]), siluf_(v8[5])); o.w = pk2(siluf_(v8[6]), siluf_(v8[7]));
            *(u32x4*)(Qs + l * 272 + ch * 16) = o;
            conv8(PM, p.conv_w, b, c * 128 + l, 512 + h * 128 + ch * 8, 512 + h * 128 + ch * 8, v8);
            const float sc = 0.08838834764831845f;
            o.x = pk2(siluf_(v8[0]) * sc, siluf_(v8[1]) * sc); o.y = pk2(siluf_(v8[2]) * sc, siluf_(v8[3]) * sc); o.z = pk2(siluf_(v8[4]) * sc, siluf_(v8[5]) * sc); o.w = pk2(siluf_(v8[6]) * sc, siluf_(v8[7]) * sc);
            *(u32x4*)(Ks + l * 272 + ch * 16) = o;
            const u32x4 x = *(const u32x4*)(PM + (size_t)(rowbase + l) * LPM + 1024 + h * 128 + ch * 8);
#pragma unroll
            for (int e = 0; e < 8; ++e) *(bf16_t*)(VT + (ch * 8 + e) * 272 + l * 2) = (bf16_t)((e & 1) ? (x[e >> 1] >> 16) : (x[e >> 1] & 0xffffu));
            *(u32x4*)(CT + l * 272 + ch * 16) = *(const u32x4*)(CST + (size_t)unit * 16384 + l * 128 + ch * 8);
        }
        if (tid < 128) s_nst[tid] = NST[unit * 128 + tid];
        __syncthreads();
        if (tid < 128) { const float mst = MST[unit]; const float bc = gs[tid]; const float mo = bc + fmaxf(mst, gs[384 + tid]); s_mo[tid] = mo; s_wi[tid] = __expf(bc + mst - mo); }
        __syncthreads();
        const int l = 16 * wave + fr;
        f32x4 s[8];
        bf16x8 qf[4];
#pragma unroll
        for (int ks = 0; ks < 4; ++ks) qf[ks] = *(const bf16x8*)(Qs + l * 272 + (32 * ks + 8 * fq) * 2);
#pragma unroll
        for (int t = 0; t < 8; ++t) {
            s[t] = (f32x4){0.f, 0.f, 0.f, 0.f};
            if (t <= wave) {
#pragma unroll
                for (int ks = 0; ks < 4; ++ks) { const bf16x8 kf = *(const bf16x8*)(Ks + (16 * t + fr) * 272 + (32 * ks + 8 * fq) * 2); s[t] = mfma16(kf, qf[ks], s[t]); }
            }
        }
        const float bl = gs[l], mol = s_mo[l];
        float dsum = 0.f;
#pragma unroll
        for (int t = 0; t < 8; ++t)
#pragma unroll
            for (int r = 0; r < 4; ++r) {
                const int si = 16 * t + 4 * fq + r; float wv = 0.f;
                if (t <= wave && si <= l) wv = __expf(bl + gs[128 + si] - mol) * s[t][r];
                s[t][r] = wv; dsum += wv;
            }
        dsum += __shfl_xor(dsum, 16); dsum += __shfl_xor(dsum, 32);
        float qn = 0.f;
        {
            const char* qrow = Qs + l * 272 + fq * 64;
#pragma unroll
            for (int i = 0; i < 4; ++i) {
                const u32x4 x = *(const u32x4*)(qrow + 16 * i); const float* nn = s_nst + fq * 32 + 8 * i;
                qn += bflo(x[0]) * nn[0] + bfhi(x[0]) * nn[1] + bflo(x[1]) * nn[2] + bfhi(x[1]) * nn[3] + bflo(x[2]) * nn[4] + bfhi(x[2]) * nn[5] + bflo(x[3]) * nn[6] + bfhi(x[3]) * nn[7];
            }
        }
        qn += __shfl_xor(qn, 16); qn += __shfl_xor(qn, 32);
        __syncthreads();
#pragma unroll
        for (int t = 0; t < 8; ++t)
            if (t <= wave + 1) { u32x2 o; o.x = pk2(s[t][0], s[t][1]); o.y = pk2(s[t][2], s[t][3]); *(u32x2*)(Ks + l * 272 + (16 * t + 4 * fq) * 2) = o; }
        __syncthreads();
        f32x4 acc[8];
#pragma unroll
        for (int t = 0; t < 8; ++t) acc[t] = (f32x4){0.f, 0.f, 0.f, 0.f};
#pragma unroll
        for (int ks = 0; ks < 4; ++ks)
#pragma unroll
            for (int t = 0; t < 8; ++t) { const bf16x8 cf = *(const bf16x8*)(CT + (16 * t + fr) * 272 + (32 * ks + 8 * fq) * 2); acc[t] = mfma16(cf, qf[ks], acc[t]); }
        const float wi = s_wi[l];
#pragma unroll
        for (int t = 0; t < 8; ++t) acc[t] = acc[t] * wi;
        const int nks = (wave + 2) >> 1;
#pragma unroll
        for (int ks = 0; ks < 4; ++ks)
            if (ks < nks) {
                const bf16x8 wf = *(const bf16x8*)(Ks + l * 272 + (32 * ks + 8 * fq) * 2);
#pragma unroll
                for (int t = 0; t < 8; ++t) { const bf16x8 vf = *(const bf16x8*)(VT + (16 * t + fr) * 272 + (32 * ks + 8 * fq) * 2); acc[t] = mfma16(vf, wf, acc[t]); }
            }
        const float den = dsum + wi * qn;
        const float invd = 1.f / fmaxf(fabsf(den), __expf(-mol));
        bf16_t* mop = PM + (size_t)(rowbase + l) * LPM + 1536 + h * 128 + 4 * fq;
        float ssq = 0.f;
#pragma unroll
        for (int t = 0; t < 8; ++t) {
            const u32x2 g2 = *(const u32x2*)(mop + 16 * t);
            const float gg[4] = {bflo(g2.x), bfhi(g2.x), bflo(g2.y), bfhi(g2.y)};
#pragma unroll
            for (int r = 0; r < 4; ++r) { const float hv = acc[t][r] * invd * sigmoidf_(gg[r]); acc[t][r] = hv; ssq += hv * hv; }
        }
        ssq += __shfl_xor(ssq, 16); ssq += __shfl_xor(ssq, 32);
        const float rn = rsqrtf(ssq * (1.f / 128.f) + 1e-6f);
#pragma unroll
        for (int t = 0; t < 8; ++t) {
            const float4 nw = *(const float4*)(p.mnorm_w + h * 128 + 16 * t + 4 * fq);
            u32x2 o; o.x = pk2(acc[t][0] * rn * nw.x, acc[t][1] * rn * nw.y); o.y = pk2(acc[t][2] * rn * nw.z, acc[t][3] * rn * nw.w);
            *(u32x2*)(mop + 16 * t) = o;
        }
    }
}

DEV void stage_norm2(const Params& p, char* lds, int vb, int nvb) {
    const int tid = threadIdx.x, lane = tid & 63, wave = __builtin_amdgcn_readfirstlane(tid >> 6);
    const float* mod = (const float*)(p.ws + WS_MOD);
    bf16_t* U2 = (bf16_t*)(p.ws + WS_PG);
    for (int m = vb * NW + wave; m < M; m += nvb * NW) {
        const int b = m >= SEQ ? 1 : 0;
        const float4* xr = (const float4*)(p.out + (size_t)m * D);
        float4 v[4]; float ss = 0.f;
#pragma unroll
        for (int j = 0; j < 4; ++j) { v[j] = xr[lane + 64 * j]; ss += v[j].x * v[j].x + v[j].y * v[j].y + v[j].z * v[j].z + v[j].w * v[j].w; }
        ss = wave_sum(ss);
        const float rstd = rsqrtf(ss * (1.f / 1024.f) + 1e-6f);
#pragma unroll
        for (int j = 0; j < 4; ++j) {
            const int col = 4 * (lane + 64 * j);
            const float4 w1 = *(const float4*)(p.norm2_w + col), sc = *(const float4*)(mod + b * 6144 + 4096 + col), sh = *(const float4*)(mod + b * 6144 + 3072 + col);
            u32x2 o;
            o.x = pk2(v[j].x * rstd * w1.x * (1.f + sc.x) + sh.x, v[j].y * rstd * w1.y * (1.f + sc.y) + sh.y);
            o.y = pk2(v[j].z * rstd * w1.z * (1.f + sc.z) + sh.z, v[j].w * rstd * w1.w * (1.f + sc.w) + sh.w);
            *(u32x2*)(U2 + (size_t)m * D + col) = o;
        }
    }
}

DEV void stage_peer(const Params& p, char* lds, int vb, int nvb) {
    const int tid = threadIdx.x, lane = tid & 63, wave = __builtin_amdgcn_readfirstlane(tid >> 6);
    char* s_keys = lds;
    char* qw = lds + 66560 + wave * 4096;
    float* tops = (float*)(lds + 99328 + wave * 256); int* topi = (int*)(tops + 32);
    int* sidx = (int*)(lds + 101376 + wave * 1088); float* sgate = (float*)(sidx + 128); float* bests = sgate + 128;
    const bf16_t* SK = (const bf16_t*)(p.ws + WS_SK); const bf16_t* QY = (const bf16_t*)(p.ws + WS_PM); const bf16_t* U2 = (const bf16_t*)(p.ws + WS_PG);
    const bf16_t* TU = (const bf16_t*)(p.ws + WS_TU); const bf16_t* TV = (const bf16_t*)(p.ws + WS_TV);
    const float* mod = (const float*)(p.ws + WS_MOD);
    for (int i = tid; i < 2 * 128 * 64; i += NTH) { const int pk = i >> 6, d2 = i & 63; *(unsigned*)(s_keys + pk * 260 + d2 * 4) = ((const unsigned*)SK)[pk * 64 + d2]; }
    __syncthreads();
    for (int tkn = vb * NW + wave; tkn < M; tkn += nvb * NW) {
#pragma unroll
        for (int i = 0; i < 4; ++i) *(u32x4*)(qw + (lane + 64 * i) * 16) = *(const u32x4*)(QY + (size_t)tkn * 2048 + (lane + 64 * i) * 8);
        wave_lds_sync();
        for (int h = 0; h < 8; ++h) {
            for (int pp = 0; pp < 2; ++pp) {
                const char* qseg = qw + (h * 256 + pp * 128) * 2;
                const char* k0 = s_keys + (pp * 128 + lane) * 260; const char* k1 = k0 + 64 * 260;
                float s0 = 0.f, s1 = 0.f;
#pragma unroll 8
                for (int d2 = 0; d2 < 64; ++d2) {
                    const unsigned qv = *(const unsigned*)(qseg + d2 * 4), a = *(const unsigned*)(k0 + d2 * 4), bq = *(const unsigned*)(k1 + d2 * 4);
                    const float q0 = bflo(qv), q1 = bfhi(qv);
                    s0 += q0 * bflo(a) + q1 * bfhi(a); s1 += q0 * bflo(bq) + q1 * bfhi(bq);
                }
                for (int r = 0; r < 16; ++r) {
                    float bv; int bi;
                    if (s0 >= s1) { bv = s0; bi = lane; } else { bv = s1; bi = lane + 64; }
#pragma unroll
                    for (int o = 32; o > 0; o >>= 1) { const float ov = __shfl_xor(bv, o); const int oi = __shfl_xor(bi, o); if (ov > bv || (ov == bv && oi < bi)) { bv = ov; bi = oi; } }
                    if (lane == 0) { tops[pp * 16 + r] = bv; topi[pp * 16 + r] = bi; }
                    if (bi == lane) s0 = -INFINITY; else if (bi == lane + 64) s1 = -INFINITY;
                }
            }
            wave_lds_sync();
            float cs[4];
#pragma unroll
            for (int q = 0; q < 4; ++q) cs[q] = tops[lane >> 2] + tops[16 + (lane & 3) * 4 + q];
            for (int r = 0; r < 16; ++r) {
                float bv = cs[0]; int bi = lane * 4;
#pragma unroll
                for (int q = 1; q < 4; ++q) if (cs[q] > bv) { bv = cs[q]; bi = lane * 4 + q; }
#pragma unroll
                for (int o = 32; o > 0; o >>= 1) { const float ov = __shfl_xor(bv, o); const int oi = __shfl_xor(bi, o); if (ov > bv || (ov == bv && oi < bi)) { bv = ov; bi = oi; } }
                if (lane == 0) { bests[r] = bv; sidx[h * 16 + r] = topi[bi >> 4] * 128 + topi[16 + (bi & 15)]; }
#pragma unroll
                for (int q = 0; q < 4; ++q) if (lane * 4 + q == bi) cs[q] = -INFINITY;
            }
            wave_lds_sync();
            {
                const float v = bests[lane & 15]; const float e = __expf(v - bests[0]);
                float sm = e; sm += __shfl_xor(sm, 1); sm += __shfl_xor(sm, 2); sm += __shfl_xor(sm, 4); sm += __shfl_xor(sm, 8);
                if (lane < 16) sgate[h * 16 + lane] = e / sm;
            }
            wave_lds_sync();
        }
        float xa[16];
        {
            const u32x4* xr = (const u32x4*)(U2 + (size_t)tkn * D); const u32x4 x0 = xr[lane], x1 = xr[64 + lane];
#pragma unroll
            for (int i = 0; i < 4; ++i) { xa[2 * i] = bflo(x0[i]); xa[2 * i + 1] = bfhi(x0[i]); xa[8 + 2 * i] = bflo(x1[i]); xa[8 + 2 * i + 1] = bfhi(x1[i]); }
        }
        float oa[16];
#pragma unroll
        for (int i = 0; i < 16; ++i) oa[i] = 0.f;
        for (int e = 0; e < 128; ++e) {
            const int id = sidx[e]; const float gt = sgate[e];
            const u32x4* ur = (const u32x4*)(TU + (size_t)id * D); const u32x4 u0 = ur[lane], u1 = ur[64 + lane];
            const u32x4* vr = (const u32x4*)(TV + (size_t)id * D); const u32x4 v0 = vr[lane], v1 = vr[64 + lane];
            float d = 0.f;
#pragma unroll
            for (int i = 0; i < 4; ++i) d += xa[2 * i] * bflo(u0[i]) + xa[2 * i + 1] * bfhi(u0[i]) + xa[8 + 2 * i] * bflo(u1[i]) + xa[8 + 2 * i + 1] * bfhi(u1[i]);
            d = wave_sum(d);
            const float w = gt * 0.5f * d * (1.f + erff(d * 0.7071067811865476f));
#pragma unroll
            for (int i = 0; i < 4; ++i) { oa[2 * i] += w * bflo(v0[i]); oa[2 * i + 1] += w * bfhi(v0[i]); oa[8 + 2 * i] += w * bflo(v1[i]); oa[8 + 2 * i + 1] += w * bfhi(v1[i]); }
        }
        const int b = tkn >= SEQ ? 1 : 0;
        float* hr = p.out + (size_t)tkn * D;
        float y[16]; float ss = 0.f;
#pragma unroll
        for (int half = 0; half < 2; ++half)
#pragma unroll
            for (int q = 0; q < 2; ++q) {
                const int col = half * 512 + 8 * lane + 4 * q;
                const float4 hv = *(const float4*)(hr + col); const float4 g2 = *(const float4*)(mod + b * 6144 + 5120 + col);
                const int k = half * 8 + 4 * q;
                y[k] = hv.x + g2.x * oa[k]; y[k + 1] = hv.y + g2.y * oa[k + 1]; y[k + 2] = hv.z + g2.z * oa[k + 2]; y[k + 3] = hv.w + g2.w * oa[k + 3];
                ss += y[k] * y[k] + y[k + 1] * y[k + 1] + y[k + 2] * y[k + 2] + y[k + 3] * y[k + 3];
            }
        ss = wave_sum(ss);
        const float rstd = rsqrtf(ss * (1.f / 1024.f) + 1e-6f);
#pragma unroll
        for (int half = 0; half < 2; ++half)
#pragma unroll
            for (int q = 0; q < 2; ++q) {
                const int col = half * 512 + 8 * lane + 4 * q; const int k = half * 8 + 4 * q;
                const float4 nw = *(const float4*)(p.normf_w + col);
                float4 o; o.x = y[k] * rstd * nw.x; o.y = y[k + 1] * rstd * nw.y; o.z = y[k + 2] * rstd * nw.z; o.w = y[k + 3] * rstd * nw.w;
                *(float4*)(hr + col) = o;
            }
        wave_lds_sync();
    }
}

#define DEF_KERNEL(name, fn) __global__ void __launch_bounds__(512) name(Params p) { extern __shared__ __attribute__((aligned(16))) char lds[]; fn(p, lds, blockIdx.x, gridDim.x); }
DEF_KERNEL(k_prep, stage_prep)
DEF_KERNEL(k_norm1, stage_norm1)
DEF_KERNEL(k_gemm_in, stage_gemm_in)
DEF_KERNEL(k_attn, stage_attn)
DEF_KERNEL(k_mstate, stage_mstate)
DEF_KERNEL(k_mscan, stage_mscan)
DEF_KERNEL(k_mout, stage_mout)
DEF_KERNEL(k_gemm_merge, stage_gemm_merge)
DEF_KERNEL(k_gemm_out, stage_gemm_out)
DEF_KERNEL(k_norm2, stage_norm2)
DEF_KERNEL(k_gemm_q, stage_gemm_q)
DEF_KERNEL(k_peer, stage_peer)

extern "C" void kernel_launch(void* const* d_in, const int* in_sizes, int n_in, void* d_out, int out_size, void* d_ws, size_t ws_size, hipStream_t stream) {
    if (n_in != 20 || ws_size < WS_END) { fprintf(stderr, "kernel_launch: unexpected n_in %d or ws_size %zu\n", n_in, ws_size); return; }
    Params p{};
    p.x = (const float*)d_in[0]; p.c = (const float*)d_in[1]; p.w_ada = (const float*)d_in[2]; p.b_ada = (const float*)d_in[3]; p.norm1_w = (const float*)d_in[4];
    p.w_in = (const float*)d_in[5]; p.conv_w = (const float*)d_in[6]; p.sinks = (const float*)d_in[7]; p.i_bias = (const float*)d_in[8]; p.f_bias = (const float*)d_in[9];
    p.mnorm_w = (const float*)d_in[10]; p.w_a = (const float*)d_in[11]; p.w_b = (const float*)d_in[12]; p.w_out = (const float*)d_in[13]; p.norm2_w = (const float*)d_in[14];
    p.w_q = (const float*)d_in[15]; p.sub_keys = (const float*)d_in[16]; p.peer_u = (const float*)d_in[17]; p.peer_v = (const float*)d_in[18]; p.normf_w = (const float*)d_in[19];
    p.out = (float*)d_out; p.ws = (unsigned char*)d_ws;
    static bool attr_done = false;
    const int LDS_PREP = 16384 + 8 * 8448, LDS_NORM1 = 32768, LDS_GEMM = 65536, LDS_ATTN = 130048, LDS_MSTATE = 69632 + 2080, LDS_MSCAN = 1024, LDS_MOUT = 139264 + 3616, LDS_NORM2 = 16, LDS_PEER = 101376 + 8 * 1088;
    if (!attr_done) {
        attr_done = true;
        (void)hipFuncSetAttribute((const void*)k_prep, hipFuncAttributeMaxDynamicSharedMemorySize, LDS_PREP);
        (void)hipFuncSetAttribute((const void*)k_attn, hipFuncAttributeMaxDynamicSharedMemorySize, LDS_ATTN);
        (void)hipFuncSetAttribute((const void*)k_mstate, hipFuncAttributeMaxDynamicSharedMemorySize, LDS_MSTATE);
        (void)hipFuncSetAttribute((const void*)k_mout, hipFuncAttributeMaxDynamicSharedMemorySize, LDS_MOUT);
        (void)hipFuncSetAttribute((const void*)k_peer, hipFuncAttributeMaxDynamicSharedMemorySize, LDS_PEER);
        (void)hipFuncSetAttribute((const void*)k_gemm_in, hipFuncAttributeMaxDynamicSharedMemorySize, LDS_GEMM);
        (void)hipFuncSetAttribute((const void*)k_gemm_merge, hipFuncAttributeMaxDynamicSharedMemorySize, LDS_GEMM);
        (void)hipFuncSetAttribute((const void*)k_gemm_out, hipFuncAttributeMaxDynamicSharedMemorySize, LDS_GEMM);
        (void)hipFuncSetAttribute((const void*)k_gemm_q, hipFuncAttributeMaxDynamicSharedMemorySize, LDS_GEMM);
    }
    const dim3 grid(256), blk(512);
    hipLaunchKernelGGL(k_prep, grid, blk, LDS_PREP, stream, p);
    hipLaunchKernelGGL(k_norm1, grid, blk, LDS_NORM1, stream, p);
    hipLaunchKernelGGL(k_gemm_in, grid, blk, LDS_GEMM, stream, p);
    hipLaunchKernelGGL(k_attn, grid, blk, LDS_ATTN, stream, p);
    hipLaunchKernelGGL(k_mstate, grid, blk, LDS_MSTATE, stream, p);
    hipLaunchKernelGGL(k_mscan, grid, blk, LDS_MSCAN, stream, p);
    hipLaunchKernelGGL(k_mout, grid, blk, LDS_MOUT, stream, p);
    hipLaunchKernelGGL(k_gemm_merge, grid, blk, LDS_GEMM, stream, p);
    hipLaunchKernelGGL(k_gemm_out, grid, blk, LDS_GEMM, stream, p);
    hipLaunchKernelGGL(k_norm2, grid, blk, LDS_NORM2, stream, p);
    hipLaunchKernelGGL(k_gemm_q, grid, blk, LDS_GEMM, stream, p);
    hipLaunchKernelGGL(k_peer, grid, blk, LDS_PEER, stream, p);
}
```

```cpp
#include <hip/hip_runtime.h>
#include <hip/hip_cooperative_groups.h>
#include <stdint.h>
#include <stdio.h>

#define DEV __device__ __forceinline__
typedef unsigned short bf16_t;
typedef short bf16x8 __attribute__((ext_vector_type(8)));
typedef float f32x4 __attribute__((ext_vector_type(4)));
typedef unsigned u32x4 __attribute__((ext_vector_type(4)));
typedef unsigned u32x2 __attribute__((ext_vector_type(2)));

constexpr int BATCH = 2, SEQ = 16384, M = BATCH * SEQ, D = 1024;
constexpr int NTH = 512, NW = 8;
constexpr int LPA = 768, LPM = 2048, LPG = 2048;

struct Params {
    const float *x, *c, *w_ada, *b_ada, *norm1_w, *w_in, *conv_w, *sinks, *i_bias, *f_bias, *mnorm_w, *w_a, *w_b, *w_out, *norm2_w, *w_q, *sub_keys, *peer_u, *peer_v, *normf_w;
    float* out; unsigned char* ws;
};

constexpr size_t MiB = 1u << 20;
constexpr size_t WS_MOD = 1 * MiB;
constexpr size_t WS_IPRE = 2 * MiB;
constexpr size_t WS_FPRE = 2 * MiB + 512 * 1024;
constexpr size_t WS_CHG = 3 * MiB;
constexpr size_t WS_NLOC = 4 * MiB;
constexpr size_t WS_NST = 4 * MiB + 512 * 1024;
constexpr size_t WS_ROPE = 5 * MiB;
constexpr size_t WS_WIN = 10 * MiB;
constexpr size_t WS_WA = 20 * MiB;
constexpr size_t WS_WB = 21 * MiB;
constexpr size_t WS_WOUT = 22 * MiB;
constexpr size_t WS_WQ = 24 * MiB;
constexpr size_t WS_SK = 28 * MiB;
constexpr size_t WS_TU = 32 * MiB;
constexpr size_t WS_TV = 64 * MiB;
constexpr size_t WS_UB = 96 * MiB;
constexpr size_t WS_PA = 160 * MiB;
constexpr size_t WS_PM = 208 * MiB;
constexpr size_t WS_PG = 336 * MiB;
constexpr size_t WS_CST = 464 * MiB;
constexpr size_t WS_END = 496 * MiB;

DEV unsigned f2bf(float f) { unsigned u = __float_as_uint(f); return (u + 0x7fffu + ((u >> 16) & 1u)) >> 16; }
DEV unsigned pk2(float lo, float hi) { return f2bf(lo) | (f2bf(hi) << 16); }
DEV float bflo(unsigned u) { return __uint_as_float(u << 16); }
DEV float bfhi(unsigned u) { return __uint_as_float(u & 0xffff0000u); }
DEV float bf2f(bf16_t h) { return __uint_as_float(((unsigned)h) << 16); }
DEV float wave_sum(float v) {
#pragma unroll
    for (int o = 32; o > 0; o >>= 1) v += __shfl_xor(v, o);
    return v;
}
DEV float wave_max(float v) {
#pragma unroll
    for (int o = 32; o > 0; o >>= 1) v = fmaxf(v, __shfl_xor(v, o));
    return v;
}
DEV float sigmoidf_(float v) { return 1.f / (1.f + __expf(-v)); }
DEV f32x4 mfma16(bf16x8 a, bf16x8 b, f32x4 c) { return __builtin_amdgcn_mfma_f32_16x16x32_bf16(a, b, c, 0, 0, 0); }
DEV void wave_lds_sync() { __builtin_amdgcn_fence(__ATOMIC_ACQ_REL, "wavefront"); __builtin_amdgcn_wave_barrier(); }

DEV void transpose_item(const float* W, int ldw, int k0, int nsrc0, bf16_t* WT, int ldt, int ndst0, float* scr, int lane) {
#pragma unroll 8
    for (int i = 0; i < 32; ++i) { const int kk = 2 * i + (lane >> 5); scr[kk * 33 + (lane & 31)] = W[(size_t)(k0 + kk) * ldw + nsrc0 + (lane & 31)]; }
    wave_lds_sync();
    const int c = lane & 7;
#pragma unroll
    for (int j = 0; j < 4; ++j) {
        const int n = (lane >> 3) + 8 * j; const float* s = scr + (8 * c) * 33 + n;
        u32x4 o; o.x = pk2(s[0 * 33], s[1 * 33]); o.y = pk2(s[2 * 33], s[3 * 33]); o.z = pk2(s[4 * 33], s[5 * 33]); o.w = pk2(s[6 * 33], s[7 * 33]);
        *(u32x4*)(WT + (size_t)(ndst0 + n) * ldt + k0 + 8 * c) = o;
    }
    wave_lds_sync();
}

DEV void stage_prep(const Params& p, char* lds, int vb, int nvb) {
    const int tid = threadIdx.x, lane = tid & 63, wave = __builtin_amdgcn_readfirstlane(tid >> 6);
    float* mod = (float*)(p.ws + WS_MOD);
    float* s_act = (float*)lds;
    float* s_red = (float*)(lds + 8192);
    for (int i = tid; i < 2048; i += NTH) { const float v = p.c[i]; s_act[i] = v / (1.f + expf(-v)); }
    __syncthreads();
    for (int item = vb; item < 192; item += nvb) {
        const int kg = tid >> 5, cl = tid & 31, col = item * 32 + cl;
        float s0 = 0.f, s1 = 0.f;
        for (int k = kg; k < 1024; k += 16) { const float w = p.w_ada[(size_t)k * 6144 + col]; s0 += s_act[k] * w; s1 += s_act[1024 + k] * w; }
        s_red[(kg * 32 + cl) * 2] = s0; s_red[(kg * 32 + cl) * 2 + 1] = s1;
        __syncthreads();
        if (tid < 64) { const int b = tid >> 5, c2 = tid & 31; float s = 0.f; for (int g = 0; g < 16; ++g) s += s_red[(g * 32 + c2) * 2 + b]; mod[b * 6144 + item * 32 + c2] = s + p.b_ada[item * 32 + c2]; }
        __syncthreads();
    }
    float* scr = (float*)(lds + 16384 + wave * 8448);
    const int gw = vb * NW + wave, ngw = nvb * NW;
    bf16_t* Wt_in = (bf16_t*)(p.ws + WS_WIN); bf16_t* Wt_a = (bf16_t*)(p.ws + WS_WA); bf16_t* Wt_b = (bf16_t*)(p.ws + WS_WB);
    bf16_t* Wt_out = (bf16_t*)(p.ws + WS_WOUT); bf16_t* Wt_q = (bf16_t*)(p.ws + WS_WQ);
    for (int it = gw; it < 4480; it += ngw) {
        int r = it;
        if (r < 2432) { const int kb = r / 152, nb = r % 152; transpose_item(p.w_in, 4872, kb * 64, nb * 32 + (nb >= 88 ? 8 : 0), Wt_in, 1024, nb * 32, scr, lane); continue; } r -= 2432;
        if (r < 256) { const int kb = r / 32, nb = r % 32; transpose_item(p.w_a, 1024, kb * 64, nb * 32, Wt_a, 512, nb * 32, scr, lane); continue; } r -= 256;
        if (r < 256) { const int kb = r / 32, nb = r % 32; transpose_item(p.w_b, 1024, kb * 64, nb * 32, Wt_b, 512, nb * 32, scr, lane); continue; } r -= 256;
        if (r < 512) { const int kb = r / 32, nb = r % 32; transpose_item(p.w_out, 1024, kb * 64, nb * 32, Wt_out, 1024, nb * 32, scr, lane); continue; } r -= 512;
        { const int kb = r / 64, nb = r % 64; transpose_item(p.w_q, 2048, kb * 64, nb * 32, Wt_q, 1024, nb * 32, scr, lane); }
    }
    const size_t gt = (size_t)vb * NTH + tid, ngt = (size_t)nvb * NTH;
    for (size_t g = gt; g < 2 * 2097152 + 4096; g += ngt) {
        const float* src; bf16_t* dst; size_t o;
        if (g < 2097152) { src = p.peer_u; dst = (bf16_t*)(p.ws + WS_TU); o = g; }
        else if (g < 4194304) { src = p.peer_v; dst = (bf16_t*)(p.ws + WS_TV); o = g - 2097152; }
        else { src = p.sub_keys; dst = (bf16_t*)(p.ws + WS_SK); o = g - 4194304; }
        const float4 a = ((const float4*)src)[2 * o], b = ((const float4*)src)[2 * o + 1];
        u32x4 w; w.x = pk2(a.x, a.y); w.y = pk2(a.z, a.w); w.z = pk2(b.x, b.y); w.w = pk2(b.z, b.w);
        ((u32x4*)dst)[o] = w;
    }
    float2* rope = (float2*)(p.ws + WS_ROPE);
    for (size_t e = gt; e < 16384 * 32; e += ngt) {
        const int pos = (int)(e >> 5), i = (int)(e & 31);
        const float inv = (float)exp2(-(double)i * (13.287712379549449 / 32.0));
        const float ang = (float)pos * inv;
        const double a = (double)ang; const double n = rint(a * 0.15915494309189535); const double r = a - n * 6.283185307179586;
        float s, c; sincosf((float)r, &s, &c);
        rope[e] = make_float2(c, s);
    }
}

DEV void stage_norm1(const Params& p, char* lds, int vb, int nvb) {
    const int tid = threadIdx.x, lane = tid & 63, wave = __builtin_amdgcn_readfirstlane(tid >> 6);
    float* wg = (float*)lds;
    for (int i = tid; i < 8192; i += NTH) { const int cc = i >> 10, k = i & 1023; wg[i] = p.w_in[(size_t)k * 4872 + 2816 + cc]; }
    __syncthreads();
    const float* mod = (const float*)(p.ws + WS_MOD);
    bf16_t* ub = (bf16_t*)(p.ws + WS_UB);
    float* ipre = (float*)(p.ws + WS_IPRE); float* fpre = (float*)(p.ws + WS_FPRE);
    for (int m = vb * NW + wave; m < M; m += nvb * NW) {
        const int b = m >= SEQ ? 1 : 0;
        const float4* xr = (const float4*)(p.x + (size_t)m * D);
        float4 v[4]; float ss = 0.f;
#pragma unroll
        for (int j = 0; j < 4; ++j) { v[j] = xr[lane + 64 * j]; ss += v[j].x * v[j].x + v[j].y * v[j].y + v[j].z * v[j].z + v[j].w * v[j].w; }
        ss = wave_sum(ss);
        const float rstd = rsqrtf(ss * (1.f / 1024.f) + 1e-6f);
        float ga[8];
#pragma unroll
        for (int cc = 0; cc < 8; ++cc) ga[cc] = 0.f;
#pragma unroll
        for (int j = 0; j < 4; ++j) {
            const int col = 4 * (lane + 64 * j);
            const float4 w1 = *(const float4*)(p.norm1_w + col), sc = *(const float4*)(mod + b * 6144 + 1024 + col), sh = *(const float4*)(mod + b * 6144 + col);
            float4 u;
            u.x = v[j].x * rstd * w1.x * (1.f + sc.x) + sh.x; u.y = v[j].y * rstd * w1.y * (1.f + sc.y) + sh.y;
            u.z = v[j].z * rstd * w1.z * (1.f + sc.z) + sh.z; u.w = v[j].w * rstd * w1.w * (1.f + sc.w) + sh.w;
            u32x2 o; o.x = pk2(u.x, u.y); o.y = pk2(u.z, u.w);
            *(u32x2*)(ub + (size_t)m * D + col) = o;
#pragma unroll
            for (int cc = 0; cc < 8; ++cc) { const float4 g = *(const float4*)(wg + cc * 1024 + col); ga[cc] += u.x * g.x + u.y * g.y + u.z * g.z + u.w * g.w; }
        }
#pragma unroll
        for (int cc = 0; cc < 8; ++cc) ga[cc] = wave_sum(ga[cc]);
        if (lane == 0) {
#pragma unroll
            for (int h = 0; h < 4; ++h) { ipre[(size_t)m * 4 + h] = ga[h] + p.i_bias[h]; fpre[(size_t)m * 4 + h] = ga[4 + h] + p.f_bias[h]; }
        }
    }
}

struct GemmOp { const bf16_t* A; int lda; const bf16_t* Bt; int ldb; int K; };

DEV void gemm_tile(f32x4 (&acc)[4][2], const GemmOp& g, int m0, int n0, char* lds) {
    const int tid = threadIdx.x, lane = tid & 63, wid = __builtin_amdgcn_readfirstlane(tid >> 6), wm = wid >> 2, wn = wid & 3, fr = lane & 15, fq = lane >> 4;
    const int sr = tid >> 3, sc = tid & 7;
    const bf16_t* ga = g.A + (size_t)(m0 + sr) * g.lda + sc * 8;
    const bf16_t* gb = g.Bt + (size_t)(n0 + sr) * g.ldb + sc * 8;
    const size_t a64 = (size_t)64 * g.lda, b64 = (size_t)64 * g.ldb;
    const int so = sr * 128 + ((sc ^ (sr & 7)) << 4);
    const int nk = g.K >> 6;
    u32x4 ra0 = *(const u32x4*)ga, ra1 = *(const u32x4*)(ga + a64), rb0 = *(const u32x4*)gb, rb1 = *(const u32x4*)(gb + b64);
    *(u32x4*)(lds + so) = ra0; *(u32x4*)(lds + so + 8192) = ra1; *(u32x4*)(lds + 32768 + so) = rb0; *(u32x4*)(lds + 32768 + so + 8192) = rb1;
    __syncthreads();
    const int aoff = (wm * 64 + fr) * 128, boff = 32768 + (wn * 32 + fr) * 128, sw = fr & 7;
    for (int kt = 0; kt < nk; ++kt) {
        const int cur = (kt & 1) * 16384;
        if (kt + 1 < nk) { ga += 64; gb += 64; ra0 = *(const u32x4*)ga; ra1 = *(const u32x4*)(ga + a64); rb0 = *(const u32x4*)gb; rb1 = *(const u32x4*)(gb + b64); }
#pragma unroll
        for (int ks = 0; ks < 2; ++ks) {
            const int ch = ((fq + 4 * ks) ^ sw) << 4;
            bf16x8 af[4], bfr[2];
#pragma unroll
            for (int mi = 0; mi < 4; ++mi) af[mi] = *(const bf16x8*)(lds + cur + aoff + mi * 2048 + ch);
#pragma unroll
            for (int ni = 0; ni < 2; ++ni) bfr[ni] = *(const bf16x8*)(lds + cur + boff + ni * 2048 + ch);
#pragma unroll
            for (int mi = 0; mi < 4; ++mi)
#pragma unroll
                for (int ni = 0; ni < 2; ++ni) acc[mi][ni] = mfma16(bfr[ni], af[mi], acc[mi][ni]);
        }
        if (kt + 1 < nk) {
            const int nxt = cur ^ 16384;
            *(u32x4*)(lds + nxt + so) = ra0; *(u32x4*)(lds + nxt + so + 8192) = ra1; *(u32x4*)(lds + 32768 + nxt + so) = rb0; *(u32x4*)(lds + 32768 + nxt + so + 8192) = rb1;
        }
        __syncthreads();
    }
}
#define GEMM_EPI_LOOP(...) { const int tid_ = threadIdx.x, lane_ = tid_ & 63, wid_ = tid_ >> 6, wm_ = wid_ >> 2, wn_ = wid_ & 3, fr_ = lane_ & 15, fq_ = lane_ >> 4; \
    _Pragma("unroll") for (int mi = 0; mi < 4; ++mi) _Pragma("unroll") for (int ni = 0; ni < 2; ++ni) { const int m = m0 + wm_ * 64 + mi * 16 + fr_, n = n0 + wn_ * 32 + ni * 16 + fq_ * 4; __VA_ARGS__ } }

DEV void stage_gemm_in(const Params& p, char* lds, int vb, int nvb) {
    GemmOp g{(const bf16_t*)(p.ws + WS_UB), 1024, (const bf16_t*)(p.ws + WS_WIN), 1024, 1024};
    bf16_t* PA = (bf16_t*)(p.ws + WS_PA); bf16_t* PM = (bf16_t*)(p.ws + WS_PM); bf16_t* PG = (bf16_t*)(p.ws + WS_PG);
    const int tn = 38, tiles = 256 * tn;
    for (int t = vb; t < tiles; t += nvb) {
        const int m0 = (t / tn) * 128, n0 = (t % tn) * 128;
        f32x4 acc[4][2];
#pragma unroll
        for (int i = 0; i < 4; ++i) { acc[i][0] = (f32x4){0.f, 0.f, 0.f, 0.f}; acc[i][1] = (f32x4){0.f, 0.f, 0.f, 0.f}; }
        gemm_tile(acc, g, m0, n0, lds);
        bf16_t* dst; int ld, nb;
        if (n0 < 768) { dst = PA; ld = LPA; nb = n0; } else if (n0 < 2816) { dst = PM; ld = LPM; nb = n0 - 768; } else { dst = PG; ld = LPG; nb = n0 - 2816; }
        GEMM_EPI_LOOP({ const f32x4 v = acc[mi][ni]; u32x2 o; o.x = pk2(v[0], v[1]); o.y = pk2(v[2], v[3]); *(u32x2*)(dst + (size_t)m * ld + (n - n0 + nb)) = o; })
    }
}

DEV void stage_gemm_merge(const Params& p, char* lds, int vb, int nvb) {
    GemmOp g1{(const bf16_t*)(p.ws + WS_PA), LPA, (const bf16_t*)(p.ws + WS_WA), 512, 512};
    GemmOp g2{(const bf16_t*)(p.ws + WS_PM) + 1536, LPM, (const bf16_t*)(p.ws + WS_WB), 512, 512};
    const bf16_t* PG = (const bf16_t*)(p.ws + WS_PG); bf16_t* MG = (bf16_t*)(p.ws + WS_UB);
    const int tn = 8, tiles = 256 * tn;
    for (int t = vb; t < tiles; t += nvb) {
        const int m0 = (t / tn) * 128, n0 = (t % tn) * 128;
        f32x4 acc[4][2], acc2[4][2];
#pragma unroll
        for (int i = 0; i < 4; ++i) { acc[i][0] = (f32x4){0.f, 0.f, 0.f, 0.f}; acc[i][1] = acc[i][0]; acc2[i][0] = acc[i][0]; acc2[i][1] = acc[i][0]; }
        gemm_tile(acc, g1, m0, n0, lds);
        gemm_tile(acc2, g2, m0, n0, lds);
        GEMM_EPI_LOOP({ const f32x4 v1 = acc[mi][ni], v2 = acc2[mi][ni];
            const u32x2 a = *(const u32x2*)(PG + (size_t)m * LPG + n), b = *(const u32x2*)(PG + (size_t)m * LPG + 1024 + n);
            const float r0 = sigmoidf_(bflo(a.x)) * v1[0] + sigmoidf_(bflo(b.x)) * v2[0], r1 = sigmoidf_(bfhi(a.x)) * v1[1] + sigmoidf_(bfhi(b.x)) * v2[1];
            const float r2 = sigmoidf_(bflo(a.y)) * v1[2] + sigmoidf_(bflo(b.y)) * v2[2], r3 = sigmoidf_(bfhi(a.y)) * v1[3] + sigmoidf_(bfhi(b.y)) * v2[3];
            u32x2 o; o.x = pk2(r0, r1); o.y = pk2(r2, r3); *(u32x2*)(MG + (size_t)m * 1024 + n) = o; })
    }
}

DEV void stage_gemm_out(const Params& p, char* lds, int vb, int nvb) {
    GemmOp g{(const bf16_t*)(p.ws + WS_UB), 1024, (const bf16_t*)(p.ws + WS_WOUT), 1024, 1024};
    const float* mod = (const float*)(p.ws + WS_MOD);
    const int tn = 8, tiles = 256 * tn;
    for (int t = vb; t < tiles; t += nvb) {
        const int m0 = (t / tn) * 128, n0 = (t % tn) * 128;
        f32x4 acc[4][2];
#pragma unroll
        for (int i = 0; i < 4; ++i) { acc[i][0] = (f32x4){0.f, 0.f, 0.f, 0.f}; acc[i][1] = acc[i][0]; }
        gemm_tile(acc, g, m0, n0, lds);
        const int b = m0 >= SEQ ? 1 : 0;
        GEMM_EPI_LOOP({ const f32x4 v = acc[mi][ni]; const f32x4 xv = *(const f32x4*)(p.x + (size_t)m * D + n); const f32x4 gv = *(const f32x4*)(mod + b * 6144 + 2048 + n);
            *(f32x4*)(p.out + (size_t)m * D + n) = xv + gv * v; })
    }
}

DEV void stage_gemm_q(const Params& p, char* lds, int vb, int nvb) {
    GemmOp g{(const bf16_t*)(p.ws + WS_PG), 1024, (const bf16_t*)(p.ws + WS_WQ), 1024, 1024};
    bf16_t* QY = (bf16_t*)(p.ws + WS_PM);
    const int tn = 16, tiles = 256 * tn;
    for (int t = vb; t < tiles; t += nvb) {
        const int m0 = (t / tn) * 128, n0 = (t % tn) * 128;
        f32x4 acc[4][2];
#pragma unroll
        for (int i = 0; i < 4; ++i) { acc[i][0] = (f32x4){0.f, 0.f, 0.f, 0.f}; acc[i][1] = acc[i][0]; }
        gemm_tile(acc, g, m0, n0, lds);
        GEMM_EPI_LOOP({ const f32x4 v = acc[mi][ni]; u32x2 o; o.x = pk2(v[0], v[1]); o.y = pk2(v[2], v[3]); *(u32x2*)(QY + (size_t)m * 2048 + n) = o; })
    }
}

DEV void rope8(u32x4 x1, u32x4 x2, const float4* rp, float scale, u32x4& o1, u32x4& o2) {
#pragma unroll
    for (int w = 0; w < 4; ++w) {
        const float4 cs = rp[w];
        const float a0 = bflo(x1[w]), a1 = bfhi(x1[w]), b0 = bflo(x2[w]), b1 = bfhi(x2[w]);
        o1[w] = pk2((a0 * cs.x - b0 * cs.y) * scale, (a1 * cs.z - b1 * cs.w) * scale);
        o2[w] = pk2((b0 * cs.x + a0 * cs.y) * scale, (b1 * cs.z + a1 * cs.w) * scale);
    }
}

DEV void stage_attn(const Params& p, char* lds, int vb, int nvb) {
    const int tid = threadIdx.x, lane = tid & 63, wave = __builtin_amdgcn_readfirstlane(tid >> 6), fr = lane & 15, fq = lane >> 4;
    char* Ks = lds;
    char* VT = lds + 32768;
    char* Qs = lds + 70656;
    char* Ps = lds + 87040;
    bf16_t* PA = (bf16_t*)(p.ws + WS_PA);
    const float2* rope = (const float2*)(p.ws + WS_ROPE);
    for (int unit = vb; unit < 512; unit += nvb) {
        const int kvh = unit & 1, n = (unit >> 1) & 127, b = unit >> 8;
        __syncthreads();
        for (int task = tid; task < 1024; task += NTH) {
            const int ki = task >> 2, cp = task & 3, pos = 128 * (n - 1) + ki;
            u32x4 o1 = {0u, 0u, 0u, 0u}, o2 = {0u, 0u, 0u, 0u};
            if (pos >= 0) {
                const bf16_t* src = PA + (size_t)(b * SEQ + pos) * LPA + 512 + kvh * 64 + cp * 8;
                const u32x4 x1 = *(const u32x4*)src, x2 = *(const u32x4*)(src + 32);
                rope8(x1, x2, (const float4*)(rope + (size_t)pos * 32 + cp * 8), 1.0f, o1, o2);
            }
            const int sw = ki & 7;
            *(u32x4*)(Ks + ki * 128 + ((cp ^ sw) << 4)) = o1;
            *(u32x4*)(Ks + ki * 128 + (((cp + 4) ^ sw) << 4)) = o2;
        }
        for (int task = tid; task < 2048; task += NTH) {
            const int ki = task >> 3, c = task & 7, pos = 128 * (n - 1) + ki;
            u32x4 x = {0u, 0u, 0u, 0u};
            if (pos >= 0) x = *(const u32x4*)(PA + (size_t)(b * SEQ + pos) * LPA + 640 + kvh * 64 + c * 8);
#pragma unroll
            for (int e = 0; e < 8; ++e) *(bf16_t*)(VT + (c * 8 + e) * 592 + ki * 2) = (bf16_t)((e & 1) ? (x[e >> 1] >> 16) : (x[e >> 1] & 0xffffu));
        }
        for (int i = tid; i < 64 * 40; i += NTH) { const int d = i / 40, kk = 256 + i % 40; *(bf16_t*)(VT + d * 592 + kk * 2) = 0; }
        for (int i = tid; i < 2048; i += NTH) { const int w = i >> 8, r = (i >> 4) & 15, kk = 144 + (i & 15); *(bf16_t*)(Ps + w * 5376 + r * 336 + kk * 2) = 0; }
        for (int j = 0; j < 4; ++j) {
            const int hq = kvh * 4 + j;
            {
                const int qi = tid >> 2, cp = tid & 3, pos = 128 * n + qi;
                const bf16_t* src = PA + (size_t)(b * SEQ + pos) * LPA + hq * 64 + cp * 8;
                const u32x4 x1 = *(const u32x4*)src, x2 = *(const u32x4*)(src + 32);
                u32x4 o1, o2;
                rope8(x1, x2, (const float4*)(rope + (size_t)pos * 32 + cp * 8), 0.125f, o1, o2);
                const int sw = qi & 7;
                *(u32x4*)(Qs + qi * 128 + ((cp ^ sw) << 4)) = o1;
                *(u32x4*)(Qs + qi * 128 + (((cp + 4) ^ sw) << 4)) = o2;
            }
            __syncthreads();
            f32x4 s[9];
            const int sw = fr & 7;
            bf16x8 qf[2];
#pragma unroll
            for (int ks = 0; ks < 2; ++ks) qf[ks] = *(const bf16x8*)(Qs + (16 * wave + fr) * 128 + (((fq + 4 * ks) ^ sw) << 4));
#pragma unroll
            for (int t = 0; t < 9; ++t) {
                s[t] = (f32x4){0.f, 0.f, 0.f, 0.f};
#pragma unroll
                for (int ks = 0; ks < 2; ++ks) { const bf16x8 kf = *(const bf16x8*)(Ks + (16 * (wave + t) + fr) * 128 + (((fq + 4 * ks) ^ sw) << 4)); s[t] = mfma16(kf, qf[ks], s[t]); }
            }
            const float sink = p.sinks[hq];
            float mx = sink;
#pragma unroll
            for (int t = 0; t < 9; ++t)
#pragma unroll
                for (int r = 0; r < 4; ++r) {
                    const int dd = 16 * t + 4 * fq + r - fr, ki = 16 * (wave + t) + 4 * fq + r;
                    const bool ok = (dd >= 1) && (dd <= 128) && (n > 0 || ki >= 128);
                    const float v = ok ? s[t][r] : -INFINITY;
                    s[t][r] = v; mx = fmaxf(mx, v);
                }
            mx = fmaxf(mx, __shfl_xor(mx, 16)); mx = fmaxf(mx, __shfl_xor(mx, 32));
            float sum = 0.f;
#pragma unroll
            for (int t = 0; t < 9; ++t)
#pragma unroll
                for (int r = 0; r < 4; ++r) { const float pv = __expf(s[t][r] - mx); s[t][r] = pv; sum += pv; }
            sum += __shfl_xor(sum, 16); sum += __shfl_xor(sum, 32);
            const float inv = 1.f / (sum + __expf(sink - mx));
            char* Pw = Ps + wave * 5376 + fr * 336;
#pragma unroll
            for (int t = 0; t < 9; ++t) { u32x2 o; o.x = pk2(s[t][0], s[t][1]); o.y = pk2(s[t][2], s[t][3]); *(u32x2*)(Pw + (16 * t + 4 * fq) * 2) = o; }
            __syncthreads();
            f32x4 o[4];
#pragma unroll
            for (int di = 0; di < 4; ++di) o[di] = (f32x4){0.f, 0.f, 0.f, 0.f};
#pragma unroll
            for (int ks = 0; ks < 5; ++ks) {
                const bf16x8 pf = *(const bf16x8*)(Pw + (32 * ks + 8 * fq) * 2);
#pragma unroll
                for (int di = 0; di < 4; ++di) { const bf16x8 vf = *(const bf16x8*)(VT + (16 * di + fr) * 592 + (16 * wave + 32 * ks + 8 * fq) * 2); o[di] = mfma16(vf, pf, o[di]); }
            }
            bf16_t* dst = PA + (size_t)(b * SEQ + 128 * n + 16 * wave + fr) * LPA + hq * 64 + 4 * fq;
#pragma unroll
            for (int di = 0; di < 4; ++di) { u32x2 w; w.x = pk2(o[di][0] * inv, o[di][1] * inv); w.y = pk2(o[di][2] * inv, o[di][3] * inv); *(u32x2*)(dst + 16 * di) = w; }
            __syncthreads();
        }
    }
}

DEV float logsigf(float x) { return fminf(x, 0.f) - log1pf(expf(-fabsf(x))); }

DEV void chunk_gates(const float* ipre, const float* fpre, int rowbase, int h, float* gs, int lane) {
    const int l0 = 2 * lane;
    const float i0 = ipre[(size_t)(rowbase + l0) * 4 + h], i1 = ipre[(size_t)(rowbase + l0 + 1) * 4 + h];
    const float lf0 = logsigf(fpre[(size_t)(rowbase + l0) * 4 + h]), lf1 = logsigf(fpre[(size_t)(rowbase + l0 + 1) * 4 + h]);
    const float pair = lf0 + lf1;
    float sc = pair;
#pragma unroll
    for (int o = 1; o < 64; o <<= 1) { const float t = __shfl_up(sc, o); if (lane >= o) sc += t; }
    const float b0 = (sc - pair) + lf0, b1 = b0 + lf1;
    const float g = __shfl(sc, 63);
    const float a0 = g - b0 + i0, a1 = g - b1 + i1;
    const float mloc = wave_max(fmaxf(a0, a1));
    const float ib0 = i0 - b0, ib1 = i1 - b1;
    float scm = fmaxf(ib0, ib1);
#pragma unroll
    for (int o = 1; o < 64; o <<= 1) { const float t = __shfl_up(scm, o); if (lane >= o) scm = fmaxf(scm, t); }
    float ex = __shfl_up(scm, 1); if (lane == 0) ex = -INFINITY;
    const float pm0 = fmaxf(ex, ib0), pm1 = fmaxf(pm0, ib1);
    gs[l0] = b0; gs[l0 + 1] = b1; gs[128 + l0] = ib0; gs[128 + l0 + 1] = ib1; gs[256 + l0] = a0; gs[256 + l0 + 1] = a1; gs[384 + l0] = pm0; gs[384 + l0 + 1] = pm1;
    if (lane == 0) { gs[512] = g; gs[513] = mloc; }
}

DEV void conv8(const bf16_t* PM, const float* cw, int b, int t, int pmcol, int cch, float (&out)[8]) {
#pragma unroll
    for (int e = 0; e < 8; ++e) out[e] = 0.f;
#pragma unroll
    for (int j = 0; j < 4; ++j) {
        const int tt = t - 3 + j;
        if (tt >= 0) {
            const u32x4 x = *(const u32x4*)(PM + (size_t)(b * SEQ + tt) * LPM + pmcol);
            const float4 w0 = *(const float4*)(cw + j * 1024 + cch), w1 = *(const float4*)(cw + j * 1024 + cch + 4);
            out[0] += bflo(x[0]) * w0.x; out[1] += bfhi(x[0]) * w0.y; out[2] += bflo(x[1]) * w0.z; out[3] += bfhi(x[1]) * w0.w;
            out[4] += bflo(x[2]) * w1.x; out[5] += bfhi(x[2]) * w1.y; out[6] += bflo(x[3]) * w1.z; out[7] += bfhi(x[3]) * w1.w;
        }
    }
}
DEV float siluf_(float y) { return y / (1.f + __expf(-y)); }

DEV void stage_mstate(const Params& p, char* lds, int vb, int nvb) {
    const int tid = threadIdx.x, lane = tid & 63, wave = __builtin_amdgcn_readfirstlane(tid >> 6), fr = lane & 15, fq = lane >> 4;
    char* KT = lds;
    char* VT = lds + 34816;
    float* gs = (float*)(lds + 69632);
    const bf16_t* PM = (const bf16_t*)(p.ws + WS_PM);
    const float* ipre = (const float*)(p.ws + WS_IPRE); const float* fpre = (const float*)(p.ws + WS_FPRE);
    float* UT = (float*)(p.ws + WS_UB); float* NLOC = (float*)(p.ws + WS_NLOC);
    float* G = (float*)(p.ws + WS_CHG); float* MLOC = G + 1024;
    for (int unit = vb; unit < 1024; unit += nvb) {
        const int c = unit & 127, h = (unit >> 7) & 3, b = unit >> 9;
        const int rowbase = b * SEQ + c * 128;
        __syncthreads();
        if (wave == 0) chunk_gates(ipre, fpre, rowbase, h, gs, lane);
        __syncthreads();
        const float mloc = gs[513];
        for (int task = tid; task < 2048; task += NTH) {
            const int l = task >> 4, ch = task & 15;
            float v8[8]; conv8(PM, p.conv_w, b, c * 128 + l, 512 + h * 128 + ch * 8, 512 + h * 128 + ch * 8, v8);
            const float wgt = __expf(gs[256 + l] - mloc) * 0.08838834764831845f;
#pragma unroll
            for (int e = 0; e < 8; ++e) *(bf16_t*)(KT + (ch * 8 + e) * 272 + l * 2) = (bf16_t)f2bf(siluf_(v8[e]) * wgt);
        }
        for (int task = tid; task < 2048; task += NTH) {
            const int l = task >> 4, ch = task & 15;
            const u32x4 x = *(const u32x4*)(PM + (size_t)(rowbase + l) * LPM + 1024 + h * 128 + ch * 8);
#pragma unroll
            for (int e = 0; e < 8; ++e) *(bf16_t*)(VT + (ch * 8 + e) * 272 + l * 2) = (bf16_t)((e & 1) ? (x[e >> 1] >> 16) : (x[e >> 1] & 0xffffu));
        }
        __syncthreads();
        f32x4 acc[8];
#pragma unroll
        for (int t = 0; t < 8; ++t) acc[t] = (f32x4){0.f, 0.f, 0.f, 0.f};
#pragma unroll
        for (int ks = 0; ks < 4; ++ks) {
            const bf16x8 vf = *(const bf16x8*)(VT + (16 * wave + fr) * 272 + (32 * ks + 8 * fq) * 2);
#pragma unroll
            for (int t = 0; t < 8; ++t) { const bf16x8 kf = *(const bf16x8*)(KT + (16 * t + fr) * 272 + (32 * ks + 8 * fq) * 2); acc[t] = mfma16(kf, vf, acc[t]); }
        }
        float* UTu = UT + (size_t)unit * 16384 + (16 * wave + fr) * 128 + 4 * fq;
#pragma unroll
        for (int t = 0; t < 8; ++t) *(f32x4*)(UTu + 16 * t) = acc[t];
        if (tid < 128) { float s = 0.f; for (int l = 0; l < 128; ++l) s += bf2f(*(const bf16_t*)(KT + tid * 272 + l * 2)); NLOC[unit * 128 + tid] = s; }
        if (tid == 0) { G[unit] = gs[512]; MLOC[unit] = mloc; }
    }
}

DEV void stage_mscan(const Params& p, char* lds, int vb, int nvb) {
    const int tid = threadIdx.x;
    float* s_dec = (float*)lds; float* s_scl = s_dec + 128;
    const float* UT = (const float*)(p.ws + WS_UB); const float* NLOC = (const float*)(p.ws + WS_NLOC);
    const float* G = (const float*)(p.ws + WS_CHG); const float* MLOC = G + 1024; float* MST = (float*)(p.ws + WS_CHG) + 2048;
    bf16_t* CST = (bf16_t*)(p.ws + WS_CST); float* NST = (float*)(p.ws + WS_NST);
    for (int item = vb; item < 256; item += nvb) {
        const int bh = item >> 5, part = item & 31;
        __syncthreads();
        if (tid == 0) {
            float m = 0.f;
            for (int c = 0; c < 128; ++c) { const int u = bh * 128 + c; const float g = G[u], ml = MLOC[u]; const float mn = fmaxf(g + m, ml); s_dec[c] = expf(g + m - mn); s_scl[c] = expf(ml - mn); if (part == 0) MST[u] = m; m = mn; }
        }
        __syncthreads();
        const int e = part * 512 + tid;
        float C = 0.f;
        const float* up = UT + (size_t)bh * 128 * 16384 + e; bf16_t* cp = CST + (size_t)bh * 128 * 16384 + e;
        for (int c = 0; c < 128; c += 8) {
            float uu[8];
#pragma unroll
            for (int i = 0; i < 8; ++i) uu[i] = up[(size_t)(c + i) * 16384];
#pragma unroll
            for (int i = 0; i < 8; ++i) { cp[(size_t)(c + i) * 16384] = (bf16_t)f2bf(C); C = s_dec[c + i] * C + s_scl[c + i] * uu[i]; }
        }
        if (part == 0 && tid < 128) { float nn = 0.f; for (int c = 0; c < 128; ++c) { NST[(bh * 128 + c) * 128 + tid] = nn; nn = s_dec[c] * nn + s_scl[c] * NLOC[(bh * 128 + c) * 128 + tid]; } }
    }
}

DEV void stage_mout(const Params& p, char* lds, int vb, int nvb) {
    const int tid = threadIdx.x, lane = tid & 63, wave = __builtin_amdgcn_readfirstlane(tid >> 6), fr = lane & 15, fq = lane >> 4;
    char* Qs = lds; char* Ks = lds + 34816; char* VT = lds + 69632; char* CT = lds + 104448;
    float* gs = (float*)(lds + 139264); float* s_nst = gs + 520; float* s_mo = gs + 648; float* s_wi = gs + 776;
    bf16_t* PM = (bf16_t*)(p.ws + WS_PM);
    const float* ipre = (const float*)(p.ws + WS_IPRE); const float* fpre = (const float*)(p.ws + WS_FPRE);
    const float* MST = (const float*)(p.ws + WS_CHG) + 2048; const float* NST = (const float*)(p.ws + WS_NST);
    const bf16_t* CST = (const bf16_t*)(p.ws + WS_CST);
    for (int unit = vb; unit < 1024; unit += nvb) {
        const int c = unit & 127, h = (unit >> 7) & 3, b = unit >> 9;
        const int rowbase = b * SEQ + c * 128;
        __syncthreads();
        if (wave == 0) chunk_gates(ipre, fpre, rowbase, h, gs, lane);
        for (int task = tid; task < 2048; task += NTH) {
            const int l = task >> 4, ch = task & 15;
            float v8[8]; u32x4 o;
            conv8(PM, p.conv_w, b, c * 128 + l, h * 128 + ch * 8, h * 128 + ch * 8, v8);
            o.x = pk2(siluf_(v8[0]), siluf_(v8[1])); o.y = pk2(siluf_(v8[2]), siluf_(v8[3])); o.z = pk2(siluf_(v8[4]), siluf_(v8[5])); o.w = pk2(siluf_(v8[6]), siluf_(v8[7]));
            *(u32x4*)(Qs + l * 272 + ch * 16) = o;
            conv8(PM, p.conv_w, b, c * 128 + l, 512 + h * 128 + ch * 8, 512 + h * 128 + ch * 8, v8);
            const float sc = 0.08838834764831845f;
            o.x = pk2(siluf_(v8[0]) * sc, siluf_(v8[1]) * sc); o.y = pk2(siluf_(v8[2]) * sc, siluf_(v8[3]) * sc); o.z = pk2(siluf_(v8[4]) * sc, siluf_(v8[5]) * sc); o.w = pk2(siluf_(v8[6]) * sc, siluf_(v8[7]) * sc);
            *(u32x4*)(Ks + l * 272 + ch * 16) = o;
            const u32x4 x = *(const u32x4*)(PM + (size_t)(rowbase + l) * LPM + 1024 + h * 128 + ch * 8);
#pragma unroll
            for (int e = 0; e < 8; ++e) *(bf16_t*)(VT + (ch * 8 + e) * 272 + l * 2) = (bf16_t)((e & 1) ? (x[e >> 1] >> 16) : (x[e >> 1] & 0xffffu));
            *(u32x4*)(CT + l * 272 + ch * 16) = *(const u32x4*)(CST + (size_t)unit * 16384 + l * 128 + ch * 8);
        }
        if (tid < 128) s_nst[tid] = NST[unit * 128 + tid];
        __syncthreads();
        if (tid < 128) { const float mst = MST[unit]; const float bc = gs[tid]; const float mo = bc + fmaxf(mst, gs[384 + tid]); s_mo[tid] = mo; s_wi[tid] = __expf(bc + mst - mo); }
        __syncthreads();
        const int l = 16 * wave + fr;
        f32x4 s[8];
        bf16x8 qf[4];
#pragma unroll
        for (int ks = 0; ks < 4; ++ks) qf[ks] = *(const bf16x8*)(Qs + l * 272 + (32 * ks + 8 * fq) * 2);
#pragma unroll
        for (int t = 0; t < 8; ++t) {
            s[t] = (f32x4){0.f, 0.f, 0.f, 0.f};
            if (t <= wave) {
#pragma unroll
                for (int ks = 0; ks < 4; ++ks) { const bf16x8 kf = *(const bf16x8*)(Ks + (16 * t + fr) * 272 + (32 * ks + 8 * fq) * 2); s[t] = mfma16(kf, qf[ks], s[t]); }
            }
        }
        const float bl = gs[l], mol = s_mo[l];
        float dsum = 0.f;
#pragma unroll
        for (int t = 0; t < 8; ++t)
#pragma unroll
            for (int r = 0; r < 4; ++r) {
                const int si = 16 * t + 4 * fq + r; float wv = 0.f;
                if (t <= wave && si <= l) wv = __expf(bl + gs[128 + si] - mol) * s[t][r];
                s[t][r] = wv; dsum += wv;
            }
        dsum += __shfl_xor(dsum, 16); dsum += __shfl_xor(dsum, 32);
        float qn = 0.f;
        {
            const char* qrow = Qs + l * 272 + fq * 64;
#pragma unroll
            for (int i = 0; i < 4; ++i) {
                const u32x4 x = *(const u32x4*)(qrow + 16 * i); const float* nn = s_nst + fq * 32 + 8 * i;
                qn += bflo(x[0]) * nn[0] + bfhi(x[0]) * nn[1] + bflo(x[1]) * nn[2] + bfhi(x[1]) * nn[3] + bflo(x[2]) * nn[4] + bfhi(x[2]) * nn[5] + bflo(x[3]) * nn[6] + bfhi(x[3]) * nn[7];
            }
        }
        qn += __shfl_xor(qn, 16); qn += __shfl_xor(qn, 32);
        __syncthreads();
#pragma unroll
        for (int t = 0; t < 8; ++t)
            if (t <= wave + 1) { u32x2 o; o.x = pk2(s[t][0], s[t][1]); o.y = pk2(s[t][2], s[t][3]); *(u32x2*)(Ks + l * 272 + (16 * t + 4 * fq) * 2) = o; }
        __syncthreads();
        f32x4 acc[8];
#pragma unroll
        for (int t = 0; t < 8; ++t) acc[t] = (f32x4){0.f, 0.f, 0.f, 0.f};
#pragma unroll
        for (int ks = 0; ks < 4; ++ks)
#pragma unroll
            for (int t = 0; t < 8; ++t) { const bf16x8 cf = *(const bf16x8*)(CT + (16 * t + fr) * 272 + (32 * ks + 8 * fq) * 2); acc[t] = mfma16(cf, qf[ks], acc[t]); }
        const float wi = s_wi[l];
#pragma unroll
        for (int t = 0; t < 8; ++t) acc[t] = acc[t] * wi;
        const int nks = (wave + 2) >> 1;
#pragma unroll
        for (int ks = 0; ks < 4; ++ks)
            if (ks < nks) {
                const bf16x8 wf = *(const bf16x8*)(Ks + l * 272 + (32 * ks + 8 * fq) * 2);
#pragma unroll
                for (int t = 0; t < 8; ++t) { const bf16x8 vf = *(const bf16x8*)(VT + (16 * t + fr) * 272 + (32 * ks + 8 * fq) * 2); acc[t] = mfma16(vf, wf, acc[t]); }
            }
        const float den = dsum + wi * qn;
        const float invd = 1.f / fmaxf(fabsf(den), __expf(-mol));
        bf16_t* mop = PM + (size_t)(rowbase + l) * LPM + 1536 + h * 128 + 4 * fq;
        float ssq = 0.f;
#pragma unroll
        for (int t = 0; t < 8; ++t) {
            const u32x2 g2 = *(const u32x2*)(mop + 16 * t);
            const float gg[4] = {bflo(g2.x), bfhi(g2.x), bflo(g2.y), bfhi(g2.y)};
#pragma unroll
            for (int r = 0; r < 4; ++r) { const float hv = acc[t][r] * invd * sigmoidf_(gg[r]); acc[t][r] = hv; ssq += hv * hv; }
        }
        ssq += __shfl_xor(ssq, 16); ssq += __shfl_xor(ssq, 32);
        const float rn = rsqrtf(ssq * (1.f / 128.f) + 1e-6f);
#pragma unroll
        for (int t = 0; t < 8; ++t) {
            const float4 nw = *(const float4*)(p.mnorm_w + h * 128 + 16 * t + 4 * fq);
            u32x2 o; o.x = pk2(acc[t][0] * rn * nw.x, acc[t][1] * rn * nw.y); o.y = pk2(acc[t][2] * rn * nw.z, acc[t][3] * rn * nw.w);
            *(u32x2*)(mop + 16 * t) = o;
        }
    }
}

DEV void stage_norm2(const Params& p, char* lds, int vb, int nvb) {
    const int tid = threadIdx.x, lane = tid & 63, wave = __builtin_amdgcn_readfirstlane(tid >> 6);
    const float* mod = (const float*)(p.ws + WS_MOD);
    bf16_t* U2 = (bf16_t*)(p.ws + WS_PG);
    for (int m = vb * NW + wave; m < M; m += nvb * NW) {
        const int b = m >= SEQ ? 1 : 0;
        const float4* xr = (const float4*)(p.out + (size_t)m * D);
        float4 v[4]; float ss = 0.f;
#pragma unroll
        for (int j = 0; j < 4; ++j) { v[j] = xr[lane + 64 * j]; ss += v[j].x * v[j].x + v[j].y * v[j].y + v[j].z * v[j].z + v[j].w * v[j].w; }
        ss = wave_sum(ss);
        const float rstd = rsqrtf(ss * (1.f / 1024.f) + 1e-6f);
#pragma unroll
        for (int j = 0; j < 4; ++j) {
            const int col = 4 * (lane + 64 * j);
            const float4 w1 = *(const float4*)(p.norm2_w + col), sc = *(const float4*)(mod + b * 6144 + 4096 + col), sh = *(const float4*)(mod + b * 6144 + 3072 + col);
            u32x2 o;
            o.x = pk2(v[j].x * rstd * w1.x * (1.f + sc.x) + sh.x, v[j].y * rstd * w1.y * (1.f + sc.y) + sh.y);
            o.y = pk2(v[j].z * rstd * w1.z * (1.f + sc.z) + sh.z, v[j].w * rstd * w1.w * (1.f + sc.w) + sh.w);
            *(u32x2*)(U2 + (size_t)m * D + col) = o;
        }
    }
}

DEV void stage_peer(const Params& p, char* lds, int vb, int nvb) {
    const int tid = threadIdx.x, lane = tid & 63, wave = __builtin_amdgcn_readfirstlane(tid >> 6);
    char* s_keys = lds;
    char* qw = lds + 66560 + wave * 4096;
    float* tops = (float*)(lds + 99328 + wave * 256); int* topi = (int*)(tops + 32);
    int* sidx = (int*)(lds + 101376 + wave * 1088); float* sgate = (float*)(sidx + 128); float* bests = sgate + 128;
    const bf16_t* SK = (const bf16_t*)(p.ws + WS_SK); const bf16_t* QY = (const bf16_t*)(p.ws + WS_PM); const bf16_t* U2 = (const bf16_t*)(p.ws + WS_PG);
    const bf16_t* TU = (const bf16_t*)(p.ws + WS_TU); const bf16_t* TV = (const bf16_t*)(p.ws + WS_TV);
    const float* mod = (const float*)(p.ws + WS_MOD);
    for (int i = tid; i < 2 * 128 * 64; i += NTH) { const int pk = i >> 6, d2 = i & 63; *(unsigned*)(s_keys + pk * 260 + d2 * 4) = ((const unsigned*)SK)[pk * 64 + d2]; }
    __syncthreads();
    for (int tkn = vb * NW + wave; tkn < M; tkn += nvb * NW) {
#pragma unroll
        for (int i = 0; i < 4; ++i) *(u32x4*)(qw + (lane + 64 * i) * 16) = *(const u32x4*)(QY + (size_t)tkn * 2048 + (lane + 64 * i) * 8);
        wave_lds_sync();
        for (int h = 0; h < 8; ++h) {
            for (int pp = 0; pp < 2; ++pp) {
                const char* qseg = qw + (h * 256 + pp * 128) * 2;
                const char* k0 = s_keys + (pp * 128 + lane) * 260; const char* k1 = k0 + 64 * 260;
                float s0 = 0.f, s1 = 0.f;
#pragma unroll 8
                for (int d2 = 0; d2 < 64; ++d2) {
                    const unsigned qv = *(const unsigned*)(qseg + d2 * 4), a = *(const unsigned*)(k0 + d2 * 4), bq = *(const unsigned*)(k1 + d2 * 4);
                    const float q0 = bflo(qv), q1 = bfhi(qv);
                    s0 += q0 * bflo(a) + q1 * bfhi(a); s1 += q0 * bflo(bq) + q1 * bfhi(bq);
                }
                for (int r = 0; r < 16; ++r) {
                    float bv; int bi;
                    if (s0 >= s1) { bv = s0; bi = lane; } else { bv = s1; bi = lane + 64; }
#pragma unroll
                    for (int o = 32; o > 0; o >>= 1) { const float ov = __shfl_xor(bv, o); const int oi = __shfl_xor(bi, o); if (ov > bv || (ov == bv && oi < bi)) { bv = ov; bi = oi; } }
                    if (lane == 0) { tops[pp * 16 + r] = bv; topi[pp * 16 + r] = bi; }
                    if (bi == lane) s0 = -INFINITY; else if (bi == lane + 64) s1 = -INFINITY;
                }
            }
            wave_lds_sync();
            float cs[4];
#pragma unroll
            for (int q = 0; q < 4; ++q) cs[q] = tops[lane >> 2] + tops[16 + (lane & 3) * 4 + q];
            for (int r = 0; r < 16; ++r) {
                float bv = cs[0]; int bi = lane * 4;
#pragma unroll
                for (int q = 1; q < 4; ++q) if (cs[q] > bv) { bv = cs[q]; bi = lane * 4 + q; }
#pragma unroll
                for (int o = 32; o > 0; o >>= 1) { const float ov = __shfl_xor(bv, o); const int oi = __shfl_xor(bi, o); if (ov > bv || (ov == bv && oi < bi)) { bv = ov; bi = oi; } }
                if (lane == 0) { bests[r] = bv; sidx[h * 16 + r] = topi[bi >> 4] * 128 + topi[16 + (bi & 15)]; }
#pragma unroll
                for (int q = 0; q < 4; ++q) if (lane * 4 + q == bi) cs[q] = -INFINITY;
            }
            wave_lds_sync();
            {
                const float v = bests[lane & 15]; const float e = __expf(v - bests[0]);
                float sm = e; sm += __shfl_xor(sm, 1); sm += __shfl_xor(sm, 2); sm += __shfl_xor(sm, 4); sm += __shfl_xor(sm, 8);
                if (lane < 16) sgate[h * 16 + lane] = e / sm;
            }
            wave_lds_sync();
        }
        float xa[16];
        {
            const u32x4* xr = (const u32x4*)(U2 + (size_t)tkn * D); const u32x4 x0 = xr[lane], x1 = xr[64 + lane];
#pragma unroll
            for (int i = 0; i < 4; ++i) { xa[2 * i] = bflo(x0[i]); xa[2 * i + 1] = bfhi(x0[i]); xa[8 + 2 * i] = bflo(x1[i]); xa[8 + 2 * i + 1] = bfhi(x1[i]); }
        }
        float oa[16];
#pragma unroll
        for (int i = 0; i < 16; ++i) oa[i] = 0.f;
        for (int e = 0; e < 128; ++e) {
            const int id = sidx[e]; const float gt = sgate[e];
            const u32x4* ur = (const u32x4*)(TU + (size_t)id * D); const u32x4 u0 = ur[lane], u1 = ur[64 + lane];
            const u32x4* vr = (const u32x4*)(TV + (size_t)id * D); const u32x4 v0 = vr[lane], v1 = vr[64 + lane];
            float d = 0.f;
#pragma unroll
            for (int i = 0; i < 4; ++i) d += xa[2 * i] * bflo(u0[i]) + xa[2 * i + 1] * bfhi(u0[i]) + xa[8 + 2 * i] * bflo(u1[i]) + xa[8 + 2 * i + 1] * bfhi(u1[i]);
            d = wave_sum(d);
            const float w = gt * 0.5f * d * (1.f + erff(d * 0.7071067811865476f));
#pragma unroll
            for (int i = 0; i < 4; ++i) { oa[2 * i] += w * bflo(v0[i]); oa[2 * i + 1] += w * bfhi(v0[i]); oa[8 + 2 * i] += w * bflo(v1[i]); oa[8 + 2 * i + 1] += w * bfhi(v1[i]); }
        }
        const int b = tkn >= SEQ ? 1 : 0;
        float* hr = p.out + (size_t)tkn * D;
        float y[16]; float ss = 0.f;
#pragma unroll
        for (int half = 0; half < 2; ++half)
#pragma unroll
            for (int q = 0; q < 2; ++q) {
                const int col = half * 512 + 8 * lane + 4 * q;
                const float4 hv = *(const float4*)(hr + col); const float4 g2 = *(const float4*)(mod + b * 6144 + 5120 + col);
                const int k = half * 8 + 4 * q;
                y[k] = hv.x + g2.x * oa[k]; y[k + 1] = hv.y + g2.y * oa[k + 1]; y[k + 2] = hv.z + g2.z * oa[k + 2]; y[k + 3] = hv.w + g2.w * oa[k + 3];
                ss += y[k] * y[k] + y[k + 1] * y[k + 1] + y[k + 2] * y[k + 2] + y[k + 3] * y[k + 3];
            }
        ss = wave_sum(ss);
        const float rstd = rsqrtf(ss * (1.f / 1024.f) + 1e-6f);
#pragma unroll
        for (int half = 0; half < 2; ++half)
#pragma unroll
            for (int q = 0; q < 2; ++q) {
                const int col = half * 512 + 8 * lane + 4 * q; const int k = half * 8 + 4 * q;
                const float4 nw = *(const float4*)(p.normf_w + col);
                float4 o; o.x = y[k] * rstd * nw.x; o.y = y[k + 1] * rstd * nw.y; o.z = y[k + 2] * rstd * nw.z; o.w = y[k + 3] * rstd * nw.w;
                *(float4*)(hr + col) = o;
            }
        wave_lds_sync();
    }
}

namespace cg = cooperative_groups;
constexpr int LDS_BYTES = 139264 + 3616;

__global__ void __launch_bounds__(512) k_mega(Params p) {
    extern __shared__ __attribute__((aligned(16))) char lds[];
    cg::grid_group grid = cg::this_grid();
    const int vb = blockIdx.x, nvb = gridDim.x;
    stage_prep(p, lds, vb, nvb);        grid.sync();
    stage_norm1(p, lds, vb, nvb);       grid.sync();
    stage_gemm_in(p, lds, vb, nvb);     grid.sync();
    stage_attn(p, lds, vb, nvb);
    stage_mstate(p, lds, vb, nvb);      grid.sync();
    stage_mscan(p, lds, vb, nvb);       grid.sync();
    stage_mout(p, lds, vb, nvb);        grid.sync();
    stage_gemm_merge(p, lds, vb, nvb);  grid.sync();
    stage_gemm_out(p, lds, vb, nvb);    grid.sync();
    stage_norm2(p, lds, vb, nvb);       grid.sync();
    stage_gemm_q(p, lds, vb, nvb);      grid.sync();
    stage_peer(p, lds, vb, nvb);
}

extern "C" void kernel_launch(void* const* d_in, const int* in_sizes, int n_in, void* d_out, int out_size, void* d_ws, size_t ws_size, hipStream_t stream) {
    if (n_in != 20 || ws_size < WS_END) { fprintf(stderr, "kernel_launch: unexpected n_in %d or ws_size %zu\n", n_in, ws_size); return; }
    static int grid_blocks = 0;
    if (!grid_blocks) {
        int dev = 0, cus = 0, per_cu = 0;
        (void)hipGetDevice(&dev);
        (void)hipDeviceGetAttribute(&cus, hipDeviceAttributeMultiprocessorCount, dev);
        (void)hipFuncSetAttribute((const void*)k_mega, hipFuncAttributeMaxDynamicSharedMemorySize, LDS_BYTES);
        (void)hipOccupancyMaxActiveBlocksPerMultiprocessor(&per_cu, (const void*)k_mega, 512, LDS_BYTES);
        if (per_cu < 1) { fprintf(stderr, "kernel_launch: occupancy query says %d blocks per CU\n", per_cu); per_cu = 1; }
        grid_blocks = cus * 1;
    }
    Params p{};
    p.x = (const float*)d_in[0]; p.c = (const float*)d_in[1]; p.w_ada = (const float*)d_in[2]; p.b_ada = (const float*)d_in[3]; p.norm1_w = (const float*)d_in[4];
    p.w_in = (const float*)d_in[5]; p.conv_w = (const float*)d_in[6]; p.sinks = (const float*)d_in[7]; p.i_bias = (const float*)d_in[8]; p.f_bias = (const float*)d_in[9];
    p.mnorm_w = (const float*)d_in[10]; p.w_a = (const float*)d_in[11]; p.w_b = (const float*)d_in[12]; p.w_out = (const float*)d_in[13]; p.norm2_w = (const float*)d_in[14];
    p.w_q = (const float*)d_in[15]; p.sub_keys = (const float*)d_in[16]; p.peer_u = (const float*)d_in[17]; p.peer_v = (const float*)d_in[18]; p.normf_w = (const float*)d_in[19];
    p.out = (float*)d_out; p.ws = (unsigned char*)d_ws;
    void* args[] = {&p};
    hipError_t e = hipLaunchCooperativeKernel((const void*)k_mega, dim3(grid_blocks), dim3(512), args, LDS_BYTES, stream);
    if (e != hipSuccess) fprintf(stderr, "cooperative launch failed: %s (grid %d)\n", hipGetErrorString(e), grid_blocks);
}
```

```cpp
#include <hip/hip_runtime.h>
#include <hip/hip_cooperative_groups.h>
#include <stdint.h>
#include <stdio.h>

#define DEV __device__ __forceinline__
typedef unsigned short bf16_t;
typedef short bf16x8 __attribute__((ext_vector_type(8)));
typedef float f32x4 __attribute__((ext_vector_type(4)));
typedef unsigned u32x4 __attribute__((ext_vector_type(4)));
typedef unsigned u32x2 __attribute__((ext_vector_type(2)));

constexpr int BATCH = 2, SEQ = 16384, M = BATCH * SEQ, D = 1024;
constexpr int NTH = 512, NW = 8;
constexpr int LPA = 768, LPM = 2048, LPG = 2048;

struct Params {
    const float *x, *c, *w_ada, *b_ada, *norm1_w, *w_in, *conv_w, *sinks, *i_bias, *f_bias, *mnorm_w, *w_a, *w_b, *w_out, *norm2_w, *w_q, *sub_keys, *peer_u, *peer_v, *normf_w;
    float* out; unsigned char* ws;
};

constexpr size_t MiB = 1u << 20;
constexpr size_t WS_MOD = 1 * MiB;
constexpr size_t WS_IPRE = 2 * MiB;
constexpr size_t WS_FPRE = 2 * MiB + 512 * 1024;
constexpr size_t WS_CHG = 3 * MiB;
constexpr size_t WS_NLOC = 4 * MiB;
constexpr size_t WS_NST = 4 * MiB + 512 * 1024;
constexpr size_t WS_ROPE = 5 * MiB;
constexpr size_t WS_WIN = 10 * MiB;
constexpr size_t WS_WA = 20 * MiB;
constexpr size_t WS_WB = 21 * MiB;
constexpr size_t WS_WOUT = 22 * MiB;
constexpr size_t WS_WQ = 24 * MiB;
constexpr size_t WS_SK = 28 * MiB;
constexpr size_t WS_TU = 32 * MiB;
constexpr size_t WS_TV = 64 * MiB;
constexpr size_t WS_UB = 96 * MiB;
constexpr size_t WS_PA = 160 * MiB;
constexpr size_t WS_PM = 208 * MiB;
constexpr size_t WS_PG = 336 * MiB;
constexpr size_t WS_CST = 464 * MiB;
constexpr size_t WS_END = 496 * MiB;

DEV unsigned f2bf(float f) { unsigned u = __float_as_uint(f); return (u + 0x7fffu + ((u >> 16) & 1u)) >> 16; }
DEV unsigned pk2(float lo, float hi) { return f2bf(lo) | (f2bf(hi) << 16); }
DEV float bflo(unsigned u) { return __uint_as_float(u << 16); }
DEV float bfhi(unsigned u) { return __uint_as_float(u & 0xffff0000u); }
DEV float bf2f(bf16_t h) { return __uint_as_float(((unsigned)h) << 16); }
DEV float wave_sum(float v) {
#pragma unroll
    for (int o = 32; o > 0; o >>= 1) v += __shfl_xor(v, o);
    return v;
}
DEV float wave_max(float v) {
#pragma unroll
    for (int o = 32; o > 0; o >>= 1) v = fmaxf(v, __shfl_xor(v, o));
    return v;
}
DEV float sigmoidf_(float v) { return 1.f / (1.f + __expf(-v)); }
DEV f32x4 mfma16(bf16x8 a, bf16x8 b, f32x4 c) { return __builtin_amdgcn_mfma_f32_16x16x32_bf16(a, b, c, 0, 0, 0); }
DEV void wave_lds_sync() { __builtin_amdgcn_fence(__ATOMIC_ACQ_REL, "wavefront"); __builtin_amdgcn_wave_barrier(); }

DEV void transpose_item(const float* W, int ldw, int k0, int nsrc0, bf16_t* WT, int ldt, int ndst0, float* scr, int lane) {
#pragma unroll 8
    for (int i = 0; i < 32; ++i) { const int kk = 2 * i + (lane >> 5); scr[kk * 33 + (lane & 31)] = W[(size_t)(k0 + kk) * ldw + nsrc0 + (lane & 31)]; }
    wave_lds_sync();
    const int c = lane & 7;
#pragma unroll
    for (int j = 0; j < 4; ++j) {
        const int n = (lane >> 3) + 8 * j; const float* s = scr + (8 * c) * 33 + n;
        u32x4 o; o.x = pk2(s[0 * 33], s[1 * 33]); o.y = pk2(s[2 * 33], s[3 * 33]); o.z = pk2(s[4 * 33], s[5 * 33]); o.w = pk2(s[6 * 33], s[7 * 33]);
        *(u32x4*)(WT + (size_t)(ndst0 + n) * ldt + k0 + 8 * c) = o;
    }
    wave_lds_sync();
}

DEV void stage_prep(const Params& p, char* lds, int vb, int nvb) {
    const int tid = threadIdx.x, lane = tid & 63, wave = __builtin_amdgcn_readfirstlane(tid >> 6);
    float* mod = (float*)(p.ws + WS_MOD);
    float* s_act = (float*)lds;
    float* s_red = (float*)(lds + 8192);
    for (int i = tid; i < 2048; i += NTH) { const float v = p.c[i]; s_act[i] = v / (1.f + expf(-v)); }
    __syncthreads();
    for (int item = vb; item < 192; item += nvb) {
        const int kg = tid >> 5, cl = tid & 31, col = item * 32 + cl;
        float s0 = 0.f, s1 = 0.f;
        for (int k = kg; k < 1024; k += 16) { const float w = p.w_ada[(size_t)k * 6144 + col]; s0 += s_act[k] * w; s1 += s_act[1024 + k] * w; }
        s_red[(kg * 32 + cl) * 2] = s0; s_red[(kg * 32 + cl) * 2 + 1] = s1;
        __syncthreads();
        if (tid < 64) { const int b = tid >> 5, c2 = tid & 31; float s = 0.f; for (int g = 0; g < 16; ++g) s += s_red[(g * 32 + c2) * 2 + b]; mod[b * 6144 + item * 32 + c2] = s + p.b_ada[item * 32 + c2]; }
        __syncthreads();
    }
    float* scr = (float*)(lds + 16384 + wave * 8448);
    const int gw = vb * NW + wave, ngw = nvb * NW;
    bf16_t* Wt_in = (bf16_t*)(p.ws + WS_WIN); bf16_t* Wt_a = (bf16_t*)(p.ws + WS_WA); bf16_t* Wt_b = (bf16_t*)(p.ws + WS_WB);
    bf16_t* Wt_out = (bf16_t*)(p.ws + WS_WOUT); bf16_t* Wt_q = (bf16_t*)(p.ws + WS_WQ);
    for (int it = gw; it < 4480; it += ngw) {
        int r = it;
        if (r < 2432) { const int kb = r / 152, nb = r % 152; transpose_item(p.w_in, 4872, kb * 64, nb * 32 + (nb >= 88 ? 8 : 0), Wt_in, 1024, nb * 32, scr, lane); continue; } r -= 2432;
        if (r < 256) { const int kb = r / 32, nb = r % 32; transpose_item(p.w_a, 1024, kb * 64, nb * 32, Wt_a, 512, nb * 32, scr, lane); continue; } r -= 256;
        if (r < 256) { const int kb = r / 32, nb = r % 32; transpose_item(p.w_b, 1024, kb * 64, nb * 32, Wt_b, 512, nb * 32, scr, lane); continue; } r -= 256;
        if (r < 512) { const int kb = r / 32, nb = r % 32; transpose_item(p.w_out, 1024, kb * 64, nb * 32, Wt_out, 1024, nb * 32, scr, lane); continue; } r -= 512;
        { const int kb = r / 64, nb = r % 64; transpose_item(p.w_q, 2048, kb * 64, nb * 32, Wt_q, 1024, nb * 32, scr, lane); }
    }
    const size_t gt = (size_t)vb * NTH + tid, ngt = (size_t)nvb * NTH;
    for (size_t g = gt; g < 2 * 2097152 + 4096; g += ngt) {
        const float* src; bf16_t* dst; size_t o;
        if (g < 2097152) { src = p.peer_u; dst = (bf16_t*)(p.ws + WS_TU); o = g; }
        else if (g < 4194304) { src = p.peer_v; dst = (bf16_t*)(p.ws + WS_TV); o = g - 2097152; }
        else { src = p.sub_keys; dst = (bf16_t*)(p.ws + WS_SK); o = g - 4194304; }
        const float4 a = ((const float4*)src)[2 * o], b = ((const float4*)src)[2 * o + 1];
        u32x4 w; w.x = pk2(a.x, a.y); w.y = pk2(a.z, a.w); w.z = pk2(b.x, b.y); w.w = pk2(b.z, b.w);
        ((u32x4*)dst)[o] = w;
    }
    float2* rope = (float2*)(p.ws + WS_ROPE);
    for (size_t e = gt; e < 16384 * 32; e += ngt) {
        const int pos = (int)(e >> 5), i = (int)(e & 31);
        const float inv = (float)exp2(-(double)i * (13.287712379549449 / 32.0));
        const float ang = (float)pos * inv;
        const double a = (double)ang; const double n = rint(a * 0.15915494309189535); const double r = a - n * 6.283185307179586;
        float s, c; sincosf((float)r, &s, &c);
        rope[e] = make_float2(c, s);
    }
}

DEV void stage_norm1(const Params& p, char* lds, int vb, int nvb) {
    const int tid = threadIdx.x, lane = tid & 63, wave = __builtin_amdgcn_readfirstlane(tid >> 6);
    float* wg = (float*)lds;
    for (int i = tid; i < 8192; i += NTH) { const int cc = i >> 10, k = i & 1023; wg[i] = p.w_in[(size_t)k * 4872 + 2816 + cc]; }
    __syncthreads();
    const float* mod = (const float*)(p.ws + WS_MOD);
    bf16_t* ub = (bf16_t*)(p.ws + WS_UB);
    float* ipre = (float*)(p.ws + WS_IPRE); float* fpre = (float*)(p.ws + WS_FPRE);
    for (int m = vb * NW + wave; m < M; m += nvb * NW) {
        const int b = m >= SEQ ? 1 : 0;
        const float4* xr = (const float4*)(p.x + (size_t)m * D);
        float4 v[4]; float ss = 0.f;
#pragma unroll
        for (int j = 0; j < 4; ++j) { v[j] = xr[lane + 64 * j]; ss += v[j].x * v[j].x + v[j].y * v[j].y + v[j].z * v[j].z + v[j].w * v[j].w; }
        ss = wave_sum(ss);
        const float rstd = rsqrtf(ss * (1.f / 1024.f) + 1e-6f);
        float ga[8];
#pragma unroll
        for (int cc = 0; cc < 8; ++cc) ga[cc] = 0.f;
#pragma unroll
        for (int j = 0; j < 4; ++j) {
            const int col = 4 * (lane + 64 * j);
            const float4 w1 = *(const float4*)(p.norm1_w + col), sc = *(const float4*)(mod + b * 6144 + 1024 + col), sh = *(const float4*)(mod + b * 6144 + col);
            float4 u;
            u.x = v[j].x * rstd * w1.x * (1.f + sc.x) + sh.x; u.y = v[j].y * rstd * w1.y * (1.f + sc.y) + sh.y;
            u.z = v[j].z * rstd * w1.z * (1.f + sc.z) + sh.z; u.w = v[j].w * rstd * w1.w * (1.f + sc.w) + sh.w;
            u32x2 o; o.x = pk2(u.x, u.y); o.y = pk2(u.z, u.w);
            *(u32x2*)(ub + (size_t)m * D + col) = o;
#pragma unroll
            for (int cc = 0; cc < 8; ++cc) { const float4 g = *(const float4*)(wg + cc * 1024 + col); ga[cc] += u.x * g.x + u.y * g.y + u.z * g.z + u.w * g.w; }
        }
#pragma unroll
        for (int cc = 0; cc < 8; ++cc) ga[cc] = wave_sum(ga[cc]);
        if (lane == 0) {
#pragma unroll
            for (int h = 0; h < 4; ++h) { ipre[(size_t)m * 4 + h] = ga[h] + p.i_bias[h]; fpre[(size_t)m * 4 + h] = ga[4 + h] + p.f_bias[h]; }
        }
    }
}

struct GemmOp { const bf16_t* A; int lda; const bf16_t* Bt; int ldb; int K; };

DEV void gemm_tile(f32x4 (&acc)[4][2], const GemmOp& g, int m0, int n0, char* lds) {
    const int tid = threadIdx.x, lane = tid & 63, wid = __builtin_amdgcn_readfirstlane(tid >> 6), wm = wid >> 2, wn = wid & 3, fr = lane & 15, fq = lane >> 4;
    const int sr = tid >> 3, sc = tid & 7;
    const bf16_t* ga = g.A + (size_t)(m0 + sr) * g.lda + sc * 8;
    const bf16_t* gb = g.Bt + (size_t)(n0 + sr) * g.ldb + sc * 8;
    const size_t a64 = (size_t)64 * g.lda, b64 = (size_t)64 * g.ldb;
    const int so = sr * 128 + ((sc ^ (sr & 7)) << 4);
    const int nk = g.K >> 6;
    u32x4 ra0 = *(const u32x4*)ga, ra1 = *(const u32x4*)(ga + a64), rb0 = *(const u32x4*)gb, rb1 = *(const u32x4*)(gb + b64);
    *(u32x4*)(lds + so) = ra0; *(u32x4*)(lds + so + 8192) = ra1; *(u32x4*)(lds + 32768 + so) = rb0; *(u32x4*)(lds + 32768 + so + 8192) = rb1;
    __syncthreads();
    const int aoff = (wm * 64 + fr) * 128, boff = 32768 + (wn * 32 + fr) * 128, sw = fr & 7;
    for (int kt = 0; kt < nk; ++kt) {
        const int cur = (kt & 1) * 16384;
        if (kt + 1 < nk) { ga += 64; gb += 64; ra0 = *(const u32x4*)ga; ra1 = *(const u32x4*)(ga + a64); rb0 = *(const u32x4*)gb; rb1 = *(const u32x4*)(gb + b64); }
#pragma unroll
        for (int ks = 0; ks < 2; ++ks) {
            const int ch = ((fq + 4 * ks) ^ sw) << 4;
            bf16x8 af[4], bfr[2];
#pragma unroll
            for (int mi = 0; mi < 4; ++mi) af[mi] = *(const bf16x8*)(lds + cur + aoff + mi * 2048 + ch);
#pragma unroll
            for (int ni = 0; ni < 2; ++ni) bfr[ni] = *(const bf16x8*)(lds + cur + boff + ni * 2048 + ch);
#pragma unroll
            for (int mi = 0; mi < 4; ++mi)
#pragma unroll
                for (int ni = 0; ni < 2; ++ni) acc[mi][ni] = mfma16(bfr[ni], af[mi], acc[mi][ni]);
        }
        if (kt + 1 < nk) {
            const int nxt = cur ^ 16384;
            *(u32x4*)(lds + nxt + so) = ra0; *(u32x4*)(lds + nxt + so + 8192) = ra1; *(u32x4*)(lds + 32768 + nxt + so) = rb0; *(u32x4*)(lds + 32768 + nxt + so + 8192) = rb1;
        }
        __syncthreads();
    }
}
#define GEMM_EPI_LOOP(...) { const int tid_ = threadIdx.x, lane_ = tid_ & 63, wid_ = tid_ >> 6, wm_ = wid_ >> 2, wn_ = wid_ & 3, fr_ = lane_ & 15, fq_ = lane_ >> 4; \
    _Pragma("unroll") for (int mi = 0; mi < 4; ++mi) _Pragma("unroll") for (int ni = 0; ni < 2; ++ni) { const int m = m0 + wm_ * 64 + mi * 16 + fr_, n = n0 + wn_ * 32 + ni * 16 + fq_ * 4; __VA_ARGS__ } }

DEV void stage_gemm_in(const Params& p, char* lds, int vb, int nvb) {
    GemmOp g{(const bf16_t*)(p.ws + WS_UB), 1024, (const bf16_t*)(p.ws + WS_WIN), 1024, 1024};
    bf16_t* PA = (bf16_t*)(p.ws + WS_PA); bf16_t* PM = (bf16_t*)(p.ws + WS_PM); bf16_t* PG = (bf16_t*)(p.ws + WS_PG);
    const int tn = 38, tiles = 256 * tn;
    for (int t = vb; t < tiles; t += nvb) {
        const int m0 = (t / tn) * 128, n0 = (t % tn) * 128;
        f32x4 acc[4][2];
#pragma unroll
        for (int i = 0; i < 4; ++i) { acc[i][0] = (f32x4){0.f, 0.f, 0.f, 0.f}; acc[i][1] = (f32x4){0.f, 0.f, 0.f, 0.f}; }
        gemm_tile(acc, g, m0, n0, lds);
        bf16_t* dst; int ld, nb;
        if (n0 < 768) { dst = PA; ld = LPA; nb = n0; } else if (n0 < 2816) { dst = PM; ld = LPM; nb = n0 - 768; } else { dst = PG; ld = LPG; nb = n0 - 2816; }
        GEMM_EPI_LOOP({ const f32x4 v = acc[mi][ni]; u32x2 o; o.x = pk2(v[0], v[1]); o.y = pk2(v[2], v[3]); *(u32x2*)(dst + (size_t)m * ld + (n - n0 + nb)) = o; })
    }
}

DEV void stage_gemm_merge(const Params& p, char* lds, int vb, int nvb) {
    GemmOp g1{(const bf16_t*)(p.ws + WS_PA), LPA, (const bf16_t*)(p.ws + WS_WA), 512, 512};
    GemmOp g2{(const bf16_t*)(p.ws + WS_PM) + 1536, LPM, (const bf16_t*)(p.ws + WS_WB), 512, 512};
    const bf16_t* PG = (const bf16_t*)(p.ws + WS_PG); bf16_t* MG = (bf16_t*)(p.ws + WS_UB);
    const int tn = 8, tiles = 256 * tn;
    for (int t = vb; t < tiles; t += nvb) {
        const int m0 = (t / tn) * 128, n0 = (t % tn) * 128;
        f32x4 acc[4][2], acc2[4][2];
#pragma unroll
        for (int i = 0; i < 4; ++i) { acc[i][0] = (f32x4){0.f, 0.f, 0.f, 0.f}; acc[i][1] = acc[i][0]; acc2[i][0] = acc[i][0]; acc2[i][1] = acc[i][0]; }
        gemm_tile(acc, g1, m0, n0, lds);
        gemm_tile(acc2, g2, m0, n0, lds);
        GEMM_EPI_LOOP({ const f32x4 v1 = acc[mi][ni], v2 = acc2[mi][ni];
            const u32x2 a = *(const u32x2*)(PG + (size_t)m * LPG + n), b = *(const u32x2*)(PG + (size_t)m * LPG + 1024 + n);
            const float r0 = sigmoidf_(bflo(a.x)) * v1[0] + sigmoidf_(bflo(b.x)) * v2[0], r1 = sigmoidf_(bfhi(a.x)) * v1[1] + sigmoidf_(bfhi(b.x)) * v2[1];
            const float r2 = sigmoidf_(bflo(a.y)) * v1[2] + sigmoidf_(bflo(b.y)) * v2[2], r3 = sigmoidf_(bfhi(a.y)) * v1[3] + sigmoidf_(bfhi(b.y)) * v2[3];
            u32x2 o; o.x = pk2(r0, r1); o.y = pk2(r2, r3); *(u32x2*)(MG + (size_t)m * 1024 + n) = o; })
    }
}

DEV void stage_gemm_out(const Params& p, char* lds, int vb, int nvb) {
    GemmOp g{(const bf16_t*)(p.ws + WS_UB), 1024, (const bf16_t*)(p.ws + WS_WOUT), 1024, 1024};
    const float* mod = (const float*)(p.ws + WS_MOD);
    const int tn = 8, tiles = 256 * tn;
    for (int t = vb; t < tiles; t += nvb) {
        const int m0 = (t / tn) * 128, n0 = (t % tn) * 128;
        f32x4 acc[4][2];
#pragma unroll
        for (int i = 0; i < 4; ++i) { acc[i][0] = (f32x4){0.f, 0.f, 0.f, 0.f}; acc[i][1] = acc[i][0]; }
        gemm_tile(acc, g, m0, n0, lds);
        const int b = m0 >= SEQ ? 1 : 0;
        GEMM_EPI_LOOP({ const f32x4 v = acc[mi][ni]; const f32x4 xv = *(const f32x4*)(p.x + (size_t)m * D + n); const f32x4 gv = *(const f32x4*)(mod + b * 6144 + 2048 + n);
            *(f32x4*)(p.out + (size_t)m * D + n) = xv + gv * v; })
    }
}

DEV void rope8(u32x4 x1, u32x4 x2, const float4* rp, float scale, u32x4& o1, u32x4& o2) {
#pragma unroll
    for (int w = 0; w < 4; ++w) {
        const float4 cs = rp[w];
        const float a0 = bflo(x1[w]), a1 = bfhi(x1[w]), b0 = bflo(x2[w]), b1 = bfhi(x2[w]);
        o1[w] = pk2((a0 * cs.x - b0 * cs.y) * scale, (a1 * cs.z - b1 * cs.w) * scale);
        o2[w] = pk2((b0 * cs.x + a0 * cs.y) * scale, (b1 * cs.z + a1 * cs.w) * scale);
    }
}

DEV void stage_attn(const Params& p, char* lds, int vb, int nvb) {
    const int tid = threadIdx.x, lane = tid & 63, wave = __builtin_amdgcn_readfirstlane(tid >> 6), fr = lane & 15, fq = lane >> 4;
    char* Ks = lds;
    char* VT = lds + 32768;
    char* Qs = lds + 70656;
    char* Ps = lds + 87040;
    bf16_t* PA = (bf16_t*)(p.ws + WS_PA);
    const float2* rope = (const float2*)(p.ws + WS_ROPE);
    for (int unit = vb; unit < 512; unit += nvb) {
        const int kvh = unit & 1, n = (unit >> 1) & 127, b = unit >> 8;
        __syncthreads();
        for (int task = tid; task < 1024; task += NTH) {
            const int ki = task >> 2, cp = task & 3, pos = 128 * (n - 1) + ki;
            u32x4 o1 = {0u, 0u, 0u, 0u}, o2 = {0u, 0u, 0u, 0u};
            if (pos >= 0) {
                const bf16_t* src = PA + (size_t)(b * SEQ + pos) * LPA + 512 + kvh * 64 + cp * 8;
                const u32x4 x1 = *(const u32x4*)src, x2 = *(const u32x4*)(src + 32);
                rope8(x1, x2, (const float4*)(rope + (size_t)pos * 32 + cp * 8), 1.0f, o1, o2);
            }
            const int sw = ki & 7;
            *(u32x4*)(Ks + ki * 128 + ((cp ^ sw) << 4)) = o1;
            *(u32x4*)(Ks + ki * 128 + (((cp + 4) ^ sw) << 4)) = o2;
        }
        for (int task = tid; task < 2048; task += NTH) {
            const int ki = task >> 3, c = task & 7, pos = 128 * (n - 1) + ki;
            u32x4 x = {0u, 0u, 0u, 0u};
            if (pos >= 0) x = *(const u32x4*)(PA + (size_t)(b * SEQ + pos) * LPA + 640 + kvh * 64 + c * 8);
#pragma unroll
            for (int e = 0; e < 8; ++e) *(bf16_t*)(VT + (c * 8 + e) * 592 + ki * 2) = (bf16_t)((e & 1) ? (x[e >> 1] >> 16) : (x[e >> 1] & 0xffffu));
        }
        for (int i = tid; i < 64 * 40; i += NTH) { const int d = i / 40, kk = 256 + i % 40; *(bf16_t*)(VT + d * 592 + kk * 2) = 0; }
        for (int i = tid; i < 2048; i += NTH) { const int w = i >> 8, r = (i >> 4) & 15, kk = 144 + (i & 15); *(bf16_t*)(Ps + w * 5376 + r * 336 + kk * 2) = 0; }
        for (int j = 0; j < 4; ++j) {
            const int hq = kvh * 4 + j;
            {
                const int qi = tid >> 2, cp = tid & 3, pos = 128 * n + qi;
                const bf16_t* src = PA + (size_t)(b * SEQ + pos) * LPA + hq * 64 + cp * 8;
                const u32x4 x1 = *(const u32x4*)src, x2 = *(const u32x4*)(src + 32);
                u32x4 o1, o2;
                rope8(x1, x2, (const float4*)(rope + (size_t)pos * 32 + cp * 8), 0.125f, o1, o2);
                const int sw = qi & 7;
                *(u32x4*)(Qs + qi * 128 + ((cp ^ sw) << 4)) = o1;
                *(u32x4*)(Qs + qi * 128 + (((cp + 4) ^ sw) << 4)) = o2;
            }
            __syncthreads();
            f32x4 s[9];
            const int sw = fr & 7;
            bf16x8 qf[2];
#pragma unroll
            for (int ks = 0; ks < 2; ++ks) qf[ks] = *(const bf16x8*)(Qs + (16 * wave + fr) * 128 + (((fq + 4 * ks) ^ sw) << 4));
#pragma unroll
            for (int t = 0; t < 9; ++t) {
                s[t] = (f32x4){0.f, 0.f, 0.f, 0.f};
#pragma unroll
                for (int ks = 0; ks < 2; ++ks) { const bf16x8 kf = *(const bf16x8*)(Ks + (16 * (wave + t) + fr) * 128 + (((fq + 4 * ks) ^ sw) << 4)); s[t] = mfma16(kf, qf[ks], s[t]); }
            }
            const float sink = p.sinks[hq];
            float mx = sink;
#pragma unroll
            for (int t = 0; t < 9; ++t)
#pragma unroll
                for (int r = 0; r < 4; ++r) {
                    const int dd = 16 * t + 4 * fq + r - fr, ki = 16 * (wave + t) + 4 * fq + r;
                    const bool ok = (dd >= 1) && (dd <= 128) && (n > 0 || ki >= 128);
                    const float v = ok ? s[t][r] : -INFINITY;
                    s[t][r] = v; mx = fmaxf(mx, v);
                }
            mx = fmaxf(mx, __shfl_xor(mx, 16)); mx = fmaxf(mx, __shfl_xor(mx, 32));
            float sum = 0.f;
#pragma unroll
            for (int t = 0; t < 9; ++t)
#pragma unroll
                for (int r = 0; r < 4; ++r) { const float pv = __expf(s[t][r] - mx); s[t][r] = pv; sum += pv; }
            sum += __shfl_xor(sum, 16); sum += __shfl_xor(sum, 32);
            const float inv = 1.f / (sum + __expf(sink - mx));
            char* Pw = Ps + wave * 5376 + fr * 336;
#pragma unroll
            for (int t = 0; t < 9; ++t) { u32x2 o; o.x = pk2(s[t][0], s[t][1]); o.y = pk2(s[t][2], s[t][3]); *(u32x2*)(Pw + (16 * t + 4 * fq) * 2) = o; }
            __syncthreads();
            f32x4 o[4];
#pragma unroll
            for (int di = 0; di < 4; ++di) o[di] = (f32x4){0.f, 0.f, 0.f, 0.f};
#pragma unroll
            for (int ks = 0; ks < 5; ++ks) {
                const bf16x8 pf = *(const bf16x8*)(Pw + (32 * ks + 8 * fq) * 2);
#pragma unroll
                for (int di = 0; di < 4; ++di) { const bf16x8 vf = *(const bf16x8*)(VT + (16 * di + fr) * 592 + (16 * wave + 32 * ks + 8 * fq) * 2); o[di] = mfma16(vf, pf, o[di]); }
            }
            bf16_t* dst = PA + (size_t)(b * SEQ + 128 * n + 16 * wave + fr) * LPA + hq * 64 + 4 * fq;
#pragma unroll
            for (int di = 0; di < 4; ++di) { u32x2 w; w.x = pk2(o[di][0] * inv, o[di][1] * inv); w.y = pk2(o[di][2] * inv, o[di][3] * inv); *(u32x2*)(dst + 16 * di) = w; }
            __syncthreads();
        }
    }
}

DEV float logsigf(float x) { return fminf(x, 0.f) - log1pf(expf(-fabsf(x))); }

DEV void chunk_gates(const float* ipre, const float* fpre, int rowbase, int h, float* gs, int lane) {
    const int l0 = 2 * lane;
    const float i0 = ipre[(size_t)(rowbase + l0) * 4 + h], i1 = ipre[(size_t)(rowbase + l0 + 1) * 4 + h];
    const float lf0 = logsigf(fpre[(size_t)(rowbase + l0) * 4 + h]), lf1 = logsigf(fpre[(size_t)(rowbase + l0 + 1) * 4 + h]);
    const float pair = lf0 + lf1;
    float sc = pair;
#pragma unroll
    for (int o = 1; o < 64; o <<= 1) { const float t = __shfl_up(sc, o); if (lane >= o) sc += t; }
    const float b0 = (sc - pair) + lf0, b1 = b0 + lf1;
    const float g = __shfl(sc, 63);
    const float a0 = g - b0 + i0, a1 = g - b1 + i1;
    const float mloc = wave_max(fmaxf(a0, a1));
    const float ib0 = i0 - b0, ib1 = i1 - b1;
    float scm = fmaxf(ib0, ib1);
#pragma unroll
    for (int o = 1; o < 64; o <<= 1) { const float t = __shfl_up(scm, o); if (lane >= o) scm = fmaxf(scm, t); }
    float ex = __shfl_up(scm, 1); if (lane == 0) ex = -INFINITY;
    const float pm0 = fmaxf(ex, ib0), pm1 = fmaxf(pm0, ib1);
    gs[l0] = b0; gs[l0 + 1] = b1; gs[128 + l0] = ib0; gs[128 + l0 + 1] = ib1; gs[256 + l0] = a0; gs[256 + l0 + 1] = a1; gs[384 + l0] = pm0; gs[384 + l0 + 1] = pm1;
    if (lane == 0) { gs[512] = g; gs[513] = mloc; }
}

DEV void conv8(const bf16_t* PM, const float* cw, int b, int t, int pmcol, int cch, float (&out)[8]) {
#pragma unroll
    for (int e = 0; e < 8; ++e) out[e] = 0.f;
#pragma unroll
    for (int j = 0; j < 4; ++j) {
        const int tt = t - 3 + j;
        if (tt >= 0) {
            const u32x4 x = *(const u32x4*)(PM + (size_t)(b * SEQ + tt) * LPM + pmcol);
            const float4 w0 = *(const float4*)(cw + j * 1024 + cch), w1 = *(const float4*)(cw + j * 1024 + cch + 4);
            out[0] += bflo(x[0]) * w0.x; out[1] += bfhi(x[0]) * w0.y; out[2] += bflo(x[1]) * w0.z; out[3] += bfhi(x[1]) * w0.w;
            out[4] += bflo(x[2]) * w1.x; out[5] += bfhi(x[2]) * w1.y; out[6] += bflo(x[3]) * w1.z; out[7] += bfhi(x[3]) * w1.w;
        }
    }
}
DEV float siluf_(float y) { return y / (1.f + __expf(-y)); }

DEV void stage_mstate(const Params& p, char* lds, int vb, int nvb) {
    const int tid = threadIdx.x, lane = tid & 63, wave = __builtin_amdgcn_readfirstlane(tid >> 6), fr = lane & 15, fq = lane >> 4;
    char* KT = lds;
    char* VT = lds + 34816;
    float* gs = (float*)(lds + 69632);
    const bf16_t* PM = (const bf16_t*)(p.ws + WS_PM);
    const float* ipre = (const float*)(p.ws + WS_IPRE); const float* fpre = (const float*)(p.ws + WS_FPRE);
    float* UT = (float*)(p.ws + WS_UB); float* NLOC = (float*)(p.ws + WS_NLOC);
    float* G = (float*)(p.ws + WS_CHG); float* MLOC = G + 1024;
    for (int unit = vb; unit < 1024; unit += nvb) {
        const int c = unit & 127, h = (unit >> 7) & 3, b = unit >> 9;
        const int rowbase = b * SEQ + c * 128;
        __syncthreads();
        if (wave == 0) chunk_gates(ipre, fpre, rowbase, h, gs, lane);
        __syncthreads();
        const float mloc = gs[513];
        for (int task = tid; task < 2048; task += NTH) {
            const int l = task >> 4, ch = task & 15;
            float v8[8]; conv8(PM, p.conv_w, b, c * 128 + l, 512 + h * 128 + ch * 8, 512 + h * 128 + ch * 8, v8);
            const float wgt = __expf(gs[256 + l] - mloc) * 0.08838834764831845f;
#pragma unroll
            for (int e = 0; e < 8; ++e) *(bf16_t*)(KT + (ch * 8 + e) * 272 + l * 2) = (bf16_t)f2bf(siluf_(v8[e]) * wgt);
        }
        for (int task = tid; task < 2048; task += NTH) {
            const int l = task >> 4, ch = task & 15;
            const u32x4 x = *(const u32x4*)(PM + (size_t)(rowbase + l) * LPM + 1024 + h * 128 + ch * 8);
#pragma unroll
            for (int e = 0; e < 8; ++e) *(bf16_t*)(VT + (ch * 8 + e) * 272 + l * 2) = (bf16_t)((e & 1) ? (x[e >> 1] >> 16) : (x[e >> 1] & 0xffffu));
        }
        __syncthreads();
        f32x4 acc[8];
#pragma unroll
        for (int t = 0; t < 8; ++t) acc[t] = (f32x4){0.f, 0.f, 0.f, 0.f};
#pragma unroll
        for (int ks = 0; ks < 4; ++ks) {
            const bf16x8 vf = *(const bf16x8*)(VT + (16 * wave + fr) * 272 + (32 * ks + 8 * fq) * 2);
#pragma unroll
            for (int t = 0; t < 8; ++t) { const bf16x8 kf = *(const bf16x8*)(KT + (16 * t + fr) * 272 + (32 * ks + 8 * fq) * 2); acc[t] = mfma16(kf, vf, acc[t]); }
        }
        float* UTu = UT + (size_t)unit * 16384 + (16 * wave + fr) * 128 + 4 * fq;
#pragma unroll
        for (int t = 0; t < 8; ++t) *(f32x4*)(UTu + 16 * t) = acc[t];
        if (tid < 128) { float s = 0.f; for (int l = 0; l < 128; ++l) s += bf2f(*(const bf16_t*)(KT + tid * 272 + l * 2)); NLOC[unit * 128 + tid] = s; }
        if (tid == 0) { G[unit] = gs[512]; MLOC[unit] = mloc; }
    }
}

DEV void stage_mscan(const Params& p, char* lds, int vb, int nvb) {
    const int tid = threadIdx.x;
    float* s_dec = (float*)lds; float* s_scl = s_dec + 128;
    const float* UT = (const float*)(p.ws + WS_UB); const float* NLOC = (const float*)(p.ws + WS_NLOC);
    const float* G = (const float*)(p.ws + WS_CHG); const float* MLOC = G + 1024; float* MST = (float*)(p.ws + WS_CHG) + 2048;
    bf16_t* CST = (bf16_t*)(p.ws + WS_CST); float* NST = (float*)(p.ws + WS_NST);
    for (int item = vb; item < 256; item += nvb) {
        const int bh = item >> 5, part = item & 31;
        __syncthreads();
        if (tid == 0) {
            float m = 0.f;
            for (int c = 0; c < 128; ++c) { const int u = bh * 128 + c; const float g = G[u], ml = MLOC[u]; const float mn = fmaxf(g + m, ml); s_dec[c] = expf(g + m - mn); s_scl[c] = expf(ml - mn); if (part == 0) MST[u] = m; m = mn; }
        }
        __syncthreads();
        const int e = part * 512 + tid;
        float C = 0.f;
        const float* up = UT + (size_t)bh * 128 * 16384 + e; bf16_t* cp = CST + (size_t)bh * 128 * 16384 + e;
        for (int c = 0; c < 128; c += 8) {
            float uu[8];
#pragma unroll
            for (int i = 0; i < 8; ++i) uu[i] = up[(size_t)(c + i) * 16384];
#pragma unroll
            for (int i = 0; i < 8; ++i) { cp[(size_t)(c + i) * 16384] = (bf16_t)f2bf(C); C = s_dec[c + i] * C + s_scl[c + i] * uu[i]; }
        }
        if (part == 0 && tid < 128) { float nn = 0.f; for (int c = 0; c < 128; ++c) { NST[(bh * 128 + c) * 128 + tid] = nn; nn = s_dec[c] * nn + s_scl[c] * NLOC[(bh * 128 + c) * 128 + tid]; } }
    }
}

DEV void stage_mout(const Params& p, char* lds, int vb, int nvb) {
    const int tid = threadIdx.x, lane = tid & 63, wave = __builtin_amdgcn_readfirstlane(tid >> 6), fr = lane & 15, fq = lane >> 4;
    char* Qs = lds; char* Ks = lds + 34816; char* VT = lds + 69632; char* CT = lds + 104448;
    float* gs = (float*)(lds + 139264); float* s_nst = gs + 520; float* s_mo = gs + 648; float* s_wi = gs + 776;
    bf16_t* PM = (bf16_t*)(p.ws + WS_PM);
    const float* ipre = (const float*)(p.ws + WS_IPRE); const float* fpre = (const float*)(p.ws + WS_FPRE);
    const float* MST = (const float*)(p.ws + WS_CHG) + 2048; const float* NST = (const float*)(p.ws + WS_NST);
    const bf16_t* CST = (const bf16_t*)(p.ws + WS_CST);
    for (int unit = vb; unit < 1024; unit += nvb) {
        const int c = unit & 127, h = (unit >> 7) & 3, b = unit >> 9;
        const int rowbase = b * SEQ + c * 128;
        __syncthreads();
        if (wave == 0) chunk_gates(ipre, fpre, rowbase, h, gs, lane);
        for (int task = tid; task < 2048; task += NTH) {
            const int l = task >> 4, ch = task & 15;
            float v8[8]; u32x4 o;
            conv8(PM, p.conv_w, b, c * 128 + l, h * 128 + ch * 8, h * 128 + ch * 8, v8);
            o.x = pk2(siluf_(v8[0]), siluf_(v8[1])); o.y = pk2(siluf_(v8[2]), siluf_(v8[3])); o.z = pk2(siluf_(v8[4]), siluf_(v8[5])); o.w = pk2(siluf_(v8[6]), siluf_(v8[7]));
            *(u32x4*)(Qs + l * 272 + ch * 16) = o;
            conv8(PM, p.conv_w, b, c * 128 + l, 512 + h * 128 + ch * 8, 512 + h * 128 + ch * 8, v8);
            const float sc = 0.08838834764831845f;
            o.x = pk2(siluf_(v8[0]) * sc, siluf_(v8[1]) * sc); o.y = pk2(siluf_(v8[2]) * sc, siluf_(v8[3]) * sc); o.z = pk2(siluf_(v8[4]) * sc, siluf_(v8[5]) * sc); o.w = pk2(siluf_(v8[6]) * sc, siluf_(v8[7]) * sc);
            *(u32x4*)(Ks + l * 272 + ch * 16) = o;
            const u32x4 x = *(const u32x4*)(PM + (size_t)(rowbase + l) * LPM + 1024 + h * 128 + ch * 8);
#pragma unroll
            for (int e = 0; e < 8; ++e) *(bf16_t*)(VT + (ch * 8 + e) * 272 + l * 2) = (bf16_t)((e & 1) ? (x[e >> 1] >> 16) : (x[e >> 1] & 0xffffu));
            *(u32x4*)(CT + l * 272 + ch * 16) = *(const u32x4*)(CST + (size_t)unit * 16384 + l * 128 + ch * 8);
        }
        if (tid < 128) s_nst[tid] = NST[unit * 128 + tid];
        __syncthreads();
        if (tid < 128) { const float mst = MST[unit]; const float bc = gs[tid]; const float mo = bc + fmaxf(mst, gs[384 + tid]); s_mo[tid] = mo; s_wi[tid] = __expf(bc + mst - mo); }
        __syncthreads();
        const int l = 16 * wave + fr;
        f32x4 s[8];
        bf16x8 qf[4];
#pragma unroll
        for (int ks = 0; ks < 4; ++ks) qf[ks] = *(const bf16x8*)(Qs + l * 272 + (32 * ks + 8 * fq) * 2);
#pragma unroll
        for (int t = 0; t < 8; ++t) {
            s[t] = (f32x4){0.f, 0.f, 0.f, 0.f};
            if (t <= wave) {
#pragma unroll
                for (int ks = 0; ks < 4; ++ks) { const bf16x8 kf = *(const bf16x8*)(Ks + (16 * t + fr) * 272 + (32 * ks + 8 * fq) * 2); s[t] = mfma16(kf, qf[ks], s[t]); }
            }
        }
        const float bl = gs[l], mol = s_mo[l];
        float dsum = 0.f;
#pragma unroll
        for (int t = 0; t < 8; ++t)
#pragma unroll
            for (int r = 0; r < 4; ++r) {
                const int si = 16 * t + 4 * fq + r; float wv = 0.f;
                if (t <= wave && si <= l) wv = __expf(bl + gs[128 + si] - mol) * s[t][r];
                s[t][r] = wv; dsum += wv;
            }
        dsum += __shfl_xor(dsum, 16); dsum += __shfl_xor(dsum, 32);
        float qn = 0.f;
        {
            const char* qrow = Qs + l * 272 + fq * 64;
#pragma unroll
            for (int i = 0; i < 4; ++i) {
                const u32x4 x = *(const u32x4*)(qrow + 16 * i); const float* nn = s_nst + fq * 32 + 8 * i;
                qn += bflo(x[0]) * nn[0] + bfhi(x[0]) * nn[1] + bflo(x[1]) * nn[2] + bfhi(x[1]) * nn[3] + bflo(x[2]) * nn[4] + bfhi(x[2]) * nn[5] + bflo(x[3]) * nn[6] + bfhi(x[3]) * nn[7];
            }
        }
        qn += __shfl_xor(qn, 16); qn += __shfl_xor(qn, 32);
        __syncthreads();
#pragma unroll
        for (int t = 0; t < 8; ++t)
            if (t <= wave + 1) { u32x2 o; o.x = pk2(s[t][0], s[t][1]); o.y = pk2(s[t][2], s[t][3]); *(u32x2*)(Ks + l * 272 + (16 * t + 4 * fq) * 2) = o; }
        __syncthreads();
        f32x4 acc[8];
#pragma unroll
        for (int t = 0; t < 8; ++t) acc[t] = (f32x4){0.f, 0.f, 0.f, 0.f};
#pragma unroll
        for (int ks = 0; ks < 4; ++ks)
#pragma unroll
            for (int t = 0; t < 8; ++t) { const bf16x8 cf = *(const bf16x8*)(CT + (16 * t + fr) * 272 + (32 * ks + 8 * fq) * 2); acc[t] = mfma16(cf, qf[ks], acc[t]); }
        const float wi = s_wi[l];
#pragma unroll
        for (int t = 0; t < 8; ++t) acc[t] = acc[t] * wi;
        const int nks = (wave + 2) >> 1;
#pragma unroll
        for (int ks = 0; ks < 4; ++ks)
            if (ks < nks) {
                const bf16x8 wf = *(const bf16x8*)(Ks + l * 272 + (32 * ks + 8 * fq) * 2);
#pragma unroll
                for (int t = 0; t < 8; ++t) { const bf16x8 vf = *(const bf16x8*)(VT + (16 * t + fr) * 272 + (32 * ks + 8 * fq) * 2); acc[t] = mfma16(vf, wf, acc[t]); }
            }
        const float den = dsum + wi * qn;
        const float invd = 1.f / fmaxf(fabsf(den), __expf(-mol));
        bf16_t* mop = PM + (size_t)(rowbase + l) * LPM + 1536 + h * 128 + 4 * fq;
        float ssq = 0.f;
#pragma unroll
        for (int t = 0; t < 8; ++t) {
            const u32x2 g2 = *(const u32x2*)(mop + 16 * t);
            const float gg[4] = {bflo(g2.x), bfhi(g2.x), bflo(g2.y), bfhi(g2.y)};
#pragma unroll
            for (int r = 0; r < 4; ++r) { const float hv = acc[t][r] * invd * sigmoidf_(gg[r]); acc[t][r] = hv; ssq += hv * hv; }
        }
        ssq += __shfl_xor(ssq, 16); ssq += __shfl_xor(ssq, 32);
        const float rn = rsqrtf(ssq * (1.f / 128.f) + 1e-6f);
#pragma unroll
        for (int t = 0; t < 8; ++t) {
            const float4 nw = *(const float4*)(p.mnorm_w + h * 128 + 16 * t + 4 * fq);
            u32x2 o; o.x = pk2(acc[t][0] * rn * nw.x, acc[t][1] * rn * nw.y); o.y = pk2(acc[t][2] * rn * nw.z, acc[t][3] * rn * nw.w);
            *(u32x2*)(mop + 16 * t) = o;
        }
    }
}

DEV void stage_norm2(const Params& p, char* lds, int vb, int nvb) {
    const int tid = threadIdx.x, lane = tid & 63, wave = __builtin_amdgcn_readfirstlane(tid >> 6);
    const float* mod = (const float*)(p.ws + WS_MOD);
    bf16_t* U2 = (bf16_t*)(p.ws + WS_PG);
    for (int m = vb * NW + wave; m < M; m += nvb * NW) {
        const int b = m >= SEQ ? 1 : 0;
        const float4* xr = (const float4*)(p.out + (size_t)m * D);
        float4 v[4]; float ss = 0.f;
#pragma unroll
        for (int j = 0; j < 4; ++j) { v[j] = xr[lane + 64 * j]; ss += v[j].x * v[j].x + v[j].y * v[j].y + v[j].z * v[j].z + v[j].w * v[j].w; }
        ss = wave_sum(ss);
        const float rstd = rsqrtf(ss * (1.f / 1024.f) + 1e-6f);
#pragma unroll
        for (int j = 0; j < 4; ++j) {
            const int col = 4 * (lane + 64 * j);
            const float4 w1 = *(const float4*)(p.norm2_w + col), sc = *(const float4*)(mod + b * 6144 + 4096 + col), sh = *(const float4*)(mod + b * 6144 + 3072 + col);
            u32x2 o;
            o.x = pk2(v[j].x * rstd * w1.x * (1.f + sc.x) + sh.x, v[j].y * rstd * w1.y * (1.f + sc.y) + sh.y);
            o.y = pk2(v[j].z * rstd * w1.z * (1.f + sc.z) + sh.z, v[j].w * rstd * w1.w * (1.f + sc.w) + sh.w);
            *(u32x2*)(U2 + (size_t)m * D + col) = o;
        }
    }
}

constexpr size_t WS_SELI = WS_PM;
constexpr size_t WS_SELG = WS_PM + 16 * MiB;
DEV unsigned f2ord(float f) { const unsigned u = __float_as_uint(f); return (u & 0x80000000u) ? ~u : (u | 0x80000000u); }
DEV float ord2f(unsigned k) { return __uint_as_float((k & 0x80000000u) ? (k ^ 0x80000000u) : ~k); }
DEV unsigned umax_(unsigned a, unsigned b) { return a > b ? a : b; }

DEV void stage_q_topk(const Params& p, char* lds, int vb, int nvb) {
    const int tid = threadIdx.x, lane = tid & 63, wave = __builtin_amdgcn_readfirstlane(tid >> 6), fr = lane & 15, fq = lane >> 4;
    char* Qt = lds;
    char* Kd = lds + 65536;
    unsigned* tops = (unsigned*)(lds + 135168);
    const bf16_t* SK = (const bf16_t*)(p.ws + WS_SK);
    for (int i = tid; i < 2 * 128 * 16; i += NTH) { const int row = i >> 4, ch = i & 15; *(u32x4*)(Kd + row * 272 + ch * 16) = *(const u32x4*)(SK + row * 128 + ch * 8); }
    GemmOp g{(const bf16_t*)(p.ws + WS_PG), 1024, (const bf16_t*)(p.ws + WS_WQ), 1024, 1024};
    int* SELI = (int*)(p.ws + WS_SELI); float* SELG = (float*)(p.ws + WS_SELG);
    for (int item = vb; item < 2048; item += nvb) {
        const int mt = item >> 3, h = item & 7, m0 = mt * 128;
        for (int pp = 0; pp < 2; ++pp) {
            f32x4 acc[4][2];
#pragma unroll
            for (int i = 0; i < 4; ++i) { acc[i][0] = (f32x4){0.f, 0.f, 0.f, 0.f}; acc[i][1] = acc[i][0]; }
            gemm_tile(acc, g, m0, h * 256 + pp * 128, lds);
            {
                const int wm = wave >> 2, wn = wave & 3;
#pragma unroll
                for (int mi = 0; mi < 4; ++mi)
#pragma unroll
                    for (int ni = 0; ni < 2; ++ni) { const f32x4 v = acc[mi][ni]; u32x2 o; o.x = pk2(v[0], v[1]); o.y = pk2(v[2], v[3]);
                        *(u32x2*)(Qt + (wm * 64 + mi * 16 + fr) * 272 + (wn * 32 + ni * 16 + 4 * fq) * 2) = o; }
            }
            __syncthreads();
            bf16x8 qf[4];
#pragma unroll
            for (int ks = 0; ks < 4; ++ks) qf[ks] = *(const bf16x8*)(Qt + (16 * wave + fr) * 272 + (32 * ks + 8 * fq) * 2);
            unsigned key[32];
#pragma unroll
            for (int t = 0; t < 8; ++t) {
                f32x4 sc = {0.f, 0.f, 0.f, 0.f};
#pragma unroll
                for (int ks = 0; ks < 4; ++ks) { const bf16x8 kf = *(const bf16x8*)(Kd + (pp * 128 + 16 * t + fr) * 272 + (32 * ks + 8 * fq) * 2); sc = mfma16(kf, qf[ks], sc); }
#pragma unroll
                for (int r = 0; r < 4; ++r) key[4 * t + r] = (f2ord(sc[r]) & ~127u) | (127u - (unsigned)(16 * t + 4 * fq + r));
            }
            unsigned prev = 0xffffffffu;
            for (int r = 0; r < 16; ++r) {
                unsigned best = 0u;
#pragma unroll
                for (int i = 0; i < 32; ++i) { const unsigned c = key[i] < prev ? key[i] : 0u; best = umax_(best, c); }
                best = umax_(best, (unsigned)__shfl_xor((int)best, 16)); best = umax_(best, (unsigned)__shfl_xor((int)best, 32));
                prev = best;
                if (fq == 0) tops[((16 * wave + fr) * 2 + pp) * 16 + r] = best;
            }
            __syncthreads();
        }
        const unsigned* tp = tops + (16 * wave + fr) * 32;
        float A[4], B[16];
#pragma unroll
        for (int m = 0; m < 4; ++m) A[m] = ord2f(tp[fq + 4 * m] & ~127u);
#pragma unroll
        for (int j = 0; j < 16; ++j) B[j] = ord2f(tp[16 + j] & ~127u);
        unsigned ck[21];
#pragma unroll
        for (int sl = 0; sl < 21; ++sl) {
            const int m = sl < 16 ? 0 : (sl < 19 ? 1 : (sl < 20 ? 2 : 3)), j = sl < 16 ? sl : (sl < 19 ? sl - 16 : 0);
            const int i = fq + 4 * m;
            const bool ok = j < 16 / (i + 1);
            ck[sl] = ok ? ((f2ord(A[m] + B[j]) & ~255u) | (255u - (unsigned)(i * 16 + j))) : 0u;
        }
        unsigned wins[16];
        {
            unsigned prev = 0xffffffffu;
#pragma unroll
            for (int r = 0; r < 16; ++r) {
                unsigned best = 0u;
#pragma unroll
                for (int sl = 0; sl < 21; ++sl) { const unsigned c = ck[sl] < prev ? ck[sl] : 0u; best = umax_(best, c); }
                best = umax_(best, (unsigned)__shfl_xor((int)best, 16)); best = umax_(best, (unsigned)__shfl_xor((int)best, 32));
                prev = best; wins[r] = best;
            }
        }
        const float v0 = ord2f(wins[0] & ~255u);
        float ex[16], sm = 0.f;
#pragma unroll
        for (int r = 0; r < 16; ++r) { ex[r] = __expf(ord2f(wins[r] & ~255u) - v0); sm += ex[r]; }
        const float rs = 1.f / sm;
        int oi[4]; float og[4];
#pragma unroll
        for (int q = 0; q < 4; ++q) {
            const unsigned w = fq == 0 ? wins[q] : (fq == 1 ? wins[4 + q] : (fq == 2 ? wins[8 + q] : wins[12 + q]));
            const float e = fq == 0 ? ex[q] : (fq == 1 ? ex[4 + q] : (fq == 2 ? ex[8 + q] : ex[12 + q]));
            const unsigned flat = 255u - (w & 255u); const unsigned ia = flat >> 4, jb = flat & 15u;
            oi[q] = (int)((127u - (tp[ia] & 127u)) * 128u + (127u - (tp[16 + jb] & 127u)));
            og[q] = e * rs;
        }
        const size_t so = (size_t)(m0 + 16 * wave + fr) * 128 + h * 16 + 4 * fq;
        *(int4*)(SELI + so) = make_int4(oi[0], oi[1], oi[2], oi[3]);
        *(float4*)(SELG + so) = make_float4(og[0], og[1], og[2], og[3]);
    }
}

typedef __bf16 bf16x2_t __attribute__((ext_vector_type(2)));
DEV float dot2bf(unsigned a, unsigned b, float c) { return __builtin_amdgcn_fdot2_f32_bf16(__builtin_bit_cast(bf16x2_t, a), __builtin_bit_cast(bf16x2_t, b), c, false); }
struct EB { u32x4 u[4][2], v[4][2]; };

DEV void peer_load(EB& b, const bf16_t* TU, const bf16_t* TV, int iv, int e0, int lane) {
#pragma unroll
    for (int q = 0; q < 4; ++q) {
        const int id = __builtin_amdgcn_readlane(iv, e0 + q);
        const u32x4* ur = (const u32x4*)(TU + (size_t)id * D); const u32x4* vr = (const u32x4*)(TV + (size_t)id * D);
        b.u[q][0] = ur[lane]; b.u[q][1] = ur[64 + lane]; b.v[q][0] = vr[lane]; b.v[q][1] = vr[64 + lane];
    }
}
DEV void peer_compute(const EB& b, const u32x4& x0, const u32x4& x1, float gv, int e0, int lane, float (&oa)[16]) {
    float d[4];
#pragma unroll
    for (int q = 0; q < 4; ++q) {
        float a = 0.f;
#pragma unroll
        for (int i = 0; i < 4; ++i) a = dot2bf(x0[i], b.u[q][0][i], a);
#pragma unroll
        for (int i = 0; i < 4; ++i) a = dot2bf(x1[i], b.u[q][1][i], a);
        d[q] = a;
    }
    const bool hi32 = (lane & 32) != 0, hi16 = (lane & 16) != 0;
    float k0 = hi32 ? d[2] : d[0], k1 = hi32 ? d[3] : d[1];
    k0 += __shfl_xor(hi32 ? d[0] : d[2], 32); k1 += __shfl_xor(hi32 ? d[1] : d[3], 32);
    float k = hi16 ? k1 : k0;
    k += __shfl_xor(hi16 ? k0 : k1, 16);
    k += __shfl_xor(k, 8); k += __shfl_xor(k, 4); k += __shfl_xor(k, 2); k += __shfl_xor(k, 1);
    const float gl = __shfl(gv, e0 + 2 * (lane >> 5) + ((lane >> 4) & 1));
    const float w = gl * 0.5f * k * (1.f + erff(k * 0.7071067811865476f));
    const int wi_ = (int)__float_as_uint(w);
    const float w0 = __uint_as_float((unsigned)__builtin_amdgcn_readlane(wi_, 0)), w1 = __uint_as_float((unsigned)__builtin_amdgcn_readlane(wi_, 16));
    const float w2 = __uint_as_float((unsigned)__builtin_amdgcn_readlane(wi_, 32)), w3 = __uint_as_float((unsigned)__builtin_amdgcn_readlane(wi_, 48));
    const unsigned w01 = pk2(w0, w1), w23 = pk2(w2, w3);
#pragma unroll
    for (int c = 0; c < 2; ++c)
#pragma unroll
        for (int i = 0; i < 4; ++i) {
            const unsigned a0 = b.v[0][c][i], a1 = b.v[1][c][i], a2 = b.v[2][c][i], a3 = b.v[3][c][i];
            const unsigned lo01 = __builtin_amdgcn_perm(a1, a0, 0x05040100u), hi01 = __builtin_amdgcn_perm(a1, a0, 0x07060302u);
            const unsigned lo23 = __builtin_amdgcn_perm(a3, a2, 0x05040100u), hi23 = __builtin_amdgcn_perm(a3, a2, 0x07060302u);
            float s0 = oa[c * 8 + 2 * i], s1 = oa[c * 8 + 2 * i + 1];
            s0 = dot2bf(lo01, w01, s0); s0 = dot2bf(lo23, w23, s0);
            s1 = dot2bf(hi01, w01, s1); s1 = dot2bf(hi23, w23, s1);
            oa[c * 8 + 2 * i] = s0; oa[c * 8 + 2 * i + 1] = s1;
        }
}

DEV void stage_peer_gather(const Params& p, char* lds, int vb, int nvb, bool dry = false) {
    const int tid = threadIdx.x, lane = tid & 63, wave = __builtin_amdgcn_readfirstlane(tid >> 6);
    const bf16_t* U2 = (const bf16_t*)(p.ws + WS_PG);
    const bf16_t* TU = (const bf16_t*)(p.ws + WS_TU); const bf16_t* TV = (const bf16_t*)(p.ws + WS_TV);
    const int* SELI = (const int*)(p.ws + WS_SELI); const float* SELG = (const float*)(p.ws + WS_SELG);
    const float* mod = (const float*)(p.ws + WS_MOD);
    for (int tkn = vb * NW + wave; tkn < M; tkn += nvb * NW) {
        const u32x4* xr = (const u32x4*)(U2 + (size_t)tkn * D); const u32x4 x0 = xr[lane], x1 = xr[64 + lane];
        const int iv0 = SELI[(size_t)tkn * 128 + lane], iv1 = SELI[(size_t)tkn * 128 + 64 + lane];
        const float gv0 = SELG[(size_t)tkn * 128 + lane], gv1 = SELG[(size_t)tkn * 128 + 64 + lane];
        float oa[16];
#pragma unroll
        for (int i = 0; i < 16; ++i) oa[i] = 0.f;
        EB ba, bb;
#pragma unroll
        for (int half = 0; half < 2; ++half) {
            const int iv = half ? iv1 : iv0; const float gv = half ? gv1 : gv0;
            peer_load(ba, TU, TV, iv, 0, lane);
            for (int bt = 0; bt < 16; bt += 2) {
                peer_load(bb, TU, TV, iv, 4 * bt + 4, lane);
                peer_compute(ba, x0, x1, gv, 4 * bt, lane, oa);
                if (bt + 2 < 16) peer_load(ba, TU, TV, iv, 4 * bt + 8, lane);
                peer_compute(bb, x0, x1, gv, 4 * bt + 4, lane, oa);
            }
        }
        const int b = tkn >= SEQ ? 1 : 0;
        float* hr = p.out + (size_t)tkn * D;
        float y[16]; float ss = 0.f;
#pragma unroll
        for (int half = 0; half < 2; ++half)
#pragma unroll
            for (int q = 0; q < 2; ++q) {
                const int col = half * 512 + 8 * lane + 4 * q;
                const float4 hv = *(const float4*)(hr + col); const float4 g2 = *(const float4*)(mod + b * 6144 + 5120 + col);
                const int k = half * 8 + 4 * q;
                y[k] = hv.x + g2.x * oa[k]; y[k + 1] = hv.y + g2.y * oa[k + 1]; y[k + 2] = hv.z + g2.z * oa[k + 2]; y[k + 3] = hv.w + g2.w * oa[k + 3];
                ss += y[k] * y[k] + y[k + 1] * y[k + 1] + y[k + 2] * y[k + 2] + y[k + 3] * y[k + 3];
            }
        ss = wave_sum(ss);
        const float rstd = rsqrtf(ss * (1.f / 1024.f) + 1e-6f);
        if (!dry || rstd == 123.456f)
#pragma unroll
        for (int half = 0; half < 2; ++half)
#pragma unroll
            for (int q = 0; q < 2; ++q) {
                const int col = half * 512 + 8 * lane + 4 * q; const int k = half * 8 + 4 * q;
                const float4 nw = *(const float4*)(p.normf_w + col);
                float4 o; o.x = y[k] * rstd * nw.x; o.y = y[k + 1] * rstd * nw.y; o.z = y[k + 2] * rstd * nw.z; o.w = y[k + 3] * rstd * nw.w;
                *(float4*)(hr + col) = o;
            }
    }
}

namespace cg = cooperative_groups;
constexpr int LDS_BYTES = 151552;

__global__ void __launch_bounds__(512) k_mega(Params p) {
    extern __shared__ __attribute__((aligned(16))) char lds[];
    cg::grid_group grid = cg::this_grid();
    const int vb = blockIdx.x, nvb = gridDim.x;
    stage_prep(p, lds, vb, nvb);        grid.sync();
    stage_norm1(p, lds, vb, nvb);       grid.sync();
    stage_gemm_in(p, lds, vb, nvb);     grid.sync();
    stage_attn(p, lds, vb, nvb);
    stage_mstate(p, lds, vb, nvb);      grid.sync();
    stage_mscan(p, lds, vb, nvb);       grid.sync();
    stage_mout(p, lds, vb, nvb);        grid.sync();
    stage_gemm_merge(p, lds, vb, nvb);  grid.sync();
    stage_gemm_out(p, lds, vb, nvb);    grid.sync();
    stage_norm2(p, lds, vb, nvb);       grid.sync();
    stage_q_topk(p, lds, vb, nvb);      grid.sync();
#ifdef XP_PEER
    stage_peer_gather(p, lds, vb, nvb, p.ws != nullptr);
#endif
    stage_peer_gather(p, lds, vb, nvb);
}

extern "C" void kernel_launch(void* const* d_in, const int* in_sizes, int n_in, void* d_out, int out_size, void* d_ws, size_t ws_size, hipStream_t stream) {
    if (n_in != 20 || ws_size < WS_END) { fprintf(stderr, "kernel_launch: unexpected n_in %d or ws_size %zu\n", n_in, ws_size); return; }
    static int grid_blocks = 0;
    if (!grid_blocks) {
        int dev = 0, cus = 0, per_cu = 0;
        (void)hipGetDevice(&dev);
        (void)hipDeviceGetAttribute(&cus, hipDeviceAttributeMultiprocessorCount, dev);
        (void)hipFuncSetAttribute((const void*)k_mega, hipFuncAttributeMaxDynamicSharedMemorySize, LDS_BYTES);
        (void)hipOccupancyMaxActiveBlocksPerMultiprocessor(&per_cu, (const void*)k_mega, 512, LDS_BYTES);
        if (per_cu < 1) { fprintf(stderr, "kernel_launch: occupancy query says %d blocks per CU\n", per_cu); per_cu = 1; }
        grid_blocks = cus * 1;
    }
    Params p{};
    p.x = (const float*)d_in[0]; p.c = (const float*)d_in[1]; p.w_ada = (const float*)d_in[2]; p.b_ada = (const float*)d_in[3]; p.norm1_w = (const float*)d_in[4];
    p.w_in = (const float*)d_in[5]; p.conv_w = (const float*)d_in[6]; p.sinks = (const float*)d_in[7]; p.i_bias = (const float*)d_in[8]; p.f_bias = (const float*)d_in[9];
    p.mnorm_w = (const float*)d_in[10]; p.w_a = (const float*)d_in[11]; p.w_b = (const float*)d_in[12]; p.w_out = (const float*)d_in[13]; p.norm2_w = (const float*)d_in[14];
    p.w_q = (const float*)d_in[15]; p.sub_keys = (const float*)d_in[16]; p.peer_u = (const float*)d_in[17]; p.peer_v = (const float*)d_in[18]; p.normf_w = (const float*)d_in[19];
    p.out = (float*)d_out; p.ws = (unsigned char*)d_ws;
    void* args[] = {&p};
    hipError_t e = hipLaunchCooperativeKernel((const void*)k_mega, dim3(grid_blocks), dim3(512), args, LDS_BYTES, stream);
    if (e != hipSuccess) fprintf(stderr, "cooperative launch failed: %s (grid %d)\n", hipGetErrorString(e), grid_blocks);
}
```

```cpp
#include <hip/hip_runtime.h>
#include <hip/hip_cooperative_groups.h>
#include <stdint.h>
#include <stdio.h>

#define DEV __device__ __forceinline__
typedef unsigned short bf16_t;
typedef short bf16x8 __attribute__((ext_vector_type(8)));
typedef float f32x4 __attribute__((ext_vector_type(4)));
typedef unsigned u32x4 __attribute__((ext_vector_type(4)));
typedef unsigned u32x2 __attribute__((ext_vector_type(2)));

constexpr int BATCH = 2, SEQ = 16384, M = BATCH * SEQ, D = 1024;
constexpr int NTH = 512, NW = 8;
constexpr int LPA = 768, LPM = 2048, LPG = 2048;

struct Params {
    const float *x, *c, *w_ada, *b_ada, *norm1_w, *w_in, *conv_w, *sinks, *i_bias, *f_bias, *mnorm_w, *w_a, *w_b, *w_out, *norm2_w, *w_q, *sub_keys, *peer_u, *peer_v, *normf_w;
    float* out; unsigned char* ws;
};

constexpr size_t MiB = 1u << 20;
constexpr size_t WS_MOD = 1 * MiB;
constexpr size_t WS_IPRE = 2 * MiB;
constexpr size_t WS_FPRE = 2 * MiB + 512 * 1024;
constexpr size_t WS_CHG = 3 * MiB;
constexpr size_t WS_NLOC = 4 * MiB;
constexpr size_t WS_NST = 4 * MiB + 512 * 1024;
constexpr size_t WS_ROPE = 5 * MiB;
constexpr size_t WS_WIN = 10 * MiB;
constexpr size_t WS_WA = 20 * MiB;
constexpr size_t WS_WB = 21 * MiB;
constexpr size_t WS_WOUT = 22 * MiB;
constexpr size_t WS_WQ = 24 * MiB;
constexpr size_t WS_SK = 28 * MiB;
constexpr size_t WS_ISU = 29 * MiB;
constexpr size_t WS_ISV = 29 * MiB + 65536;
constexpr size_t WS_TU = 32 * MiB;
constexpr size_t WS_TV = 48 * MiB;
constexpr size_t WS_UB = 96 * MiB;
constexpr size_t WS_PA = 160 * MiB;
constexpr size_t WS_PM = 208 * MiB;
constexpr size_t WS_PG = 336 * MiB;
constexpr size_t WS_CST = 464 * MiB;
constexpr size_t WS_END = 496 * MiB;

DEV unsigned f2bf(float f) { unsigned u = __float_as_uint(f); return (u + 0x7fffu + ((u >> 16) & 1u)) >> 16; }
DEV unsigned pk2(float lo, float hi) { return f2bf(lo) | (f2bf(hi) << 16); }
DEV float bflo(unsigned u) { return __uint_as_float(u << 16); }
DEV float bfhi(unsigned u) { return __uint_as_float(u & 0xffff0000u); }
DEV float bf2f(bf16_t h) { return __uint_as_float(((unsigned)h) << 16); }
DEV float wave_sum(float v) {
#pragma unroll
    for (int o = 32; o > 0; o >>= 1) v += __shfl_xor(v, o);
    return v;
}
DEV float wave_max(float v) {
#pragma unroll
    for (int o = 32; o > 0; o >>= 1) v = fmaxf(v, __shfl_xor(v, o));
    return v;
}
DEV float sigmoidf_(float v) { return 1.f / (1.f + __expf(-v)); }
DEV f32x4 mfma16(bf16x8 a, bf16x8 b, f32x4 c) { return __builtin_amdgcn_mfma_f32_16x16x32_bf16(a, b, c, 0, 0, 0); }
DEV void wave_lds_sync() { __builtin_amdgcn_fence(__ATOMIC_ACQ_REL, "wavefront"); __builtin_amdgcn_wave_barrier(); }

DEV void transpose_item(const float* W, int ldw, int k0, int nsrc0, bf16_t* WT, int ldt, int ndst0, float* scr, int lane) {
#pragma unroll 8
    for (int i = 0; i < 32; ++i) { const int kk = 2 * i + (lane >> 5); scr[kk * 33 + (lane & 31)] = W[(size_t)(k0 + kk) * ldw + nsrc0 + (lane & 31)]; }
    wave_lds_sync();
    const int c = lane & 7;
#pragma unroll
    for (int j = 0; j < 4; ++j) {
        const int n = (lane >> 3) + 8 * j; const float* s = scr + (8 * c) * 33 + n;
        u32x4 o; o.x = pk2(s[0 * 33], s[1 * 33]); o.y = pk2(s[2 * 33], s[3 * 33]); o.z = pk2(s[4 * 33], s[5 * 33]); o.w = pk2(s[6 * 33], s[7 * 33]);
        *(u32x4*)(WT + (size_t)(ndst0 + n) * ldt + k0 + 8 * c) = o;
    }
    wave_lds_sync();
}

DEV void stage_prep(const Params& p, char* lds, int vb, int nvb) {
    const int tid = threadIdx.x, lane = tid & 63, wave = __builtin_amdgcn_readfirstlane(tid >> 6);
    float* mod = (float*)(p.ws + WS_MOD);
    float* s_act = (float*)lds;
    float* s_red = (float*)(lds + 8192);
    for (int i = tid; i < 2048; i += NTH) { const float v = p.c[i]; s_act[i] = v / (1.f + expf(-v)); }
    __syncthreads();
    for (int item = vb; item < 192; item += nvb) {
        const int kg = tid >> 5, cl = tid & 31, col = item * 32 + cl;
        float s0 = 0.f, s1 = 0.f;
        for (int k = kg; k < 1024; k += 16) { const float w = p.w_ada[(size_t)k * 6144 + col]; s0 += s_act[k] * w; s1 += s_act[1024 + k] * w; }
        s_red[(kg * 32 + cl) * 2] = s0; s_red[(kg * 32 + cl) * 2 + 1] = s1;
        __syncthreads();
        if (tid < 64) { const int b = tid >> 5, c2 = tid & 31; float s = 0.f; for (int g = 0; g < 16; ++g) s += s_red[(g * 32 + c2) * 2 + b]; mod[b * 6144 + item * 32 + c2] = s + p.b_ada[item * 32 + c2]; }
        __syncthreads();
    }
    float* scr = (float*)(lds + 16384 + wave * 8448);
    const int gw = vb * NW + wave, ngw = nvb * NW;
    bf16_t* Wt_in = (bf16_t*)(p.ws + WS_WIN); bf16_t* Wt_a = (bf16_t*)(p.ws + WS_WA); bf16_t* Wt_b = (bf16_t*)(p.ws + WS_WB);
    bf16_t* Wt_out = (bf16_t*)(p.ws + WS_WOUT); bf16_t* Wt_q = (bf16_t*)(p.ws + WS_WQ);
    for (int it = gw; it < 4480; it += ngw) {
        int r = it;
        if (r < 2432) { const int kb = r / 152, nb = r % 152; transpose_item(p.w_in, 4872, kb * 64, nb * 32 + (nb >= 88 ? 8 : 0), Wt_in, 1024, nb * 32, scr, lane); continue; } r -= 2432;
        if (r < 256) { const int kb = r / 32, nb = r % 32; transpose_item(p.w_a, 1024, kb * 64, nb * 32, Wt_a, 512, nb * 32, scr, lane); continue; } r -= 256;
        if (r < 256) { const int kb = r / 32, nb = r % 32; transpose_item(p.w_b, 1024, kb * 64, nb * 32, Wt_b, 512, nb * 32, scr, lane); continue; } r -= 256;
        if (r < 512) { const int kb = r / 32, nb = r % 32; transpose_item(p.w_out, 1024, kb * 64, nb * 32, Wt_out, 1024, nb * 32, scr, lane); continue; } r -= 512;
        { const int kb = r / 64, nb = r % 64; transpose_item(p.w_q, 2048, kb * 64, nb * 32, Wt_q, 1024, nb * 32, scr, lane); }
    }
    const size_t gt = (size_t)vb * NTH + tid, ngt = (size_t)nvb * NTH;
    for (int row = gw; row < 32768; row += ngw) {
        const bool isv = row >= 16384; const int r = row & 16383;
        const float4* src = (const float4*)((isv ? p.peer_v : p.peer_u) + (size_t)r * D) + 4 * lane;
        float4 a[4]; float mx = 0.f;
#pragma unroll
        for (int i = 0; i < 4; ++i) { a[i] = src[i]; mx = fmaxf(mx, fmaxf(fmaxf(fabsf(a[i].x), fabsf(a[i].y)), fmaxf(fabsf(a[i].z), fabsf(a[i].w)))); }
        mx = wave_max(mx);
        int ex = 0; if (mx > 0.f) (void)frexpf(mx, &ex); else ex = 8;
        const float sc = ldexpf(1.f, 8 - ex), isc = ldexpf(1.f, ex - 8);
        u32x4 w;
#pragma unroll
        for (int i = 0; i < 4; ++i) { int pk = 0; pk = __builtin_amdgcn_cvt_pk_fp8_f32(a[i].x * sc, a[i].y * sc, pk, false); pk = __builtin_amdgcn_cvt_pk_fp8_f32(a[i].z * sc, a[i].w * sc, pk, true); w[i] = (unsigned)pk; }
        ((u32x4*)(p.ws + (isv ? WS_TV : WS_TU) + (size_t)r * 1024))[lane] = w;
        if (lane == 0) ((float*)(p.ws + (isv ? WS_ISV : WS_ISU)))[r] = isc;
    }
    for (size_t g = gt; g < 4096; g += ngt) {
        const float4 a = ((const float4*)p.sub_keys)[2 * g], b = ((const float4*)p.sub_keys)[2 * g + 1];
        u32x4 w; w.x = pk2(a.x, a.y); w.y = pk2(a.z, a.w); w.z = pk2(b.x, b.y); w.w = pk2(b.z, b.w);
        ((u32x4*)(p.ws + WS_SK))[g] = w;
    }
    float2* rope = (float2*)(p.ws + WS_ROPE);
    for (size_t e = gt; e < 16384 * 32; e += ngt) {
        const int pos = (int)(e >> 5), i = (int)(e & 31);
        const float inv = (float)exp2(-(double)i * (13.287712379549449 / 32.0));
        const float ang = (float)pos * inv;
        const double a = (double)ang; const double n = rint(a * 0.15915494309189535); const double r = a - n * 6.283185307179586;
        float s, c; sincosf((float)r, &s, &c);
        rope[e] = make_float2(c, s);
    }
}

DEV void stage_norm1(const Params& p, char* lds, int vb, int nvb) {
    const int tid = threadIdx.x, lane = tid & 63, wave = __builtin_amdgcn_readfirstlane(tid >> 6);
    float* wg = (float*)lds;
    for (int i = tid; i < 8192; i += NTH) { const int cc = i >> 10, k = i & 1023; wg[i] = p.w_in[(size_t)k * 4872 + 2816 + cc]; }
    __syncthreads();
    const float* mod = (const float*)(p.ws + WS_MOD);
    bf16_t* ub = (bf16_t*)(p.ws + WS_UB);
    float* ipre = (float*)(p.ws + WS_IPRE); float* fpre = (float*)(p.ws + WS_FPRE);
    for (int m = vb * NW + wave; m < M; m += nvb * NW) {
        const int b = m >= SEQ ? 1 : 0;
        const float4* xr = (const float4*)(p.x + (size_t)m * D);
        float4 v[4]; float ss = 0.f;
#pragma unroll
        for (int j = 0; j < 4; ++j) { v[j] = xr[lane + 64 * j]; ss += v[j].x * v[j].x + v[j].y * v[j].y + v[j].z * v[j].z + v[j].w * v[j].w; }
        ss = wave_sum(ss);
        const float rstd = rsqrtf(ss * (1.f / 1024.f) + 1e-6f);
        float ga[8];
#pragma unroll
        for (int cc = 0; cc < 8; ++cc) ga[cc] = 0.f;
#pragma unroll
        for (int j = 0; j < 4; ++j) {
            const int col = 4 * (lane + 64 * j);
            const float4 w1 = *(const float4*)(p.norm1_w + col), sc = *(const float4*)(mod + b * 6144 + 1024 + col), sh = *(const float4*)(mod + b * 6144 + col);
            float4 u;
            u.x = v[j].x * rstd * w1.x * (1.f + sc.x) + sh.x; u.y = v[j].y * rstd * w1.y * (1.f + sc.y) + sh.y;
            u.z = v[j].z * rstd * w1.z * (1.f + sc.z) + sh.z; u.w = v[j].w * rstd * w1.w * (1.f + sc.w) + sh.w;
            u32x2 o; o.x = pk2(u.x, u.y); o.y = pk2(u.z, u.w);
            *(u32x2*)(ub + (size_t)m * D + col) = o;
#pragma unroll
            for (int cc = 0; cc < 8; ++cc) { const float4 g = *(const float4*)(wg + cc * 1024 + col); ga[cc] += u.x * g.x + u.y * g.y + u.z * g.z + u.w * g.w; }
        }
#pragma unroll
        for (int cc = 0; cc < 8; ++cc) ga[cc] = wave_sum(ga[cc]);
        if (lane == 0) {
#pragma unroll
            for (int h = 0; h < 4; ++h) { ipre[(size_t)m * 4 + h] = ga[h] + p.i_bias[h]; fpre[(size_t)m * 4 + h] = ga[4 + h] + p.f_bias[h]; }
        }
    }
}

struct GemmOp { const bf16_t* A; int lda; const bf16_t* Bt; int ldb; int K; };

DEV void gemm_tile(f32x4 (&acc)[4][2], const GemmOp& g, int m0, int n0, char* lds) {
    const int tid = threadIdx.x, lane = tid & 63, wid = __builtin_amdgcn_readfirstlane(tid >> 6), wm = wid >> 2, wn = wid & 3, fr = lane & 15, fq = lane >> 4;
    const int sr = tid >> 3, sc = tid & 7;
    const bf16_t* ga = g.A + (size_t)(m0 + sr) * g.lda + sc * 8;
    const bf16_t* gb = g.Bt + (size_t)(n0 + sr) * g.ldb + sc * 8;
    const size_t a64 = (size_t)64 * g.lda, b64 = (size_t)64 * g.ldb;
    const int so = sr * 128 + ((sc ^ (sr & 7)) << 4);
    const int nk = g.K >> 6;
    u32x4 ra0 = *(const u32x4*)ga, ra1 = *(const u32x4*)(ga + a64), rb0 = *(const u32x4*)gb, rb1 = *(const u32x4*)(gb + b64);
    *(u32x4*)(lds + so) = ra0; *(u32x4*)(lds + so + 8192) = ra1; *(u32x4*)(lds + 32768 + so) = rb0; *(u32x4*)(lds + 32768 + so + 8192) = rb1;
    __syncthreads();
    const int aoff = (wm * 64 + fr) * 128, boff = 32768 + (wn * 32 + fr) * 128, sw = fr & 7;
    for (int kt = 0; kt < nk; ++kt) {
        const int cur = (kt & 1) * 16384;
        if (kt + 1 < nk) { ga += 64; gb += 64; ra0 = *(const u32x4*)ga; ra1 = *(const u32x4*)(ga + a64); rb0 = *(const u32x4*)gb; rb1 = *(const u32x4*)(gb + b64); }
#pragma unroll
        for (int ks = 0; ks < 2; ++ks) {
            const int ch = ((fq + 4 * ks) ^ sw) << 4;
            bf16x8 af[4], bfr[2];
#pragma unroll
            for (int mi = 0; mi < 4; ++mi) af[mi] = *(const bf16x8*)(lds + cur + aoff + mi * 2048 + ch);
#pragma unroll
            for (int ni = 0; ni < 2; ++ni) bfr[ni] = *(const bf16x8*)(lds + cur + boff + ni * 2048 + ch);
#pragma unroll
            for (int mi = 0; mi < 4; ++mi)
#pragma unroll
                for (int ni = 0; ni < 2; ++ni) acc[mi][ni] = mfma16(bfr[ni], af[mi], acc[mi][ni]);
        }
        if (kt + 1 < nk) {
            const int nxt = cur ^ 16384;
            *(u32x4*)(lds + nxt + so) = ra0; *(u32x4*)(lds + nxt + so + 8192) = ra1; *(u32x4*)(lds + 32768 + nxt + so) = rb0; *(u32x4*)(lds + 32768 + nxt + so + 8192) = rb1;
        }
        __syncthreads();
    }
}
#define GEMM_EPI_LOOP(...) { const int tid_ = threadIdx.x, lane_ = tid_ & 63, wid_ = tid_ >> 6, wm_ = wid_ >> 2, wn_ = wid_ & 3, fr_ = lane_ & 15, fq_ = lane_ >> 4; \
    _Pragma("unroll") for (int mi = 0; mi < 4; ++mi) _Pragma("unroll") for (int ni = 0; ni < 2; ++ni) { const int m = m0 + wm_ * 64 + mi * 16 + fr_, n = n0 + wn_ * 32 + ni * 16 + fq_ * 4; __VA_ARGS__ } }

DEV void stage_gemm_in(const Params& p, char* lds, int vb, int nvb) {
    GemmOp g{(const bf16_t*)(p.ws + WS_UB), 1024, (const bf16_t*)(p.ws + WS_WIN), 1024, 1024};
    bf16_t* PA = (bf16_t*)(p.ws + WS_PA); bf16_t* PM = (bf16_t*)(p.ws + WS_PM); bf16_t* PG = (bf16_t*)(p.ws + WS_PG);
    const int tn = 38, tiles = 256 * tn;
    for (int t = vb; t < tiles; t += nvb) {
        const int m0 = (t / tn) * 128, n0 = (t % tn) * 128;
        f32x4 acc[4][2];
#pragma unroll
        for (int i = 0; i < 4; ++i) { acc[i][0] = (f32x4){0.f, 0.f, 0.f, 0.f}; acc[i][1] = (f32x4){0.f, 0.f, 0.f, 0.f}; }
        gemm_tile(acc, g, m0, n0, lds);
        bf16_t* dst; int ld, nb;
        if (n0 < 768) { dst = PA; ld = LPA; nb = n0; } else if (n0 < 2816) { dst = PM; ld = LPM; nb = n0 - 768; } else { dst = PG; ld = LPG; nb = n0 - 2816; }
        GEMM_EPI_LOOP({ const f32x4 v = acc[mi][ni]; u32x2 o; o.x = pk2(v[0], v[1]); o.y = pk2(v[2], v[3]); *(u32x2*)(dst + (size_t)m * ld + (n - n0 + nb)) = o; })
    }
}

DEV void stage_gemm_merge(const Params& p, char* lds, int vb, int nvb) {
    GemmOp g1{(const bf16_t*)(p.ws + WS_PA), LPA, (const bf16_t*)(p.ws + WS_WA), 512, 512};
    GemmOp g2{(const bf16_t*)(p.ws + WS_PM) + 1536, LPM, (const bf16_t*)(p.ws + WS_WB), 512, 512};
    const bf16_t* PG = (const bf16_t*)(p.ws + WS_PG); bf16_t* MG = (bf16_t*)(p.ws + WS_UB);
    const int tn = 8, tiles = 256 * tn;
    for (int t = vb; t < tiles; t += nvb) {
        const int m0 = (t / tn) * 128, n0 = (t % tn) * 128;
        f32x4 acc[4][2], acc2[4][2];
#pragma unroll
        for (int i = 0; i < 4; ++i) { acc[i][0] = (f32x4){0.f, 0.f, 0.f, 0.f}; acc[i][1] = acc[i][0]; acc2[i][0] = acc[i][0]; acc2[i][1] = acc[i][0]; }
        gemm_tile(acc, g1, m0, n0, lds);
        gemm_tile(acc2, g2, m0, n0, lds);
        GEMM_EPI_LOOP({ const f32x4 v1 = acc[mi][ni], v2 = acc2[mi][ni];
            const u32x2 a = *(const u32x2*)(PG + (size_t)m * LPG + n), b = *(const u32x2*)(PG + (size_t)m * LPG + 1024 + n);
            const float r0 = sigmoidf_(bflo(a.x)) * v1[0] + sigmoidf_(bflo(b.x)) * v2[0], r1 = sigmoidf_(bfhi(a.x)) * v1[1] + sigmoidf_(bfhi(b.x)) * v2[1];
            const float r2 = sigmoidf_(bflo(a.y)) * v1[2] + sigmoidf_(bflo(b.y)) * v2[2], r3 = sigmoidf_(bfhi(a.y)) * v1[3] + sigmoidf_(bfhi(b.y)) * v2[3];
            u32x2 o; o.x = pk2(r0, r1); o.y = pk2(r2, r3); *(u32x2*)(MG + (size_t)m * 1024 + n) = o; })
    }
}

DEV void stage_gemm_out(const Params& p, char* lds, int vb, int nvb) {
    GemmOp g{(const bf16_t*)(p.ws + WS_UB), 1024, (const bf16_t*)(p.ws + WS_WOUT), 1024, 1024};
    const float* mod = (const float*)(p.ws + WS_MOD);
    const int tn = 8, tiles = 256 * tn;
    for (int t = vb; t < tiles; t += nvb) {
        const int m0 = (t / tn) * 128, n0 = (t % tn) * 128;
        f32x4 acc[4][2];
#pragma unroll
        for (int i = 0; i < 4; ++i) { acc[i][0] = (f32x4){0.f, 0.f, 0.f, 0.f}; acc[i][1] = acc[i][0]; }
        gemm_tile(acc, g, m0, n0, lds);
        const int b = m0 >= SEQ ? 1 : 0;
        GEMM_EPI_LOOP({ const f32x4 v = acc[mi][ni]; const f32x4 xv = *(const f32x4*)(p.x + (size_t)m * D + n); const f32x4 gv = *(const f32x4*)(mod + b * 6144 + 2048 + n);
            *(f32x4*)(p.out + (size_t)m * D + n) = xv + gv * v; })
    }
}

DEV void rope8(u32x4 x1, u32x4 x2, const float4* rp, float scale, u32x4& o1, u32x4& o2) {
#pragma unroll
    for (int w = 0; w < 4; ++w) {
        const float4 cs = rp[w];
        const float a0 = bflo(x1[w]), a1 = bfhi(x1[w]), b0 = bflo(x2[w]), b1 = bfhi(x2[w]);
        o1[w] = pk2((a0 * cs.x - b0 * cs.y) * scale, (a1 * cs.z - b1 * cs.w) * scale);
        o2[w] = pk2((b0 * cs.x + a0 * cs.y) * scale, (b1 * cs.z + a1 * cs.w) * scale);
    }
}

DEV void stage_attn(const Params& p, char* lds, int vb, int nvb) {
    const int tid = threadIdx.x, lane = tid & 63, wave = __builtin_amdgcn_readfirstlane(tid >> 6), fr = lane & 15, fq = lane >> 4;
    char* Ks = lds;
    char* VT = lds + 32768;
    char* Qs = lds + 70656;
    char* Ps = lds + 87040;
    bf16_t* PA = (bf16_t*)(p.ws + WS_PA);
    const float2* rope = (const float2*)(p.ws + WS_ROPE);
    for (int unit = vb; unit < 512; unit += nvb) {
        const int kvh = unit & 1, n = (unit >> 1) & 127, b = unit >> 8;
        __syncthreads();
        for (int task = tid; task < 1024; task += NTH) {
            const int ki = task >> 2, cp = task & 3, pos = 128 * (n - 1) + ki;
            u32x4 o1 = {0u, 0u, 0u, 0u}, o2 = {0u, 0u, 0u, 0u};
            if (pos >= 0) {
                const bf16_t* src = PA + (size_t)(b * SEQ + pos) * LPA + 512 + kvh * 64 + cp * 8;
                const u32x4 x1 = *(const u32x4*)src, x2 = *(const u32x4*)(src + 32);
                rope8(x1, x2, (const float4*)(rope + (size_t)pos * 32 + cp * 8), 1.0f, o1, o2);
            }
            const int sw = ki & 7;
            *(u32x4*)(Ks + ki * 128 + ((cp ^ sw) << 4)) = o1;
            *(u32x4*)(Ks + ki * 128 + (((cp + 4) ^ sw) << 4)) = o2;
        }
        for (int task = tid; task < 2048; task += NTH) {
            const int ki = task >> 3, c = task & 7, pos = 128 * (n - 1) + ki;
            u32x4 x = {0u, 0u, 0u, 0u};
            if (pos >= 0) x = *(const u32x4*)(PA + (size_t)(b * SEQ + pos) * LPA + 640 + kvh * 64 + c * 8);
#pragma unroll
            for (int e = 0; e < 8; ++e) *(bf16_t*)(VT + (c * 8 + e) * 592 + ki * 2) = (bf16_t)((e & 1) ? (x[e >> 1] >> 16) : (x[e >> 1] & 0xffffu));
        }
        for (int i = tid; i < 64 * 40; i += NTH) { const int d = i / 40, kk = 256 + i % 40; *(bf16_t*)(VT + d * 592 + kk * 2) = 0; }
        for (int i = tid; i < 2048; i += NTH) { const int w = i >> 8, r = (i >> 4) & 15, kk = 144 + (i & 15); *(bf16_t*)(Ps + w * 5376 + r * 336 + kk * 2) = 0; }
        for (int j = 0; j < 4; ++j) {
            const int hq = kvh * 4 + j;
            {
                const int qi = tid >> 2, cp = tid & 3, pos = 128 * n + qi;
                const bf16_t* src = PA + (size_t)(b * SEQ + pos) * LPA + hq * 64 + cp * 8;
                const u32x4 x1 = *(const u32x4*)src, x2 = *(const u32x4*)(src + 32);
                u32x4 o1, o2;
                rope8(x1, x2, (const float4*)(rope + (size_t)pos * 32 + cp * 8), 0.125f, o1, o2);
                const int sw = qi & 7;
                *(u32x4*)(Qs + qi * 128 + ((cp ^ sw) << 4)) = o1;
                *(u32x4*)(Qs + qi * 128 + (((cp + 4) ^ sw) << 4)) = o2;
            }
            __syncthreads();
            f32x4 s[9];
            const int sw = fr & 7;
            bf16x8 qf[2];
#pragma unroll
            for (int ks = 0; ks < 2; ++ks) qf[ks] = *(const bf16x8*)(Qs + (16 * wave + fr) * 128 + (((fq + 4 * ks) ^ sw) << 4));
#pragma unroll
            for (int t = 0; t < 9; ++t) {
                s[t] = (f32x4){0.f, 0.f, 0.f, 0.f};
#pragma unroll
                for (int ks = 0; ks < 2; ++ks) { const bf16x8 kf = *(const bf16x8*)(Ks + (16 * (wave + t) + fr) * 128 + (((fq + 4 * ks) ^ sw) << 4)); s[t] = mfma16(kf, qf[ks], s[t]); }
            }
            const float sink = p.sinks[hq];
            float mx = sink;
#pragma unroll
            for (int t = 0; t < 9; ++t)
#pragma unroll
                for (int r = 0; r < 4; ++r) {
                    const int dd = 16 * t + 4 * fq + r - fr, ki = 16 * (wave + t) + 4 * fq + r;
                    const bool ok = (dd >= 1) && (dd <= 128) && (n > 0 || ki >= 128);
                    const float v = ok ? s[t][r] : -INFINITY;
                    s[t][r] = v; mx = fmaxf(mx, v);
                }
            mx = fmaxf(mx, __shfl_xor(mx, 16)); mx = fmaxf(mx, __shfl_xor(mx, 32));
            float sum = 0.f;
#pragma unroll
            for (int t = 0; t < 9; ++t)
#pragma unroll
                for (int r = 0; r < 4; ++r) { const float pv = __expf(s[t][r] - mx); s[t][r] = pv; sum += pv; }
            sum += __shfl_xor(sum, 16); sum += __shfl_xor(sum, 32);
            const float inv = 1.f / (sum + __expf(sink - mx));
            char* Pw = Ps + wave * 5376 + fr * 336;
#pragma unroll
            for (int t = 0; t < 9; ++t) { u32x2 o; o.x = pk2(s[t][0], s[t][1]); o.y = pk2(s[t][2], s[t][3]); *(u32x2*)(Pw + (16 * t + 4 * fq) * 2) = o; }
            __syncthreads();
            f32x4 o[4];
#pragma unroll
            for (int di = 0; di < 4; ++di) o[di] = (f32x4){0.f, 0.f, 0.f, 0.f};
#pragma unroll
            for (int ks = 0; ks < 5; ++ks) {
                const bf16x8 pf = *(const bf16x8*)(Pw + (32 * ks + 8 * fq) * 2);
#pragma unroll
                for (int di = 0; di < 4; ++di) { const bf16x8 vf = *(const bf16x8*)(VT + (16 * di + fr) * 592 + (16 * wave + 32 * ks + 8 * fq) * 2); o[di] = mfma16(vf, pf, o[di]); }
            }
            bf16_t* dst = PA + (size_t)(b * SEQ + 128 * n + 16 * wave + fr) * LPA + hq * 64 + 4 * fq;
#pragma unroll
            for (int di = 0; di < 4; ++di) { u32x2 w; w.x = pk2(o[di][0] * inv, o[di][1] * inv); w.y = pk2(o[di][2] * inv, o[di][3] * inv); *(u32x2*)(dst + 16 * di) = w; }
            __syncthreads();
        }
    }
}

DEV float logsigf(float x) { return fminf(x, 0.f) - log1pf(expf(-fabsf(x))); }

DEV void chunk_gates(const float* ipre, const float* fpre, int rowbase, int h, float* gs, int lane) {
    const int l0 = 2 * lane;
    const float i0 = ipre[(size_t)(rowbase + l0) * 4 + h], i1 = ipre[(size_t)(rowbase + l0 + 1) * 4 + h];
    const float lf0 = logsigf(fpre[(size_t)(rowbase + l0) * 4 + h]), lf1 = logsigf(fpre[(size_t)(rowbase + l0 + 1) * 4 + h]);
    const float pair = lf0 + lf1;
    float sc = pair;
#pragma unroll
    for (int o = 1; o < 64; o <<= 1) { const float t = __shfl_up(sc, o); if (lane >= o) sc += t; }
    const float b0 = (sc - pair) + lf0, b1 = b0 + lf1;
    const float g = __shfl(sc, 63);
    const float a0 = g - b0 + i0, a1 = g - b1 + i1;
    const float mloc = wave_max(fmaxf(a0, a1));
    const float ib0 = i0 - b0, ib1 = i1 - b1;
    float scm = fmaxf(ib0, ib1);
#pragma unroll
    for (int o = 1; o < 64; o <<= 1) { const float t = __shfl_up(scm, o); if (lane >= o) scm = fmaxf(scm, t); }
    float ex = __shfl_up(scm, 1); if (lane == 0) ex = -INFINITY;
    const float pm0 = fmaxf(ex, ib0), pm1 = fmaxf(pm0, ib1);
    gs[l0] = b0; gs[l0 + 1] = b1; gs[128 + l0] = ib0; gs[128 + l0 + 1] = ib1; gs[256 + l0] = a0; gs[256 + l0 + 1] = a1; gs[384 + l0] = pm0; gs[384 + l0 + 1] = pm1;
    if (lane == 0) { gs[512] = g; gs[513] = mloc; }
}

DEV void conv8(const bf16_t* PM, const float* cw, int b, int t, int pmcol, int cch, float (&out)[8]) {
#pragma unroll
    for (int e = 0; e < 8; ++e) out[e] = 0.f;
#pragma unroll
    for (int j = 0; j < 4; ++j) {
        const int tt = t - 3 + j;
        if (tt >= 0) {
            const u32x4 x = *(const u32x4*)(PM + (size_t)(b * SEQ + tt) * LPM + pmcol);
            const float4 w0 = *(const float4*)(cw + j * 1024 + cch), w1 = *(const float4*)(cw + j * 1024 + cch + 4);
            out[0] += bflo(x[0]) * w0.x; out[1] += bfhi(x[0]) * w0.y; out[2] += bflo(x[1]) * w0.z; out[3] += bfhi(x[1]) * w0.w;
            out[4] += bflo(x[2]) * w1.x; out[5] += bfhi(x[2]) * w1.y; out[6] += bflo(x[3]) * w1.z; out[7] += bfhi(x[3]) * w1.w;
        }
    }
}
DEV float siluf_(float y) { return y / (1.f + __expf(-y)); }

DEV void stage_mstate(const Params& p, char* lds, int vb, int nvb) {
    const int tid = threadIdx.x, lane = tid & 63, wave = __builtin_amdgcn_readfirstlane(tid >> 6), fr = lane & 15, fq = lane >> 4;
    char* KT = lds;
    char* VT = lds + 34816;
    float* gs = (float*)(lds + 69632);
    const bf16_t* PM = (const bf16_t*)(p.ws + WS_PM);
    const float* ipre = (const float*)(p.ws + WS_IPRE); const float* fpre = (const float*)(p.ws + WS_FPRE);
    float* UT = (float*)(p.ws + WS_UB); float* NLOC = (float*)(p.ws + WS_NLOC);
    float* G = (float*)(p.ws + WS_CHG); float* MLOC = G + 1024;
    for (int unit = vb; unit < 1024; unit += nvb) {
        const int c = unit & 127, h = (unit >> 7) & 3, b = unit >> 9;
        const int rowbase = b * SEQ + c * 128;
        __syncthreads();
        if (wave == 0) chunk_gates(ipre, fpre, rowbase, h, gs, lane);
        __syncthreads();
        const float mloc = gs[513];
        for (int task = tid; task < 2048; task += NTH) {
            const int l = task >> 4, ch = task & 15;
            float v8[8]; conv8(PM, p.conv_w, b, c * 128 + l, 512 + h * 128 + ch * 8, 512 + h * 128 + ch * 8, v8);
            const float wgt = __expf(gs[256 + l] - mloc) * 0.08838834764831845f;
#pragma unroll
            for (int e = 0; e < 8; ++e) *(bf16_t*)(KT + (ch * 8 + e) * 272 + l * 2) = (bf16_t)f2bf(siluf_(v8[e]) * wgt);
        }
        for (int task = tid; task < 2048; task += NTH) {
            const int l = task >> 4, ch = task & 15;
            const u32x4 x = *(const u32x4*)(PM + (size_t)(rowbase + l) * LPM + 1024 + h * 128 + ch * 8);
#pragma unroll
            for (int e = 0; e < 8; ++e) *(bf16_t*)(VT + (ch * 8 + e) * 272 + l * 2) = (bf16_t)((e & 1) ? (x[e >> 1] >> 16) : (x[e >> 1] & 0xffffu));
        }
        __syncthreads();
        f32x4 acc[8];
#pragma unroll
        for (int t = 0; t < 8; ++t) acc[t] = (f32x4){0.f, 0.f, 0.f, 0.f};
#pragma unroll
        for (int ks = 0; ks < 4; ++ks) {
            const bf16x8 vf = *(const bf16x8*)(VT + (16 * wave + fr) * 272 + (32 * ks + 8 * fq) * 2);
#pragma unroll
            for (int t = 0; t < 8; ++t) { const bf16x8 kf = *(const bf16x8*)(KT + (16 * t + fr) * 272 + (32 * ks + 8 * fq) * 2); acc[t] = mfma16(kf, vf, acc[t]); }
        }
        float* UTu = UT + (size_t)unit * 16384 + (16 * wave + fr) * 128 + 4 * fq;
#pragma unroll
        for (int t = 0; t < 8; ++t) *(f32x4*)(UTu + 16 * t) = acc[t];
        if (tid < 128) { float s = 0.f; for (int l = 0; l < 128; ++l) s += bf2f(*(const bf16_t*)(KT + tid * 272 + l * 2)); NLOC[unit * 128 + tid] = s; }
        if (tid == 0) { G[unit] = gs[512]; MLOC[unit] = mloc; }
    }
}

DEV void stage_mscan(const Params& p, char* lds, int vb, int nvb) {
    const int tid = threadIdx.x;
    float* s_dec = (float*)lds; float* s_scl = s_dec + 128;
    const float* UT = (const float*)(p.ws + WS_UB); const float* NLOC = (const float*)(p.ws + WS_NLOC);
    const float* G = (const float*)(p.ws + WS_CHG); const float* MLOC = G + 1024; float* MST = (float*)(p.ws + WS_CHG) + 2048;
    bf16_t* CST = (bf16_t*)(p.ws + WS_CST); float* NST = (float*)(p.ws + WS_NST);
    for (int item = vb; item < 256; item += nvb) {
        const int bh = item >> 5, part = item & 31;
        __syncthreads();
        if (tid == 0) {
            float m = 0.f;
            for (int c = 0; c < 128; ++c) { const int u = bh * 128 + c; const float g = G[u], ml = MLOC[u]; const float mn = fmaxf(g + m, ml); s_dec[c] = expf(g + m - mn); s_scl[c] = expf(ml - mn); if (part == 0) MST[u] = m; m = mn; }
        }
        __syncthreads();
        const int e = part * 512 + tid;
        float C = 0.f;
        const float* up = UT + (size_t)bh * 128 * 16384 + e; bf16_t* cp = CST + (size_t)bh * 128 * 16384 + e;
        for (int c = 0; c < 128; c += 8) {
            float uu[8];
#pragma unroll
            for (int i = 0; i < 8; ++i) uu[i] = up[(size_t)(c + i) * 16384];
#pragma unroll
            for (int i = 0; i < 8; ++i) { cp[(size_t)(c + i) * 16384] = (bf16_t)f2bf(C); C = s_dec[c + i] * C + s_scl[c + i] * uu[i]; }
        }
        if (part == 0 && tid < 128) { float nn = 0.f; for (int c = 0; c < 128; ++c) { NST[(bh * 128 + c) * 128 + tid] = nn; nn = s_dec[c] * nn + s_scl[c] * NLOC[(bh * 128 + c) * 128 + tid]; } }
    }
}

DEV void stage_mout(const Params& p, char* lds, int vb, int nvb) {
    const int tid = threadIdx.x, lane = tid & 63, wave = __builtin_amdgcn_readfirstlane(tid >> 6), fr = lane & 15, fq = lane >> 4;
    char* Qs = lds; char* Ks = lds + 34816; char* VT = lds + 69632; char* CT = lds + 104448;
    float* gs = (float*)(lds + 139264); float* s_nst = gs + 520; float* s_mo = gs + 648; float* s_wi = gs + 776;
    bf16_t* PM = (bf16_t*)(p.ws + WS_PM);
    const float* ipre = (const float*)(p.ws + WS_IPRE); const float* fpre = (const float*)(p.ws + WS_FPRE);
    const float* MST = (const float*)(p.ws + WS_CHG) + 2048; const float* NST = (const float*)(p.ws + WS_NST);
    const bf16_t* CST = (const bf16_t*)(p.ws + WS_CST);
    for (int unit = vb; unit < 1024; unit += nvb) {
        const int c = unit & 127, h = (unit >> 7) & 3, b = unit >> 9;
        const int rowbase = b * SEQ + c * 128;
        __syncthreads();
        if (wave == 0) chunk_gates(ipre, fpre, rowbase, h, gs, lane);
        for (int task = tid; task < 2048; task += NTH) {
            const int l = task >> 4, ch = task & 15;
            float v8[8]; u32x4 o;
            conv8(PM, p.conv_w, b, c * 128 + l, h * 128 + ch * 8, h * 128 + ch * 8, v8);
            o.x = pk2(siluf_(v8[0]), siluf_(v8[1])); o.y = pk2(siluf_(v8[2]), siluf_(v8[3])); o.z = pk2(siluf_(v8[4]), siluf_(v8[5])); o.w = pk2(siluf_(v8[6]), siluf_(v8[7]));
            *(u32x4*)(Qs + l * 272 + ch * 16) = o;
            conv8(PM, p.conv_w, b, c * 128 + l, 512 + h * 128 + ch * 8, 512 + h * 128 + ch * 8, v8);
            const float sc = 0.08838834764831845f;
            o.x = pk2(siluf_(v8[0]) * sc, siluf_(v8[1]) * sc); o.y = pk2(siluf_(v8[2]) * sc, siluf_(v8[3]) * sc); o.z = pk2(siluf_(v8[4]) * sc, siluf_(v8[5]) * sc); o.w = pk2(siluf_(v8[6]) * sc, siluf_(v8[7]) * sc);
            *(u32x4*)(Ks + l * 272 + ch * 16) = o;
            const u32x4 x = *(const u32x4*)(PM + (size_t)(rowbase + l) * LPM + 1024 + h * 128 + ch * 8);
#pragma unroll
            for (int e = 0; e < 8; ++e) *(bf16_t*)(VT + (ch * 8 + e) * 272 + l * 2) = (bf16_t)((e & 1) ? (x[e >> 1] >> 16) : (x[e >> 1] & 0xffffu));
            *(u32x4*)(CT + l * 272 + ch * 16) = *(const u32x4*)(CST + (size_t)unit * 16384 + l * 128 + ch * 8);
        }
        if (tid < 128) s_nst[tid] = NST[unit * 128 + tid];
        __syncthreads();
        if (tid < 128) { const float mst = MST[unit]; const float bc = gs[tid]; const float mo = bc + fmaxf(mst, gs[384 + tid]); s_mo[tid] = mo; s_wi[tid] = __expf(bc + mst - mo); }
        __syncthreads();
        const int l = 16 * wave + fr;
        f32x4 s[8];
        bf16x8 qf[4];
#pragma unroll
        for (int ks = 0; ks < 4; ++ks) qf[ks] = *(const bf16x8*)(Qs + l * 272 + (32 * ks + 8 * fq) * 2);
#pragma unroll
        for (int t = 0; t < 8; ++t) {
            s[t] = (f32x4){0.f, 0.f, 0.f, 0.f};
            if (t <= wave) {
#pragma unroll
                for (int ks = 0; ks < 4; ++ks) { const bf16x8 kf = *(const bf16x8*)(Ks + (16 * t + fr) * 272 + (32 * ks + 8 * fq) * 2); s[t] = mfma16(kf, qf[ks], s[t]); }
            }
        }
        const float bl = gs[l], mol = s_mo[l];
        float dsum = 0.f;
#pragma unroll
        for (int t = 0; t < 8; ++t)
#pragma unroll
            for (int r = 0; r < 4; ++r) {
                const int si = 16 * t + 4 * fq + r; float wv = 0.f;
                if (t <= wave && si <= l) wv = __expf(bl + gs[128 + si] - mol) * s[t][r];
                s[t][r] = wv; dsum += wv;
            }
        dsum += __shfl_xor(dsum, 16); dsum += __shfl_xor(dsum, 32);
        float qn = 0.f;
        {
            const char* qrow = Qs + l * 272 + fq * 64;
#pragma unroll
            for (int i = 0; i < 4; ++i) {
                const u32x4 x = *(const u32x4*)(qrow + 16 * i); const float* nn = s_nst + fq * 32 + 8 * i;
                qn += bflo(x[0]) * nn[0] + bfhi(x[0]) * nn[1] + bflo(x[1]) * nn[2] + bfhi(x[1]) * nn[3] + bflo(x[2]) * nn[4] + bfhi(x[2]) * nn[5] + bflo(x[3]) * nn[6] + bfhi(x[3]) * nn[7];
            }
        }
        qn += __shfl_xor(qn, 16); qn += __shfl_xor(qn, 32);
        __syncthreads();
#pragma unroll
        for (int t = 0; t < 8; ++t)
            if (t <= wave + 1) { u32x2 o; o.x = pk2(s[t][0], s[t][1]); o.y = pk2(s[t][2], s[t][3]); *(u32x2*)(Ks + l * 272 + (16 * t + 4 * fq) * 2) = o; }
        __syncthreads();
        f32x4 acc[8];
#pragma unroll
        for (int t = 0; t < 8; ++t) acc[t] = (f32x4){0.f, 0.f, 0.f, 0.f};
#pragma unroll
        for (int ks = 0; ks < 4; ++ks)
#pragma unroll
            for (int t = 0; t < 8; ++t) { const bf16x8 cf = *(const bf16x8*)(CT + (16 * t + fr) * 272 + (32 * ks + 8 * fq) * 2); acc[t] = mfma16(cf, qf[ks], acc[t]); }
        const float wi = s_wi[l];
#pragma unroll
        for (int t = 0; t < 8; ++t) acc[t] = acc[t] * wi;
        const int nks = (wave + 2) >> 1;
#pragma unroll
        for (int ks = 0; ks < 4; ++ks)
            if (ks < nks) {
                const bf16x8 wf = *(const bf16x8*)(Ks + l * 272 + (32 * ks + 8 * fq) * 2);
#pragma unroll
                for (int t = 0; t < 8; ++t) { const bf16x8 vf = *(const bf16x8*)(VT + (16 * t + fr) * 272 + (32 * ks + 8 * fq) * 2); acc[t] = mfma16(vf, wf, acc[t]); }
            }
        const float den = dsum + wi * qn;
        const float invd = 1.f / fmaxf(fabsf(den), __expf(-mol));
        bf16_t* mop = PM + (size_t)(rowbase + l) * LPM + 1536 + h * 128 + 4 * fq;
        float ssq = 0.f;
#pragma unroll
        for (int t = 0; t < 8; ++t) {
            const u32x2 g2 = *(const u32x2*)(mop + 16 * t);
            const float gg[4] = {bflo(g2.x), bfhi(g2.x), bflo(g2.y), bfhi(g2.y)};
#pragma unroll
            for (int r = 0; r < 4; ++r) { const float hv = acc[t][r] * invd * sigmoidf_(gg[r]); acc[t][r] = hv; ssq += hv * hv; }
        }
        ssq += __shfl_xor(ssq, 16); ssq += __shfl_xor(ssq, 32);
        const float rn = rsqrtf(ssq * (1.f / 128.f) + 1e-6f);
#pragma unroll
        for (int t = 0; t < 8; ++t) {
            const float4 nw = *(const float4*)(p.mnorm_w + h * 128 + 16 * t + 4 * fq);
            u32x2 o; o.x = pk2(acc[t][0] * rn * nw.x, acc[t][1] * rn * nw.y); o.y = pk2(acc[t][2] * rn * nw.z, acc[t][3] * rn * nw.w);
            *(u32x2*)(mop + 16 * t) = o;
        }
    }
}

DEV void stage_norm2(const Params& p, char* lds, int vb, int nvb) {
    const int tid = threadIdx.x, lane = tid & 63, wave = __builtin_amdgcn_readfirstlane(tid >> 6);
    const float* mod = (const float*)(p.ws + WS_MOD);
    bf16_t* U2 = (bf16_t*)(p.ws + WS_PG);
    for (int m = vb * NW + wave; m < M; m += nvb * NW) {
        const int b = m >= SEQ ? 1 : 0;
        const float4* xr = (const float4*)(p.out + (size_t)m * D);
        float4 v[4]; float ss = 0.f;
#pragma unroll
        for (int j = 0; j < 4; ++j) { v[j] = xr[lane + 64 * j]; ss += v[j].x * v[j].x + v[j].y * v[j].y + v[j].z * v[j].z + v[j].w * v[j].w; }
        ss = wave_sum(ss);
        const float rstd = rsqrtf(ss * (1.f / 1024.f) + 1e-6f);
#pragma unroll
        for (int j = 0; j < 4; ++j) {
            const int col = 4 * (lane + 64 * j);
            const float4 w1 = *(const float4*)(p.norm2_w + col), sc = *(const float4*)(mod + b * 6144 + 4096 + col), sh = *(const float4*)(mod + b * 6144 + 3072 + col);
            u32x2 o;
            o.x = pk2(v[j].x * rstd * w1.x * (1.f + sc.x) + sh.x, v[j].y * rstd * w1.y * (1.f + sc.y) + sh.y);
            o.y = pk2(v[j].z * rstd * w1.z * (1.f + sc.z) + sh.z, v[j].w * rstd * w1.w * (1.f + sc.w) + sh.w);
            *(u32x2*)(U2 + (size_t)m * D + col) = o;
        }
    }
}

constexpr size_t WS_SELI = WS_PM;
constexpr size_t WS_SELG = WS_PM + 16 * MiB;
DEV unsigned f2ord(float f) { const unsigned u = __float_as_uint(f); return (u & 0x80000000u) ? ~u : (u | 0x80000000u); }
DEV float ord2f(unsigned k) { return __uint_as_float((k & 0x80000000u) ? (k ^ 0x80000000u) : ~k); }
DEV unsigned umax_(unsigned a, unsigned b) { return a > b ? a : b; }

DEV void stage_q_topk(const Params& p, char* lds, int vb, int nvb) {
    const int tid = threadIdx.x, lane = tid & 63, wave = __builtin_amdgcn_readfirstlane(tid >> 6), fr = lane & 15, fq = lane >> 4;
    char* Qt = lds;
    char* Kd = lds + 65536;
    unsigned* tops = (unsigned*)(lds + 135168);
    const bf16_t* SK = (const bf16_t*)(p.ws + WS_SK);
    for (int i = tid; i < 2 * 128 * 16; i += NTH) { const int row = i >> 4, ch = i & 15; *(u32x4*)(Kd + row * 272 + ch * 16) = *(const u32x4*)(SK + row * 128 + ch * 8); }
    GemmOp g{(const bf16_t*)(p.ws + WS_PG), 1024, (const bf16_t*)(p.ws + WS_WQ), 1024, 1024};
    int* SELI = (int*)(p.ws + WS_SELI); float* SELG = (float*)(p.ws + WS_SELG);
    for (int item = vb; item < 2048; item += nvb) {
        const int mt = item >> 3, h = item & 7, m0 = mt * 128;
        for (int pp = 0; pp < 2; ++pp) {
            f32x4 acc[4][2];
#pragma unroll
            for (int i = 0; i < 4; ++i) { acc[i][0] = (f32x4){0.f, 0.f, 0.f, 0.f}; acc[i][1] = acc[i][0]; }
            gemm_tile(acc, g, m0, h * 256 + pp * 128, lds);
            {
                const int wm = wave >> 2, wn = wave & 3;
#pragma unroll
                for (int mi = 0; mi < 4; ++mi)
#pragma unroll
                    for (int ni = 0; ni < 2; ++ni) { const f32x4 v = acc[mi][ni]; u32x2 o; o.x = pk2(v[0], v[1]); o.y = pk2(v[2], v[3]);
                        *(u32x2*)(Qt + (wm * 64 + mi * 16 + fr) * 272 + (wn * 32 + ni * 16 + 4 * fq) * 2) = o; }
            }
            __syncthreads();
            bf16x8 qf[4];
#pragma unroll
            for (int ks = 0; ks < 4; ++ks) qf[ks] = *(const bf16x8*)(Qt + (16 * wave + fr) * 272 + (32 * ks + 8 * fq) * 2);
            unsigned key[32];
#pragma unroll
            for (int t = 0; t < 8; ++t) {
                f32x4 sc = {0.f, 0.f, 0.f, 0.f};
#pragma unroll
                for (int ks = 0; ks < 4; ++ks) { const bf16x8 kf = *(const bf16x8*)(Kd + (pp * 128 + 16 * t + fr) * 272 + (32 * ks + 8 * fq) * 2); sc = mfma16(kf, qf[ks], sc); }
#pragma unroll
                for (int r = 0; r < 4; ++r) key[4 * t + r] = (f2ord(sc[r]) & ~127u) | (127u - (unsigned)(16 * t + 4 * fq + r));
            }
            unsigned prev = 0xffffffffu;
            for (int r = 0; r < 16; ++r) {
                unsigned best = 0u;
#pragma unroll
                for (int i = 0; i < 32; ++i) { const unsigned c = key[i] < prev ? key[i] : 0u; best = umax_(best, c); }
                best = umax_(best, (unsigned)__shfl_xor((int)best, 16)); best = umax_(best, (unsigned)__shfl_xor((int)best, 32));
                prev = best;
                if (fq == 0) tops[((16 * wave + fr) * 2 + pp) * 16 + r] = best;
            }
            __syncthreads();
        }
        const unsigned* tp = tops + (16 * wave + fr) * 32;
        float A[4], B[16];
#pragma unroll
        for (int m = 0; m < 4; ++m) A[m] = ord2f(tp[fq + 4 * m] & ~127u);
#pragma unroll
        for (int j = 0; j < 16; ++j) B[j] = ord2f(tp[16 + j] & ~127u);
        unsigned ck[21];
#pragma unroll
        for (int sl = 0; sl < 21; ++sl) {
            const int m = sl < 16 ? 0 : (sl < 19 ? 1 : (sl < 20 ? 2 : 3)), j = sl < 16 ? sl : (sl < 19 ? sl - 16 : 0);
            const int i = fq + 4 * m;
            const bool ok = j < 16 / (i + 1);
            ck[sl] = ok ? ((f2ord(A[m] + B[j]) & ~255u) | (255u - (unsigned)(i * 16 + j))) : 0u;
        }
        unsigned wins[16];
        {
            unsigned prev = 0xffffffffu;
#pragma unroll
            for (int r = 0; r < 16; ++r) {
                unsigned best = 0u;
#pragma unroll
                for (int sl = 0; sl < 21; ++sl) { const unsigned c = ck[sl] < prev ? ck[sl] : 0u; best = umax_(best, c); }
                best = umax_(best, (unsigned)__shfl_xor((int)best, 16)); best = umax_(best, (unsigned)__shfl_xor((int)best, 32));
                prev = best; wins[r] = best;
            }
        }
        const float v0 = ord2f(wins[0] & ~255u);
        float ex[16], sm = 0.f;
#pragma unroll
        for (int r = 0; r < 16; ++r) { ex[r] = __expf(ord2f(wins[r] & ~255u) - v0); sm += ex[r]; }
        const float rs = 1.f / sm;
        int oi[4]; float og[4];
#pragma unroll
        for (int q = 0; q < 4; ++q) {
            const unsigned w = fq == 0 ? wins[q] : (fq == 1 ? wins[4 + q] : (fq == 2 ? wins[8 + q] : wins[12 + q]));
            const float e = fq == 0 ? ex[q] : (fq == 1 ? ex[4 + q] : (fq == 2 ? ex[8 + q] : ex[12 + q]));
            const unsigned flat = 255u - (w & 255u); const unsigned ia = flat >> 4, jb = flat & 15u;
            oi[q] = (int)((127u - (tp[ia] & 127u)) * 128u + (127u - (tp[16 + jb] & 127u)));
            og[q] = e * rs;
        }
        const size_t so = (size_t)(m0 + 16 * wave + fr) * 128 + h * 16 + 4 * fq;
        *(int4*)(SELI + so) = make_int4(oi[0], oi[1], oi[2], oi[3]);
        *(float4*)(SELG + so) = make_float4(og[0], og[1], og[2], og[3]);
    }
}

typedef float f32x2 __attribute__((ext_vector_type(2)));
struct EB { u32x4 u[8], v[8]; };

DEV void peer_load(EB& b, const unsigned char* TU, const unsigned char* TV, int iv, int e0, int lane) {
#pragma unroll
    for (int q = 0; q < 8; ++q) {
        const int id = __builtin_amdgcn_readlane(iv, e0 + q);
        b.u[q] = ((const u32x4*)(TU + (size_t)id * 1024))[lane]; b.v[q] = ((const u32x4*)(TV + (size_t)id * 1024))[lane];
    }
}
DEV void peer_compute(const EB& b, const f32x2 (&x)[8], float isu, float gsv, int e0, int lane, f32x2 (&oa)[8]) {
    float d[8];
#pragma unroll
    for (int q = 0; q < 8; ++q) {
        f32x2 a = {0.f, 0.f};
#pragma unroll
        for (int i = 0; i < 4; ++i) {
            a = __builtin_elementwise_fma(__builtin_amdgcn_cvt_pk_f32_fp8((int)b.u[q][i], false), x[2 * i], a);
            a = __builtin_elementwise_fma(__builtin_amdgcn_cvt_pk_f32_fp8((int)b.u[q][i], true), x[2 * i + 1], a);
        }
        d[q] = (a.x + a.y) * __uint_as_float((unsigned)__builtin_amdgcn_readlane((int)__float_as_uint(isu), e0 + q));
    }
    const bool h32 = (lane & 32) != 0, h16 = (lane & 16) != 0, h8 = (lane & 8) != 0;
    float k[4];
#pragma unroll
    for (int i = 0; i < 4; ++i) k[i] = (h32 ? d[4 + i] : d[i]) + __shfl_xor(h32 ? d[i] : d[4 + i], 32);
    float m2[2];
#pragma unroll
    for (int i = 0; i < 2; ++i) m2[i] = (h16 ? k[2 + i] : k[i]) + __shfl_xor(h16 ? k[i] : k[2 + i], 16);
    float v1 = (h8 ? m2[1] : m2[0]) + __shfl_xor(h8 ? m2[0] : m2[1], 8);
    v1 += __shfl_xor(v1, 4); v1 += __shfl_xor(v1, 2); v1 += __shfl_xor(v1, 1);
    const float gl = __shfl(gsv, e0 + ((lane >> 3) & 7));
    const int wi_ = (int)__float_as_uint(gl * 0.5f * v1 * (1.f + erff(v1 * 0.7071067811865476f)));
#pragma unroll
    for (int q = 0; q < 8; ++q) {
        const float w = __uint_as_float((unsigned)__builtin_amdgcn_readlane(wi_, 8 * q));
        const f32x2 w2 = {w, w};
#pragma unroll
        for (int i = 0; i < 4; ++i) {
            oa[2 * i] = __builtin_elementwise_fma(__builtin_amdgcn_cvt_pk_f32_fp8((int)b.v[q][i], false), w2, oa[2 * i]);
            oa[2 * i + 1] = __builtin_elementwise_fma(__builtin_amdgcn_cvt_pk_f32_fp8((int)b.v[q][i], true), w2, oa[2 * i + 1]);
        }
    }
}

DEV void stage_peer_gather(const Params& p, char* lds, int vb, int nvb, bool dry = false) {
    const int tid = threadIdx.x, lane = tid & 63, wave = __builtin_amdgcn_readfirstlane(tid >> 6);
    const bf16_t* U2 = (const bf16_t*)(p.ws + WS_PG);
    const unsigned char* TU = p.ws + WS_TU; const unsigned char* TV = p.ws + WS_TV;
    const float* ISU = (const float*)(p.ws + WS_ISU); const float* ISV = (const float*)(p.ws + WS_ISV);
    const int* SELI = (const int*)(p.ws + WS_SELI); const float* SELG = (const float*)(p.ws + WS_SELG);
    const float* mod = (const float*)(p.ws + WS_MOD);
    for (int tkn = vb * NW + wave; tkn < M; tkn += nvb * NW) {
        f32x2 x[8];
        {
            const u32x4* xr = (const u32x4*)(U2 + (size_t)tkn * D + 16 * lane); const u32x4 x0 = xr[0], x1 = xr[1];
#pragma unroll
            for (int i = 0; i < 4; ++i) { x[i] = (f32x2){bflo(x0[i]), bfhi(x0[i])}; x[4 + i] = (f32x2){bflo(x1[i]), bfhi(x1[i])}; }
        }
        const int iv0 = SELI[(size_t)tkn * 128 + lane], iv1 = SELI[(size_t)tkn * 128 + 64 + lane];
        const float gs0 = SELG[(size_t)tkn * 128 + lane] * ISV[iv0], gs1 = SELG[(size_t)tkn * 128 + 64 + lane] * ISV[iv1];
        const float su0 = ISU[iv0], su1 = ISU[iv1];
        f32x2 oa[8];
#pragma unroll
        for (int i = 0; i < 8; ++i) oa[i] = (f32x2){0.f, 0.f};
        EB ba, bb;
#pragma unroll
        for (int half = 0; half < 2; ++half) {
            const int iv = half ? iv1 : iv0; const float gsv = half ? gs1 : gs0, isu = half ? su1 : su0;
            peer_load(ba, TU, TV, iv, 0, lane);
            for (int bt = 0; bt < 8; bt += 2) {
                peer_load(bb, TU, TV, iv, 8 * bt + 8, lane);
                peer_compute(ba, x, isu, gsv, 8 * bt, lane, oa);
                if (bt + 2 < 8) peer_load(ba, TU, TV, iv, 8 * bt + 16, lane);
                peer_compute(bb, x, isu, gsv, 8 * bt + 8, lane, oa);
            }
        }
        const int b = tkn >= SEQ ? 1 : 0;
        float* hr = p.out + (size_t)tkn * D + 16 * lane;
        const float* g2p = mod + b * 6144 + 5120 + 16 * lane;
        float4 y[4]; float ss = 0.f;
#pragma unroll
        for (int q = 0; q < 4; ++q) {
            const float4 hv = *(const float4*)(hr + 4 * q); const float4 g2 = *(const float4*)(g2p + 4 * q);
            y[q].x = hv.x + g2.x * oa[2 * q].x; y[q].y = hv.y + g2.y * oa[2 * q].y; y[q].z = hv.z + g2.z * oa[2 * q + 1].x; y[q].w = hv.w + g2.w * oa[2 * q + 1].y;
            ss += y[q].x * y[q].x + y[q].y * y[q].y + y[q].z * y[q].z + y[q].w * y[q].w;
        }
        ss = wave_sum(ss);
        const float rstd = rsqrtf(ss * (1.f / 1024.f) + 1e-6f);
        if (!dry || rstd == 123.456f)
#pragma unroll
        for (int q = 0; q < 4; ++q) {
            const float4 nw = *(const float4*)(p.normf_w + 16 * lane + 4 * q);
            float4 o; o.x = y[q].x * rstd * nw.x; o.y = y[q].y * rstd * nw.y; o.z = y[q].z * rstd * nw.z; o.w = y[q].w * rstd * nw.w;
            *(float4*)(hr + 4 * q) = o;
        }
    }
}

namespace cg = cooperative_groups;
constexpr int LDS_BYTES = 151552;

__global__ void __launch_bounds__(512) k_mega(Params p) {
    extern __shared__ __attribute__((aligned(16))) char lds[];
    cg::grid_group grid = cg::this_grid();
    const int vb = blockIdx.x, nvb = gridDim.x;
    stage_prep(p, lds, vb, nvb);        grid.sync();
    stage_norm1(p, lds, vb, nvb);       grid.sync();
    stage_gemm_in(p, lds, vb, nvb);     grid.sync();
    stage_attn(p, lds, vb, nvb);
    stage_mstate(p, lds, vb, nvb);      grid.sync();
    stage_mscan(p, lds, vb, nvb);       grid.sync();
    stage_mout(p, lds, vb, nvb);        grid.sync();
    stage_gemm_merge(p, lds, vb, nvb);  grid.sync();
    stage_gemm_out(p, lds, vb, nvb);    grid.sync();
    stage_norm2(p, lds, vb, nvb);       grid.sync();
    stage_q_topk(p, lds, vb, nvb);      grid.sync();
#ifdef XP_PEER
    stage_peer_gather(p, lds, vb, nvb, p.ws != nullptr);
#endif
    stage_peer_gather(p, lds, vb, nvb);
}

extern "C" void kernel_launch(void* const* d_in, const int* in_sizes, int n_in, void* d_out, int out_size, void* d_ws, size_t ws_size, hipStream_t stream) {
    if (n_in != 20 || ws_size < WS_END) { fprintf(stderr, "kernel_launch: unexpected n_in %d or ws_size %zu\n", n_in, ws_size); return; }
    static int grid_blocks = 0;
    if (!grid_blocks) {
        int dev = 0, cus = 0, per_cu = 0;
        (void)hipGetDevice(&dev);
        (void)hipDeviceGetAttribute(&cus, hipDeviceAttributeMultiprocessorCount, dev);
        (void)hipFuncSetAttribute((const void*)k_mega, hipFuncAttributeMaxDynamicSharedMemorySize, LDS_BYTES);
        (void)hipOccupancyMaxActiveBlocksPerMultiprocessor(&per_cu, (const void*)k_mega, 512, LDS_BYTES);
        if (per_cu < 1) { fprintf(stderr, "kernel_launch: occupancy query says %d blocks per CU\n", per_cu); per_cu = 1; }
        grid_blocks = cus * 1;
    }
    Params p{};
    p.x = (const float*)d_in[0]; p.c = (const float*)d_in[1]; p.w_ada = (const float*)d_in[2]; p.b_ada = (const float*)d_in[3]; p.norm1_w = (const float*)d_in[4];
    p.w_in = (const float*)d_in[5]; p.conv_w = (const float*)d_in[6]; p.sinks = (const float*)d_in[7]; p.i_bias = (const float*)d_in[8]; p.f_bias = (const float*)d_in[9];
    p.mnorm_w = (const float*)d_in[10]; p.w_a = (const float*)d_in[11]; p.w_b = (const float*)d_in[12]; p.w_out = (const float*)d_in[13]; p.norm2_w = (const float*)d_in[14];
    p.w_q = (const float*)d_in[15]; p.sub_keys = (const float*)d_in[16]; p.peer_u = (const float*)d_in[17]; p.peer_v = (const float*)d_in[18]; p.normf_w = (const float*)d_in[19];
    p.out = (float*)d_out; p.ws = (unsigned char*)d_ws;
    void* args[] = {&p};
    hipError_t e = hipLaunchCooperativeKernel((const void*)k_mega, dim3(grid_blocks), dim3(512), args, LDS_BYTES, stream);
    if (e != hipSuccess) fprintf(stderr, "cooperative launch failed: %s (grid %d)\n", hipGetErrorString(e), grid_blocks);
}
```

```cpp
#include <hip/hip_runtime.h>
#include <hip/hip_cooperative_groups.h>
#include <stdint.h>
#include <stdio.h>

#define DEV __device__ __forceinline__
typedef unsigned short bf16_t;
typedef short bf16x8 __attribute__((ext_vector_type(8)));
typedef float f32x4 __attribute__((ext_vector_type(4)));
typedef unsigned u32x4 __attribute__((ext_vector_type(4)));
typedef unsigned u32x2 __attribute__((ext_vector_type(2)));

constexpr int BATCH = 2, SEQ = 16384, M = BATCH * SEQ, D = 1024;
constexpr int NTH = 512, NW = 8;
constexpr int LPA = 768, LPM = 2048, LPG = 2048;

struct Params {
    const float *x, *c, *w_ada, *b_ada, *norm1_w, *w_in, *conv_w, *sinks, *i_bias, *f_bias, *mnorm_w, *w_a, *w_b, *w_out, *norm2_w, *w_q, *sub_keys, *peer_u, *peer_v, *normf_w;
    float* out; unsigned char* ws;
};

constexpr size_t MiB = 1u << 20;
constexpr size_t WS_MOD = 1 * MiB;
constexpr size_t WS_IPRE = 2 * MiB;
constexpr size_t WS_FPRE = 2 * MiB + 512 * 1024;
constexpr size_t WS_CHG = 3 * MiB;
constexpr size_t WS_NLOC = 4 * MiB;
constexpr size_t WS_NST = 4 * MiB + 512 * 1024;
constexpr size_t WS_ROPE = 5 * MiB;
constexpr size_t WS_WIN = 10 * MiB;
constexpr size_t WS_WA = 20 * MiB;
constexpr size_t WS_WB = 21 * MiB;
constexpr size_t WS_WOUT = 22 * MiB;
constexpr size_t WS_WQ = 24 * MiB;
constexpr size_t WS_SK = 28 * MiB;
constexpr size_t WS_ISU = 29 * MiB;
constexpr size_t WS_ISV = 29 * MiB + 65536;
constexpr size_t WS_TU = 32 * MiB;
constexpr size_t WS_TV = 48 * MiB;
constexpr size_t WS_UB = 96 * MiB;
constexpr size_t WS_PA = 160 * MiB;
constexpr size_t WS_PM = 208 * MiB;
constexpr size_t WS_PG = 336 * MiB;
constexpr size_t WS_CST = 464 * MiB;
constexpr size_t WS_END = 496 * MiB;

DEV unsigned f2bf(float f) { unsigned u = __float_as_uint(f); return (u + 0x7fffu + ((u >> 16) & 1u)) >> 16; }
DEV unsigned pk2(float lo, float hi) { return f2bf(lo) | (f2bf(hi) << 16); }
DEV float bflo(unsigned u) { return __uint_as_float(u << 16); }
DEV float bfhi(unsigned u) { return __uint_as_float(u & 0xffff0000u); }
DEV float bf2f(bf16_t h) { return __uint_as_float(((unsigned)h) << 16); }
DEV float wave_sum(float v) {
#pragma unroll
    for (int o = 32; o > 0; o >>= 1) v += __shfl_xor(v, o);
    return v;
}
DEV float wave_max(float v) {
#pragma unroll
    for (int o = 32; o > 0; o >>= 1) v = fmaxf(v, __shfl_xor(v, o));
    return v;
}
DEV float sigmoidf_(float v) { return 1.f / (1.f + __expf(-v)); }
DEV f32x4 mfma16(bf16x8 a, bf16x8 b, f32x4 c) { return __builtin_amdgcn_mfma_f32_16x16x32_bf16(a, b, c, 0, 0, 0); }
DEV void wave_lds_sync() { __builtin_amdgcn_fence(__ATOMIC_ACQ_REL, "wavefront"); __builtin_amdgcn_wave_barrier(); }

DEV void transpose_item(const float* W, int ldw, int k0, int nsrc0, bf16_t* WT, int ldt, int ndst0, float* scr, int lane) {
#pragma unroll 8
    for (int i = 0; i < 32; ++i) { const int kk = 2 * i + (lane >> 5); scr[kk * 33 + (lane & 31)] = W[(size_t)(k0 + kk) * ldw + nsrc0 + (lane & 31)]; }
    wave_lds_sync();
    const int c = lane & 7;
#pragma unroll
    for (int j = 0; j < 4; ++j) {
        const int n = (lane >> 3) + 8 * j; const float* s = scr + (8 * c) * 33 + n;
        u32x4 o; o.x = pk2(s[0 * 33], s[1 * 33]); o.y = pk2(s[2 * 33], s[3 * 33]); o.z = pk2(s[4 * 33], s[5 * 33]); o.w = pk2(s[6 * 33], s[7 * 33]);
        *(u32x4*)(WT + (size_t)(ndst0 + n) * ldt + k0 + 8 * c) = o;
    }
    wave_lds_sync();
}

DEV void stage_prep(const Params& p, char* lds, int vb, int nvb) {
    const int tid = threadIdx.x, lane = tid & 63, wave = __builtin_amdgcn_readfirstlane(tid >> 6);
    float* mod = (float*)(p.ws + WS_MOD);
    float* s_act = (float*)lds;
    float* s_red = (float*)(lds + 8192);
    for (int i = tid; i < 2048; i += NTH) { const float v = p.c[i]; s_act[i] = v / (1.f + expf(-v)); }
    __syncthreads();
    for (int item = vb; item < 192; item += nvb) {
        const int kg = tid >> 5, cl = tid & 31, col = item * 32 + cl;
        float s0 = 0.f, s1 = 0.f;
        for (int k = kg; k < 1024; k += 16) { const float w = p.w_ada[(size_t)k * 6144 + col]; s0 += s_act[k] * w; s1 += s_act[1024 + k] * w; }
        s_red[(kg * 32 + cl) * 2] = s0; s_red[(kg * 32 + cl) * 2 + 1] = s1;
        __syncthreads();
        if (tid < 64) { const int b = tid >> 5, c2 = tid & 31; float s = 0.f; for (int g = 0; g < 16; ++g) s += s_red[(g * 32 + c2) * 2 + b]; mod[b * 6144 + item * 32 + c2] = s + p.b_ada[item * 32 + c2]; }
        __syncthreads();
    }
    float* scr = (float*)(lds + 16384 + wave * 8448);
    const int gw = vb * NW + wave, ngw = nvb * NW;
    bf16_t* Wt_in = (bf16_t*)(p.ws + WS_WIN); bf16_t* Wt_a = (bf16_t*)(p.ws + WS_WA); bf16_t* Wt_b = (bf16_t*)(p.ws + WS_WB);
    bf16_t* Wt_out = (bf16_t*)(p.ws + WS_WOUT); bf16_t* Wt_q = (bf16_t*)(p.ws + WS_WQ);
    for (int it = gw; it < 4480; it += ngw) {
        int r = it;
        if (r < 2432) { const int kb = r / 152, nb = r % 152; transpose_item(p.w_in, 4872, kb * 64, nb * 32 + (nb >= 88 ? 8 : 0), Wt_in, 1024, nb * 32, scr, lane); continue; } r -= 2432;
        if (r < 256) { const int kb = r / 32, nb = r % 32; transpose_item(p.w_a, 1024, kb * 64, nb * 32, Wt_a, 512, nb * 32, scr, lane); continue; } r -= 256;
        if (r < 256) { const int kb = r / 32, nb = r % 32; transpose_item(p.w_b, 1024, kb * 64, nb * 32, Wt_b, 512, nb * 32, scr, lane); continue; } r -= 256;
        if (r < 512) { const int kb = r / 32, nb = r % 32; transpose_item(p.w_out, 1024, kb * 64, nb * 32, Wt_out, 1024, nb * 32, scr, lane); continue; } r -= 512;
        { const int kb = r / 64, nb = r % 64; transpose_item(p.w_q, 2048, kb * 64, nb * 32, Wt_q, 1024, nb * 32, scr, lane); }
    }
    const size_t gt = (size_t)vb * NTH + tid, ngt = (size_t)nvb * NTH;
    for (int row = gw; row < 32768; row += ngw) {
        const bool isv = row >= 16384; const int r = row & 16383;
        const float4* src = (const float4*)((isv ? p.peer_v : p.peer_u) + (size_t)r * D) + 4 * lane;
        float4 a[4]; float mx = 0.f;
#pragma unroll
        for (int i = 0; i < 4; ++i) { a[i] = src[i]; mx = fmaxf(mx, fmaxf(fmaxf(fabsf(a[i].x), fabsf(a[i].y)), fmaxf(fabsf(a[i].z), fabsf(a[i].w)))); }
        mx = wave_max(mx);
        int ex = 0; if (mx > 0.f) (void)frexpf(mx, &ex); else ex = 8;
        const float sc = ldexpf(1.f, 8 - ex), isc = ldexpf(1.f, ex - 8);
        u32x4 w;
#pragma unroll
        for (int i = 0; i < 4; ++i) { int pk = 0; pk = __builtin_amdgcn_cvt_pk_fp8_f32(a[i].x * sc, a[i].y * sc, pk, false); pk = __builtin_amdgcn_cvt_pk_fp8_f32(a[i].z * sc, a[i].w * sc, pk, true); w[i] = (unsigned)pk; }
        ((u32x4*)(p.ws + (isv ? WS_TV : WS_TU) + (size_t)r * 1024))[lane] = w;
        if (lane == 0) ((float*)(p.ws + (isv ? WS_ISV : WS_ISU)))[r] = isc;
    }
    for (size_t g = gt; g < 4096; g += ngt) {
        const float4 a = ((const float4*)p.sub_keys)[2 * g], b = ((const float4*)p.sub_keys)[2 * g + 1];
        u32x4 w; w.x = pk2(a.x, a.y); w.y = pk2(a.z, a.w); w.z = pk2(b.x, b.y); w.w = pk2(b.z, b.w);
        ((u32x4*)(p.ws + WS_SK))[g] = w;
    }
    float2* rope = (float2*)(p.ws + WS_ROPE);
    for (size_t e = gt; e < 16384 * 32; e += ngt) {
        const int pos = (int)(e >> 5), i = (int)(e & 31);
        const float inv = (float)exp2(-(double)i * (13.287712379549449 / 32.0));
        const float ang = (float)pos * inv;
        const double a = (double)ang; const double n = rint(a * 0.15915494309189535); const double r = a - n * 6.283185307179586;
        float s, c; sincosf((float)r, &s, &c);
        rope[e] = make_float2(c, s);
    }
}

DEV void stage_norm1(const Params& p, char* lds, int vb, int nvb) {
    const int tid = threadIdx.x, lane = tid & 63, wave = __builtin_amdgcn_readfirstlane(tid >> 6);
    float* wg = (float*)lds;
    for (int i = tid; i < 8192; i += NTH) { const int cc = i >> 10, k = i & 1023; wg[i] = p.w_in[(size_t)k * 4872 + 2816 + cc]; }
    __syncthreads();
    const float* mod = (const float*)(p.ws + WS_MOD);
    bf16_t* ub = (bf16_t*)(p.ws + WS_UB);
    float* ipre = (float*)(p.ws + WS_IPRE); float* fpre = (float*)(p.ws + WS_FPRE);
    for (int m = vb * NW + wave; m < M; m += nvb * NW) {
        const int b = m >= SEQ ? 1 : 0;
        const float4* xr = (const float4*)(p.x + (size_t)m * D);
        float4 v[4]; float ss = 0.f;
#pragma unroll
        for (int j = 0; j < 4; ++j) { v[j] = xr[lane + 64 * j]; ss += v[j].x * v[j].x + v[j].y * v[j].y + v[j].z * v[j].z + v[j].w * v[j].w; }
        ss = wave_sum(ss);
        const float rstd = rsqrtf(ss * (1.f / 1024.f) + 1e-6f);
        float ga[8];
#pragma unroll
        for (int cc = 0; cc < 8; ++cc) ga[cc] = 0.f;
#pragma unroll
        for (int j = 0; j < 4; ++j) {
            const int col = 4 * (lane + 64 * j);
            const float4 w1 = *(const float4*)(p.norm1_w + col), sc = *(const float4*)(mod + b * 6144 + 1024 + col), sh = *(const float4*)(mod + b * 6144 + col);
            float4 u;
            u.x = v[j].x * rstd * w1.x * (1.f + sc.x) + sh.x; u.y = v[j].y * rstd * w1.y * (1.f + sc.y) + sh.y;
            u.z = v[j].z * rstd * w1.z * (1.f + sc.z) + sh.z; u.w = v[j].w * rstd * w1.w * (1.f + sc.w) + sh.w;
            u32x2 o; o.x = pk2(u.x, u.y); o.y = pk2(u.z, u.w);
            *(u32x2*)(ub + (size_t)m * D + col) = o;
#pragma unroll
            for (int cc = 0; cc < 8; ++cc) { const float4 g = *(const float4*)(wg + cc * 1024 + col); ga[cc] += u.x * g.x + u.y * g.y + u.z * g.z + u.w * g.w; }
        }
#pragma unroll
        for (int cc = 0; cc < 8; ++cc) ga[cc] = wave_sum(ga[cc]);
        if (lane == 0) {
#pragma unroll
            for (int h = 0; h < 4; ++h) { ipre[(size_t)m * 4 + h] = ga[h] + p.i_bias[h]; fpre[(size_t)m * 4 + h] = ga[4 + h] + p.f_bias[h]; }
        }
    }
}

namespace pg8 {
#define PG8_LAS __attribute__((address_space(3)))
typedef unsigned short bf16_t;
typedef short bf16x8 __attribute__((ext_vector_type(8)));
typedef float f32x4 __attribute__((ext_vector_type(4)));
typedef unsigned u32x4 __attribute__((ext_vector_type(4)));
constexpr int BM = 256, BK = 64, HALF = 128, HTB = HALF * BK * 2  , STAGE_BYTES = 8 * HTB, NXCD = 8, WGM = 8;

__host__ __device__ __forceinline__ int lds_byte(int r, int c) { const int st = (r >> 4) * 2 + (c >> 5), rr = r & 15, cc = c & 31, ob = rr * 64 + cc * 2; return st * 1024 + (ob ^ (((ob >> 9) & 1) << 5)); }
__host__ __device__ __forceinline__ void stage_rc(int b, int& R, int& C) { const int st = b / 1024, sb = b % 1024, swz = sb ^ (((sb >> 9) & 1) << 5); R = (st >> 1) * 16 + swz / 64; C = (st & 1) * 32 + (swz % 64) / 2; }
__host__ __device__ __forceinline__ int perm32(int rho) { const int n = rho >> 4, i = rho & 15; return 8 * (i >> 2) + 4 * n + (i & 3); }

struct Unit { int pm, pn; };
struct Gemm { const bf16_t* A; const bf16_t* Bt; int M, N, K, lda, ldb; };

struct StaticOrder {
    int nM, nN, nwg, G, c;
    __host__ __device__ void init(int M, int N, int G_, int c_) { nM = M / BM; nN = N / BM; nwg = nM * nN; G = G_; c = c_; }
    __host__ __device__ bool next(int i, Unit& u) const {
        const long L = (long)i * G + c; if (L >= nwg) return false;
        int wgid = (int)L; { const int q = nwg / NXCD, r = nwg % NXCD, xcd = wgid % NXCD, off = wgid / NXCD; wgid = (xcd < r ? xcd * (q + 1) : r * (q + 1) + (xcd - r) * q) + off; }
        const int nig = WGM * nN, gid = wgid / nig, fm = gid * WGM, gsz = (nM - fm) < WGM ? (nM - fm) : WGM;
        u.pm = fm + ((wgid % nig) % gsz); u.pn = (wgid % nig) / gsz; return true;
    }
    __device__ __forceinline__ void a_ready(const Unit&) const {}
    __device__ __forceinline__ void done(const Unit&) const {}
};

__device__ __forceinline__ unsigned cvt_pk_bf16(float lo, float hi) { unsigned r; asm volatile("v_cvt_pk_bf16_f32 %0, %1, %2" : "=v"(r) : "v"(lo), "v"(hi)); return r; }
__device__ __forceinline__ float sg_(float v) { return 1.f / (1.f + __expf(-v)); }
struct EpiIn {
    static constexpr bool PERM = true, AFTER_DRAIN = false;
    bf16_t *PA, *PM, *PG;
    __device__ __forceinline__ void operator()(const f32x4 (&acc)[2][2][4][2], const Unit& u, int wr, int wc, int fr, int fq) const {
        const int colt = u.pn * BM; bf16_t* base; int ldc, cb;
        if (colt < 768) { base = PA; ldc = 768; cb = colt; } else if (colt < 2816) { base = PM; ldc = 2048; cb = colt - 768; } else { base = PG; ldc = 2048; cb = colt - 2816; }
        const int row0 = u.pm * BM + wr * 64 + fr, col0 = cb + wc * 32 + 8 * fq;
#pragma unroll
        for (int ai = 0; ai < 2; ++ai)
#pragma unroll
            for (int m = 0; m < 4; ++m) { bf16_t* rowp = base + (size_t)(row0 + ai * HALF + m * 16) * ldc + col0;
#pragma unroll
                for (int bj = 0; bj < 2; ++bj) { const f32x4 v0 = acc[ai][bj][m][0], v1 = acc[ai][bj][m][1];
                    u32x4 w; w.x = cvt_pk_bf16(v0[0], v0[1]); w.y = cvt_pk_bf16(v0[2], v0[3]); w.z = cvt_pk_bf16(v1[0], v1[1]); w.w = cvt_pk_bf16(v1[2], v1[3]);
                    *(u32x4*)(rowp + bj * HALF) = w; } }
    }
};
struct EpiMerge {
    static constexpr bool PERM = true, AFTER_DRAIN = false;
    const bf16_t* G; bf16_t* MG; int second;
    __device__ __forceinline__ void operator()(const f32x4 (&acc)[2][2][4][2], const Unit& u, int wr, int wc, int fr, int fq) const {
        const int row0 = u.pm * BM + wr * 64 + fr, col0 = u.pn * BM + wc * 32 + 8 * fq;
#pragma unroll
        for (int ai = 0; ai < 2; ++ai)
#pragma unroll
            for (int m = 0; m < 4; ++m) { const size_t row = (size_t)(row0 + ai * HALF + m * 16);
#pragma unroll
                for (int bj = 0; bj < 2; ++bj) { const f32x4 v0 = acc[ai][bj][m][0], v1 = acc[ai][bj][m][1]; const int col = col0 + bj * HALF;
                    const u32x4 gv = *(const u32x4*)(G + row * 2048 + col);
                    float r[8];
                    r[0] = sg_(__uint_as_float(gv.x << 16)) * v0[0]; r[1] = sg_(__uint_as_float(gv.x & 0xffff0000u)) * v0[1];
                    r[2] = sg_(__uint_as_float(gv.y << 16)) * v0[2]; r[3] = sg_(__uint_as_float(gv.y & 0xffff0000u)) * v0[3];
                    r[4] = sg_(__uint_as_float(gv.z << 16)) * v1[0]; r[5] = sg_(__uint_as_float(gv.z & 0xffff0000u)) * v1[1];
                    r[6] = sg_(__uint_as_float(gv.w << 16)) * v1[2]; r[7] = sg_(__uint_as_float(gv.w & 0xffff0000u)) * v1[3];
                    u32x4* dst = (u32x4*)(MG + row * 1024 + col);
                    if (second) { const u32x4 t = *dst;
                        r[0] += __uint_as_float(t.x << 16); r[1] += __uint_as_float(t.x & 0xffff0000u); r[2] += __uint_as_float(t.y << 16); r[3] += __uint_as_float(t.y & 0xffff0000u);
                        r[4] += __uint_as_float(t.z << 16); r[5] += __uint_as_float(t.z & 0xffff0000u); r[6] += __uint_as_float(t.w << 16); r[7] += __uint_as_float(t.w & 0xffff0000u); }
                    u32x4 w; w.x = cvt_pk_bf16(r[0], r[1]); w.y = cvt_pk_bf16(r[2], r[3]); w.z = cvt_pk_bf16(r[4], r[5]); w.w = cvt_pk_bf16(r[6], r[7]);
                    *dst = w; } }
    }
};
struct EpiOut {
    static constexpr bool PERM = true, AFTER_DRAIN = false;
    const float* x; const float* g1; float* out; int seq;
    __device__ __forceinline__ void operator()(const f32x4 (&acc)[2][2][4][2], const Unit& u, int wr, int wc, int fr, int fq) const {
        const int row0 = u.pm * BM + wr * 64 + fr, col0 = u.pn * BM + wc * 32 + 8 * fq;
        const float* gp = g1 + (u.pm * BM >= seq ? 6144 : 0);
#pragma unroll
        for (int bj = 0; bj < 2; ++bj) { const int col = col0 + bj * HALF; const f32x4 ga = *(const f32x4*)(gp + col), gb = *(const f32x4*)(gp + col + 4);
#pragma unroll
            for (int ai = 0; ai < 2; ++ai)
#pragma unroll
                for (int m = 0; m < 4; ++m) { const size_t off = (size_t)(row0 + ai * HALF + m * 16) * 1024 + col;
                    const f32x4 xa = *(const f32x4*)(x + off), xb = *(const f32x4*)(x + off + 4);
                    *(f32x4*)(out + off) = xa + ga * acc[ai][bj][m][0]; *(f32x4*)(out + off + 4) = xb + gb * acc[ai][bj][m][1]; } }
    }
};

template <class Epi, class Sched, bool ALIGN_EPI = false, bool SP2 = false>
__device__ __forceinline__ void gemm_phase(PG8_LAS unsigned char* lds, const Gemm g, const Sched& S, const Epi& E) {
    const int tid = threadIdx.x, wid = __builtin_amdgcn_readfirstlane(tid >> 6), lane = tid & 63, wr = wid >> 2, wc = wid & 3, fr = lane & 15, fq = lane >> 4;
    const int K = g.K, nt = K / BK;
    unsigned voffA[2], voffB[2];
#pragma unroll
    for (int i = 0; i < 2; ++i) { int R, C; stage_rc(tid * 16 + i * 8192, R, C); const int Rb = Epi::PERM ? ((R & ~31) + perm32(R & 31)) : R;
        voffA[i] = (unsigned)(R * g.lda + C) * 2u; voffB[i] = (unsigned)(Rb * g.ldb + C) * 2u; }
    const size_t kstep = (size_t)(BK * 2);
    const size_t hstepA = (size_t)HALF * g.lda * 2, hstepB = (size_t)HALF * g.ldb * 2;
    const size_t tstepA = 2 * hstepA, tstepB = 2 * hstepB;
    const unsigned ldsw = (unsigned)wid * 1024u;
    const int aoff = lds_byte(wr * 64 + fr, fq * 8), boff = lds_byte(wc * 32 + fr, fq * 8);
#define PG8_SA(b, h) (((b) * 2 + (h)) * HTB)
#define PG8_SB(b, h) ((4 + (b) * 2 + (h)) * HTB)
#define PG8_STAGE(bufoff, gbase, voff) do { _Pragma("unroll") for (int _i = 0; _i < 2; ++_i) \
        __builtin_amdgcn_global_load_lds((const unsigned*)((const char*)(gbase) + (voff)[_i]), (PG8_LAS unsigned*)(lds + (bufoff) + ldsw + _i * 8192), 16, 0, 0); } while (0)
#define PG8_LDA(dst, b, h) do { _Pragma("unroll") for (int m = 0; m < 4; ++m) _Pragma("unroll") for (int k = 0; k < 2; ++k) dst[m][k] = *(const PG8_LAS bf16x8*)(lds + PG8_SA(b, h) + aoff + m * 2048 + k * 1024); } while (0)
#define PG8_LDB(dst, b, h) do { _Pragma("unroll") for (int n = 0; n < 2; ++n) _Pragma("unroll") for (int k = 0; k < 2; ++k) dst[n][k] = *(const PG8_LAS bf16x8*)(lds + PG8_SB(b, h) + boff + n * 2048 + k * 1024); } while (0)
#define PG8_MMA(ai, bj, At, Bt) do { __builtin_amdgcn_s_setprio(1); _Pragma("unroll") for (int m = 0; m < 4; ++m) _Pragma("unroll") for (int n = 0; n < 2; ++n) _Pragma("unroll") for (int k = 0; k < 2; ++k) \
        acc[ai][bj][m][n] = __builtin_amdgcn_mfma_f32_16x16x32_bf16(Bt[n][k], At[m][k], acc[ai][bj][m][n], 0, 0, 0); __builtin_amdgcn_s_setprio(0); } while (0)
#define PG8_WAIT_V(n) asm volatile("s_waitcnt vmcnt(" #n ")" ::: "memory")
#define PG8_WAIT_L(n) asm volatile("s_waitcnt lgkmcnt(" #n ")" ::: "memory")
#define PG8_BAR __builtin_amdgcn_s_barrier()
#define PG8_SCHED __builtin_amdgcn_sched_barrier(0)
    Unit cur, nxt; int ui = 0;
    if (!S.next(0, cur)) return;
    f32x4 acc[2][2][4][2];
#pragma unroll
    for (int a = 0; a < 2; ++a)
#pragma unroll
        for (int b = 0; b < 2; ++b)
#pragma unroll
            for (int m = 0; m < 4; ++m)
#pragma unroll
                for (int n = 0; n < 2; ++n) acc[a][b][m][n] = (f32x4){0.f, 0.f, 0.f, 0.f};
    bf16x8 At[4][2], B0[2][2], B1[2][2];
    const char* cA = (const char*)g.A + (size_t)cur.pm * tstepA; const char* cB = (const char*)g.Bt + (size_t)cur.pn * tstepB;
    S.a_ready(cur);
    if constexpr (SP2) {
        PG8_STAGE(PG8_SB(0, 0), cB, voffB); PG8_STAGE(PG8_SB(0, 1), cB + hstepB, voffB); PG8_STAGE(PG8_SA(0, 0), cA, voffA); PG8_STAGE(PG8_SA(0, 1), cA + hstepA, voffA);
        if (wr == 1) PG8_BAR;
        PG8_WAIT_V(2); PG8_BAR;
        PG8_STAGE(PG8_SB(1, 0), cB + kstep, voffB); PG8_STAGE(PG8_SA(1, 0), cA + kstep, voffA); PG8_STAGE(PG8_SB(1, 1), cB + hstepB + kstep, voffB);
        PG8_WAIT_V(6); PG8_BAR;
    } else {
        PG8_STAGE(PG8_SB(0, 0), cB, voffB); PG8_STAGE(PG8_SA(0, 0), cA, voffA); PG8_STAGE(PG8_SB(0, 1), cB + hstepB, voffB); PG8_STAGE(PG8_SA(0, 1), cA + hstepA, voffA);
        if (wr == 1) PG8_BAR;
        PG8_WAIT_V(4); PG8_BAR;
        PG8_STAGE(PG8_SB(1, 0), cB + kstep, voffB); PG8_STAGE(PG8_SA(1, 0), cA + kstep, voffA); PG8_STAGE(PG8_SB(1, 1), cB + hstepB + kstep, voffB);
        PG8_WAIT_V(6); PG8_BAR;
    }
    for (;;) {
        const bool has_next = S.next(ui + 1, nxt);
        const char* nA = has_next ? (const char*)g.A + (size_t)nxt.pm * tstepA : cA; const char* nB = has_next ? (const char*)g.Bt + (size_t)nxt.pn * tstepB : cB;
        for (int t = 0; t < nt; t += 2) {
            const bool last = (t == nt - 2);
            const char* a1 = cA + (size_t)(t + 1) * kstep;
            const char* a2 = last ? nA : cA + (size_t)(t + 2) * kstep; const char* b2 = last ? nB : cB + (size_t)(t + 2) * kstep;
            const char* a3 = a2 + kstep; const char* b3 = b2 + kstep;
            if (last && has_next) S.a_ready(nxt);
            if constexpr (SP2) {
            PG8_LDB(B0, 0, 0); PG8_LDB(B1, 0, 1); PG8_SCHED; PG8_LDA(At, 0, 0); PG8_STAGE(PG8_SA(1, 1), a1 + hstepA, voffA);
            PG8_WAIT_V(8); PG8_WAIT_L(0); PG8_BAR; PG8_MMA(0, 0, At, B0); PG8_MMA(0, 1, At, B1); PG8_BAR; PG8_SCHED;
            PG8_LDA(At, 0, 1); PG8_STAGE(PG8_SB(0, 0), b2, voffB); PG8_STAGE(PG8_SB(0, 1), b2 + hstepB, voffB); PG8_STAGE(PG8_SA(0, 0), a2, voffA);
            PG8_WAIT_V(8); PG8_WAIT_L(0); PG8_BAR; PG8_MMA(1, 0, At, B0); PG8_MMA(1, 1, At, B1); PG8_BAR; PG8_SCHED;
            PG8_LDB(B0, 1, 0); PG8_LDB(B1, 1, 1); PG8_SCHED; PG8_LDA(At, 1, 0); PG8_STAGE(PG8_SA(0, 1), a2 + hstepA, voffA);
            PG8_WAIT_V(8); PG8_WAIT_L(0); PG8_BAR; PG8_MMA(0, 0, At, B0); PG8_MMA(0, 1, At, B1); PG8_BAR; PG8_SCHED;
            PG8_LDA(At, 1, 1); PG8_STAGE(PG8_SB(1, 0), b3, voffB); PG8_STAGE(PG8_SB(1, 1), b3 + hstepB, voffB); PG8_STAGE(PG8_SA(1, 0), a3, voffA);
            PG8_WAIT_V(8); PG8_WAIT_L(0); PG8_BAR; PG8_MMA(1, 0, At, B0); PG8_MMA(1, 1, At, B1); PG8_BAR; PG8_SCHED;
            } else {
            PG8_LDB(B0, 0, 0); PG8_SCHED; PG8_LDA(At, 0, 0); PG8_STAGE(PG8_SA(1, 1), a1 + hstepA, voffA);
            PG8_WAIT_L(8); PG8_BAR; PG8_WAIT_L(0); PG8_MMA(0, 0, At, B0); PG8_BAR; PG8_SCHED;
            PG8_LDB(B1, 0, 1); PG8_STAGE(PG8_SB(0, 0), b2, voffB);
            PG8_BAR; PG8_WAIT_L(0); PG8_MMA(0, 1, At, B1); PG8_BAR;
            PG8_LDA(At, 0, 1); PG8_STAGE(PG8_SA(0, 0), a2, voffA);
            PG8_BAR; PG8_WAIT_L(0); PG8_MMA(1, 0, At, B0); PG8_BAR; PG8_SCHED;
            PG8_STAGE(PG8_SB(0, 1), b2 + hstepB, voffB);
            PG8_WAIT_V(6); PG8_BAR; PG8_MMA(1, 1, At, B1); PG8_BAR;
            PG8_LDB(B0, 1, 0); PG8_SCHED; PG8_LDA(At, 1, 0); PG8_STAGE(PG8_SA(0, 1), a2 + hstepA, voffA);
            PG8_WAIT_L(8); PG8_BAR; PG8_WAIT_L(0); PG8_MMA(0, 0, At, B0); PG8_BAR; PG8_SCHED;
            PG8_LDB(B1, 1, 1); PG8_STAGE(PG8_SB(1, 0), b3, voffB);
            PG8_BAR; PG8_WAIT_L(0); PG8_MMA(0, 1, At, B1); PG8_BAR;
            PG8_LDA(At, 1, 1); PG8_STAGE(PG8_SA(1, 0), a3, voffA);
            PG8_BAR; PG8_WAIT_L(0); PG8_MMA(1, 0, At, B0); PG8_BAR; PG8_SCHED;
            PG8_STAGE(PG8_SB(1, 1), b3 + hstepB, voffB);
            PG8_WAIT_V(6); PG8_BAR; PG8_MMA(1, 1, At, B1); PG8_BAR;
            }
        }
        if constexpr (ALIGN_EPI) { if (wr == 0) PG8_BAR; }
        if constexpr (!Epi::AFTER_DRAIN) { E(acc, cur, wr, wc, fr, fq); S.done(cur); }
        if (!has_next) break;
#pragma unroll
        for (int a = 0; a < 2; ++a)
#pragma unroll
            for (int b = 0; b < 2; ++b)
#pragma unroll
                for (int m = 0; m < 4; ++m)
#pragma unroll
                    for (int n = 0; n < 2; ++n) acc[a][b][m][n] = (f32x4){0.f, 0.f, 0.f, 0.f};
        cur = nxt; cA = nA; cB = nB; ++ui;
        if constexpr (ALIGN_EPI) { if (wr == 1) PG8_BAR; }
    }
    PG8_WAIT_V(0);
    if constexpr (!ALIGN_EPI) { if (wr == 0) PG8_BAR; }
    PG8_BAR;
    if constexpr (Epi::AFTER_DRAIN) { E.fused(acc, cur, wr, wc, fr, fq, lds, wid, lane); S.done(cur); }
#undef PG8_SA
#undef PG8_SB
#undef PG8_STAGE
#undef PG8_LDA
#undef PG8_LDB
#undef PG8_MMA
#undef PG8_WAIT_V
#undef PG8_WAIT_L
#undef PG8_BAR
#undef PG8_SCHED
}
}

struct GemmOp { const bf16_t* A; int lda; const bf16_t* Bt; int ldb; int K; };

DEV void gemm_tile(f32x4 (&acc)[4][2], const GemmOp& g, int m0, int n0, char* lds) {
    const int tid = threadIdx.x, lane = tid & 63, wid = __builtin_amdgcn_readfirstlane(tid >> 6), wm = wid >> 2, wn = wid & 3, fr = lane & 15, fq = lane >> 4;
    const int sr = tid >> 3, sc = tid & 7;
    const bf16_t* ga = g.A + (size_t)(m0 + sr) * g.lda + sc * 8;
    const bf16_t* gb = g.Bt + (size_t)(n0 + sr) * g.ldb + sc * 8;
    const size_t a64 = (size_t)64 * g.lda, b64 = (size_t)64 * g.ldb;
    const int so = sr * 128 + ((sc ^ (sr & 7)) << 4);
    const int nk = g.K >> 6;
    u32x4 ra0 = *(const u32x4*)ga, ra1 = *(const u32x4*)(ga + a64), rb0 = *(const u32x4*)gb, rb1 = *(const u32x4*)(gb + b64);
    *(u32x4*)(lds + so) = ra0; *(u32x4*)(lds + so + 8192) = ra1; *(u32x4*)(lds + 32768 + so) = rb0; *(u32x4*)(lds + 32768 + so + 8192) = rb1;
    __syncthreads();
    const int aoff = (wm * 64 + fr) * 128, boff = 32768 + (wn * 32 + fr) * 128, sw = fr & 7;
    for (int kt = 0; kt < nk; ++kt) {
        const int cur = (kt & 1) * 16384;
        if (kt + 1 < nk) { ga += 64; gb += 64; ra0 = *(const u32x4*)ga; ra1 = *(const u32x4*)(ga + a64); rb0 = *(const u32x4*)gb; rb1 = *(const u32x4*)(gb + b64); }
#pragma unroll
        for (int ks = 0; ks < 2; ++ks) {
            const int ch = ((fq + 4 * ks) ^ sw) << 4;
            bf16x8 af[4], bfr[2];
#pragma unroll
            for (int mi = 0; mi < 4; ++mi) af[mi] = *(const bf16x8*)(lds + cur + aoff + mi * 2048 + ch);
#pragma unroll
            for (int ni = 0; ni < 2; ++ni) bfr[ni] = *(const bf16x8*)(lds + cur + boff + ni * 2048 + ch);
#pragma unroll
            for (int mi = 0; mi < 4; ++mi)
#pragma unroll
                for (int ni = 0; ni < 2; ++ni) acc[mi][ni] = mfma16(bfr[ni], af[mi], acc[mi][ni]);
        }
        if (kt + 1 < nk) {
            const int nxt = cur ^ 16384;
            *(u32x4*)(lds + nxt + so) = ra0; *(u32x4*)(lds + nxt + so + 8192) = ra1; *(u32x4*)(lds + 32768 + nxt + so) = rb0; *(u32x4*)(lds + 32768 + nxt + so + 8192) = rb1;
        }
        __syncthreads();
    }
}
#define GEMM_EPI_LOOP(...) { const int tid_ = threadIdx.x, lane_ = tid_ & 63, wid_ = tid_ >> 6, wm_ = wid_ >> 2, wn_ = wid_ & 3, fr_ = lane_ & 15, fq_ = lane_ >> 4; \
    _Pragma("unroll") for (int mi = 0; mi < 4; ++mi) _Pragma("unroll") for (int ni = 0; ni < 2; ++ni) { const int m = m0 + wm_ * 64 + mi * 16 + fr_, n = n0 + wn_ * 32 + ni * 16 + fq_ * 4; __VA_ARGS__ } }

DEV void stage_gemm_in(const Params& p, char* lds, int vb, int nvb) {
    pg8::Gemm g{(const bf16_t*)(p.ws + WS_UB), (const bf16_t*)(p.ws + WS_WIN), M, 4864, 1024, 1024, 1024};
    pg8::StaticOrder S; S.init(M, 4864, nvb, vb);
    pg8::EpiIn E{(bf16_t*)(p.ws + WS_PA), (bf16_t*)(p.ws + WS_PM), (bf16_t*)(p.ws + WS_PG)};
    pg8::gemm_phase<pg8::EpiIn, pg8::StaticOrder, true, true>((PG8_LAS unsigned char*)lds, g, S, E);
}
DEV void stage_gemm_merge(const Params& p, char* lds, int vb, int nvb) {
    const bf16_t* PG = (const bf16_t*)(p.ws + WS_PG); bf16_t* MG = (bf16_t*)(p.ws + WS_UB);
    {
        pg8::Gemm g{(const bf16_t*)(p.ws + WS_PA), (const bf16_t*)(p.ws + WS_WA), M, 1024, 512, LPA, 512};
        pg8::StaticOrder S; S.init(M, 1024, nvb, vb);
        pg8::EpiMerge E{PG, MG, 0};
        pg8::gemm_phase<pg8::EpiMerge, pg8::StaticOrder, true, true>((PG8_LAS unsigned char*)lds, g, S, E);
    }
    {
        pg8::Gemm g{(const bf16_t*)(p.ws + WS_PM) + 1536, (const bf16_t*)(p.ws + WS_WB), M, 1024, 512, LPM, 512};
        pg8::StaticOrder S; S.init(M, 1024, nvb, vb);
        pg8::EpiMerge E{PG + 1024, MG, 1};
        pg8::gemm_phase<pg8::EpiMerge, pg8::StaticOrder, true, true>((PG8_LAS unsigned char*)lds, g, S, E);
    }
}
DEV void stage_gemm_out(const Params& p, char* lds, int vb, int nvb) {
    pg8::Gemm g{(const bf16_t*)(p.ws + WS_UB), (const bf16_t*)(p.ws + WS_WOUT), M, 1024, 1024, 1024, 1024};
    pg8::StaticOrder S; S.init(M, 1024, nvb, vb);
    pg8::EpiOut E{p.x, (const float*)(p.ws + WS_MOD) + 2048, p.out, SEQ};
    pg8::gemm_phase<pg8::EpiOut, pg8::StaticOrder, true, true>((PG8_LAS unsigned char*)lds, g, S, E);
}

DEV void rope8(u32x4 x1, u32x4 x2, const float4* rp, float scale, u32x4& o1, u32x4& o2) {
#pragma unroll
    for (int w = 0; w < 4; ++w) {
        const float4 cs = rp[w];
        const float a0 = bflo(x1[w]), a1 = bfhi(x1[w]), b0 = bflo(x2[w]), b1 = bfhi(x2[w]);
        o1[w] = pk2((a0 * cs.x - b0 * cs.y) * scale, (a1 * cs.z - b1 * cs.w) * scale);
        o2[w] = pk2((b0 * cs.x + a0 * cs.y) * scale, (b1 * cs.z + a1 * cs.w) * scale);
    }
}

DEV void stage_attn(const Params& p, char* lds, int vb, int nvb) {
    const int tid = threadIdx.x, lane = tid & 63, wave = __builtin_amdgcn_readfirstlane(tid >> 6), fr = lane & 15, fq = lane >> 4;
    char* Ks = lds;
    char* VT = lds + 32768;
    char* Qs = lds + 70656;
    char* Ps = lds + 87040;
    bf16_t* PA = (bf16_t*)(p.ws + WS_PA);
    const float2* rope = (const float2*)(p.ws + WS_ROPE);
    for (int unit = vb; unit < 512; unit += nvb) {
        const int kvh = unit & 1, n = (unit >> 1) & 127, b = unit >> 8;
        __syncthreads();
        for (int task = tid; task < 1024; task += NTH) {
            const int ki = task >> 2, cp = task & 3, pos = 128 * (n - 1) + ki;
            u32x4 o1 = {0u, 0u, 0u, 0u}, o2 = {0u, 0u, 0u, 0u};
            if (pos >= 0) {
                const bf16_t* src = PA + (size_t)(b * SEQ + pos) * LPA + 512 + kvh * 64 + cp * 8;
                const u32x4 x1 = *(const u32x4*)src, x2 = *(const u32x4*)(src + 32);
                rope8(x1, x2, (const float4*)(rope + (size_t)pos * 32 + cp * 8), 1.0f, o1, o2);
            }
            const int sw = ki & 7;
            *(u32x4*)(Ks + ki * 128 + ((cp ^ sw) << 4)) = o1;
            *(u32x4*)(Ks + ki * 128 + (((cp + 4) ^ sw) << 4)) = o2;
        }
        for (int task = tid; task < 2048; task += NTH) {
            const int ki = task >> 3, c = task & 7, pos = 128 * (n - 1) + ki;
            u32x4 x = {0u, 0u, 0u, 0u};
            if (pos >= 0) x = *(const u32x4*)(PA + (size_t)(b * SEQ + pos) * LPA + 640 + kvh * 64 + c * 8);
#pragma unroll
            for (int e = 0; e < 8; ++e) *(bf16_t*)(VT + (c * 8 + e) * 592 + ki * 2) = (bf16_t)((e & 1) ? (x[e >> 1] >> 16) : (x[e >> 1] & 0xffffu));
        }
        for (int i = tid; i < 64 * 40; i += NTH) { const int d = i / 40, kk = 256 + i % 40; *(bf16_t*)(VT + d * 592 + kk * 2) = 0; }
        for (int i = tid; i < 2048; i += NTH) { const int w = i >> 8, r = (i >> 4) & 15, kk = 144 + (i & 15); *(bf16_t*)(Ps + w * 5376 + r * 336 + kk * 2) = 0; }
        for (int j = 0; j < 4; ++j) {
            const int hq = kvh * 4 + j;
            {
                const int qi = tid >> 2, cp = tid & 3, pos = 128 * n + qi;
                const bf16_t* src = PA + (size_t)(b * SEQ + pos) * LPA + hq * 64 + cp * 8;
                const u32x4 x1 = *(const u32x4*)src, x2 = *(const u32x4*)(src + 32);
                u32x4 o1, o2;
                rope8(x1, x2, (const float4*)(rope + (size_t)pos * 32 + cp * 8), 0.125f, o1, o2);
                const int sw = qi & 7;
                *(u32x4*)(Qs + qi * 128 + ((cp ^ sw) << 4)) = o1;
                *(u32x4*)(Qs + qi * 128 + (((cp + 4) ^ sw) << 4)) = o2;
            }
            __syncthreads();
            f32x4 s[9];
            const int sw = fr & 7;
            bf16x8 qf[2];
#pragma unroll
            for (int ks = 0; ks < 2; ++ks) qf[ks] = *(const bf16x8*)(Qs + (16 * wave + fr) * 128 + (((fq + 4 * ks) ^ sw) << 4));
#pragma unroll
            for (int t = 0; t < 9; ++t) {
                s[t] = (f32x4){0.f, 0.f, 0.f, 0.f};
#pragma unroll
                for (int ks = 0; ks < 2; ++ks) { const bf16x8 kf = *(const bf16x8*)(Ks + (16 * (wave + t) + fr) * 128 + (((fq + 4 * ks) ^ sw) << 4)); s[t] = mfma16(kf, qf[ks], s[t]); }
            }
            const float sink = p.sinks[hq];
            float mx = sink;
#pragma unroll
            for (int t = 0; t < 9; ++t)
#pragma unroll
                for (int r = 0; r < 4; ++r) {
                    const int dd = 16 * t + 4 * fq + r - fr, ki = 16 * (wave + t) + 4 * fq + r;
                    const bool ok = (dd >= 1) && (dd <= 128) && (n > 0 || ki >= 128);
                    const float v = ok ? s[t][r] : -INFINITY;
                    s[t][r] = v; mx = fmaxf(mx, v);
                }
            mx = fmaxf(mx, __shfl_xor(mx, 16)); mx = fmaxf(mx, __shfl_xor(mx, 32));
            float sum = 0.f;
#pragma unroll
            for (int t = 0; t < 9; ++t)
#pragma unroll
                for (int r = 0; r < 4; ++r) { const float pv = __expf(s[t][r] - mx); s[t][r] = pv; sum += pv; }
            sum += __shfl_xor(sum, 16); sum += __shfl_xor(sum, 32);
            const float inv = 1.f / (sum + __expf(sink - mx));
            char* Pw = Ps + wave * 5376 + fr * 336;
#pragma unroll
            for (int t = 0; t < 9; ++t) { u32x2 o; o.x = pk2(s[t][0], s[t][1]); o.y = pk2(s[t][2], s[t][3]); *(u32x2*)(Pw + (16 * t + 4 * fq) * 2) = o; }
            __syncthreads();
            f32x4 o[4];
#pragma unroll
            for (int di = 0; di < 4; ++di) o[di] = (f32x4){0.f, 0.f, 0.f, 0.f};
#pragma unroll
            for (int ks = 0; ks < 5; ++ks) {
                const bf16x8 pf = *(const bf16x8*)(Pw + (32 * ks + 8 * fq) * 2);
#pragma unroll
                for (int di = 0; di < 4; ++di) { const bf16x8 vf = *(const bf16x8*)(VT + (16 * di + fr) * 592 + (16 * wave + 32 * ks + 8 * fq) * 2); o[di] = mfma16(vf, pf, o[di]); }
            }
            bf16_t* dst = PA + (size_t)(b * SEQ + 128 * n + 16 * wave + fr) * LPA + hq * 64 + 4 * fq;
#pragma unroll
            for (int di = 0; di < 4; ++di) { u32x2 w; w.x = pk2(o[di][0] * inv, o[di][1] * inv); w.y = pk2(o[di][2] * inv, o[di][3] * inv); *(u32x2*)(dst + 16 * di) = w; }
            __syncthreads();
        }
    }
}

DEV float logsigf(float x) { return fminf(x, 0.f) - log1pf(expf(-fabsf(x))); }

DEV void chunk_gates(const float* ipre, const float* fpre, int rowbase, int h, float* gs, int lane) {
    const int l0 = 2 * lane;
    const float i0 = ipre[(size_t)(rowbase + l0) * 4 + h], i1 = ipre[(size_t)(rowbase + l0 + 1) * 4 + h];
    const float lf0 = logsigf(fpre[(size_t)(rowbase + l0) * 4 + h]), lf1 = logsigf(fpre[(size_t)(rowbase + l0 + 1) * 4 + h]);
    const float pair = lf0 + lf1;
    float sc = pair;
#pragma unroll
    for (int o = 1; o < 64; o <<= 1) { const float t = __shfl_up(sc, o); if (lane >= o) sc += t; }
    const float b0 = (sc - pair) + lf0, b1 = b0 + lf1;
    const float g = __shfl(sc, 63);
    const float a0 = g - b0 + i0, a1 = g - b1 + i1;
    const float mloc = wave_max(fmaxf(a0, a1));
    const float ib0 = i0 - b0, ib1 = i1 - b1;
    float scm = fmaxf(ib0, ib1);
#pragma unroll
    for (int o = 1; o < 64; o <<= 1) { const float t = __shfl_up(scm, o); if (lane >= o) scm = fmaxf(scm, t); }
    float ex = __shfl_up(scm, 1); if (lane == 0) ex = -INFINITY;
    const float pm0 = fmaxf(ex, ib0), pm1 = fmaxf(pm0, ib1);
    gs[l0] = b0; gs[l0 + 1] = b1; gs[128 + l0] = ib0; gs[128 + l0 + 1] = ib1; gs[256 + l0] = a0; gs[256 + l0 + 1] = a1; gs[384 + l0] = pm0; gs[384 + l0 + 1] = pm1;
    if (lane == 0) { gs[512] = g; gs[513] = mloc; }
}

DEV void conv8(const bf16_t* PM, const float* cw, int b, int t, int pmcol, int cch, float (&out)[8]) {
#pragma unroll
    for (int e = 0; e < 8; ++e) out[e] = 0.f;
#pragma unroll
    for (int j = 0; j < 4; ++j) {
        const int tt = t - 3 + j;
        if (tt >= 0) {
            const u32x4 x = *(const u32x4*)(PM + (size_t)(b * SEQ + tt) * LPM + pmcol);
            const float4 w0 = *(const float4*)(cw + j * 1024 + cch), w1 = *(const float4*)(cw + j * 1024 + cch + 4);
            out[0] += bflo(x[0]) * w0.x; out[1] += bfhi(x[0]) * w0.y; out[2] += bflo(x[1]) * w0.z; out[3] += bfhi(x[1]) * w0.w;
            out[4] += bflo(x[2]) * w1.x; out[5] += bfhi(x[2]) * w1.y; out[6] += bflo(x[3]) * w1.z; out[7] += bfhi(x[3]) * w1.w;
        }
    }
}
DEV float siluf_(float y) { return y / (1.f + __expf(-y)); }

DEV void stage_mstate(const Params& p, char* lds, int vb, int nvb) {
    const int tid = threadIdx.x, lane = tid & 63, wave = __builtin_amdgcn_readfirstlane(tid >> 6), fr = lane & 15, fq = lane >> 4;
    char* KT = lds;
    char* VT = lds + 34816;
    float* gs = (float*)(lds + 69632);
    const bf16_t* PM = (const bf16_t*)(p.ws + WS_PM);
    const float* ipre = (const float*)(p.ws + WS_IPRE); const float* fpre = (const float*)(p.ws + WS_FPRE);
    float* UT = (float*)(p.ws + WS_UB); float* NLOC = (float*)(p.ws + WS_NLOC);
    float* G = (float*)(p.ws + WS_CHG); float* MLOC = G + 1024;
    for (int unit = vb; unit < 1024; unit += nvb) {
        const int c = unit & 127, h = (unit >> 7) & 3, b = unit >> 9;
        const int rowbase = b * SEQ + c * 128;
        __syncthreads();
        if (wave == 0) chunk_gates(ipre, fpre, rowbase, h, gs, lane);
        __syncthreads();
        const float mloc = gs[513];
        for (int task = tid; task < 2048; task += NTH) {
            const int l = task >> 4, ch = task & 15;
            float v8[8]; conv8(PM, p.conv_w, b, c * 128 + l, 512 + h * 128 + ch * 8, 512 + h * 128 + ch * 8, v8);
            const float wgt = __expf(gs[256 + l] - mloc) * 0.08838834764831845f;
#pragma unroll
            for (int e = 0; e < 8; ++e) *(bf16_t*)(KT + (ch * 8 + e) * 272 + l * 2) = (bf16_t)f2bf(siluf_(v8[e]) * wgt);
        }
        for (int task = tid; task < 2048; task += NTH) {
            const int l = task >> 4, ch = task & 15;
            const u32x4 x = *(const u32x4*)(PM + (size_t)(rowbase + l) * LPM + 1024 + h * 128 + ch * 8);
#pragma unroll
            for (int e = 0; e < 8; ++e) *(bf16_t*)(VT + (ch * 8 + e) * 272 + l * 2) = (bf16_t)((e & 1) ? (x[e >> 1] >> 16) : (x[e >> 1] & 0xffffu));
        }
        __syncthreads();
        f32x4 acc[8];
#pragma unroll
        for (int t = 0; t < 8; ++t) acc[t] = (f32x4){0.f, 0.f, 0.f, 0.f};
#pragma unroll
        for (int ks = 0; ks < 4; ++ks) {
            const bf16x8 vf = *(const bf16x8*)(VT + (16 * wave + fr) * 272 + (32 * ks + 8 * fq) * 2);
#pragma unroll
            for (int t = 0; t < 8; ++t) { const bf16x8 kf = *(const bf16x8*)(KT + (16 * t + fr) * 272 + (32 * ks + 8 * fq) * 2); acc[t] = mfma16(kf, vf, acc[t]); }
        }
        float* UTu = UT + (size_t)unit * 16384 + (16 * wave + fr) * 128 + 4 * fq;
#pragma unroll
        for (int t = 0; t < 8; ++t) *(f32x4*)(UTu + 16 * t) = acc[t];
        if (tid < 128) { float s = 0.f; for (int l = 0; l < 128; ++l) s += bf2f(*(const bf16_t*)(KT + tid * 272 + l * 2)); NLOC[unit * 128 + tid] = s; }
        if (tid == 0) { G[unit] = gs[512]; MLOC[unit] = mloc; }
    }
}

DEV void stage_mscan(const Params& p, char* lds, int vb, int nvb) {
    const int tid = threadIdx.x;
    float* s_dec = (float*)lds; float* s_scl = s_dec + 128;
    const float* UT = (const float*)(p.ws + WS_UB); const float* NLOC = (const float*)(p.ws + WS_NLOC);
    const float* G = (const float*)(p.ws + WS_CHG); const float* MLOC = G + 1024; float* MST = (float*)(p.ws + WS_CHG) + 2048;
    bf16_t* CST = (bf16_t*)(p.ws + WS_CST); float* NST = (float*)(p.ws + WS_NST);
    for (int item = vb; item < 256; item += nvb) {
        const int bh = item >> 5, part = item & 31;
        __syncthreads();
        if (tid == 0) {
            float m = 0.f;
            for (int c = 0; c < 128; ++c) { const int u = bh * 128 + c; const float g = G[u], ml = MLOC[u]; const float mn = fmaxf(g + m, ml); s_dec[c] = expf(g + m - mn); s_scl[c] = expf(ml - mn); if (part == 0) MST[u] = m; m = mn; }
        }
        __syncthreads();
        const int e = part * 512 + tid;
        float C = 0.f;
        const float* up = UT + (size_t)bh * 128 * 16384 + e; bf16_t* cp = CST + (size_t)bh * 128 * 16384 + e;
        for (int c = 0; c < 128; c += 8) {
            float uu[8];
#pragma unroll
            for (int i = 0; i < 8; ++i) uu[i] = up[(size_t)(c + i) * 16384];
#pragma unroll
            for (int i = 0; i < 8; ++i) { cp[(size_t)(c + i) * 16384] = (bf16_t)f2bf(C); C = s_dec[c + i] * C + s_scl[c + i] * uu[i]; }
        }
        if (part == 0 && tid < 128) { float nn = 0.f; for (int c = 0; c < 128; ++c) { NST[(bh * 128 + c) * 128 + tid] = nn; nn = s_dec[c] * nn + s_scl[c] * NLOC[(bh * 128 + c) * 128 + tid]; } }
    }
}

DEV void stage_mout(const Params& p, char* lds, int vb, int nvb) {
    const int tid = threadIdx.x, lane = tid & 63, wave = __builtin_amdgcn_readfirstlane(tid >> 6), fr = lane & 15, fq = lane >> 4;
    char* Qs = lds; char* Ks = lds + 34816; char* VT = lds + 69632; char* CT = lds + 104448;
    float* gs = (float*)(lds + 139264); float* s_nst = gs + 520; float* s_mo = gs + 648; float* s_wi = gs + 776;
    bf16_t* PM = (bf16_t*)(p.ws + WS_PM);
    const float* ipre = (const float*)(p.ws + WS_IPRE); const float* fpre = (const float*)(p.ws + WS_FPRE);
    const float* MST = (const float*)(p.ws + WS_CHG) + 2048; const float* NST = (const float*)(p.ws + WS_NST);
    const bf16_t* CST = (const bf16_t*)(p.ws + WS_CST);
    for (int unit = vb; unit < 1024; unit += nvb) {
        const int c = unit & 127, h = (unit >> 7) & 3, b = unit >> 9;
        const int rowbase = b * SEQ + c * 128;
        __syncthreads();
        if (wave == 0) chunk_gates(ipre, fpre, rowbase, h, gs, lane);
        for (int task = tid; task < 2048; task += NTH) {
            const int l = task >> 4, ch = task & 15;
            float v8[8]; u32x4 o;
            conv8(PM, p.conv_w, b, c * 128 + l, h * 128 + ch * 8, h * 128 + ch * 8, v8);
            o.x = pk2(siluf_(v8[0]), siluf_(v8[1])); o.y = pk2(siluf_(v8[2]), siluf_(v8[3])); o.z = pk2(siluf_(v8[4]), siluf_(v8[5])); o.w = pk2(siluf_(v8[6]), siluf_(v8[7]));
            *(u32x4*)(Qs + l * 272 + ch * 16) = o;
            conv8(PM, p.conv_w, b, c * 128 + l, 512 + h * 128 + ch * 8, 512 + h * 128 + ch * 8, v8);
            const float sc = 0.08838834764831845f;
            o.x = pk2(siluf_(v8[0]) * sc, siluf_(v8[1]) * sc); o.y = pk2(siluf_(v8[2]) * sc, siluf_(v8[3]) * sc); o.z = pk2(siluf_(v8[4]) * sc, siluf_(v8[5]) * sc); o.w = pk2(siluf_(v8[6]) * sc, siluf_(v8[7]) * sc);
            *(u32x4*)(Ks + l * 272 + ch * 16) = o;
            const u32x4 x = *(const u32x4*)(PM + (size_t)(rowbase + l) * LPM + 1024 + h * 128 + ch * 8);
#pragma unroll
            for (int e = 0; e < 8; ++e) *(bf16_t*)(VT + (ch * 8 + e) * 272 + l * 2) = (bf16_t)((e & 1) ? (x[e >> 1] >> 16) : (x[e >> 1] & 0xffffu));
            *(u32x4*)(CT + l * 272 + ch * 16) = *(const u32x4*)(CST + (size_t)unit * 16384 + l * 128 + ch * 8);
        }
        if (tid < 128) s_nst[tid] = NST[unit * 128 + tid];
        __syncthreads();
        if (tid < 128) { const float mst = MST[unit]; const float bc = gs[tid]; const float mo = bc + fmaxf(mst, gs[384 + tid]); s_mo[tid] = mo; s_wi[tid] = __expf(bc + mst - mo); }
        __syncthreads();
        const int l = 16 * wave + fr;
        f32x4 s[8];
        bf16x8 qf[4];
#pragma unroll
        for (int ks = 0; ks < 4; ++ks) qf[ks] = *(const bf16x8*)(Qs + l * 272 + (32 * ks + 8 * fq) * 2);
#pragma unroll
        for (int t = 0; t < 8; ++t) {
            s[t] = (f32x4){0.f, 0.f, 0.f, 0.f};
            if (t <= wave) {
#pragma unroll
                for (int ks = 0; ks < 4; ++ks) { const bf16x8 kf = *(const bf16x8*)(Ks + (16 * t + fr) * 272 + (32 * ks + 8 * fq) * 2); s[t] = mfma16(kf, qf[ks], s[t]); }
            }
        }
        const float bl = gs[l], mol = s_mo[l];
        float dsum = 0.f;
#pragma unroll
        for (int t = 0; t < 8; ++t)
#pragma unroll
            for (int r = 0; r < 4; ++r) {
                const int si = 16 * t + 4 * fq + r; float wv = 0.f;
                if (t <= wave && si <= l) wv = __expf(bl + gs[128 + si] - mol) * s[t][r];
                s[t][r] = wv; dsum += wv;
            }
        dsum += __shfl_xor(dsum, 16); dsum += __shfl_xor(dsum, 32);
        float qn = 0.f;
        {
            const char* qrow = Qs + l * 272 + fq * 64;
#pragma unroll
            for (int i = 0; i < 4; ++i) {
                const u32x4 x = *(const u32x4*)(qrow + 16 * i); const float* nn = s_nst + fq * 32 + 8 * i;
                qn += bflo(x[0]) * nn[0] + bfhi(x[0]) * nn[1] + bflo(x[1]) * nn[2] + bfhi(x[1]) * nn[3] + bflo(x[2]) * nn[4] + bfhi(x[2]) * nn[5] + bflo(x[3]) * nn[6] + bfhi(x[3]) * nn[7];
            }
        }
        qn += __shfl_xor(qn, 16); qn += __shfl_xor(qn, 32);
        __syncthreads();
#pragma unroll
        for (int t = 0; t < 8; ++t)
            if (t <= wave + 1) { u32x2 o; o.x = pk2(s[t][0], s[t][1]); o.y = pk2(s[t][2], s[t][3]); *(u32x2*)(Ks + l * 272 + (16 * t + 4 * fq) * 2) = o; }
        __syncthreads();
        f32x4 acc[8];
#pragma unroll
        for (int t = 0; t < 8; ++t) acc[t] = (f32x4){0.f, 0.f, 0.f, 0.f};
#pragma unroll
        for (int ks = 0; ks < 4; ++ks)
#pragma unroll
            for (int t = 0; t < 8; ++t) { const bf16x8 cf = *(const bf16x8*)(CT + (16 * t + fr) * 272 + (32 * ks + 8 * fq) * 2); acc[t] = mfma16(cf, qf[ks], acc[t]); }
        const float wi = s_wi[l];
#pragma unroll
        for (int t = 0; t < 8; ++t) acc[t] = acc[t] * wi;
        const int nks = (wave + 2) >> 1;
#pragma unroll
        for (int ks = 0; ks < 4; ++ks)
            if (ks < nks) {
                const bf16x8 wf = *(const bf16x8*)(Ks + l * 272 + (32 * ks + 8 * fq) * 2);
#pragma unroll
                for (int t = 0; t < 8; ++t) { const bf16x8 vf = *(const bf16x8*)(VT + (16 * t + fr) * 272 + (32 * ks + 8 * fq) * 2); acc[t] = mfma16(vf, wf, acc[t]); }
            }
        const float den = dsum + wi * qn;
        const float invd = 1.f / fmaxf(fabsf(den), __expf(-mol));
        bf16_t* mop = PM + (size_t)(rowbase + l) * LPM + 1536 + h * 128 + 4 * fq;
        float ssq = 0.f;
#pragma unroll
        for (int t = 0; t < 8; ++t) {
            const u32x2 g2 = *(const u32x2*)(mop + 16 * t);
            const float gg[4] = {bflo(g2.x), bfhi(g2.x), bflo(g2.y), bfhi(g2.y)};
#pragma unroll
            for (int r = 0; r < 4; ++r) { const float hv = acc[t][r] * invd * sigmoidf_(gg[r]); acc[t][r] = hv; ssq += hv * hv; }
        }
        ssq += __shfl_xor(ssq, 16); ssq += __shfl_xor(ssq, 32);
        const float rn = rsqrtf(ssq * (1.f / 128.f) + 1e-6f);
#pragma unroll
        for (int t = 0; t < 8; ++t) {
            const float4 nw = *(const float4*)(p.mnorm_w + h * 128 + 16 * t + 4 * fq);
            u32x2 o; o.x = pk2(acc[t][0] * rn * nw.x, acc[t][1] * rn * nw.y); o.y = pk2(acc[t][2] * rn * nw.z, acc[t][3] * rn * nw.w);
            *(u32x2*)(mop + 16 * t) = o;
        }
    }
}

DEV void stage_norm2(const Params& p, char* lds, int vb, int nvb) {
    const int tid = threadIdx.x, lane = tid & 63, wave = __builtin_amdgcn_readfirstlane(tid >> 6);
    const float* mod = (const float*)(p.ws + WS_MOD);
    bf16_t* U2 = (bf16_t*)(p.ws + WS_PG);
    for (int m = vb * NW + wave; m < M; m += nvb * NW) {
        const int b = m >= SEQ ? 1 : 0;
        const float4* xr = (const float4*)(p.out + (size_t)m * D);
        float4 v[4]; float ss = 0.f;
#pragma unroll
        for (int j = 0; j < 4; ++j) { v[j] = xr[lane + 64 * j]; ss += v[j].x * v[j].x + v[j].y * v[j].y + v[j].z * v[j].z + v[j].w * v[j].w; }
        ss = wave_sum(ss);
        const float rstd = rsqrtf(ss * (1.f / 1024.f) + 1e-6f);
#pragma unroll
        for (int j = 0; j < 4; ++j) {
            const int col = 4 * (lane + 64 * j);
            const float4 w1 = *(const float4*)(p.norm2_w + col), sc = *(const float4*)(mod + b * 6144 + 4096 + col), sh = *(const float4*)(mod + b * 6144 + 3072 + col);
            u32x2 o;
            o.x = pk2(v[j].x * rstd * w1.x * (1.f + sc.x) + sh.x, v[j].y * rstd * w1.y * (1.f + sc.y) + sh.y);
            o.y = pk2(v[j].z * rstd * w1.z * (1.f + sc.z) + sh.z, v[j].w * rstd * w1.w * (1.f + sc.w) + sh.w);
            *(u32x2*)(U2 + (size_t)m * D + col) = o;
        }
    }
}

constexpr size_t WS_SELI = WS_PM;
constexpr size_t WS_SELG = WS_PM + 16 * MiB;
DEV unsigned f2ord(float f) { const unsigned u = __float_as_uint(f); return (u & 0x80000000u) ? ~u : (u | 0x80000000u); }
DEV float ord2f(unsigned k) { return __uint_as_float((k & 0x80000000u) ? (k ^ 0x80000000u) : ~k); }
DEV unsigned umax_(unsigned a, unsigned b) { return a > b ? a : b; }

DEV void stage_q_topk(const Params& p, char* lds, int vb, int nvb) {
    const int tid = threadIdx.x, lane = tid & 63, wave = __builtin_amdgcn_readfirstlane(tid >> 6), fr = lane & 15, fq = lane >> 4;
    char* Qt = lds;
    char* Kd = lds + 65536;
    unsigned* tops = (unsigned*)(lds + 135168);
    const bf16_t* SK = (const bf16_t*)(p.ws + WS_SK);
    for (int i = tid; i < 2 * 128 * 16; i += NTH) { const int row = i >> 4, ch = i & 15; *(u32x4*)(Kd + row * 272 + ch * 16) = *(const u32x4*)(SK + row * 128 + ch * 8); }
    GemmOp g{(const bf16_t*)(p.ws + WS_PG), 1024, (const bf16_t*)(p.ws + WS_WQ), 1024, 1024};
    int* SELI = (int*)(p.ws + WS_SELI); float* SELG = (float*)(p.ws + WS_SELG);
    for (int item = vb; item < 2048; item += nvb) {
        const int mt = item >> 3, h = item & 7, m0 = mt * 128;
        for (int pp = 0; pp < 2; ++pp) {
            f32x4 acc[4][2];
#pragma unroll
            for (int i = 0; i < 4; ++i) { acc[i][0] = (f32x4){0.f, 0.f, 0.f, 0.f}; acc[i][1] = acc[i][0]; }
            gemm_tile(acc, g, m0, h * 256 + pp * 128, lds);
            {
                const int wm = wave >> 2, wn = wave & 3;
#pragma unroll
                for (int mi = 0; mi < 4; ++mi)
#pragma unroll
                    for (int ni = 0; ni < 2; ++ni) { const f32x4 v = acc[mi][ni]; u32x2 o; o.x = pk2(v[0], v[1]); o.y = pk2(v[2], v[3]);
                        *(u32x2*)(Qt + (wm * 64 + mi * 16 + fr) * 272 + (wn * 32 + ni * 16 + 4 * fq) * 2) = o; }
            }
            __syncthreads();
            bf16x8 qf[4];
#pragma unroll
            for (int ks = 0; ks < 4; ++ks) qf[ks] = *(const bf16x8*)(Qt + (16 * wave + fr) * 272 + (32 * ks + 8 * fq) * 2);
            unsigned key[32];
#pragma unroll
            for (int t = 0; t < 8; ++t) {
                f32x4 sc = {0.f, 0.f, 0.f, 0.f};
#pragma unroll
                for (int ks = 0; ks < 4; ++ks) { const bf16x8 kf = *(const bf16x8*)(Kd + (pp * 128 + 16 * t + fr) * 272 + (32 * ks + 8 * fq) * 2); sc = mfma16(kf, qf[ks], sc); }
#pragma unroll
                for (int r = 0; r < 4; ++r) key[4 * t + r] = (f2ord(sc[r]) & ~127u) | (127u - (unsigned)(16 * t + 4 * fq + r));
            }
            unsigned prev = 0xffffffffu;
            for (int r = 0; r < 16; ++r) {
                unsigned best = 0u;
#pragma unroll
                for (int i = 0; i < 32; ++i) { const unsigned c = key[i] < prev ? key[i] : 0u; best = umax_(best, c); }
                best = umax_(best, (unsigned)__shfl_xor((int)best, 16)); best = umax_(best, (unsigned)__shfl_xor((int)best, 32));
                prev = best;
                if (fq == 0) tops[((16 * wave + fr) * 2 + pp) * 16 + r] = best;
            }
            __syncthreads();
        }
        const unsigned* tp = tops + (16 * wave + fr) * 32;
        float A[4], B[16];
#pragma unroll
        for (int m = 0; m < 4; ++m) A[m] = ord2f(tp[fq + 4 * m] & ~127u);
#pragma unroll
        for (int j = 0; j < 16; ++j) B[j] = ord2f(tp[16 + j] & ~127u);
        unsigned ck[21];
#pragma unroll
        for (int sl = 0; sl < 21; ++sl) {
            const int m = sl < 16 ? 0 : (sl < 19 ? 1 : (sl < 20 ? 2 : 3)), j = sl < 16 ? sl : (sl < 19 ? sl - 16 : 0);
            const int i = fq + 4 * m;
            const bool ok = j < 16 / (i + 1);
            ck[sl] = ok ? ((f2ord(A[m] + B[j]) & ~255u) | (255u - (unsigned)(i * 16 + j))) : 0u;
        }
        unsigned wins[16];
        {
            unsigned prev = 0xffffffffu;
#pragma unroll
            for (int r = 0; r < 16; ++r) {
                unsigned best = 0u;
#pragma unroll
                for (int sl = 0; sl < 21; ++sl) { const unsigned c = ck[sl] < prev ? ck[sl] : 0u; best = umax_(best, c); }
                best = umax_(best, (unsigned)__shfl_xor((int)best, 16)); best = umax_(best, (unsigned)__shfl_xor((int)best, 32));
                prev = best; wins[r] = best;
            }
        }
        const float v0 = ord2f(wins[0] & ~255u);
        float ex[16], sm = 0.f;
#pragma unroll
        for (int r = 0; r < 16; ++r) { ex[r] = __expf(ord2f(wins[r] & ~255u) - v0); sm += ex[r]; }
        const float rs = 1.f / sm;
        int oi[4]; float og[4];
#pragma unroll
        for (int q = 0; q < 4; ++q) {
            const unsigned w = fq == 0 ? wins[q] : (fq == 1 ? wins[4 + q] : (fq == 2 ? wins[8 + q] : wins[12 + q]));
            const float e = fq == 0 ? ex[q] : (fq == 1 ? ex[4 + q] : (fq == 2 ? ex[8 + q] : ex[12 + q]));
            const unsigned flat = 255u - (w & 255u); const unsigned ia = flat >> 4, jb = flat & 15u;
            oi[q] = (int)((127u - (tp[ia] & 127u)) * 128u + (127u - (tp[16 + jb] & 127u)));
            og[q] = e * rs;
        }
        const size_t so = (size_t)(m0 + 16 * wave + fr) * 128 + h * 16 + 4 * fq;
        *(int4*)(SELI + so) = make_int4(oi[0], oi[1], oi[2], oi[3]);
        *(float4*)(SELG + so) = make_float4(og[0], og[1], og[2], og[3]);
    }
}

typedef float f32x2 __attribute__((ext_vector_type(2)));
struct EB { u32x4 u[8], v[8]; };

DEV void peer_load(EB& b, const unsigned char* TU, const unsigned char* TV, int iv, int e0, int lane) {
#pragma unroll
    for (int q = 0; q < 8; ++q) {
        const int id = __builtin_amdgcn_readlane(iv, e0 + q);
        b.u[q] = ((const u32x4*)(TU + (size_t)id * 1024))[lane]; b.v[q] = ((const u32x4*)(TV + (size_t)id * 1024))[lane];
    }
}
DEV void peer_compute(const EB& b, const f32x2 (&x)[8], float isu, float gsv, int e0, int lane, f32x2 (&oa)[8]) {
    float d[8];
#pragma unroll
    for (int q = 0; q < 8; ++q) {
        f32x2 a = {0.f, 0.f};
#pragma unroll
        for (int i = 0; i < 4; ++i) {
            a = __builtin_elementwise_fma(__builtin_amdgcn_cvt_pk_f32_fp8((int)b.u[q][i], false), x[2 * i], a);
            a = __builtin_elementwise_fma(__builtin_amdgcn_cvt_pk_f32_fp8((int)b.u[q][i], true), x[2 * i + 1], a);
        }
        d[q] = (a.x + a.y) * __uint_as_float((unsigned)__builtin_amdgcn_readlane((int)__float_as_uint(isu), e0 + q));
    }
    const bool h32 = (lane & 32) != 0, h16 = (lane & 16) != 0, h8 = (lane & 8) != 0;
    float k[4];
#pragma unroll
    for (int i = 0; i < 4; ++i) k[i] = (h32 ? d[4 + i] : d[i]) + __shfl_xor(h32 ? d[i] : d[4 + i], 32);
    float m2[2];
#pragma unroll
    for (int i = 0; i < 2; ++i) m2[i] = (h16 ? k[2 + i] : k[i]) + __shfl_xor(h16 ? k[i] : k[2 + i], 16);
    float v1 = (h8 ? m2[1] : m2[0]) + __shfl_xor(h8 ? m2[0] : m2[1], 8);
    v1 += __shfl_xor(v1, 4); v1 += __shfl_xor(v1, 2); v1 += __shfl_xor(v1, 1);
    const float gl = __shfl(gsv, e0 + ((lane >> 3) & 7));
    const int wi_ = (int)__float_as_uint(gl * 0.5f * v1 * (1.f + erff(v1 * 0.7071067811865476f)));
#pragma unroll
    for (int q = 0; q < 8; ++q) {
        const float w = __uint_as_float((unsigned)__builtin_amdgcn_readlane(wi_, 8 * q));
        const f32x2 w2 = {w, w};
#pragma unroll
        for (int i = 0; i < 4; ++i) {
            oa[2 * i] = __builtin_elementwise_fma(__builtin_amdgcn_cvt_pk_f32_fp8((int)b.v[q][i], false), w2, oa[2 * i]);
            oa[2 * i + 1] = __builtin_elementwise_fma(__builtin_amdgcn_cvt_pk_f32_fp8((int)b.v[q][i], true), w2, oa[2 * i + 1]);
        }
    }
}

DEV void stage_peer_gather(const Params& p, char* lds, int vb, int nvb, bool dry = false) {
    const int tid = threadIdx.x, lane = tid & 63, wave = __builtin_amdgcn_readfirstlane(tid >> 6);
    const bf16_t* U2 = (const bf16_t*)(p.ws + WS_PG);
    const unsigned char* TU = p.ws + WS_TU; const unsigned char* TV = p.ws + WS_TV;
    const float* ISU = (const float*)(p.ws + WS_ISU); const float* ISV = (const float*)(p.ws + WS_ISV);
    const int* SELI = (const int*)(p.ws + WS_SELI); const float* SELG = (const float*)(p.ws + WS_SELG);
    const float* mod = (const float*)(p.ws + WS_MOD);
    for (int tkn = vb * NW + wave; tkn < M; tkn += nvb * NW) {
        f32x2 x[8];
        {
            const u32x4* xr = (const u32x4*)(U2 + (size_t)tkn * D + 16 * lane); const u32x4 x0 = xr[0], x1 = xr[1];
#pragma unroll
            for (int i = 0; i < 4; ++i) { x[i] = (f32x2){bflo(x0[i]), bfhi(x0[i])}; x[4 + i] = (f32x2){bflo(x1[i]), bfhi(x1[i])}; }
        }
        const int iv0 = SELI[(size_t)tkn * 128 + lane], iv1 = SELI[(size_t)tkn * 128 + 64 + lane];
        const float gs0 = SELG[(size_t)tkn * 128 + lane] * ISV[iv0], gs1 = SELG[(size_t)tkn * 128 + 64 + lane] * ISV[iv1];
        const float su0 = ISU[iv0], su1 = ISU[iv1];
        f32x2 oa[8];
#pragma unroll
        for (int i = 0; i < 8; ++i) oa[i] = (f32x2){0.f, 0.f};
        EB ba, bb;
#pragma unroll
        for (int half = 0; half < 2; ++half) {
            const int iv = half ? iv1 : iv0; const float gsv = half ? gs1 : gs0, isu = half ? su1 : su0;
            peer_load(ba, TU, TV, iv, 0, lane);
            for (int bt = 0; bt < 8; bt += 2) {
                peer_load(bb, TU, TV, iv, 8 * bt + 8, lane);
                peer_compute(ba, x, isu, gsv, 8 * bt, lane, oa);
                if (bt + 2 < 8) peer_load(ba, TU, TV, iv, 8 * bt + 16, lane);
                peer_compute(bb, x, isu, gsv, 8 * bt + 8, lane, oa);
            }
        }
        const int b = tkn >= SEQ ? 1 : 0;
        float* hr = p.out + (size_t)tkn * D + 16 * lane;
        const float* g2p = mod + b * 6144 + 5120 + 16 * lane;
        float4 y[4]; float ss = 0.f;
#pragma unroll
        for (int q = 0; q < 4; ++q) {
            const float4 hv = *(const float4*)(hr + 4 * q); const float4 g2 = *(const float4*)(g2p + 4 * q);
            y[q].x = hv.x + g2.x * oa[2 * q].x; y[q].y = hv.y + g2.y * oa[2 * q].y; y[q].z = hv.z + g2.z * oa[2 * q + 1].x; y[q].w = hv.w + g2.w * oa[2 * q + 1].y;
            ss += y[q].x * y[q].x + y[q].y * y[q].y + y[q].z * y[q].z + y[q].w * y[q].w;
        }
        ss = wave_sum(ss);
        const float rstd = rsqrtf(ss * (1.f / 1024.f) + 1e-6f);
        if (!dry || rstd == 123.456f)
#pragma unroll
        for (int q = 0; q < 4; ++q) {
            const float4 nw = *(const float4*)(p.normf_w + 16 * lane + 4 * q);
            float4 o; o.x = y[q].x * rstd * nw.x; o.y = y[q].y * rstd * nw.y; o.z = y[q].z * rstd * nw.z; o.w = y[q].w * rstd * nw.w;
            *(float4*)(hr + 4 * q) = o;
        }
    }
}

namespace cg = cooperative_groups;
constexpr int LDS_BYTES = 151552;

__global__ void __launch_bounds__(512) k_mega(Params p) {
    extern __shared__ __attribute__((aligned(16))) char lds[];
    cg::grid_group grid = cg::this_grid();
    const int vb = blockIdx.x, nvb = gridDim.x;
    stage_prep(p, lds, vb, nvb);        grid.sync();
    stage_norm1(p, lds, vb, nvb);       grid.sync();
    stage_gemm_in(p, lds, vb, nvb);     grid.sync();
    stage_attn(p, lds, vb, nvb);
    stage_mstate(p, lds, vb, nvb);      grid.sync();
    stage_mscan(p, lds, vb, nvb);       grid.sync();
    stage_mout(p, lds, vb, nvb);        grid.sync();
    stage_gemm_merge(p, lds, vb, nvb);  grid.sync();
    stage_gemm_out(p, lds, vb, nvb);    grid.sync();
    stage_norm2(p, lds, vb, nvb);       grid.sync();
    stage_q_topk(p, lds, vb, nvb);      grid.sync();
#ifdef XP_PEER
    stage_peer_gather(p, lds, vb, nvb, p.ws != nullptr);
#endif
    stage_peer_gather(p, lds, vb, nvb);
}

extern "C" void kernel_launch(void* const* d_in, const int* in_sizes, int n_in, void* d_out, int out_size, void* d_ws, size_t ws_size, hipStream_t stream) {
    if (n_in != 20 || ws_size < WS_END) { fprintf(stderr, "kernel_launch: unexpected n_in %d or ws_size %zu\n", n_in, ws_size); return; }
    static int grid_blocks = 0;
    if (!grid_blocks) {
        int dev = 0, cus = 0, per_cu = 0;
        (void)hipGetDevice(&dev);
        (void)hipDeviceGetAttribute(&cus, hipDeviceAttributeMultiprocessorCount, dev);
        (void)hipFuncSetAttribute((const void*)k_mega, hipFuncAttributeMaxDynamicSharedMemorySize, LDS_BYTES);
        (void)hipOccupancyMaxActiveBlocksPerMultiprocessor(&per_cu, (const void*)k_mega, 512, LDS_BYTES);
        if (per_cu < 1) { fprintf(stderr, "kernel_launch: occupancy query says %d blocks per CU\n", per_cu); per_cu = 1; }
        grid_blocks = cus * 1;
    }
    Params p{};
    p.x = (const float*)d_in[0]; p.c = (const float*)d_in[1]; p.w_ada = (const float*)d_in[2]; p.b_ada = (const float*)d_in[3]; p.norm1_w = (const float*)d_in[4];
    p.w_in = (const float*)d_in[5]; p.conv_w = (const float*)d_in[6]; p.sinks = (const float*)d_in[7]; p.i_bias = (const float*)d_in[8]; p.f_bias = (const float*)d_in[9];
    p.mnorm_w = (const float*)d_in[10]; p.w_a = (const float*)d_in[11]; p.w_b = (const float*)d_in[12]; p.w_out = (const float*)d_in[13]; p.norm2_w = (const float*)d_in[14];
    p.w_q = (const float*)d_in[15]; p.sub_keys = (const float*)d_in[16]; p.peer_u = (const float*)d_in[17]; p.peer_v = (const float*)d_in[18]; p.normf_w = (const float*)d_in[19];
    p.out = (float*)d_out; p.ws = (unsigned char*)d_ws;
    void* args[] = {&p};
    hipError_t e = hipLaunchCooperativeKernel((const void*)k_mega, dim3(grid_blocks), dim3(512), args, LDS_BYTES, stream);
    if (e != hipSuccess) fprintf(stderr, "cooperative launch failed: %s (grid %d)\n", hipGetErrorString(e), grid_blocks);
}
```

```cpp
#include <hip/hip_runtime.h>
#include <hip/hip_cooperative_groups.h>
#include <stdint.h>
#include <stdio.h>

#define DEV __device__ __forceinline__
typedef unsigned short bf16_t;
typedef short bf16x8 __attribute__((ext_vector_type(8)));
typedef float f32x4 __attribute__((ext_vector_type(4)));
typedef unsigned u32x4 __attribute__((ext_vector_type(4)));
typedef unsigned u32x2 __attribute__((ext_vector_type(2)));

constexpr int BATCH = 2, SEQ = 16384, M = BATCH * SEQ, D = 1024;
constexpr int NTH = 512, NW = 8;
constexpr int LPA = 768, LPM = 2048, LPG = 2048;

struct Params {
    const float *x, *c, *w_ada, *b_ada, *norm1_w, *w_in, *conv_w, *sinks, *i_bias, *f_bias, *mnorm_w, *w_a, *w_b, *w_out, *norm2_w, *w_q, *sub_keys, *peer_u, *peer_v, *normf_w;
    float* out; unsigned char* ws;
};

constexpr size_t MiB = 1u << 20;
constexpr size_t WS_MOD = 1 * MiB;
constexpr size_t WS_IPRE = 2 * MiB;
constexpr size_t WS_FPRE = 2 * MiB + 512 * 1024;
constexpr size_t WS_CHG = 3 * MiB;
constexpr size_t WS_NLOC = 4 * MiB;
constexpr size_t WS_NST = 4 * MiB + 512 * 1024;
constexpr size_t WS_ROPE = 5 * MiB;
constexpr size_t WS_WIN = 10 * MiB;
constexpr size_t WS_WA = 20 * MiB;
constexpr size_t WS_WB = 21 * MiB;
constexpr size_t WS_WOUT = 22 * MiB;
constexpr size_t WS_WQ = 24 * MiB;
constexpr size_t WS_SK = 28 * MiB;
constexpr size_t WS_ISU = 29 * MiB;
constexpr size_t WS_ISV = 29 * MiB + 65536;
constexpr size_t WS_TU = 32 * MiB;
constexpr size_t WS_TV = 48 * MiB;
constexpr size_t WS_UB = 96 * MiB;
constexpr size_t WS_PA = 160 * MiB;
constexpr size_t WS_PM = 208 * MiB;
constexpr size_t WS_PG = 336 * MiB;
constexpr size_t WS_CST = 464 * MiB;
constexpr size_t WS_END = 496 * MiB;

DEV unsigned f2bf(float f) { unsigned u = __float_as_uint(f); return (u + 0x7fffu + ((u >> 16) & 1u)) >> 16; }
DEV unsigned pk2(float lo, float hi) { return f2bf(lo) | (f2bf(hi) << 16); }
DEV float bflo(unsigned u) { return __uint_as_float(u << 16); }
DEV float bfhi(unsigned u) { return __uint_as_float(u & 0xffff0000u); }
DEV float bf2f(bf16_t h) { return __uint_as_float(((unsigned)h) << 16); }
DEV float wave_sum(float v) {
#pragma unroll
    for (int o = 32; o > 0; o >>= 1) v += __shfl_xor(v, o);
    return v;
}
DEV float wave_max(float v) {
#pragma unroll
    for (int o = 32; o > 0; o >>= 1) v = fmaxf(v, __shfl_xor(v, o));
    return v;
}
DEV float sigmoidf_(float v) { return 1.f / (1.f + __expf(-v)); }
DEV f32x4 mfma16(bf16x8 a, bf16x8 b, f32x4 c) { return __builtin_amdgcn_mfma_f32_16x16x32_bf16(a, b, c, 0, 0, 0); }
DEV void wave_lds_sync() { __builtin_amdgcn_fence(__ATOMIC_ACQ_REL, "wavefront"); __builtin_amdgcn_wave_barrier(); }

DEV void transpose_item(const float* W, int ldw, int k0, int nsrc0, bf16_t* WT, int ldt, int ndst0, float* scr, int lane) {
#pragma unroll 8
    for (int i = 0; i < 32; ++i) { const int kk = 2 * i + (lane >> 5); scr[kk * 33 + (lane & 31)] = W[(size_t)(k0 + kk) * ldw + nsrc0 + (lane & 31)]; }
    wave_lds_sync();
    const int c = lane & 7;
#pragma unroll
    for (int j = 0; j < 4; ++j) {
        const int n = (lane >> 3) + 8 * j; const float* s = scr + (8 * c) * 33 + n;
        u32x4 o; o.x = pk2(s[0 * 33], s[1 * 33]); o.y = pk2(s[2 * 33], s[3 * 33]); o.z = pk2(s[4 * 33], s[5 * 33]); o.w = pk2(s[6 * 33], s[7 * 33]);
        *(u32x4*)(WT + (size_t)(ndst0 + n) * ldt + k0 + 8 * c) = o;
    }
    wave_lds_sync();
}

DEV void stage_prep(const Params& p, char* lds, int vb, int nvb) {
    const int tid = threadIdx.x, lane = tid & 63, wave = __builtin_amdgcn_readfirstlane(tid >> 6);
    float* mod = (float*)(p.ws + WS_MOD);
    float* s_act = (float*)lds;
    float* s_red = (float*)(lds + 8192);
    for (int i = tid; i < 2048; i += NTH) { const float v = p.c[i]; s_act[i] = v / (1.f + expf(-v)); }
    __syncthreads();
    for (int item = vb; item < 192; item += nvb) {
        const int kg = tid >> 5, cl = tid & 31, col = item * 32 + cl;
        float s0 = 0.f, s1 = 0.f;
        for (int k = kg; k < 1024; k += 16) { const float w = p.w_ada[(size_t)k * 6144 + col]; s0 += s_act[k] * w; s1 += s_act[1024 + k] * w; }
        s_red[(kg * 32 + cl) * 2] = s0; s_red[(kg * 32 + cl) * 2 + 1] = s1;
        __syncthreads();
        if (tid < 64) { const int b = tid >> 5, c2 = tid & 31; float s = 0.f; for (int g = 0; g < 16; ++g) s += s_red[(g * 32 + c2) * 2 + b]; mod[b * 6144 + item * 32 + c2] = s + p.b_ada[item * 32 + c2]; }
        __syncthreads();
    }
    float* scr = (float*)(lds + 16384 + wave * 8448);
    const int gw = vb * NW + wave, ngw = nvb * NW;
    bf16_t* Wt_in = (bf16_t*)(p.ws + WS_WIN); bf16_t* Wt_a = (bf16_t*)(p.ws + WS_WA); bf16_t* Wt_b = (bf16_t*)(p.ws + WS_WB);
    bf16_t* Wt_out = (bf16_t*)(p.ws + WS_WOUT); bf16_t* Wt_q = (bf16_t*)(p.ws + WS_WQ);
    for (int it = gw; it < 4480; it += ngw) {
        int r = it;
        if (r < 2432) { const int kb = r / 152, nb = r % 152; transpose_item(p.w_in, 4872, kb * 64, nb * 32 + (nb >= 88 ? 8 : 0), Wt_in, 1024, nb * 32, scr, lane); continue; } r -= 2432;
        if (r < 256) { const int kb = r / 32, nb = r % 32; transpose_item(p.w_a, 1024, kb * 64, nb * 32, Wt_a, 512, nb * 32, scr, lane); continue; } r -= 256;
        if (r < 256) { const int kb = r / 32, nb = r % 32; transpose_item(p.w_b, 1024, kb * 64, nb * 32, Wt_b, 512, nb * 32, scr, lane); continue; } r -= 256;
        if (r < 512) { const int kb = r / 32, nb = r % 32; transpose_item(p.w_out, 1024, kb * 64, nb * 32, Wt_out, 1024, nb * 32, scr, lane); continue; } r -= 512;
        { const int kb = r / 64, nb = r % 64; transpose_item(p.w_q, 2048, kb * 64, nb * 32, Wt_q, 1024, nb * 32, scr, lane); }
    }
    const size_t gt = (size_t)vb * NTH + tid, ngt = (size_t)nvb * NTH;
    for (int row = gw; row < 32768; row += ngw) {
        const bool isv = row >= 16384; const int r = row & 16383;
        const float4* src = (const float4*)((isv ? p.peer_v : p.peer_u) + (size_t)r * D) + 4 * lane;
        float4 a[4]; float mx = 0.f;
#pragma unroll
        for (int i = 0; i < 4; ++i) { a[i] = src[i]; mx = fmaxf(mx, fmaxf(fmaxf(fabsf(a[i].x), fabsf(a[i].y)), fmaxf(fabsf(a[i].z), fabsf(a[i].w)))); }
        mx = wave_max(mx);
        int ex = 0; if (mx > 0.f) (void)frexpf(mx, &ex); else ex = 8;
        const float sc = ldexpf(1.f, 8 - ex), isc = ldexpf(1.f, ex - 8);
        u32x4 w;
#pragma unroll
        for (int i = 0; i < 4; ++i) { int pk = 0; pk = __builtin_amdgcn_cvt_pk_fp8_f32(a[i].x * sc, a[i].y * sc, pk, false); pk = __builtin_amdgcn_cvt_pk_fp8_f32(a[i].z * sc, a[i].w * sc, pk, true); w[i] = (unsigned)pk; }
        ((u32x4*)(p.ws + (isv ? WS_TV : WS_TU) + (size_t)r * 1024))[lane] = w;
        if (lane == 0) ((float*)(p.ws + (isv ? WS_ISV : WS_ISU)))[r] = isc;
    }
    for (size_t g = gt; g < 4096; g += ngt) {
        const float4 a = ((const float4*)p.sub_keys)[2 * g], b = ((const float4*)p.sub_keys)[2 * g + 1];
        u32x4 w; w.x = pk2(a.x, a.y); w.y = pk2(a.z, a.w); w.z = pk2(b.x, b.y); w.w = pk2(b.z, b.w);
        ((u32x4*)(p.ws + WS_SK))[g] = w;
    }
    float2* rope = (float2*)(p.ws + WS_ROPE);
    for (size_t e = gt; e < 16384 * 32; e += ngt) {
        const int pos = (int)(e >> 5), i = (int)(e & 31);
        const float inv = (float)exp2(-(double)i * (13.287712379549449 / 32.0));
        const float ang = (float)pos * inv;
        const double a = (double)ang; const double n = rint(a * 0.15915494309189535); const double r = a - n * 6.283185307179586;
        float s, c; sincosf((float)r, &s, &c);
        rope[e] = make_float2(c, s);
    }
}

DEV void stage_norm1(const Params& p, char* lds, int vb, int nvb) {
    const int tid = threadIdx.x, lane = tid & 63, wave = __builtin_amdgcn_readfirstlane(tid >> 6);
    float* wg = (float*)lds;
    for (int i = tid; i < 8192; i += NTH) { const int cc = i >> 10, k = i & 1023; wg[i] = p.w_in[(size_t)k * 4872 + 2816 + cc]; }
    __syncthreads();
    const float* mod = (const float*)(p.ws + WS_MOD);
    bf16_t* ub = (bf16_t*)(p.ws + WS_UB);
    float* ipre = (float*)(p.ws + WS_IPRE); float* fpre = (float*)(p.ws + WS_FPRE);
    for (int m = vb * NW + wave; m < M; m += nvb * NW) {
        const int b = m >= SEQ ? 1 : 0;
        const float4* xr = (const float4*)(p.x + (size_t)m * D);
        float4 v[4]; float ss = 0.f;
#pragma unroll
        for (int j = 0; j < 4; ++j) { v[j] = xr[lane + 64 * j]; ss += v[j].x * v[j].x + v[j].y * v[j].y + v[j].z * v[j].z + v[j].w * v[j].w; }
        ss = wave_sum(ss);
        const float rstd = rsqrtf(ss * (1.f / 1024.f) + 1e-6f);
        float ga[8];
#pragma unroll
        for (int cc = 0; cc < 8; ++cc) ga[cc] = 0.f;
#pragma unroll
        for (int j = 0; j < 4; ++j) {
            const int col = 4 * (lane + 64 * j);
            const float4 w1 = *(const float4*)(p.norm1_w + col), sc = *(const float4*)(mod + b * 6144 + 1024 + col), sh = *(const float4*)(mod + b * 6144 + col);
            float4 u;
            u.x = v[j].x * rstd * w1.x * (1.f + sc.x) + sh.x; u.y = v[j].y * rstd * w1.y * (1.f + sc.y) + sh.y;
            u.z = v[j].z * rstd * w1.z * (1.f + sc.z) + sh.z; u.w = v[j].w * rstd * w1.w * (1.f + sc.w) + sh.w;
            u32x2 o; o.x = pk2(u.x, u.y); o.y = pk2(u.z, u.w);
            *(u32x2*)(ub + (size_t)m * D + col) = o;
#pragma unroll
            for (int cc = 0; cc < 8; ++cc) { const float4 g = *(const float4*)(wg + cc * 1024 + col); ga[cc] += u.x * g.x + u.y * g.y + u.z * g.z + u.w * g.w; }
        }
#pragma unroll
        for (int cc = 0; cc < 8; ++cc) ga[cc] = wave_sum(ga[cc]);
        if (lane == 0) {
#pragma unroll
            for (int h = 0; h < 4; ++h) { ipre[(size_t)m * 4 + h] = ga[h] + p.i_bias[h]; fpre[(size_t)m * 4 + h] = ga[4 + h] + p.f_bias[h]; }
        }
    }
}

namespace pg8 {
#define PG8_LAS __attribute__((address_space(3)))
typedef unsigned short bf16_t;
typedef short bf16x8 __attribute__((ext_vector_type(8)));
typedef float f32x4 __attribute__((ext_vector_type(4)));
typedef unsigned u32x4 __attribute__((ext_vector_type(4)));
constexpr int BM = 256, BK = 64, HALF = 128, HTB = HALF * BK * 2  , STAGE_BYTES = 8 * HTB, NXCD = 8, WGM = 8;

__host__ __device__ __forceinline__ int lds_byte(int r, int c) { const int st = (r >> 4) * 2 + (c >> 5), rr = r & 15, cc = c & 31, ob = rr * 64 + cc * 2; return st * 1024 + (ob ^ (((ob >> 9) & 1) << 5)); }
__host__ __device__ __forceinline__ void stage_rc(int b, int& R, int& C) { const int st = b / 1024, sb = b % 1024, swz = sb ^ (((sb >> 9) & 1) << 5); R = (st >> 1) * 16 + swz / 64; C = (st & 1) * 32 + (swz % 64) / 2; }
__host__ __device__ __forceinline__ int perm32(int rho) { const int n = rho >> 4, i = rho & 15; return 8 * (i >> 2) + 4 * n + (i & 3); }

struct Unit { int pm, pn; };
struct Gemm { const bf16_t* A; const bf16_t* Bt; int M, N, K, lda, ldb; };

struct StaticOrder {
    int nM, nN, nwg, G, c;
    __host__ __device__ void init(int M, int N, int G_, int c_) { nM = M / BM; nN = N / BM; nwg = nM * nN; G = G_; c = c_; }
    __host__ __device__ bool next(int i, Unit& u) const {
        const long L = (long)i * G + c; if (L >= nwg) return false;
        int wgid = (int)L; { const int q = nwg / NXCD, r = nwg % NXCD, xcd = wgid % NXCD, off = wgid / NXCD; wgid = (xcd < r ? xcd * (q + 1) : r * (q + 1) + (xcd - r) * q) + off; }
        const int nig = WGM * nN, gid = wgid / nig, fm = gid * WGM, gsz = (nM - fm) < WGM ? (nM - fm) : WGM;
        u.pm = fm + ((wgid % nig) % gsz); u.pn = (wgid % nig) / gsz; return true;
    }
    __device__ __forceinline__ void a_ready(const Unit&) const {}
    __device__ __forceinline__ void done(const Unit&) const {}
};

__device__ __forceinline__ unsigned cvt_pk_bf16(float lo, float hi) { unsigned r; asm volatile("v_cvt_pk_bf16_f32 %0, %1, %2" : "=v"(r) : "v"(lo), "v"(hi)); return r; }
__device__ __forceinline__ float sg_(float v) { return 1.f / (1.f + __expf(-v)); }
struct EpiIn {
    static constexpr bool PERM = true, AFTER_DRAIN = false;
    bf16_t *PA, *PM, *PG;
    __device__ __forceinline__ void operator()(const f32x4 (&acc)[2][2][4][2], const Unit& u, int wr, int wc, int fr, int fq) const {
        const int colt = u.pn * BM; bf16_t* base; int ldc, cb;
        if (colt < 768) { base = PA; ldc = 768; cb = colt; } else if (colt < 2816) { base = PM; ldc = 2048; cb = colt - 768; } else { base = PG; ldc = 2048; cb = colt - 2816; }
        const int row0 = u.pm * BM + wr * 64 + fr, col0 = cb + wc * 32 + 8 * fq;
#pragma unroll
        for (int ai = 0; ai < 2; ++ai)
#pragma unroll
            for (int m = 0; m < 4; ++m) { bf16_t* rowp = base + (size_t)(row0 + ai * HALF + m * 16) * ldc + col0;
#pragma unroll
                for (int bj = 0; bj < 2; ++bj) { const f32x4 v0 = acc[ai][bj][m][0], v1 = acc[ai][bj][m][1];
                    u32x4 w; w.x = cvt_pk_bf16(v0[0], v0[1]); w.y = cvt_pk_bf16(v0[2], v0[3]); w.z = cvt_pk_bf16(v1[0], v1[1]); w.w = cvt_pk_bf16(v1[2], v1[3]);
                    *(u32x4*)(rowp + bj * HALF) = w; } }
    }
};
struct EpiMerge {
    static constexpr bool PERM = true, AFTER_DRAIN = false;
    const bf16_t* G; bf16_t* MG; int second;
    __device__ __forceinline__ void operator()(const f32x4 (&acc)[2][2][4][2], const Unit& u, int wr, int wc, int fr, int fq) const {
        const int row0 = u.pm * BM + wr * 64 + fr, col0 = u.pn * BM + wc * 32 + 8 * fq;
#pragma unroll
        for (int ai = 0; ai < 2; ++ai)
#pragma unroll
            for (int m = 0; m < 4; ++m) { const size_t row = (size_t)(row0 + ai * HALF + m * 16);
#pragma unroll
                for (int bj = 0; bj < 2; ++bj) { const f32x4 v0 = acc[ai][bj][m][0], v1 = acc[ai][bj][m][1]; const int col = col0 + bj * HALF;
                    const u32x4 gv = *(const u32x4*)(G + row * 2048 + col);
                    float r[8];
                    r[0] = sg_(__uint_as_float(gv.x << 16)) * v0[0]; r[1] = sg_(__uint_as_float(gv.x & 0xffff0000u)) * v0[1];
                    r[2] = sg_(__uint_as_float(gv.y << 16)) * v0[2]; r[3] = sg_(__uint_as_float(gv.y & 0xffff0000u)) * v0[3];
                    r[4] = sg_(__uint_as_float(gv.z << 16)) * v1[0]; r[5] = sg_(__uint_as_float(gv.z & 0xffff0000u)) * v1[1];
                    r[6] = sg_(__uint_as_float(gv.w << 16)) * v1[2]; r[7] = sg_(__uint_as_float(gv.w & 0xffff0000u)) * v1[3];
                    u32x4* dst = (u32x4*)(MG + row * 1024 + col);
                    if (second) { const u32x4 t = *dst;
                        r[0] += __uint_as_float(t.x << 16); r[1] += __uint_as_float(t.x & 0xffff0000u); r[2] += __uint_as_float(t.y << 16); r[3] += __uint_as_float(t.y & 0xffff0000u);
                        r[4] += __uint_as_float(t.z << 16); r[5] += __uint_as_float(t.z & 0xffff0000u); r[6] += __uint_as_float(t.w << 16); r[7] += __uint_as_float(t.w & 0xffff0000u); }
                    u32x4 w; w.x = cvt_pk_bf16(r[0], r[1]); w.y = cvt_pk_bf16(r[2], r[3]); w.z = cvt_pk_bf16(r[4], r[5]); w.w = cvt_pk_bf16(r[6], r[7]);
                    *dst = w; } }
    }
};
struct EpiOut {
    static constexpr bool PERM = true, AFTER_DRAIN = false;
    const float* x; const float* g1; float* out; int seq;
    __device__ __forceinline__ void operator()(const f32x4 (&acc)[2][2][4][2], const Unit& u, int wr, int wc, int fr, int fq) const {
        const int row0 = u.pm * BM + wr * 64 + fr, col0 = u.pn * BM + wc * 32 + 8 * fq;
        const float* gp = g1 + (u.pm * BM >= seq ? 6144 : 0);
#pragma unroll
        for (int bj = 0; bj < 2; ++bj) { const int col = col0 + bj * HALF; const f32x4 ga = *(const f32x4*)(gp + col), gb = *(const f32x4*)(gp + col + 4);
#pragma unroll
            for (int ai = 0; ai < 2; ++ai)
#pragma unroll
                for (int m = 0; m < 4; ++m) { const size_t off = (size_t)(row0 + ai * HALF + m * 16) * 1024 + col;
                    const f32x4 xa = *(const f32x4*)(x + off), xb = *(const f32x4*)(x + off + 4);
                    *(f32x4*)(out + off) = xa + ga * acc[ai][bj][m][0]; *(f32x4*)(out + off + 4) = xb + gb * acc[ai][bj][m][1]; } }
    }
};

template <class Epi, class Sched, bool ALIGN_EPI = false, bool SP2 = false>
__device__ __forceinline__ void gemm_phase(PG8_LAS unsigned char* lds, const Gemm g, const Sched& S, const Epi& E) {
    const int tid = threadIdx.x, wid = __builtin_amdgcn_readfirstlane(tid >> 6), lane = tid & 63, wr = wid >> 2, wc = wid & 3, fr = lane & 15, fq = lane >> 4;
    const int K = g.K, nt = K / BK;
    unsigned voffA[2], voffB[2];
#pragma unroll
    for (int i = 0; i < 2; ++i) { int R, C; stage_rc(tid * 16 + i * 8192, R, C); const int Rb = Epi::PERM ? ((R & ~31) + perm32(R & 31)) : R;
        voffA[i] = (unsigned)(R * g.lda + C) * 2u; voffB[i] = (unsigned)(Rb * g.ldb + C) * 2u; }
    const size_t kstep = (size_t)(BK * 2);
    const size_t hstepA = (size_t)HALF * g.lda * 2, hstepB = (size_t)HALF * g.ldb * 2;
    const size_t tstepA = 2 * hstepA, tstepB = 2 * hstepB;
    const unsigned ldsw = (unsigned)wid * 1024u;
    const int aoff = lds_byte(wr * 64 + fr, fq * 8), boff = lds_byte(wc * 32 + fr, fq * 8);
#define PG8_SA(b, h) (((b) * 2 + (h)) * HTB)
#define PG8_SB(b, h) ((4 + (b) * 2 + (h)) * HTB)
#define PG8_STAGE(bufoff, gbase, voff) do { _Pragma("unroll") for (int _i = 0; _i < 2; ++_i) \
        __builtin_amdgcn_global_load_lds((const unsigned*)((const char*)(gbase) + (voff)[_i]), (PG8_LAS unsigned*)(lds + (bufoff) + ldsw + _i * 8192), 16, 0, 0); } while (0)
#define PG8_LDA(dst, b, h) do { _Pragma("unroll") for (int m = 0; m < 4; ++m) _Pragma("unroll") for (int k = 0; k < 2; ++k) dst[m][k] = *(const PG8_LAS bf16x8*)(lds + PG8_SA(b, h) + aoff + m * 2048 + k * 1024); } while (0)
#define PG8_LDB(dst, b, h) do { _Pragma("unroll") for (int n = 0; n < 2; ++n) _Pragma("unroll") for (int k = 0; k < 2; ++k) dst[n][k] = *(const PG8_LAS bf16x8*)(lds + PG8_SB(b, h) + boff + n * 2048 + k * 1024); } while (0)
#define PG8_MMA(ai, bj, At, Bt) do { __builtin_amdgcn_s_setprio(1); _Pragma("unroll") for (int m = 0; m < 4; ++m) _Pragma("unroll") for (int n = 0; n < 2; ++n) _Pragma("unroll") for (int k = 0; k < 2; ++k) \
        acc[ai][bj][m][n] = __builtin_amdgcn_mfma_f32_16x16x32_bf16(Bt[n][k], At[m][k], acc[ai][bj][m][n], 0, 0, 0); __builtin_amdgcn_s_setprio(0); } while (0)
#define PG8_WAIT_V(n) asm volatile("s_waitcnt vmcnt(" #n ")" ::: "memory")
#define PG8_WAIT_L(n) asm volatile("s_waitcnt lgkmcnt(" #n ")" ::: "memory")
#define PG8_BAR __builtin_amdgcn_s_barrier()
#define PG8_SCHED __builtin_amdgcn_sched_barrier(0)
    Unit cur, nxt; int ui = 0;
    if (!S.next(0, cur)) return;
    f32x4 acc[2][2][4][2];
#pragma unroll
    for (int a = 0; a < 2; ++a)
#pragma unroll
        for (int b = 0; b < 2; ++b)
#pragma unroll
            for (int m = 0; m < 4; ++m)
#pragma unroll
                for (int n = 0; n < 2; ++n) acc[a][b][m][n] = (f32x4){0.f, 0.f, 0.f, 0.f};
    bf16x8 At[4][2], B0[2][2], B1[2][2];
    const char* cA = (const char*)g.A + (size_t)cur.pm * tstepA; const char* cB = (const char*)g.Bt + (size_t)cur.pn * tstepB;
    S.a_ready(cur);
    if constexpr (SP2) {
        PG8_STAGE(PG8_SB(0, 0), cB, voffB); PG8_STAGE(PG8_SB(0, 1), cB + hstepB, voffB); PG8_STAGE(PG8_SA(0, 0), cA, voffA); PG8_STAGE(PG8_SA(0, 1), cA + hstepA, voffA);
        if (wr == 1) PG8_BAR;
        PG8_WAIT_V(2); PG8_BAR;
        PG8_STAGE(PG8_SB(1, 0), cB + kstep, voffB); PG8_STAGE(PG8_SA(1, 0), cA + kstep, voffA); PG8_STAGE(PG8_SB(1, 1), cB + hstepB + kstep, voffB);
        PG8_WAIT_V(6); PG8_BAR;
    } else {
        PG8_STAGE(PG8_SB(0, 0), cB, voffB); PG8_STAGE(PG8_SA(0, 0), cA, voffA); PG8_STAGE(PG8_SB(0, 1), cB + hstepB, voffB); PG8_STAGE(PG8_SA(0, 1), cA + hstepA, voffA);
        if (wr == 1) PG8_BAR;
        PG8_WAIT_V(4); PG8_BAR;
        PG8_STAGE(PG8_SB(1, 0), cB + kstep, voffB); PG8_STAGE(PG8_SA(1, 0), cA + kstep, voffA); PG8_STAGE(PG8_SB(1, 1), cB + hstepB + kstep, voffB);
        PG8_WAIT_V(6); PG8_BAR;
    }
    for (;;) {
        const bool has_next = S.next(ui + 1, nxt);
        const char* nA = has_next ? (const char*)g.A + (size_t)nxt.pm * tstepA : cA; const char* nB = has_next ? (const char*)g.Bt + (size_t)nxt.pn * tstepB : cB;
        for (int t = 0; t < nt; t += 2) {
            const bool last = (t == nt - 2);
            const char* a1 = cA + (size_t)(t + 1) * kstep;
            const char* a2 = last ? nA : cA + (size_t)(t + 2) * kstep; const char* b2 = last ? nB : cB + (size_t)(t + 2) * kstep;
            const char* a3 = a2 + kstep; const char* b3 = b2 + kstep;
            if (last && has_next) S.a_ready(nxt);
            if constexpr (SP2) {
            PG8_LDB(B0, 0, 0); PG8_LDB(B1, 0, 1); PG8_SCHED; PG8_LDA(At, 0, 0); PG8_STAGE(PG8_SA(1, 1), a1 + hstepA, voffA);
            PG8_WAIT_V(8); PG8_WAIT_L(0); PG8_BAR; PG8_MMA(0, 0, At, B0); PG8_MMA(0, 1, At, B1); PG8_BAR; PG8_SCHED;
            PG8_LDA(At, 0, 1); PG8_STAGE(PG8_SB(0, 0), b2, voffB); PG8_STAGE(PG8_SB(0, 1), b2 + hstepB, voffB); PG8_STAGE(PG8_SA(0, 0), a2, voffA);
            PG8_WAIT_V(8); PG8_WAIT_L(0); PG8_BAR; PG8_MMA(1, 0, At, B0); PG8_MMA(1, 1, At, B1); PG8_BAR; PG8_SCHED;
            PG8_LDB(B0, 1, 0); PG8_LDB(B1, 1, 1); PG8_SCHED; PG8_LDA(At, 1, 0); PG8_STAGE(PG8_SA(0, 1), a2 + hstepA, voffA);
            PG8_WAIT_V(8); PG8_WAIT_L(0); PG8_BAR; PG8_MMA(0, 0, At, B0); PG8_MMA(0, 1, At, B1); PG8_BAR; PG8_SCHED;
            PG8_LDA(At, 1, 1); PG8_STAGE(PG8_SB(1, 0), b3, voffB); PG8_STAGE(PG8_SB(1, 1), b3 + hstepB, voffB); PG8_STAGE(PG8_SA(1, 0), a3, voffA);
            PG8_WAIT_V(8); PG8_WAIT_L(0); PG8_BAR; PG8_MMA(1, 0, At, B0); PG8_MMA(1, 1, At, B1); PG8_BAR; PG8_SCHED;
            } else {
            PG8_LDB(B0, 0, 0); PG8_SCHED; PG8_LDA(At, 0, 0); PG8_STAGE(PG8_SA(1, 1), a1 + hstepA, voffA);
            PG8_WAIT_L(8); PG8_BAR; PG8_WAIT_L(0); PG8_MMA(0, 0, At, B0); PG8_BAR; PG8_SCHED;
            PG8_LDB(B1, 0, 1); PG8_STAGE(PG8_SB(0, 0), b2, voffB);
            PG8_BAR; PG8_WAIT_L(0); PG8_MMA(0, 1, At, B1); PG8_BAR;
            PG8_LDA(At, 0, 1); PG8_STAGE(PG8_SA(0, 0), a2, voffA);
            PG8_BAR; PG8_WAIT_L(0); PG8_MMA(1, 0, At, B0); PG8_BAR; PG8_SCHED;
            PG8_STAGE(PG8_SB(0, 1), b2 + hstepB, voffB);
            PG8_WAIT_V(6); PG8_BAR; PG8_MMA(1, 1, At, B1); PG8_BAR;
            PG8_LDB(B0, 1, 0); PG8_SCHED; PG8_LDA(At, 1, 0); PG8_STAGE(PG8_SA(0, 1), a2 + hstepA, voffA);
            PG8_WAIT_L(8); PG8_BAR; PG8_WAIT_L(0); PG8_MMA(0, 0, At, B0); PG8_BAR; PG8_SCHED;
            PG8_LDB(B1, 1, 1); PG8_STAGE(PG8_SB(1, 0), b3, voffB);
            PG8_BAR; PG8_WAIT_L(0); PG8_MMA(0, 1, At, B1); PG8_BAR;
            PG8_LDA(At, 1, 1); PG8_STAGE(PG8_SA(1, 0), a3, voffA);
            PG8_BAR; PG8_WAIT_L(0); PG8_MMA(1, 0, At, B0); PG8_BAR; PG8_SCHED;
            PG8_STAGE(PG8_SB(1, 1), b3 + hstepB, voffB);
            PG8_WAIT_V(6); PG8_BAR; PG8_MMA(1, 1, At, B1); PG8_BAR;
            }
        }
        if constexpr (ALIGN_EPI) { if (wr == 0) PG8_BAR; }
        if constexpr (!Epi::AFTER_DRAIN) { E(acc, cur, wr, wc, fr, fq); S.done(cur); }
        if (!has_next) break;
#pragma unroll
        for (int a = 0; a < 2; ++a)
#pragma unroll
            for (int b = 0; b < 2; ++b)
#pragma unroll
                for (int m = 0; m < 4; ++m)
#pragma unroll
                    for (int n = 0; n < 2; ++n) acc[a][b][m][n] = (f32x4){0.f, 0.f, 0.f, 0.f};
        cur = nxt; cA = nA; cB = nB; ++ui;
        if constexpr (ALIGN_EPI) { if (wr == 1) PG8_BAR; }
    }
    PG8_WAIT_V(0);
    if constexpr (!ALIGN_EPI) { if (wr == 0) PG8_BAR; }
    PG8_BAR;
    if constexpr (Epi::AFTER_DRAIN) { E.fused(acc, cur, wr, wc, fr, fq, lds, wid, lane); S.done(cur); }
#undef PG8_SA
#undef PG8_SB
#undef PG8_STAGE
#undef PG8_LDA
#undef PG8_LDB
#undef PG8_MMA
#undef PG8_WAIT_V
#undef PG8_WAIT_L
#undef PG8_BAR
#undef PG8_SCHED
}
}

struct GemmOp { const bf16_t* A; int lda; const bf16_t* Bt; int ldb; int K; };

DEV void gemm_tile(f32x4 (&acc)[4][2], const GemmOp& g, int m0, int n0, char* lds) {
    const int tid = threadIdx.x, lane = tid & 63, wid = __builtin_amdgcn_readfirstlane(tid >> 6), wm = wid >> 2, wn = wid & 3, fr = lane & 15, fq = lane >> 4;
    const int sr = tid >> 3, sc = tid & 7;
    const bf16_t* ga = g.A + (size_t)(m0 + sr) * g.lda + sc * 8;
    const bf16_t* gb = g.Bt + (size_t)(n0 + sr) * g.ldb + sc * 8;
    const size_t a64 = (size_t)64 * g.lda, b64 = (size_t)64 * g.ldb;
    const int so = sr * 128 + ((sc ^ (sr & 7)) << 4);
    const int nk = g.K >> 6;
    u32x4 ra0 = *(const u32x4*)ga, ra1 = *(const u32x4*)(ga + a64), rb0 = *(const u32x4*)gb, rb1 = *(const u32x4*)(gb + b64);
    *(u32x4*)(lds + so) = ra0; *(u32x4*)(lds + so + 8192) = ra1; *(u32x4*)(lds + 32768 + so) = rb0; *(u32x4*)(lds + 32768 + so + 8192) = rb1;
    __syncthreads();
    const int aoff = (wm * 64 + fr) * 128, boff = 32768 + (wn * 32 + fr) * 128, sw = fr & 7;
    for (int kt = 0; kt < nk; ++kt) {
        const int cur = (kt & 1) * 16384;
        if (kt + 1 < nk) { ga += 64; gb += 64; ra0 = *(const u32x4*)ga; ra1 = *(const u32x4*)(ga + a64); rb0 = *(const u32x4*)gb; rb1 = *(const u32x4*)(gb + b64); }
#pragma unroll
        for (int ks = 0; ks < 2; ++ks) {
            const int ch = ((fq + 4 * ks) ^ sw) << 4;
            bf16x8 af[4], bfr[2];
#pragma unroll
            for (int mi = 0; mi < 4; ++mi) af[mi] = *(const bf16x8*)(lds + cur + aoff + mi * 2048 + ch);
#pragma unroll
            for (int ni = 0; ni < 2; ++ni) bfr[ni] = *(const bf16x8*)(lds + cur + boff + ni * 2048 + ch);
#pragma unroll
            for (int mi = 0; mi < 4; ++mi)
#pragma unroll
                for (int ni = 0; ni < 2; ++ni) acc[mi][ni] = mfma16(bfr[ni], af[mi], acc[mi][ni]);
        }
        if (kt + 1 < nk) {
            const int nxt = cur ^ 16384;
            *(u32x4*)(lds + nxt + so) = ra0; *(u32x4*)(lds + nxt + so + 8192) = ra1; *(u32x4*)(lds + 32768 + nxt + so) = rb0; *(u32x4*)(lds + 32768 + nxt + so + 8192) = rb1;
        }
        __syncthreads();
    }
}
#define GEMM_EPI_LOOP(...) { const int tid_ = threadIdx.x, lane_ = tid_ & 63, wid_ = tid_ >> 6, wm_ = wid_ >> 2, wn_ = wid_ & 3, fr_ = lane_ & 15, fq_ = lane_ >> 4; \
    _Pragma("unroll") for (int mi = 0; mi < 4; ++mi) _Pragma("unroll") for (int ni = 0; ni < 2; ++ni) { const int m = m0 + wm_ * 64 + mi * 16 + fr_, n = n0 + wn_ * 32 + ni * 16 + fq_ * 4; __VA_ARGS__ } }

DEV void stage_gemm_in(const Params& p, char* lds, int vb, int nvb) {
    pg8::Gemm g{(const bf16_t*)(p.ws + WS_UB), (const bf16_t*)(p.ws + WS_WIN), M, 4864, 1024, 1024, 1024};
    pg8::StaticOrder S; S.init(M, 4864, nvb, vb);
    pg8::EpiIn E{(bf16_t*)(p.ws + WS_PA), (bf16_t*)(p.ws + WS_PM), (bf16_t*)(p.ws + WS_PG)};
    pg8::gemm_phase<pg8::EpiIn, pg8::StaticOrder, true, true>((PG8_LAS unsigned char*)lds, g, S, E);
}
DEV void stage_gemm_merge(const Params& p, char* lds, int vb, int nvb) {
    const bf16_t* PG = (const bf16_t*)(p.ws + WS_PG); bf16_t* MG = (bf16_t*)(p.ws + WS_UB);
    {
        pg8::Gemm g{(const bf16_t*)(p.ws + WS_PA), (const bf16_t*)(p.ws + WS_WA), M, 1024, 512, LPA, 512};
        pg8::StaticOrder S; S.init(M, 1024, nvb, vb);
        pg8::EpiMerge E{PG, MG, 0};
        pg8::gemm_phase<pg8::EpiMerge, pg8::StaticOrder, true, true>((PG8_LAS unsigned char*)lds, g, S, E);
    }
    {
        pg8::Gemm g{(const bf16_t*)(p.ws + WS_PM) + 1536, (const bf16_t*)(p.ws + WS_WB), M, 1024, 512, LPM, 512};
        pg8::StaticOrder S; S.init(M, 1024, nvb, vb);
        pg8::EpiMerge E{PG + 1024, MG, 1};
        pg8::gemm_phase<pg8::EpiMerge, pg8::StaticOrder, true, true>((PG8_LAS unsigned char*)lds, g, S, E);
    }
}
DEV void stage_gemm_out(const Params& p, char* lds, int vb, int nvb) {
    pg8::Gemm g{(const bf16_t*)(p.ws + WS_UB), (const bf16_t*)(p.ws + WS_WOUT), M, 1024, 1024, 1024, 1024};
    pg8::StaticOrder S; S.init(M, 1024, nvb, vb);
    pg8::EpiOut E{p.x, (const float*)(p.ws + WS_MOD) + 2048, p.out, SEQ};
    pg8::gemm_phase<pg8::EpiOut, pg8::StaticOrder, true, true>((PG8_LAS unsigned char*)lds, g, S, E);
}

DEV void rope8(u32x4 x1, u32x4 x2, const float4* rp, float scale, u32x4& o1, u32x4& o2) {
#pragma unroll
    for (int w = 0; w < 4; ++w) {
        const float4 cs = rp[w];
        const float a0 = bflo(x1[w]), a1 = bfhi(x1[w]), b0 = bflo(x2[w]), b1 = bfhi(x2[w]);
        o1[w] = pk2((a0 * cs.x - b0 * cs.y) * scale, (a1 * cs.z - b1 * cs.w) * scale);
        o2[w] = pk2((b0 * cs.x + a0 * cs.y) * scale, (b1 * cs.z + a1 * cs.w) * scale);
    }
}

DEV void stage_attn(const Params& p, char* lds, int vb, int nvb) {
    const int tid = threadIdx.x, lane = tid & 63, wave = __builtin_amdgcn_readfirstlane(tid >> 6), fr = lane & 15, fq = lane >> 4;
    char* Ks = lds;
    char* VT = lds + 32768;
    char* Qs = lds + 70656;
    char* Ps = lds + 87040;
    bf16_t* PA = (bf16_t*)(p.ws + WS_PA);
    const float2* rope = (const float2*)(p.ws + WS_ROPE);
    for (int unit = vb; unit < 512; unit += nvb) {
        const int kvh = unit & 1, n = (unit >> 1) & 127, b = unit >> 8;
        __syncthreads();
        for (int task = tid; task < 1024; task += NTH) {
            const int ki = task >> 2, cp = task & 3, pos = 128 * (n - 1) + ki;
            u32x4 o1 = {0u, 0u, 0u, 0u}, o2 = {0u, 0u, 0u, 0u};
            if (pos >= 0) {
                const bf16_t* src = PA + (size_t)(b * SEQ + pos) * LPA + 512 + kvh * 64 + cp * 8;
                const u32x4 x1 = *(const u32x4*)src, x2 = *(const u32x4*)(src + 32);
                rope8(x1, x2, (const float4*)(rope + (size_t)pos * 32 + cp * 8), 1.0f, o1, o2);
            }
            const int sw = ki & 7;
            *(u32x4*)(Ks + ki * 128 + ((cp ^ sw) << 4)) = o1;
            *(u32x4*)(Ks + ki * 128 + (((cp + 4) ^ sw) << 4)) = o2;
        }
        for (int task = tid; task < 2048; task += NTH) {
            const int ki = task >> 3, c = task & 7, pos = 128 * (n - 1) + ki;
            u32x4 x = {0u, 0u, 0u, 0u};
            if (pos >= 0) x = *(const u32x4*)(PA + (size_t)(b * SEQ + pos) * LPA + 640 + kvh * 64 + c * 8);
#pragma unroll
            for (int e = 0; e < 8; ++e) *(bf16_t*)(VT + (c * 8 + e) * 592 + ki * 2) = (bf16_t)((e & 1) ? (x[e >> 1] >> 16) : (x[e >> 1] & 0xffffu));
        }
        for (int i = tid; i < 64 * 40; i += NTH) { const int d = i / 40, kk = 256 + i % 40; *(bf16_t*)(VT + d * 592 + kk * 2) = 0; }
        for (int i = tid; i < 2048; i += NTH) { const int w = i >> 8, r = (i >> 4) & 15, kk = 144 + (i & 15); *(bf16_t*)(Ps + w * 5376 + r * 336 + kk * 2) = 0; }
        for (int j = 0; j < 4; ++j) {
            const int hq = kvh * 4 + j;
            {
                const int qi = tid >> 2, cp = tid & 3, pos = 128 * n + qi;
                const bf16_t* src = PA + (size_t)(b * SEQ + pos) * LPA + hq * 64 + cp * 8;
                const u32x4 x1 = *(const u32x4*)src, x2 = *(const u32x4*)(src + 32);
                u32x4 o1, o2;
                rope8(x1, x2, (const float4*)(rope + (size_t)pos * 32 + cp * 8), 0.125f, o1, o2);
                const int sw = qi & 7;
                *(u32x4*)(Qs + qi * 128 + ((cp ^ sw) << 4)) = o1;
                *(u32x4*)(Qs + qi * 128 + (((cp + 4) ^ sw) << 4)) = o2;
            }
            __syncthreads();
            f32x4 s[9];
            const int sw = fr & 7;
            bf16x8 qf[2];
#pragma unroll
            for (int ks = 0; ks < 2; ++ks) qf[ks] = *(const bf16x8*)(Qs + (16 * wave + fr) * 128 + (((fq + 4 * ks) ^ sw) << 4));
#pragma unroll
            for (int t = 0; t < 9; ++t) {
                s[t] = (f32x4){0.f, 0.f, 0.f, 0.f};
#pragma unroll
                for (int ks = 0; ks < 2; ++ks) { const bf16x8 kf = *(const bf16x8*)(Ks + (16 * (wave + t) + fr) * 128 + (((fq + 4 * ks) ^ sw) << 4)); s[t] = mfma16(kf, qf[ks], s[t]); }
            }
            const float sink = p.sinks[hq];
            float mx = sink;
#pragma unroll
            for (int t = 0; t < 9; ++t)
#pragma unroll
                for (int r = 0; r < 4; ++r) {
                    const int dd = 16 * t + 4 * fq + r - fr, ki = 16 * (wave + t) + 4 * fq + r;
                    const bool ok = (dd >= 1) && (dd <= 128) && (n > 0 || ki >= 128);
                    const float v = ok ? s[t][r] : -INFINITY;
                    s[t][r] = v; mx = fmaxf(mx, v);
                }
            mx = fmaxf(mx, __shfl_xor(mx, 16)); mx = fmaxf(mx, __shfl_xor(mx, 32));
            float sum = 0.f;
#pragma unroll
            for (int t = 0; t < 9; ++t)
#pragma unroll
                for (int r = 0; r < 4; ++r) { const float pv = __expf(s[t][r] - mx); s[t][r] = pv; sum += pv; }
            sum += __shfl_xor(sum, 16); sum += __shfl_xor(sum, 32);
            const float inv = 1.f / (sum + __expf(sink - mx));
            char* Pw = Ps + wave * 5376 + fr * 336;
#pragma unroll
            for (int t = 0; t < 9; ++t) { u32x2 o; o.x = pk2(s[t][0], s[t][1]); o.y = pk2(s[t][2], s[t][3]); *(u32x2*)(Pw + (16 * t + 4 * fq) * 2) = o; }
            __syncthreads();
            f32x4 o[4];
#pragma unroll
            for (int di = 0; di < 4; ++di) o[di] = (f32x4){0.f, 0.f, 0.f, 0.f};
#pragma unroll
            for (int ks = 0; ks < 5; ++ks) {
                const bf16x8 pf = *(const bf16x8*)(Pw + (32 * ks + 8 * fq) * 2);
#pragma unroll
                for (int di = 0; di < 4; ++di) { const bf16x8 vf = *(const bf16x8*)(VT + (16 * di + fr) * 592 + (16 * wave + 32 * ks + 8 * fq) * 2); o[di] = mfma16(vf, pf, o[di]); }
            }
            bf16_t* dst = PA + (size_t)(b * SEQ + 128 * n + 16 * wave + fr) * LPA + hq * 64 + 4 * fq;
#pragma unroll
            for (int di = 0; di < 4; ++di) { u32x2 w; w.x = pk2(o[di][0] * inv, o[di][1] * inv); w.y = pk2(o[di][2] * inv, o[di][3] * inv); *(u32x2*)(dst + 16 * di) = w; }
            __syncthreads();
        }
    }
}

DEV float logsigf(float x) { return fminf(x, 0.f) - log1pf(expf(-fabsf(x))); }

DEV void chunk_gates(const float* ipre, const float* fpre, int rowbase, int h, float* gs, int lane) {
    const int l0 = 2 * lane;
    const float i0 = ipre[(size_t)(rowbase + l0) * 4 + h], i1 = ipre[(size_t)(rowbase + l0 + 1) * 4 + h];
    const float lf0 = logsigf(fpre[(size_t)(rowbase + l0) * 4 + h]), lf1 = logsigf(fpre[(size_t)(rowbase + l0 + 1) * 4 + h]);
    const float pair = lf0 + lf1;
    float sc = pair;
#pragma unroll
    for (int o = 1; o < 64; o <<= 1) { const float t = __shfl_up(sc, o); if (lane >= o) sc += t; }
    const float b0 = (sc - pair) + lf0, b1 = b0 + lf1;
    const float g = __shfl(sc, 63);
    const float a0 = g - b0 + i0, a1 = g - b1 + i1;
    const float mloc = wave_max(fmaxf(a0, a1));
    const float ib0 = i0 - b0, ib1 = i1 - b1;
    float scm = fmaxf(ib0, ib1);
#pragma unroll
    for (int o = 1; o < 64; o <<= 1) { const float t = __shfl_up(scm, o); if (lane >= o) scm = fmaxf(scm, t); }
    float ex = __shfl_up(scm, 1); if (lane == 0) ex = -INFINITY;
    const float pm0 = fmaxf(ex, ib0), pm1 = fmaxf(pm0, ib1);
    gs[l0] = b0; gs[l0 + 1] = b1; gs[128 + l0] = ib0; gs[128 + l0 + 1] = ib1; gs[256 + l0] = a0; gs[256 + l0 + 1] = a1; gs[384 + l0] = pm0; gs[384 + l0 + 1] = pm1;
    if (lane == 0) { gs[512] = g; gs[513] = mloc; }
}

DEV void conv8(const bf16_t* PM, const float* cw, int b, int t, int pmcol, int cch, float (&out)[8]) {
#pragma unroll
    for (int e = 0; e < 8; ++e) out[e] = 0.f;
#pragma unroll
    for (int j = 0; j < 4; ++j) {
        const int tt = t - 3 + j;
        if (tt >= 0) {
            const u32x4 x = *(const u32x4*)(PM + (size_t)(b * SEQ + tt) * LPM + pmcol);
            const float4 w0 = *(const float4*)(cw + j * 1024 + cch), w1 = *(const float4*)(cw + j * 1024 + cch + 4);
            out[0] += bflo(x[0]) * w0.x; out[1] += bfhi(x[0]) * w0.y; out[2] += bflo(x[1]) * w0.z; out[3] += bfhi(x[1]) * w0.w;
            out[4] += bflo(x[2]) * w1.x; out[5] += bfhi(x[2]) * w1.y; out[6] += bflo(x[3]) * w1.z; out[7] += bfhi(x[3]) * w1.w;
        }
    }
}
DEV float siluf_(float y) { return y / (1.f + __expf(-y)); }

DEV void stage_mstate(const Params& p, char* lds, int vb, int nvb) {
    const int tid = threadIdx.x, lane = tid & 63, wave = __builtin_amdgcn_readfirstlane(tid >> 6), fr = lane & 15, fq = lane >> 4;
    char* KT = lds;
    char* VT = lds + 34816;
    float* gs = (float*)(lds + 69632);
    const bf16_t* PM = (const bf16_t*)(p.ws + WS_PM);
    const float* ipre = (const float*)(p.ws + WS_IPRE); const float* fpre = (const float*)(p.ws + WS_FPRE);
    float* UT = (float*)(p.ws + WS_UB); float* NLOC = (float*)(p.ws + WS_NLOC);
    float* G = (float*)(p.ws + WS_CHG); float* MLOC = G + 1024;
    for (int unit = vb; unit < 1024; unit += nvb) {
        const int c = unit & 127, h = (unit >> 7) & 3, b = unit >> 9;
        const int rowbase = b * SEQ + c * 128;
        __syncthreads();
        if (wave == 0) chunk_gates(ipre, fpre, rowbase, h, gs, lane);
        __syncthreads();
        const float mloc = gs[513];
        for (int task = tid; task < 2048; task += NTH) {
            const int l = task >> 4, ch = task & 15;
            float v8[8]; conv8(PM, p.conv_w, b, c * 128 + l, 512 + h * 128 + ch * 8, 512 + h * 128 + ch * 8, v8);
            const float wgt = __expf(gs[256 + l] - mloc) * 0.08838834764831845f;
#pragma unroll
            for (int e = 0; e < 8; ++e) *(bf16_t*)(KT + (ch * 8 + e) * 272 + l * 2) = (bf16_t)f2bf(siluf_(v8[e]) * wgt);
        }
        for (int task = tid; task < 2048; task += NTH) {
            const int l = task >> 4, ch = task & 15;
            const u32x4 x = *(const u32x4*)(PM + (size_t)(rowbase + l) * LPM + 1024 + h * 128 + ch * 8);
#pragma unroll
            for (int e = 0; e < 8; ++e) *(bf16_t*)(VT + (ch * 8 + e) * 272 + l * 2) = (bf16_t)((e & 1) ? (x[e >> 1] >> 16) : (x[e >> 1] & 0xffffu));
        }
        __syncthreads();
        f32x4 acc[8];
#pragma unroll
        for (int t = 0; t < 8; ++t) acc[t] = (f32x4){0.f, 0.f, 0.f, 0.f};
#pragma unroll
        for (int ks = 0; ks < 4; ++ks) {
            const bf16x8 vf = *(const bf16x8*)(VT + (16 * wave + fr) * 272 + (32 * ks + 8 * fq) * 2);
#pragma unroll
            for (int t = 0; t < 8; ++t) { const bf16x8 kf = *(const bf16x8*)(KT + (16 * t + fr) * 272 + (32 * ks + 8 * fq) * 2); acc[t] = mfma16(kf, vf, acc[t]); }
        }
        float* UTu = UT + (size_t)unit * 16384 + (16 * wave + fr) * 128 + 4 * fq;
#pragma unroll
        for (int t = 0; t < 8; ++t) *(f32x4*)(UTu + 16 * t) = acc[t];
        if (tid < 128) { float s = 0.f; for (int l = 0; l < 128; ++l) s += bf2f(*(const bf16_t*)(KT + tid * 272 + l * 2)); NLOC[unit * 128 + tid] = s; }
        if (tid == 0) { G[unit] = gs[512]; MLOC[unit] = mloc; }
    }
}

DEV void stage_mscan(const Params& p, char* lds, int vb, int nvb) {
    const int tid = threadIdx.x;
    float* s_dec = (float*)lds; float* s_scl = s_dec + 128;
    const float* UT = (const float*)(p.ws + WS_UB); const float* NLOC = (const float*)(p.ws + WS_NLOC);
    const float* G = (const float*)(p.ws + WS_CHG); const float* MLOC = G + 1024; float* MST = (float*)(p.ws + WS_CHG) + 2048;
    bf16_t* CST = (bf16_t*)(p.ws + WS_CST); float* NST = (float*)(p.ws + WS_NST);
    for (int item = vb; item < 256; item += nvb) {
        const int bh = item >> 5, part = item & 31;
        __syncthreads();
        if (tid == 0) {
            float m = 0.f;
            for (int c = 0; c < 128; ++c) { const int u = bh * 128 + c; const float g = G[u], ml = MLOC[u]; const float mn = fmaxf(g + m, ml); s_dec[c] = expf(g + m - mn); s_scl[c] = expf(ml - mn); if (part == 0) MST[u] = m; m = mn; }
        }
        __syncthreads();
        const int e = part * 512 + tid;
        float C = 0.f;
        const float* up = UT + (size_t)bh * 128 * 16384 + e; bf16_t* cp = CST + (size_t)bh * 128 * 16384 + e;
        for (int c = 0; c < 128; c += 8) {
            float uu[8];
#pragma unroll
            for (int i = 0; i < 8; ++i) uu[i] = up[(size_t)(c + i) * 16384];
#pragma unroll
            for (int i = 0; i < 8; ++i) { cp[(size_t)(c + i) * 16384] = (bf16_t)f2bf(C); C = s_dec[c + i] * C + s_scl[c + i] * uu[i]; }
        }
        if (part == 0 && tid < 128) { float nn = 0.f; for (int c = 0; c < 128; ++c) { NST[(bh * 128 + c) * 128 + tid] = nn; nn = s_dec[c] * nn + s_scl[c] * NLOC[(bh * 128 + c) * 128 + tid]; } }
    }
}

DEV void stage_mout(const Params& p, char* lds, int vb, int nvb) {
    const int tid = threadIdx.x, lane = tid & 63, wave = __builtin_amdgcn_readfirstlane(tid >> 6), fr = lane & 15, fq = lane >> 4;
    char* Qs = lds; char* Ks = lds + 34816; char* VT = lds + 69632; char* CT = lds + 104448;
    float* gs = (float*)(lds + 139264); float* s_nst = gs + 520; float* s_mo = gs + 648; float* s_wi = gs + 776;
    bf16_t* PM = (bf16_t*)(p.ws + WS_PM);
    const float* ipre = (const float*)(p.ws + WS_IPRE); const float* fpre = (const float*)(p.ws + WS_FPRE);
    const float* MST = (const float*)(p.ws + WS_CHG) + 2048; const float* NST = (const float*)(p.ws + WS_NST);
    const bf16_t* CST = (const bf16_t*)(p.ws + WS_CST);
    for (int unit = vb; unit < 1024; unit += nvb) {
        const int c = unit & 127, h = (unit >> 7) & 3, b = unit >> 9;
        const int rowbase = b * SEQ + c * 128;
        __syncthreads();
        if (wave == 0) chunk_gates(ipre, fpre, rowbase, h, gs, lane);
        for (int task = tid; task < 2048; task += NTH) {
            const int l = task >> 4, ch = task & 15;
            float v8[8]; u32x4 o;
            conv8(PM, p.conv_w, b, c * 128 + l, h * 128 + ch * 8, h * 128 + ch * 8, v8);
            o.x = pk2(siluf_(v8[0]), siluf_(v8[1])); o.y = pk2(siluf_(v8[2]), siluf_(v8[3])); o.z = pk2(siluf_(v8[4]), siluf_(v8[5])); o.w = pk2(siluf_(v8[6]), siluf_(v8[7]));
            *(u32x4*)(Qs + l * 272 + ch * 16) = o;
            conv8(PM, p.conv_w, b, c * 128 + l, 512 + h * 128 + ch * 8, 512 + h * 128 + ch * 8, v8);
            const float sc = 0.08838834764831845f;
            o.x = pk2(siluf_(v8[0]) * sc, siluf_(v8[1]) * sc); o.y = pk2(siluf_(v8[2]) * sc, siluf_(v8[3]) * sc); o.z = pk2(siluf_(v8[4]) * sc, siluf_(v8[5]) * sc); o.w = pk2(siluf_(v8[6]) * sc, siluf_(v8[7]) * sc);
            *(u32x4*)(Ks + l * 272 + ch * 16) = o;
            const u32x4 x = *(const u32x4*)(PM + (size_t)(rowbase + l) * LPM + 1024 + h * 128 + ch * 8);
#pragma unroll
            for (int e = 0; e < 8; ++e) *(bf16_t*)(VT + (ch * 8 + e) * 272 + l * 2) = (bf16_t)((e & 1) ? (x[e >> 1] >> 16) : (x[e >> 1] & 0xffffu));
            *(u32x4*)(CT + l * 272 + ch * 16) = *(const u32x4*)(CST + (size_t)unit * 16384 + l * 128 + ch * 8);
        }
        if (tid < 128) s_nst[tid] = NST[unit * 128 + tid];
        __syncthreads();
        if (tid < 128) { const float mst = MST[unit]; const float bc = gs[tid]; const float mo = bc + fmaxf(mst, gs[384 + tid]); s_mo[tid] = mo; s_wi[tid] = __expf(bc + mst - mo); }
        __syncthreads();
        const int l = 16 * wave + fr;
        f32x4 s[8];
        bf16x8 qf[4];
#pragma unroll
        for (int ks = 0; ks < 4; ++ks) qf[ks] = *(const bf16x8*)(Qs + l * 272 + (32 * ks + 8 * fq) * 2);
#pragma unroll
        for (int t = 0; t < 8; ++t) {
            s[t] = (f32x4){0.f, 0.f, 0.f, 0.f};
            if (t <= wave) {
#pragma unroll
                for (int ks = 0; ks < 4; ++ks) { const bf16x8 kf = *(const bf16x8*)(Ks + (16 * t + fr) * 272 + (32 * ks + 8 * fq) * 2); s[t] = mfma16(kf, qf[ks], s[t]); }
            }
        }
        const float bl = gs[l], mol = s_mo[l];
        float dsum = 0.f;
#pragma unroll
        for (int t = 0; t < 8; ++t)
#pragma unroll
            for (int r = 0; r < 4; ++r) {
                const int si = 16 * t + 4 * fq + r; float wv = 0.f;
                if (t <= wave && si <= l) wv = __expf(bl + gs[128 + si] - mol) * s[t][r];
                s[t][r] = wv; dsum += wv;
            }
        dsum += __shfl_xor(dsum, 16); dsum += __shfl_xor(dsum, 32);
        float qn = 0.f;
        {
            const char* qrow = Qs + l * 272 + fq * 64;
#pragma unroll
            for (int i = 0; i < 4; ++i) {
                const u32x4 x = *(const u32x4*)(qrow + 16 * i); const float* nn = s_nst + fq * 32 + 8 * i;
                qn += bflo(x[0]) * nn[0] + bfhi(x[0]) * nn[1] + bflo(x[1]) * nn[2] + bfhi(x[1]) * nn[3] + bflo(x[2]) * nn[4] + bfhi(x[2]) * nn[5] + bflo(x[3]) * nn[6] + bfhi(x[3]) * nn[7];
            }
        }
        qn += __shfl_xor(qn, 16); qn += __shfl_xor(qn, 32);
        __syncthreads();
#pragma unroll
        for (int t = 0; t < 8; ++t)
            if (t <= wave + 1) { u32x2 o; o.x = pk2(s[t][0], s[t][1]); o.y = pk2(s[t][2], s[t][3]); *(u32x2*)(Ks + l * 272 + (16 * t + 4 * fq) * 2) = o; }
        __syncthreads();
        f32x4 acc[8];
#pragma unroll
        for (int t = 0; t < 8; ++t) acc[t] = (f32x4){0.f, 0.f, 0.f, 0.f};
#pragma unroll
        for (int ks = 0; ks < 4; ++ks)
#pragma unroll
            for (int t = 0; t < 8; ++t) { const bf16x8 cf = *(const bf16x8*)(CT + (16 * t + fr) * 272 + (32 * ks + 8 * fq) * 2); acc[t] = mfma16(cf, qf[ks], acc[t]); }
        const float wi = s_wi[l];
#pragma unroll
        for (int t = 0; t < 8; ++t) acc[t] = acc[t] * wi;
        const int nks = (wave + 2) >> 1;
#pragma unroll
        for (int ks = 0; ks < 4; ++ks)
            if (ks < nks) {
                const bf16x8 wf = *(const bf16x8*)(Ks + l * 272 + (32 * ks + 8 * fq) * 2);
#pragma unroll
                for (int t = 0; t < 8; ++t) { const bf16x8 vf = *(const bf16x8*)(VT + (16 * t + fr) * 272 + (32 * ks + 8 * fq) * 2); acc[t] = mfma16(vf, wf, acc[t]); }
            }
        const float den = dsum + wi * qn;
        const float invd = 1.f / fmaxf(fabsf(den), __expf(-mol));
        bf16_t* mop = PM + (size_t)(rowbase + l) * LPM + 1536 + h * 128 + 4 * fq;
        float ssq = 0.f;
#pragma unroll
        for (int t = 0; t < 8; ++t) {
            const u32x2 g2 = *(const u32x2*)(mop + 16 * t);
            const float gg[4] = {bflo(g2.x), bfhi(g2.x), bflo(g2.y), bfhi(g2.y)};
#pragma unroll
            for (int r = 0; r < 4; ++r) { const float hv = acc[t][r] * invd * sigmoidf_(gg[r]); acc[t][r] = hv; ssq += hv * hv; }
        }
        ssq += __shfl_xor(ssq, 16); ssq += __shfl_xor(ssq, 32);
        const float rn = rsqrtf(ssq * (1.f / 128.f) + 1e-6f);
#pragma unroll
        for (int t = 0; t < 8; ++t) {
            const float4 nw = *(const float4*)(p.mnorm_w + h * 128 + 16 * t + 4 * fq);
            u32x2 o; o.x = pk2(acc[t][0] * rn * nw.x, acc[t][1] * rn * nw.y); o.y = pk2(acc[t][2] * rn * nw.z, acc[t][3] * rn * nw.w);
            *(u32x2*)(mop + 16 * t) = o;
        }
    }
}

DEV void stage_norm2(const Params& p, char* lds, int vb, int nvb) {
    const int tid = threadIdx.x, lane = tid & 63, wave = __builtin_amdgcn_readfirstlane(tid >> 6);
    const float* mod = (const float*)(p.ws + WS_MOD);
    bf16_t* U2 = (bf16_t*)(p.ws + WS_PG);
    for (int m = vb * NW + wave; m < M; m += nvb * NW) {
        const int b = m >= SEQ ? 1 : 0;
        const float4* xr = (const float4*)(p.out + (size_t)m * D);
        float4 v[4]; float ss = 0.f;
#pragma unroll
        for (int j = 0; j < 4; ++j) { v[j] = xr[lane + 64 * j]; ss += v[j].x * v[j].x + v[j].y * v[j].y + v[j].z * v[j].z + v[j].w * v[j].w; }
        ss = wave_sum(ss);
        const float rstd = rsqrtf(ss * (1.f / 1024.f) + 1e-6f);
#pragma unroll
        for (int j = 0; j < 4; ++j) {
            const int col = 4 * (lane + 64 * j);
            const float4 w1 = *(const float4*)(p.norm2_w + col), sc = *(const float4*)(mod + b * 6144 + 4096 + col), sh = *(const float4*)(mod + b * 6144 + 3072 + col);
            u32x2 o;
            o.x = pk2(v[j].x * rstd * w1.x * (1.f + sc.x) + sh.x, v[j].y * rstd * w1.y * (1.f + sc.y) + sh.y);
            o.y = pk2(v[j].z * rstd * w1.z * (1.f + sc.z) + sh.z, v[j].w * rstd * w1.w * (1.f + sc.w) + sh.w);
            *(u32x2*)(U2 + (size_t)m * D + col) = o;
        }
    }
}

constexpr size_t WS_SELI = WS_PM;
constexpr size_t WS_SELG = WS_PM + 16 * MiB;
DEV unsigned f2ord(float f) { const unsigned u = __float_as_uint(f); return (u & 0x80000000u) ? ~u : (u | 0x80000000u); }
DEV float ord2f(unsigned k) { return __uint_as_float((k & 0x80000000u) ? (k ^ 0x80000000u) : ~k); }
DEV unsigned umax_(unsigned a, unsigned b) { return a > b ? a : b; }

DEV void stage_q_topk(const Params& p, char* lds, int vb, int nvb) {
    const int tid = threadIdx.x, lane = tid & 63, wave = __builtin_amdgcn_readfirstlane(tid >> 6), fr = lane & 15, fq = lane >> 4;
    char* Qt = lds;
    char* Kd = lds + 65536;
    unsigned* tops = (unsigned*)(lds + 135168);
    const bf16_t* SK = (const bf16_t*)(p.ws + WS_SK);
    for (int i = tid; i < 2 * 128 * 16; i += NTH) { const int row = i >> 4, ch = i & 15; *(u32x4*)(Kd + row * 272 + ch * 16) = *(const u32x4*)(SK + row * 128 + ch * 8); }
    GemmOp g{(const bf16_t*)(p.ws + WS_PG), 1024, (const bf16_t*)(p.ws + WS_WQ), 1024, 1024};
    int* SELI = (int*)(p.ws + WS_SELI); float* SELG = (float*)(p.ws + WS_SELG);
    for (int item = vb; item < 2048; item += nvb) {
        const int mt = item >> 3, h = item & 7, m0 = mt * 128;
        for (int pp = 0; pp < 2; ++pp) {
            f32x4 acc[4][2];
#pragma unroll
            for (int i = 0; i < 4; ++i) { acc[i][0] = (f32x4){0.f, 0.f, 0.f, 0.f}; acc[i][1] = acc[i][0]; }
            gemm_tile(acc, g, m0, h * 256 + pp * 128, lds);
            {
                const int wm = wave >> 2, wn = wave & 3;
#pragma unroll
                for (int mi = 0; mi < 4; ++mi)
#pragma unroll
                    for (int ni = 0; ni < 2; ++ni) { const f32x4 v = acc[mi][ni]; u32x2 o; o.x = pk2(v[0], v[1]); o.y = pk2(v[2], v[3]);
                        *(u32x2*)(Qt + (wm * 64 + mi * 16 + fr) * 272 + (wn * 32 + ni * 16 + 4 * fq) * 2) = o; }
            }
            __syncthreads();
            bf16x8 qf[4];
#pragma unroll
            for (int ks = 0; ks < 4; ++ks) qf[ks] = *(const bf16x8*)(Qt + (16 * wave + fr) * 272 + (32 * ks + 8 * fq) * 2);
            unsigned key[32];
#pragma unroll
            for (int t = 0; t < 8; ++t) {
                f32x4 sc = {0.f, 0.f, 0.f, 0.f};
#pragma unroll
                for (int ks = 0; ks < 4; ++ks) { const bf16x8 kf = *(const bf16x8*)(Kd + (pp * 128 + 16 * t + fr) * 272 + (32 * ks + 8 * fq) * 2); sc = mfma16(kf, qf[ks], sc); }
#pragma unroll
                for (int r = 0; r < 4; ++r) key[4 * t + r] = (f2ord(sc[r]) & ~127u) | (127u - (unsigned)(16 * t + 4 * fq + r));
            }
            unsigned prev = 0xffffffffu;
            for (int r = 0; r < 16; ++r) {
                unsigned best = 0u;
#pragma unroll
                for (int i = 0; i < 32; ++i) { const unsigned c = key[i] < prev ? key[i] : 0u; best = umax_(best, c); }
                best = umax_(best, (unsigned)__shfl_xor((int)best, 16)); best = umax_(best, (unsigned)__shfl_xor((int)best, 32));
                prev = best;
                if (fq == 0) tops[((16 * wave + fr) * 2 + pp) * 16 + r] = best;
            }
            __syncthreads();
        }
        const unsigned* tp = tops + (16 * wave + fr) * 32;
        float A[4], B[16];
#pragma unroll
        for (int m = 0; m < 4; ++m) A[m] = ord2f(tp[fq + 4 * m] & ~127u);
#pragma unroll
        for (int j = 0; j < 16; ++j) B[j] = ord2f(tp[16 + j] & ~127u);
        unsigned ck[21];
#pragma unroll
        for (int sl = 0; sl < 21; ++sl) {
            const int m = sl < 16 ? 0 : (sl < 19 ? 1 : (sl < 20 ? 2 : 3)), j = sl < 16 ? sl : (sl < 19 ? sl - 16 : 0);
            const int i = fq + 4 * m;
            const bool ok = j < 16 / (i + 1);
            ck[sl] = ok ? ((f2ord(A[m] + B[j]) & ~255u) | (255u - (unsigned)(i * 16 + j))) : 0u;
        }
        unsigned wins[16];
        {
            unsigned prev = 0xffffffffu;
#pragma unroll
            for (int r = 0; r < 16; ++r) {
                unsigned best = 0u;
#pragma unroll
                for (int sl = 0; sl < 21; ++sl) { const unsigned c = ck[sl] < prev ? ck[sl] : 0u; best = umax_(best, c); }
                best = umax_(best, (unsigned)__shfl_xor((int)best, 16)); best = umax_(best, (unsigned)__shfl_xor((int)best, 32));
                prev = best; wins[r] = best;
            }
        }
        const float v0 = ord2f(wins[0] & ~255u);
        float ex[16], sm = 0.f;
#pragma unroll
        for (int r = 0; r < 16; ++r) { ex[r] = __expf(ord2f(wins[r] & ~255u) - v0); sm += ex[r]; }
        const float rs = 1.f / sm;
        int oi[4]; float og[4];
#pragma unroll
        for (int q = 0; q < 4; ++q) {
            const unsigned w = fq == 0 ? wins[q] : (fq == 1 ? wins[4 + q] : (fq == 2 ? wins[8 + q] : wins[12 + q]));
            const float e = fq == 0 ? ex[q] : (fq == 1 ? ex[4 + q] : (fq == 2 ? ex[8 + q] : ex[12 + q]));
            const unsigned flat = 255u - (w & 255u); const unsigned ia = flat >> 4, jb = flat & 15u;
            oi[q] = (int)((127u - (tp[ia] & 127u)) * 128u + (127u - (tp[16 + jb] & 127u)));
            og[q] = e * rs;
        }
        const size_t so = (size_t)(m0 + 16 * wave + fr) * 128 + h * 16 + 4 * fq;
        *(int4*)(SELI + so) = make_int4(oi[0], oi[1], oi[2], oi[3]);
        *(float4*)(SELG + so) = make_float4(og[0], og[1], og[2], og[3]);
    }
}

typedef float f32x2 __attribute__((ext_vector_type(2)));
struct EB { u32x4 u[8], v[8]; };

DEV void peer_load(EB& b, const unsigned char* TU, const unsigned char* TV, int iv, int e0, int lane) {
#pragma unroll
    for (int q = 0; q < 8; ++q) {
        const int id = __builtin_amdgcn_readlane(iv, e0 + q);
        b.u[q] = ((const u32x4*)(TU + (size_t)id * 1024))[lane]; b.v[q] = ((const u32x4*)(TV + (size_t)id * 1024))[lane];
    }
}
DEV void peer_compute(const EB& b, const f32x2 (&x)[8], float isu, float gsv, int e0, int lane, f32x2 (&oa)[8]) {
    float d[8];
#pragma unroll
    for (int q = 0; q < 8; ++q) {
        f32x2 a = {0.f, 0.f};
#pragma unroll
        for (int i = 0; i < 4; ++i) {
            a = __builtin_elementwise_fma(__builtin_amdgcn_cvt_pk_f32_fp8((int)b.u[q][i], false), x[2 * i], a);
            a = __builtin_elementwise_fma(__builtin_amdgcn_cvt_pk_f32_fp8((int)b.u[q][i], true), x[2 * i + 1], a);
        }
        d[q] = (a.x + a.y) * __uint_as_float((unsigned)__builtin_amdgcn_readlane((int)__float_as_uint(isu), e0 + q));
    }
    const bool h32 = (lane & 32) != 0, h16 = (lane & 16) != 0, h8 = (lane & 8) != 0;
    float k[4];
#pragma unroll
    for (int i = 0; i < 4; ++i) k[i] = (h32 ? d[4 + i] : d[i]) + __shfl_xor(h32 ? d[i] : d[4 + i], 32);
    float m2[2];
#pragma unroll
    for (int i = 0; i < 2; ++i) m2[i] = (h16 ? k[2 + i] : k[i]) + __shfl_xor(h16 ? k[i] : k[2 + i], 16);
    float v1 = (h8 ? m2[1] : m2[0]) + __shfl_xor(h8 ? m2[0] : m2[1], 8);
    v1 += __shfl_xor(v1, 4); v1 += __shfl_xor(v1, 2); v1 += __shfl_xor(v1, 1);
    const float gl = __shfl(gsv, e0 + ((lane >> 3) & 7));
    const int wi_ = (int)__float_as_uint(gl * 0.5f * v1 * (1.f + erff(v1 * 0.7071067811865476f)));
#pragma unroll
    for (int q = 0; q < 8; ++q) {
        const float w = __uint_as_float((unsigned)__builtin_amdgcn_readlane(wi_, 8 * q));
        const f32x2 w2 = {w, w};
#pragma unroll
        for (int i = 0; i < 4; ++i) {
            oa[2 * i] = __builtin_elementwise_fma(__builtin_amdgcn_cvt_pk_f32_fp8((int)b.v[q][i], false), w2, oa[2 * i]);
            oa[2 * i + 1] = __builtin_elementwise_fma(__builtin_amdgcn_cvt_pk_f32_fp8((int)b.v[q][i], true), w2, oa[2 * i + 1]);
        }
    }
}

DEV void stage_peer_gather(const Params& p, char* lds, int vb, int nvb, bool dry = false) {
    const int tid = threadIdx.x, lane = tid & 63, wave = __builtin_amdgcn_readfirstlane(tid >> 6);
    const bf16_t* U2 = (const bf16_t*)(p.ws + WS_PG);
    const unsigned char* TU = p.ws + WS_TU; const unsigned char* TV = p.ws + WS_TV;
    const float* ISU = (const float*)(p.ws + WS_ISU); const float* ISV = (const float*)(p.ws + WS_ISV);
    const int* SELI = (const int*)(p.ws + WS_SELI); const float* SELG = (const float*)(p.ws + WS_SELG);
    const float* mod = (const float*)(p.ws + WS_MOD);
    for (int tkn = vb * NW + wave; tkn < M; tkn += nvb * NW) {
        f32x2 x[8];
        {
            const u32x4* xr = (const u32x4*)(U2 + (size_t)tkn * D + 16 * lane); const u32x4 x0 = xr[0], x1 = xr[1];
#pragma unroll
            for (int i = 0; i < 4; ++i) { x[i] = (f32x2){bflo(x0[i]), bfhi(x0[i])}; x[4 + i] = (f32x2){bflo(x1[i]), bfhi(x1[i])}; }
        }
        const int iv0 = SELI[(size_t)tkn * 128 + lane], iv1 = SELI[(size_t)tkn * 128 + 64 + lane];
        const float gs0 = SELG[(size_t)tkn * 128 + lane] * ISV[iv0], gs1 = SELG[(size_t)tkn * 128 + 64 + lane] * ISV[iv1];
        const float su0 = ISU[iv0], su1 = ISU[iv1];
        f32x2 oa[8];
#pragma unroll
        for (int i = 0; i < 8; ++i) oa[i] = (f32x2){0.f, 0.f};
        EB ba, bb;
#pragma unroll
        for (int half = 0; half < 2; ++half) {
            const int iv = half ? iv1 : iv0; const float gsv = half ? gs1 : gs0, isu = half ? su1 : su0;
            peer_load(ba, TU, TV, iv, 0, lane);
            for (int bt = 0; bt < 8; bt += 2) {
                peer_load(bb, TU, TV, iv, 8 * bt + 8, lane);
                peer_compute(ba, x, isu, gsv, 8 * bt, lane, oa);
                if (bt + 2 < 8) peer_load(ba, TU, TV, iv, 8 * bt + 16, lane);
                peer_compute(bb, x, isu, gsv, 8 * bt + 8, lane, oa);
            }
        }
        const int b = tkn >= SEQ ? 1 : 0;
        float* hr = p.out + (size_t)tkn * D + 16 * lane;
        const float* g2p = mod + b * 6144 + 5120 + 16 * lane;
        float4 y[4]; float ss = 0.f;
#pragma unroll
        for (int q = 0; q < 4; ++q) {
            const float4 hv = *(const float4*)(hr + 4 * q); const float4 g2 = *(const float4*)(g2p + 4 * q);
            y[q].x = hv.x + g2.x * oa[2 * q].x; y[q].y = hv.y + g2.y * oa[2 * q].y; y[q].z = hv.z + g2.z * oa[2 * q + 1].x; y[q].w = hv.w + g2.w * oa[2 * q + 1].y;
            ss += y[q].x * y[q].x + y[q].y * y[q].y + y[q].z * y[q].z + y[q].w * y[q].w;
        }
        ss = wave_sum(ss);
        const float rstd = rsqrtf(ss * (1.f / 1024.f) + 1e-6f);
        if (!dry || rstd == 123.456f)
#pragma unroll
        for (int q = 0; q < 4; ++q) {
            const float4 nw = *(const float4*)(p.normf_w + 16 * lane + 4 * q);
            float4 o; o.x = y[q].x * rstd * nw.x; o.y = y[q].y * rstd * nw.y; o.z = y[q].z * rstd * nw.z; o.w = y[q].w * rstd * nw.w;
            *(float4*)(hr + 4 * q) = o;
        }
    }
}

#define LAS __attribute__((address_space(3)))
#define XB_TMO      128
#define XB_XCNT(j)  (256  + 64 * (j))
#define XB_XSUB(j)  (1280 + 64 * (j))
#define XB_XGEN(j)  (2304 + 64 * (j))
#define XB_TOP      3328
#define XB_TOPGEN   3392
#define XCD_BAR_WORDS 3456
#define XB_SPIN_CAP (1u << 18)

__device__ __forceinline__ unsigned xb_ld(unsigned* p)              { return __hip_atomic_load(p, __ATOMIC_RELAXED, __HIP_MEMORY_SCOPE_AGENT); }
__device__ __forceinline__ unsigned xb_add(unsigned* p, unsigned v) { return __hip_atomic_fetch_add(p, v, __ATOMIC_RELAXED, __HIP_MEMORY_SCOPE_AGENT); }
__device__ __forceinline__ unsigned xb_xcc_id() { return (unsigned)__builtin_amdgcn_s_getreg((3 << 11) | 20) & 0xFu; }
#define XB_SPIN(cond, bar) do { unsigned _sp = 0; while (cond) { __builtin_amdgcn_s_sleep(1); \
    if ((++_sp & 255u) == 0u) { if (xb_ld(&(bar)[XB_TMO])) break; if (_sp > XB_SPIN_CAP) { atomicAdd(&(bar)[XB_TMO], 1u); break; } } } } while (0)

struct XcdBarrier {
    unsigned* bar; unsigned x;
    volatile LAS unsigned* st;
};

__device__ __forceinline__ XcdBarrier xcd_barrier_post(unsigned* bar, volatile LAS unsigned* st) {
    XcdBarrier b; b.bar = bar; b.x = xb_xcc_id(); b.st = st;
    if (threadIdx.x == 0) (void)xb_add(&bar[XB_XCNT(b.x)], 1u);
    return b;
}
__device__ __forceinline__ void xcd_barrier_complete(unsigned* bar, unsigned x, unsigned& nloc, unsigned& nx) {
    const unsigned G = gridDim.x * gridDim.y * gridDim.z;
    unsigned sum, cnt, mine, sp = 0u;
    for (;;) {
        sum = 0u; cnt = 0u; mine = 0u;
#pragma unroll
        for (unsigned j = 0; j < 16; ++j) { const unsigned c = xb_ld(&bar[XB_XCNT(j)]); sum += c; cnt += (c > 0u) ? 1u : 0u; mine = (j == x) ? c : mine; }
        if (sum == G) break;
        __builtin_amdgcn_s_sleep(1);
        if ((++sp & 255u) == 0u) { if (xb_ld(&bar[XB_TMO])) break; if (sp > XB_SPIN_CAP) { atomicAdd(&bar[XB_TMO], 1u); break; } }
    }
    nloc = mine > 0u ? mine : 1u; nx = cnt > 0u ? cnt : 1u;
}

__device__ __forceinline__ void xcd_barrier(const XcdBarrier& b) {
    asm volatile("s_waitcnt vmcnt(0)" ::: "memory");
    __syncthreads();
    if (threadIdx.x == 0) {
        unsigned* bar = b.bar;
        __builtin_amdgcn_s_waitcnt(0);
        unsigned nloc = b.st[0], nx = b.st[1];
        if (nloc == 0u) { xcd_barrier_complete(bar, b.x, nloc, nx); b.st[0] = nloc; b.st[1] = nx; }
        const unsigned old = xb_add(&bar[XB_XSUB(b.x)], 1u);
        const unsigned gen = old / nloc;
        if (old + 1u == (gen + 1u) * nloc) {
            __builtin_amdgcn_fence(__ATOMIC_RELEASE, "agent");
            asm volatile("s_waitcnt vmcnt(0)" ::: "memory");
            const unsigned og = xb_add(&bar[XB_TOP], 1u);
            const unsigned tg = og / nx;
            if (og + 1u == (tg + 1u) * nx) xb_add(&bar[XB_TOPGEN], 1u);
            else XB_SPIN(xb_ld(&bar[XB_TOPGEN]) == tg, bar);
            __builtin_amdgcn_fence(__ATOMIC_ACQUIRE, "agent");
            xb_add(&bar[XB_XGEN(b.x)], 1u);
            asm volatile("s_waitcnt vmcnt(0)" ::: "memory");
        } else {
            XB_SPIN(xb_ld(&bar[XB_XGEN(b.x)]) == gen, bar);
            __builtin_amdgcn_fence(__ATOMIC_ACQUIRE, "agent");
            asm volatile("s_waitcnt vmcnt(0)" ::: "memory");
        }
    }
    __syncthreads();
}

namespace cg = cooperative_groups;
constexpr int LDS_BYTES = 151552;

constexpr int LDS_TOTAL = LDS_BYTES + 64;

__global__ void __launch_bounds__(512) k_mega(Params p) {
    extern __shared__ __attribute__((aligned(16))) char lds[];
    cg::grid_group grid = cg::this_grid();
    const int vb = blockIdx.x, nvb = gridDim.x;
    volatile LAS unsigned* bst = (volatile LAS unsigned*)((LAS char*)lds + LDS_BYTES);
    if (threadIdx.x < 16) bst[threadIdx.x] = 0u;
    __syncthreads();
    XcdBarrier bar = xcd_barrier_post((unsigned*)p.ws, bst);
#define GRID_BAR() xcd_barrier(bar)
    stage_prep(p, lds, vb, nvb);        grid.sync();
    stage_norm1(p, lds, vb, nvb);       GRID_BAR();
    stage_gemm_in(p, lds, vb, nvb);     GRID_BAR();
    stage_attn(p, lds, vb, nvb);
    stage_mstate(p, lds, vb, nvb);      GRID_BAR();
    stage_mscan(p, lds, vb, nvb);       GRID_BAR();
    stage_mout(p, lds, vb, nvb);        GRID_BAR();
    stage_gemm_merge(p, lds, vb, nvb);  GRID_BAR();
    stage_gemm_out(p, lds, vb, nvb);    GRID_BAR();
    stage_norm2(p, lds, vb, nvb);       GRID_BAR();
    stage_q_topk(p, lds, vb, nvb);      GRID_BAR();
    stage_peer_gather(p, lds, vb, nvb);
}

extern "C" void kernel_launch(void* const* d_in, const int* in_sizes, int n_in, void* d_out, int out_size, void* d_ws, size_t ws_size, hipStream_t stream) {
    if (n_in != 20 || ws_size < WS_END) { fprintf(stderr, "kernel_launch: unexpected n_in %d or ws_size %zu\n", n_in, ws_size); return; }
    static int grid_blocks = 0;
    if (!grid_blocks) {
        int dev = 0, cus = 0, per_cu = 0;
        (void)hipGetDevice(&dev);
        (void)hipDeviceGetAttribute(&cus, hipDeviceAttributeMultiprocessorCount, dev);
        (void)hipFuncSetAttribute((const void*)k_mega, hipFuncAttributeMaxDynamicSharedMemorySize, LDS_TOTAL);
        (void)hipOccupancyMaxActiveBlocksPerMultiprocessor(&per_cu, (const void*)k_mega, 512, LDS_TOTAL);
        if (per_cu < 1) { fprintf(stderr, "kernel_launch: occupancy query says %d blocks per CU\n", per_cu); per_cu = 1; }
        grid_blocks = cus * 1;
    }
    Params p{};
    p.x = (const float*)d_in[0]; p.c = (const float*)d_in[1]; p.w_ada = (const float*)d_in[2]; p.b_ada = (const float*)d_in[3]; p.norm1_w = (const float*)d_in[4];
    p.w_in = (const float*)d_in[5]; p.conv_w = (const float*)d_in[6]; p.sinks = (const float*)d_in[7]; p.i_bias = (const float*)d_in[8]; p.f_bias = (const float*)d_in[9];
    p.mnorm_w = (const float*)d_in[10]; p.w_a = (const float*)d_in[11]; p.w_b = (const float*)d_in[12]; p.w_out = (const float*)d_in[13]; p.norm2_w = (const float*)d_in[14];
    p.w_q = (const float*)d_in[15]; p.sub_keys = (const float*)d_in[16]; p.peer_u = (const float*)d_in[17]; p.peer_v = (const float*)d_in[18]; p.normf_w = (const float*)d_in[19];
    p.out = (float*)d_out; p.ws = (unsigned char*)d_ws;
    (void)hipMemsetAsync(d_ws, 0, XCD_BAR_WORDS * 4, stream);
    void* args[] = {&p};
    hipError_t e = hipLaunchCooperativeKernel((const void*)k_mega, dim3(grid_blocks), dim3(512), args, LDS_TOTAL, stream);
    if (e != hipSuccess) fprintf(stderr, "cooperative launch failed: %s (grid %d)\n", hipGetErrorString(e), grid_blocks);
}
```

```cpp
#include <hip/hip_runtime.h>
#include <hip/hip_cooperative_groups.h>
#include <stdint.h>
#include <stdio.h>

#define DEV __device__ __forceinline__
typedef unsigned short bf16_t;
typedef short bf16x8 __attribute__((ext_vector_type(8)));
typedef float f32x4 __attribute__((ext_vector_type(4)));
typedef unsigned u32x4 __attribute__((ext_vector_type(4)));
typedef unsigned u32x2 __attribute__((ext_vector_type(2)));

constexpr int BATCH = 2, SEQ = 16384, M = BATCH * SEQ, D = 1024;
constexpr int NTH = 512, NW = 8;
constexpr int LPA = 768, LPM = 2048, LPG = 2048;

struct Params {
    const float *x, *c, *w_ada, *b_ada, *norm1_w, *w_in, *conv_w, *sinks, *i_bias, *f_bias, *mnorm_w, *w_a, *w_b, *w_out, *norm2_w, *w_q, *sub_keys, *peer_u, *peer_v, *normf_w;
    float* out; unsigned char* ws;
};

constexpr size_t MiB = 1u << 20;
constexpr size_t WS_MOD = 1 * MiB;
constexpr size_t WS_IPRE = 2 * MiB;
constexpr size_t WS_FPRE = 2 * MiB + 512 * 1024;
constexpr size_t WS_CHG = 3 * MiB;
constexpr size_t WS_NLOC = 4 * MiB;
constexpr size_t WS_NST = 4 * MiB + 512 * 1024;
constexpr size_t WS_ROPE = 5 * MiB;
constexpr size_t WS_WIN = 10 * MiB;
constexpr size_t WS_WA = 20 * MiB;
constexpr size_t WS_WB = 21 * MiB;
constexpr size_t WS_WOUT = 22 * MiB;
constexpr size_t WS_WQ = 24 * MiB;
constexpr size_t WS_SK = 28 * MiB;
constexpr size_t WS_ISU = 29 * MiB;
constexpr size_t WS_ISV = 29 * MiB + 65536;
constexpr size_t WS_TU = 32 * MiB;
constexpr size_t WS_TV = 48 * MiB;
constexpr size_t WS_UB = 96 * MiB;
constexpr size_t WS_PA = 160 * MiB;
constexpr size_t WS_PM = 208 * MiB;
constexpr size_t WS_PG = 336 * MiB;
constexpr size_t WS_CST = 464 * MiB;
constexpr size_t WS_END = 496 * MiB;

DEV unsigned f2bf(float f) { unsigned u = __float_as_uint(f); return (u + 0x7fffu + ((u >> 16) & 1u)) >> 16; }
DEV unsigned pk2(float lo, float hi) { return f2bf(lo) | (f2bf(hi) << 16); }
DEV float bflo(unsigned u) { return __uint_as_float(u << 16); }
DEV float bfhi(unsigned u) { return __uint_as_float(u & 0xffff0000u); }
DEV float bf2f(bf16_t h) { return __uint_as_float(((unsigned)h) << 16); }
DEV float wave_sum(float v) {
#pragma unroll
    for (int o = 32; o > 0; o >>= 1) v += __shfl_xor(v, o);
    return v;
}
DEV float wave_max(float v) {
#pragma unroll
    for (int o = 32; o > 0; o >>= 1) v = fmaxf(v, __shfl_xor(v, o));
    return v;
}
DEV float sigmoidf_(float v) { return 1.f / (1.f + __expf(-v)); }
DEV f32x4 mfma16(bf16x8 a, bf16x8 b, f32x4 c) { return __builtin_amdgcn_mfma_f32_16x16x32_bf16(a, b, c, 0, 0, 0); }
DEV void wave_lds_sync() { __builtin_amdgcn_fence(__ATOMIC_ACQ_REL, "wavefront"); __builtin_amdgcn_wave_barrier(); }

DEV void transpose_item(const float* W, int ldw, int k0, int nsrc0, bf16_t* WT, int ldt, int ndst0, float* scr, int lane) {
#pragma unroll 8
    for (int i = 0; i < 32; ++i) { const int kk = 2 * i + (lane >> 5); scr[kk * 33 + (lane & 31)] = W[(size_t)(k0 + kk) * ldw + nsrc0 + (lane & 31)]; }
    wave_lds_sync();
    const int c = lane & 7;
#pragma unroll
    for (int j = 0; j < 4; ++j) {
        const int n = (lane >> 3) + 8 * j; const float* s = scr + (8 * c) * 33 + n;
        u32x4 o; o.x = pk2(s[0 * 33], s[1 * 33]); o.y = pk2(s[2 * 33], s[3 * 33]); o.z = pk2(s[4 * 33], s[5 * 33]); o.w = pk2(s[6 * 33], s[7 * 33]);
        *(u32x4*)(WT + (size_t)(ndst0 + n) * ldt + k0 + 8 * c) = o;
    }
    wave_lds_sync();
}

DEV void stage_prep(const Params& p, char* lds, int vb, int nvb) {
    const int tid = threadIdx.x, lane = tid & 63, wave = __builtin_amdgcn_readfirstlane(tid >> 6);
    float* mod = (float*)(p.ws + WS_MOD);
    float* s_act = (float*)lds;
    float* s_red = (float*)(lds + 8192);
    for (int i = tid; i < 2048; i += NTH) { const float v = p.c[i]; s_act[i] = v / (1.f + expf(-v)); }
    __syncthreads();
    for (int item = vb; item < 192; item += nvb) {
        const int kg = tid >> 5, cl = tid & 31, col = item * 32 + cl;
        float s0 = 0.f, s1 = 0.f;
        for (int k = kg; k < 1024; k += 16) { const float w = p.w_ada[(size_t)k * 6144 + col]; s0 += s_act[k] * w; s1 += s_act[1024 + k] * w; }
        s_red[(kg * 32 + cl) * 2] = s0; s_red[(kg * 32 + cl) * 2 + 1] = s1;
        __syncthreads();
        if (tid < 64) { const int b = tid >> 5, c2 = tid & 31; float s = 0.f; for (int g = 0; g < 16; ++g) s += s_red[(g * 32 + c2) * 2 + b]; mod[b * 6144 + item * 32 + c2] = s + p.b_ada[item * 32 + c2]; }
        __syncthreads();
    }
    float* scr = (float*)(lds + 16384 + wave * 8448);
    const int gw = vb * NW + wave, ngw = nvb * NW;
    bf16_t* Wt_in = (bf16_t*)(p.ws + WS_WIN); bf16_t* Wt_a = (bf16_t*)(p.ws + WS_WA); bf16_t* Wt_b = (bf16_t*)(p.ws + WS_WB);
    bf16_t* Wt_out = (bf16_t*)(p.ws + WS_WOUT); bf16_t* Wt_q = (bf16_t*)(p.ws + WS_WQ);
    for (int it = gw; it < 3456; it += ngw) {
        int r = it;
        if (r < 2432) { const int kb = r / 152, nb = r % 152; transpose_item(p.w_in, 4872, kb * 64, nb * 32 + (nb >= 88 ? 8 : 0), Wt_in, 1024, nb * 32, scr, lane); continue; } r -= 2432;
        if (r < 256) { const int kb = r / 32, nb = r % 32; transpose_item(p.w_a, 1024, kb * 64, nb * 32, Wt_a, 512, nb * 32, scr, lane); continue; } r -= 256;
        if (r < 256) { const int kb = r / 32, nb = r % 32; transpose_item(p.w_b, 1024, kb * 64, nb * 32, Wt_b, 512, nb * 32, scr, lane); continue; } r -= 256;
        { const int kb = r / 32, nb = r % 32; transpose_item(p.w_out, 1024, kb * 64, nb * 32, Wt_out, 1024, nb * 32, scr, lane); }
    }
    {
        float* WL = (float*)lds;
        float* KL = (float*)(lds + 33792);
        for (int item = vb; item < 256; item += nvb) {
            const int hp = item >> 4, k0 = (item & 15) * 64, pidx = hp & 1;
            __syncthreads();
            for (int i = tid; i < 64 * 32; i += NTH) { const int kk = i >> 5, d4 = i & 31; *(float4*)(WL + kk * 132 + 4 * d4) = *(const float4*)(p.w_q + (size_t)(k0 + kk) * 2048 + hp * 128 + 4 * d4); }
            for (int i = tid; i < 128 * 32; i += NTH) ((float4*)KL)[i] = ((const float4*)(p.sub_keys + (size_t)pidx * 16384))[i];
            __syncthreads();
            const int kk = tid & 63, n0 = (tid >> 6) * 16;
            float acc[16];
#pragma unroll
            for (int j = 0; j < 16; ++j) acc[j] = 0.f;
            for (int d4 = 0; d4 < 32; ++d4) {
                const float4 w = *(const float4*)(WL + kk * 132 + 4 * d4);
#pragma unroll
                for (int j = 0; j < 16; ++j) { const float4 kv = *(const float4*)(KL + (n0 + j) * 128 + 4 * d4); acc[j] += w.x * kv.x + w.y * kv.y + w.z * kv.z + w.w * kv.w; }
            }
#pragma unroll
            for (int j = 0; j < 16; ++j) Wt_q[(size_t)(hp * 128 + n0 + j) * 1024 + k0 + kk] = (bf16_t)f2bf(acc[j]);
        }
        __syncthreads();
    }
    const size_t gt = (size_t)vb * NTH + tid, ngt = (size_t)nvb * NTH;
    for (int row = gw; row < 32768; row += ngw) {
        const bool isv = row >= 16384; const int r = row & 16383;
        const float4* src = (const float4*)((isv ? p.peer_v : p.peer_u) + (size_t)r * D) + 4 * lane;
        float4 a[4]; float mx = 0.f;
#pragma unroll
        for (int i = 0; i < 4; ++i) { a[i] = src[i]; mx = fmaxf(mx, fmaxf(fmaxf(fabsf(a[i].x), fabsf(a[i].y)), fmaxf(fabsf(a[i].z), fabsf(a[i].w)))); }
        mx = wave_max(mx);
        int ex = 0; if (mx > 0.f) (void)frexpf(mx, &ex); else ex = 8;
        const float sc = ldexpf(1.f, 8 - ex), isc = ldexpf(1.f, ex - 8);
        u32x4 w;
#pragma unroll
        for (int i = 0; i < 4; ++i) { int pk = 0; pk = __builtin_amdgcn_cvt_pk_fp8_f32(a[i].x * sc, a[i].y * sc, pk, false); pk = __builtin_amdgcn_cvt_pk_fp8_f32(a[i].z * sc, a[i].w * sc, pk, true); w[i] = (unsigned)pk; }
        ((u32x4*)(p.ws + (isv ? WS_TV : WS_TU) + (size_t)r * 1024))[lane] = w;
        if (lane == 0) ((float*)(p.ws + (isv ? WS_ISV : WS_ISU)))[r] = isc;
    }
    for (size_t g = gt; g < 4096; g += ngt) {
        const float4 a = ((const float4*)p.sub_keys)[2 * g], b = ((const float4*)p.sub_keys)[2 * g + 1];
        u32x4 w; w.x = pk2(a.x, a.y); w.y = pk2(a.z, a.w); w.z = pk2(b.x, b.y); w.w = pk2(b.z, b.w);
        ((u32x4*)(p.ws + WS_SK))[g] = w;
    }
    float2* rope = (float2*)(p.ws + WS_ROPE);
    for (size_t e = gt; e < 16384 * 32; e += ngt) {
        const int pos = (int)(e >> 5), i = (int)(e & 31);
        const float inv = (float)exp2(-(double)i * (13.287712379549449 / 32.0));
        const float ang = (float)pos * inv;
        const double a = (double)ang; const double n = rint(a * 0.15915494309189535); const double r = a - n * 6.283185307179586;
        float s, c; sincosf((float)r, &s, &c);
        rope[e] = make_float2(c, s);
    }
}

DEV void stage_norm1(const Params& p, char* lds, int vb, int nvb) {
    const int tid = threadIdx.x, lane = tid & 63, wave = __builtin_amdgcn_readfirstlane(tid >> 6);
    float* wg = (float*)lds;
    for (int i = tid; i < 8192; i += NTH) { const int cc = i >> 10, k = i & 1023; wg[i] = p.w_in[(size_t)k * 4872 + 2816 + cc]; }
    __syncthreads();
    const float* mod = (const float*)(p.ws + WS_MOD);
    bf16_t* ub = (bf16_t*)(p.ws + WS_UB);
    float* ipre = (float*)(p.ws + WS_IPRE); float* fpre = (float*)(p.ws + WS_FPRE);
    for (int m = vb * NW + wave; m < M; m += nvb * NW) {
        const int b = m >= SEQ ? 1 : 0;
        const float4* xr = (const float4*)(p.x + (size_t)m * D);
        float4 v[4]; float ss = 0.f;
#pragma unroll
        for (int j = 0; j < 4; ++j) { v[j] = xr[lane + 64 * j]; ss += v[j].x * v[j].x + v[j].y * v[j].y + v[j].z * v[j].z + v[j].w * v[j].w; }
        ss = wave_sum(ss);
        const float rstd = rsqrtf(ss * (1.f / 1024.f) + 1e-6f);
        float ga[8];
#pragma unroll
        for (int cc = 0; cc < 8; ++cc) ga[cc] = 0.f;
#pragma unroll
        for (int j = 0; j < 4; ++j) {
            const int col = 4 * (lane + 64 * j);
            const float4 w1 = *(const float4*)(p.norm1_w + col), sc = *(const float4*)(mod + b * 6144 + 1024 + col), sh = *(const float4*)(mod + b * 6144 + col);
            float4 u;
            u.x = v[j].x * rstd * w1.x * (1.f + sc.x) + sh.x; u.y = v[j].y * rstd * w1.y * (1.f + sc.y) + sh.y;
            u.z = v[j].z * rstd * w1.z * (1.f + sc.z) + sh.z; u.w = v[j].w * rstd * w1.w * (1.f + sc.w) + sh.w;
            u32x2 o; o.x = pk2(u.x, u.y); o.y = pk2(u.z, u.w);
            *(u32x2*)(ub + (size_t)m * D + col) = o;
#pragma unroll
            for (int cc = 0; cc < 8; ++cc) { const float4 g = *(const float4*)(wg + cc * 1024 + col); ga[cc] += u.x * g.x + u.y * g.y + u.z * g.z + u.w * g.w; }
        }
#pragma unroll
        for (int cc = 0; cc < 8; ++cc) ga[cc] = wave_sum(ga[cc]);
        if (lane == 0) {
#pragma unroll
            for (int h = 0; h < 4; ++h) { ipre[(size_t)m * 4 + h] = ga[h] + p.i_bias[h]; fpre[(size_t)m * 4 + h] = ga[4 + h] + p.f_bias[h]; }
        }
    }
}

namespace pg8 {
#define PG8_LAS __attribute__((address_space(3)))
typedef unsigned short bf16_t;
typedef short bf16x8 __attribute__((ext_vector_type(8)));
typedef float f32x4 __attribute__((ext_vector_type(4)));
typedef unsigned u32x4 __attribute__((ext_vector_type(4)));
constexpr int BM = 256, BK = 64, HALF = 128, HTB = HALF * BK * 2  , STAGE_BYTES = 8 * HTB, NXCD = 8, WGM = 8;

__host__ __device__ __forceinline__ int lds_byte(int r, int c) { const int st = (r >> 4) * 2 + (c >> 5), rr = r & 15, cc = c & 31, ob = rr * 64 + cc * 2; return st * 1024 + (ob ^ (((ob >> 9) & 1) << 5)); }
__host__ __device__ __forceinline__ void stage_rc(int b, int& R, int& C) { const int st = b / 1024, sb = b % 1024, swz = sb ^ (((sb >> 9) & 1) << 5); R = (st >> 1) * 16 + swz / 64; C = (st & 1) * 32 + (swz % 64) / 2; }
__host__ __device__ __forceinline__ int perm32(int rho) { const int n = rho >> 4, i = rho & 15; return 8 * (i >> 2) + 4 * n + (i & 3); }

struct Unit { int pm, pn; };
struct Gemm { const bf16_t* A; const bf16_t* Bt; int M, N, K, lda, ldb; };

struct StaticOrder {
    int nM, nN, nwg, G, c;
    __host__ __device__ void init(int M, int N, int G_, int c_) { nM = M / BM; nN = N / BM; nwg = nM * nN; G = G_; c = c_; }
    __host__ __device__ bool next(int i, Unit& u) const {
        const long L = (long)i * G + c; if (L >= nwg) return false;
        int wgid = (int)L; { const int q = nwg / NXCD, r = nwg % NXCD, xcd = wgid % NXCD, off = wgid / NXCD; wgid = (xcd < r ? xcd * (q + 1) : r * (q + 1) + (xcd - r) * q) + off; }
        const int nig = WGM * nN, gid = wgid / nig, fm = gid * WGM, gsz = (nM - fm) < WGM ? (nM - fm) : WGM;
        u.pm = fm + ((wgid % nig) % gsz); u.pn = (wgid % nig) / gsz; return true;
    }
    __device__ __forceinline__ void a_ready(const Unit&) const {}
    __device__ __forceinline__ void done(const Unit&) const {}
};

__device__ __forceinline__ unsigned cvt_pk_bf16(float lo, float hi) { unsigned r; asm volatile("v_cvt_pk_bf16_f32 %0, %1, %2" : "=v"(r) : "v"(lo), "v"(hi)); return r; }
__device__ __forceinline__ float sg_(float v) { return 1.f / (1.f + __expf(-v)); }
struct EpiIn {
    static constexpr bool PERM = true, AFTER_DRAIN = false;
    bf16_t *PA, *PM, *PG;
    __device__ __forceinline__ void operator()(const f32x4 (&acc)[2][2][4][2], const Unit& u, int wr, int wc, int fr, int fq) const {
        const int colt = u.pn * BM; bf16_t* base; int ldc, cb;
        if (colt < 768) { base = PA; ldc = 768; cb = colt; } else if (colt < 2816) { base = PM; ldc = 2048; cb = colt - 768; } else { base = PG; ldc = 2048; cb = colt - 2816; }
        const int row0 = u.pm * BM + wr * 64 + fr, col0 = cb + wc * 32 + 8 * fq;
#pragma unroll
        for (int ai = 0; ai < 2; ++ai)
#pragma unroll
            for (int m = 0; m < 4; ++m) { bf16_t* rowp = base + (size_t)(row0 + ai * HALF + m * 16) * ldc + col0;
#pragma unroll
                for (int bj = 0; bj < 2; ++bj) { const f32x4 v0 = acc[ai][bj][m][0], v1 = acc[ai][bj][m][1];
                    u32x4 w; w.x = cvt_pk_bf16(v0[0], v0[1]); w.y = cvt_pk_bf16(v0[2], v0[3]); w.z = cvt_pk_bf16(v1[0], v1[1]); w.w = cvt_pk_bf16(v1[2], v1[3]);
                    *(u32x4*)(rowp + bj * HALF) = w; } }
    }
};
struct EpiMerge {
    static constexpr bool PERM = true, AFTER_DRAIN = false;
    const bf16_t* G; bf16_t* MG; int second;
    __device__ __forceinline__ void operator()(const f32x4 (&acc)[2][2][4][2], const Unit& u, int wr, int wc, int fr, int fq) const {
        const int row0 = u.pm * BM + wr * 64 + fr, col0 = u.pn * BM + wc * 32 + 8 * fq;
#pragma unroll
        for (int ai = 0; ai < 2; ++ai)
#pragma unroll
            for (int m = 0; m < 4; ++m) { const size_t row = (size_t)(row0 + ai * HALF + m * 16);
#pragma unroll
                for (int bj = 0; bj < 2; ++bj) { const f32x4 v0 = acc[ai][bj][m][0], v1 = acc[ai][bj][m][1]; const int col = col0 + bj * HALF;
                    const u32x4 gv = *(const u32x4*)(G + row * 2048 + col);
                    float r[8];
                    r[0] = sg_(__uint_as_float(gv.x << 16)) * v0[0]; r[1] = sg_(__uint_as_float(gv.x & 0xffff0000u)) * v0[1];
                    r[2] = sg_(__uint_as_float(gv.y << 16)) * v0[2]; r[3] = sg_(__uint_as_float(gv.y & 0xffff0000u)) * v0[3];
                    r[4] = sg_(__uint_as_float(gv.z << 16)) * v1[0]; r[5] = sg_(__uint_as_float(gv.z & 0xffff0000u)) * v1[1];
                    r[6] = sg_(__uint_as_float(gv.w << 16)) * v1[2]; r[7] = sg_(__uint_as_float(gv.w & 0xffff0000u)) * v1[3];
                    u32x4* dst = (u32x4*)(MG + row * 1024 + col);
                    if (second) { const u32x4 t = *dst;
                        r[0] += __uint_as_float(t.x << 16); r[1] += __uint_as_float(t.x & 0xffff0000u); r[2] += __uint_as_float(t.y << 16); r[3] += __uint_as_float(t.y & 0xffff0000u);
                        r[4] += __uint_as_float(t.z << 16); r[5] += __uint_as_float(t.z & 0xffff0000u); r[6] += __uint_as_float(t.w << 16); r[7] += __uint_as_float(t.w & 0xffff0000u); }
                    u32x4 w; w.x = cvt_pk_bf16(r[0], r[1]); w.y = cvt_pk_bf16(r[2], r[3]); w.z = cvt_pk_bf16(r[4], r[5]); w.w = cvt_pk_bf16(r[6], r[7]);
                    *dst = w; } }
    }
};
struct EpiF32 {
    static constexpr bool PERM = true, AFTER_DRAIN = false;
    float* O; int ldc;
    __device__ __forceinline__ void operator()(const f32x4 (&acc)[2][2][4][2], const Unit& u, int wr, int wc, int fr, int fq) const {
        const int row0 = u.pm * BM + wr * 64 + fr, col0 = u.pn * BM + wc * 32 + 8 * fq;
#pragma unroll
        for (int ai = 0; ai < 2; ++ai)
#pragma unroll
            for (int m = 0; m < 4; ++m) { float* rowp = O + (size_t)(row0 + ai * HALF + m * 16) * ldc + col0;
#pragma unroll
                for (int bj = 0; bj < 2; ++bj) { *(f32x4*)(rowp + bj * HALF) = acc[ai][bj][m][0]; *(f32x4*)(rowp + bj * HALF + 4) = acc[ai][bj][m][1]; } }
    }
};
struct EpiOut {
    static constexpr bool PERM = true, AFTER_DRAIN = false;
    const float* x; const float* g1; float* out; int seq;
    __device__ __forceinline__ void operator()(const f32x4 (&acc)[2][2][4][2], const Unit& u, int wr, int wc, int fr, int fq) const {
        const int row0 = u.pm * BM + wr * 64 + fr, col0 = u.pn * BM + wc * 32 + 8 * fq;
        const float* gp = g1 + (u.pm * BM >= seq ? 6144 : 0);
#pragma unroll
        for (int bj = 0; bj < 2; ++bj) { const int col = col0 + bj * HALF; const f32x4 ga = *(const f32x4*)(gp + col), gb = *(const f32x4*)(gp + col + 4);
#pragma unroll
            for (int ai = 0; ai < 2; ++ai)
#pragma unroll
                for (int m = 0; m < 4; ++m) { const size_t off = (size_t)(row0 + ai * HALF + m * 16) * 1024 + col;
                    const f32x4 xa = *(const f32x4*)(x + off), xb = *(const f32x4*)(x + off + 4);
                    *(f32x4*)(out + off) = xa + ga * acc[ai][bj][m][0]; *(f32x4*)(out + off + 4) = xb + gb * acc[ai][bj][m][1]; } }
    }
};

template <class Epi, class Sched, bool ALIGN_EPI = false, bool SP2 = false>
__device__ __forceinline__ void gemm_phase(PG8_LAS unsigned char* lds, const Gemm g, const Sched& S, const Epi& E) {
    const int tid = threadIdx.x, wid = __builtin_amdgcn_readfirstlane(tid >> 6), lane = tid & 63, wr = wid >> 2, wc = wid & 3, fr = lane & 15, fq = lane >> 4;
    const int K = g.K, nt = K / BK;
    unsigned voffA[2], voffB[2];
#pragma unroll
    for (int i = 0; i < 2; ++i) { int R, C; stage_rc(tid * 16 + i * 8192, R, C); const int Rb = Epi::PERM ? ((R & ~31) + perm32(R & 31)) : R;
        voffA[i] = (unsigned)(R * g.lda + C) * 2u; voffB[i] = (unsigned)(Rb * g.ldb + C) * 2u; }
    const size_t kstep = (size_t)(BK * 2);
    const size_t hstepA = (size_t)HALF * g.lda * 2, hstepB = (size_t)HALF * g.ldb * 2;
    const size_t tstepA = 2 * hstepA, tstepB = 2 * hstepB;
    const unsigned ldsw = (unsigned)wid * 1024u;
    const int aoff = lds_byte(wr * 64 + fr, fq * 8), boff = lds_byte(wc * 32 + fr, fq * 8);
#define PG8_SA(b, h) (((b) * 2 + (h)) * HTB)
#define PG8_SB(b, h) ((4 + (b) * 2 + (h)) * HTB)
#define PG8_STAGE(bufoff, gbase, voff) do { _Pragma("unroll") for (int _i = 0; _i < 2; ++_i) \
        __builtin_amdgcn_global_load_lds((const unsigned*)((const char*)(gbase) + (voff)[_i]), (PG8_LAS unsigned*)(lds + (bufoff) + ldsw + _i * 8192), 16, 0, 0); } while (0)
#define PG8_LDA(dst, b, h) do { _Pragma("unroll") for (int m = 0; m < 4; ++m) _Pragma("unroll") for (int k = 0; k < 2; ++k) dst[m][k] = *(const PG8_LAS bf16x8*)(lds + PG8_SA(b, h) + aoff + m * 2048 + k * 1024); } while (0)
#define PG8_LDB(dst, b, h) do { _Pragma("unroll") for (int n = 0; n < 2; ++n) _Pragma("unroll") for (int k = 0; k < 2; ++k) dst[n][k] = *(const PG8_LAS bf16x8*)(lds + PG8_SB(b, h) + boff + n * 2048 + k * 1024); } while (0)
#define PG8_MMA(ai, bj, At, Bt) do { __builtin_amdgcn_s_setprio(1); _Pragma("unroll") for (int m = 0; m < 4; ++m) _Pragma("unroll") for (int n = 0; n < 2; ++n) _Pragma("unroll") for (int k = 0; k < 2; ++k) \
        acc[ai][bj][m][n] = __builtin_amdgcn_mfma_f32_16x16x32_bf16(Bt[n][k], At[m][k], acc[ai][bj][m][n], 0, 0, 0); __builtin_amdgcn_s_setprio(0); } while (0)
#define PG8_WAIT_V(n) asm volatile("s_waitcnt vmcnt(" #n ")" ::: "memory")
#define PG8_WAIT_L(n) asm volatile("s_waitcnt lgkmcnt(" #n ")" ::: "memory")
#define PG8_BAR __builtin_amdgcn_s_barrier()
#define PG8_SCHED __builtin_amdgcn_sched_barrier(0)
    Unit cur, nxt; int ui = 0;
    if (!S.next(0, cur)) return;
    f32x4 acc[2][2][4][2];
#pragma unroll
    for (int a = 0; a < 2; ++a)
#pragma unroll
        for (int b = 0; b < 2; ++b)
#pragma unroll
            for (int m = 0; m < 4; ++m)
#pragma unroll
                for (int n = 0; n < 2; ++n) acc[a][b][m][n] = (f32x4){0.f, 0.f, 0.f, 0.f};
    bf16x8 At[4][2], B0[2][2], B1[2][2];
    const char* cA = (const char*)g.A + (size_t)cur.pm * tstepA; const char* cB = (const char*)g.Bt + (size_t)cur.pn * tstepB;
    S.a_ready(cur);
    if constexpr (SP2) {
        PG8_STAGE(PG8_SB(0, 0), cB, voffB); PG8_STAGE(PG8_SB(0, 1), cB + hstepB, voffB); PG8_STAGE(PG8_SA(0, 0), cA, voffA); PG8_STAGE(PG8_SA(0, 1), cA + hstepA, voffA);
        if (wr == 1) PG8_BAR;
        PG8_WAIT_V(2); PG8_BAR;
        PG8_STAGE(PG8_SB(1, 0), cB + kstep, voffB); PG8_STAGE(PG8_SA(1, 0), cA + kstep, voffA); PG8_STAGE(PG8_SB(1, 1), cB + hstepB + kstep, voffB);
        PG8_WAIT_V(6); PG8_BAR;
    } else {
        PG8_STAGE(PG8_SB(0, 0), cB, voffB); PG8_STAGE(PG8_SA(0, 0), cA, voffA); PG8_STAGE(PG8_SB(0, 1), cB + hstepB, voffB); PG8_STAGE(PG8_SA(0, 1), cA + hstepA, voffA);
        if (wr == 1) PG8_BAR;
        PG8_WAIT_V(4); PG8_BAR;
        PG8_STAGE(PG8_SB(1, 0), cB + kstep, voffB); PG8_STAGE(PG8_SA(1, 0), cA + kstep, voffA); PG8_STAGE(PG8_SB(1, 1), cB + hstepB + kstep, voffB);
        PG8_WAIT_V(6); PG8_BAR;
    }
    for (;;) {
        const bool has_next = S.next(ui + 1, nxt);
        const char* nA = has_next ? (const char*)g.A + (size_t)nxt.pm * tstepA : cA; const char* nB = has_next ? (const char*)g.Bt + (size_t)nxt.pn * tstepB : cB;
        for (int t = 0; t < nt; t += 2) {
            const bool last = (t == nt - 2);
            const char* a1 = cA + (size_t)(t + 1) * kstep;
            const char* a2 = last ? nA : cA + (size_t)(t + 2) * kstep; const char* b2 = last ? nB : cB + (size_t)(t + 2) * kstep;
            const char* a3 = a2 + kstep; const char* b3 = b2 + kstep;
            if (last && has_next) S.a_ready(nxt);
            if constexpr (SP2) {
            PG8_LDB(B0, 0, 0); PG8_LDB(B1, 0, 1); PG8_SCHED; PG8_LDA(At, 0, 0); PG8_STAGE(PG8_SA(1, 1), a1 + hstepA, voffA);
            PG8_WAIT_V(8); PG8_WAIT_L(0); PG8_BAR; PG8_MMA(0, 0, At, B0); PG8_MMA(0, 1, At, B1); PG8_BAR; PG8_SCHED;
            PG8_LDA(At, 0, 1); PG8_STAGE(PG8_SB(0, 0), b2, voffB); PG8_STAGE(PG8_SB(0, 1), b2 + hstepB, voffB); PG8_STAGE(PG8_SA(0, 0), a2, voffA);
            PG8_WAIT_V(8); PG8_WAIT_L(0); PG8_BAR; PG8_MMA(1, 0, At, B0); PG8_MMA(1, 1, At, B1); PG8_BAR; PG8_SCHED;
            PG8_LDB(B0, 1, 0); PG8_LDB(B1, 1, 1); PG8_SCHED; PG8_LDA(At, 1, 0); PG8_STAGE(PG8_SA(0, 1), a2 + hstepA, voffA);
            PG8_WAIT_V(8); PG8_WAIT_L(0); PG8_BAR; PG8_MMA(0, 0, At, B0); PG8_MMA(0, 1, At, B1); PG8_BAR; PG8_SCHED;
            PG8_LDA(At, 1, 1); PG8_STAGE(PG8_SB(1, 0), b3, voffB); PG8_STAGE(PG8_SB(1, 1), b3 + hstepB, voffB); PG8_STAGE(PG8_SA(1, 0), a3, voffA);
            PG8_WAIT_V(8); PG8_WAIT_L(0); PG8_BAR; PG8_MMA(1, 0, At, B0); PG8_MMA(1, 1, At, B1); PG8_BAR; PG8_SCHED;
            } else {
            PG8_LDB(B0, 0, 0); PG8_SCHED; PG8_LDA(At, 0, 0); PG8_STAGE(PG8_SA(1, 1), a1 + hstepA, voffA);
            PG8_WAIT_L(8); PG8_BAR; PG8_WAIT_L(0); PG8_MMA(0, 0, At, B0); PG8_BAR; PG8_SCHED;
            PG8_LDB(B1, 0, 1); PG8_STAGE(PG8_SB(0, 0), b2, voffB);
            PG8_BAR; PG8_WAIT_L(0); PG8_MMA(0, 1, At, B1); PG8_BAR;
            PG8_LDA(At, 0, 1); PG8_STAGE(PG8_SA(0, 0), a2, voffA);
            PG8_BAR; PG8_WAIT_L(0); PG8_MMA(1, 0, At, B0); PG8_BAR; PG8_SCHED;
            PG8_STAGE(PG8_SB(0, 1), b2 + hstepB, voffB);
            PG8_WAIT_V(6); PG8_BAR; PG8_MMA(1, 1, At, B1); PG8_BAR;
            PG8_LDB(B0, 1, 0); PG8_SCHED; PG8_LDA(At, 1, 0); PG8_STAGE(PG8_SA(0, 1), a2 + hstepA, voffA);
            PG8_WAIT_L(8); PG8_BAR; PG8_WAIT_L(0); PG8_MMA(0, 0, At, B0); PG8_BAR; PG8_SCHED;
            PG8_LDB(B1, 1, 1); PG8_STAGE(PG8_SB(1, 0), b3, voffB);
            PG8_BAR; PG8_WAIT_L(0); PG8_MMA(0, 1, At, B1); PG8_BAR;
            PG8_LDA(At, 1, 1); PG8_STAGE(PG8_SA(1, 0), a3, voffA);
            PG8_BAR; PG8_WAIT_L(0); PG8_MMA(1, 0, At, B0); PG8_BAR; PG8_SCHED;
            PG8_STAGE(PG8_SB(1, 1), b3 + hstepB, voffB);
            PG8_WAIT_V(6); PG8_BAR; PG8_MMA(1, 1, At, B1); PG8_BAR;
            }
        }
        if constexpr (ALIGN_EPI) { if (wr == 0) PG8_BAR; }
        if constexpr (!Epi::AFTER_DRAIN) { E(acc, cur, wr, wc, fr, fq); S.done(cur); }
        if (!has_next) break;
#pragma unroll
        for (int a = 0; a < 2; ++a)
#pragma unroll
            for (int b = 0; b < 2; ++b)
#pragma unroll
                for (int m = 0; m < 4; ++m)
#pragma unroll
                    for (int n = 0; n < 2; ++n) acc[a][b][m][n] = (f32x4){0.f, 0.f, 0.f, 0.f};
        cur = nxt; cA = nA; cB = nB; ++ui;
        if constexpr (ALIGN_EPI) { if (wr == 1) PG8_BAR; }
    }
    PG8_WAIT_V(0);
    if constexpr (!ALIGN_EPI) { if (wr == 0) PG8_BAR; }
    PG8_BAR;
    if constexpr (Epi::AFTER_DRAIN) { E.fused(acc, cur, wr, wc, fr, fq, lds, wid, lane); S.done(cur); }
#undef PG8_SA
#undef PG8_SB
#undef PG8_STAGE
#undef PG8_LDA
#undef PG8_LDB
#undef PG8_MMA
#undef PG8_WAIT_V
#undef PG8_WAIT_L
#undef PG8_BAR
#undef PG8_SCHED
}
}

struct GemmOp { const bf16_t* A; int lda; const bf16_t* Bt; int ldb; int K; };

DEV void gemm_tile(f32x4 (&acc)[4][2], const GemmOp& g, int m0, int n0, char* lds) {
    const int tid = threadIdx.x, lane = tid & 63, wid = __builtin_amdgcn_readfirstlane(tid >> 6), wm = wid >> 2, wn = wid & 3, fr = lane & 15, fq = lane >> 4;
    const int sr = tid >> 3, sc = tid & 7;
    const bf16_t* ga = g.A + (size_t)(m0 + sr) * g.lda + sc * 8;
    const bf16_t* gb = g.Bt + (size_t)(n0 + sr) * g.ldb + sc * 8;
    const size_t a64 = (size_t)64 * g.lda, b64 = (size_t)64 * g.ldb;
    const int so = sr * 128 + ((sc ^ (sr & 7)) << 4);
    const int nk = g.K >> 6;
    u32x4 ra0 = *(const u32x4*)ga, ra1 = *(const u32x4*)(ga + a64), rb0 = *(const u32x4*)gb, rb1 = *(const u32x4*)(gb + b64);
    *(u32x4*)(lds + so) = ra0; *(u32x4*)(lds + so + 8192) = ra1; *(u32x4*)(lds + 32768 + so) = rb0; *(u32x4*)(lds + 32768 + so + 8192) = rb1;
    __syncthreads();
    const int aoff = (wm * 64 + fr) * 128, boff = 32768 + (wn * 32 + fr) * 128, sw = fr & 7;
    for (int kt = 0; kt < nk; ++kt) {
        const int cur = (kt & 1) * 16384;
        if (kt + 1 < nk) { ga += 64; gb += 64; ra0 = *(const u32x4*)ga; ra1 = *(const u32x4*)(ga + a64); rb0 = *(const u32x4*)gb; rb1 = *(const u32x4*)(gb + b64); }
#pragma unroll
        for (int ks = 0; ks < 2; ++ks) {
            const int ch = ((fq + 4 * ks) ^ sw) << 4;
            bf16x8 af[4], bfr[2];
#pragma unroll
            for (int mi = 0; mi < 4; ++mi) af[mi] = *(const bf16x8*)(lds + cur + aoff + mi * 2048 + ch);
#pragma unroll
            for (int ni = 0; ni < 2; ++ni) bfr[ni] = *(const bf16x8*)(lds + cur + boff + ni * 2048 + ch);
#pragma unroll
            for (int mi = 0; mi < 4; ++mi)
#pragma unroll
                for (int ni = 0; ni < 2; ++ni) acc[mi][ni] = mfma16(bfr[ni], af[mi], acc[mi][ni]);
        }
        if (kt + 1 < nk) {
            const int nxt = cur ^ 16384;
            *(u32x4*)(lds + nxt + so) = ra0; *(u32x4*)(lds + nxt + so + 8192) = ra1; *(u32x4*)(lds + 32768 + nxt + so) = rb0; *(u32x4*)(lds + 32768 + nxt + so + 8192) = rb1;
        }
        __syncthreads();
    }
}
#define GEMM_EPI_LOOP(...) { const int tid_ = threadIdx.x, lane_ = tid_ & 63, wid_ = tid_ >> 6, wm_ = wid_ >> 2, wn_ = wid_ & 3, fr_ = lane_ & 15, fq_ = lane_ >> 4; \
    _Pragma("unroll") for (int mi = 0; mi < 4; ++mi) _Pragma("unroll") for (int ni = 0; ni < 2; ++ni) { const int m = m0 + wm_ * 64 + mi * 16 + fr_, n = n0 + wn_ * 32 + ni * 16 + fq_ * 4; __VA_ARGS__ } }

DEV void stage_gemm_in(const Params& p, char* lds, int vb, int nvb) {
    pg8::Gemm g{(const bf16_t*)(p.ws + WS_UB), (const bf16_t*)(p.ws + WS_WIN), M, 4864, 1024, 1024, 1024};
    pg8::StaticOrder S; S.init(M, 4864, nvb, vb);
    pg8::EpiIn E{(bf16_t*)(p.ws + WS_PA), (bf16_t*)(p.ws + WS_PM), (bf16_t*)(p.ws + WS_PG)};
    pg8::gemm_phase<pg8::EpiIn, pg8::StaticOrder, true, true>((PG8_LAS unsigned char*)lds, g, S, E);
}
DEV void stage_gemm_merge(const Params& p, char* lds, int vb, int nvb) {
    const bf16_t* PG = (const bf16_t*)(p.ws + WS_PG); bf16_t* MG = (bf16_t*)(p.ws + WS_UB);
    {
        pg8::Gemm g{(const bf16_t*)(p.ws + WS_PA), (const bf16_t*)(p.ws + WS_WA), M, 1024, 512, LPA, 512};
        pg8::StaticOrder S; S.init(M, 1024, nvb, vb);
        pg8::EpiMerge E{PG, MG, 0};
        pg8::gemm_phase<pg8::EpiMerge, pg8::StaticOrder, true, true>((PG8_LAS unsigned char*)lds, g, S, E);
    }
    {
        pg8::Gemm g{(const bf16_t*)(p.ws + WS_PM) + 1536, (const bf16_t*)(p.ws + WS_WB), M, 1024, 512, LPM, 512};
        pg8::StaticOrder S; S.init(M, 1024, nvb, vb);
        pg8::EpiMerge E{PG + 1024, MG, 1};
        pg8::gemm_phase<pg8::EpiMerge, pg8::StaticOrder, true, true>((PG8_LAS unsigned char*)lds, g, S, E);
    }
}
DEV void stage_gemm_out(const Params& p, char* lds, int vb, int nvb) {
    pg8::Gemm g{(const bf16_t*)(p.ws + WS_UB), (const bf16_t*)(p.ws + WS_WOUT), M, 1024, 1024, 1024, 1024};
    pg8::StaticOrder S; S.init(M, 1024, nvb, vb);
    pg8::EpiOut E{p.x, (const float*)(p.ws + WS_MOD) + 2048, p.out, SEQ};
    pg8::gemm_phase<pg8::EpiOut, pg8::StaticOrder, true, true>((PG8_LAS unsigned char*)lds, g, S, E);
}

DEV void rope8(u32x4 x1, u32x4 x2, const float4* rp, float scale, u32x4& o1, u32x4& o2) {
#pragma unroll
    for (int w = 0; w < 4; ++w) {
        const float4 cs = rp[w];
        const float a0 = bflo(x1[w]), a1 = bfhi(x1[w]), b0 = bflo(x2[w]), b1 = bfhi(x2[w]);
        o1[w] = pk2((a0 * cs.x - b0 * cs.y) * scale, (a1 * cs.z - b1 * cs.w) * scale);
        o2[w] = pk2((b0 * cs.x + a0 * cs.y) * scale, (b1 * cs.z + a1 * cs.w) * scale);
    }
}

DEV void stage_attn(const Params& p, char* lds, int vb, int nvb) {
    const int tid = threadIdx.x, lane = tid & 63, wave = __builtin_amdgcn_readfirstlane(tid >> 6), fr = lane & 15, fq = lane >> 4;
    char* Ks = lds;
    char* VT = lds + 32768;
    char* Qs = lds + 70656;
    char* Ps = lds + 87040;
    bf16_t* PA = (bf16_t*)(p.ws + WS_PA);
    const float2* rope = (const float2*)(p.ws + WS_ROPE);
    for (int unit = vb; unit < 512; unit += nvb) {
        const int kvh = unit & 1, n = (unit >> 1) & 127, b = unit >> 8;
        __syncthreads();
        for (int task = tid; task < 1024; task += NTH) {
            const int ki = task >> 2, cp = task & 3, pos = 128 * (n - 1) + ki;
            u32x4 o1 = {0u, 0u, 0u, 0u}, o2 = {0u, 0u, 0u, 0u};
            if (pos >= 0) {
                const bf16_t* src = PA + (size_t)(b * SEQ + pos) * LPA + 512 + kvh * 64 + cp * 8;
                const u32x4 x1 = *(const u32x4*)src, x2 = *(const u32x4*)(src + 32);
                rope8(x1, x2, (const float4*)(rope + (size_t)pos * 32 + cp * 8), 1.0f, o1, o2);
            }
            const int sw = ki & 7;
            *(u32x4*)(Ks + ki * 128 + ((cp ^ sw) << 4)) = o1;
            *(u32x4*)(Ks + ki * 128 + (((cp + 4) ^ sw) << 4)) = o2;
        }
        for (int task = tid; task < 2048; task += NTH) {
            const int ki = task >> 3, c = task & 7, pos = 128 * (n - 1) + ki;
            u32x4 x = {0u, 0u, 0u, 0u};
            if (pos >= 0) x = *(const u32x4*)(PA + (size_t)(b * SEQ + pos) * LPA + 640 + kvh * 64 + c * 8);
#pragma unroll
            for (int e = 0; e < 8; ++e) *(bf16_t*)(VT + (c * 8 + e) * 592 + ki * 2) = (bf16_t)((e & 1) ? (x[e >> 1] >> 16) : (x[e >> 1] & 0xffffu));
        }
        for (int i = tid; i < 64 * 40; i += NTH) { const int d = i / 40, kk = 256 + i % 40; *(bf16_t*)(VT + d * 592 + kk * 2) = 0; }
        for (int i = tid; i < 2048; i += NTH) { const int w = i >> 8, r = (i >> 4) & 15, kk = 144 + (i & 15); *(bf16_t*)(Ps + w * 5376 + r * 336 + kk * 2) = 0; }
        for (int j = 0; j < 4; ++j) {
            const int hq = kvh * 4 + j;
            {
                const int qi = tid >> 2, cp = tid & 3, pos = 128 * n + qi;
                const bf16_t* src = PA + (size_t)(b * SEQ + pos) * LPA + hq * 64 + cp * 8;
                const u32x4 x1 = *(const u32x4*)src, x2 = *(const u32x4*)(src + 32);
                u32x4 o1, o2;
                rope8(x1, x2, (const float4*)(rope + (size_t)pos * 32 + cp * 8), 0.125f, o1, o2);
                const int sw = qi & 7;
                *(u32x4*)(Qs + qi * 128 + ((cp ^ sw) << 4)) = o1;
                *(u32x4*)(Qs + qi * 128 + (((cp + 4) ^ sw) << 4)) = o2;
            }
            __syncthreads();
            f32x4 s[9];
            const int sw = fr & 7;
            bf16x8 qf[2];
#pragma unroll
            for (int ks = 0; ks < 2; ++ks) qf[ks] = *(const bf16x8*)(Qs + (16 * wave + fr) * 128 + (((fq + 4 * ks) ^ sw) << 4));
#pragma unroll
            for (int t = 0; t < 9; ++t) {
                s[t] = (f32x4){0.f, 0.f, 0.f, 0.f};
#pragma unroll
                for (int ks = 0; ks < 2; ++ks) { const bf16x8 kf = *(const bf16x8*)(Ks + (16 * (wave + t) + fr) * 128 + (((fq + 4 * ks) ^ sw) << 4)); s[t] = mfma16(kf, qf[ks], s[t]); }
            }
            const float sink = p.sinks[hq];
            float mx = sink;
#pragma unroll
            for (int t = 0; t < 9; ++t)
#pragma unroll
                for (int r = 0; r < 4; ++r) {
                    const int dd = 16 * t + 4 * fq + r - fr, ki = 16 * (wave + t) + 4 * fq + r;
                    const bool ok = (dd >= 1) && (dd <= 128) && (n > 0 || ki >= 128);
                    const float v = ok ? s[t][r] : -INFINITY;
                    s[t][r] = v; mx = fmaxf(mx, v);
                }
            mx = fmaxf(mx, __shfl_xor(mx, 16)); mx = fmaxf(mx, __shfl_xor(mx, 32));
            float sum = 0.f;
#pragma unroll
            for (int t = 0; t < 9; ++t)
#pragma unroll
                for (int r = 0; r < 4; ++r) { const float pv = __expf(s[t][r] - mx); s[t][r] = pv; sum += pv; }
            sum += __shfl_xor(sum, 16); sum += __shfl_xor(sum, 32);
            const float inv = 1.f / (sum + __expf(sink - mx));
            char* Pw = Ps + wave * 5376 + fr * 336;
#pragma unroll
            for (int t = 0; t < 9; ++t) { u32x2 o; o.x = pk2(s[t][0], s[t][1]); o.y = pk2(s[t][2], s[t][3]); *(u32x2*)(Pw + (16 * t + 4 * fq) * 2) = o; }
            __syncthreads();
            f32x4 o[4];
#pragma unroll
            for (int di = 0; di < 4; ++di) o[di] = (f32x4){0.f, 0.f, 0.f, 0.f};
#pragma unroll
            for (int ks = 0; ks < 5; ++ks) {
                const bf16x8 pf = *(const bf16x8*)(Pw + (32 * ks + 8 * fq) * 2);
#pragma unroll
                for (int di = 0; di < 4; ++di) { const bf16x8 vf = *(const bf16x8*)(VT + (16 * di + fr) * 592 + (16 * wave + 32 * ks + 8 * fq) * 2); o[di] = mfma16(vf, pf, o[di]); }
            }
            bf16_t* dst = PA + (size_t)(b * SEQ + 128 * n + 16 * wave + fr) * LPA + hq * 64 + 4 * fq;
#pragma unroll
            for (int di = 0; di < 4; ++di) { u32x2 w; w.x = pk2(o[di][0] * inv, o[di][1] * inv); w.y = pk2(o[di][2] * inv, o[di][3] * inv); *(u32x2*)(dst + 16 * di) = w; }
            __syncthreads();
        }
    }
}

DEV float logsigf(float x) { return fminf(x, 0.f) - log1pf(expf(-fabsf(x))); }

DEV void chunk_gates(const float* ipre, const float* fpre, int rowbase, int h, float* gs, int lane) {
    const int l0 = 2 * lane;
    const float i0 = ipre[(size_t)(rowbase + l0) * 4 + h], i1 = ipre[(size_t)(rowbase + l0 + 1) * 4 + h];
    const float lf0 = logsigf(fpre[(size_t)(rowbase + l0) * 4 + h]), lf1 = logsigf(fpre[(size_t)(rowbase + l0 + 1) * 4 + h]);
    const float pair = lf0 + lf1;
    float sc = pair;
#pragma unroll
    for (int o = 1; o < 64; o <<= 1) { const float t = __shfl_up(sc, o); if (lane >= o) sc += t; }
    const float b0 = (sc - pair) + lf0, b1 = b0 + lf1;
    const float g = __shfl(sc, 63);
    const float a0 = g - b0 + i0, a1 = g - b1 + i1;
    const float mloc = wave_max(fmaxf(a0, a1));
    const float ib0 = i0 - b0, ib1 = i1 - b1;
    float scm = fmaxf(ib0, ib1);
#pragma unroll
    for (int o = 1; o < 64; o <<= 1) { const float t = __shfl_up(scm, o); if (lane >= o) scm = fmaxf(scm, t); }
    float ex = __shfl_up(scm, 1); if (lane == 0) ex = -INFINITY;
    const float pm0 = fmaxf(ex, ib0), pm1 = fmaxf(pm0, ib1);
    gs[l0] = b0; gs[l0 + 1] = b1; gs[128 + l0] = ib0; gs[128 + l0 + 1] = ib1; gs[256 + l0] = a0; gs[256 + l0 + 1] = a1; gs[384 + l0] = pm0; gs[384 + l0 + 1] = pm1;
    if (lane == 0) { gs[512] = g; gs[513] = mloc; }
}

DEV void conv8(const bf16_t* PM, const float* cw, int b, int t, int pmcol, int cch, float (&out)[8]) {
#pragma unroll
    for (int e = 0; e < 8; ++e) out[e] = 0.f;
#pragma unroll
    for (int j = 0; j < 4; ++j) {
        const int tt = t - 3 + j;
        if (tt >= 0) {
            const u32x4 x = *(const u32x4*)(PM + (size_t)(b * SEQ + tt) * LPM + pmcol);
            const float4 w0 = *(const float4*)(cw + j * 1024 + cch), w1 = *(const float4*)(cw + j * 1024 + cch + 4);
            out[0] += bflo(x[0]) * w0.x; out[1] += bfhi(x[0]) * w0.y; out[2] += bflo(x[1]) * w0.z; out[3] += bfhi(x[1]) * w0.w;
            out[4] += bflo(x[2]) * w1.x; out[5] += bfhi(x[2]) * w1.y; out[6] += bflo(x[3]) * w1.z; out[7] += bfhi(x[3]) * w1.w;
        }
    }
}
DEV float siluf_(float y) { return y / (1.f + __expf(-y)); }

DEV void stage_mstate(const Params& p, char* lds, int vb, int nvb) {
    const int tid = threadIdx.x, lane = tid & 63, wave = __builtin_amdgcn_readfirstlane(tid >> 6), fr = lane & 15, fq = lane >> 4;
    char* KT = lds;
    char* VT = lds + 34816;
    float* gs = (float*)(lds + 69632);
    const bf16_t* PM = (const bf16_t*)(p.ws + WS_PM);
    const float* ipre = (const float*)(p.ws + WS_IPRE); const float* fpre = (const float*)(p.ws + WS_FPRE);
    float* UT = (float*)(p.ws + WS_UB); float* NLOC = (float*)(p.ws + WS_NLOC);
    float* G = (float*)(p.ws + WS_CHG); float* MLOC = G + 1024;
    for (int unit = vb; unit < 1024; unit += nvb) {
        const int c = unit & 127, h = (unit >> 7) & 3, b = unit >> 9;
        const int rowbase = b * SEQ + c * 128;
        __syncthreads();
        if (wave == 0) chunk_gates(ipre, fpre, rowbase, h, gs, lane);
        __syncthreads();
        const float mloc = gs[513];
        for (int task = tid; task < 2048; task += NTH) {
            const int l = task >> 4, ch = task & 15;
            float v8[8]; conv8(PM, p.conv_w, b, c * 128 + l, 512 + h * 128 + ch * 8, 512 + h * 128 + ch * 8, v8);
            const float wgt = __expf(gs[256 + l] - mloc) * 0.08838834764831845f;
#pragma unroll
            for (int e = 0; e < 8; ++e) *(bf16_t*)(KT + (ch * 8 + e) * 272 + l * 2) = (bf16_t)f2bf(siluf_(v8[e]) * wgt);
        }
        for (int task = tid; task < 2048; task += NTH) {
            const int l = task >> 4, ch = task & 15;
            const u32x4 x = *(const u32x4*)(PM + (size_t)(rowbase + l) * LPM + 1024 + h * 128 + ch * 8);
#pragma unroll
            for (int e = 0; e < 8; ++e) *(bf16_t*)(VT + (ch * 8 + e) * 272 + l * 2) = (bf16_t)((e & 1) ? (x[e >> 1] >> 16) : (x[e >> 1] & 0xffffu));
        }
        __syncthreads();
        f32x4 acc[8];
#pragma unroll
        for (int t = 0; t < 8; ++t) acc[t] = (f32x4){0.f, 0.f, 0.f, 0.f};
#pragma unroll
        for (int ks = 0; ks < 4; ++ks) {
            const bf16x8 vf = *(const bf16x8*)(VT + (16 * wave + fr) * 272 + (32 * ks + 8 * fq) * 2);
#pragma unroll
            for (int t = 0; t < 8; ++t) { const bf16x8 kf = *(const bf16x8*)(KT + (16 * t + fr) * 272 + (32 * ks + 8 * fq) * 2); acc[t] = mfma16(kf, vf, acc[t]); }
        }
        float* UTu = UT + (size_t)unit * 16384 + (16 * wave + fr) * 128 + 4 * fq;
#pragma unroll
        for (int t = 0; t < 8; ++t) *(f32x4*)(UTu + 16 * t) = acc[t];
        if (tid < 128) { float s = 0.f; for (int l = 0; l < 128; ++l) s += bf2f(*(const bf16_t*)(KT + tid * 272 + l * 2)); NLOC[unit * 128 + tid] = s; }
        if (tid == 0) { G[unit] = gs[512]; MLOC[unit] = mloc; }
    }
}

DEV void stage_mscan(const Params& p, char* lds, int vb, int nvb) {
    const int tid = threadIdx.x;
    float* s_dec = (float*)lds; float* s_scl = s_dec + 128;
    const float* UT = (const float*)(p.ws + WS_UB); const float* NLOC = (const float*)(p.ws + WS_NLOC);
    const float* G = (const float*)(p.ws + WS_CHG); const float* MLOC = G + 1024; float* MST = (float*)(p.ws + WS_CHG) + 2048;
    bf16_t* CST = (bf16_t*)(p.ws + WS_CST); float* NST = (float*)(p.ws + WS_NST);
    for (int item = vb; item < 256; item += nvb) {
        const int bh = item >> 5, part = item & 31;
        __syncthreads();
        if (tid == 0) {
            float m = 0.f;
            for (int c = 0; c < 128; ++c) { const int u = bh * 128 + c; const float g = G[u], ml = MLOC[u]; const float mn = fmaxf(g + m, ml); s_dec[c] = expf(g + m - mn); s_scl[c] = expf(ml - mn); if (part == 0) MST[u] = m; m = mn; }
        }
        __syncthreads();
        const int e = part * 512 + tid;
        float C = 0.f;
        const float* up = UT + (size_t)bh * 128 * 16384 + e; bf16_t* cp = CST + (size_t)bh * 128 * 16384 + e;
        for (int c = 0; c < 128; c += 8) {
            float uu[8];
#pragma unroll
            for (int i = 0; i < 8; ++i) uu[i] = up[(size_t)(c + i) * 16384];
#pragma unroll
            for (int i = 0; i < 8; ++i) { cp[(size_t)(c + i) * 16384] = (bf16_t)f2bf(C); C = s_dec[c + i] * C + s_scl[c + i] * uu[i]; }
        }
        if (part == 0 && tid < 128) { float nn = 0.f; for (int c = 0; c < 128; ++c) { NST[(bh * 128 + c) * 128 + tid] = nn; nn = s_dec[c] * nn + s_scl[c] * NLOC[(bh * 128 + c) * 128 + tid]; } }
    }
}

DEV void stage_mout(const Params& p, char* lds, int vb, int nvb) {
    const int tid = threadIdx.x, lane = tid & 63, wave = __builtin_amdgcn_readfirstlane(tid >> 6), fr = lane & 15, fq = lane >> 4;
    char* Qs = lds; char* Ks = lds + 34816; char* VT = lds + 69632; char* CT = lds + 104448;
    float* gs = (float*)(lds + 139264); float* s_nst = gs + 520; float* s_mo = gs + 648; float* s_wi = gs + 776;
    bf16_t* PM = (bf16_t*)(p.ws + WS_PM);
    const float* ipre = (const float*)(p.ws + WS_IPRE); const float* fpre = (const float*)(p.ws + WS_FPRE);
    const float* MST = (const float*)(p.ws + WS_CHG) + 2048; const float* NST = (const float*)(p.ws + WS_NST);
    const bf16_t* CST = (const bf16_t*)(p.ws + WS_CST);
    for (int unit = vb; unit < 1024; unit += nvb) {
        const int c = unit & 127, h = (unit >> 7) & 3, b = unit >> 9;
        const int rowbase = b * SEQ + c * 128;
        __syncthreads();
        if (wave == 0) chunk_gates(ipre, fpre, rowbase, h, gs, lane);
        for (int task = tid; task < 2048; task += NTH) {
            const int l = task >> 4, ch = task & 15;
            float v8[8]; u32x4 o;
            conv8(PM, p.conv_w, b, c * 128 + l, h * 128 + ch * 8, h * 128 + ch * 8, v8);
            o.x = pk2(siluf_(v8[0]), siluf_(v8[1])); o.y = pk2(siluf_(v8[2]), siluf_(v8[3])); o.z = pk2(siluf_(v8[4]), siluf_(v8[5])); o.w = pk2(siluf_(v8[6]), siluf_(v8[7]));
            *(u32x4*)(Qs + l * 272 + ch * 16) = o;
            conv8(PM, p.conv_w, b, c * 128 + l, 512 + h * 128 + ch * 8, 512 + h * 128 + ch * 8, v8);
            const float sc = 0.08838834764831845f;
            o.x = pk2(siluf_(v8[0]) * sc, siluf_(v8[1]) * sc); o.y = pk2(siluf_(v8[2]) * sc, siluf_(v8[3]) * sc); o.z = pk2(siluf_(v8[4]) * sc, siluf_(v8[5]) * sc); o.w = pk2(siluf_(v8[6]) * sc, siluf_(v8[7]) * sc);
            *(u32x4*)(Ks + l * 272 + ch * 16) = o;
            const u32x4 x = *(const u32x4*)(PM + (size_t)(rowbase + l) * LPM + 1024 + h * 128 + ch * 8);
#pragma unroll
            for (int e = 0; e < 8; ++e) *(bf16_t*)(VT + (ch * 8 + e) * 272 + l * 2) = (bf16_t)((e & 1) ? (x[e >> 1] >> 16) : (x[e >> 1] & 0xffffu));
            *(u32x4*)(CT + l * 272 + ch * 16) = *(const u32x4*)(CST + (size_t)unit * 16384 + l * 128 + ch * 8);
        }
        if (tid < 128) s_nst[tid] = NST[unit * 128 + tid];
        __syncthreads();
        if (tid < 128) { const float mst = MST[unit]; const float bc = gs[tid]; const float mo = bc + fmaxf(mst, gs[384 + tid]); s_mo[tid] = mo; s_wi[tid] = __expf(bc + mst - mo); }
        __syncthreads();
        const int l = 16 * wave + fr;
        f32x4 s[8];
        bf16x8 qf[4];
#pragma unroll
        for (int ks = 0; ks < 4; ++ks) qf[ks] = *(const bf16x8*)(Qs + l * 272 + (32 * ks + 8 * fq) * 2);
#pragma unroll
        for (int t = 0; t < 8; ++t) {
            s[t] = (f32x4){0.f, 0.f, 0.f, 0.f};
            if (t <= wave) {
#pragma unroll
                for (int ks = 0; ks < 4; ++ks) { const bf16x8 kf = *(const bf16x8*)(Ks + (16 * t + fr) * 272 + (32 * ks + 8 * fq) * 2); s[t] = mfma16(kf, qf[ks], s[t]); }
            }
        }
        const float bl = gs[l], mol = s_mo[l];
        float dsum = 0.f;
#pragma unroll
        for (int t = 0; t < 8; ++t)
#pragma unroll
            for (int r = 0; r < 4; ++r) {
                const int si = 16 * t + 4 * fq + r; float wv = 0.f;
                if (t <= wave && si <= l) wv = __expf(bl + gs[128 + si] - mol) * s[t][r];
                s[t][r] = wv; dsum += wv;
            }
        dsum += __shfl_xor(dsum, 16); dsum += __shfl_xor(dsum, 32);
        float qn = 0.f;
        {
            const char* qrow = Qs + l * 272 + fq * 64;
#pragma unroll
            for (int i = 0; i < 4; ++i) {
                const u32x4 x = *(const u32x4*)(qrow + 16 * i); const float* nn = s_nst + fq * 32 + 8 * i;
                qn += bflo(x[0]) * nn[0] + bfhi(x[0]) * nn[1] + bflo(x[1]) * nn[2] + bfhi(x[1]) * nn[3] + bflo(x[2]) * nn[4] + bfhi(x[2]) * nn[5] + bflo(x[3]) * nn[6] + bfhi(x[3]) * nn[7];
            }
        }
        qn += __shfl_xor(qn, 16); qn += __shfl_xor(qn, 32);
        __syncthreads();
#pragma unroll
        for (int t = 0; t < 8; ++t)
            if (t <= wave + 1) { u32x2 o; o.x = pk2(s[t][0], s[t][1]); o.y = pk2(s[t][2], s[t][3]); *(u32x2*)(Ks + l * 272 + (16 * t + 4 * fq) * 2) = o; }
        __syncthreads();
        f32x4 acc[8];
#pragma unroll
        for (int t = 0; t < 8; ++t) acc[t] = (f32x4){0.f, 0.f, 0.f, 0.f};
#pragma unroll
        for (int ks = 0; ks < 4; ++ks)
#pragma unroll
            for (int t = 0; t < 8; ++t) { const bf16x8 cf = *(const bf16x8*)(CT + (16 * t + fr) * 272 + (32 * ks + 8 * fq) * 2); acc[t] = mfma16(cf, qf[ks], acc[t]); }
        const float wi = s_wi[l];
#pragma unroll
        for (int t = 0; t < 8; ++t) acc[t] = acc[t] * wi;
        const int nks = (wave + 2) >> 1;
#pragma unroll
        for (int ks = 0; ks < 4; ++ks)
            if (ks < nks) {
                const bf16x8 wf = *(const bf16x8*)(Ks + l * 272 + (32 * ks + 8 * fq) * 2);
#pragma unroll
                for (int t = 0; t < 8; ++t) { const bf16x8 vf = *(const bf16x8*)(VT + (16 * t + fr) * 272 + (32 * ks + 8 * fq) * 2); acc[t] = mfma16(vf, wf, acc[t]); }
            }
        const float den = dsum + wi * qn;
        const float invd = 1.f / fmaxf(fabsf(den), __expf(-mol));
        bf16_t* mop = PM + (size_t)(rowbase + l) * LPM + 1536 + h * 128 + 4 * fq;
        float ssq = 0.f;
#pragma unroll
        for (int t = 0; t < 8; ++t) {
            const u32x2 g2 = *(const u32x2*)(mop + 16 * t);
            const float gg[4] = {bflo(g2.x), bfhi(g2.x), bflo(g2.y), bfhi(g2.y)};
#pragma unroll
            for (int r = 0; r < 4; ++r) { const float hv = acc[t][r] * invd * sigmoidf_(gg[r]); acc[t][r] = hv; ssq += hv * hv; }
        }
        ssq += __shfl_xor(ssq, 16); ssq += __shfl_xor(ssq, 32);
        const float rn = rsqrtf(ssq * (1.f / 128.f) + 1e-6f);
#pragma unroll
        for (int t = 0; t < 8; ++t) {
            const float4 nw = *(const float4*)(p.mnorm_w + h * 128 + 16 * t + 4 * fq);
            u32x2 o; o.x = pk2(acc[t][0] * rn * nw.x, acc[t][1] * rn * nw.y); o.y = pk2(acc[t][2] * rn * nw.z, acc[t][3] * rn * nw.w);
            *(u32x2*)(mop + 16 * t) = o;
        }
    }
}

DEV void stage_norm2(const Params& p, char* lds, int vb, int nvb) {
    const int tid = threadIdx.x, lane = tid & 63, wave = __builtin_amdgcn_readfirstlane(tid >> 6);
    const float* mod = (const float*)(p.ws + WS_MOD);
    bf16_t* U2 = (bf16_t*)(p.ws + WS_PG);
    for (int m = vb * NW + wave; m < M; m += nvb * NW) {
        const int b = m >= SEQ ? 1 : 0;
        const float4* xr = (const float4*)(p.out + (size_t)m * D);
        float4 v[4]; float ss = 0.f;
#pragma unroll
        for (int j = 0; j < 4; ++j) { v[j] = xr[lane + 64 * j]; ss += v[j].x * v[j].x + v[j].y * v[j].y + v[j].z * v[j].z + v[j].w * v[j].w; }
        ss = wave_sum(ss);
        const float rstd = rsqrtf(ss * (1.f / 1024.f) + 1e-6f);
#pragma unroll
        for (int j = 0; j < 4; ++j) {
            const int col = 4 * (lane + 64 * j);
            const float4 w1 = *(const float4*)(p.norm2_w + col), sc = *(const float4*)(mod + b * 6144 + 4096 + col), sh = *(const float4*)(mod + b * 6144 + 3072 + col);
            u32x2 o;
            o.x = pk2(v[j].x * rstd * w1.x * (1.f + sc.x) + sh.x, v[j].y * rstd * w1.y * (1.f + sc.y) + sh.y);
            o.y = pk2(v[j].z * rstd * w1.z * (1.f + sc.z) + sh.z, v[j].w * rstd * w1.w * (1.f + sc.w) + sh.w);
            *(u32x2*)(U2 + (size_t)m * D + col) = o;
        }
    }
}

constexpr size_t WS_SELI = 400 * MiB;
constexpr size_t WS_SELG = 416 * MiB;
constexpr size_t WS_SC = 64 * MiB;
DEV unsigned f2ord(float f) { const unsigned u = __float_as_uint(f); return (u & 0x80000000u) ? ~u : (u | 0x80000000u); }
DEV float ord2f(unsigned k) { return __uint_as_float((k & 0x80000000u) ? (k ^ 0x80000000u) : ~k); }
DEV unsigned umax_(unsigned a, unsigned b) { return a > b ? a : b; }

DEV void stage_gemm_q(const Params& p, char* lds, int vb, int nvb) {
    pg8::Gemm g{(const bf16_t*)(p.ws + WS_PG), (const bf16_t*)(p.ws + WS_WQ), M, 2048, 1024, 1024, 1024};
    pg8::StaticOrder S; S.init(M, 2048, nvb, vb);
    pg8::EpiF32 E{(float*)(p.ws + WS_SC), 2048};
    pg8::gemm_phase<pg8::EpiF32, pg8::StaticOrder, true, true>((PG8_LAS unsigned char*)lds, g, S, E);
}

DEV void stage_q_topk(const Params& p, char* lds, int vb, int nvb) {
    const int tid = threadIdx.x, lane = tid & 63, wave = __builtin_amdgcn_readfirstlane(tid >> 6), fr = lane & 15, fq = lane >> 4;
    unsigned* tops = (unsigned*)lds;
    const float* SC = (const float*)(p.ws + WS_SC);
    int* SELI = (int*)(p.ws + WS_SELI); float* SELG = (float*)(p.ws + WS_SELG);
    __syncthreads();
    for (int item = vb; item < 2048; item += nvb) {
        const int mt = item >> 3, h = item & 7, m0 = mt * 128;
        const float* srow = SC + (size_t)(m0 + 16 * wave + fr) * 2048 + h * 256 + 4 * fq;
        f32x4 sv[2][8];
#pragma unroll
        for (int pp = 0; pp < 2; ++pp)
#pragma unroll
            for (int t = 0; t < 8; ++t) sv[pp][t] = *(const f32x4*)(srow + pp * 128 + 16 * t);
#pragma unroll
        for (int pp = 0; pp < 2; ++pp) {
            unsigned key[32];
#pragma unroll
            for (int t = 0; t < 8; ++t)
#pragma unroll
                for (int r = 0; r < 4; ++r) key[4 * t + r] = (f2ord(sv[pp][t][r]) & ~127u) | (127u - (unsigned)(16 * t + 4 * fq + r));
            unsigned prev = 0xffffffffu;
            for (int r = 0; r < 16; ++r) {
                unsigned best = 0u;
#pragma unroll
                for (int i = 0; i < 32; ++i) { const unsigned c = key[i] < prev ? key[i] : 0u; best = umax_(best, c); }
                best = umax_(best, (unsigned)__shfl_xor((int)best, 16)); best = umax_(best, (unsigned)__shfl_xor((int)best, 32));
                prev = best;
                if (fq == 0) tops[((16 * wave + fr) * 2 + pp) * 16 + r] = best;
            }
        }
        wave_lds_sync();
        const unsigned* tp = tops + (16 * wave + fr) * 32;
        float A[4], B[16];
#pragma unroll
        for (int m = 0; m < 4; ++m) A[m] = ord2f(tp[fq + 4 * m] & ~127u);
#pragma unroll
        for (int j = 0; j < 16; ++j) B[j] = ord2f(tp[16 + j] & ~127u);
        unsigned ck[21];
#pragma unroll
        for (int sl = 0; sl < 21; ++sl) {
            const int m = sl < 16 ? 0 : (sl < 19 ? 1 : (sl < 20 ? 2 : 3)), j = sl < 16 ? sl : (sl < 19 ? sl - 16 : 0);
            const int i = fq + 4 * m;
            const bool ok = j < 16 / (i + 1);
            ck[sl] = ok ? ((f2ord(A[m] + B[j]) & ~255u) | (255u - (unsigned)(i * 16 + j))) : 0u;
        }
        unsigned wins[16];
        {
            unsigned prev = 0xffffffffu;
#pragma unroll
            for (int r = 0; r < 16; ++r) {
                unsigned best = 0u;
#pragma unroll
                for (int sl = 0; sl < 21; ++sl) { const unsigned c = ck[sl] < prev ? ck[sl] : 0u; best = umax_(best, c); }
                best = umax_(best, (unsigned)__shfl_xor((int)best, 16)); best = umax_(best, (unsigned)__shfl_xor((int)best, 32));
                prev = best; wins[r] = best;
            }
        }
        const float v0 = ord2f(wins[0] & ~255u);
        float ex[16], sm = 0.f;
#pragma unroll
        for (int r = 0; r < 16; ++r) { ex[r] = __expf(ord2f(wins[r] & ~255u) - v0); sm += ex[r]; }
        const float rs = 1.f / sm;
        int oi[4]; float og[4];
#pragma unroll
        for (int q = 0; q < 4; ++q) {
            const unsigned w = fq == 0 ? wins[q] : (fq == 1 ? wins[4 + q] : (fq == 2 ? wins[8 + q] : wins[12 + q]));
            const float e = fq == 0 ? ex[q] : (fq == 1 ? ex[4 + q] : (fq == 2 ? ex[8 + q] : ex[12 + q]));
            const unsigned flat = 255u - (w & 255u); const unsigned ia = flat >> 4, jb = flat & 15u;
            oi[q] = (int)((127u - (tp[ia] & 127u)) * 128u + (127u - (tp[16 + jb] & 127u)));
            og[q] = e * rs;
        }
        const size_t so = (size_t)(m0 + 16 * wave + fr) * 128 + h * 16 + 4 * fq;
        *(int4*)(SELI + so) = make_int4(oi[0], oi[1], oi[2], oi[3]);
        *(float4*)(SELG + so) = make_float4(og[0], og[1], og[2], og[3]);
        wave_lds_sync();
    }
}

typedef float f32x2 __attribute__((ext_vector_type(2)));
typedef __bf16 bf16x2_t __attribute__((ext_vector_type(2)));
DEV float dpp_row_sum(float v) {
    v += __int_as_float(__builtin_amdgcn_update_dpp(0, __float_as_int(v), 0xB1, 0xF, 0xF, true));
    v += __int_as_float(__builtin_amdgcn_update_dpp(0, __float_as_int(v), 0x4E, 0xF, 0xF, true));
    v += __int_as_float(__builtin_amdgcn_update_dpp(0, __float_as_int(v), 0x141, 0xF, 0xF, true));
    v += __int_as_float(__builtin_amdgcn_update_dpp(0, __float_as_int(v), 0x140, 0xF, 0xF, true));
    return v;
}
DEV float gelu_as(float v) {
    const float av = fabsf(v), t = __builtin_amdgcn_rcpf(av * 0.2316418882f + 1.0f);
    float q = t * 0.5307027145f + (-0.7265760135f); q = q * t + 0.7107068705f; q = q * t + (-0.142248368f); q = q * t + 0.127414796f; q = q * t;
    const float e = __builtin_amdgcn_exp2f(v * v * (-0.72134752044f));
    const float m = v * (q * e);
    return v < 0.f ? m : v - m;
}
constexpr int NBIN = 32;
DEV void g_sort_token(const int* SELI, const float* SELG, const float* ISU, const float* ISV, int tkn, unsigned short* lidx, unsigned* lgs, int lane, int msk) {
    const int i0 = SELI[(size_t)tkn * 128 + lane] & msk, i1 = SELI[(size_t)tkn * 128 + 64 + lane] & msk;
    const unsigned g0 = (__float_as_uint(SELG[(size_t)tkn * 128 + lane] * ISV[i0]) & ~0xffu) | ((__float_as_uint(ISU[i0]) >> 23) & 0xffu);
    const unsigned g1 = (__float_as_uint(SELG[(size_t)tkn * 128 + 64 + lane] * ISV[i1]) & ~0xffu) | ((__float_as_uint(ISU[i1]) >> 23) & 0xffu);
    const int s0 = i0 >> 9, s1 = i1 >> 9;
    const unsigned long long lt = (1ull << lane) - 1ull;
    int base = 0, p0 = 0, p1 = 0;
#pragma unroll
    for (int s = 0; s < NBIN; ++s) {
        const unsigned long long m0 = __ballot(s0 == s), m1 = __ballot(s1 == s);
        const int c0 = __popcll(m0), c1 = __popcll(m1);
        if (s0 == s) p0 = base + __popcll(m0 & lt);
        if (s1 == s) p1 = base + c0 + __popcll(m1 & lt);
        base += c0 + c1;
    }
    lidx[p0] = (unsigned short)i0; lgs[p0] = g0; lidx[p1] = (unsigned short)i1; lgs[p1] = g1;
}
DEV void r_load(u32x4 (&d)[4], const unsigned char* T, int id, int c) {
    const u32x4* q = (const u32x4*)(T + (size_t)id * 1024 + c * 64);
#pragma unroll
    for (int k = 0; k < 4; ++k) d[k] = q[k];
}
DEV float r_dot(const u32x4 (&u)[4], const unsigned (&xp)[32]) {
    float d0 = 0.f, d1 = 0.f, d2 = 0.f, d3 = 0.f;
#pragma unroll
    for (int k = 0; k < 4; ++k)
#pragma unroll
        for (int w = 0; w < 4; w += 2) {
            d0 = __builtin_amdgcn_fdot2_f32_bf16(__builtin_amdgcn_cvt_scalef32_pk_bf16_fp8(u[k][w], 1.0f, false), __builtin_bit_cast(bf16x2_t, xp[8 * k + 2 * w]), d0, false);
            d1 = __builtin_amdgcn_fdot2_f32_bf16(__builtin_amdgcn_cvt_scalef32_pk_bf16_fp8(u[k][w], 1.0f, true), __builtin_bit_cast(bf16x2_t, xp[8 * k + 2 * w + 1]), d1, false);
            d2 = __builtin_amdgcn_fdot2_f32_bf16(__builtin_amdgcn_cvt_scalef32_pk_bf16_fp8(u[k][w + 1], 1.0f, false), __builtin_bit_cast(bf16x2_t, xp[8 * k + 2 * w + 2]), d2, false);
            d3 = __builtin_amdgcn_fdot2_f32_bf16(__builtin_amdgcn_cvt_scalef32_pk_bf16_fp8(u[k][w + 1], 1.0f, true), __builtin_bit_cast(bf16x2_t, xp[8 * k + 2 * w + 3]), d3, false);
        }
    return (d0 + d1) + (d2 + d3);
}
DEV float r_weight(float dpart, unsigned gb) {
    const float dd = dpp_row_sum(dpart) * __uint_as_float((gb & 0xffu) << 23);
    return __uint_as_float(gb & ~0xffu) * gelu_as(dd);
}
DEV void r_vacc(const u32x4 (&v)[4], float w, f32x2 (&acc)[32]) {
    const f32x2 w2 = {w, w};
#pragma unroll
    for (int k = 0; k < 4; ++k)
#pragma unroll
        for (int q = 0; q < 4; ++q) {
            acc[8 * k + 2 * q] = __builtin_elementwise_fma(__builtin_amdgcn_cvt_pk_f32_fp8((int)v[k][q], false), w2, acc[8 * k + 2 * q]);
            acc[8 * k + 2 * q + 1] = __builtin_elementwise_fma(__builtin_amdgcn_cvt_pk_f32_fp8((int)v[k][q], true), w2, acc[8 * k + 2 * q + 1]);
        }
}

DEV void stage_peer_gather(const Params& p, char* lds, int slot, int nslots, bool dry = false, int msk = 0x3fff) {
    const int tid = threadIdx.x, lane = tid & 63, wave = __builtin_amdgcn_readfirstlane(tid >> 6), r = lane >> 4, c = lane & 15;
    const bf16_t* U2 = (const bf16_t*)(p.ws + WS_PG);
    const unsigned char* TU = p.ws + WS_TU; const unsigned char* TV = p.ws + WS_TV;
    const float* ISU = (const float*)(p.ws + WS_ISU); const float* ISV = (const float*)(p.ws + WS_ISV);
    const int* SELI = (const int*)(p.ws + WS_SELI); const float* SELG = (const float*)(p.ws + WS_SELG);
    const float* mod = (const float*)(p.ws + WS_MOD);
    unsigned short* lidx = (unsigned short*)(lds + wave * 3072); unsigned* lgs = (unsigned*)(lds + wave * 3072 + 1024);
    const int tpb = M / nslots;
    __syncthreads();
    for (int g0 = 0; g0 < tpb; g0 += 32) {
        const int tbase = slot * tpb + g0 + 4 * wave;
#pragma unroll
        for (int j = 0; j < 4; ++j) g_sort_token(SELI, SELG, ISU, ISV, tbase + j, lidx + j * 128, lgs + j * 128, lane, msk);
        const int tkn = tbase + r;
        unsigned xp[32];
        {
            const u32x4* xr = (const u32x4*)(U2 + (size_t)tkn * D + 64 * c);
#pragma unroll
            for (int k = 0; k < 8; ++k) { const u32x4 t = xr[k]; xp[4 * k] = t[0]; xp[4 * k + 1] = t[1]; xp[4 * k + 2] = t[2]; xp[4 * k + 3] = t[3]; }
        }
        f32x2 acc[32];
#pragma unroll
        for (int i = 0; i < 32; ++i) acc[i] = (f32x2){0.f, 0.f};
        wave_lds_sync();
        const unsigned short* myi = lidx + r * 128; const unsigned* myg = lgs + r * 128;
        u32x4 ua[4], ub[4], va[4], vb[4];
        r_load(ua, TU, (int)myi[0], c); r_load(va, TV, (int)myi[0], c);
        r_load(ub, TU, (int)myi[1], c); r_load(vb, TV, (int)myi[1], c);
        float wcur = r_weight(r_dot(ua, xp), myg[0]);
        r_load(ua, TU, (int)myi[2], c);
        for (int e = 0; e < 128; e += 2) {
            const int e1 = e + 1, e2 = e + 2 < 128 ? e + 2 : 127, e3 = e + 3 < 128 ? e + 3 : 127;
#define SB_() __builtin_amdgcn_sched_barrier(0)
            SB_();
            const float dn = r_dot(ub, xp);
            SB_();
            r_load(ub, TU, (int)myi[e3], c);
            SB_();
            const float wn = r_weight(dn, myg[e1]);
            r_vacc(va, wcur, acc);
            SB_();
            r_load(va, TV, (int)myi[e2], c);
            SB_();
            const float dn2 = r_dot(ua, xp);
            SB_();
            r_load(ua, TU, (int)myi[e + 4 < 128 ? e + 4 : 127], c);
            SB_();
            const float wn2 = r_weight(dn2, myg[e2]);
            r_vacc(vb, wn, acc);
            SB_();
            r_load(vb, TV, (int)myi[e3], c);
            SB_();
            wcur = wn2;
        }
        const int b = tkn >= SEQ ? 1 : 0;
        float* hr = p.out + (size_t)tkn * D + 64 * c;
        const float* g2p = mod + b * 6144 + 5120 + 64 * c;
        float ss = 0.f;
#pragma unroll
        for (int q = 0; q < 16; ++q) {
            const float4 hv = *(const float4*)(hr + 4 * q); const float4 g2 = *(const float4*)(g2p + 4 * q);
            f32x2 y0 = acc[2 * q], y1 = acc[2 * q + 1];
            y0.x = hv.x + g2.x * y0.x; y0.y = hv.y + g2.y * y0.y; y1.x = hv.z + g2.z * y1.x; y1.y = hv.w + g2.w * y1.y;
            acc[2 * q] = y0; acc[2 * q + 1] = y1;
            ss += y0.x * y0.x + y0.y * y0.y + y1.x * y1.x + y1.y * y1.y;
        }
        ss = dpp_row_sum(ss);
        const float rstd = rsqrtf(ss * (1.f / 1024.f) + 1e-6f);
        if (!dry || rstd == 123.456f)
#pragma unroll
        for (int q = 0; q < 16; ++q) {
            const float4 nw = *(const float4*)(p.normf_w + 64 * c + 4 * q);
            float4 o; o.x = acc[2 * q].x * rstd * nw.x; o.y = acc[2 * q].y * rstd * nw.y; o.z = acc[2 * q + 1].x * rstd * nw.z; o.w = acc[2 * q + 1].y * rstd * nw.w;
            *(float4*)(hr + 4 * q) = o;
        }
        wave_lds_sync();
    }
}

#define LAS __attribute__((address_space(3)))
#define XB_TMO      128
#define XB_XCNT(j)  (256  + 64 * (j))
#define XB_XSUB(j)  (1280 + 64 * (j))
#define XB_XGEN(j)  (2304 + 64 * (j))
#define XB_TOP      3328
#define XB_TOPGEN   3392
#define XCD_BAR_WORDS 3456
#define XB_SPIN_CAP (1u << 18)

__device__ __forceinline__ unsigned xb_ld(unsigned* p)              { return __hip_atomic_load(p, __ATOMIC_RELAXED, __HIP_MEMORY_SCOPE_AGENT); }
__device__ __forceinline__ unsigned xb_add(unsigned* p, unsigned v) { return __hip_atomic_fetch_add(p, v, __ATOMIC_RELAXED, __HIP_MEMORY_SCOPE_AGENT); }
__device__ __forceinline__ unsigned xb_xcc_id() { return (unsigned)__builtin_amdgcn_s_getreg((3 << 11) | 20) & 0xFu; }
#define XB_SPIN(cond, bar) do { unsigned _sp = 0; while (cond) { __builtin_amdgcn_s_sleep(1); \
    if ((++_sp & 255u) == 0u) { if (xb_ld(&(bar)[XB_TMO])) break; if (_sp > XB_SPIN_CAP) { atomicAdd(&(bar)[XB_TMO], 1u); break; } } } } while (0)

struct XcdBarrier {
    unsigned* bar; unsigned x;
    volatile LAS unsigned* st;
};

__device__ __forceinline__ XcdBarrier xcd_barrier_post(unsigned* bar, volatile LAS unsigned* st) {
    XcdBarrier b; b.bar = bar; b.x = xb_xcc_id(); b.st = st;
    if (threadIdx.x == 0) (void)xb_add(&bar[XB_XCNT(b.x)], 1u);
    return b;
}
__device__ __forceinline__ void xcd_barrier_complete(unsigned* bar, unsigned x, unsigned& nloc, unsigned& nx) {
    const unsigned G = gridDim.x * gridDim.y * gridDim.z;
    unsigned sum, cnt, mine, sp = 0u;
    for (;;) {
        sum = 0u; cnt = 0u; mine = 0u;
#pragma unroll
        for (unsigned j = 0; j < 16; ++j) { const unsigned c = xb_ld(&bar[XB_XCNT(j)]); sum += c; cnt += (c > 0u) ? 1u : 0u; mine = (j == x) ? c : mine; }
        if (sum == G) break;
        __builtin_amdgcn_s_sleep(1);
        if ((++sp & 255u) == 0u) { if (xb_ld(&bar[XB_TMO])) break; if (sp > XB_SPIN_CAP) { atomicAdd(&bar[XB_TMO], 1u); break; } }
    }
    nloc = mine > 0u ? mine : 1u; nx = cnt > 0u ? cnt : 1u;
}

__device__ __forceinline__ void xcd_barrier(const XcdBarrier& b) {
    asm volatile("s_waitcnt vmcnt(0)" ::: "memory");
    __syncthreads();
    if (threadIdx.x == 0) {
        unsigned* bar = b.bar;
        __builtin_amdgcn_s_waitcnt(0);
        unsigned nloc = b.st[0], nx = b.st[1];
        if (nloc == 0u) { xcd_barrier_complete(bar, b.x, nloc, nx); b.st[0] = nloc; b.st[1] = nx; }
        const unsigned old = xb_add(&bar[XB_XSUB(b.x)], 1u);
        const unsigned gen = old / nloc;
        if (old + 1u == (gen + 1u) * nloc) {
            __builtin_amdgcn_fence(__ATOMIC_RELEASE, "agent");
            asm volatile("s_waitcnt vmcnt(0)" ::: "memory");
            const unsigned og = xb_add(&bar[XB_TOP], 1u);
            const unsigned tg = og / nx;
            if (og + 1u == (tg + 1u) * nx) xb_add(&bar[XB_TOPGEN], 1u);
            else XB_SPIN(xb_ld(&bar[XB_TOPGEN]) == tg, bar);
            __builtin_amdgcn_fence(__ATOMIC_ACQUIRE, "agent");
            xb_add(&bar[XB_XGEN(b.x)], 1u);
            asm volatile("s_waitcnt vmcnt(0)" ::: "memory");
        } else {
            XB_SPIN(xb_ld(&bar[XB_XGEN(b.x)]) == gen, bar);
            __builtin_amdgcn_fence(__ATOMIC_ACQUIRE, "agent");
            asm volatile("s_waitcnt vmcnt(0)" ::: "memory");
        }
    }
    __syncthreads();
}

namespace cg = cooperative_groups;
constexpr int LDS_BYTES = 151552;
constexpr int CW_RANK = XCD_BAR_WORDS;

constexpr int LDS_TOTAL = LDS_BYTES + 64;

__global__ void __launch_bounds__(512) k_mega(Params p) {
    extern __shared__ __attribute__((aligned(16))) char lds[];
    cg::grid_group grid = cg::this_grid();
    const int vb = blockIdx.x, nvb = gridDim.x;
    volatile LAS unsigned* bst = (volatile LAS unsigned*)((LAS char*)lds + LDS_BYTES);
    if (threadIdx.x < 16) bst[threadIdx.x] = 0u;
    __syncthreads();
    XcdBarrier bar = xcd_barrier_post((unsigned*)p.ws, bst);
    if (threadIdx.x == 0) bst[2] = xb_add((unsigned*)p.ws + CW_RANK + 64 * bar.x, 1u);
#define GRID_BAR() xcd_barrier(bar)
    stage_prep(p, lds, vb, nvb);        grid.sync();
    stage_norm1(p, lds, vb, nvb);       GRID_BAR();
    stage_gemm_in(p, lds, vb, nvb);     GRID_BAR();
    stage_attn(p, lds, vb, nvb);
    stage_mstate(p, lds, vb, nvb);      GRID_BAR();
    stage_mscan(p, lds, vb, nvb);       GRID_BAR();
    stage_mout(p, lds, vb, nvb);        GRID_BAR();
    stage_gemm_merge(p, lds, vb, nvb);  GRID_BAR();
    stage_gemm_out(p, lds, vb, nvb);    GRID_BAR();
    stage_norm2(p, lds, vb, nvb);       GRID_BAR();
    stage_gemm_q(p, lds, vb, nvb);      GRID_BAR();
    stage_q_topk(p, lds, vb, nvb);      GRID_BAR();
    if (threadIdx.x == 0) { unsigned base = 0u; for (unsigned j = 0; j < bar.x; ++j) base += xb_ld((unsigned*)p.ws + XB_XCNT(j)); bst[3] = base + bst[2]; }
    __syncthreads();
    const int slot = (int)bst[3];
#ifdef XPG
    stage_peer_gather(p, lds, slot < nvb ? slot : vb, nvb, p.ws != nullptr, XPG == 1 ? 0x3fff : 0x3e1f);
#endif
    stage_peer_gather(p, lds, slot < nvb ? slot : vb, nvb);
}

extern "C" void kernel_launch(void* const* d_in, const int* in_sizes, int n_in, void* d_out, int out_size, void* d_ws, size_t ws_size, hipStream_t stream) {
    if (n_in != 20 || ws_size < WS_END) { fprintf(stderr, "kernel_launch: unexpected n_in %d or ws_size %zu\n", n_in, ws_size); return; }
    static int grid_blocks = 0;
    if (!grid_blocks) {
        int dev = 0, cus = 0, per_cu = 0;
        (void)hipGetDevice(&dev);
        (void)hipDeviceGetAttribute(&cus, hipDeviceAttributeMultiprocessorCount, dev);
        (void)hipFuncSetAttribute((const void*)k_mega, hipFuncAttributeMaxDynamicSharedMemorySize, LDS_TOTAL);
        (void)hipOccupancyMaxActiveBlocksPerMultiprocessor(&per_cu, (const void*)k_mega, 512, LDS_TOTAL);
        if (per_cu < 1) { fprintf(stderr, "kernel_launch: occupancy query says %d blocks per CU\n", per_cu); per_cu = 1; }
        grid_blocks = cus * 1;
    }
    Params p{};
    p.x = (const float*)d_in[0]; p.c = (const float*)d_in[1]; p.w_ada = (const float*)d_in[2]; p.b_ada = (const float*)d_in[3]; p.norm1_w = (const float*)d_in[4];
    p.w_in = (const float*)d_in[5]; p.conv_w = (const float*)d_in[6]; p.sinks = (const float*)d_in[7]; p.i_bias = (const float*)d_in[8]; p.f_bias = (const float*)d_in[9];
    p.mnorm_w = (const float*)d_in[10]; p.w_a = (const float*)d_in[11]; p.w_b = (const float*)d_in[12]; p.w_out = (const float*)d_in[13]; p.norm2_w = (const float*)d_in[14];
    p.w_q = (const float*)d_in[15]; p.sub_keys = (const float*)d_in[16]; p.peer_u = (const float*)d_in[17]; p.peer_v = (const float*)d_in[18]; p.normf_w = (const float*)d_in[19];
    p.out = (float*)d_out; p.ws = (unsigned char*)d_ws;
    (void)hipMemsetAsync(d_ws, 0, 32768, stream);
    void* args[] = {&p};
    hipError_t e = hipLaunchCooperativeKernel((const void*)k_mega, dim3(grid_blocks), dim3(512), args, LDS_TOTAL, stream);
    if (e != hipSuccess) fprintf(stderr, "cooperative launch failed: %s (grid %d)\n", hipGetErrorString(e), grid_blocks);
}
```

```cpp
#include <hip/hip_runtime.h>
#include <hip/hip_cooperative_groups.h>
#include <stdint.h>
#include <stdio.h>

#define DEV __device__ __forceinline__
typedef unsigned short bf16_t;
typedef short bf16x8 __attribute__((ext_vector_type(8)));
typedef float f32x4 __attribute__((ext_vector_type(4)));
typedef unsigned u32x4 __attribute__((ext_vector_type(4)));
typedef unsigned u32x2 __attribute__((ext_vector_type(2)));

constexpr int BATCH = 2, SEQ = 16384, M = BATCH * SEQ, D = 1024;
constexpr int NTH = 512, NW = 8;
constexpr int LPA = 768, LPM = 2048, LPG = 2048;

struct Params {
    const float *x, *c, *w_ada, *b_ada, *norm1_w, *w_in, *conv_w, *sinks, *i_bias, *f_bias, *mnorm_w, *w_a, *w_b, *w_out, *norm2_w, *w_q, *sub_keys, *peer_u, *peer_v, *normf_w;
    float* out; unsigned char* ws;
};

constexpr size_t MiB = 1u << 20;
constexpr size_t WS_MOD = 1 * MiB;
constexpr size_t WS_IPRE = 2 * MiB;
constexpr size_t WS_FPRE = 2 * MiB + 512 * 1024;
constexpr size_t WS_CHG = 3 * MiB;
constexpr size_t WS_NLOC = 4 * MiB;
constexpr size_t WS_NST = 4 * MiB + 512 * 1024;
constexpr size_t WS_ROPE = 5 * MiB;
constexpr size_t WS_WIN = 10 * MiB;
constexpr size_t WS_WA = 20 * MiB;
constexpr size_t WS_WB = 21 * MiB;
constexpr size_t WS_WOUT = 22 * MiB;
constexpr size_t WS_WQ = 24 * MiB;
constexpr size_t WS_SK = 28 * MiB;
constexpr size_t WS_ISU = 29 * MiB;
constexpr size_t WS_ISV = 29 * MiB + 65536;
constexpr size_t WS_TU = 32 * MiB;
constexpr size_t WS_TV = 48 * MiB;
constexpr size_t WS_UB = 96 * MiB;
constexpr size_t WS_PA = 160 * MiB;
constexpr size_t WS_PM = 208 * MiB;
constexpr size_t WS_PG = 336 * MiB;
constexpr size_t WS_CST = 464 * MiB;
constexpr size_t WS_END = 496 * MiB;

DEV unsigned f2bf(float f) { unsigned u = __float_as_uint(f); return (u + 0x7fffu + ((u >> 16) & 1u)) >> 16; }
DEV unsigned pk2(float lo, float hi) { return f2bf(lo) | (f2bf(hi) << 16); }
DEV float bflo(unsigned u) { return __uint_as_float(u << 16); }
DEV float bfhi(unsigned u) { return __uint_as_float(u & 0xffff0000u); }
DEV float bf2f(bf16_t h) { return __uint_as_float(((unsigned)h) << 16); }
DEV float wave_sum(float v) {
#pragma unroll
    for (int o = 32; o > 0; o >>= 1) v += __shfl_xor(v, o);
    return v;
}
DEV float wave_max(float v) {
#pragma unroll
    for (int o = 32; o > 0; o >>= 1) v = fmaxf(v, __shfl_xor(v, o));
    return v;
}
DEV float sigmoidf_(float v) { return 1.f / (1.f + __expf(-v)); }
DEV f32x4 mfma16(bf16x8 a, bf16x8 b, f32x4 c) { return __builtin_amdgcn_mfma_f32_16x16x32_bf16(a, b, c, 0, 0, 0); }
DEV void wave_lds_sync() { __builtin_amdgcn_fence(__ATOMIC_ACQ_REL, "wavefront"); __builtin_amdgcn_wave_barrier(); }

DEV void transpose_item(const float* W, int ldw, int k0, int nsrc0, bf16_t* WT, int ldt, int ndst0, float* scr, int lane) {
#pragma unroll 8
    for (int i = 0; i < 32; ++i) { const int kk = 2 * i + (lane >> 5); scr[kk * 33 + (lane & 31)] = W[(size_t)(k0 + kk) * ldw + nsrc0 + (lane & 31)]; }
    wave_lds_sync();
    const int c = lane & 7;
#pragma unroll
    for (int j = 0; j < 4; ++j) {
        const int n = (lane >> 3) + 8 * j; const float* s = scr + (8 * c) * 33 + n;
        u32x4 o; o.x = pk2(s[0 * 33], s[1 * 33]); o.y = pk2(s[2 * 33], s[3 * 33]); o.z = pk2(s[4 * 33], s[5 * 33]); o.w = pk2(s[6 * 33], s[7 * 33]);
        *(u32x4*)(WT + (size_t)(ndst0 + n) * ldt + k0 + 8 * c) = o;
    }
    wave_lds_sync();
}

DEV void stage_prep(const Params& p, char* lds, int vb, int nvb) {
    const int tid = threadIdx.x, lane = tid & 63, wave = __builtin_amdgcn_readfirstlane(tid >> 6);
    float* mod = (float*)(p.ws + WS_MOD);
    float* s_act = (float*)lds;
    float* s_red = (float*)(lds + 8192);
    for (int i = tid; i < 2048; i += NTH) { const float v = p.c[i]; s_act[i] = v / (1.f + expf(-v)); }
    __syncthreads();
    for (int item = vb; item < 192; item += nvb) {
        const int kg = tid >> 5, cl = tid & 31, col = item * 32 + cl;
        float s0 = 0.f, s1 = 0.f;
        for (int k = kg; k < 1024; k += 16) { const float w = p.w_ada[(size_t)k * 6144 + col]; s0 += s_act[k] * w; s1 += s_act[1024 + k] * w; }
        s_red[(kg * 32 + cl) * 2] = s0; s_red[(kg * 32 + cl) * 2 + 1] = s1;
        __syncthreads();
        if (tid < 64) { const int b = tid >> 5, c2 = tid & 31; float s = 0.f; for (int g = 0; g < 16; ++g) s += s_red[(g * 32 + c2) * 2 + b]; mod[b * 6144 + item * 32 + c2] = s + p.b_ada[item * 32 + c2]; }
        __syncthreads();
    }
    float* scr = (float*)(lds + 16384 + wave * 8448);
    const int gw = vb * NW + wave, ngw = nvb * NW;
    bf16_t* Wt_in = (bf16_t*)(p.ws + WS_WIN); bf16_t* Wt_a = (bf16_t*)(p.ws + WS_WA); bf16_t* Wt_b = (bf16_t*)(p.ws + WS_WB);
    bf16_t* Wt_out = (bf16_t*)(p.ws + WS_WOUT); bf16_t* Wt_q = (bf16_t*)(p.ws + WS_WQ);
    for (int it = gw; it < 3456; it += ngw) {
        int r = it;
        if (r < 2432) { const int kb = r / 152, nb = r % 152; transpose_item(p.w_in, 4872, kb * 64, nb * 32 + (nb >= 88 ? 8 : 0), Wt_in, 1024, nb * 32, scr, lane); continue; } r -= 2432;
        if (r < 256) { const int kb = r / 32, nb = r % 32; transpose_item(p.w_a, 1024, kb * 64, nb * 32, Wt_a, 512, nb * 32, scr, lane); continue; } r -= 256;
        if (r < 256) { const int kb = r / 32, nb = r % 32; transpose_item(p.w_b, 1024, kb * 64, nb * 32, Wt_b, 512, nb * 32, scr, lane); continue; } r -= 256;
        { const int kb = r / 32, nb = r % 32; transpose_item(p.w_out, 1024, kb * 64, nb * 32, Wt_out, 1024, nb * 32, scr, lane); }
    }
    {
        float* WL = (float*)lds;
        float* KL = (float*)(lds + 33792);
        for (int item = vb; item < 256; item += nvb) {
            const int hp = item >> 4, k0 = (item & 15) * 64, pidx = hp & 1;
            __syncthreads();
            for (int i = tid; i < 64 * 32; i += NTH) { const int kk = i >> 5, d4 = i & 31; *(float4*)(WL + kk * 132 + 4 * d4) = *(const float4*)(p.w_q + (size_t)(k0 + kk) * 2048 + hp * 128 + 4 * d4); }
            for (int i = tid; i < 128 * 32; i += NTH) ((float4*)KL)[i] = ((const float4*)(p.sub_keys + (size_t)pidx * 16384))[i];
            __syncthreads();
            const int kk = tid & 63, n0 = (tid >> 6) * 16;
            float acc[16];
#pragma unroll
            for (int j = 0; j < 16; ++j) acc[j] = 0.f;
            for (int d4 = 0; d4 < 32; ++d4) {
                const float4 w = *(const float4*)(WL + kk * 132 + 4 * d4);
#pragma unroll
                for (int j = 0; j < 16; ++j) { const float4 kv = *(const float4*)(KL + (n0 + j) * 128 + 4 * d4); acc[j] += w.x * kv.x + w.y * kv.y + w.z * kv.z + w.w * kv.w; }
            }
#pragma unroll
            for (int j = 0; j < 16; ++j) Wt_q[(size_t)(hp * 128 + n0 + j) * 1024 + k0 + kk] = (bf16_t)f2bf(acc[j]);
        }
        __syncthreads();
    }
    const size_t gt = (size_t)vb * NTH + tid, ngt = (size_t)nvb * NTH;
    for (int row = gw; row < 32768; row += ngw) {
        const bool isv = row >= 16384; const int r = row & 16383;
        const float4* src = (const float4*)((isv ? p.peer_v : p.peer_u) + (size_t)r * D) + 4 * lane;
        float4 a[4]; float mx = 0.f;
#pragma unroll
        for (int i = 0; i < 4; ++i) { a[i] = src[i]; mx = fmaxf(mx, fmaxf(fmaxf(fabsf(a[i].x), fabsf(a[i].y)), fmaxf(fabsf(a[i].z), fabsf(a[i].w)))); }
        mx = wave_max(mx);
        const float inv = mx > 0.f ? 127.f / mx : 0.f, sc = mx > 0.f ? mx * (1.f / 127.f) : 1.f;
        u32x4 w;
#pragma unroll
        for (int i = 0; i < 4; ++i) w[i] = ((unsigned)__float2int_rn(a[i].x * inv) & 0xffu) | (((unsigned)__float2int_rn(a[i].y * inv) & 0xffu) << 8) | (((unsigned)__float2int_rn(a[i].z * inv) & 0xffu) << 16) | ((unsigned)__float2int_rn(a[i].w * inv) << 24);
        ((u32x4*)(p.ws + (isv ? WS_TV : WS_TU) + (size_t)r * 1024))[lane] = w;
        if (lane == 0) ((float*)(p.ws + (isv ? WS_ISV : WS_ISU)))[r] = sc;
    }
    for (size_t g = gt; g < 4096; g += ngt) {
        const float4 a = ((const float4*)p.sub_keys)[2 * g], b = ((const float4*)p.sub_keys)[2 * g + 1];
        u32x4 w; w.x = pk2(a.x, a.y); w.y = pk2(a.z, a.w); w.z = pk2(b.x, b.y); w.w = pk2(b.z, b.w);
        ((u32x4*)(p.ws + WS_SK))[g] = w;
    }
    float2* rope = (float2*)(p.ws + WS_ROPE);
    for (size_t e = gt; e < 16384 * 32; e += ngt) {
        const int pos = (int)(e >> 5), i = (int)(e & 31);
        const float inv = (float)exp2(-(double)i * (13.287712379549449 / 32.0));
        const float ang = (float)pos * inv;
        const double a = (double)ang; const double n = rint(a * 0.15915494309189535); const double r = a - n * 6.283185307179586;
        float s, c; sincosf((float)r, &s, &c);
        rope[e] = make_float2(c, s);
    }
}

DEV void stage_norm1(const Params& p, char* lds, int vb, int nvb) {
    const int tid = threadIdx.x, lane = tid & 63, wave = __builtin_amdgcn_readfirstlane(tid >> 6);
    float* wg = (float*)lds;
    for (int i = tid; i < 8192; i += NTH) { const int cc = i >> 10, k = i & 1023; wg[i] = p.w_in[(size_t)k * 4872 + 2816 + cc]; }
    __syncthreads();
    const float* mod = (const float*)(p.ws + WS_MOD);
    bf16_t* ub = (bf16_t*)(p.ws + WS_UB);
    float* ipre = (float*)(p.ws + WS_IPRE); float* fpre = (float*)(p.ws + WS_FPRE);
    for (int m = vb * NW + wave; m < M; m += nvb * NW) {
        const int b = m >= SEQ ? 1 : 0;
        const float4* xr = (const float4*)(p.x + (size_t)m * D);
        float4 v[4]; float ss = 0.f;
#pragma unroll
        for (int j = 0; j < 4; ++j) { v[j] = xr[lane + 64 * j]; ss += v[j].x * v[j].x + v[j].y * v[j].y + v[j].z * v[j].z + v[j].w * v[j].w; }
        ss = wave_sum(ss);
        const float rstd = rsqrtf(ss * (1.f / 1024.f) + 1e-6f);
        float ga[8];
#pragma unroll
        for (int cc = 0; cc < 8; ++cc) ga[cc] = 0.f;
#pragma unroll
        for (int j = 0; j < 4; ++j) {
            const int col = 4 * (lane + 64 * j);
            const float4 w1 = *(const float4*)(p.norm1_w + col), sc = *(const float4*)(mod + b * 6144 + 1024 + col), sh = *(const float4*)(mod + b * 6144 + col);
            float4 u;
            u.x = v[j].x * rstd * w1.x * (1.f + sc.x) + sh.x; u.y = v[j].y * rstd * w1.y * (1.f + sc.y) + sh.y;
            u.z = v[j].z * rstd * w1.z * (1.f + sc.z) + sh.z; u.w = v[j].w * rstd * w1.w * (1.f + sc.w) + sh.w;
            u32x2 o; o.x = pk2(u.x, u.y); o.y = pk2(u.z, u.w);
            *(u32x2*)(ub + (size_t)m * D + col) = o;
#pragma unroll
            for (int cc = 0; cc < 8; ++cc) { const float4 g = *(const float4*)(wg + cc * 1024 + col); ga[cc] += u.x * g.x + u.y * g.y + u.z * g.z + u.w * g.w; }
        }
#pragma unroll
        for (int cc = 0; cc < 8; ++cc) ga[cc] = wave_sum(ga[cc]);
        if (lane == 0) {
#pragma unroll
            for (int h = 0; h < 4; ++h) { ipre[(size_t)m * 4 + h] = ga[h] + p.i_bias[h]; fpre[(size_t)m * 4 + h] = ga[4 + h] + p.f_bias[h]; }
        }
    }
}

namespace pg8 {
#define PG8_LAS __attribute__((address_space(3)))
typedef unsigned short bf16_t;
typedef short bf16x8 __attribute__((ext_vector_type(8)));
typedef float f32x4 __attribute__((ext_vector_type(4)));
typedef unsigned u32x4 __attribute__((ext_vector_type(4)));
constexpr int BM = 256, BK = 64, HALF = 128, HTB = HALF * BK * 2  , STAGE_BYTES = 8 * HTB, NXCD = 8, WGM = 8;

__host__ __device__ __forceinline__ int lds_byte(int r, int c) { const int st = (r >> 4) * 2 + (c >> 5), rr = r & 15, cc = c & 31, ob = rr * 64 + cc * 2; return st * 1024 + (ob ^ (((ob >> 9) & 1) << 5)); }
__host__ __device__ __forceinline__ void stage_rc(int b, int& R, int& C) { const int st = b / 1024, sb = b % 1024, swz = sb ^ (((sb >> 9) & 1) << 5); R = (st >> 1) * 16 + swz / 64; C = (st & 1) * 32 + (swz % 64) / 2; }
__host__ __device__ __forceinline__ int perm32(int rho) { const int n = rho >> 4, i = rho & 15; return 8 * (i >> 2) + 4 * n + (i & 3); }

struct Unit { int pm, pn; };
struct Gemm { const bf16_t* A; const bf16_t* Bt; int M, N, K, lda, ldb; };

struct StaticOrder {
    int nM, nN, nwg, G, c;
    __host__ __device__ void init(int M, int N, int G_, int c_) { nM = M / BM; nN = N / BM; nwg = nM * nN; G = G_; c = c_; }
    __host__ __device__ bool next(int i, Unit& u) const {
        const long L = (long)i * G + c; if (L >= nwg) return false;
        int wgid = (int)L; { const int q = nwg / NXCD, r = nwg % NXCD, xcd = wgid % NXCD, off = wgid / NXCD; wgid = (xcd < r ? xcd * (q + 1) : r * (q + 1) + (xcd - r) * q) + off; }
        const int nig = WGM * nN, gid = wgid / nig, fm = gid * WGM, gsz = (nM - fm) < WGM ? (nM - fm) : WGM;
        u.pm = fm + ((wgid % nig) % gsz); u.pn = (wgid % nig) / gsz; return true;
    }
    __device__ __forceinline__ void a_ready(const Unit&) const {}
    __device__ __forceinline__ void done(const Unit&) const {}
};

__device__ __forceinline__ unsigned cvt_pk_bf16(float lo, float hi) { unsigned r; asm volatile("v_cvt_pk_bf16_f32 %0, %1, %2" : "=v"(r) : "v"(lo), "v"(hi)); return r; }
__device__ __forceinline__ float sg_(float v) { return 1.f / (1.f + __expf(-v)); }
struct EpiIn {
    static constexpr bool PERM = true, AFTER_DRAIN = false;
    bf16_t *PA, *PM, *PG;
    __device__ __forceinline__ void operator()(const f32x4 (&acc)[2][2][4][2], const Unit& u, int wr, int wc, int fr, int fq) const {
        const int colt = u.pn * BM; bf16_t* base; int ldc, cb;
        if (colt < 768) { base = PA; ldc = 768; cb = colt; } else if (colt < 2816) { base = PM; ldc = 2048; cb = colt - 768; } else { base = PG; ldc = 2048; cb = colt - 2816; }
        const int row0 = u.pm * BM + wr * 64 + fr, col0 = cb + wc * 32 + 8 * fq;
#pragma unroll
        for (int ai = 0; ai < 2; ++ai)
#pragma unroll
            for (int m = 0; m < 4; ++m) { bf16_t* rowp = base + (size_t)(row0 + ai * HALF + m * 16) * ldc + col0;
#pragma unroll
                for (int bj = 0; bj < 2; ++bj) { const f32x4 v0 = acc[ai][bj][m][0], v1 = acc[ai][bj][m][1];
                    u32x4 w; w.x = cvt_pk_bf16(v0[0], v0[1]); w.y = cvt_pk_bf16(v0[2], v0[3]); w.z = cvt_pk_bf16(v1[0], v1[1]); w.w = cvt_pk_bf16(v1[2], v1[3]);
                    *(u32x4*)(rowp + bj * HALF) = w; } }
    }
};
struct EpiMerge {
    static constexpr bool PERM = true, AFTER_DRAIN = false;
    const bf16_t* G; bf16_t* MG; int second;
    __device__ __forceinline__ void operator()(const f32x4 (&acc)[2][2][4][2], const Unit& u, int wr, int wc, int fr, int fq) const {
        const int row0 = u.pm * BM + wr * 64 + fr, col0 = u.pn * BM + wc * 32 + 8 * fq;
#pragma unroll
        for (int ai = 0; ai < 2; ++ai)
#pragma unroll
            for (int m = 0; m < 4; ++m) { const size_t row = (size_t)(row0 + ai * HALF + m * 16);
#pragma unroll
                for (int bj = 0; bj < 2; ++bj) { const f32x4 v0 = acc[ai][bj][m][0], v1 = acc[ai][bj][m][1]; const int col = col0 + bj * HALF;
                    const u32x4 gv = *(const u32x4*)(G + row * 2048 + col);
                    float r[8];
                    r[0] = sg_(__uint_as_float(gv.x << 16)) * v0[0]; r[1] = sg_(__uint_as_float(gv.x & 0xffff0000u)) * v0[1];
                    r[2] = sg_(__uint_as_float(gv.y << 16)) * v0[2]; r[3] = sg_(__uint_as_float(gv.y & 0xffff0000u)) * v0[3];
                    r[4] = sg_(__uint_as_float(gv.z << 16)) * v1[0]; r[5] = sg_(__uint_as_float(gv.z & 0xffff0000u)) * v1[1];
                    r[6] = sg_(__uint_as_float(gv.w << 16)) * v1[2]; r[7] = sg_(__uint_as_float(gv.w & 0xffff0000u)) * v1[3];
                    u32x4* dst = (u32x4*)(MG + row * 1024 + col);
                    if (second) { const u32x4 t = *dst;
                        r[0] += __uint_as_float(t.x << 16); r[1] += __uint_as_float(t.x & 0xffff0000u); r[2] += __uint_as_float(t.y << 16); r[3] += __uint_as_float(t.y & 0xffff0000u);
                        r[4] += __uint_as_float(t.z << 16); r[5] += __uint_as_float(t.z & 0xffff0000u); r[6] += __uint_as_float(t.w << 16); r[7] += __uint_as_float(t.w & 0xffff0000u); }
                    u32x4 w; w.x = cvt_pk_bf16(r[0], r[1]); w.y = cvt_pk_bf16(r[2], r[3]); w.z = cvt_pk_bf16(r[4], r[5]); w.w = cvt_pk_bf16(r[6], r[7]);
                    *dst = w; } }
    }
};
struct EpiF32 {
    static constexpr bool PERM = true, AFTER_DRAIN = false;
    float* O; int ldc;
    __device__ __forceinline__ void operator()(const f32x4 (&acc)[2][2][4][2], const Unit& u, int wr, int wc, int fr, int fq) const {
        const int row0 = u.pm * BM + wr * 64 + fr, col0 = u.pn * BM + wc * 32 + 8 * fq;
#pragma unroll
        for (int ai = 0; ai < 2; ++ai)
#pragma unroll
            for (int m = 0; m < 4; ++m) { float* rowp = O + (size_t)(row0 + ai * HALF + m * 16) * ldc + col0;
#pragma unroll
                for (int bj = 0; bj < 2; ++bj) { *(f32x4*)(rowp + bj * HALF) = acc[ai][bj][m][0]; *(f32x4*)(rowp + bj * HALF + 4) = acc[ai][bj][m][1]; } }
    }
};
struct EpiOut {
    static constexpr bool PERM = true, AFTER_DRAIN = false;
    const float* x; const float* g1; float* out; int seq;
    __device__ __forceinline__ void operator()(const f32x4 (&acc)[2][2][4][2], const Unit& u, int wr, int wc, int fr, int fq) const {
        const int row0 = u.pm * BM + wr * 64 + fr, col0 = u.pn * BM + wc * 32 + 8 * fq;
        const float* gp = g1 + (u.pm * BM >= seq ? 6144 : 0);
#pragma unroll
        for (int bj = 0; bj < 2; ++bj) { const int col = col0 + bj * HALF; const f32x4 ga = *(const f32x4*)(gp + col), gb = *(const f32x4*)(gp + col + 4);
#pragma unroll
            for (int ai = 0; ai < 2; ++ai)
#pragma unroll
                for (int m = 0; m < 4; ++m) { const size_t off = (size_t)(row0 + ai * HALF + m * 16) * 1024 + col;
                    const f32x4 xa = *(const f32x4*)(x + off), xb = *(const f32x4*)(x + off + 4);
                    *(f32x4*)(out + off) = xa + ga * acc[ai][bj][m][0]; *(f32x4*)(out + off + 4) = xb + gb * acc[ai][bj][m][1]; } }
    }
};

template <class Epi, class Sched, bool ALIGN_EPI = false, bool SP2 = false>
__device__ __forceinline__ void gemm_phase(PG8_LAS unsigned char* lds, const Gemm g, const Sched& S, const Epi& E) {
    const int tid = threadIdx.x, wid = __builtin_amdgcn_readfirstlane(tid >> 6), lane = tid & 63, wr = wid >> 2, wc = wid & 3, fr = lane & 15, fq = lane >> 4;
    const int K = g.K, nt = K / BK;
    unsigned voffA[2], voffB[2];
#pragma unroll
    for (int i = 0; i < 2; ++i) { int R, C; stage_rc(tid * 16 + i * 8192, R, C); const int Rb = Epi::PERM ? ((R & ~31) + perm32(R & 31)) : R;
        voffA[i] = (unsigned)(R * g.lda + C) * 2u; voffB[i] = (unsigned)(Rb * g.ldb + C) * 2u; }
    const size_t kstep = (size_t)(BK * 2);
    const size_t hstepA = (size_t)HALF * g.lda * 2, hstepB = (size_t)HALF * g.ldb * 2;
    const size_t tstepA = 2 * hstepA, tstepB = 2 * hstepB;
    const unsigned ldsw = (unsigned)wid * 1024u;
    const int aoff = lds_byte(wr * 64 + fr, fq * 8), boff = lds_byte(wc * 32 + fr, fq * 8);
#define PG8_SA(b, h) (((b) * 2 + (h)) * HTB)
#define PG8_SB(b, h) ((4 + (b) * 2 + (h)) * HTB)
#define PG8_STAGE(bufoff, gbase, voff) do { _Pragma("unroll") for (int _i = 0; _i < 2; ++_i) \
        __builtin_amdgcn_global_load_lds((const unsigned*)((const char*)(gbase) + (voff)[_i]), (PG8_LAS unsigned*)(lds + (bufoff) + ldsw + _i * 8192), 16, 0, 0); } while (0)
#define PG8_LDA(dst, b, h) do { _Pragma("unroll") for (int m = 0; m < 4; ++m) _Pragma("unroll") for (int k = 0; k < 2; ++k) dst[m][k] = *(const PG8_LAS bf16x8*)(lds + PG8_SA(b, h) + aoff + m * 2048 + k * 1024); } while (0)
#define PG8_LDB(dst, b, h) do { _Pragma("unroll") for (int n = 0; n < 2; ++n) _Pragma("unroll") for (int k = 0; k < 2; ++k) dst[n][k] = *(const PG8_LAS bf16x8*)(lds + PG8_SB(b, h) + boff + n * 2048 + k * 1024); } while (0)
#define PG8_MMA(ai, bj, At, Bt) do { __builtin_amdgcn_s_setprio(1); _Pragma("unroll") for (int m = 0; m < 4; ++m) _Pragma("unroll") for (int n = 0; n < 2; ++n) _Pragma("unroll") for (int k = 0; k < 2; ++k) \
        acc[ai][bj][m][n] = __builtin_amdgcn_mfma_f32_16x16x32_bf16(Bt[n][k], At[m][k], acc[ai][bj][m][n], 0, 0, 0); __builtin_amdgcn_s_setprio(0); } while (0)
#define PG8_WAIT_V(n) asm volatile("s_waitcnt vmcnt(" #n ")" ::: "memory")
#define PG8_WAIT_L(n) asm volatile("s_waitcnt lgkmcnt(" #n ")" ::: "memory")
#define PG8_BAR __builtin_amdgcn_s_barrier()
#define PG8_SCHED __builtin_amdgcn_sched_barrier(0)
    Unit cur, nxt; int ui = 0;
    if (!S.next(0, cur)) return;
    f32x4 acc[2][2][4][2];
#pragma unroll
    for (int a = 0; a < 2; ++a)
#pragma unroll
        for (int b = 0; b < 2; ++b)
#pragma unroll
            for (int m = 0; m < 4; ++m)
#pragma unroll
                for (int n = 0; n < 2; ++n) acc[a][b][m][n] = (f32x4){0.f, 0.f, 0.f, 0.f};
    bf16x8 At[4][2], B0[2][2], B1[2][2];
    const char* cA = (const char*)g.A + (size_t)cur.pm * tstepA; const char* cB = (const char*)g.Bt + (size_t)cur.pn * tstepB;
    S.a_ready(cur);
    if constexpr (SP2) {
        PG8_STAGE(PG8_SB(0, 0), cB, voffB); PG8_STAGE(PG8_SB(0, 1), cB + hstepB, voffB); PG8_STAGE(PG8_SA(0, 0), cA, voffA); PG8_STAGE(PG8_SA(0, 1), cA + hstepA, voffA);
        if (wr == 1) PG8_BAR;
        PG8_WAIT_V(2); PG8_BAR;
        PG8_STAGE(PG8_SB(1, 0), cB + kstep, voffB); PG8_STAGE(PG8_SA(1, 0), cA + kstep, voffA); PG8_STAGE(PG8_SB(1, 1), cB + hstepB + kstep, voffB);
        PG8_WAIT_V(6); PG8_BAR;
    } else {
        PG8_STAGE(PG8_SB(0, 0), cB, voffB); PG8_STAGE(PG8_SA(0, 0), cA, voffA); PG8_STAGE(PG8_SB(0, 1), cB + hstepB, voffB); PG8_STAGE(PG8_SA(0, 1), cA + hstepA, voffA);
        if (wr == 1) PG8_BAR;
        PG8_WAIT_V(4); PG8_BAR;
        PG8_STAGE(PG8_SB(1, 0), cB + kstep, voffB); PG8_STAGE(PG8_SA(1, 0), cA + kstep, voffA); PG8_STAGE(PG8_SB(1, 1), cB + hstepB + kstep, voffB);
        PG8_WAIT_V(6); PG8_BAR;
    }
    for (;;) {
        const bool has_next = S.next(ui + 1, nxt);
        const char* nA = has_next ? (const char*)g.A + (size_t)nxt.pm * tstepA : cA; const char* nB = has_next ? (const char*)g.Bt + (size_t)nxt.pn * tstepB : cB;
        for (int t = 0; t < nt; t += 2) {
            const bool last = (t == nt - 2);
            const char* a1 = cA + (size_t)(t + 1) * kstep;
            const char* a2 = last ? nA : cA + (size_t)(t + 2) * kstep; const char* b2 = last ? nB : cB + (size_t)(t + 2) * kstep;
            const char* a3 = a2 + kstep; const char* b3 = b2 + kstep;
            if (last && has_next) S.a_ready(nxt);
            if constexpr (SP2) {
            PG8_LDB(B0, 0, 0); PG8_LDB(B1, 0, 1); PG8_SCHED; PG8_LDA(At, 0, 0); PG8_STAGE(PG8_SA(1, 1), a1 + hstepA, voffA);
            PG8_WAIT_V(8); PG8_WAIT_L(0); PG8_BAR; PG8_MMA(0, 0, At, B0); PG8_MMA(0, 1, At, B1); PG8_BAR; PG8_SCHED;
            PG8_LDA(At, 0, 1); PG8_STAGE(PG8_SB(0, 0), b2, voffB); PG8_STAGE(PG8_SB(0, 1), b2 + hstepB, voffB); PG8_STAGE(PG8_SA(0, 0), a2, voffA);
            PG8_WAIT_V(8); PG8_WAIT_L(0); PG8_BAR; PG8_MMA(1, 0, At, B0); PG8_MMA(1, 1, At, B1); PG8_BAR; PG8_SCHED;
            PG8_LDB(B0, 1, 0); PG8_LDB(B1, 1, 1); PG8_SCHED; PG8_LDA(At, 1, 0); PG8_STAGE(PG8_SA(0, 1), a2 + hstepA, voffA);
            PG8_WAIT_V(8); PG8_WAIT_L(0); PG8_BAR; PG8_MMA(0, 0, At, B0); PG8_MMA(0, 1, At, B1); PG8_BAR; PG8_SCHED;
            PG8_LDA(At, 1, 1); PG8_STAGE(PG8_SB(1, 0), b3, voffB); PG8_STAGE(PG8_SB(1, 1), b3 + hstepB, voffB); PG8_STAGE(PG8_SA(1, 0), a3, voffA);
            PG8_WAIT_V(8); PG8_WAIT_L(0); PG8_BAR; PG8_MMA(1, 0, At, B0); PG8_MMA(1, 1, At, B1); PG8_BAR; PG8_SCHED;
            } else {
            PG8_LDB(B0, 0, 0); PG8_SCHED; PG8_LDA(At, 0, 0); PG8_STAGE(PG8_SA(1, 1), a1 + hstepA, voffA);
            PG8_WAIT_L(8); PG8_BAR; PG8_WAIT_L(0); PG8_MMA(0, 0, At, B0); PG8_BAR; PG8_SCHED;
            PG8_LDB(B1, 0, 1); PG8_STAGE(PG8_SB(0, 0), b2, voffB);
            PG8_BAR; PG8_WAIT_L(0); PG8_MMA(0, 1, At, B1); PG8_BAR;
            PG8_LDA(At, 0, 1); PG8_STAGE(PG8_SA(0, 0), a2, voffA);
            PG8_BAR; PG8_WAIT_L(0); PG8_MMA(1, 0, At, B0); PG8_BAR; PG8_SCHED;
            PG8_STAGE(PG8_SB(0, 1), b2 + hstepB, voffB);
            PG8_WAIT_V(6); PG8_BAR; PG8_MMA(1, 1, At, B1); PG8_BAR;
            PG8_LDB(B0, 1, 0); PG8_SCHED; PG8_LDA(At, 1, 0); PG8_STAGE(PG8_SA(0, 1), a2 + hstepA, voffA);
            PG8_WAIT_L(8); PG8_BAR; PG8_WAIT_L(0); PG8_MMA(0, 0, At, B0); PG8_BAR; PG8_SCHED;
            PG8_LDB(B1, 1, 1); PG8_STAGE(PG8_SB(1, 0), b3, voffB);
            PG8_BAR; PG8_WAIT_L(0); PG8_MMA(0, 1, At, B1); PG8_BAR;
            PG8_LDA(At, 1, 1); PG8_STAGE(PG8_SA(1, 0), a3, voffA);
            PG8_BAR; PG8_WAIT_L(0); PG8_MMA(1, 0, At, B0); PG8_BAR; PG8_SCHED;
            PG8_STAGE(PG8_SB(1, 1), b3 + hstepB, voffB);
            PG8_WAIT_V(6); PG8_BAR; PG8_MMA(1, 1, At, B1); PG8_BAR;
            }
        }
        if constexpr (ALIGN_EPI) { if (wr == 0) PG8_BAR; }
        if constexpr (!Epi::AFTER_DRAIN) { E(acc, cur, wr, wc, fr, fq); S.done(cur); }
        if (!has_next) break;
#pragma unroll
        for (int a = 0; a < 2; ++a)
#pragma unroll
            for (int b = 0; b < 2; ++b)
#pragma unroll
                for (int m = 0; m < 4; ++m)
#pragma unroll
                    for (int n = 0; n < 2; ++n) acc[a][b][m][n] = (f32x4){0.f, 0.f, 0.f, 0.f};
        cur = nxt; cA = nA; cB = nB; ++ui;
        if constexpr (ALIGN_EPI) { if (wr == 1) PG8_BAR; }
    }
    PG8_WAIT_V(0);
    if constexpr (!ALIGN_EPI) { if (wr == 0) PG8_BAR; }
    PG8_BAR;
    if constexpr (Epi::AFTER_DRAIN) { E.fused(acc, cur, wr, wc, fr, fq, lds, wid, lane); S.done(cur); }
#undef PG8_SA
#undef PG8_SB
#undef PG8_STAGE
#undef PG8_LDA
#undef PG8_LDB
#undef PG8_MMA
#undef PG8_WAIT_V
#undef PG8_WAIT_L
#undef PG8_BAR
#undef PG8_SCHED
}
}

struct GemmOp { const bf16_t* A; int lda; const bf16_t* Bt; int ldb; int K; };

DEV void gemm_tile(f32x4 (&acc)[4][2], const GemmOp& g, int m0, int n0, char* lds) {
    const int tid = threadIdx.x, lane = tid & 63, wid = __builtin_amdgcn_readfirstlane(tid >> 6), wm = wid >> 2, wn = wid & 3, fr = lane & 15, fq = lane >> 4;
    const int sr = tid >> 3, sc = tid & 7;
    const bf16_t* ga = g.A + (size_t)(m0 + sr) * g.lda + sc * 8;
    const bf16_t* gb = g.Bt + (size_t)(n0 + sr) * g.ldb + sc * 8;
    const size_t a64 = (size_t)64 * g.lda, b64 = (size_t)64 * g.ldb;
    const int so = sr * 128 + ((sc ^ (sr & 7)) << 4);
    const int nk = g.K >> 6;
    u32x4 ra0 = *(const u32x4*)ga, ra1 = *(const u32x4*)(ga + a64), rb0 = *(const u32x4*)gb, rb1 = *(const u32x4*)(gb + b64);
    *(u32x4*)(lds + so) = ra0; *(u32x4*)(lds + so + 8192) = ra1; *(u32x4*)(lds + 32768 + so) = rb0; *(u32x4*)(lds + 32768 + so + 8192) = rb1;
    __syncthreads();
    const int aoff = (wm * 64 + fr) * 128, boff = 32768 + (wn * 32 + fr) * 128, sw = fr & 7;
    for (int kt = 0; kt < nk; ++kt) {
        const int cur = (kt & 1) * 16384;
        if (kt + 1 < nk) { ga += 64; gb += 64; ra0 = *(const u32x4*)ga; ra1 = *(const u32x4*)(ga + a64); rb0 = *(const u32x4*)gb; rb1 = *(const u32x4*)(gb + b64); }
#pragma unroll
        for (int ks = 0; ks < 2; ++ks) {
            const int ch = ((fq + 4 * ks) ^ sw) << 4;
            bf16x8 af[4], bfr[2];
#pragma unroll
            for (int mi = 0; mi < 4; ++mi) af[mi] = *(const bf16x8*)(lds + cur + aoff + mi * 2048 + ch);
#pragma unroll
            for (int ni = 0; ni < 2; ++ni) bfr[ni] = *(const bf16x8*)(lds + cur + boff + ni * 2048 + ch);
#pragma unroll
            for (int mi = 0; mi < 4; ++mi)
#pragma unroll
                for (int ni = 0; ni < 2; ++ni) acc[mi][ni] = mfma16(bfr[ni], af[mi], acc[mi][ni]);
        }
        if (kt + 1 < nk) {
            const int nxt = cur ^ 16384;
            *(u32x4*)(lds + nxt + so) = ra0; *(u32x4*)(lds + nxt + so + 8192) = ra1; *(u32x4*)(lds + 32768 + nxt + so) = rb0; *(u32x4*)(lds + 32768 + nxt + so + 8192) = rb1;
        }
        __syncthreads();
    }
}
#define GEMM_EPI_LOOP(...) { const int tid_ = threadIdx.x, lane_ = tid_ & 63, wid_ = tid_ >> 6, wm_ = wid_ >> 2, wn_ = wid_ & 3, fr_ = lane_ & 15, fq_ = lane_ >> 4; \
    _Pragma("unroll") for (int mi = 0; mi < 4; ++mi) _Pragma("unroll") for (int ni = 0; ni < 2; ++ni) { const int m = m0 + wm_ * 64 + mi * 16 + fr_, n = n0 + wn_ * 32 + ni * 16 + fq_ * 4; __VA_ARGS__ } }

DEV void stage_gemm_in(const Params& p, char* lds, int vb, int nvb) {
    pg8::Gemm g{(const bf16_t*)(p.ws + WS_UB), (const bf16_t*)(p.ws + WS_WIN), M, 4864, 1024, 1024, 1024};
    pg8::StaticOrder S; S.init(M, 4864, nvb, vb);
    pg8::EpiIn E{(bf16_t*)(p.ws + WS_PA), (bf16_t*)(p.ws + WS_PM), (bf16_t*)(p.ws + WS_PG)};
    pg8::gemm_phase<pg8::EpiIn, pg8::StaticOrder, true, true>((PG8_LAS unsigned char*)lds, g, S, E);
}
DEV void stage_gemm_merge(const Params& p, char* lds, int vb, int nvb) {
    const bf16_t* PG = (const bf16_t*)(p.ws + WS_PG); bf16_t* MG = (bf16_t*)(p.ws + WS_UB);
    {
        pg8::Gemm g{(const bf16_t*)(p.ws + WS_PA), (const bf16_t*)(p.ws + WS_WA), M, 1024, 512, LPA, 512};
        pg8::StaticOrder S; S.init(M, 1024, nvb, vb);
        pg8::EpiMerge E{PG, MG, 0};
        pg8::gemm_phase<pg8::EpiMerge, pg8::StaticOrder, true, true>((PG8_LAS unsigned char*)lds, g, S, E);
    }
    {
        pg8::Gemm g{(const bf16_t*)(p.ws + WS_PM) + 1536, (const bf16_t*)(p.ws + WS_WB), M, 1024, 512, LPM, 512};
        pg8::StaticOrder S; S.init(M, 1024, nvb, vb);
        pg8::EpiMerge E{PG + 1024, MG, 1};
        pg8::gemm_phase<pg8::EpiMerge, pg8::StaticOrder, true, true>((PG8_LAS unsigned char*)lds, g, S, E);
    }
}
DEV void stage_gemm_out(const Params& p, char* lds, int vb, int nvb) {
    pg8::Gemm g{(const bf16_t*)(p.ws + WS_UB), (const bf16_t*)(p.ws + WS_WOUT), M, 1024, 1024, 1024, 1024};
    pg8::StaticOrder S; S.init(M, 1024, nvb, vb);
    pg8::EpiOut E{p.x, (const float*)(p.ws + WS_MOD) + 2048, p.out, SEQ};
    pg8::gemm_phase<pg8::EpiOut, pg8::StaticOrder, true, true>((PG8_LAS unsigned char*)lds, g, S, E);
}

DEV void rope8(u32x4 x1, u32x4 x2, const float4* rp, float scale, u32x4& o1, u32x4& o2) {
#pragma unroll
    for (int w = 0; w < 4; ++w) {
        const float4 cs = rp[w];
        const float a0 = bflo(x1[w]), a1 = bfhi(x1[w]), b0 = bflo(x2[w]), b1 = bfhi(x2[w]);
        o1[w] = pk2((a0 * cs.x - b0 * cs.y) * scale, (a1 * cs.z - b1 * cs.w) * scale);
        o2[w] = pk2((b0 * cs.x + a0 * cs.y) * scale, (b1 * cs.z + a1 * cs.w) * scale);
    }
}

DEV void stage_attn(const Params& p, char* lds, int vb, int nvb) {
    const int tid = threadIdx.x, lane = tid & 63, wave = __builtin_amdgcn_readfirstlane(tid >> 6), fr = lane & 15, fq = lane >> 4;
    char* Ks = lds;
    char* VT = lds + 32768;
    char* Qs = lds + 70656;
    char* Ps = lds + 87040;
    bf16_t* PA = (bf16_t*)(p.ws + WS_PA);
    const float2* rope = (const float2*)(p.ws + WS_ROPE);
    for (int unit = vb; unit < 512; unit += nvb) {
        const int kvh = unit & 1, n = (unit >> 1) & 127, b = unit >> 8;
        __syncthreads();
        for (int task = tid; task < 1024; task += NTH) {
            const int ki = task >> 2, cp = task & 3, pos = 128 * (n - 1) + ki;
            u32x4 o1 = {0u, 0u, 0u, 0u}, o2 = {0u, 0u, 0u, 0u};
            if (pos >= 0) {
                const bf16_t* src = PA + (size_t)(b * SEQ + pos) * LPA + 512 + kvh * 64 + cp * 8;
                const u32x4 x1 = *(const u32x4*)src, x2 = *(const u32x4*)(src + 32);
                rope8(x1, x2, (const float4*)(rope + (size_t)pos * 32 + cp * 8), 1.0f, o1, o2);
            }
            const int sw = ki & 7;
            *(u32x4*)(Ks + ki * 128 + ((cp ^ sw) << 4)) = o1;
            *(u32x4*)(Ks + ki * 128 + (((cp + 4) ^ sw) << 4)) = o2;
        }
        for (int task = tid; task < 2048; task += NTH) {
            const int ki = task >> 3, c = task & 7, pos = 128 * (n - 1) + ki;
            u32x4 x = {0u, 0u, 0u, 0u};
            if (pos >= 0) x = *(const u32x4*)(PA + (size_t)(b * SEQ + pos) * LPA + 640 + kvh * 64 + c * 8);
#pragma unroll
            for (int e = 0; e < 8; ++e) *(bf16_t*)(VT + (c * 8 + e) * 592 + ki * 2) = (bf16_t)((e & 1) ? (x[e >> 1] >> 16) : (x[e >> 1] & 0xffffu));
        }
        for (int i = tid; i < 64 * 40; i += NTH) { const int d = i / 40, kk = 256 + i % 40; *(bf16_t*)(VT + d * 592 + kk * 2) = 0; }
        for (int i = tid; i < 2048; i += NTH) { const int w = i >> 8, r = (i >> 4) & 15, kk = 144 + (i & 15); *(bf16_t*)(Ps + w * 5376 + r * 336 + kk * 2) = 0; }
        for (int j = 0; j < 4; ++j) {
            const int hq = kvh * 4 + j;
            {
                const int qi = tid >> 2, cp = tid & 3, pos = 128 * n + qi;
                const bf16_t* src = PA + (size_t)(b * SEQ + pos) * LPA + hq * 64 + cp * 8;
                const u32x4 x1 = *(const u32x4*)src, x2 = *(const u32x4*)(src + 32);
                u32x4 o1, o2;
                rope8(x1, x2, (const float4*)(rope + (size_t)pos * 32 + cp * 8), 0.125f, o1, o2);
                const int sw = qi & 7;
                *(u32x4*)(Qs + qi * 128 + ((cp ^ sw) << 4)) = o1;
                *(u32x4*)(Qs + qi * 128 + (((cp + 4) ^ sw) << 4)) = o2;
            }
            __syncthreads();
            f32x4 s[9];
            const int sw = fr & 7;
            bf16x8 qf[2];
#pragma unroll
            for (int ks = 0; ks < 2; ++ks) qf[ks] = *(const bf16x8*)(Qs + (16 * wave + fr) * 128 + (((fq + 4 * ks) ^ sw) << 4));
#pragma unroll
            for (int t = 0; t < 9; ++t) {
                s[t] = (f32x4){0.f, 0.f, 0.f, 0.f};
#pragma unroll
                for (int ks = 0; ks < 2; ++ks) { const bf16x8 kf = *(const bf16x8*)(Ks + (16 * (wave + t) + fr) * 128 + (((fq + 4 * ks) ^ sw) << 4)); s[t] = mfma16(kf, qf[ks], s[t]); }
            }
            const float sink = p.sinks[hq];
            float mx = sink;
#pragma unroll
            for (int t = 0; t < 9; ++t)
#pragma unroll
                for (int r = 0; r < 4; ++r) {
                    const int dd = 16 * t + 4 * fq + r - fr, ki = 16 * (wave + t) + 4 * fq + r;
                    const bool ok = (dd >= 1) && (dd <= 128) && (n > 0 || ki >= 128);
                    const float v = ok ? s[t][r] : -INFINITY;
                    s[t][r] = v; mx = fmaxf(mx, v);
                }
            mx = fmaxf(mx, __shfl_xor(mx, 16)); mx = fmaxf(mx, __shfl_xor(mx, 32));
            float sum = 0.f;
#pragma unroll
            for (int t = 0; t < 9; ++t)
#pragma unroll
                for (int r = 0; r < 4; ++r) { const float pv = __expf(s[t][r] - mx); s[t][r] = pv; sum += pv; }
            sum += __shfl_xor(sum, 16); sum += __shfl_xor(sum, 32);
            const float inv = 1.f / (sum + __expf(sink - mx));
            char* Pw = Ps + wave * 5376 + fr * 336;
#pragma unroll
            for (int t = 0; t < 9; ++t) { u32x2 o; o.x = pk2(s[t][0], s[t][1]); o.y = pk2(s[t][2], s[t][3]); *(u32x2*)(Pw + (16 * t + 4 * fq) * 2) = o; }
            __syncthreads();
            f32x4 o[4];
#pragma unroll
            for (int di = 0; di < 4; ++di) o[di] = (f32x4){0.f, 0.f, 0.f, 0.f};
#pragma unroll
            for (int ks = 0; ks < 5; ++ks) {
                const bf16x8 pf = *(const bf16x8*)(Pw + (32 * ks + 8 * fq) * 2);
#pragma unroll
                for (int di = 0; di < 4; ++di) { const bf16x8 vf = *(const bf16x8*)(VT + (16 * di + fr) * 592 + (16 * wave + 32 * ks + 8 * fq) * 2); o[di] = mfma16(vf, pf, o[di]); }
            }
            bf16_t* dst = PA + (size_t)(b * SEQ + 128 * n + 16 * wave + fr) * LPA + hq * 64 + 4 * fq;
#pragma unroll
            for (int di = 0; di < 4; ++di) { u32x2 w; w.x = pk2(o[di][0] * inv, o[di][1] * inv); w.y = pk2(o[di][2] * inv, o[di][3] * inv); *(u32x2*)(dst + 16 * di) = w; }
            __syncthreads();
        }
    }
}

DEV float logsigf(float x) { return fminf(x, 0.f) - log1pf(expf(-fabsf(x))); }

DEV void chunk_gates(const float* ipre, const float* fpre, int rowbase, int h, float* gs, int lane) {
    const int l0 = 2 * lane;
    const float i0 = ipre[(size_t)(rowbase + l0) * 4 + h], i1 = ipre[(size_t)(rowbase + l0 + 1) * 4 + h];
    const float lf0 = logsigf(fpre[(size_t)(rowbase + l0) * 4 + h]), lf1 = logsigf(fpre[(size_t)(rowbase + l0 + 1) * 4 + h]);
    const float pair = lf0 + lf1;
    float sc = pair;
#pragma unroll
    for (int o = 1; o < 64; o <<= 1) { const float t = __shfl_up(sc, o); if (lane >= o) sc += t; }
    const float b0 = (sc - pair) + lf0, b1 = b0 + lf1;
    const float g = __shfl(sc, 63);
    const float a0 = g - b0 + i0, a1 = g - b1 + i1;
    const float mloc = wave_max(fmaxf(a0, a1));
    const float ib0 = i0 - b0, ib1 = i1 - b1;
    float scm = fmaxf(ib0, ib1);
#pragma unroll
    for (int o = 1; o < 64; o <<= 1) { const float t = __shfl_up(scm, o); if (lane >= o) scm = fmaxf(scm, t); }
    float ex = __shfl_up(scm, 1); if (lane == 0) ex = -INFINITY;
    const float pm0 = fmaxf(ex, ib0), pm1 = fmaxf(pm0, ib1);
    gs[l0] = b0; gs[l0 + 1] = b1; gs[128 + l0] = ib0; gs[128 + l0 + 1] = ib1; gs[256 + l0] = a0; gs[256 + l0 + 1] = a1; gs[384 + l0] = pm0; gs[384 + l0 + 1] = pm1;
    if (lane == 0) { gs[512] = g; gs[513] = mloc; }
}

DEV void conv8(const bf16_t* PM, const float* cw, int b, int t, int pmcol, int cch, float (&out)[8]) {
#pragma unroll
    for (int e = 0; e < 8; ++e) out[e] = 0.f;
#pragma unroll
    for (int j = 0; j < 4; ++j) {
        const int tt = t - 3 + j;
        if (tt >= 0) {
            const u32x4 x = *(const u32x4*)(PM + (size_t)(b * SEQ + tt) * LPM + pmcol);
            const float4 w0 = *(const float4*)(cw + j * 1024 + cch), w1 = *(const float4*)(cw + j * 1024 + cch + 4);
            out[0] += bflo(x[0]) * w0.x; out[1] += bfhi(x[0]) * w0.y; out[2] += bflo(x[1]) * w0.z; out[3] += bfhi(x[1]) * w0.w;
            out[4] += bflo(x[2]) * w1.x; out[5] += bfhi(x[2]) * w1.y; out[6] += bflo(x[3]) * w1.z; out[7] += bfhi(x[3]) * w1.w;
        }
    }
}
DEV float siluf_(float y) { return y / (1.f + __expf(-y)); }

DEV void stage_mstate(const Params& p, char* lds, int vb, int nvb) {
    const int tid = threadIdx.x, lane = tid & 63, wave = __builtin_amdgcn_readfirstlane(tid >> 6), fr = lane & 15, fq = lane >> 4;
    char* KT = lds;
    char* VT = lds + 34816;
    float* gs = (float*)(lds + 69632);
    const bf16_t* PM = (const bf16_t*)(p.ws + WS_PM);
    const float* ipre = (const float*)(p.ws + WS_IPRE); const float* fpre = (const float*)(p.ws + WS_FPRE);
    float* UT = (float*)(p.ws + WS_UB); float* NLOC = (float*)(p.ws + WS_NLOC);
    float* G = (float*)(p.ws + WS_CHG); float* MLOC = G + 1024;
    for (int unit = vb; unit < 1024; unit += nvb) {
        const int c = unit & 127, h = (unit >> 7) & 3, b = unit >> 9;
        const int rowbase = b * SEQ + c * 128;
        __syncthreads();
        if (wave == 0) chunk_gates(ipre, fpre, rowbase, h, gs, lane);
        __syncthreads();
        const float mloc = gs[513];
        for (int task = tid; task < 2048; task += NTH) {
            const int l = task >> 4, ch = task & 15;
            float v8[8]; conv8(PM, p.conv_w, b, c * 128 + l, 512 + h * 128 + ch * 8, 512 + h * 128 + ch * 8, v8);
            const float wgt = __expf(gs[256 + l] - mloc) * 0.08838834764831845f;
#pragma unroll
            for (int e = 0; e < 8; ++e) *(bf16_t*)(KT + (ch * 8 + e) * 272 + l * 2) = (bf16_t)f2bf(siluf_(v8[e]) * wgt);
        }
        for (int task = tid; task < 2048; task += NTH) {
            const int l = task >> 4, ch = task & 15;
            const u32x4 x = *(const u32x4*)(PM + (size_t)(rowbase + l) * LPM + 1024 + h * 128 + ch * 8);
#pragma unroll
            for (int e = 0; e < 8; ++e) *(bf16_t*)(VT + (ch * 8 + e) * 272 + l * 2) = (bf16_t)((e & 1) ? (x[e >> 1] >> 16) : (x[e >> 1] & 0xffffu));
        }
        __syncthreads();
        f32x4 acc[8];
#pragma unroll
        for (int t = 0; t < 8; ++t) acc[t] = (f32x4){0.f, 0.f, 0.f, 0.f};
#pragma unroll
        for (int ks = 0; ks < 4; ++ks) {
            const bf16x8 vf = *(const bf16x8*)(VT + (16 * wave + fr) * 272 + (32 * ks + 8 * fq) * 2);
#pragma unroll
            for (int t = 0; t < 8; ++t) { const bf16x8 kf = *(const bf16x8*)(KT + (16 * t + fr) * 272 + (32 * ks + 8 * fq) * 2); acc[t] = mfma16(kf, vf, acc[t]); }
        }
        float* UTu = UT + (size_t)unit * 16384 + (16 * wave + fr) * 128 + 4 * fq;
#pragma unroll
        for (int t = 0; t < 8; ++t) *(f32x4*)(UTu + 16 * t) = acc[t];
        if (tid < 128) { float s = 0.f; for (int l = 0; l < 128; ++l) s += bf2f(*(const bf16_t*)(KT + tid * 272 + l * 2)); NLOC[unit * 128 + tid] = s; }
        if (tid == 0) { G[unit] = gs[512]; MLOC[unit] = mloc; }
    }
}

DEV void stage_mscan(const Params& p, char* lds, int vb, int nvb) {
    const int tid = threadIdx.x;
    float* s_dec = (float*)lds; float* s_scl = s_dec + 128;
    const float* UT = (const float*)(p.ws + WS_UB); const float* NLOC = (const float*)(p.ws + WS_NLOC);
    const float* G = (const float*)(p.ws + WS_CHG); const float* MLOC = G + 1024; float* MST = (float*)(p.ws + WS_CHG) + 2048;
    bf16_t* CST = (bf16_t*)(p.ws + WS_CST); float* NST = (float*)(p.ws + WS_NST);
    for (int item = vb; item < 256; item += nvb) {
        const int bh = item >> 5, part = item & 31;
        __syncthreads();
        if (tid == 0) {
            float m = 0.f;
            for (int c = 0; c < 128; ++c) { const int u = bh * 128 + c; const float g = G[u], ml = MLOC[u]; const float mn = fmaxf(g + m, ml); s_dec[c] = expf(g + m - mn); s_scl[c] = expf(ml - mn); if (part == 0) MST[u] = m; m = mn; }
        }
        __syncthreads();
        const int e = part * 512 + tid;
        float C = 0.f;
        const float* up = UT + (size_t)bh * 128 * 16384 + e; bf16_t* cp = CST + (size_t)bh * 128 * 16384 + e;
        for (int c = 0; c < 128; c += 8) {
            float uu[8];
#pragma unroll
            for (int i = 0; i < 8; ++i) uu[i] = up[(size_t)(c + i) * 16384];
#pragma unroll
            for (int i = 0; i < 8; ++i) { cp[(size_t)(c + i) * 16384] = (bf16_t)f2bf(C); C = s_dec[c + i] * C + s_scl[c + i] * uu[i]; }
        }
        if (part == 0 && tid < 128) { float nn = 0.f; for (int c = 0; c < 128; ++c) { NST[(bh * 128 + c) * 128 + tid] = nn; nn = s_dec[c] * nn + s_scl[c] * NLOC[(bh * 128 + c) * 128 + tid]; } }
    }
}

DEV void stage_mout(const Params& p, char* lds, int vb, int nvb) {
    const int tid = threadIdx.x, lane = tid & 63, wave = __builtin_amdgcn_readfirstlane(tid >> 6), fr = lane & 15, fq = lane >> 4;
    char* Qs = lds; char* Ks = lds + 34816; char* VT = lds + 69632; char* CT = lds + 104448;
    float* gs = (float*)(lds + 139264); float* s_nst = gs + 520; float* s_mo = gs + 648; float* s_wi = gs + 776;
    bf16_t* PM = (bf16_t*)(p.ws + WS_PM);
    const float* ipre = (const float*)(p.ws + WS_IPRE); const float* fpre = (const float*)(p.ws + WS_FPRE);
    const float* MST = (const float*)(p.ws + WS_CHG) + 2048; const float* NST = (const float*)(p.ws + WS_NST);
    const bf16_t* CST = (const bf16_t*)(p.ws + WS_CST);
    for (int unit = vb; unit < 1024; unit += nvb) {
        const int c = unit & 127, h = (unit >> 7) & 3, b = unit >> 9;
        const int rowbase = b * SEQ + c * 128;
        __syncthreads();
        if (wave == 0) chunk_gates(ipre, fpre, rowbase, h, gs, lane);
        for (int task = tid; task < 2048; task += NTH) {
            const int l = task >> 4, ch = task & 15;
            float v8[8]; u32x4 o;
            conv8(PM, p.conv_w, b, c * 128 + l, h * 128 + ch * 8, h * 128 + ch * 8, v8);
            o.x = pk2(siluf_(v8[0]), siluf_(v8[1])); o.y = pk2(siluf_(v8[2]), siluf_(v8[3])); o.z = pk2(siluf_(v8[4]), siluf_(v8[5])); o.w = pk2(siluf_(v8[6]), siluf_(v8[7]));
            *(u32x4*)(Qs + l * 272 + ch * 16) = o;
            conv8(PM, p.conv_w, b, c * 128 + l, 512 + h * 128 + ch * 8, 512 + h * 128 + ch * 8, v8);
            const float sc = 0.08838834764831845f;
            o.x = pk2(siluf_(v8[0]) * sc, siluf_(v8[1]) * sc); o.y = pk2(siluf_(v8[2]) * sc, siluf_(v8[3]) * sc); o.z = pk2(siluf_(v8[4]) * sc, siluf_(v8[5]) * sc); o.w = pk2(siluf_(v8[6]) * sc, siluf_(v8[7]) * sc);
            *(u32x4*)(Ks + l * 272 + ch * 16) = o;
            const u32x4 x = *(const u32x4*)(PM + (size_t)(rowbase + l) * LPM + 1024 + h * 128 + ch * 8);
#pragma unroll
            for (int e = 0; e < 8; ++e) *(bf16_t*)(VT + (ch * 8 + e) * 272 + l * 2) = (bf16_t)((e & 1) ? (x[e >> 1] >> 16) : (x[e >> 1] & 0xffffu));
            *(u32x4*)(CT + l * 272 + ch * 16) = *(const u32x4*)(CST + (size_t)unit * 16384 + l * 128 + ch * 8);
        }
        if (tid < 128) s_nst[tid] = NST[unit * 128 + tid];
        __syncthreads();
        if (tid < 128) { const float mst = MST[unit]; const float bc = gs[tid]; const float mo = bc + fmaxf(mst, gs[384 + tid]); s_mo[tid] = mo; s_wi[tid] = __expf(bc + mst - mo); }
        __syncthreads();
        const int l = 16 * wave + fr;
        f32x4 s[8];
        bf16x8 qf[4];
#pragma unroll
        for (int ks = 0; ks < 4; ++ks) qf[ks] = *(const bf16x8*)(Qs + l * 272 + (32 * ks + 8 * fq) * 2);
#pragma unroll
        for (int t = 0; t < 8; ++t) {
            s[t] = (f32x4){0.f, 0.f, 0.f, 0.f};
            if (t <= wave) {
#pragma unroll
                for (int ks = 0; ks < 4; ++ks) { const bf16x8 kf = *(const bf16x8*)(Ks + (16 * t + fr) * 272 + (32 * ks + 8 * fq) * 2); s[t] = mfma16(kf, qf[ks], s[t]); }
            }
        }
        const float bl = gs[l], mol = s_mo[l];
        float dsum = 0.f;
#pragma unroll
        for (int t = 0; t < 8; ++t)
#pragma unroll
            for (int r = 0; r < 4; ++r) {
                const int si = 16 * t + 4 * fq + r; float wv = 0.f;
                if (t <= wave && si <= l) wv = __expf(bl + gs[128 + si] - mol) * s[t][r];
                s[t][r] = wv; dsum += wv;
            }
        dsum += __shfl_xor(dsum, 16); dsum += __shfl_xor(dsum, 32);
        float qn = 0.f;
        {
            const char* qrow = Qs + l * 272 + fq * 64;
#pragma unroll
            for (int i = 0; i < 4; ++i) {
                const u32x4 x = *(const u32x4*)(qrow + 16 * i); const float* nn = s_nst + fq * 32 + 8 * i;
                qn += bflo(x[0]) * nn[0] + bfhi(x[0]) * nn[1] + bflo(x[1]) * nn[2] + bfhi(x[1]) * nn[3] + bflo(x[2]) * nn[4] + bfhi(x[2]) * nn[5] + bflo(x[3]) * nn[6] + bfhi(x[3]) * nn[7];
            }
        }
        qn += __shfl_xor(qn, 16); qn += __shfl_xor(qn, 32);
        __syncthreads();
#pragma unroll
        for (int t = 0; t < 8; ++t)
            if (t <= wave + 1) { u32x2 o; o.x = pk2(s[t][0], s[t][1]); o.y = pk2(s[t][2], s[t][3]); *(u32x2*)(Ks + l * 272 + (16 * t + 4 * fq) * 2) = o; }
        __syncthreads();
        f32x4 acc[8];
#pragma unroll
        for (int t = 0; t < 8; ++t) acc[t] = (f32x4){0.f, 0.f, 0.f, 0.f};
#pragma unroll
        for (int ks = 0; ks < 4; ++ks)
#pragma unroll
            for (int t = 0; t < 8; ++t) { const bf16x8 cf = *(const bf16x8*)(CT + (16 * t + fr) * 272 + (32 * ks + 8 * fq) * 2); acc[t] = mfma16(cf, qf[ks], acc[t]); }
        const float wi = s_wi[l];
#pragma unroll
        for (int t = 0; t < 8; ++t) acc[t] = acc[t] * wi;
        const int nks = (wave + 2) >> 1;
#pragma unroll
        for (int ks = 0; ks < 4; ++ks)
            if (ks < nks) {
                const bf16x8 wf = *(const bf16x8*)(Ks + l * 272 + (32 * ks + 8 * fq) * 2);
#pragma unroll
                for (int t = 0; t < 8; ++t) { const bf16x8 vf = *(const bf16x8*)(VT + (16 * t + fr) * 272 + (32 * ks + 8 * fq) * 2); acc[t] = mfma16(vf, wf, acc[t]); }
            }
        const float den = dsum + wi * qn;
        const float invd = 1.f / fmaxf(fabsf(den), __expf(-mol));
        bf16_t* mop = PM + (size_t)(rowbase + l) * LPM + 1536 + h * 128 + 4 * fq;
        float ssq = 0.f;
#pragma unroll
        for (int t = 0; t < 8; ++t) {
            const u32x2 g2 = *(const u32x2*)(mop + 16 * t);
            const float gg[4] = {bflo(g2.x), bfhi(g2.x), bflo(g2.y), bfhi(g2.y)};
#pragma unroll
            for (int r = 0; r < 4; ++r) { const float hv = acc[t][r] * invd * sigmoidf_(gg[r]); acc[t][r] = hv; ssq += hv * hv; }
        }
        ssq += __shfl_xor(ssq, 16); ssq += __shfl_xor(ssq, 32);
        const float rn = rsqrtf(ssq * (1.f / 128.f) + 1e-6f);
#pragma unroll
        for (int t = 0; t < 8; ++t) {
            const float4 nw = *(const float4*)(p.mnorm_w + h * 128 + 16 * t + 4 * fq);
            u32x2 o; o.x = pk2(acc[t][0] * rn * nw.x, acc[t][1] * rn * nw.y); o.y = pk2(acc[t][2] * rn * nw.z, acc[t][3] * rn * nw.w);
            *(u32x2*)(mop + 16 * t) = o;
        }
    }
}

DEV void stage_norm2(const Params& p, char* lds, int vb, int nvb) {
    const int tid = threadIdx.x, lane = tid & 63, wave = __builtin_amdgcn_readfirstlane(tid >> 6);
    const float* mod = (const float*)(p.ws + WS_MOD);
    bf16_t* U2 = (bf16_t*)(p.ws + WS_PG);
    for (int m = vb * NW + wave; m < M; m += nvb * NW) {
        const int b = m >= SEQ ? 1 : 0;
        const float4* xr = (const float4*)(p.out + (size_t)m * D);
        float4 v[4]; float ss = 0.f;
#pragma unroll
        for (int j = 0; j < 4; ++j) { v[j] = xr[lane + 64 * j]; ss += v[j].x * v[j].x + v[j].y * v[j].y + v[j].z * v[j].z + v[j].w * v[j].w; }
        ss = wave_sum(ss);
        const float rstd = rsqrtf(ss * (1.f / 1024.f) + 1e-6f);
#pragma unroll
        for (int j = 0; j < 4; ++j) {
            const int col = 4 * (lane + 64 * j);
            const float4 w1 = *(const float4*)(p.norm2_w + col), sc = *(const float4*)(mod + b * 6144 + 4096 + col), sh = *(const float4*)(mod + b * 6144 + 3072 + col);
            u32x2 o;
            o.x = pk2(v[j].x * rstd * w1.x * (1.f + sc.x) + sh.x, v[j].y * rstd * w1.y * (1.f + sc.y) + sh.y);
            o.y = pk2(v[j].z * rstd * w1.z * (1.f + sc.z) + sh.z, v[j].w * rstd * w1.w * (1.f + sc.w) + sh.w);
            *(u32x2*)(U2 + (size_t)m * D + col) = o;
        }
    }
}

constexpr size_t WS_SELI = 400 * MiB;
constexpr size_t WS_SELG = 416 * MiB;
constexpr size_t WS_SC = 64 * MiB;
DEV unsigned f2ord(float f) { const unsigned u = __float_as_uint(f); return (u & 0x80000000u) ? ~u : (u | 0x80000000u); }
DEV float ord2f(unsigned k) { return __uint_as_float((k & 0x80000000u) ? (k ^ 0x80000000u) : ~k); }
DEV unsigned umax_(unsigned a, unsigned b) { return a > b ? a : b; }

DEV void stage_gemm_q(const Params& p, char* lds, int vb, int nvb) {
    pg8::Gemm g{(const bf16_t*)(p.ws + WS_PG), (const bf16_t*)(p.ws + WS_WQ), M, 2048, 1024, 1024, 1024};
    pg8::StaticOrder S; S.init(M, 2048, nvb, vb);
    pg8::EpiF32 E{(float*)(p.ws + WS_SC), 2048};
    pg8::gemm_phase<pg8::EpiF32, pg8::StaticOrder, true, true>((PG8_LAS unsigned char*)lds, g, S, E);
}

DEV unsigned umin_(unsigned a, unsigned b) { return a < b ? a : b; }
template <int N> DEV void bitonic_sort_desc(unsigned (&a)[N]) {
#pragma unroll
    for (int k = 2; k <= N; k <<= 1)
#pragma unroll
        for (int j = k >> 1; j > 0; j >>= 1)
#pragma unroll
            for (int i = 0; i < N; ++i) { const int l = i ^ j; if (l > i) { const unsigned x = a[i], y = a[l]; const bool dsc = (i & k) == 0; a[i] = dsc ? umax_(x, y) : umin_(x, y); a[l] = dsc ? umin_(x, y) : umax_(x, y); } }
}
template <int N> DEV void bitonic_merge_desc(unsigned (&a)[N]) {
#pragma unroll
    for (int j = N >> 1; j > 0; j >>= 1)
#pragma unroll
        for (int i = 0; i < N; ++i) { const int l = i ^ j; if (l > i) { const unsigned x = a[i], y = a[l]; a[i] = umax_(x, y); a[l] = umin_(x, y); } }
}
template <bool X16> DEV void merge_top16_xlane(unsigned (&x)[16], int lane) {
    unsigned m[16];
#pragma unroll
    for (int i = 0; i < 16; ++i) {
        unsigned pv;
        if (X16) { auto r = __builtin_amdgcn_permlane16_swap(x[15 - i], x[15 - i], false, false); pv = (lane & 16) ? r[0] : r[1]; }
        else { auto r = __builtin_amdgcn_permlane32_swap(x[15 - i], x[15 - i], false, false); pv = (lane & 32) ? r[0] : r[1]; }
        m[i] = umax_(x[i], pv);
    }
    bitonic_merge_desc<16>(m);
#pragma unroll
    for (int i = 0; i < 16; ++i) x[i] = m[i];
}

DEV void stage_q_topk(const Params& p, char* lds, int vb, int nvb) {
    const int tid = threadIdx.x, lane = tid & 63, wave = __builtin_amdgcn_readfirstlane(tid >> 6), fr = lane & 15, fq = lane >> 4;
    unsigned* tops = (unsigned*)lds;
    unsigned char* ptab = (unsigned char*)(lds + 16384);
    const float* SC = (const float*)(p.ws + WS_SC);
    int* SELI = (int*)(p.ws + WS_SELI); float* SELG = (float*)(p.ws + WS_SELG);
    __syncthreads();
    if (tid < 64) { int cnt = 0; unsigned char v = 0xff; for (int i = 0; i < 16; ++i) for (int j = 0; j < 16 / (i + 1); ++j) { if (cnt == tid) v = (unsigned char)(i | (j << 4)); ++cnt; } ptab[tid] = v; }
    __syncthreads();
    for (int item = vb; item < 2048; item += nvb) {
        const int mt = item >> 3, h = item & 7, m0 = mt * 128;
        const float* srow = SC + (size_t)(m0 + 16 * wave + fr) * 2048 + h * 256 + 4 * fq;
        f32x4 sv[2][8];
#pragma unroll
        for (int pp = 0; pp < 2; ++pp)
#pragma unroll
            for (int t = 0; t < 8; ++t) sv[pp][t] = *(const f32x4*)(srow + pp * 128 + 16 * t);
        unsigned* tp = tops + (16 * wave + fr) * 32;
#pragma unroll
        for (int pp = 0; pp < 2; ++pp) {
            unsigned lo[16], hi[16];
#pragma unroll
            for (int t = 0; t < 4; ++t)
#pragma unroll
                for (int r = 0; r < 4; ++r) {
                    lo[4 * t + r] = (f2ord(sv[pp][t][r]) & ~127u) | (127u - (unsigned)(16 * t + 4 * fq + r));
                    hi[4 * t + r] = (f2ord(sv[pp][t + 4][r]) & ~127u) | (127u - (unsigned)(16 * (t + 4) + 4 * fq + r));
                }
            bitonic_sort_desc<16>(lo); bitonic_sort_desc<16>(hi);
#pragma unroll
            for (int i = 0; i < 16; ++i) lo[i] = umax_(lo[i], hi[15 - i]);
            bitonic_merge_desc<16>(lo);
            merge_top16_xlane<true>(lo, lane); merge_top16_xlane<false>(lo, lane);
            if (fq == 0) {
#pragma unroll
                for (int q = 0; q < 4; ++q) *(u32x4*)(tp + pp * 16 + 4 * q) = (u32x4){lo[4 * q], lo[4 * q + 1], lo[4 * q + 2], lo[4 * q + 3]};
            }
        }
        wave_lds_sync();
        unsigned ck[16];
#pragma unroll
        for (int sl = 0; sl < 13; ++sl) {
            const unsigned pr = ptab[4 * sl + fq]; const unsigned i = pr & 15u, j = pr >> 4;
            const float sum = ord2f(tp[i] & ~127u) + ord2f(tp[16 + (j & 15u)] & ~127u);
            ck[sl] = pr != 0xffu ? ((f2ord(sum) & ~255u) | (255u - (i * 16u + j))) : 0u;
        }
        ck[13] = 0u; ck[14] = 0u; ck[15] = 0u;
        bitonic_sort_desc<16>(ck);
        merge_top16_xlane<true>(ck, lane); merge_top16_xlane<false>(ck, lane);
        const float v0 = ord2f(ck[0] & ~255u);
        float ex[16], sm = 0.f;
#pragma unroll
        for (int r = 0; r < 16; ++r) { ex[r] = __expf(ord2f(ck[r] & ~255u) - v0); sm += ex[r]; }
        const float rs = 1.f / sm;
        int oi[4]; float og[4];
#pragma unroll
        for (int q = 0; q < 4; ++q) {
            const unsigned w = fq == 0 ? ck[q] : (fq == 1 ? ck[4 + q] : (fq == 2 ? ck[8 + q] : ck[12 + q]));
            const float e = fq == 0 ? ex[q] : (fq == 1 ? ex[4 + q] : (fq == 2 ? ex[8 + q] : ex[12 + q]));
            const unsigned flat = 255u - (w & 255u); const unsigned ia = flat >> 4, jb = flat & 15u;
            oi[q] = (int)((127u - (tp[ia] & 127u)) * 128u + (127u - (tp[16 + jb] & 127u)));
            og[q] = e * rs;
        }
        const size_t so = (size_t)(m0 + 16 * wave + fr) * 128 + h * 16 + 4 * fq;
        *(int4*)(SELI + so) = make_int4(oi[0], oi[1], oi[2], oi[3]);
        *(float4*)(SELG + so) = make_float4(og[0], og[1], og[2], og[3]);
        wave_lds_sync();
    }
}

DEV float dpp_row_sum(float v) {
    v += __int_as_float(__builtin_amdgcn_update_dpp(0, __float_as_int(v), 0xB1, 0xF, 0xF, true));
    v += __int_as_float(__builtin_amdgcn_update_dpp(0, __float_as_int(v), 0x4E, 0xF, 0xF, true));
    v += __int_as_float(__builtin_amdgcn_update_dpp(0, __float_as_int(v), 0x141, 0xF, 0xF, true));
    v += __int_as_float(__builtin_amdgcn_update_dpp(0, __float_as_int(v), 0x140, 0xF, 0xF, true));
    return v;
}
DEV int dpp_row_isum(int v) {
    v += __builtin_amdgcn_update_dpp(0, v, 0xB1, 0xF, 0xF, true); v += __builtin_amdgcn_update_dpp(0, v, 0x4E, 0xF, 0xF, true);
    v += __builtin_amdgcn_update_dpp(0, v, 0x141, 0xF, 0xF, true); v += __builtin_amdgcn_update_dpp(0, v, 0x140, 0xF, 0xF, true);
    return v;
}
DEV float dpp_row_max(float v) {
    v = fmaxf(v, __int_as_float(__builtin_amdgcn_update_dpp(0, __float_as_int(v), 0xB1, 0xF, 0xF, true))); v = fmaxf(v, __int_as_float(__builtin_amdgcn_update_dpp(0, __float_as_int(v), 0x4E, 0xF, 0xF, true)));
    v = fmaxf(v, __int_as_float(__builtin_amdgcn_update_dpp(0, __float_as_int(v), 0x141, 0xF, 0xF, true))); v = fmaxf(v, __int_as_float(__builtin_amdgcn_update_dpp(0, __float_as_int(v), 0x140, 0xF, 0xF, true)));
    return v;
}
DEV float gelu_as(float v) {
    const float av = fabsf(v), t = __builtin_amdgcn_rcpf(av * 0.2316418882f + 1.0f);
    float q = t * 0.5307027145f + (-0.7265760135f); q = q * t + 0.7107068705f; q = q * t + (-0.142248368f); q = q * t + 0.127414796f; q = q * t;
    const float e = __builtin_amdgcn_exp2f(v * v * (-0.72134752044f));
    const float m = v * (q * e);
    return v < 0.f ? m : v - m;
}
constexpr int NBIN = 32;
constexpr int GW_IDX = 0, GW_GATE = 1024, GW_SU = 3072, GW_SV = 5120, GW_W = 7168, GW_WQ = 9216, GW_BYTES = 9728;
DEV void g_sort_token(const int* SELI, const float* SELG, const float* SU, const float* SV, int tkn, char* wl, int j, int lane, int msk) {
    const int i0 = SELI[(size_t)tkn * 128 + lane] & msk, i1 = SELI[(size_t)tkn * 128 + 64 + lane] & msk;
    const float g0 = SELG[(size_t)tkn * 128 + lane], g1 = SELG[(size_t)tkn * 128 + 64 + lane];
    const float su0 = SU[i0], su1 = SU[i1], sv0 = SV[i0], sv1 = SV[i1];
    const int s0 = i0 >> 9, s1 = i1 >> 9;
    const unsigned long long lt = (1ull << lane) - 1ull;
    int base = 0, p0 = 0, p1 = 0;
#pragma unroll
    for (int s = 0; s < NBIN; ++s) {
        const unsigned long long m0 = __ballot(s0 == s), m1 = __ballot(s1 == s);
        const int c0 = __popcll(m0), c1 = __popcll(m1);
        if (s0 == s) p0 = base + __popcll(m0 & lt);
        if (s1 == s) p1 = base + c0 + __popcll(m1 & lt);
        base += c0 + c1;
    }
    unsigned short* li = (unsigned short*)(wl + GW_IDX) + j * 128; float* lg = (float*)(wl + GW_GATE) + j * 128; float* lsu = (float*)(wl + GW_SU) + j * 128; float* lsv = (float*)(wl + GW_SV) + j * 128;
    li[p0] = (unsigned short)i0; lg[p0] = g0; lsu[p0] = su0; lsv[p0] = sv0;
    li[p1] = (unsigned short)i1; lg[p1] = g1; lsu[p1] = su1; lsv[p1] = sv1;
}
DEV void r_load(u32x4 (&d)[4], const unsigned char* T, int id, int c) {
    const u32x4* q = (const u32x4*)(T + (size_t)id * 1024 + c * 64);
#pragma unroll
    for (int k = 0; k < 4; ++k) d[k] = q[k];
}
DEV int r_dotq(const u32x4 (&u)[4], const unsigned (&xq)[16]) {
    int s0 = 0, s1 = 0, s2 = 0, s3 = 0;
#pragma unroll
    for (int k = 0; k < 4; ++k) {
        s0 = __builtin_amdgcn_sdot4((int)u[k][0], (int)xq[4 * k], s0, false); s1 = __builtin_amdgcn_sdot4((int)u[k][1], (int)xq[4 * k + 1], s1, false);
        s2 = __builtin_amdgcn_sdot4((int)u[k][2], (int)xq[4 * k + 2], s2, false); s3 = __builtin_amdgcn_sdot4((int)u[k][3], (int)xq[4 * k + 3], s3, false);
    }
    return (s0 + s1) + (s2 + s3);
}
DEV float r_weight(int part, float sx, const char* wl, int r, int e) {
    const float d = (float)dpp_row_isum(part) * (((const float*)(wl + GW_SU))[r * 128 + e] * sx);
    return ((const float*)(wl + GW_GATE))[r * 128 + e] * gelu_as(d) * ((const float*)(wl + GW_SV))[r * 128 + e];
}
DEV void r_vaccq(const u32x4 (&v0)[4], const u32x4 (&v1)[4], const u32x4 (&v2)[4], const u32x4 (&v3)[4], unsigned wpk, int (&acc)[64]) {
#pragma unroll
    for (int k = 0; k < 4; ++k)
#pragma unroll
        for (int w = 0; w < 4; ++w) {
            const unsigned r0 = v0[k][w], r1 = v1[k][w], r2 = v2[k][w], r3 = v3[k][w];
            const unsigned p0 = __builtin_amdgcn_perm(r1, r0, 0x05010400u), p1 = __builtin_amdgcn_perm(r1, r0, 0x07030602u);
            const unsigned q0 = __builtin_amdgcn_perm(r3, r2, 0x05010400u), q1 = __builtin_amdgcn_perm(r3, r2, 0x07030602u);
            const unsigned t0 = __builtin_amdgcn_perm(q0, p0, 0x05040100u), t1 = __builtin_amdgcn_perm(q0, p0, 0x07060302u);
            const unsigned t2 = __builtin_amdgcn_perm(q1, p1, 0x05040100u), t3 = __builtin_amdgcn_perm(q1, p1, 0x07060302u);
            const int o = 16 * k + 4 * w;
            acc[o] = __builtin_amdgcn_sdot4((int)t0, (int)wpk, acc[o], false); acc[o + 1] = __builtin_amdgcn_sdot4((int)t1, (int)wpk, acc[o + 1], false);
            acc[o + 2] = __builtin_amdgcn_sdot4((int)t2, (int)wpk, acc[o + 2], false); acc[o + 3] = __builtin_amdgcn_sdot4((int)t3, (int)wpk, acc[o + 3], false);
        }
}
#define SB_() __builtin_amdgcn_sched_barrier(0)

DEV void stage_peer_gather(const Params& p, char* lds, int slot, int nslots, bool dry = false, int msk = 0x3fff) {
    const int tid = threadIdx.x, lane = tid & 63, wave = __builtin_amdgcn_readfirstlane(tid >> 6), r = lane >> 4, c = lane & 15;
    const bf16_t* U2 = (const bf16_t*)(p.ws + WS_PG);
    const unsigned char* TU = p.ws + WS_TU; const unsigned char* TV = p.ws + WS_TV;
    const float* SU = (const float*)(p.ws + WS_ISU); const float* SV = (const float*)(p.ws + WS_ISV);
    const int* SELI = (const int*)(p.ws + WS_SELI); const float* SELG = (const float*)(p.ws + WS_SELG);
    const float* mod = (const float*)(p.ws + WS_MOD);
    char* wl = lds + wave * GW_BYTES;
    const unsigned short* myi = (const unsigned short*)(wl + GW_IDX) + r * 128;
    float* lw = (float*)(wl + GW_W) + r * 128; unsigned* lwq = (unsigned*)(wl + GW_WQ) + r * 32;
    const int tpb = M / nslots;
    __syncthreads();
    for (int g0 = 0; g0 < tpb; g0 += 32) {
        const int tbase = slot * tpb + g0 + 4 * wave;
#pragma unroll
        for (int j = 0; j < 4; ++j) g_sort_token(SELI, SELG, SU, SV, tbase + j, wl, j, lane, msk);
        const int tkn = tbase + r;
        unsigned xq[16]; float sx;
        {
            const u32x4* xr = (const u32x4*)(U2 + (size_t)tkn * D + 64 * c);
            u32x4 t[8]; float amax = 0.f;
#pragma unroll
            for (int k = 0; k < 8; ++k) { t[k] = xr[k];
#pragma unroll
                for (int i = 0; i < 4; ++i) amax = fmaxf(amax, fmaxf(fabsf(bflo(t[k][i])), fabsf(bfhi(t[k][i])))); }
            amax = dpp_row_max(amax);
            const float inv = amax > 0.f ? 127.f / amax : 0.f; sx = amax > 0.f ? amax * (1.f / 127.f) : 1.f;
#pragma unroll
            for (int k = 0; k < 8; ++k)
#pragma unroll
                for (int h2 = 0; h2 < 2; ++h2) {
                    const unsigned a = t[k][2 * h2], b = t[k][2 * h2 + 1];
                    const unsigned wv = ((unsigned)__float2int_rn(bflo(a) * inv) & 0xffu) | (((unsigned)__float2int_rn(bfhi(a) * inv) & 0xffu) << 8) | (((unsigned)__float2int_rn(bflo(b) * inv) & 0xffu) << 16) | ((unsigned)__float2int_rn(bfhi(b) * inv) << 24);
                    xq[2 * k + h2] = wv;
                }
        }
        wave_lds_sync();
        float wmax = 0.f;
        {
            u32x4 ua[4], ub[4], uc[4], ud[4];
            r_load(ua, TU, (int)myi[0], c); r_load(ub, TU, (int)myi[1], c); r_load(uc, TU, (int)myi[2], c); r_load(ud, TU, (int)myi[3], c);
            for (int e = 0; e < 128; e += 4) {
                SB_(); const int pa = r_dotq(ua, xq); SB_(); r_load(ua, TU, (int)myi[e + 4 < 128 ? e + 4 : 127], c); SB_();
                const int pb = r_dotq(ub, xq); SB_(); r_load(ub, TU, (int)myi[e + 5 < 128 ? e + 5 : 127], c); SB_();
                const int pc = r_dotq(uc, xq); SB_(); r_load(uc, TU, (int)myi[e + 6 < 128 ? e + 6 : 127], c); SB_();
                const int pd = r_dotq(ud, xq); SB_(); r_load(ud, TU, (int)myi[e + 7 < 128 ? e + 7 : 127], c); SB_();
                const float w0 = r_weight(pa, sx, wl, r, e), w1 = r_weight(pb, sx, wl, r, e + 1), w2 = r_weight(pc, sx, wl, r, e + 2), w3 = r_weight(pd, sx, wl, r, e + 3);
                wmax = fmaxf(fmaxf(wmax, fmaxf(fabsf(w0), fabsf(w1))), fmaxf(fabsf(w2), fabsf(w3)));
                if (c == 0) *(f32x4*)(lw + e) = (f32x4){w0, w1, w2, w3};
            }
        }
        const float T = wmax > 0.f ? wmax * (1.f / 127.f) : 1.f, invT = wmax > 0.f ? 127.f / wmax : 0.f;
        wave_lds_sync();
#pragma unroll
        for (int h2 = 0; h2 < 2; ++h2) {
            const int gg = c + 16 * h2; const f32x4 wv = *(const f32x4*)(lw + 4 * gg);
            lwq[gg] = ((unsigned)__float2int_rn(wv[0] * invT) & 0xffu) | (((unsigned)__float2int_rn(wv[1] * invT) & 0xffu) << 8) | (((unsigned)__float2int_rn(wv[2] * invT) & 0xffu) << 16) | ((unsigned)__float2int_rn(wv[3] * invT) << 24);
        }
        wave_lds_sync();
        int acc[64];
#pragma unroll
        for (int i = 0; i < 64; ++i) acc[i] = 0;
        {
            u32x4 a0[4], a1[4], a2[4], a3[4], b0[4], b1[4], b2[4], b3[4];
            r_load(a0, TV, (int)myi[0], c); r_load(a1, TV, (int)myi[1], c); r_load(a2, TV, (int)myi[2], c); r_load(a3, TV, (int)myi[3], c);
            r_load(b0, TV, (int)myi[4], c); r_load(b1, TV, (int)myi[5], c); r_load(b2, TV, (int)myi[6], c); r_load(b3, TV, (int)myi[7], c);
            for (int g = 0; g < 32; g += 2) {
                const int n2 = g + 2 < 32 ? 4 * (g + 2) : 124, n3 = g + 3 < 32 ? 4 * (g + 3) : 124;
                SB_(); r_vaccq(a0, a1, a2, a3, lwq[g], acc); SB_();
                r_load(a0, TV, (int)myi[n2], c); r_load(a1, TV, (int)myi[n2 + 1], c); r_load(a2, TV, (int)myi[n2 + 2], c); r_load(a3, TV, (int)myi[n2 + 3], c); SB_();
                r_vaccq(b0, b1, b2, b3, lwq[g + 1], acc); SB_();
                r_load(b0, TV, (int)myi[n3], c); r_load(b1, TV, (int)myi[n3 + 1], c); r_load(b2, TV, (int)myi[n3 + 2], c); r_load(b3, TV, (int)myi[n3 + 3], c); SB_();
            }
        }
        const int b = tkn >= SEQ ? 1 : 0;
        float* hr = p.out + (size_t)tkn * D + 64 * c;
        const float* g2p = mod + b * 6144 + 5120 + 64 * c;
        float y[64]; float ss = 0.f;
#pragma unroll
        for (int q = 0; q < 16; ++q) {
            const float4 hv = *(const float4*)(hr + 4 * q); const float4 g2 = *(const float4*)(g2p + 4 * q);
            y[4 * q] = hv.x + g2.x * (T * (float)acc[4 * q]); y[4 * q + 1] = hv.y + g2.y * (T * (float)acc[4 * q + 1]);
            y[4 * q + 2] = hv.z + g2.z * (T * (float)acc[4 * q + 2]); y[4 * q + 3] = hv.w + g2.w * (T * (float)acc[4 * q + 3]);
            ss += y[4 * q] * y[4 * q] + y[4 * q + 1] * y[4 * q + 1] + y[4 * q + 2] * y[4 * q + 2] + y[4 * q + 3] * y[4 * q + 3];
        }
        ss = dpp_row_sum(ss);
        const float rstd = rsqrtf(ss * (1.f / 1024.f) + 1e-6f);
        if (!dry || rstd == 123.456f)
#pragma unroll
        for (int q = 0; q < 16; ++q) {
            const float4 nw = *(const float4*)(p.normf_w + 64 * c + 4 * q);
            float4 o; o.x = y[4 * q] * rstd * nw.x; o.y = y[4 * q + 1] * rstd * nw.y; o.z = y[4 * q + 2] * rstd * nw.z; o.w = y[4 * q + 3] * rstd * nw.w;
            *(float4*)(hr + 4 * q) = o;
        }
        wave_lds_sync();
    }
}

#define LAS __attribute__((address_space(3)))
#define XB_TMO      128
#define XB_XCNT(j)  (256  + 64 * (j))
#define XB_XSUB(j)  (1280 + 64 * (j))
#define XB_XGEN(j)  (2304 + 64 * (j))
#define XB_TOP      3328
#define XB_TOPGEN   3392
#define XCD_BAR_WORDS 3456
#define XB_SPIN_CAP (1u << 18)

__device__ __forceinline__ unsigned xb_ld(unsigned* p)              { return __hip_atomic_load(p, __ATOMIC_RELAXED, __HIP_MEMORY_SCOPE_AGENT); }
__device__ __forceinline__ unsigned xb_add(unsigned* p, unsigned v) { return __hip_atomic_fetch_add(p, v, __ATOMIC_RELAXED, __HIP_MEMORY_SCOPE_AGENT); }
__device__ __forceinline__ unsigned xb_xcc_id() { return (unsigned)__builtin_amdgcn_s_getreg((3 << 11) | 20) & 0xFu; }
#define XB_SPIN(cond, bar) do { unsigned _sp = 0; while (cond) { __builtin_amdgcn_s_sleep(1); \
    if ((++_sp & 255u) == 0u) { if (xb_ld(&(bar)[XB_TMO])) break; if (_sp > XB_SPIN_CAP) { atomicAdd(&(bar)[XB_TMO], 1u); break; } } } } while (0)

struct XcdBarrier {
    unsigned* bar; unsigned x;
    volatile LAS unsigned* st;
};

__device__ __forceinline__ XcdBarrier xcd_barrier_post(unsigned* bar, volatile LAS unsigned* st) {
    XcdBarrier b; b.bar = bar; b.x = xb_xcc_id(); b.st = st;
    if (threadIdx.x == 0) (void)xb_add(&bar[XB_XCNT(b.x)], 1u);
    return b;
}
__device__ __forceinline__ void xcd_barrier_complete(unsigned* bar, unsigned x, unsigned& nloc, unsigned& nx) {
    const unsigned G = gridDim.x * gridDim.y * gridDim.z;
    unsigned sum, cnt, mine, sp = 0u;
    for (;;) {
        sum = 0u; cnt = 0u; mine = 0u;
#pragma unroll
        for (unsigned j = 0; j < 16; ++j) { const unsigned c = xb_ld(&bar[XB_XCNT(j)]); sum += c; cnt += (c > 0u) ? 1u : 0u; mine = (j == x) ? c : mine; }
        if (sum == G) break;
        __builtin_amdgcn_s_sleep(1);
        if ((++sp & 255u) == 0u) { if (xb_ld(&bar[XB_TMO])) break; if (sp > XB_SPIN_CAP) { atomicAdd(&bar[XB_TMO], 1u); break; } }
    }
    nloc = mine > 0u ? mine : 1u; nx = cnt > 0u ? cnt : 1u;
}

__device__ __forceinline__ void xcd_barrier(const XcdBarrier& b) {
    asm volatile("s_waitcnt vmcnt(0)" ::: "memory");
    __syncthreads();
    if (threadIdx.x == 0) {
        unsigned* bar = b.bar;
        __builtin_amdgcn_s_waitcnt(0);
        unsigned nloc = b.st[0], nx = b.st[1];
        if (nloc == 0u) { xcd_barrier_complete(bar, b.x, nloc, nx); b.st[0] = nloc; b.st[1] = nx; }
        const unsigned old = xb_add(&bar[XB_XSUB(b.x)], 1u);
        const unsigned gen = old / nloc;
        if (old + 1u == (gen + 1u) * nloc) {
            __builtin_amdgcn_fence(__ATOMIC_RELEASE, "agent");
            asm volatile("s_waitcnt vmcnt(0)" ::: "memory");
            const unsigned og = xb_add(&bar[XB_TOP], 1u);
            const unsigned tg = og / nx;
            if (og + 1u == (tg + 1u) * nx) xb_add(&bar[XB_TOPGEN], 1u);
            else XB_SPIN(xb_ld(&bar[XB_TOPGEN]) == tg, bar);
            __builtin_amdgcn_fence(__ATOMIC_ACQUIRE, "agent");
            xb_add(&bar[XB_XGEN(b.x)], 1u);
            asm volatile("s_waitcnt vmcnt(0)" ::: "memory");
        } else {
            XB_SPIN(xb_ld(&bar[XB_XGEN(b.x)]) == gen, bar);
            __builtin_amdgcn_fence(__ATOMIC_ACQUIRE, "agent");
            asm volatile("s_waitcnt vmcnt(0)" ::: "memory");
        }
    }
    __syncthreads();
}

namespace cg = cooperative_groups;
constexpr int LDS_BYTES = 151552;
constexpr int CW_RANK = XCD_BAR_WORDS;

constexpr int LDS_TOTAL = LDS_BYTES + 64;

__global__ void __launch_bounds__(512) k_mega(Params p) {
    extern __shared__ __attribute__((aligned(16))) char lds[];
    cg::grid_group grid = cg::this_grid();
    const int vb = blockIdx.x, nvb = gridDim.x;
    volatile LAS unsigned* bst = (volatile LAS unsigned*)((LAS char*)lds + LDS_BYTES);
    if (threadIdx.x < 16) bst[threadIdx.x] = 0u;
    __syncthreads();
    XcdBarrier bar = xcd_barrier_post((unsigned*)p.ws, bst);
    if (threadIdx.x == 0) bst[2] = xb_add((unsigned*)p.ws + CW_RANK + 64 * bar.x, 1u);
#define GRID_BAR() xcd_barrier(bar)
    stage_prep(p, lds, vb, nvb);        grid.sync();
    stage_norm1(p, lds, vb, nvb);       GRID_BAR();
    stage_gemm_in(p, lds, vb, nvb);     GRID_BAR();
    stage_attn(p, lds, vb, nvb);
    stage_mstate(p, lds, vb, nvb);      GRID_BAR();
    stage_mscan(p, lds, vb, nvb);       GRID_BAR();
    stage_mout(p, lds, vb, nvb);        GRID_BAR();
    stage_gemm_merge(p, lds, vb, nvb);  GRID_BAR();
    stage_gemm_out(p, lds, vb, nvb);    GRID_BAR();
    stage_norm2(p, lds, vb, nvb);       GRID_BAR();
    stage_gemm_q(p, lds, vb, nvb);      GRID_BAR();
    stage_q_topk(p, lds, vb, nvb);      GRID_BAR();
    if (threadIdx.x == 0) { unsigned base = 0u; for (unsigned j = 0; j < bar.x; ++j) base += xb_ld((unsigned*)p.ws + XB_XCNT(j)); bst[3] = base + bst[2]; }
    __syncthreads();
    const int slot = (int)bst[3];
#ifdef XPG
    stage_peer_gather(p, lds, slot < nvb ? slot : vb, nvb, p.ws != nullptr, XPG == 1 ? 0x3fff : 0x3e1f);
#endif
    stage_peer_gather(p, lds, slot < nvb ? slot : vb, nvb);
}

extern "C" void kernel_launch(void* const* d_in, const int* in_sizes, int n_in, void* d_out, int out_size, void* d_ws, size_t ws_size, hipStream_t stream) {
    if (n_in != 20 || ws_size < WS_END) { fprintf(stderr, "kernel_launch: unexpected n_in %d or ws_size %zu\n", n_in, ws_size); return; }
    static int grid_blocks = 0;
    if (!grid_blocks) {
        int dev = 0, cus = 0, per_cu = 0;
        (void)hipGetDevice(&dev);
        (void)hipDeviceGetAttribute(&cus, hipDeviceAttributeMultiprocessorCount, dev);
        (void)hipFuncSetAttribute((const void*)k_mega, hipFuncAttributeMaxDynamicSharedMemorySize, LDS_TOTAL);
        (void)hipOccupancyMaxActiveBlocksPerMultiprocessor(&per_cu, (const void*)k_mega, 512, LDS_TOTAL);
        if (per_cu < 1) { fprintf(stderr, "kernel_launch: occupancy query says %d blocks per CU\n", per_cu); per_cu = 1; }
        grid_blocks = cus * 1;
    }
    Params p{};
    p.x = (const float*)d_in[0]; p.c = (const float*)d_in[1]; p.w_ada = (const float*)d_in[2]; p.b_ada = (const float*)d_in[3]; p.norm1_w = (const float*)d_in[4];
    p.w_in = (const float*)d_in[5]; p.conv_w = (const float*)d_in[6]; p.sinks = (const float*)d_in[7]; p.i_bias = (const float*)d_in[8]; p.f_bias = (const float*)d_in[9];
    p.mnorm_w = (const float*)d_in[10]; p.w_a = (const float*)d_in[11]; p.w_b = (const float*)d_in[12]; p.w_out = (const float*)d_in[13]; p.norm2_w = (const float*)d_in[14];
    p.w_q = (const float*)d_in[15]; p.sub_keys = (const float*)d_in[16]; p.peer_u = (const float*)d_in[17]; p.peer_v = (const float*)d_in[18]; p.normf_w = (const float*)d_in[19];
    p.out = (float*)d_out; p.ws = (unsigned char*)d_ws;
    (void)hipMemsetAsync(d_ws, 0, 32768, stream);
    void* args[] = {&p};
    hipError_t e = hipLaunchCooperativeKernel((const void*)k_mega, dim3(grid_blocks), dim3(512), args, LDS_TOTAL, stream);
    if (e != hipSuccess) fprintf(stderr, "cooperative launch failed: %s (grid %d)\n", hipGetErrorString(e), grid_blocks);
}
```

```cpp
#include <hip/hip_runtime.h>
#include <hip/hip_cooperative_groups.h>
#include <stdint.h>
#include <stdio.h>

#define DEV __device__ __forceinline__
typedef unsigned short bf16_t;
typedef short bf16x8 __attribute__((ext_vector_type(8)));
typedef float f32x4 __attribute__((ext_vector_type(4)));
typedef unsigned u32x4 __attribute__((ext_vector_type(4)));
typedef unsigned u32x2 __attribute__((ext_vector_type(2)));

constexpr int BATCH = 2, SEQ = 16384, M = BATCH * SEQ, D = 1024;
constexpr int NTH = 512, NW = 8;
constexpr int LPA = 768, LPM = 2048, LPG = 2048;

struct Params {
    const float *x, *c, *w_ada, *b_ada, *norm1_w, *w_in, *conv_w, *sinks, *i_bias, *f_bias, *mnorm_w, *w_a, *w_b, *w_out, *norm2_w, *w_q, *sub_keys, *peer_u, *peer_v, *normf_w;
    float* out; unsigned char* ws;
};

constexpr size_t MiB = 1u << 20;
constexpr size_t WS_MOD = 1 * MiB;
constexpr size_t WS_IPRE = 2 * MiB;
constexpr size_t WS_FPRE = 2 * MiB + 512 * 1024;
constexpr size_t WS_CHG = 3 * MiB;
constexpr size_t WS_NLOC = 4 * MiB;
constexpr size_t WS_NST = 4 * MiB + 512 * 1024;
constexpr size_t WS_ROPE = 5 * MiB;
constexpr size_t WS_WIN = 10 * MiB;
constexpr size_t WS_WA = 20 * MiB;
constexpr size_t WS_WB = 21 * MiB;
constexpr size_t WS_WOUT = 22 * MiB;
constexpr size_t WS_WQ = 24 * MiB;
constexpr size_t WS_SK = 28 * MiB;
constexpr size_t WS_ISU = 29 * MiB;
constexpr size_t WS_ISV = 29 * MiB + 65536;
constexpr size_t WS_TU = 32 * MiB;
constexpr size_t WS_TV = 48 * MiB;
constexpr size_t WS_UB = 96 * MiB;
constexpr size_t WS_PA = 160 * MiB;
constexpr size_t WS_PM = 208 * MiB;
constexpr size_t WS_PG = 336 * MiB;
constexpr size_t WS_CST = 464 * MiB;
constexpr size_t WS_END = 496 * MiB;

DEV unsigned f2bf(float f) { unsigned u = __float_as_uint(f); return (u + 0x7fffu + ((u >> 16) & 1u)) >> 16; }
DEV unsigned pk2(float lo, float hi) { return f2bf(lo) | (f2bf(hi) << 16); }
DEV float bflo(unsigned u) { return __uint_as_float(u << 16); }
DEV float bfhi(unsigned u) { return __uint_as_float(u & 0xffff0000u); }
DEV float bf2f(bf16_t h) { return __uint_as_float(((unsigned)h) << 16); }
DEV float wave_sum(float v) {
#pragma unroll
    for (int o = 32; o > 0; o >>= 1) v += __shfl_xor(v, o);
    return v;
}
DEV float wave_max(float v) {
#pragma unroll
    for (int o = 32; o > 0; o >>= 1) v = fmaxf(v, __shfl_xor(v, o));
    return v;
}
DEV float sigmoidf_(float v) { return 1.f / (1.f + __expf(-v)); }
DEV f32x4 mfma16(bf16x8 a, bf16x8 b, f32x4 c) { return __builtin_amdgcn_mfma_f32_16x16x32_bf16(a, b, c, 0, 0, 0); }
DEV void wave_lds_sync() { __builtin_amdgcn_fence(__ATOMIC_ACQ_REL, "wavefront"); __builtin_amdgcn_wave_barrier(); }

DEV void transpose_item(const float* W, int ldw, int k0, int nsrc0, bf16_t* WT, int ldt, int ndst0, float* scr, int lane) {
#pragma unroll 8
    for (int i = 0; i < 32; ++i) { const int kk = 2 * i + (lane >> 5); scr[kk * 33 + (lane & 31)] = W[(size_t)(k0 + kk) * ldw + nsrc0 + (lane & 31)]; }
    wave_lds_sync();
    const int c = lane & 7;
#pragma unroll
    for (int j = 0; j < 4; ++j) {
        const int n = (lane >> 3) + 8 * j; const float* s = scr + (8 * c) * 33 + n;
        u32x4 o; o.x = pk2(s[0 * 33], s[1 * 33]); o.y = pk2(s[2 * 33], s[3 * 33]); o.z = pk2(s[4 * 33], s[5 * 33]); o.w = pk2(s[6 * 33], s[7 * 33]);
        *(u32x4*)(WT + (size_t)(ndst0 + n) * ldt + k0 + 8 * c) = o;
    }
    wave_lds_sync();
}

DEV void stage_prep(const Params& p, char* lds, int vb, int nvb) {
    const int tid = threadIdx.x, lane = tid & 63, wave = __builtin_amdgcn_readfirstlane(tid >> 6);
    float* mod = (float*)(p.ws + WS_MOD);
    float* s_act = (float*)lds;
    float* s_red = (float*)(lds + 8192);
    for (int i = tid; i < 2048; i += NTH) { const float v = p.c[i]; s_act[i] = v / (1.f + expf(-v)); }
    __syncthreads();
    for (int item = vb; item < 192; item += nvb) {
        const int kg = tid >> 5, cl = tid & 31, col = item * 32 + cl;
        float s0 = 0.f, s1 = 0.f;
        for (int k = kg; k < 1024; k += 16) { const float w = p.w_ada[(size_t)k * 6144 + col]; s0 += s_act[k] * w; s1 += s_act[1024 + k] * w; }
        s_red[(kg * 32 + cl) * 2] = s0; s_red[(kg * 32 + cl) * 2 + 1] = s1;
        __syncthreads();
        if (tid < 64) { const int b = tid >> 5, c2 = tid & 31; float s = 0.f; for (int g = 0; g < 16; ++g) s += s_red[(g * 32 + c2) * 2 + b]; mod[b * 6144 + item * 32 + c2] = s + p.b_ada[item * 32 + c2]; }
        __syncthreads();
    }
    float* scr = (float*)(lds + 16384 + wave * 8448);
    const int gw = vb * NW + wave, ngw = nvb * NW;
    bf16_t* Wt_in = (bf16_t*)(p.ws + WS_WIN); bf16_t* Wt_a = (bf16_t*)(p.ws + WS_WA); bf16_t* Wt_b = (bf16_t*)(p.ws + WS_WB);
    bf16_t* Wt_out = (bf16_t*)(p.ws + WS_WOUT); bf16_t* Wt_q = (bf16_t*)(p.ws + WS_WQ);
    for (int it = gw; it < 3456; it += ngw) {
        int r = it;
        if (r < 2432) { const int kb = r / 152, nb = r % 152; transpose_item(p.w_in, 4872, kb * 64, nb * 32 + (nb >= 88 ? 8 : 0), Wt_in, 1024, nb * 32, scr, lane); continue; } r -= 2432;
        if (r < 256) { const int kb = r / 32, nb = r % 32; transpose_item(p.w_a, 1024, kb * 64, nb * 32, Wt_a, 512, nb * 32, scr, lane); continue; } r -= 256;
        if (r < 256) { const int kb = r / 32, nb = r % 32; transpose_item(p.w_b, 1024, kb * 64, nb * 32, Wt_b, 512, nb * 32, scr, lane); continue; } r -= 256;
        { const int kb = r / 32, nb = r % 32; transpose_item(p.w_out, 1024, kb * 64, nb * 32, Wt_out, 1024, nb * 32, scr, lane); }
    }
    {
        float* WL = (float*)lds;
        float* KL = (float*)(lds + 33792);
        for (int item = vb; item < 256; item += nvb) {
            const int hp = item >> 4, k0 = (item & 15) * 64, pidx = hp & 1;
            __syncthreads();
            for (int i = tid; i < 64 * 32; i += NTH) { const int kk = i >> 5, d4 = i & 31; *(float4*)(WL + kk * 132 + 4 * d4) = *(const float4*)(p.w_q + (size_t)(k0 + kk) * 2048 + hp * 128 + 4 * d4); }
            for (int i = tid; i < 128 * 32; i += NTH) ((float4*)KL)[i] = ((const float4*)(p.sub_keys + (size_t)pidx * 16384))[i];
            __syncthreads();
            const int kk = tid & 63, n0 = (tid >> 6) * 16;
            float acc[16];
#pragma unroll
            for (int j = 0; j < 16; ++j) acc[j] = 0.f;
            for (int d4 = 0; d4 < 32; ++d4) {
                const float4 w = *(const float4*)(WL + kk * 132 + 4 * d4);
#pragma unroll
                for (int j = 0; j < 16; ++j) { const float4 kv = *(const float4*)(KL + (n0 + j) * 128 + 4 * d4); acc[j] += w.x * kv.x + w.y * kv.y + w.z * kv.z + w.w * kv.w; }
            }
#pragma unroll
            for (int j = 0; j < 16; ++j) Wt_q[(size_t)(hp * 128 + n0 + j) * 1024 + k0 + kk] = (bf16_t)f2bf(acc[j]);
        }
        __syncthreads();
    }
    const size_t gt = (size_t)vb * NTH + tid, ngt = (size_t)nvb * NTH;
    for (int rowb = gw; rowb < 32768; rowb += 4 * ngw) {
        float4 aa[4][4];
#pragma unroll
        for (int rr = 0; rr < 4; ++rr) { const int row = rowb + rr * ngw < 32768 ? rowb + rr * ngw : rowb; const float4* src = (const float4*)((row >= 16384 ? p.peer_v : p.peer_u) + (size_t)(row & 16383) * D) + 4 * lane;
#pragma unroll
            for (int i = 0; i < 4; ++i) aa[rr][i] = src[i]; }
#pragma unroll
        for (int rr = 0; rr < 4; ++rr) {
            const int row = rowb + rr * ngw;
            if (row < 32768) {
                const bool isv = row >= 16384; const int r = row & 16383;
                float mx = 0.f;
#pragma unroll
                for (int i = 0; i < 4; ++i) mx = fmaxf(mx, fmaxf(fmaxf(fabsf(aa[rr][i].x), fabsf(aa[rr][i].y)), fmaxf(fabsf(aa[rr][i].z), fabsf(aa[rr][i].w))));
                mx = wave_max(mx);
                const float inv = mx > 0.f ? 127.f / mx : 0.f, sc = mx > 0.f ? mx * (1.f / 127.f) : 1.f;
                u32x4 w;
#pragma unroll
                for (int i = 0; i < 4; ++i) w[i] = ((unsigned)__float2int_rn(aa[rr][i].x * inv) & 0xffu) | (((unsigned)__float2int_rn(aa[rr][i].y * inv) & 0xffu) << 8) | (((unsigned)__float2int_rn(aa[rr][i].z * inv) & 0xffu) << 16) | ((unsigned)__float2int_rn(aa[rr][i].w * inv) << 24);
                ((u32x4*)(p.ws + (isv ? WS_TV : WS_TU) + (size_t)r * 1024))[lane] = w;
                if (lane == 0) ((float*)(p.ws + (isv ? WS_ISV : WS_ISU)))[r] = sc;
            }
        }
    }
    for (size_t g = gt; g < 4096; g += ngt) {
        const float4 a = ((const float4*)p.sub_keys)[2 * g], b = ((const float4*)p.sub_keys)[2 * g + 1];
        u32x4 w; w.x = pk2(a.x, a.y); w.y = pk2(a.z, a.w); w.z = pk2(b.x, b.y); w.w = pk2(b.z, b.w);
        ((u32x4*)(p.ws + WS_SK))[g] = w;
    }
    float2* rope = (float2*)(p.ws + WS_ROPE);
    for (size_t e = gt; e < 16384 * 32; e += ngt) {
        const int pos = (int)(e >> 5), i = (int)(e & 31);
        const float inv = (float)exp2(-(double)i * (13.287712379549449 / 32.0));
        const float ang = (float)pos * inv;
        const double a = (double)ang; const double n = rint(a * 0.15915494309189535); const double r = a - n * 6.283185307179586;
        float s, c; sincosf((float)r, &s, &c);
        rope[e] = make_float2(c, s);
    }
}

DEV void stage_norm1(const Params& p, char* lds, int vb, int nvb) {
    const int tid = threadIdx.x, lane = tid & 63, wave = __builtin_amdgcn_readfirstlane(tid >> 6);
    float* wg = (float*)lds;
    for (int i = tid; i < 8192; i += NTH) { const int cc = i >> 10, k = i & 1023; wg[i] = p.w_in[(size_t)k * 4872 + 2816 + cc]; }
    __syncthreads();
    const float* mod = (const float*)(p.ws + WS_MOD);
    bf16_t* ub = (bf16_t*)(p.ws + WS_UB);
    float* ipre = (float*)(p.ws + WS_IPRE); float* fpre = (float*)(p.ws + WS_FPRE);
    const int rstride = nvb * NW;
    for (int mb = vb * NW + wave; mb < M; mb += 2 * rstride) {
        float4 vv[2][4];
#pragma unroll
        for (int rr = 0; rr < 2; ++rr) { const int mr = mb + rr * rstride < M ? mb + rr * rstride : mb; const float4* xr = (const float4*)(p.x + (size_t)mr * D);
#pragma unroll
            for (int j = 0; j < 4; ++j) vv[rr][j] = xr[lane + 64 * j]; }
#pragma unroll
        for (int rr = 0; rr < 2; ++rr) {
        const int m = mb + rr * rstride;
        if (m < M) {
        const int b = m >= SEQ ? 1 : 0;
        float4 v[4]; float ss = 0.f;
#pragma unroll
        for (int j = 0; j < 4; ++j) { v[j] = vv[rr][j]; ss += v[j].x * v[j].x + v[j].y * v[j].y + v[j].z * v[j].z + v[j].w * v[j].w; }
        ss = wave_sum(ss);
        const float rstd = rsqrtf(ss * (1.f / 1024.f) + 1e-6f);
        float ga[8];
#pragma unroll
        for (int cc = 0; cc < 8; ++cc) ga[cc] = 0.f;
#pragma unroll
        for (int j = 0; j < 4; ++j) {
            const int col = 4 * (lane + 64 * j);
            const float4 w1 = *(const float4*)(p.norm1_w + col), sc = *(const float4*)(mod + b * 6144 + 1024 + col), sh = *(const float4*)(mod + b * 6144 + col);
            float4 u;
            u.x = v[j].x * rstd * w1.x * (1.f + sc.x) + sh.x; u.y = v[j].y * rstd * w1.y * (1.f + sc.y) + sh.y;
            u.z = v[j].z * rstd * w1.z * (1.f + sc.z) + sh.z; u.w = v[j].w * rstd * w1.w * (1.f + sc.w) + sh.w;
            u32x2 o; o.x = pk2(u.x, u.y); o.y = pk2(u.z, u.w);
            *(u32x2*)(ub + (size_t)m * D + col) = o;
#pragma unroll
            for (int cc = 0; cc < 8; ++cc) { const float4 g = *(const float4*)(wg + cc * 1024 + col); ga[cc] += u.x * g.x + u.y * g.y + u.z * g.z + u.w * g.w; }
        }
        {
            const bool h32 = (lane & 32) != 0, h16 = (lane & 16) != 0, h8 = (lane & 8) != 0;
            float k4[4], k2[2];
#pragma unroll
            for (int i = 0; i < 4; ++i) k4[i] = (h32 ? ga[4 + i] : ga[i]) + __shfl_xor(h32 ? ga[i] : ga[4 + i], 32);
#pragma unroll
            for (int i = 0; i < 2; ++i) k2[i] = (h16 ? k4[2 + i] : k4[i]) + __shfl_xor(h16 ? k4[i] : k4[2 + i], 16);
            float k1 = (h8 ? k2[1] : k2[0]) + __shfl_xor(h8 ? k2[0] : k2[1], 8);
            k1 += __shfl_xor(k1, 4); k1 += __shfl_xor(k1, 2); k1 += __shfl_xor(k1, 1);
            const int cc = (lane >> 3) & 7;
            if ((lane & 7) == 0) { if (cc < 4) ipre[(size_t)m * 4 + cc] = k1 + p.i_bias[cc]; else fpre[(size_t)m * 4 + cc - 4] = k1 + p.f_bias[cc - 4]; }
        }
        }
        }
    }
}

namespace pg8 {
#define PG8_LAS __attribute__((address_space(3)))
typedef unsigned short bf16_t;
typedef short bf16x8 __attribute__((ext_vector_type(8)));
typedef float f32x4 __attribute__((ext_vector_type(4)));
typedef unsigned u32x4 __attribute__((ext_vector_type(4)));
constexpr int BM = 256, BK = 64, HALF = 128, HTB = HALF * BK * 2  , STAGE_BYTES = 8 * HTB, NXCD = 8, WGM = 8;

__host__ __device__ __forceinline__ int lds_byte(int r, int c) { const int st = (r >> 4) * 2 + (c >> 5), rr = r & 15, cc = c & 31, ob = rr * 64 + cc * 2; return st * 1024 + (ob ^ (((ob >> 9) & 1) << 5)); }
__host__ __device__ __forceinline__ void stage_rc(int b, int& R, int& C) { const int st = b / 1024, sb = b % 1024, swz = sb ^ (((sb >> 9) & 1) << 5); R = (st >> 1) * 16 + swz / 64; C = (st & 1) * 32 + (swz % 64) / 2; }
__host__ __device__ __forceinline__ int perm32(int rho) { const int n = rho >> 4, i = rho & 15; return 8 * (i >> 2) + 4 * n + (i & 3); }

struct Unit { int pm, pn; };
struct Gemm { const bf16_t* A; const bf16_t* Bt; int M, N, K, lda, ldb; };

struct StaticOrder {
    int nM, nN, nwg, G, c;
    __host__ __device__ void init(int M, int N, int G_, int c_) { nM = M / BM; nN = N / BM; nwg = nM * nN; G = G_; c = c_; }
    __host__ __device__ bool next(int i, Unit& u) const {
        const long L = (long)i * G + c; if (L >= nwg) return false;
        int wgid = (int)L; { const int q = nwg / NXCD, r = nwg % NXCD, xcd = wgid % NXCD, off = wgid / NXCD; wgid = (xcd < r ? xcd * (q + 1) : r * (q + 1) + (xcd - r) * q) + off; }
        const int nig = WGM * nN, gid = wgid / nig, fm = gid * WGM, gsz = (nM - fm) < WGM ? (nM - fm) : WGM;
        u.pm = fm + ((wgid % nig) % gsz); u.pn = (wgid % nig) / gsz; return true;
    }
    __device__ __forceinline__ void a_ready(const Unit&) const {}
    __device__ __forceinline__ void done(const Unit&) const {}
};

__device__ __forceinline__ unsigned cvt_pk_bf16(float lo, float hi) { unsigned r; asm volatile("v_cvt_pk_bf16_f32 %0, %1, %2" : "=v"(r) : "v"(lo), "v"(hi)); return r; }
__device__ __forceinline__ float sg_(float v) { return 1.f / (1.f + __expf(-v)); }
struct EpiIn {
    static constexpr bool PERM = true, AFTER_DRAIN = false;
    bf16_t *PA, *PM, *PG;
    __device__ __forceinline__ void operator()(const f32x4 (&acc)[2][2][4][2], const Unit& u, int wr, int wc, int fr, int fq) const {
        const int colt = u.pn * BM; bf16_t* base; int ldc, cb;
        if (colt < 768) { base = PA; ldc = 768; cb = colt; } else if (colt < 2816) { base = PM; ldc = 2048; cb = colt - 768; } else { base = PG; ldc = 2048; cb = colt - 2816; }
        const int row0 = u.pm * BM + wr * 64 + fr, col0 = cb + wc * 32 + 8 * fq;
#pragma unroll
        for (int ai = 0; ai < 2; ++ai)
#pragma unroll
            for (int m = 0; m < 4; ++m) { bf16_t* rowp = base + (size_t)(row0 + ai * HALF + m * 16) * ldc + col0;
#pragma unroll
                for (int bj = 0; bj < 2; ++bj) { const f32x4 v0 = acc[ai][bj][m][0], v1 = acc[ai][bj][m][1];
                    u32x4 w; w.x = cvt_pk_bf16(v0[0], v0[1]); w.y = cvt_pk_bf16(v0[2], v0[3]); w.z = cvt_pk_bf16(v1[0], v1[1]); w.w = cvt_pk_bf16(v1[2], v1[3]);
                    *(u32x4*)(rowp + bj * HALF) = w; } }
    }
};
struct EpiMerge {
    static constexpr bool PERM = true, AFTER_DRAIN = false;
    const bf16_t* G; bf16_t* MG; int second;
    __device__ __forceinline__ void operator()(const f32x4 (&acc)[2][2][4][2], const Unit& u, int wr, int wc, int fr, int fq) const {
        const int row0 = u.pm * BM + wr * 64 + fr, col0 = u.pn * BM + wc * 32 + 8 * fq;
#pragma unroll
        for (int ai = 0; ai < 2; ++ai)
#pragma unroll
            for (int m = 0; m < 4; ++m) { const size_t row = (size_t)(row0 + ai * HALF + m * 16);
#pragma unroll
                for (int bj = 0; bj < 2; ++bj) { const f32x4 v0 = acc[ai][bj][m][0], v1 = acc[ai][bj][m][1]; const int col = col0 + bj * HALF;
                    const u32x4 gv = *(const u32x4*)(G + row * 2048 + col);
                    float r[8];
                    r[0] = sg_(__uint_as_float(gv.x << 16)) * v0[0]; r[1] = sg_(__uint_as_float(gv.x & 0xffff0000u)) * v0[1];
                    r[2] = sg_(__uint_as_float(gv.y << 16)) * v0[2]; r[3] = sg_(__uint_as_float(gv.y & 0xffff0000u)) * v0[3];
                    r[4] = sg_(__uint_as_float(gv.z << 16)) * v1[0]; r[5] = sg_(__uint_as_float(gv.z & 0xffff0000u)) * v1[1];
                    r[6] = sg_(__uint_as_float(gv.w << 16)) * v1[2]; r[7] = sg_(__uint_as_float(gv.w & 0xffff0000u)) * v1[3];
                    u32x4* dst = (u32x4*)(MG + row * 1024 + col);
                    if (second) { const u32x4 t = *dst;
                        r[0] += __uint_as_float(t.x << 16); r[1] += __uint_as_float(t.x & 0xffff0000u); r[2] += __uint_as_float(t.y << 16); r[3] += __uint_as_float(t.y & 0xffff0000u);
                        r[4] += __uint_as_float(t.z << 16); r[5] += __uint_as_float(t.z & 0xffff0000u); r[6] += __uint_as_float(t.w << 16); r[7] += __uint_as_float(t.w & 0xffff0000u); }
                    u32x4 w; w.x = cvt_pk_bf16(r[0], r[1]); w.y = cvt_pk_bf16(r[2], r[3]); w.z = cvt_pk_bf16(r[4], r[5]); w.w = cvt_pk_bf16(r[6], r[7]);
                    *dst = w; } }
    }
};
struct EpiF32 {
    static constexpr bool PERM = true, AFTER_DRAIN = false;
    float* O; int ldc;
    __device__ __forceinline__ void operator()(const f32x4 (&acc)[2][2][4][2], const Unit& u, int wr, int wc, int fr, int fq) const {
        const int row0 = u.pm * BM + wr * 64 + fr, col0 = u.pn * BM + wc * 32 + 8 * fq;
#pragma unroll
        for (int ai = 0; ai < 2; ++ai)
#pragma unroll
            for (int m = 0; m < 4; ++m) { float* rowp = O + (size_t)(row0 + ai * HALF + m * 16) * ldc + col0;
#pragma unroll
                for (int bj = 0; bj < 2; ++bj) { *(f32x4*)(rowp + bj * HALF) = acc[ai][bj][m][0]; *(f32x4*)(rowp + bj * HALF + 4) = acc[ai][bj][m][1]; } }
    }
};
struct EpiOut {
    static constexpr bool PERM = true, AFTER_DRAIN = false;
    const float* x; const float* g1; float* out; int seq;
    __device__ __forceinline__ void operator()(const f32x4 (&acc)[2][2][4][2], const Unit& u, int wr, int wc, int fr, int fq) const {
        const int row0 = u.pm * BM + wr * 64 + fr, col0 = u.pn * BM + wc * 32 + 8 * fq;
        const float* gp = g1 + (u.pm * BM >= seq ? 6144 : 0);
#pragma unroll
        for (int bj = 0; bj < 2; ++bj) { const int col = col0 + bj * HALF; const f32x4 ga = *(const f32x4*)(gp + col), gb = *(const f32x4*)(gp + col + 4);
#pragma unroll
            for (int ai = 0; ai < 2; ++ai)
#pragma unroll
                for (int m = 0; m < 4; ++m) { const size_t off = (size_t)(row0 + ai * HALF + m * 16) * 1024 + col;
                    const f32x4 xa = *(const f32x4*)(x + off), xb = *(const f32x4*)(x + off + 4);
                    *(f32x4*)(out + off) = xa + ga * acc[ai][bj][m][0]; *(f32x4*)(out + off + 4) = xb + gb * acc[ai][bj][m][1]; } }
    }
};

template <class Epi, class Sched, bool ALIGN_EPI = false, bool SP2 = false>
__device__ __forceinline__ void gemm_phase(PG8_LAS unsigned char* lds, const Gemm g, const Sched& S, const Epi& E) {
    const int tid = threadIdx.x, wid = __builtin_amdgcn_readfirstlane(tid >> 6), lane = tid & 63, wr = wid >> 2, wc = wid & 3, fr = lane & 15, fq = lane >> 4;
    const int K = g.K, nt = K / BK;
    unsigned voffA[2], voffB[2];
#pragma unroll
    for (int i = 0; i < 2; ++i) { int R, C; stage_rc(tid * 16 + i * 8192, R, C); const int Rb = Epi::PERM ? ((R & ~31) + perm32(R & 31)) : R;
        voffA[i] = (unsigned)(R * g.lda + C) * 2u; voffB[i] = (unsigned)(Rb * g.ldb + C) * 2u; }
    const size_t kstep = (size_t)(BK * 2);
    const size_t hstepA = (size_t)HALF * g.lda * 2, hstepB = (size_t)HALF * g.ldb * 2;
    const size_t tstepA = 2 * hstepA, tstepB = 2 * hstepB;
    const unsigned ldsw = (unsigned)wid * 1024u;
    const int aoff = lds_byte(wr * 64 + fr, fq * 8), boff = lds_byte(wc * 32 + fr, fq * 8);
#define PG8_SA(b, h) (((b) * 2 + (h)) * HTB)
#define PG8_SB(b, h) ((4 + (b) * 2 + (h)) * HTB)
#define PG8_STAGE(bufoff, gbase, voff) do { _Pragma("unroll") for (int _i = 0; _i < 2; ++_i) \
        __builtin_amdgcn_global_load_lds((const unsigned*)((const char*)(gbase) + (voff)[_i]), (PG8_LAS unsigned*)(lds + (bufoff) + ldsw + _i * 8192), 16, 0, 0); } while (0)
#define PG8_LDA(dst, b, h) do { _Pragma("unroll") for (int m = 0; m < 4; ++m) _Pragma("unroll") for (int k = 0; k < 2; ++k) dst[m][k] = *(const PG8_LAS bf16x8*)(lds + PG8_SA(b, h) + aoff + m * 2048 + k * 1024); } while (0)
#define PG8_LDB(dst, b, h) do { _Pragma("unroll") for (int n = 0; n < 2; ++n) _Pragma("unroll") for (int k = 0; k < 2; ++k) dst[n][k] = *(const PG8_LAS bf16x8*)(lds + PG8_SB(b, h) + boff + n * 2048 + k * 1024); } while (0)
#define PG8_MMA(ai, bj, At, Bt) do { __builtin_amdgcn_s_setprio(1); _Pragma("unroll") for (int m = 0; m < 4; ++m) _Pragma("unroll") for (int n = 0; n < 2; ++n) _Pragma("unroll") for (int k = 0; k < 2; ++k) \
        acc[ai][bj][m][n] = __builtin_amdgcn_mfma_f32_16x16x32_bf16(Bt[n][k], At[m][k], acc[ai][bj][m][n], 0, 0, 0); __builtin_amdgcn_s_setprio(0); } while (0)
#define PG8_WAIT_V(n) asm volatile("s_waitcnt vmcnt(" #n ")" ::: "memory")
#define PG8_WAIT_L(n) asm volatile("s_waitcnt lgkmcnt(" #n ")" ::: "memory")
#define PG8_BAR __builtin_amdgcn_s_barrier()
#define PG8_SCHED __builtin_amdgcn_sched_barrier(0)
    Unit cur, nxt; int ui = 0;
    if (!S.next(0, cur)) return;
    f32x4 acc[2][2][4][2];
#pragma unroll
    for (int a = 0; a < 2; ++a)
#pragma unroll
        for (int b = 0; b < 2; ++b)
#pragma unroll
            for (int m = 0; m < 4; ++m)
#pragma unroll
                for (int n = 0; n < 2; ++n) acc[a][b][m][n] = (f32x4){0.f, 0.f, 0.f, 0.f};
    bf16x8 At[4][2], B0[2][2], B1[2][2];
    const char* cA = (const char*)g.A + (size_t)cur.pm * tstepA; const char* cB = (const char*)g.Bt + (size_t)cur.pn * tstepB;
    S.a_ready(cur);
    if constexpr (SP2) {
        PG8_STAGE(PG8_SB(0, 0), cB, voffB); PG8_STAGE(PG8_SB(0, 1), cB + hstepB, voffB); PG8_STAGE(PG8_SA(0, 0), cA, voffA); PG8_STAGE(PG8_SA(0, 1), cA + hstepA, voffA);
        if (wr == 1) PG8_BAR;
        PG8_WAIT_V(2); PG8_BAR;
        PG8_STAGE(PG8_SB(1, 0), cB + kstep, voffB); PG8_STAGE(PG8_SA(1, 0), cA + kstep, voffA); PG8_STAGE(PG8_SB(1, 1), cB + hstepB + kstep, voffB);
        PG8_WAIT_V(6); PG8_BAR;
    } else {
        PG8_STAGE(PG8_SB(0, 0), cB, voffB); PG8_STAGE(PG8_SA(0, 0), cA, voffA); PG8_STAGE(PG8_SB(0, 1), cB + hstepB, voffB); PG8_STAGE(PG8_SA(0, 1), cA + hstepA, voffA);
        if (wr == 1) PG8_BAR;
        PG8_WAIT_V(4); PG8_BAR;
        PG8_STAGE(PG8_SB(1, 0), cB + kstep, voffB); PG8_STAGE(PG8_SA(1, 0), cA + kstep, voffA); PG8_STAGE(PG8_SB(1, 1), cB + hstepB + kstep, voffB);
        PG8_WAIT_V(6); PG8_BAR;
    }
    for (;;) {
        const bool has_next = S.next(ui + 1, nxt);
        const char* nA = has_next ? (const char*)g.A + (size_t)nxt.pm * tstepA : cA; const char* nB = has_next ? (const char*)g.Bt + (size_t)nxt.pn * tstepB : cB;
        for (int t = 0; t < nt; t += 2) {
            const bool last = (t == nt - 2);
            const char* a1 = cA + (size_t)(t + 1) * kstep;
            const char* a2 = last ? nA : cA + (size_t)(t + 2) * kstep; const char* b2 = last ? nB : cB + (size_t)(t + 2) * kstep;
            const char* a3 = a2 + kstep; const char* b3 = b2 + kstep;
            if (last && has_next) S.a_ready(nxt);
            if constexpr (SP2) {
            PG8_LDB(B0, 0, 0); PG8_LDB(B1, 0, 1); PG8_SCHED; PG8_LDA(At, 0, 0); PG8_STAGE(PG8_SA(1, 1), a1 + hstepA, voffA);
            PG8_WAIT_V(8); PG8_WAIT_L(0); PG8_BAR; PG8_MMA(0, 0, At, B0); PG8_MMA(0, 1, At, B1); PG8_BAR; PG8_SCHED;
            PG8_LDA(At, 0, 1); PG8_STAGE(PG8_SB(0, 0), b2, voffB); PG8_STAGE(PG8_SB(0, 1), b2 + hstepB, voffB); PG8_STAGE(PG8_SA(0, 0), a2, voffA);
            PG8_WAIT_V(8); PG8_WAIT_L(0); PG8_BAR; PG8_MMA(1, 0, At, B0); PG8_MMA(1, 1, At, B1); PG8_BAR; PG8_SCHED;
            PG8_LDB(B0, 1, 0); PG8_LDB(B1, 1, 1); PG8_SCHED; PG8_LDA(At, 1, 0); PG8_STAGE(PG8_SA(0, 1), a2 + hstepA, voffA);
            PG8_WAIT_V(8); PG8_WAIT_L(0); PG8_BAR; PG8_MMA(0, 0, At, B0); PG8_MMA(0, 1, At, B1); PG8_BAR; PG8_SCHED;
            PG8_LDA(At, 1, 1); PG8_STAGE(PG8_SB(1, 0), b3, voffB); PG8_STAGE(PG8_SB(1, 1), b3 + hstepB, voffB); PG8_STAGE(PG8_SA(1, 0), a3, voffA);
            PG8_WAIT_V(8); PG8_WAIT_L(0); PG8_BAR; PG8_MMA(1, 0, At, B0); PG8_MMA(1, 1, At, B1); PG8_BAR; PG8_SCHED;
            } else {
            PG8_LDB(B0, 0, 0); PG8_SCHED; PG8_LDA(At, 0, 0); PG8_STAGE(PG8_SA(1, 1), a1 + hstepA, voffA);
            PG8_WAIT_L(8); PG8_BAR; PG8_WAIT_L(0); PG8_MMA(0, 0, At, B0); PG8_BAR; PG8_SCHED;
            PG8_LDB(B1, 0, 1); PG8_STAGE(PG8_SB(0, 0), b2, voffB);
            PG8_BAR; PG8_WAIT_L(0); PG8_MMA(0, 1, At, B1); PG8_BAR;
            PG8_LDA(At, 0, 1); PG8_STAGE(PG8_SA(0, 0), a2, voffA);
            PG8_BAR; PG8_WAIT_L(0); PG8_MMA(1, 0, At, B0); PG8_BAR; PG8_SCHED;
            PG8_STAGE(PG8_SB(0, 1), b2 + hstepB, voffB);
            PG8_WAIT_V(6); PG8_BAR; PG8_MMA(1, 1, At, B1); PG8_BAR;
            PG8_LDB(B0, 1, 0); PG8_SCHED; PG8_LDA(At, 1, 0); PG8_STAGE(PG8_SA(0, 1), a2 + hstepA, voffA);
            PG8_WAIT_L(8); PG8_BAR; PG8_WAIT_L(0); PG8_MMA(0, 0, At, B0); PG8_BAR; PG8_SCHED;
            PG8_LDB(B1, 1, 1); PG8_STAGE(PG8_SB(1, 0), b3, voffB);
            PG8_BAR; PG8_WAIT_L(0); PG8_MMA(0, 1, At, B1); PG8_BAR;
            PG8_LDA(At, 1, 1); PG8_STAGE(PG8_SA(1, 0), a3, voffA);
            PG8_BAR; PG8_WAIT_L(0); PG8_MMA(1, 0, At, B0); PG8_BAR; PG8_SCHED;
            PG8_STAGE(PG8_SB(1, 1), b3 + hstepB, voffB);
            PG8_WAIT_V(6); PG8_BAR; PG8_MMA(1, 1, At, B1); PG8_BAR;
            }
        }
        if constexpr (ALIGN_EPI) { if (wr == 0) PG8_BAR; }
        if constexpr (!Epi::AFTER_DRAIN) { E(acc, cur, wr, wc, fr, fq); S.done(cur); }
        if (!has_next) break;
#pragma unroll
        for (int a = 0; a < 2; ++a)
#pragma unroll
            for (int b = 0; b < 2; ++b)
#pragma unroll
                for (int m = 0; m < 4; ++m)
#pragma unroll
                    for (int n = 0; n < 2; ++n) acc[a][b][m][n] = (f32x4){0.f, 0.f, 0.f, 0.f};
        cur = nxt; cA = nA; cB = nB; ++ui;
        if constexpr (ALIGN_EPI) { if (wr == 1) PG8_BAR; }
    }
    PG8_WAIT_V(0);
    if constexpr (!ALIGN_EPI) { if (wr == 0) PG8_BAR; }
    PG8_BAR;
    if constexpr (Epi::AFTER_DRAIN) { E.fused(acc, cur, wr, wc, fr, fq, lds, wid, lane); S.done(cur); }
#undef PG8_SA
#undef PG8_SB
#undef PG8_STAGE
#undef PG8_LDA
#undef PG8_LDB
#undef PG8_MMA
#undef PG8_WAIT_V
#undef PG8_WAIT_L
#undef PG8_BAR
#undef PG8_SCHED
}
}

struct GemmOp { const bf16_t* A; int lda; const bf16_t* Bt; int ldb; int K; };

DEV void gemm_tile(f32x4 (&acc)[4][2], const GemmOp& g, int m0, int n0, char* lds) {
    const int tid = threadIdx.x, lane = tid & 63, wid = __builtin_amdgcn_readfirstlane(tid >> 6), wm = wid >> 2, wn = wid & 3, fr = lane & 15, fq = lane >> 4;
    const int sr = tid >> 3, sc = tid & 7;
    const bf16_t* ga = g.A + (size_t)(m0 + sr) * g.lda + sc * 8;
    const bf16_t* gb = g.Bt + (size_t)(n0 + sr) * g.ldb + sc * 8;
    const size_t a64 = (size_t)64 * g.lda, b64 = (size_t)64 * g.ldb;
    const int so = sr * 128 + ((sc ^ (sr & 7)) << 4);
    const int nk = g.K >> 6;
    u32x4 ra0 = *(const u32x4*)ga, ra1 = *(const u32x4*)(ga + a64), rb0 = *(const u32x4*)gb, rb1 = *(const u32x4*)(gb + b64);
    *(u32x4*)(lds + so) = ra0; *(u32x4*)(lds + so + 8192) = ra1; *(u32x4*)(lds + 32768 + so) = rb0; *(u32x4*)(lds + 32768 + so + 8192) = rb1;
    __syncthreads();
    const int aoff = (wm * 64 + fr) * 128, boff = 32768 + (wn * 32 + fr) * 128, sw = fr & 7;
    for (int kt = 0; kt < nk; ++kt) {
        const int cur = (kt & 1) * 16384;
        if (kt + 1 < nk) { ga += 64; gb += 64; ra0 = *(const u32x4*)ga; ra1 = *(const u32x4*)(ga + a64); rb0 = *(const u32x4*)gb; rb1 = *(const u32x4*)(gb + b64); }
#pragma unroll
        for (int ks = 0; ks < 2; ++ks) {
            const int ch = ((fq + 4 * ks) ^ sw) << 4;
            bf16x8 af[4], bfr[2];
#pragma unroll
            for (int mi = 0; mi < 4; ++mi) af[mi] = *(const bf16x8*)(lds + cur + aoff + mi * 2048 + ch);
#pragma unroll
            for (int ni = 0; ni < 2; ++ni) bfr[ni] = *(const bf16x8*)(lds + cur + boff + ni * 2048 + ch);
#pragma unroll
            for (int mi = 0; mi < 4; ++mi)
#pragma unroll
                for (int ni = 0; ni < 2; ++ni) acc[mi][ni] = mfma16(bfr[ni], af[mi], acc[mi][ni]);
        }
        if (kt + 1 < nk) {
            const int nxt = cur ^ 16384;
            *(u32x4*)(lds + nxt + so) = ra0; *(u32x4*)(lds + nxt + so + 8192) = ra1; *(u32x4*)(lds + 32768 + nxt + so) = rb0; *(u32x4*)(lds + 32768 + nxt + so + 8192) = rb1;
        }
        __syncthreads();
    }
}
#define GEMM_EPI_LOOP(...) { const int tid_ = threadIdx.x, lane_ = tid_ & 63, wid_ = tid_ >> 6, wm_ = wid_ >> 2, wn_ = wid_ & 3, fr_ = lane_ & 15, fq_ = lane_ >> 4; \
    _Pragma("unroll") for (int mi = 0; mi < 4; ++mi) _Pragma("unroll") for (int ni = 0; ni < 2; ++ni) { const int m = m0 + wm_ * 64 + mi * 16 + fr_, n = n0 + wn_ * 32 + ni * 16 + fq_ * 4; __VA_ARGS__ } }

DEV void stage_gemm_in(const Params& p, char* lds, int vb, int nvb) {
    pg8::Gemm g{(const bf16_t*)(p.ws + WS_UB), (const bf16_t*)(p.ws + WS_WIN), M, 4864, 1024, 1024, 1024};
    pg8::StaticOrder S; S.init(M, 4864, nvb, vb);
    pg8::EpiIn E{(bf16_t*)(p.ws + WS_PA), (bf16_t*)(p.ws + WS_PM), (bf16_t*)(p.ws + WS_PG)};
    pg8::gemm_phase<pg8::EpiIn, pg8::StaticOrder, true, true>((PG8_LAS unsigned char*)lds, g, S, E);
}
DEV void stage_gemm_merge(const Params& p, char* lds, int vb, int nvb) {
    const bf16_t* PG = (const bf16_t*)(p.ws + WS_PG); bf16_t* MG = (bf16_t*)(p.ws + WS_UB);
    {
        pg8::Gemm g{(const bf16_t*)(p.ws + WS_PA), (const bf16_t*)(p.ws + WS_WA), M, 1024, 512, LPA, 512};
        pg8::StaticOrder S; S.init(M, 1024, nvb, vb);
        pg8::EpiMerge E{PG, MG, 0};
        pg8::gemm_phase<pg8::EpiMerge, pg8::StaticOrder, true, true>((PG8_LAS unsigned char*)lds, g, S, E);
    }
    {
        pg8::Gemm g{(const bf16_t*)(p.ws + WS_PM) + 1536, (const bf16_t*)(p.ws + WS_WB), M, 1024, 512, LPM, 512};
        pg8::StaticOrder S; S.init(M, 1024, nvb, vb);
        pg8::EpiMerge E{PG + 1024, MG, 1};
        pg8::gemm_phase<pg8::EpiMerge, pg8::StaticOrder, true, true>((PG8_LAS unsigned char*)lds, g, S, E);
    }
}
DEV void stage_gemm_out(const Params& p, char* lds, int vb, int nvb) {
    pg8::Gemm g{(const bf16_t*)(p.ws + WS_UB), (const bf16_t*)(p.ws + WS_WOUT), M, 1024, 1024, 1024, 1024};
    pg8::StaticOrder S; S.init(M, 1024, nvb, vb);
    pg8::EpiOut E{p.x, (const float*)(p.ws + WS_MOD) + 2048, p.out, SEQ};
    pg8::gemm_phase<pg8::EpiOut, pg8::StaticOrder, true, true>((PG8_LAS unsigned char*)lds, g, S, E);
}

DEV void rope8(u32x4 x1, u32x4 x2, const float4* rp, float scale, u32x4& o1, u32x4& o2) {
#pragma unroll
    for (int w = 0; w < 4; ++w) {
        const float4 cs = rp[w];
        const float a0 = bflo(x1[w]), a1 = bfhi(x1[w]), b0 = bflo(x2[w]), b1 = bfhi(x2[w]);
        o1[w] = pk2((a0 * cs.x - b0 * cs.y) * scale, (a1 * cs.z - b1 * cs.w) * scale);
        o2[w] = pk2((b0 * cs.x + a0 * cs.y) * scale, (b1 * cs.z + a1 * cs.w) * scale);
    }
}

DEV void stage_attn(const Params& p, char* lds, int vb, int nvb) {
    const int tid = threadIdx.x, lane = tid & 63, wave = __builtin_amdgcn_readfirstlane(tid >> 6), fr = lane & 15, fq = lane >> 4;
    char* Ks = lds;
    char* VT = lds + 32768;
    char* Qs = lds + 70656;
    char* Ps = lds + 87040;
    bf16_t* PA = (bf16_t*)(p.ws + WS_PA);
    const float2* rope = (const float2*)(p.ws + WS_ROPE);
    for (int unit = vb; unit < 512; unit += nvb) {
        const int kvh = unit & 1, n = (unit >> 1) & 127, b = unit >> 8;
        __syncthreads();
        for (int task = tid; task < 1024; task += NTH) {
            const int ki = task >> 2, cp = task & 3, pos = 128 * (n - 1) + ki;
            u32x4 o1, o2;
            {
                const int pc = pos < 0 ? 0 : pos;
                const bf16_t* src = PA + (size_t)(b * SEQ + pc) * LPA + 512 + kvh * 64 + cp * 8;
                const u32x4 x1 = *(const u32x4*)src, x2 = *(const u32x4*)(src + 32);
                rope8(x1, x2, (const float4*)(rope + (size_t)pc * 32 + cp * 8), 1.0f, o1, o2);
                if (pos < 0) { o1 = (u32x4){0u, 0u, 0u, 0u}; o2 = o1; }
            }
            const int sw = ki & 7;
            *(u32x4*)(Ks + ki * 128 + ((cp ^ sw) << 4)) = o1;
            *(u32x4*)(Ks + ki * 128 + (((cp + 4) ^ sw) << 4)) = o2;
        }
        for (int task = tid; task < 2048; task += NTH) {
            const int ki = task >> 3, c = task & 7, pos = 128 * (n - 1) + ki;
            u32x4 x = *(const u32x4*)(PA + (size_t)(b * SEQ + (pos < 0 ? 0 : pos)) * LPA + 640 + kvh * 64 + c * 8);
            if (pos < 0) x = (u32x4){0u, 0u, 0u, 0u};
#pragma unroll
            for (int e = 0; e < 8; ++e) *(bf16_t*)(VT + (c * 8 + e) * 592 + ki * 2) = (bf16_t)((e & 1) ? (x[e >> 1] >> 16) : (x[e >> 1] & 0xffffu));
        }
        for (int i = tid; i < 64 * 40; i += NTH) { const int d = i / 40, kk = 256 + i % 40; *(bf16_t*)(VT + d * 592 + kk * 2) = 0; }
        for (int i = tid; i < 2048; i += NTH) { const int w = i >> 8, r = (i >> 4) & 15, kk = 144 + (i & 15); *(bf16_t*)(Ps + w * 5376 + r * 336 + kk * 2) = 0; }
        for (int j = 0; j < 4; ++j) {
            const int hq = kvh * 4 + j;
            {
                const int qi = tid >> 2, cp = tid & 3, pos = 128 * n + qi;
                const bf16_t* src = PA + (size_t)(b * SEQ + pos) * LPA + hq * 64 + cp * 8;
                const u32x4 x1 = *(const u32x4*)src, x2 = *(const u32x4*)(src + 32);
                u32x4 o1, o2;
                rope8(x1, x2, (const float4*)(rope + (size_t)pos * 32 + cp * 8), 0.125f, o1, o2);
                const int sw = qi & 7;
                *(u32x4*)(Qs + qi * 128 + ((cp ^ sw) << 4)) = o1;
                *(u32x4*)(Qs + qi * 128 + (((cp + 4) ^ sw) << 4)) = o2;
            }
            __syncthreads();
            f32x4 s[9];
            const int sw = fr & 7;
            bf16x8 qf[2];
#pragma unroll
            for (int ks = 0; ks < 2; ++ks) qf[ks] = *(const bf16x8*)(Qs + (16 * wave + fr) * 128 + (((fq + 4 * ks) ^ sw) << 4));
#pragma unroll
            for (int t = 0; t < 9; ++t) {
                s[t] = (f32x4){0.f, 0.f, 0.f, 0.f};
#pragma unroll
                for (int ks = 0; ks < 2; ++ks) { const bf16x8 kf = *(const bf16x8*)(Ks + (16 * (wave + t) + fr) * 128 + (((fq + 4 * ks) ^ sw) << 4)); s[t] = mfma16(kf, qf[ks], s[t]); }
            }
            const float sink = p.sinks[hq];
            float mx = sink;
#pragma unroll
            for (int t = 0; t < 9; ++t)
#pragma unroll
                for (int r = 0; r < 4; ++r) {
                    const int dd = 16 * t + 4 * fq + r - fr, ki = 16 * (wave + t) + 4 * fq + r;
                    const bool ok = (dd >= 1) && (dd <= 128) && (n > 0 || ki >= 128);
                    const float v = ok ? s[t][r] : -INFINITY;
                    s[t][r] = v; mx = fmaxf(mx, v);
                }
            mx = fmaxf(mx, __shfl_xor(mx, 16)); mx = fmaxf(mx, __shfl_xor(mx, 32));
            float sum = 0.f;
#pragma unroll
            for (int t = 0; t < 9; ++t)
#pragma unroll
                for (int r = 0; r < 4; ++r) { const float pv = __expf(s[t][r] - mx); s[t][r] = pv; sum += pv; }
            sum += __shfl_xor(sum, 16); sum += __shfl_xor(sum, 32);
            const float inv = 1.f / (sum + __expf(sink - mx));
            char* Pw = Ps + wave * 5376 + fr * 336;
#pragma unroll
            for (int t = 0; t < 9; ++t) { u32x2 o; o.x = pk2(s[t][0], s[t][1]); o.y = pk2(s[t][2], s[t][3]); *(u32x2*)(Pw + (16 * t + 4 * fq) * 2) = o; }
            __syncthreads();
            f32x4 o[4];
#pragma unroll
            for (int di = 0; di < 4; ++di) o[di] = (f32x4){0.f, 0.f, 0.f, 0.f};
#pragma unroll
            for (int ks = 0; ks < 5; ++ks) {
                const bf16x8 pf = *(const bf16x8*)(Pw + (32 * ks + 8 * fq) * 2);
#pragma unroll
                for (int di = 0; di < 4; ++di) { const bf16x8 vf = *(const bf16x8*)(VT + (16 * di + fr) * 592 + (16 * wave + 32 * ks + 8 * fq) * 2); o[di] = mfma16(vf, pf, o[di]); }
            }
            bf16_t* dst = PA + (size_t)(b * SEQ + 128 * n + 16 * wave + fr) * LPA + hq * 64 + 4 * fq;
#pragma unroll
            for (int di = 0; di < 4; ++di) { u32x2 w; w.x = pk2(o[di][0] * inv, o[di][1] * inv); w.y = pk2(o[di][2] * inv, o[di][3] * inv); *(u32x2*)(dst + 16 * di) = w; }
            __syncthreads();
        }
    }
}

DEV float logsigf(float x) { return fminf(x, 0.f) - log1pf(expf(-fabsf(x))); }

DEV void chunk_gates(const float* ipre, const float* fpre, int rowbase, int h, float* gs, int lane) {
    const int l0 = 2 * lane;
    const float i0 = ipre[(size_t)(rowbase + l0) * 4 + h], i1 = ipre[(size_t)(rowbase + l0 + 1) * 4 + h];
    const float lf0 = logsigf(fpre[(size_t)(rowbase + l0) * 4 + h]), lf1 = logsigf(fpre[(size_t)(rowbase + l0 + 1) * 4 + h]);
    const float pair = lf0 + lf1;
    float sc = pair;
#pragma unroll
    for (int o = 1; o < 64; o <<= 1) { const float t = __shfl_up(sc, o); if (lane >= o) sc += t; }
    const float b0 = (sc - pair) + lf0, b1 = b0 + lf1;
    const float g = __shfl(sc, 63);
    const float a0 = g - b0 + i0, a1 = g - b1 + i1;
    const float mloc = wave_max(fmaxf(a0, a1));
    const float ib0 = i0 - b0, ib1 = i1 - b1;
    float scm = fmaxf(ib0, ib1);
#pragma unroll
    for (int o = 1; o < 64; o <<= 1) { const float t = __shfl_up(scm, o); if (lane >= o) scm = fmaxf(scm, t); }
    float ex = __shfl_up(scm, 1); if (lane == 0) ex = -INFINITY;
    const float pm0 = fmaxf(ex, ib0), pm1 = fmaxf(pm0, ib1);
    gs[l0] = b0; gs[l0 + 1] = b1; gs[128 + l0] = ib0; gs[128 + l0 + 1] = ib1; gs[256 + l0] = a0; gs[256 + l0 + 1] = a1; gs[384 + l0] = pm0; gs[384 + l0 + 1] = pm1;
    if (lane == 0) { gs[512] = g; gs[513] = mloc; }
}

DEV void conv8(const bf16_t* PM, const float* cw, int b, int t, int pmcol, int cch, float (&out)[8]) {
#pragma unroll
    for (int e = 0; e < 8; ++e) out[e] = 0.f;
#pragma unroll
    for (int j = 0; j < 4; ++j) {
        const int tt = t - 3 + j; const int tc = tt < 0 ? 0 : tt; const float z = tt < 0 ? 0.f : 1.f;
        const u32x4 x = *(const u32x4*)(PM + (size_t)(b * SEQ + tc) * LPM + pmcol);
        float4 w0 = *(const float4*)(cw + j * 1024 + cch), w1 = *(const float4*)(cw + j * 1024 + cch + 4);
        w0.x *= z; w0.y *= z; w0.z *= z; w0.w *= z; w1.x *= z; w1.y *= z; w1.z *= z; w1.w *= z;
        out[0] += bflo(x[0]) * w0.x; out[1] += bfhi(x[0]) * w0.y; out[2] += bflo(x[1]) * w0.z; out[3] += bfhi(x[1]) * w0.w;
        out[4] += bflo(x[2]) * w1.x; out[5] += bfhi(x[2]) * w1.y; out[6] += bflo(x[3]) * w1.z; out[7] += bfhi(x[3]) * w1.w;
    }
}
DEV float siluf_(float y) { return y / (1.f + __expf(-y)); }

DEV void stage_mstate(const Params& p, char* lds, int vb, int nvb) {
    const int tid = threadIdx.x, lane = tid & 63, wave = __builtin_amdgcn_readfirstlane(tid >> 6), fr = lane & 15, fq = lane >> 4;
    char* KT = lds;
    char* VT = lds + 34816;
    float* gs = (float*)(lds + 69632);
    const bf16_t* PM = (const bf16_t*)(p.ws + WS_PM);
    const float* ipre = (const float*)(p.ws + WS_IPRE); const float* fpre = (const float*)(p.ws + WS_FPRE);
    float* UT = (float*)(p.ws + WS_UB); float* NLOC = (float*)(p.ws + WS_NLOC);
    float* G = (float*)(p.ws + WS_CHG); float* MLOC = G + 1024;
    for (int unit = vb; unit < 1024; unit += nvb) {
        const int c = unit & 127, h = (unit >> 7) & 3, b = unit >> 9;
        const int rowbase = b * SEQ + c * 128;
        __syncthreads();
        if (wave == 0) chunk_gates(ipre, fpre, rowbase, h, gs, lane);
        __syncthreads();
        const float mloc = gs[513];
        for (int task = tid; task < 2048; task += NTH) {
            const int l = task >> 4, ch = task & 15;
            float v8[8]; conv8(PM, p.conv_w, b, c * 128 + l, 512 + h * 128 + ch * 8, 512 + h * 128 + ch * 8, v8);
            const float wgt = __expf(gs[256 + l] - mloc) * 0.08838834764831845f;
#pragma unroll
            for (int e = 0; e < 8; ++e) *(bf16_t*)(KT + (ch * 8 + e) * 272 + l * 2) = (bf16_t)f2bf(siluf_(v8[e]) * wgt);
        }
        for (int task = tid; task < 2048; task += NTH) {
            const int l = task >> 4, ch = task & 15;
            const u32x4 x = *(const u32x4*)(PM + (size_t)(rowbase + l) * LPM + 1024 + h * 128 + ch * 8);
#pragma unroll
            for (int e = 0; e < 8; ++e) *(bf16_t*)(VT + (ch * 8 + e) * 272 + l * 2) = (bf16_t)((e & 1) ? (x[e >> 1] >> 16) : (x[e >> 1] & 0xffffu));
        }
        __syncthreads();
        f32x4 acc[8];
#pragma unroll
        for (int t = 0; t < 8; ++t) acc[t] = (f32x4){0.f, 0.f, 0.f, 0.f};
#pragma unroll
        for (int ks = 0; ks < 4; ++ks) {
            const bf16x8 vf = *(const bf16x8*)(VT + (16 * wave + fr) * 272 + (32 * ks + 8 * fq) * 2);
#pragma unroll
            for (int t = 0; t < 8; ++t) { const bf16x8 kf = *(const bf16x8*)(KT + (16 * t + fr) * 272 + (32 * ks + 8 * fq) * 2); acc[t] = mfma16(kf, vf, acc[t]); }
        }
        float* UTu = UT + (size_t)unit * 16384 + (16 * wave + fr) * 128 + 4 * fq;
#pragma unroll
        for (int t = 0; t < 8; ++t) *(f32x4*)(UTu + 16 * t) = acc[t];
        if (tid < 128) { float s = 0.f; for (int l = 0; l < 128; ++l) s += bf2f(*(const bf16_t*)(KT + tid * 272 + l * 2)); NLOC[unit * 128 + tid] = s; }
        if (tid == 0) { G[unit] = gs[512]; MLOC[unit] = mloc; }
    }
}

DEV void stage_mscan(const Params& p, char* lds, int vb, int nvb) {
    const int tid = threadIdx.x;
    float* s_dec = (float*)lds; float* s_scl = s_dec + 128;
    const float* UT = (const float*)(p.ws + WS_UB); const float* NLOC = (const float*)(p.ws + WS_NLOC);
    const float* G = (const float*)(p.ws + WS_CHG); const float* MLOC = G + 1024; float* MST = (float*)(p.ws + WS_CHG) + 2048;
    bf16_t* CST = (bf16_t*)(p.ws + WS_CST); float* NST = (float*)(p.ws + WS_NST);
    for (int item = vb; item < 256; item += nvb) {
        const int bh = item >> 5, part = item & 31;
        __syncthreads();
        float* s_g = s_dec + 256; float* s_ml = s_dec + 384; float* s_m = s_dec + 512;
        if (tid < 128) { s_g[tid] = G[bh * 128 + tid]; s_ml[tid] = MLOC[bh * 128 + tid]; }
        __syncthreads();
        if (tid == 0) { float m = 0.f; for (int c = 0; c < 128; ++c) { s_m[c] = m; m = fmaxf(s_g[c] + m, s_ml[c]); } s_m[128] = m; }
        __syncthreads();
        if (tid < 128) { const float m = s_m[tid], mn = s_m[tid + 1]; s_dec[tid] = expf(s_g[tid] + m - mn); s_scl[tid] = expf(s_ml[tid] - mn); if (part == 0) MST[bh * 128 + tid] = m; }
        __syncthreads();
        const int e = part * 512 + tid;
        float C = 0.f;
        const float* up = UT + (size_t)bh * 128 * 16384 + e; bf16_t* cp = CST + (size_t)bh * 128 * 16384 + e;
        for (int c = 0; c < 128; c += 32) {
            float uu[32];
#pragma unroll
            for (int i = 0; i < 32; ++i) uu[i] = up[(size_t)(c + i) * 16384];
#pragma unroll
            for (int i = 0; i < 32; ++i) { cp[(size_t)(c + i) * 16384] = (bf16_t)f2bf(C); C = s_dec[c + i] * C + s_scl[c + i] * uu[i]; }
        }
        if (part == 0 && tid < 128) { float nn = 0.f; for (int c = 0; c < 128; ++c) { NST[(bh * 128 + c) * 128 + tid] = nn; nn = s_dec[c] * nn + s_scl[c] * NLOC[(bh * 128 + c) * 128 + tid]; } }
    }
}

DEV void stage_mout(const Params& p, char* lds, int vb, int nvb) {
    const int tid = threadIdx.x, lane = tid & 63, wave = __builtin_amdgcn_readfirstlane(tid >> 6), fr = lane & 15, fq = lane >> 4;
    char* Qs = lds; char* Ks = lds + 34816; char* VT = lds + 69632; char* CT = lds + 104448;
    float* gs = (float*)(lds + 139264); float* s_nst = gs + 520; float* s_mo = gs + 648; float* s_wi = gs + 776;
    bf16_t* PM = (bf16_t*)(p.ws + WS_PM);
    const float* ipre = (const float*)(p.ws + WS_IPRE); const float* fpre = (const float*)(p.ws + WS_FPRE);
    const float* MST = (const float*)(p.ws + WS_CHG) + 2048; const float* NST = (const float*)(p.ws + WS_NST);
    const bf16_t* CST = (const bf16_t*)(p.ws + WS_CST);
    for (int unit = vb; unit < 1024; unit += nvb) {
        const int c = unit & 127, h = (unit >> 7) & 3, b = unit >> 9;
        const int rowbase = b * SEQ + c * 128;
        __syncthreads();
        if (wave == 0) chunk_gates(ipre, fpre, rowbase, h, gs, lane);
        for (int task = tid; task < 2048; task += NTH) {
            const int l = task >> 4, ch = task & 15;
            float v8[8]; u32x4 o;
            conv8(PM, p.conv_w, b, c * 128 + l, h * 128 + ch * 8, h * 128 + ch * 8, v8);
            o.x = pk2(siluf_(v8[0]), siluf_(v8[1])); o.y = pk2(siluf_(v8[2]), siluf_(v8[3])); o.z = pk2(siluf_(v8[4]), siluf_(v8[5])); o.w = pk2(siluf_(v8[6]), siluf_(v8[7]));
            *(u32x4*)(Qs + l * 272 + ch * 16) = o;
            conv8(PM, p.conv_w, b, c * 128 + l, 512 + h * 128 + ch * 8, 512 + h * 128 + ch * 8, v8);
            const float sc = 0.08838834764831845f;
            o.x = pk2(siluf_(v8[0]) * sc, siluf_(v8[1]) * sc); o.y = pk2(siluf_(v8[2]) * sc, siluf_(v8[3]) * sc); o.z = pk2(siluf_(v8[4]) * sc, siluf_(v8[5]) * sc); o.w = pk2(siluf_(v8[6]) * sc, siluf_(v8[7]) * sc);
            *(u32x4*)(Ks + l * 272 + ch * 16) = o;
            const u32x4 x = *(const u32x4*)(PM + (size_t)(rowbase + l) * LPM + 1024 + h * 128 + ch * 8);
#pragma unroll
            for (int e = 0; e < 8; ++e) *(bf16_t*)(VT + (ch * 8 + e) * 272 + l * 2) = (bf16_t)((e & 1) ? (x[e >> 1] >> 16) : (x[e >> 1] & 0xffffu));
            *(u32x4*)(CT + l * 272 + ch * 16) = *(const u32x4*)(CST + (size_t)unit * 16384 + l * 128 + ch * 8);
        }
        if (tid < 128) s_nst[tid] = NST[unit * 128 + tid];
        __syncthreads();
        if (tid < 128) { const float mst = MST[unit]; const float bc = gs[tid]; const float mo = bc + fmaxf(mst, gs[384 + tid]); s_mo[tid] = mo; s_wi[tid] = __expf(bc + mst - mo); }
        __syncthreads();
        const int l = 16 * wave + fr;
        f32x4 s[8];
        bf16x8 qf[4];
#pragma unroll
        for (int ks = 0; ks < 4; ++ks) qf[ks] = *(const bf16x8*)(Qs + l * 272 + (32 * ks + 8 * fq) * 2);
#pragma unroll
        for (int t = 0; t < 8; ++t) {
            s[t] = (f32x4){0.f, 0.f, 0.f, 0.f};
            if (t <= wave) {
#pragma unroll
                for (int ks = 0; ks < 4; ++ks) { const bf16x8 kf = *(const bf16x8*)(Ks + (16 * t + fr) * 272 + (32 * ks + 8 * fq) * 2); s[t] = mfma16(kf, qf[ks], s[t]); }
            }
        }
        const float bl = gs[l], mol = s_mo[l];
        float dsum = 0.f;
#pragma unroll
        for (int t = 0; t < 8; ++t)
#pragma unroll
            for (int r = 0; r < 4; ++r) {
                const int si = 16 * t + 4 * fq + r; float wv = 0.f;
                if (t <= wave && si <= l) wv = __expf(bl + gs[128 + si] - mol) * s[t][r];
                s[t][r] = wv; dsum += wv;
            }
        dsum += __shfl_xor(dsum, 16); dsum += __shfl_xor(dsum, 32);
        float qn = 0.f;
        {
            const char* qrow = Qs + l * 272 + fq * 64;
#pragma unroll
            for (int i = 0; i < 4; ++i) {
                const u32x4 x = *(const u32x4*)(qrow + 16 * i); const float* nn = s_nst + fq * 32 + 8 * i;
                qn += bflo(x[0]) * nn[0] + bfhi(x[0]) * nn[1] + bflo(x[1]) * nn[2] + bfhi(x[1]) * nn[3] + bflo(x[2]) * nn[4] + bfhi(x[2]) * nn[5] + bflo(x[3]) * nn[6] + bfhi(x[3]) * nn[7];
            }
        }
        qn += __shfl_xor(qn, 16); qn += __shfl_xor(qn, 32);
        __syncthreads();
#pragma unroll
        for (int t = 0; t < 8; ++t)
            if (t <= wave + 1) { u32x2 o; o.x = pk2(s[t][0], s[t][1]); o.y = pk2(s[t][2], s[t][3]); *(u32x2*)(Ks + l * 272 + (16 * t + 4 * fq) * 2) = o; }
        __syncthreads();
        f32x4 acc[8];
#pragma unroll
        for (int t = 0; t < 8; ++t) acc[t] = (f32x4){0.f, 0.f, 0.f, 0.f};
#pragma unroll
        for (int ks = 0; ks < 4; ++ks)
#pragma unroll
            for (int t = 0; t < 8; ++t) { const bf16x8 cf = *(const bf16x8*)(CT + (16 * t + fr) * 272 + (32 * ks + 8 * fq) * 2); acc[t] = mfma16(cf, qf[ks], acc[t]); }
        const float wi = s_wi[l];
#pragma unroll
        for (int t = 0; t < 8; ++t) acc[t] = acc[t] * wi;
        const int nks = (wave + 2) >> 1;
#pragma unroll
        for (int ks = 0; ks < 4; ++ks)
            if (ks < nks) {
                const bf16x8 wf = *(const bf16x8*)(Ks + l * 272 + (32 * ks + 8 * fq) * 2);
#pragma unroll
                for (int t = 0; t < 8; ++t) { const bf16x8 vf = *(const bf16x8*)(VT + (16 * t + fr) * 272 + (32 * ks + 8 * fq) * 2); acc[t] = mfma16(vf, wf, acc[t]); }
            }
        const float den = dsum + wi * qn;
        const float invd = 1.f / fmaxf(fabsf(den), __expf(-mol));
        bf16_t* mop = PM + (size_t)(rowbase + l) * LPM + 1536 + h * 128 + 4 * fq;
        float ssq = 0.f;
#pragma unroll
        for (int t = 0; t < 8; ++t) {
            const u32x2 g2 = *(const u32x2*)(mop + 16 * t);
            const float gg[4] = {bflo(g2.x), bfhi(g2.x), bflo(g2.y), bfhi(g2.y)};
#pragma unroll
            for (int r = 0; r < 4; ++r) { const float hv = acc[t][r] * invd * sigmoidf_(gg[r]); acc[t][r] = hv; ssq += hv * hv; }
        }
        ssq += __shfl_xor(ssq, 16); ssq += __shfl_xor(ssq, 32);
        const float rn = rsqrtf(ssq * (1.f / 128.f) + 1e-6f);
#pragma unroll
        for (int t = 0; t < 8; ++t) {
            const float4 nw = *(const float4*)(p.mnorm_w + h * 128 + 16 * t + 4 * fq);
            u32x2 o; o.x = pk2(acc[t][0] * rn * nw.x, acc[t][1] * rn * nw.y); o.y = pk2(acc[t][2] * rn * nw.z, acc[t][3] * rn * nw.w);
            *(u32x2*)(mop + 16 * t) = o;
        }
    }
}

DEV void stage_norm2(const Params& p, char* lds, int vb, int nvb) {
    const int tid = threadIdx.x, lane = tid & 63, wave = __builtin_amdgcn_readfirstlane(tid >> 6);
    const float* mod = (const float*)(p.ws + WS_MOD);
    bf16_t* U2 = (bf16_t*)(p.ws + WS_PG);
    const int rstride = nvb * NW;
    for (int mb = vb * NW + wave; mb < M; mb += 4 * rstride) {
        float4 vv[4][4];
#pragma unroll
        for (int rr = 0; rr < 4; ++rr) { const int mr = mb + rr * rstride < M ? mb + rr * rstride : mb; const float4* xr = (const float4*)(p.out + (size_t)mr * D);
#pragma unroll
            for (int j = 0; j < 4; ++j) vv[rr][j] = xr[lane + 64 * j]; }
#pragma unroll
        for (int rr = 0; rr < 4; ++rr) {
            const int m = mb + rr * rstride;
            if (m < M) {
                const int b = m >= SEQ ? 1 : 0;
                float ss = 0.f;
#pragma unroll
                for (int j = 0; j < 4; ++j) { const float4 v = vv[rr][j]; ss += v.x * v.x + v.y * v.y + v.z * v.z + v.w * v.w; }
                ss = wave_sum(ss);
                const float rstd = rsqrtf(ss * (1.f / 1024.f) + 1e-6f);
#pragma unroll
                for (int j = 0; j < 4; ++j) {
                    const int col = 4 * (lane + 64 * j); const float4 v = vv[rr][j];
                    const float4 w1 = *(const float4*)(p.norm2_w + col), sc = *(const float4*)(mod + b * 6144 + 4096 + col), sh = *(const float4*)(mod + b * 6144 + 3072 + col);
                    u32x2 o;
                    o.x = pk2(v.x * rstd * w1.x * (1.f + sc.x) + sh.x, v.y * rstd * w1.y * (1.f + sc.y) + sh.y);
                    o.y = pk2(v.z * rstd * w1.z * (1.f + sc.z) + sh.z, v.w * rstd * w1.w * (1.f + sc.w) + sh.w);
                    *(u32x2*)(U2 + (size_t)m * D + col) = o;
                }
            }
        }
    }
}

constexpr size_t WS_SELI = 400 * MiB;
constexpr size_t WS_SELG = 416 * MiB;
constexpr size_t WS_SC = 64 * MiB;
DEV unsigned f2ord(float f) { const unsigned u = __float_as_uint(f); return (u & 0x80000000u) ? ~u : (u | 0x80000000u); }
DEV float ord2f(unsigned k) { return __uint_as_float((k & 0x80000000u) ? (k ^ 0x80000000u) : ~k); }
DEV unsigned umax_(unsigned a, unsigned b) { return a > b ? a : b; }

DEV void stage_gemm_q(const Params& p, char* lds, int vb, int nvb) {
    pg8::Gemm g{(const bf16_t*)(p.ws + WS_PG), (const bf16_t*)(p.ws + WS_WQ), M, 2048, 1024, 1024, 1024};
    pg8::StaticOrder S; S.init(M, 2048, nvb, vb);
    pg8::EpiF32 E{(float*)(p.ws + WS_SC), 2048};
    pg8::gemm_phase<pg8::EpiF32, pg8::StaticOrder, true, true>((PG8_LAS unsigned char*)lds, g, S, E);
}

DEV unsigned umin_(unsigned a, unsigned b) { return a < b ? a : b; }
template <int N> DEV void bitonic_sort_desc(unsigned (&a)[N]) {
#pragma unroll
    for (int k = 2; k <= N; k <<= 1)
#pragma unroll
        for (int j = k >> 1; j > 0; j >>= 1)
#pragma unroll
            for (int i = 0; i < N; ++i) { const int l = i ^ j; if (l > i) { const unsigned x = a[i], y = a[l]; const bool dsc = (i & k) == 0; a[i] = dsc ? umax_(x, y) : umin_(x, y); a[l] = dsc ? umin_(x, y) : umax_(x, y); } }
}
template <int N> DEV void bitonic_merge_desc(unsigned (&a)[N]) {
#pragma unroll
    for (int j = N >> 1; j > 0; j >>= 1)
#pragma unroll
        for (int i = 0; i < N; ++i) { const int l = i ^ j; if (l > i) { const unsigned x = a[i], y = a[l]; a[i] = umax_(x, y); a[l] = umin_(x, y); } }
}
template <bool X16> DEV void merge_top16_xlane(unsigned (&x)[16], int lane) {
    unsigned m[16];
#pragma unroll
    for (int i = 0; i < 16; ++i) {
        unsigned pv;
        if (X16) { auto r = __builtin_amdgcn_permlane16_swap(x[15 - i], x[15 - i], false, false); pv = (lane & 16) ? r[0] : r[1]; }
        else { auto r = __builtin_amdgcn_permlane32_swap(x[15 - i], x[15 - i], false, false); pv = (lane & 32) ? r[0] : r[1]; }
        m[i] = umax_(x[i], pv);
    }
    bitonic_merge_desc<16>(m);
#pragma unroll
    for (int i = 0; i < 16; ++i) x[i] = m[i];
}

DEV void stage_q_topk(const Params& p, char* lds, int vb, int nvb) {
    const int tid = threadIdx.x, lane = tid & 63, wave = __builtin_amdgcn_readfirstlane(tid >> 6), fr = lane & 15, fq = lane >> 4;
    unsigned* tops = (unsigned*)lds;
    unsigned char* ptab = (unsigned char*)(lds + 16384);
    const float* SC = (const float*)(p.ws + WS_SC);
    int* SELI = (int*)(p.ws + WS_SELI); float* SELG = (float*)(p.ws + WS_SELG);
    __syncthreads();
    if (tid < 64) { int cnt = 0; unsigned char v = 0xff; for (int i = 0; i < 16; ++i) for (int j = 0; j < 16 / (i + 1); ++j) { if (cnt == tid) v = (unsigned char)(i | (j << 4)); ++cnt; } ptab[tid] = v; }
    __syncthreads();
    for (int item = vb; item < 2048; item += nvb) {
        const int mt = item >> 3, h = item & 7, m0 = mt * 128;
        const float* srow = SC + (size_t)(m0 + 16 * wave + fr) * 2048 + h * 256 + 4 * fq;
        f32x4 sv[2][8];
#pragma unroll
        for (int pp = 0; pp < 2; ++pp)
#pragma unroll
            for (int t = 0; t < 8; ++t) sv[pp][t] = *(const f32x4*)(srow + pp * 128 + 16 * t);
        unsigned* tp = tops + (16 * wave + fr) * 32;
#pragma unroll
        for (int pp = 0; pp < 2; ++pp) {
            unsigned lo[16], hi[16];
#pragma unroll
            for (int t = 0; t < 4; ++t)
#pragma unroll
                for (int r = 0; r < 4; ++r) {
                    lo[4 * t + r] = (f2ord(sv[pp][t][r]) & ~127u) | (127u - (unsigned)(16 * t + 4 * fq + r));
                    hi[4 * t + r] = (f2ord(sv[pp][t + 4][r]) & ~127u) | (127u - (unsigned)(16 * (t + 4) + 4 * fq + r));
                }
            bitonic_sort_desc<16>(lo); bitonic_sort_desc<16>(hi);
#pragma unroll
            for (int i = 0; i < 16; ++i) lo[i] = umax_(lo[i], hi[15 - i]);
            bitonic_merge_desc<16>(lo);
            merge_top16_xlane<true>(lo, lane); merge_top16_xlane<false>(lo, lane);
            if (fq == 0) {
#pragma unroll
                for (int q = 0; q < 4; ++q) *(u32x4*)(tp + pp * 16 + 4 * q) = (u32x4){lo[4 * q], lo[4 * q + 1], lo[4 * q + 2], lo[4 * q + 3]};
            }
        }
        wave_lds_sync();
        unsigned ck[16];
#pragma unroll
        for (int sl = 0; sl < 13; ++sl) {
            const unsigned pr = ptab[4 * sl + fq]; const unsigned i = pr & 15u, j = pr >> 4;
            const float sum = ord2f(tp[i] & ~127u) + ord2f(tp[16 + (j & 15u)] & ~127u);
            ck[sl] = pr != 0xffu ? ((f2ord(sum) & ~255u) | (255u - (i * 16u + j))) : 0u;
        }
        ck[13] = 0u; ck[14] = 0u; ck[15] = 0u;
        bitonic_sort_desc<16>(ck);
        merge_top16_xlane<true>(ck, lane); merge_top16_xlane<false>(ck, lane);
        const float v0 = ord2f(ck[0] & ~255u);
        float ex[16], sm = 0.f;
#pragma unroll
        for (int r = 0; r < 16; ++r) { ex[r] = __expf(ord2f(ck[r] & ~255u) - v0); sm += ex[r]; }
        const float rs = 1.f / sm;
        int oi[4]; float og[4];
#pragma unroll
        for (int q = 0; q < 4; ++q) {
            const unsigned w = fq == 0 ? ck[q] : (fq == 1 ? ck[4 + q] : (fq == 2 ? ck[8 + q] : ck[12 + q]));
            const float e = fq == 0 ? ex[q] : (fq == 1 ? ex[4 + q] : (fq == 2 ? ex[8 + q] : ex[12 + q]));
            const unsigned flat = 255u - (w & 255u); const unsigned ia = flat >> 4, jb = flat & 15u;
            oi[q] = (int)((127u - (tp[ia] & 127u)) * 128u + (127u - (tp[16 + jb] & 127u)));
            og[q] = e * rs;
        }
        const size_t so = (size_t)(m0 + 16 * wave + fr) * 128 + h * 16 + 4 * fq;
        *(int4*)(SELI + so) = make_int4(oi[0], oi[1], oi[2], oi[3]);
        *(float4*)(SELG + so) = make_float4(og[0], og[1], og[2], og[3]);
        wave_lds_sync();
    }
}

DEV float dpp_row_sum(float v) {
    v += __int_as_float(__builtin_amdgcn_update_dpp(0, __float_as_int(v), 0xB1, 0xF, 0xF, true));
    v += __int_as_float(__builtin_amdgcn_update_dpp(0, __float_as_int(v), 0x4E, 0xF, 0xF, true));
    v += __int_as_float(__builtin_amdgcn_update_dpp(0, __float_as_int(v), 0x141, 0xF, 0xF, true));
    v += __int_as_float(__builtin_amdgcn_update_dpp(0, __float_as_int(v), 0x140, 0xF, 0xF, true));
    return v;
}
DEV int dpp_row_isum(int v) {
    v += __builtin_amdgcn_update_dpp(0, v, 0xB1, 0xF, 0xF, true); v += __builtin_amdgcn_update_dpp(0, v, 0x4E, 0xF, 0xF, true);
    v += __builtin_amdgcn_update_dpp(0, v, 0x141, 0xF, 0xF, true); v += __builtin_amdgcn_update_dpp(0, v, 0x140, 0xF, 0xF, true);
    return v;
}
DEV float dpp_row_max(float v) {
    v = fmaxf(v, __int_as_float(__builtin_amdgcn_update_dpp(0, __float_as_int(v), 0xB1, 0xF, 0xF, true))); v = fmaxf(v, __int_as_float(__builtin_amdgcn_update_dpp(0, __float_as_int(v), 0x4E, 0xF, 0xF, true)));
    v = fmaxf(v, __int_as_float(__builtin_amdgcn_update_dpp(0, __float_as_int(v), 0x141, 0xF, 0xF, true))); v = fmaxf(v, __int_as_float(__builtin_amdgcn_update_dpp(0, __float_as_int(v), 0x140, 0xF, 0xF, true)));
    return v;
}
DEV float gelu_as(float v) {
    const float av = fabsf(v), t = __builtin_amdgcn_rcpf(av * 0.2316418882f + 1.0f);
    float q = t * 0.5307027145f + (-0.7265760135f); q = q * t + 0.7107068705f; q = q * t + (-0.142248368f); q = q * t + 0.127414796f; q = q * t;
    const float e = __builtin_amdgcn_exp2f(v * v * (-0.72134752044f));
    const float m = v * (q * e);
    return v < 0.f ? m : v - m;
}
constexpr int NBIN = 32;
constexpr int GW_IDX = 0, GW_GATE = 1024, GW_SU = 3072, GW_SV = 5120, GW_W = 7168, GW_WQ = 9216, GW_BYTES = 9728;
DEV void g_sort_token(const int* SELI, const float* SELG, const float* SU, const float* SV, int tkn, char* wl, int j, int lane, int msk) {
    const int i0 = SELI[(size_t)tkn * 128 + lane] & msk, i1 = SELI[(size_t)tkn * 128 + 64 + lane] & msk;
    const float g0 = SELG[(size_t)tkn * 128 + lane], g1 = SELG[(size_t)tkn * 128 + 64 + lane];
    const float su0 = SU[i0], su1 = SU[i1], sv0 = SV[i0], sv1 = SV[i1];
    const int s0 = i0 >> 9, s1 = i1 >> 9;
    const unsigned long long lt = (1ull << lane) - 1ull;
    int base = 0, p0 = 0, p1 = 0;
#pragma unroll
    for (int s = 0; s < NBIN; ++s) {
        const unsigned long long m0 = __ballot(s0 == s), m1 = __ballot(s1 == s);
        const int c0 = __popcll(m0), c1 = __popcll(m1);
        if (s0 == s) p0 = base + __popcll(m0 & lt);
        if (s1 == s) p1 = base + c0 + __popcll(m1 & lt);
        base += c0 + c1;
    }
    unsigned short* li = (unsigned short*)(wl + GW_IDX) + j * 128; float* lg = (float*)(wl + GW_GATE) + j * 128; float* lsu = (float*)(wl + GW_SU) + j * 128; float* lsv = (float*)(wl + GW_SV) + j * 128;
    li[p0] = (unsigned short)i0; lg[p0] = g0; lsu[p0] = su0; lsv[p0] = sv0;
    li[p1] = (unsigned short)i1; lg[p1] = g1; lsu[p1] = su1; lsv[p1] = sv1;
}
DEV void r_load(u32x4 (&d)[4], const unsigned char* T, int id, int c) {
    const u32x4* q = (const u32x4*)(T + (size_t)id * 1024) + c;
#pragma unroll
    for (int k = 0; k < 4; ++k) d[k] = q[16 * k];
}
DEV int r_dotq(const u32x4 (&u)[4], const unsigned (&xq)[16]) {
    int s0 = 0, s1 = 0, s2 = 0, s3 = 0;
#pragma unroll
    for (int k = 0; k < 4; ++k) {
        s0 = __builtin_amdgcn_sdot4((int)u[k][0], (int)xq[4 * k], s0, false); s1 = __builtin_amdgcn_sdot4((int)u[k][1], (int)xq[4 * k + 1], s1, false);
        s2 = __builtin_amdgcn_sdot4((int)u[k][2], (int)xq[4 * k + 2], s2, false); s3 = __builtin_amdgcn_sdot4((int)u[k][3], (int)xq[4 * k + 3], s3, false);
    }
    return (s0 + s1) + (s2 + s3);
}
DEV float r_weight(int part, float sx, const char* wl, int r, int e) {
    const float d = (float)dpp_row_isum(part) * (((const float*)(wl + GW_SU))[r * 128 + e] * sx);
    return ((const float*)(wl + GW_GATE))[r * 128 + e] * gelu_as(d) * ((const float*)(wl + GW_SV))[r * 128 + e];
}
DEV void r_vaccq(const u32x4 (&v0)[4], const u32x4 (&v1)[4], const u32x4 (&v2)[4], const u32x4 (&v3)[4], unsigned wpk, int (&acc)[64]) {
#pragma unroll
    for (int k = 0; k < 4; ++k)
#pragma unroll
        for (int w = 0; w < 4; ++w) {
            const unsigned r0 = v0[k][w], r1 = v1[k][w], r2 = v2[k][w], r3 = v3[k][w];
            const unsigned p0 = __builtin_amdgcn_perm(r1, r0, 0x05010400u), p1 = __builtin_amdgcn_perm(r1, r0, 0x07030602u);
            const unsigned q0 = __builtin_amdgcn_perm(r3, r2, 0x05010400u), q1 = __builtin_amdgcn_perm(r3, r2, 0x07030602u);
            const unsigned t0 = __builtin_amdgcn_perm(q0, p0, 0x05040100u), t1 = __builtin_amdgcn_perm(q0, p0, 0x07060302u);
            const unsigned t2 = __builtin_amdgcn_perm(q1, p1, 0x05040100u), t3 = __builtin_amdgcn_perm(q1, p1, 0x07060302u);
            const int o = 16 * k + 4 * w;
            acc[o] = __builtin_amdgcn_sdot4((int)t0, (int)wpk, acc[o], false); acc[o + 1] = __builtin_amdgcn_sdot4((int)t1, (int)wpk, acc[o + 1], false);
            acc[o + 2] = __builtin_amdgcn_sdot4((int)t2, (int)wpk, acc[o + 2], false); acc[o + 3] = __builtin_amdgcn_sdot4((int)t3, (int)wpk, acc[o + 3], false);
        }
}
#define SB_() __builtin_amdgcn_sched_barrier(0)

DEV void stage_peer_gather(const Params& p, char* lds, int slot, int nslots, bool dry = false, int msk = 0x3fff) {
    const int tid = threadIdx.x, lane = tid & 63, wave = __builtin_amdgcn_readfirstlane(tid >> 6), r = lane >> 4, c = lane & 15;
    const bf16_t* U2 = (const bf16_t*)(p.ws + WS_PG);
    const unsigned char* TU = p.ws + WS_TU; const unsigned char* TV = p.ws + WS_TV;
    const float* SU = (const float*)(p.ws + WS_ISU); const float* SV = (const float*)(p.ws + WS_ISV);
    const int* SELI = (const int*)(p.ws + WS_SELI); const float* SELG = (const float*)(p.ws + WS_SELG);
    const float* mod = (const float*)(p.ws + WS_MOD);
    char* wl = lds + wave * GW_BYTES;
    const unsigned short* myi = (const unsigned short*)(wl + GW_IDX) + r * 128;
    float* lw = (float*)(wl + GW_W) + r * 128; unsigned* lwq = (unsigned*)(wl + GW_WQ) + r * 32;
    const int tpb = M / nslots;
    __syncthreads();
    for (int g0 = 0; g0 < tpb; g0 += 32) {
        const int tbase = slot * tpb + g0 + 4 * wave;
#pragma unroll
        for (int j = 0; j < 4; ++j) g_sort_token(SELI, SELG, SU, SV, tbase + j, wl, j, lane, msk);
        const int tkn = tbase + r;
        unsigned xq[16]; float sx;
        {
            const bf16_t* xr = U2 + (size_t)tkn * D + 16 * c;
            u32x4 t[8]; float amax = 0.f;
#pragma unroll
            for (int k = 0; k < 8; ++k) { t[k] = *(const u32x4*)(xr + 256 * (k >> 1) + 8 * (k & 1));
#pragma unroll
                for (int i = 0; i < 4; ++i) amax = fmaxf(amax, fmaxf(fabsf(bflo(t[k][i])), fabsf(bfhi(t[k][i])))); }
            amax = dpp_row_max(amax);
            const float inv = amax > 0.f ? 127.f / amax : 0.f; sx = amax > 0.f ? amax * (1.f / 127.f) : 1.f;
#pragma unroll
            for (int k = 0; k < 8; ++k)
#pragma unroll
                for (int h2 = 0; h2 < 2; ++h2) {
                    const unsigned a = t[k][2 * h2], b = t[k][2 * h2 + 1];
                    const unsigned wv = ((unsigned)__float2int_rn(bflo(a) * inv) & 0xffu) | (((unsigned)__float2int_rn(bfhi(a) * inv) & 0xffu) << 8) | (((unsigned)__float2int_rn(bflo(b) * inv) & 0xffu) << 16) | ((unsigned)__float2int_rn(bfhi(b) * inv) << 24);
                    xq[2 * k + h2] = wv;
                }
        }
        wave_lds_sync();
        float wmax = 0.f;
        {
            u32x4 ua[4], ub[4], uc[4], ud[4];
            r_load(ua, TU, (int)myi[0], c); r_load(ub, TU, (int)myi[1], c); r_load(uc, TU, (int)myi[2], c); r_load(ud, TU, (int)myi[3], c);
            for (int e = 0; e < 128; e += 4) {
                SB_(); const int pa = r_dotq(ua, xq); SB_(); r_load(ua, TU, (int)myi[e + 4 < 128 ? e + 4 : 127], c); SB_();
                const int pb = r_dotq(ub, xq); SB_(); r_load(ub, TU, (int)myi[e + 5 < 128 ? e + 5 : 127], c); SB_();
                const int pc = r_dotq(uc, xq); SB_(); r_load(uc, TU, (int)myi[e + 6 < 128 ? e + 6 : 127], c); SB_();
                const int pd = r_dotq(ud, xq); SB_(); r_load(ud, TU, (int)myi[e + 7 < 128 ? e + 7 : 127], c); SB_();
                const float w0 = r_weight(pa, sx, wl, r, e), w1 = r_weight(pb, sx, wl, r, e + 1), w2 = r_weight(pc, sx, wl, r, e + 2), w3 = r_weight(pd, sx, wl, r, e + 3);
                wmax = fmaxf(fmaxf(wmax, fmaxf(fabsf(w0), fabsf(w1))), fmaxf(fabsf(w2), fabsf(w3)));
                if (c == 0) *(f32x4*)(lw + e) = (f32x4){w0, w1, w2, w3};
            }
        }
        const float T = wmax > 0.f ? wmax * (1.f / 127.f) : 1.f, invT = wmax > 0.f ? 127.f / wmax : 0.f;
        wave_lds_sync();
#pragma unroll
        for (int h2 = 0; h2 < 2; ++h2) {
            const int gg = c + 16 * h2; const f32x4 wv = *(const f32x4*)(lw + 4 * gg);
            lwq[gg] = ((unsigned)__float2int_rn(wv[0] * invT) & 0xffu) | (((unsigned)__float2int_rn(wv[1] * invT) & 0xffu) << 8) | (((unsigned)__float2int_rn(wv[2] * invT) & 0xffu) << 16) | ((unsigned)__float2int_rn(wv[3] * invT) << 24);
        }
        wave_lds_sync();
        int acc[64];
#pragma unroll
        for (int i = 0; i < 64; ++i) acc[i] = 0;
        {
            u32x4 a0[4], a1[4], a2[4], a3[4], b0[4], b1[4], b2[4], b3[4];
            r_load(a0, TV, (int)myi[0], c); r_load(a1, TV, (int)myi[1], c); r_load(a2, TV, (int)myi[2], c); r_load(a3, TV, (int)myi[3], c);
            r_load(b0, TV, (int)myi[4], c); r_load(b1, TV, (int)myi[5], c); r_load(b2, TV, (int)myi[6], c); r_load(b3, TV, (int)myi[7], c);
            for (int g = 0; g < 32; g += 2) {
                const int n2 = g + 2 < 32 ? 4 * (g + 2) : 124, n3 = g + 3 < 32 ? 4 * (g + 3) : 124;
                SB_(); r_vaccq(a0, a1, a2, a3, lwq[g], acc); SB_();
                r_load(a0, TV, (int)myi[n2], c); r_load(a1, TV, (int)myi[n2 + 1], c); r_load(a2, TV, (int)myi[n2 + 2], c); r_load(a3, TV, (int)myi[n2 + 3], c); SB_();
                r_vaccq(b0, b1, b2, b3, lwq[g + 1], acc); SB_();
                r_load(b0, TV, (int)myi[n3], c); r_load(b1, TV, (int)myi[n3 + 1], c); r_load(b2, TV, (int)myi[n3 + 2], c); r_load(b3, TV, (int)myi[n3 + 3], c); SB_();
            }
        }
        const int b = tkn >= SEQ ? 1 : 0;
        float* hr = p.out + (size_t)tkn * D + 16 * c;
        const float* g2p = mod + b * 6144 + 5120 + 16 * c;
        float y[64]; float ss = 0.f;
#pragma unroll
        for (int q = 0; q < 16; ++q) {
            const int eo = 256 * (q >> 2) + 4 * (q & 3);
            const float4 hv = *(const float4*)(hr + eo); const float4 g2 = *(const float4*)(g2p + eo);
            y[4 * q] = hv.x + g2.x * (T * (float)acc[4 * q]); y[4 * q + 1] = hv.y + g2.y * (T * (float)acc[4 * q + 1]);
            y[4 * q + 2] = hv.z + g2.z * (T * (float)acc[4 * q + 2]); y[4 * q + 3] = hv.w + g2.w * (T * (float)acc[4 * q + 3]);
            ss += y[4 * q] * y[4 * q] + y[4 * q + 1] * y[4 * q + 1] + y[4 * q + 2] * y[4 * q + 2] + y[4 * q + 3] * y[4 * q + 3];
        }
        ss = dpp_row_sum(ss);
        const float rstd = rsqrtf(ss * (1.f / 1024.f) + 1e-6f);
        if (!dry || rstd == 123.456f)
#pragma unroll
        for (int q = 0; q < 16; ++q) {
            const int eo = 256 * (q >> 2) + 4 * (q & 3);
            const float4 nw = *(const float4*)(p.normf_w + 16 * c + eo);
            float4 o; o.x = y[4 * q] * rstd * nw.x; o.y = y[4 * q + 1] * rstd * nw.y; o.z = y[4 * q + 2] * rstd * nw.z; o.w = y[4 * q + 3] * rstd * nw.w;
            *(float4*)(hr + eo) = o;
        }
        wave_lds_sync();
    }
}

#define LAS __attribute__((address_space(3)))
#define XB_TMO      128
#define XB_XCNT(j)  (256  + 64 * (j))
#define XB_XSUB(j)  (1280 + 64 * (j))
#define XB_XGEN(j)  (2304 + 64 * (j))
#define XB_TOP      3328
#define XB_TOPGEN   3392
#define XCD_BAR_WORDS 3456
#define XB_SPIN_CAP (1u << 18)

__device__ __forceinline__ unsigned xb_ld(unsigned* p)              { return __hip_atomic_load(p, __ATOMIC_RELAXED, __HIP_MEMORY_SCOPE_AGENT); }
__device__ __forceinline__ unsigned xb_add(unsigned* p, unsigned v) { return __hip_atomic_fetch_add(p, v, __ATOMIC_RELAXED, __HIP_MEMORY_SCOPE_AGENT); }
__device__ __forceinline__ unsigned xb_xcc_id() { return (unsigned)__builtin_amdgcn_s_getreg((3 << 11) | 20) & 0xFu; }
#define XB_SPIN(cond, bar) do { unsigned _sp = 0; while (cond) { __builtin_amdgcn_s_sleep(1); \
    if ((++_sp & 255u) == 0u) { if (xb_ld(&(bar)[XB_TMO])) break; if (_sp > XB_SPIN_CAP) { atomicAdd(&(bar)[XB_TMO], 1u); break; } } } } while (0)

struct XcdBarrier {
    unsigned* bar; unsigned x;
    volatile LAS unsigned* st;
};

__device__ __forceinline__ XcdBarrier xcd_barrier_post(unsigned* bar, volatile LAS unsigned* st) {
    XcdBarrier b; b.bar = bar; b.x = xb_xcc_id(); b.st = st;
    if (threadIdx.x == 0) (void)xb_add(&bar[XB_XCNT(b.x)], 1u);
    return b;
}
__device__ __forceinline__ void xcd_barrier_complete(unsigned* bar, unsigned x, unsigned& nloc, unsigned& nx) {
    const unsigned G = gridDim.x * gridDim.y * gridDim.z;
    unsigned sum, cnt, mine, sp = 0u;
    for (;;) {
        sum = 0u; cnt = 0u; mine = 0u;
#pragma unroll
        for (unsigned j = 0; j < 16; ++j) { const unsigned c = xb_ld(&bar[XB_XCNT(j)]); sum += c; cnt += (c > 0u) ? 1u : 0u; mine = (j == x) ? c : mine; }
        if (sum == G) break;
        __builtin_amdgcn_s_sleep(1);
        if ((++sp & 255u) == 0u) { if (xb_ld(&bar[XB_TMO])) break; if (sp > XB_SPIN_CAP) { atomicAdd(&bar[XB_TMO], 1u); break; } }
    }
    nloc = mine > 0u ? mine : 1u; nx = cnt > 0u ? cnt : 1u;
}

__device__ __forceinline__ void xcd_barrier(const XcdBarrier& b) {
    asm volatile("s_waitcnt vmcnt(0)" ::: "memory");
    __syncthreads();
    if (threadIdx.x == 0) {
        unsigned* bar = b.bar;
        __builtin_amdgcn_s_waitcnt(0);
        unsigned nloc = b.st[0], nx = b.st[1];
        if (nloc == 0u) { xcd_barrier_complete(bar, b.x, nloc, nx); b.st[0] = nloc; b.st[1] = nx; }
        const unsigned old = xb_add(&bar[XB_XSUB(b.x)], 1u);
        const unsigned gen = old / nloc;
        if (old + 1u == (gen + 1u) * nloc) {
            __builtin_amdgcn_fence(__ATOMIC_RELEASE, "agent");
            asm volatile("s_waitcnt vmcnt(0)" ::: "memory");
            const unsigned og = xb_add(&bar[XB_TOP], 1u);
            const unsigned tg = og / nx;
            if (og + 1u == (tg + 1u) * nx) xb_add(&bar[XB_TOPGEN], 1u);
            else XB_SPIN(xb_ld(&bar[XB_TOPGEN]) == tg, bar);
            __builtin_amdgcn_fence(__ATOMIC_ACQUIRE, "agent");
            xb_add(&bar[XB_XGEN(b.x)], 1u);
            asm volatile("s_waitcnt vmcnt(0)" ::: "memory");
        } else {
            XB_SPIN(xb_ld(&bar[XB_XGEN(b.x)]) == gen, bar);
            __builtin_amdgcn_fence(__ATOMIC_ACQUIRE, "agent");
            asm volatile("s_waitcnt vmcnt(0)" ::: "memory");
        }
    }
    __syncthreads();
}

namespace cg = cooperative_groups;
constexpr int LDS_BYTES = 151552;
constexpr int CW_RANK = XCD_BAR_WORDS;

constexpr int LDS_TOTAL = LDS_BYTES + 64;

__global__ void __launch_bounds__(512) k_mega(Params p) {
    extern __shared__ __attribute__((aligned(16))) char lds[];
    const int vb = blockIdx.x, nvb = gridDim.x;
    volatile LAS unsigned* bst = (volatile LAS unsigned*)((LAS char*)lds + LDS_BYTES);
    if (threadIdx.x < 16) bst[threadIdx.x] = 0u;
    __syncthreads();
    XcdBarrier bar = xcd_barrier_post((unsigned*)p.ws, bst);
    if (threadIdx.x == 0) bst[2] = xb_add((unsigned*)p.ws + CW_RANK + 64 * bar.x, 1u);
#define GRID_BAR() xcd_barrier(bar)
    stage_prep(p, lds, vb, nvb);        GRID_BAR();
    stage_norm1(p, lds, vb, nvb);       GRID_BAR();
    stage_gemm_in(p, lds, vb, nvb);     GRID_BAR();
    stage_attn(p, lds, vb, nvb);
    stage_mstate(p, lds, vb, nvb);      GRID_BAR();
    stage_mscan(p, lds, vb, nvb);       GRID_BAR();
    stage_mout(p, lds, vb, nvb);        GRID_BAR();
    stage_gemm_merge(p, lds, vb, nvb);  GRID_BAR();
    stage_gemm_out(p, lds, vb, nvb);    GRID_BAR();
    stage_norm2(p, lds, vb, nvb);       GRID_BAR();
    stage_gemm_q(p, lds, vb, nvb);      GRID_BAR();
    stage_q_topk(p, lds, vb, nvb);      GRID_BAR();
    if (threadIdx.x == 0) { unsigned base = 0u; for (unsigned j = 0; j < bar.x; ++j) base += xb_ld((unsigned*)p.ws + XB_XCNT(j)); bst[3] = base + bst[2]; }
    __syncthreads();
    const int slot = (int)bst[3];
#ifdef XPG
    stage_peer_gather(p, lds, slot < nvb ? slot : vb, nvb, p.ws != nullptr, XPG == 1 ? 0x3fff : 0x3e1f);
#endif
    stage_peer_gather(p, lds, slot < nvb ? slot : vb, nvb);
}

extern "C" void kernel_launch(void* const* d_in, const int* in_sizes, int n_in, void* d_out, int out_size, void* d_ws, size_t ws_size, hipStream_t stream) {
    if (n_in != 20 || ws_size < WS_END) { fprintf(stderr, "kernel_launch: unexpected n_in %d or ws_size %zu\n", n_in, ws_size); return; }
    static int grid_blocks = 0;
    if (!grid_blocks) {
        int dev = 0, cus = 0, per_cu = 0;
        (void)hipGetDevice(&dev);
        (void)hipDeviceGetAttribute(&cus, hipDeviceAttributeMultiprocessorCount, dev);
        (void)hipFuncSetAttribute((const void*)k_mega, hipFuncAttributeMaxDynamicSharedMemorySize, LDS_TOTAL);
        (void)hipOccupancyMaxActiveBlocksPerMultiprocessor(&per_cu, (const void*)k_mega, 512, LDS_TOTAL);
        if (per_cu < 1) { fprintf(stderr, "kernel_launch: occupancy query says %d blocks per CU\n", per_cu); per_cu = 1; }
        grid_blocks = cus * 1;
    }
    Params p{};
    p.x = (const float*)d_in[0]; p.c = (const float*)d_in[1]; p.w_ada = (const float*)d_in[2]; p.b_ada = (const float*)d_in[3]; p.norm1_w = (const float*)d_in[4];
    p.w_in = (const float*)d_in[5]; p.conv_w = (const float*)d_in[6]; p.sinks = (const float*)d_in[7]; p.i_bias = (const float*)d_in[8]; p.f_bias = (const float*)d_in[9];
    p.mnorm_w = (const float*)d_in[10]; p.w_a = (const float*)d_in[11]; p.w_b = (const float*)d_in[12]; p.w_out = (const float*)d_in[13]; p.norm2_w = (const float*)d_in[14];
    p.w_q = (const float*)d_in[15]; p.sub_keys = (const float*)d_in[16]; p.peer_u = (const float*)d_in[17]; p.peer_v = (const float*)d_in[18]; p.normf_w = (const float*)d_in[19];
    p.out = (float*)d_out; p.ws = (unsigned char*)d_ws;
    (void)hipMemsetAsync(d_ws, 0, 32768, stream);
    void* args[] = {&p};
    hipError_t e = hipLaunchCooperativeKernel((const void*)k_mega, dim3(grid_blocks), dim3(512), args, LDS_TOTAL, stream);
    if (e != hipSuccess) fprintf(stderr, "cooperative launch failed: %s (grid %d)\n", hipGetErrorString(e), grid_blocks);
}
```

```cpp
#include <hip/hip_runtime.h>
#include <hip/hip_cooperative_groups.h>
#include <stdint.h>
#include <stdio.h>

#define DEV __device__ __forceinline__
typedef unsigned short bf16_t;
typedef short bf16x8 __attribute__((ext_vector_type(8)));
typedef float f32x4 __attribute__((ext_vector_type(4)));
typedef unsigned u32x4 __attribute__((ext_vector_type(4)));
typedef unsigned u32x2 __attribute__((ext_vector_type(2)));

constexpr int BATCH = 2, SEQ = 16384, M = BATCH * SEQ, D = 1024;
constexpr int NTH = 512, NW = 8;
constexpr int LPA = 768, LPM = 2048, LPG = 2048;

struct Params {
    const float *x, *c, *w_ada, *b_ada, *norm1_w, *w_in, *conv_w, *sinks, *i_bias, *f_bias, *mnorm_w, *w_a, *w_b, *w_out, *norm2_w, *w_q, *sub_keys, *peer_u, *peer_v, *normf_w;
    float* out; unsigned char* ws;
};

constexpr size_t MiB = 1u << 20;
constexpr size_t WS_MOD = 1 * MiB;
constexpr size_t WS_IPRE = 2 * MiB;
constexpr size_t WS_FPRE = 2 * MiB + 512 * 1024;
constexpr size_t WS_CHG = 3 * MiB;
constexpr size_t WS_NLOC = 4 * MiB;
constexpr size_t WS_NST = 4 * MiB + 512 * 1024;
constexpr size_t WS_ROPE = 5 * MiB;
constexpr size_t WS_WIN = 10 * MiB;
constexpr size_t WS_WA = 20 * MiB;
constexpr size_t WS_WB = 21 * MiB;
constexpr size_t WS_WOUT = 22 * MiB;
constexpr size_t WS_WQ = 24 * MiB;
constexpr size_t WS_SK = 28 * MiB;
constexpr size_t WS_ISU = 29 * MiB;
constexpr size_t WS_ISV = 29 * MiB + 65536;
constexpr size_t WS_TU = 32 * MiB;
constexpr size_t WS_TV = 48 * MiB;
constexpr size_t WS_UB = 96 * MiB;
constexpr size_t WS_PA = 160 * MiB;
constexpr size_t WS_PM = 208 * MiB;
constexpr size_t WS_PG = 336 * MiB;
constexpr size_t WS_CST = 464 * MiB;
constexpr size_t WS_END = 496 * MiB;

DEV unsigned f2bf(float f) { unsigned u = __float_as_uint(f); return (u + 0x7fffu + ((u >> 16) & 1u)) >> 16; }
DEV unsigned pk2(float lo, float hi) { return f2bf(lo) | (f2bf(hi) << 16); }
DEV float bflo(unsigned u) { return __uint_as_float(u << 16); }
DEV float bfhi(unsigned u) { return __uint_as_float(u & 0xffff0000u); }
DEV float bf2f(bf16_t h) { return __uint_as_float(((unsigned)h) << 16); }
DEV float wave_sum(float v) {
#pragma unroll
    for (int o = 32; o > 0; o >>= 1) v += __shfl_xor(v, o);
    return v;
}
DEV float wave_max(float v) {
#pragma unroll
    for (int o = 32; o > 0; o >>= 1) v = fmaxf(v, __shfl_xor(v, o));
    return v;
}
DEV float sigmoidf_(float v) { return __builtin_amdgcn_rcpf(1.f + __expf(-v)); }
DEV f32x4 mfma16(bf16x8 a, bf16x8 b, f32x4 c) { return __builtin_amdgcn_mfma_f32_16x16x32_bf16(a, b, c, 0, 0, 0); }
DEV void wave_lds_sync() { __builtin_amdgcn_fence(__ATOMIC_ACQ_REL, "wavefront"); __builtin_amdgcn_wave_barrier(); }

DEV void transpose_item(const float* W, int ldw, int k0, int nsrc0, bf16_t* WT, int ldt, int ndst0, float* scr, int lane) {
#pragma unroll 8
    for (int i = 0; i < 32; ++i) { const int kk = 2 * i + (lane >> 5); scr[kk * 33 + (lane & 31)] = W[(size_t)(k0 + kk) * ldw + nsrc0 + (lane & 31)]; }
    wave_lds_sync();
    const int c = lane & 7;
#pragma unroll
    for (int j = 0; j < 4; ++j) {
        const int n = (lane >> 3) + 8 * j; const float* s = scr + (8 * c) * 33 + n;
        u32x4 o; o.x = pk2(s[0 * 33], s[1 * 33]); o.y = pk2(s[2 * 33], s[3 * 33]); o.z = pk2(s[4 * 33], s[5 * 33]); o.w = pk2(s[6 * 33], s[7 * 33]);
        *(u32x4*)(WT + (size_t)(ndst0 + n) * ldt + k0 + 8 * c) = o;
    }
    wave_lds_sync();
}

DEV void stage_prep(const Params& p, char* lds, int vb, int nvb) {
    const int tid = threadIdx.x, lane = tid & 63, wave = __builtin_amdgcn_readfirstlane(tid >> 6);
    float* mod = (float*)(p.ws + WS_MOD);
    float* s_act = (float*)lds;
    float* s_red = (float*)(lds + 8192);
    for (int i = tid; i < 2048; i += NTH) { const float v = p.c[i]; s_act[i] = v / (1.f + expf(-v)); }
    __syncthreads();
    for (int item = vb; item < 192; item += nvb) {
        const int kg = tid >> 5, cl = tid & 31, col = item * 32 + cl;
        float s0 = 0.f, s1 = 0.f;
        for (int k = kg; k < 1024; k += 16) { const float w = p.w_ada[(size_t)k * 6144 + col]; s0 += s_act[k] * w; s1 += s_act[1024 + k] * w; }
        s_red[(kg * 32 + cl) * 2] = s0; s_red[(kg * 32 + cl) * 2 + 1] = s1;
        __syncthreads();
        if (tid < 64) { const int b = tid >> 5, c2 = tid & 31; float s = 0.f; for (int g = 0; g < 16; ++g) s += s_red[(g * 32 + c2) * 2 + b]; mod[b * 6144 + item * 32 + c2] = s + p.b_ada[item * 32 + c2]; }
        __syncthreads();
    }
    float* scr = (float*)(lds + 16384 + wave * 8448);
    const int gw = vb * NW + wave, ngw = nvb * NW;
    bf16_t* Wt_in = (bf16_t*)(p.ws + WS_WIN); bf16_t* Wt_a = (bf16_t*)(p.ws + WS_WA); bf16_t* Wt_b = (bf16_t*)(p.ws + WS_WB);
    bf16_t* Wt_out = (bf16_t*)(p.ws + WS_WOUT); bf16_t* Wt_q = (bf16_t*)(p.ws + WS_WQ);
    for (int it = gw; it < 3456; it += ngw) {
        int r = it;
        if (r < 2432) { const int kb = r / 152, nb = r % 152; transpose_item(p.w_in, 4872, kb * 64, nb * 32 + (nb >= 88 ? 8 : 0), Wt_in, 1024, nb * 32, scr, lane); continue; } r -= 2432;
        if (r < 256) { const int kb = r / 32, nb = r % 32; transpose_item(p.w_a, 1024, kb * 64, nb * 32, Wt_a, 512, nb * 32, scr, lane); continue; } r -= 256;
        if (r < 256) { const int kb = r / 32, nb = r % 32; transpose_item(p.w_b, 1024, kb * 64, nb * 32, Wt_b, 512, nb * 32, scr, lane); continue; } r -= 256;
        { const int kb = r / 32, nb = r % 32; transpose_item(p.w_out, 1024, kb * 64, nb * 32, Wt_out, 1024, nb * 32, scr, lane); }
    }
    {
        float* WL = (float*)lds;
        float* KL = (float*)(lds + 33792);
        for (int item = vb; item < 256; item += nvb) {
            const int hp = item >> 4, k0 = (item & 15) * 64, pidx = hp & 1;
            __syncthreads();
            for (int i = tid; i < 64 * 32; i += NTH) { const int kk = i >> 5, d4 = i & 31; *(float4*)(WL + kk * 132 + 4 * d4) = *(const float4*)(p.w_q + (size_t)(k0 + kk) * 2048 + hp * 128 + 4 * d4); }
            for (int i = tid; i < 128 * 32; i += NTH) ((float4*)KL)[i] = ((const float4*)(p.sub_keys + (size_t)pidx * 16384))[i];
            __syncthreads();
            const int kk = tid & 63, n0 = (tid >> 6) * 16;
            float acc[16];
#pragma unroll
            for (int j = 0; j < 16; ++j) acc[j] = 0.f;
            for (int d4 = 0; d4 < 32; ++d4) {
                const float4 w = *(const float4*)(WL + kk * 132 + 4 * d4);
#pragma unroll
                for (int j = 0; j < 16; ++j) { const float4 kv = *(const float4*)(KL + (n0 + j) * 128 + 4 * d4); acc[j] += w.x * kv.x + w.y * kv.y + w.z * kv.z + w.w * kv.w; }
            }
#pragma unroll
            for (int j = 0; j < 16; ++j) Wt_q[(size_t)(hp * 128 + n0 + j) * 1024 + k0 + kk] = (bf16_t)f2bf(acc[j]);
        }
        __syncthreads();
    }
    const size_t gt = (size_t)vb * NTH + tid, ngt = (size_t)nvb * NTH;
    for (int rowb = gw; rowb < 32768; rowb += 4 * ngw) {
        float4 aa[4][4];
#pragma unroll
        for (int rr = 0; rr < 4; ++rr) { const int row = rowb + rr * ngw < 32768 ? rowb + rr * ngw : rowb; const float4* src = (const float4*)((row >= 16384 ? p.peer_v : p.peer_u) + (size_t)(row & 16383) * D) + 4 * lane;
#pragma unroll
            for (int i = 0; i < 4; ++i) aa[rr][i] = src[i]; }
#pragma unroll
        for (int rr = 0; rr < 4; ++rr) {
            const int row = rowb + rr * ngw;
            if (row < 32768) {
                const bool isv = row >= 16384; const int r = row & 16383;
                float mx = 0.f;
#pragma unroll
                for (int i = 0; i < 4; ++i) mx = fmaxf(mx, fmaxf(fmaxf(fabsf(aa[rr][i].x), fabsf(aa[rr][i].y)), fmaxf(fabsf(aa[rr][i].z), fabsf(aa[rr][i].w))));
                mx = wave_max(mx);
                const float inv = mx > 0.f ? 127.f / mx : 0.f, sc = mx > 0.f ? mx * (1.f / 127.f) : 1.f;
                u32x4 w;
#pragma unroll
                for (int i = 0; i < 4; ++i) w[i] = ((unsigned)__float2int_rn(aa[rr][i].x * inv) & 0xffu) | (((unsigned)__float2int_rn(aa[rr][i].y * inv) & 0xffu) << 8) | (((unsigned)__float2int_rn(aa[rr][i].z * inv) & 0xffu) << 16) | ((unsigned)__float2int_rn(aa[rr][i].w * inv) << 24);
                ((u32x4*)(p.ws + (isv ? WS_TV : WS_TU) + (size_t)r * 1024))[lane] = w;
                if (lane == 0) ((float*)(p.ws + (isv ? WS_ISV : WS_ISU)))[r] = sc;
            }
        }
    }
    for (size_t g = gt; g < 4096; g += ngt) {
        const float4 a = ((const float4*)p.sub_keys)[2 * g], b = ((const float4*)p.sub_keys)[2 * g + 1];
        u32x4 w; w.x = pk2(a.x, a.y); w.y = pk2(a.z, a.w); w.z = pk2(b.x, b.y); w.w = pk2(b.z, b.w);
        ((u32x4*)(p.ws + WS_SK))[g] = w;
    }
    float2* rope = (float2*)(p.ws + WS_ROPE);
    for (size_t e = gt; e < 16384 * 32; e += ngt) {
        const int pos = (int)(e >> 5), i = (int)(e & 31);
        const float inv = (float)exp2(-(double)i * (13.287712379549449 / 32.0));
        const float ang = (float)pos * inv;
        const double a = (double)ang; const double n = rint(a * 0.15915494309189535); const double r = a - n * 6.283185307179586;
        float s, c; sincosf((float)r, &s, &c);
        rope[e] = make_float2(c, s);
    }
}

DEV void stage_norm1(const Params& p, char* lds, int vb, int nvb) {
    const int tid = threadIdx.x, lane = tid & 63, wave = __builtin_amdgcn_readfirstlane(tid >> 6);
    float* wg = (float*)lds;
    for (int i = tid; i < 8192; i += NTH) { const int cc = i >> 10, k = i & 1023; wg[i] = p.w_in[(size_t)k * 4872 + 2816 + cc]; }
    __syncthreads();
    const float* mod = (const float*)(p.ws + WS_MOD);
    bf16_t* ub = (bf16_t*)(p.ws + WS_UB);
    float* ipre = (float*)(p.ws + WS_IPRE); float* fpre = (float*)(p.ws + WS_FPRE);
    const int rstride = nvb * NW;
    for (int mb = vb * NW + wave; mb < M; mb += 2 * rstride) {
        float4 vv[2][4];
#pragma unroll
        for (int rr = 0; rr < 2; ++rr) { const int mr = mb + rr * rstride < M ? mb + rr * rstride : mb; const float4* xr = (const float4*)(p.x + (size_t)mr * D);
#pragma unroll
            for (int j = 0; j < 4; ++j) vv[rr][j] = xr[lane + 64 * j]; }
#pragma unroll
        for (int rr = 0; rr < 2; ++rr) {
        const int m = mb + rr * rstride;
        if (m < M) {
        const int b = m >= SEQ ? 1 : 0;
        float4 v[4]; float ss = 0.f;
#pragma unroll
        for (int j = 0; j < 4; ++j) { v[j] = vv[rr][j]; ss += v[j].x * v[j].x + v[j].y * v[j].y + v[j].z * v[j].z + v[j].w * v[j].w; }
        ss = wave_sum(ss);
        const float rstd = rsqrtf(ss * (1.f / 1024.f) + 1e-6f);
        float ga[8];
#pragma unroll
        for (int cc = 0; cc < 8; ++cc) ga[cc] = 0.f;
#pragma unroll
        for (int j = 0; j < 4; ++j) {
            const int col = 4 * (lane + 64 * j);
            const float4 w1 = *(const float4*)(p.norm1_w + col), sc = *(const float4*)(mod + b * 6144 + 1024 + col), sh = *(const float4*)(mod + b * 6144 + col);
            float4 u;
            u.x = v[j].x * rstd * w1.x * (1.f + sc.x) + sh.x; u.y = v[j].y * rstd * w1.y * (1.f + sc.y) + sh.y;
            u.z = v[j].z * rstd * w1.z * (1.f + sc.z) + sh.z; u.w = v[j].w * rstd * w1.w * (1.f + sc.w) + sh.w;
            u32x2 o; o.x = pk2(u.x, u.y); o.y = pk2(u.z, u.w);
            *(u32x2*)(ub + (size_t)m * D + col) = o;
#pragma unroll
            for (int cc = 0; cc < 8; ++cc) { const float4 g = *(const float4*)(wg + cc * 1024 + col); ga[cc] += u.x * g.x + u.y * g.y + u.z * g.z + u.w * g.w; }
        }
        {
            const bool h32 = (lane & 32) != 0, h16 = (lane & 16) != 0, h8 = (lane & 8) != 0;
            float k4[4], k2[2];
#pragma unroll
            for (int i = 0; i < 4; ++i) k4[i] = (h32 ? ga[4 + i] : ga[i]) + __shfl_xor(h32 ? ga[i] : ga[4 + i], 32);
#pragma unroll
            for (int i = 0; i < 2; ++i) k2[i] = (h16 ? k4[2 + i] : k4[i]) + __shfl_xor(h16 ? k4[i] : k4[2 + i], 16);
            float k1 = (h8 ? k2[1] : k2[0]) + __shfl_xor(h8 ? k2[0] : k2[1], 8);
            k1 += __shfl_xor(k1, 4); k1 += __shfl_xor(k1, 2); k1 += __shfl_xor(k1, 1);
            const int cc = (lane >> 3) & 7;
            if ((lane & 7) == 0) { if (cc < 4) ipre[(size_t)m * 4 + cc] = k1 + p.i_bias[cc]; else fpre[(size_t)m * 4 + cc - 4] = k1 + p.f_bias[cc - 4]; }
        }
        }
        }
    }
}

namespace pg8 {
#define PG8_LAS __attribute__((address_space(3)))
typedef unsigned short bf16_t;
typedef short bf16x8 __attribute__((ext_vector_type(8)));
typedef float f32x4 __attribute__((ext_vector_type(4)));
typedef unsigned u32x4 __attribute__((ext_vector_type(4)));
constexpr int BM = 256, BK = 64, HALF = 128, HTB = HALF * BK * 2  , STAGE_BYTES = 8 * HTB, NXCD = 8, WGM = 8;

__host__ __device__ __forceinline__ int lds_byte(int r, int c) { const int st = (r >> 4) * 2 + (c >> 5), rr = r & 15, cc = c & 31, ob = rr * 64 + cc * 2; return st * 1024 + (ob ^ (((ob >> 9) & 1) << 5)); }
__host__ __device__ __forceinline__ void stage_rc(int b, int& R, int& C) { const int st = b / 1024, sb = b % 1024, swz = sb ^ (((sb >> 9) & 1) << 5); R = (st >> 1) * 16 + swz / 64; C = (st & 1) * 32 + (swz % 64) / 2; }
__host__ __device__ __forceinline__ int perm32(int rho) { const int n = rho >> 4, i = rho & 15; return 8 * (i >> 2) + 4 * n + (i & 3); }

struct Unit { int pm, pn; };
struct Gemm { const bf16_t* A; const bf16_t* Bt; int M, N, K, lda, ldb; };

struct StaticOrder {
    int nM, nN, nwg, G, c;
    __host__ __device__ void init(int M, int N, int G_, int c_) { nM = M / BM; nN = N / BM; nwg = nM * nN; G = G_; c = c_; }
    __host__ __device__ bool next(int i, Unit& u) const {
        const long L = (long)i * G + c; if (L >= nwg) return false;
        int wgid = (int)L; { const int q = nwg / NXCD, r = nwg % NXCD, xcd = wgid % NXCD, off = wgid / NXCD; wgid = (xcd < r ? xcd * (q + 1) : r * (q + 1) + (xcd - r) * q) + off; }
        const int nig = WGM * nN, gid = wgid / nig, fm = gid * WGM, gsz = (nM - fm) < WGM ? (nM - fm) : WGM;
        u.pm = fm + ((wgid % nig) % gsz); u.pn = (wgid % nig) / gsz; return true;
    }
    __device__ __forceinline__ void a_ready(const Unit&) const {}
    __device__ __forceinline__ void done(const Unit&) const {}
};

__device__ __forceinline__ unsigned cvt_pk_bf16(float lo, float hi) { unsigned r; asm volatile("v_cvt_pk_bf16_f32 %0, %1, %2" : "=v"(r) : "v"(lo), "v"(hi)); return r; }
__device__ __forceinline__ float sg_(float v) { return __builtin_amdgcn_rcpf(1.f + __expf(-v)); }
struct EpiIn {
    static constexpr bool PERM = true, AFTER_DRAIN = false;
    bf16_t *PA, *PM, *PG;
    __device__ __forceinline__ void operator()(const f32x4 (&acc)[2][2][4][2], const Unit& u, int wr, int wc, int fr, int fq) const {
        const int colt = u.pn * BM; bf16_t* base; int ldc, cb;
        if (colt < 768) { base = PA; ldc = 768; cb = colt; } else if (colt < 2816) { base = PM; ldc = 2048; cb = colt - 768; } else { base = PG; ldc = 2048; cb = colt - 2816; }
        const int row0 = u.pm * BM + wr * 64 + fr, col0 = cb + wc * 32 + 8 * fq;
#pragma unroll
        for (int ai = 0; ai < 2; ++ai)
#pragma unroll
            for (int m = 0; m < 4; ++m) { bf16_t* rowp = base + (size_t)(row0 + ai * HALF + m * 16) * ldc + col0;
#pragma unroll
                for (int bj = 0; bj < 2; ++bj) { const f32x4 v0 = acc[ai][bj][m][0], v1 = acc[ai][bj][m][1];
                    u32x4 w; w.x = cvt_pk_bf16(v0[0], v0[1]); w.y = cvt_pk_bf16(v0[2], v0[3]); w.z = cvt_pk_bf16(v1[0], v1[1]); w.w = cvt_pk_bf16(v1[2], v1[3]);
                    *(u32x4*)(rowp + bj * HALF) = w; } }
    }
};
struct EpiMerge {
    static constexpr bool PERM = true, AFTER_DRAIN = false;
    const bf16_t* G; bf16_t* MG; int second;
    __device__ __forceinline__ void operator()(const f32x4 (&acc)[2][2][4][2], const Unit& u, int wr, int wc, int fr, int fq) const {
        const int row0 = u.pm * BM + wr * 64 + fr, col0 = u.pn * BM + wc * 32 + 8 * fq;
#pragma unroll
        for (int bj = 0; bj < 2; ++bj)
#pragma unroll
        for (int ai = 0; ai < 2; ++ai) {
            const int col = col0 + bj * HALF;
            u32x4 gv[4], tv[4];
#pragma unroll
            for (int m = 0; m < 4; ++m) { const size_t row = (size_t)(row0 + ai * HALF + m * 16); gv[m] = *(const u32x4*)(G + row * 2048 + col); tv[m] = second ? *(const u32x4*)(MG + row * 1024 + col) : (u32x4){0u, 0u, 0u, 0u}; }
#pragma unroll
            for (int m = 0; m < 4; ++m) { const size_t row = (size_t)(row0 + ai * HALF + m * 16);
                const f32x4 v0 = acc[ai][bj][m][0], v1 = acc[ai][bj][m][1]; const u32x4 g = gv[m], t = tv[m];
                float r[8];
                r[0] = sg_(__uint_as_float(g.x << 16)) * v0[0] + __uint_as_float(t.x << 16); r[1] = sg_(__uint_as_float(g.x & 0xffff0000u)) * v0[1] + __uint_as_float(t.x & 0xffff0000u);
                r[2] = sg_(__uint_as_float(g.y << 16)) * v0[2] + __uint_as_float(t.y << 16); r[3] = sg_(__uint_as_float(g.y & 0xffff0000u)) * v0[3] + __uint_as_float(t.y & 0xffff0000u);
                r[4] = sg_(__uint_as_float(g.z << 16)) * v1[0] + __uint_as_float(t.z << 16); r[5] = sg_(__uint_as_float(g.z & 0xffff0000u)) * v1[1] + __uint_as_float(t.z & 0xffff0000u);
                r[6] = sg_(__uint_as_float(g.w << 16)) * v1[2] + __uint_as_float(t.w << 16); r[7] = sg_(__uint_as_float(g.w & 0xffff0000u)) * v1[3] + __uint_as_float(t.w & 0xffff0000u);
                u32x4 w; w.x = cvt_pk_bf16(r[0], r[1]); w.y = cvt_pk_bf16(r[2], r[3]); w.z = cvt_pk_bf16(r[4], r[5]); w.w = cvt_pk_bf16(r[6], r[7]);
                *(u32x4*)(MG + row * 1024 + col) = w; }
        }
    }
};
struct EpiF32 {
    static constexpr bool PERM = true, AFTER_DRAIN = false;
    float* O; int ldc;
    __device__ __forceinline__ void operator()(const f32x4 (&acc)[2][2][4][2], const Unit& u, int wr, int wc, int fr, int fq) const {
        const int row0 = u.pm * BM + wr * 64 + fr, col0 = u.pn * BM + wc * 32 + 8 * fq;
#pragma unroll
        for (int ai = 0; ai < 2; ++ai)
#pragma unroll
            for (int m = 0; m < 4; ++m) { float* rowp = O + (size_t)(row0 + ai * HALF + m * 16) * ldc + col0;
#pragma unroll
                for (int bj = 0; bj < 2; ++bj) { *(f32x4*)(rowp + bj * HALF) = acc[ai][bj][m][0]; *(f32x4*)(rowp + bj * HALF + 4) = acc[ai][bj][m][1]; } }
    }
};
struct EpiOut {
    static constexpr bool PERM = true, AFTER_DRAIN = false;
    const float* x; const float* g1; float* out; int seq;
    __device__ __forceinline__ void operator()(const f32x4 (&acc)[2][2][4][2], const Unit& u, int wr, int wc, int fr, int fq) const {
        const int row0 = u.pm * BM + wr * 64 + fr, col0 = u.pn * BM + wc * 32 + 8 * fq;
        const float* gp = g1 + (u.pm * BM >= seq ? 6144 : 0);
#pragma unroll
        for (int bj = 0; bj < 2; ++bj) { const int col = col0 + bj * HALF; const f32x4 ga = *(const f32x4*)(gp + col), gb = *(const f32x4*)(gp + col + 4);
#pragma unroll
            for (int ai = 0; ai < 2; ++ai) {
                f32x4 xa[4], xb[4];
#pragma unroll
                for (int m = 0; m < 4; ++m) { const size_t off = (size_t)(row0 + ai * HALF + m * 16) * 1024 + col; xa[m] = *(const f32x4*)(x + off); xb[m] = *(const f32x4*)(x + off + 4); }
#pragma unroll
                for (int m = 0; m < 4; ++m) { const size_t off = (size_t)(row0 + ai * HALF + m * 16) * 1024 + col;
                    *(f32x4*)(out + off) = xa[m] + ga * acc[ai][bj][m][0]; *(f32x4*)(out + off + 4) = xb[m] + gb * acc[ai][bj][m][1]; } } }
    }
};

template <class Epi, class Sched, bool ALIGN_EPI = false, bool SP2 = false>
__device__ __forceinline__ void gemm_phase(PG8_LAS unsigned char* lds, const Gemm g, const Sched& S, const Epi& E) {
    const int tid = threadIdx.x, wid = __builtin_amdgcn_readfirstlane(tid >> 6), lane = tid & 63, wr = wid >> 2, wc = wid & 3, fr = lane & 15, fq = lane >> 4;
    const int K = g.K, nt = K / BK;
    unsigned voffA[2], voffB[2];
#pragma unroll
    for (int i = 0; i < 2; ++i) { int R, C; stage_rc(tid * 16 + i * 8192, R, C); const int Rb = Epi::PERM ? ((R & ~31) + perm32(R & 31)) : R;
        voffA[i] = (unsigned)(R * g.lda + C) * 2u; voffB[i] = (unsigned)(Rb * g.ldb + C) * 2u; }
    const size_t kstep = (size_t)(BK * 2);
    const size_t hstepA = (size_t)HALF * g.lda * 2, hstepB = (size_t)HALF * g.ldb * 2;
    const size_t tstepA = 2 * hstepA, tstepB = 2 * hstepB;
    const unsigned ldsw = (unsigned)wid * 1024u;
    const int aoff = lds_byte(wr * 64 + fr, fq * 8), boff = lds_byte(wc * 32 + fr, fq * 8);
#define PG8_SA(b, h) (((b) * 2 + (h)) * HTB)
#define PG8_SB(b, h) ((4 + (b) * 2 + (h)) * HTB)
#define PG8_STAGE(bufoff, gbase, voff) do { _Pragma("unroll") for (int _i = 0; _i < 2; ++_i) \
        __builtin_amdgcn_global_load_lds((const unsigned*)((const char*)(gbase) + (voff)[_i]), (PG8_LAS unsigned*)(lds + (bufoff) + ldsw + _i * 8192), 16, 0, 0); } while (0)
#define PG8_LDA(dst, b, h) do { _Pragma("unroll") for (int m = 0; m < 4; ++m) _Pragma("unroll") for (int k = 0; k < 2; ++k) dst[m][k] = *(const PG8_LAS bf16x8*)(lds + PG8_SA(b, h) + aoff + m * 2048 + k * 1024); } while (0)
#define PG8_LDB(dst, b, h) do { _Pragma("unroll") for (int n = 0; n < 2; ++n) _Pragma("unroll") for (int k = 0; k < 2; ++k) dst[n][k] = *(const PG8_LAS bf16x8*)(lds + PG8_SB(b, h) + boff + n * 2048 + k * 1024); } while (0)
#define PG8_MMA(ai, bj, At, Bt) do { __builtin_amdgcn_s_setprio(1); _Pragma("unroll") for (int m = 0; m < 4; ++m) _Pragma("unroll") for (int n = 0; n < 2; ++n) _Pragma("unroll") for (int k = 0; k < 2; ++k) \
        acc[ai][bj][m][n] = __builtin_amdgcn_mfma_f32_16x16x32_bf16(Bt[n][k], At[m][k], acc[ai][bj][m][n], 0, 0, 0); __builtin_amdgcn_s_setprio(0); } while (0)
#define PG8_WAIT_V(n) asm volatile("s_waitcnt vmcnt(" #n ")" ::: "memory")
#define PG8_WAIT_L(n) asm volatile("s_waitcnt lgkmcnt(" #n ")" ::: "memory")
#define PG8_BAR __builtin_amdgcn_s_barrier()
#define PG8_SCHED __builtin_amdgcn_sched_barrier(0)
    Unit cur, nxt; int ui = 0;
    if (!S.next(0, cur)) return;
    f32x4 acc[2][2][4][2];
#pragma unroll
    for (int a = 0; a < 2; ++a)
#pragma unroll
        for (int b = 0; b < 2; ++b)
#pragma unroll
            for (int m = 0; m < 4; ++m)
#pragma unroll
                for (int n = 0; n < 2; ++n) acc[a][b][m][n] = (f32x4){0.f, 0.f, 0.f, 0.f};
    bf16x8 At[4][2], B0[2][2], B1[2][2];
    const char* cA = (const char*)g.A + (size_t)cur.pm * tstepA; const char* cB = (const char*)g.Bt + (size_t)cur.pn * tstepB;
    S.a_ready(cur);
    if constexpr (SP2) {
        PG8_STAGE(PG8_SB(0, 0), cB, voffB); PG8_STAGE(PG8_SB(0, 1), cB + hstepB, voffB); PG8_STAGE(PG8_SA(0, 0), cA, voffA); PG8_STAGE(PG8_SA(0, 1), cA + hstepA, voffA);
        if (wr == 1) PG8_BAR;
        PG8_WAIT_V(2); PG8_BAR;
        PG8_STAGE(PG8_SB(1, 0), cB + kstep, voffB); PG8_STAGE(PG8_SA(1, 0), cA + kstep, voffA); PG8_STAGE(PG8_SB(1, 1), cB + hstepB + kstep, voffB);
        PG8_WAIT_V(6); PG8_BAR;
    } else {
        PG8_STAGE(PG8_SB(0, 0), cB, voffB); PG8_STAGE(PG8_SA(0, 0), cA, voffA); PG8_STAGE(PG8_SB(0, 1), cB + hstepB, voffB); PG8_STAGE(PG8_SA(0, 1), cA + hstepA, voffA);
        if (wr == 1) PG8_BAR;
        PG8_WAIT_V(4); PG8_BAR;
        PG8_STAGE(PG8_SB(1, 0), cB + kstep, voffB); PG8_STAGE(PG8_SA(1, 0), cA + kstep, voffA); PG8_STAGE(PG8_SB(1, 1), cB + hstepB + kstep, voffB);
        PG8_WAIT_V(6); PG8_BAR;
    }
    for (;;) {
        const bool has_next = S.next(ui + 1, nxt);
        const char* nA = has_next ? (const char*)g.A + (size_t)nxt.pm * tstepA : cA; const char* nB = has_next ? (const char*)g.Bt + (size_t)nxt.pn * tstepB : cB;
        for (int t = 0; t < nt; t += 2) {
            const bool last = (t == nt - 2);
            const char* a1 = cA + (size_t)(t + 1) * kstep;
            const char* a2 = last ? nA : cA + (size_t)(t + 2) * kstep; const char* b2 = last ? nB : cB + (size_t)(t + 2) * kstep;
            const char* a3 = a2 + kstep; const char* b3 = b2 + kstep;
            if (last && has_next) S.a_ready(nxt);
            if constexpr (SP2) {
            PG8_LDB(B0, 0, 0); PG8_LDB(B1, 0, 1); PG8_SCHED; PG8_LDA(At, 0, 0); PG8_STAGE(PG8_SA(1, 1), a1 + hstepA, voffA);
            PG8_WAIT_V(8); PG8_WAIT_L(0); PG8_BAR; PG8_MMA(0, 0, At, B0); PG8_MMA(0, 1, At, B1); PG8_BAR; PG8_SCHED;
            PG8_LDA(At, 0, 1); PG8_STAGE(PG8_SB(0, 0), b2, voffB); PG8_STAGE(PG8_SB(0, 1), b2 + hstepB, voffB); PG8_STAGE(PG8_SA(0, 0), a2, voffA);
            PG8_WAIT_V(8); PG8_WAIT_L(0); PG8_BAR; PG8_MMA(1, 0, At, B0); PG8_MMA(1, 1, At, B1); PG8_BAR; PG8_SCHED;
            PG8_LDB(B0, 1, 0); PG8_LDB(B1, 1, 1); PG8_SCHED; PG8_LDA(At, 1, 0); PG8_STAGE(PG8_SA(0, 1), a2 + hstepA, voffA);
            PG8_WAIT_V(8); PG8_WAIT_L(0); PG8_BAR; PG8_MMA(0, 0, At, B0); PG8_MMA(0, 1, At, B1); PG8_BAR; PG8_SCHED;
            PG8_LDA(At, 1, 1); PG8_STAGE(PG8_SB(1, 0), b3, voffB); PG8_STAGE(PG8_SB(1, 1), b3 + hstepB, voffB); PG8_STAGE(PG8_SA(1, 0), a3, voffA);
            PG8_WAIT_V(8); PG8_WAIT_L(0); PG8_BAR; PG8_MMA(1, 0, At, B0); PG8_MMA(1, 1, At, B1); PG8_BAR; PG8_SCHED;
            } else {
            PG8_LDB(B0, 0, 0); PG8_SCHED; PG8_LDA(At, 0, 0); PG8_STAGE(PG8_SA(1, 1), a1 + hstepA, voffA);
            PG8_WAIT_L(8); PG8_BAR; PG8_WAIT_L(0); PG8_MMA(0, 0, At, B0); PG8_BAR; PG8_SCHED;
            PG8_LDB(B1, 0, 1); PG8_STAGE(PG8_SB(0, 0), b2, voffB);
            PG8_BAR; PG8_WAIT_L(0); PG8_MMA(0, 1, At, B1); PG8_BAR;
            PG8_LDA(At, 0, 1); PG8_STAGE(PG8_SA(0, 0), a2, voffA);
            PG8_BAR; PG8_WAIT_L(0); PG8_MMA(1, 0, At, B0); PG8_BAR; PG8_SCHED;
            PG8_STAGE(PG8_SB(0, 1), b2 + hstepB, voffB);
            PG8_WAIT_V(6); PG8_BAR; PG8_MMA(1, 1, At, B1); PG8_BAR;
            PG8_LDB(B0, 1, 0); PG8_SCHED; PG8_LDA(At, 1, 0); PG8_STAGE(PG8_SA(0, 1), a2 + hstepA, voffA);
            PG8_WAIT_L(8); PG8_BAR; PG8_WAIT_L(0); PG8_MMA(0, 0, At, B0); PG8_BAR; PG8_SCHED;
            PG8_LDB(B1, 1, 1); PG8_STAGE(PG8_SB(1, 0), b3, voffB);
            PG8_BAR; PG8_WAIT_L(0); PG8_MMA(0, 1, At, B1); PG8_BAR;
            PG8_LDA(At, 1, 1); PG8_STAGE(PG8_SA(1, 0), a3, voffA);
            PG8_BAR; PG8_WAIT_L(0); PG8_MMA(1, 0, At, B0); PG8_BAR; PG8_SCHED;
            PG8_STAGE(PG8_SB(1, 1), b3 + hstepB, voffB);
            PG8_WAIT_V(6); PG8_BAR; PG8_MMA(1, 1, At, B1); PG8_BAR;
            }
        }
        if constexpr (ALIGN_EPI) { if (wr == 0) PG8_BAR; }
        if constexpr (!Epi::AFTER_DRAIN) { E(acc, cur, wr, wc, fr, fq); S.done(cur); }
        if (!has_next) break;
#pragma unroll
        for (int a = 0; a < 2; ++a)
#pragma unroll
            for (int b = 0; b < 2; ++b)
#pragma unroll
                for (int m = 0; m < 4; ++m)
#pragma unroll
                    for (int n = 0; n < 2; ++n) acc[a][b][m][n] = (f32x4){0.f, 0.f, 0.f, 0.f};
        cur = nxt; cA = nA; cB = nB; ++ui;
        if constexpr (ALIGN_EPI) { if (wr == 1) PG8_BAR; }
    }
    PG8_WAIT_V(0);
    if constexpr (!ALIGN_EPI) { if (wr == 0) PG8_BAR; }
    PG8_BAR;
    if constexpr (Epi::AFTER_DRAIN) { E.fused(acc, cur, wr, wc, fr, fq, lds, wid, lane); S.done(cur); }
#undef PG8_SA
#undef PG8_SB
#undef PG8_STAGE
#undef PG8_LDA
#undef PG8_LDB
#undef PG8_MMA
#undef PG8_WAIT_V
#undef PG8_WAIT_L
#undef PG8_BAR
#undef PG8_SCHED
}
}

DEV void stage_gemm_in(const Params& p, char* lds, int vb, int nvb) {
    pg8::Gemm g{(const bf16_t*)(p.ws + WS_UB), (const bf16_t*)(p.ws + WS_WIN), M, 4864, 1024, 1024, 1024};
    pg8::StaticOrder S; S.init(M, 4864, nvb, vb);
    pg8::EpiIn E{(bf16_t*)(p.ws + WS_PA), (bf16_t*)(p.ws + WS_PM), (bf16_t*)(p.ws + WS_PG)};
    pg8::gemm_phase<pg8::EpiIn, pg8::StaticOrder, true, true>((PG8_LAS unsigned char*)lds, g, S, E);
}
DEV void stage_gemm_merge(const Params& p, char* lds, int vb, int nvb) {
    const bf16_t* PG = (const bf16_t*)(p.ws + WS_PG); bf16_t* MG = (bf16_t*)(p.ws + WS_UB);
    {
        pg8::Gemm g{(const bf16_t*)(p.ws + WS_PA), (const bf16_t*)(p.ws + WS_WA), M, 1024, 512, LPA, 512};
        pg8::StaticOrder S; S.init(M, 1024, nvb, vb);
        pg8::EpiMerge E{PG, MG, 0};
        pg8::gemm_phase<pg8::EpiMerge, pg8::StaticOrder, true, true>((PG8_LAS unsigned char*)lds, g, S, E);
    }
    {
        pg8::Gemm g{(const bf16_t*)(p.ws + WS_PM) + 1536, (const bf16_t*)(p.ws + WS_WB), M, 1024, 512, LPM, 512};
        pg8::StaticOrder S; S.init(M, 1024, nvb, vb);
        pg8::EpiMerge E{PG + 1024, MG, 1};
        pg8::gemm_phase<pg8::EpiMerge, pg8::StaticOrder, true, true>((PG8_LAS unsigned char*)lds, g, S, E);
    }
}
DEV void stage_gemm_out(const Params& p, char* lds, int vb, int nvb) {
    pg8::Gemm g{(const bf16_t*)(p.ws + WS_UB), (const bf16_t*)(p.ws + WS_WOUT), M, 1024, 1024, 1024, 1024};
    pg8::StaticOrder S; S.init(M, 1024, nvb, vb);
    pg8::EpiOut E{p.x, (const float*)(p.ws + WS_MOD) + 2048, p.out, SEQ};
    pg8::gemm_phase<pg8::EpiOut, pg8::StaticOrder, true, true>((PG8_LAS unsigned char*)lds, g, S, E);
}

DEV void rope8(u32x4 x1, u32x4 x2, const float4* rp, float scale, u32x4& o1, u32x4& o2) {
#pragma unroll
    for (int w = 0; w < 4; ++w) {
        const float4 cs = rp[w];
        const float a0 = bflo(x1[w]), a1 = bfhi(x1[w]), b0 = bflo(x2[w]), b1 = bfhi(x2[w]);
        o1[w] = pk2((a0 * cs.x - b0 * cs.y) * scale, (a1 * cs.z - b1 * cs.w) * scale);
        o2[w] = pk2((b0 * cs.x + a0 * cs.y) * scale, (b1 * cs.z + a1 * cs.w) * scale);
    }
}

DEV void stage_attn(const Params& p, char* lds, int vb, int nvb) {
    const int tid = threadIdx.x, lane = tid & 63, wave = __builtin_amdgcn_readfirstlane(tid >> 6), fr = lane & 15, fq = lane >> 4;
    char* Ks = lds;
    char* VT = lds + 32768;
    char* Qs = lds + 70656;
    char* Ps = lds + 87040;
    bf16_t* PA = (bf16_t*)(p.ws + WS_PA);
    const float2* rope = (const float2*)(p.ws + WS_ROPE);
    for (int unit = vb; unit < 512; unit += nvb) {
        const int kvh = unit & 1, n = (unit >> 1) & 127, b = unit >> 8;
        __syncthreads();
        for (int task = tid; task < 1024; task += NTH) {
            const int ki = task >> 2, cp = task & 3, pos = 128 * (n - 1) + ki;
            u32x4 o1, o2;
            {
                const int pc = pos < 0 ? 0 : pos;
                const bf16_t* src = PA + (size_t)(b * SEQ + pc) * LPA + 512 + kvh * 64 + cp * 8;
                const u32x4 x1 = *(const u32x4*)src, x2 = *(const u32x4*)(src + 32);
                rope8(x1, x2, (const float4*)(rope + (size_t)pc * 32 + cp * 8), 1.0f, o1, o2);
                if (pos < 0) { o1 = (u32x4){0u, 0u, 0u, 0u}; o2 = o1; }
            }
            const int sw = ki & 7;
            *(u32x4*)(Ks + ki * 128 + ((cp ^ sw) << 4)) = o1;
            *(u32x4*)(Ks + ki * 128 + (((cp + 4) ^ sw) << 4)) = o2;
        }
        for (int task = tid; task < 2048; task += NTH) {
            const int ki = task >> 3, c = task & 7, pos = 128 * (n - 1) + ki;
            u32x4 x = *(const u32x4*)(PA + (size_t)(b * SEQ + (pos < 0 ? 0 : pos)) * LPA + 640 + kvh * 64 + c * 8);
            if (pos < 0) x = (u32x4){0u, 0u, 0u, 0u};
#pragma unroll
            for (int e = 0; e < 8; ++e) *(bf16_t*)(VT + (c * 8 + e) * 592 + ki * 2) = (bf16_t)((e & 1) ? (x[e >> 1] >> 16) : (x[e >> 1] & 0xffffu));
        }
        for (int i = tid; i < 64 * 40; i += NTH) { const int d = i / 40, kk = 256 + i % 40; *(bf16_t*)(VT + d * 592 + kk * 2) = 0; }
        for (int i = tid; i < 2048; i += NTH) { const int w = i >> 8, r = (i >> 4) & 15, kk = 144 + (i & 15); *(bf16_t*)(Ps + w * 5376 + r * 336 + kk * 2) = 0; }
        for (int j = 0; j < 4; ++j) {
            const int hq = kvh * 4 + j;
            {
                const int qi = tid >> 2, cp = tid & 3, pos = 128 * n + qi;
                const bf16_t* src = PA + (size_t)(b * SEQ + pos) * LPA + hq * 64 + cp * 8;
                const u32x4 x1 = *(const u32x4*)src, x2 = *(const u32x4*)(src + 32);
                u32x4 o1, o2;
                rope8(x1, x2, (const float4*)(rope + (size_t)pos * 32 + cp * 8), 0.125f, o1, o2);
                const int sw = qi & 7;
                *(u32x4*)(Qs + qi * 128 + ((cp ^ sw) << 4)) = o1;
                *(u32x4*)(Qs + qi * 128 + (((cp + 4) ^ sw) << 4)) = o2;
            }
            __syncthreads();
            f32x4 s[9];
            const int sw = fr & 7;
            bf16x8 qf[2];
#pragma unroll
            for (int ks = 0; ks < 2; ++ks) qf[ks] = *(const bf16x8*)(Qs + (16 * wave + fr) * 128 + (((fq + 4 * ks) ^ sw) << 4));
#pragma unroll
            for (int t = 0; t < 9; ++t) {
                s[t] = (f32x4){0.f, 0.f, 0.f, 0.f};
#pragma unroll
                for (int ks = 0; ks < 2; ++ks) { const bf16x8 kf = *(const bf16x8*)(Ks + (16 * (wave + t) + fr) * 128 + (((fq + 4 * ks) ^ sw) << 4)); s[t] = mfma16(kf, qf[ks], s[t]); }
            }
            const float sink = p.sinks[hq];
            float mx = sink;
#pragma unroll
            for (int t = 0; t < 9; ++t)
#pragma unroll
                for (int r = 0; r < 4; ++r) {
                    const int dd = 16 * t + 4 * fq + r - fr, ki = 16 * (wave + t) + 4 * fq + r;
                    const bool ok = (dd >= 1) && (dd <= 128) && (n > 0 || ki >= 128);
                    const float v = ok ? s[t][r] : -INFINITY;
                    s[t][r] = v; mx = fmaxf(mx, v);
                }
            mx = fmaxf(mx, __shfl_xor(mx, 16)); mx = fmaxf(mx, __shfl_xor(mx, 32));
            float sum = 0.f;
#pragma unroll
            for (int t = 0; t < 9; ++t)
#pragma unroll
                for (int r = 0; r < 4; ++r) { const float pv = __expf(s[t][r] - mx); s[t][r] = pv; sum += pv; }
            sum += __shfl_xor(sum, 16); sum += __shfl_xor(sum, 32);
            const float inv = 1.f / (sum + __expf(sink - mx));
            char* Pw = Ps + wave * 5376 + fr * 336;
#pragma unroll
            for (int t = 0; t < 9; ++t) { u32x2 o; o.x = pk2(s[t][0], s[t][1]); o.y = pk2(s[t][2], s[t][3]); *(u32x2*)(Pw + (16 * t + 4 * fq) * 2) = o; }
            __syncthreads();
            f32x4 o[4];
#pragma unroll
            for (int di = 0; di < 4; ++di) o[di] = (f32x4){0.f, 0.f, 0.f, 0.f};
#pragma unroll
            for (int ks = 0; ks < 5; ++ks) {
                const bf16x8 pf = *(const bf16x8*)(Pw + (32 * ks + 8 * fq) * 2);
#pragma unroll
                for (int di = 0; di < 4; ++di) { const bf16x8 vf = *(const bf16x8*)(VT + (16 * di + fr) * 592 + (16 * wave + 32 * ks + 8 * fq) * 2); o[di] = mfma16(vf, pf, o[di]); }
            }
            bf16_t* dst = PA + (size_t)(b * SEQ + 128 * n + 16 * wave + fr) * LPA + hq * 64 + 4 * fq;
#pragma unroll
            for (int di = 0; di < 4; ++di) { u32x2 w; w.x = pk2(o[di][0] * inv, o[di][1] * inv); w.y = pk2(o[di][2] * inv, o[di][3] * inv); *(u32x2*)(dst + 16 * di) = w; }
            __syncthreads();
        }
    }
}

DEV float logsigf(float x) { return fminf(x, 0.f) - log1pf(expf(-fabsf(x))); }

DEV void chunk_gates(const float* ipre, const float* fpre, int rowbase, int h, float* gs, int lane) {
    const int l0 = 2 * lane;
    const float i0 = ipre[(size_t)(rowbase + l0) * 4 + h], i1 = ipre[(size_t)(rowbase + l0 + 1) * 4 + h];
    const float lf0 = logsigf(fpre[(size_t)(rowbase + l0) * 4 + h]), lf1 = logsigf(fpre[(size_t)(rowbase + l0 + 1) * 4 + h]);
    const float pair = lf0 + lf1;
    float sc = pair;
#pragma unroll
    for (int o = 1; o < 64; o <<= 1) { const float t = __shfl_up(sc, o); if (lane >= o) sc += t; }
    const float b0 = (sc - pair) + lf0, b1 = b0 + lf1;
    const float g = __shfl(sc, 63);
    const float a0 = g - b0 + i0, a1 = g - b1 + i1;
    const float mloc = wave_max(fmaxf(a0, a1));
    const float ib0 = i0 - b0, ib1 = i1 - b1;
    float scm = fmaxf(ib0, ib1);
#pragma unroll
    for (int o = 1; o < 64; o <<= 1) { const float t = __shfl_up(scm, o); if (lane >= o) scm = fmaxf(scm, t); }
    float ex = __shfl_up(scm, 1); if (lane == 0) ex = -INFINITY;
    const float pm0 = fmaxf(ex, ib0), pm1 = fmaxf(pm0, ib1);
    gs[l0] = b0; gs[l0 + 1] = b1; gs[128 + l0] = ib0; gs[128 + l0 + 1] = ib1; gs[256 + l0] = a0; gs[256 + l0 + 1] = a1; gs[384 + l0] = pm0; gs[384 + l0 + 1] = pm1;
    if (lane == 0) { gs[512] = g; gs[513] = mloc; }
}

DEV void conv8(const bf16_t* PM, const float* cw, int b, int t, int pmcol, int cch, float (&out)[8]) {
#pragma unroll
    for (int e = 0; e < 8; ++e) out[e] = 0.f;
#pragma unroll
    for (int j = 0; j < 4; ++j) {
        const int tt = t - 3 + j; const int tc = tt < 0 ? 0 : tt; const float z = tt < 0 ? 0.f : 1.f;
        const u32x4 x = *(const u32x4*)(PM + (size_t)(b * SEQ + tc) * LPM + pmcol);
        float4 w0 = *(const float4*)(cw + j * 1024 + cch), w1 = *(const float4*)(cw + j * 1024 + cch + 4);
        w0.x *= z; w0.y *= z; w0.z *= z; w0.w *= z; w1.x *= z; w1.y *= z; w1.z *= z; w1.w *= z;
        out[0] += bflo(x[0]) * w0.x; out[1] += bfhi(x[0]) * w0.y; out[2] += bflo(x[1]) * w0.z; out[3] += bfhi(x[1]) * w0.w;
        out[4] += bflo(x[2]) * w1.x; out[5] += bfhi(x[2]) * w1.y; out[6] += bflo(x[3]) * w1.z; out[7] += bfhi(x[3]) * w1.w;
    }
}

DEV void conv8r(const u32x4 (&r)[4], const float* cwl, int ch8, int t, float (&out)[8]) {
#pragma unroll
    for (int e = 0; e < 8; ++e) out[e] = 0.f;
#pragma unroll
    for (int j = 0; j < 4; ++j) {
        const float z = (t - 3 + j) < 0 ? 0.f : 1.f;
        const float4 w0 = *(const float4*)(cwl + j * 128 + ch8), w1 = *(const float4*)(cwl + j * 128 + ch8 + 4);
        out[0] += bflo(r[j][0]) * (w0.x * z); out[1] += bfhi(r[j][0]) * (w0.y * z); out[2] += bflo(r[j][1]) * (w0.z * z); out[3] += bfhi(r[j][1]) * (w0.w * z);
        out[4] += bflo(r[j][2]) * (w1.x * z); out[5] += bfhi(r[j][2]) * (w1.y * z); out[6] += bflo(r[j][3]) * (w1.z * z); out[7] += bfhi(r[j][3]) * (w1.w * z);
    }
}
DEV float siluf_(float y) { return y * __builtin_amdgcn_rcpf(1.f + __expf(-y)); }

DEV void stage_mstate(const Params& p, char* lds, int vb, int nvb) {
    const int tid = threadIdx.x, lane = tid & 63, wave = __builtin_amdgcn_readfirstlane(tid >> 6), fr = lane & 15, fq = lane >> 4;
    char* KT = lds;
    char* VT = lds + 34816;
    float* gs = (float*)(lds + 69632); float* s_cw = (float*)(lds + 73728);
    const bf16_t* PM = (const bf16_t*)(p.ws + WS_PM);
    const float* ipre = (const float*)(p.ws + WS_IPRE); const float* fpre = (const float*)(p.ws + WS_FPRE);
    float* UT = (float*)(p.ws + WS_UB); float* NLOC = (float*)(p.ws + WS_NLOC);
    float* G = (float*)(p.ws + WS_CHG); float* MLOC = G + 1024;
    for (int unit = vb; unit < 1024; unit += nvb) {
        const int c = unit & 127, h = (unit >> 7) & 3, b = unit >> 9;
        const int rowbase = b * SEQ + c * 128;
        __syncthreads();
        if (wave == 0) chunk_gates(ipre, fpre, rowbase, h, gs, lane);
        else if (tid >= 64 && tid < 192) { const int d = tid - 64;
#pragma unroll
            for (int j = 0; j < 4; ++j) s_cw[j * 128 + d] = p.conv_w[j * 1024 + 512 + h * 128 + d]; }
        __syncthreads();
        const float mloc = gs[513];
        for (int task = tid; task < 2048; task += NTH) {
            const int l = task >> 4, ch = task & 15, t = c * 128 + l;
            u32x4 rk[4];
#pragma unroll
            for (int j = 0; j < 4; ++j) { const int tc = t - 3 + j < 0 ? 0 : t - 3 + j; rk[j] = *(const u32x4*)(PM + (size_t)(b * SEQ + tc) * LPM + 512 + h * 128 + ch * 8); }
            const u32x4 x = *(const u32x4*)(PM + (size_t)(rowbase + l) * LPM + 1024 + h * 128 + ch * 8);
            float v8[8]; conv8r(rk, s_cw, ch * 8, t, v8);
            const float wgt = __expf(gs[256 + l] - mloc) * 0.08838834764831845f;
#pragma unroll
            for (int e = 0; e < 8; ++e) *(bf16_t*)(KT + (ch * 8 + e) * 272 + l * 2) = (bf16_t)f2bf(siluf_(v8[e]) * wgt);
#pragma unroll
            for (int e = 0; e < 8; ++e) *(bf16_t*)(VT + (ch * 8 + e) * 272 + l * 2) = (bf16_t)((e & 1) ? (x[e >> 1] >> 16) : (x[e >> 1] & 0xffffu));
        }
        __syncthreads();
        f32x4 acc[8];
#pragma unroll
        for (int t = 0; t < 8; ++t) acc[t] = (f32x4){0.f, 0.f, 0.f, 0.f};
#pragma unroll
        for (int ks = 0; ks < 4; ++ks) {
            const bf16x8 vf = *(const bf16x8*)(VT + (16 * wave + fr) * 272 + (32 * ks + 8 * fq) * 2);
#pragma unroll
            for (int t = 0; t < 8; ++t) { const bf16x8 kf = *(const bf16x8*)(KT + (16 * t + fr) * 272 + (32 * ks + 8 * fq) * 2); acc[t] = mfma16(kf, vf, acc[t]); }
        }
        float* UTu = UT + (size_t)unit * 16384 + (16 * wave + fr) * 128 + 4 * fq;
#pragma unroll
        for (int t = 0; t < 8; ++t) *(f32x4*)(UTu + 16 * t) = acc[t];
        if (tid < 128) { float s = 0.f; for (int l = 0; l < 128; ++l) s += bf2f(*(const bf16_t*)(KT + tid * 272 + l * 2)); NLOC[unit * 128 + tid] = s; }
        if (tid == 0) { G[unit] = gs[512]; MLOC[unit] = mloc; }
    }
}

DEV void stage_mscan(const Params& p, char* lds, int vb, int nvb) {
    const int tid = threadIdx.x;
    float* s_dec = (float*)lds; float* s_scl = s_dec + 128;
    const float* UT = (const float*)(p.ws + WS_UB); const float* NLOC = (const float*)(p.ws + WS_NLOC);
    const float* G = (const float*)(p.ws + WS_CHG); const float* MLOC = G + 1024; float* MST = (float*)(p.ws + WS_CHG) + 2048;
    bf16_t* CST = (bf16_t*)(p.ws + WS_CST); float* NST = (float*)(p.ws + WS_NST);
    for (int item = vb; item < 256; item += nvb) {
        const int bh = item >> 5, part = item & 31;
        __syncthreads();
        float* s_g = s_dec + 256; float* s_ml = s_dec + 384; float* s_m = s_dec + 512;
        if (tid < 128) { s_g[tid] = G[bh * 128 + tid]; s_ml[tid] = MLOC[bh * 128 + tid]; }
        __syncthreads();
        if (tid == 0) { float m = 0.f; for (int c = 0; c < 128; ++c) { s_m[c] = m; m = fmaxf(s_g[c] + m, s_ml[c]); } s_m[128] = m; }
        __syncthreads();
        if (tid < 128) { const float m = s_m[tid], mn = s_m[tid + 1]; s_dec[tid] = expf(s_g[tid] + m - mn); s_scl[tid] = expf(s_ml[tid] - mn); if (part == 0) MST[bh * 128 + tid] = m; }
        __syncthreads();
        const int e = part * 512 + tid;
        float C = 0.f;
        const float* up = UT + (size_t)bh * 128 * 16384 + e; bf16_t* cp = CST + (size_t)bh * 128 * 16384 + e;
        for (int c = 0; c < 128; c += 32) {
            float uu[32];
#pragma unroll
            for (int i = 0; i < 32; ++i) uu[i] = up[(size_t)(c + i) * 16384];
#pragma unroll
            for (int i = 0; i < 32; ++i) { cp[(size_t)(c + i) * 16384] = (bf16_t)f2bf(C); C = s_dec[c + i] * C + s_scl[c + i] * uu[i]; }
        }
        if (part == 0 && tid < 128) { float nn = 0.f; for (int c = 0; c < 128; ++c) { NST[(bh * 128 + c) * 128 + tid] = nn; nn = s_dec[c] * nn + s_scl[c] * NLOC[(bh * 128 + c) * 128 + tid]; } }
    }
}

DEV void stage_mout(const Params& p, char* lds, int vb, int nvb) {
    const int tid = threadIdx.x, lane = tid & 63, wave = __builtin_amdgcn_readfirstlane(tid >> 6), fr = lane & 15, fq = lane >> 4;
    char* Qs = lds; char* Ks = lds + 34816; char* VT = lds + 69632; char* CT = lds + 104448;
    float* gs = (float*)(lds + 139264); float* s_nst = gs + 520; float* s_mo = gs + 648; float* s_wi = gs + 776; float* s_cw = (float*)(lds + 143360);
    bf16_t* PM = (bf16_t*)(p.ws + WS_PM);
    const float* ipre = (const float*)(p.ws + WS_IPRE); const float* fpre = (const float*)(p.ws + WS_FPRE);
    const float* MST = (const float*)(p.ws + WS_CHG) + 2048; const float* NST = (const float*)(p.ws + WS_NST);
    const bf16_t* CST = (const bf16_t*)(p.ws + WS_CST);
    for (int unit = vb; unit < 1024; unit += nvb) {
        const int c = unit & 127, h = (unit >> 7) & 3, b = unit >> 9;
        const int rowbase = b * SEQ + c * 128;
        __syncthreads();
        if (tid < 256) { const int d = tid & 127, kq = tid >> 7;
#pragma unroll
            for (int j = 0; j < 4; ++j) s_cw[kq * 512 + j * 128 + d] = p.conv_w[j * 1024 + kq * 512 + h * 128 + d]; }
        __syncthreads();
        if (wave == 0) chunk_gates(ipre, fpre, rowbase, h, gs, lane);
        for (int task = tid; task < 2048; task += NTH) {
            const int l = task >> 4, ch = task & 15, t = c * 128 + l;
            u32x4 rq[4], rk[4];
#pragma unroll
            for (int j = 0; j < 4; ++j) { const int tc = t - 3 + j < 0 ? 0 : t - 3 + j; const bf16_t* rp = PM + (size_t)(b * SEQ + tc) * LPM + h * 128 + ch * 8; rq[j] = *(const u32x4*)rp; rk[j] = *(const u32x4*)(rp + 512); }
            const u32x4 x = *(const u32x4*)(PM + (size_t)(rowbase + l) * LPM + 1024 + h * 128 + ch * 8);
            const u32x4 cst = *(const u32x4*)(CST + (size_t)unit * 16384 + l * 128 + ch * 8);
            float v8[8]; u32x4 o;
            conv8r(rq, s_cw, ch * 8, t, v8);
            o.x = pk2(siluf_(v8[0]), siluf_(v8[1])); o.y = pk2(siluf_(v8[2]), siluf_(v8[3])); o.z = pk2(siluf_(v8[4]), siluf_(v8[5])); o.w = pk2(siluf_(v8[6]), siluf_(v8[7]));
            *(u32x4*)(Qs + l * 272 + ch * 16) = o;
            conv8r(rk, s_cw + 512, ch * 8, t, v8);
            const float sc = 0.08838834764831845f;
            o.x = pk2(siluf_(v8[0]) * sc, siluf_(v8[1]) * sc); o.y = pk2(siluf_(v8[2]) * sc, siluf_(v8[3]) * sc); o.z = pk2(siluf_(v8[4]) * sc, siluf_(v8[5]) * sc); o.w = pk2(siluf_(v8[6]) * sc, siluf_(v8[7]) * sc);
            *(u32x4*)(Ks + l * 272 + ch * 16) = o;
#pragma unroll
            for (int e = 0; e < 8; ++e) *(bf16_t*)(VT + (ch * 8 + e) * 272 + l * 2) = (bf16_t)((e & 1) ? (x[e >> 1] >> 16) : (x[e >> 1] & 0xffffu));
            *(u32x4*)(CT + l * 272 + ch * 16) = cst;
        }
        if (tid < 128) s_nst[tid] = NST[unit * 128 + tid];
        __syncthreads();
        if (tid < 128) { const float mst = MST[unit]; const float bc = gs[tid]; const float mo = bc + fmaxf(mst, gs[384 + tid]); s_mo[tid] = mo; s_wi[tid] = __expf(bc + mst - mo); }
        __syncthreads();
        const int l = 16 * wave + fr;
        f32x4 s[8];
        bf16x8 qf[4];
#pragma unroll
        for (int ks = 0; ks < 4; ++ks) qf[ks] = *(const bf16x8*)(Qs + l * 272 + (32 * ks + 8 * fq) * 2);
#pragma unroll
        for (int t = 0; t < 8; ++t) {
            s[t] = (f32x4){0.f, 0.f, 0.f, 0.f};
            if (t <= wave) {
#pragma unroll
                for (int ks = 0; ks < 4; ++ks) { const bf16x8 kf = *(const bf16x8*)(Ks + (16 * t + fr) * 272 + (32 * ks + 8 * fq) * 2); s[t] = mfma16(kf, qf[ks], s[t]); }
            }
        }
        const float bl = gs[l], mol = s_mo[l];
        float dsum = 0.f;
#pragma unroll
        for (int t = 0; t < 8; ++t)
#pragma unroll
            for (int r = 0; r < 4; ++r) {
                const int si = 16 * t + 4 * fq + r; float wv = 0.f;
                if (t <= wave && si <= l) wv = __expf(bl + gs[128 + si] - mol) * s[t][r];
                s[t][r] = wv; dsum += wv;
            }
        dsum += __shfl_xor(dsum, 16); dsum += __shfl_xor(dsum, 32);
        float qn = 0.f;
        {
            const char* qrow = Qs + l * 272 + fq * 64;
#pragma unroll
            for (int i = 0; i < 4; ++i) {
                const u32x4 x = *(const u32x4*)(qrow + 16 * i); const float* nn = s_nst + fq * 32 + 8 * i;
                qn += bflo(x[0]) * nn[0] + bfhi(x[0]) * nn[1] + bflo(x[1]) * nn[2] + bfhi(x[1]) * nn[3] + bflo(x[2]) * nn[4] + bfhi(x[2]) * nn[5] + bflo(x[3]) * nn[6] + bfhi(x[3]) * nn[7];
            }
        }
        qn += __shfl_xor(qn, 16); qn += __shfl_xor(qn, 32);
        __syncthreads();
#pragma unroll
        for (int t = 0; t < 8; ++t)
            if (t <= wave + 1) { u32x2 o; o.x = pk2(s[t][0], s[t][1]); o.y = pk2(s[t][2], s[t][3]); *(u32x2*)(Ks + l * 272 + (16 * t + 4 * fq) * 2) = o; }
        __syncthreads();
        f32x4 acc[8];
#pragma unroll
        for (int t = 0; t < 8; ++t) acc[t] = (f32x4){0.f, 0.f, 0.f, 0.f};
#pragma unroll
        for (int ks = 0; ks < 4; ++ks)
#pragma unroll
            for (int t = 0; t < 8; ++t) { const bf16x8 cf = *(const bf16x8*)(CT + (16 * t + fr) * 272 + (32 * ks + 8 * fq) * 2); acc[t] = mfma16(cf, qf[ks], acc[t]); }
        const float wi = s_wi[l];
#pragma unroll
        for (int t = 0; t < 8; ++t) acc[t] = acc[t] * wi;
        const int nks = (wave + 2) >> 1;
#pragma unroll
        for (int ks = 0; ks < 4; ++ks)
            if (ks < nks) {
                const bf16x8 wf = *(const bf16x8*)(Ks + l * 272 + (32 * ks + 8 * fq) * 2);
#pragma unroll
                for (int t = 0; t < 8; ++t) { const bf16x8 vf = *(const bf16x8*)(VT + (16 * t + fr) * 272 + (32 * ks + 8 * fq) * 2); acc[t] = mfma16(vf, wf, acc[t]); }
            }
        const float den = dsum + wi * qn;
        const float invd = 1.f / fmaxf(fabsf(den), __expf(-mol));
        bf16_t* mop = PM + (size_t)(rowbase + l) * LPM + 1536 + h * 128 + 4 * fq;
        float ssq = 0.f;
        u32x2 g2v[8]; float4 nwv[8];
#pragma unroll
        for (int t = 0; t < 8; ++t) { g2v[t] = *(const u32x2*)(mop + 16 * t); nwv[t] = *(const float4*)(p.mnorm_w + h * 128 + 16 * t + 4 * fq); }
#pragma unroll
        for (int t = 0; t < 8; ++t) {
            const u32x2 g2 = g2v[t];
            const float gg[4] = {bflo(g2.x), bfhi(g2.x), bflo(g2.y), bfhi(g2.y)};
#pragma unroll
            for (int r = 0; r < 4; ++r) { const float hv = acc[t][r] * invd * sigmoidf_(gg[r]); acc[t][r] = hv; ssq += hv * hv; }
        }
        ssq += __shfl_xor(ssq, 16); ssq += __shfl_xor(ssq, 32);
        const float rn = rsqrtf(ssq * (1.f / 128.f) + 1e-6f);
#pragma unroll
        for (int t = 0; t < 8; ++t) {
            const float4 nw = nwv[t];
            u32x2 o; o.x = pk2(acc[t][0] * rn * nw.x, acc[t][1] * rn * nw.y); o.y = pk2(acc[t][2] * rn * nw.z, acc[t][3] * rn * nw.w);
            *(u32x2*)(mop + 16 * t) = o;
        }
    }
}

DEV void stage_norm2(const Params& p, char* lds, int vb, int nvb) {
    const int tid = threadIdx.x, lane = tid & 63, wave = __builtin_amdgcn_readfirstlane(tid >> 6);
    const float* mod = (const float*)(p.ws + WS_MOD);
    bf16_t* U2 = (bf16_t*)(p.ws + WS_PG);
    const int rstride = nvb * NW;
    for (int mb = vb * NW + wave; mb < M; mb += 4 * rstride) {
        float4 vv[4][4];
#pragma unroll
        for (int rr = 0; rr < 4; ++rr) { const int mr = mb + rr * rstride < M ? mb + rr * rstride : mb; const float4* xr = (const float4*)(p.out + (size_t)mr * D);
#pragma unroll
            for (int j = 0; j < 4; ++j) vv[rr][j] = xr[lane + 64 * j]; }
#pragma unroll
        for (int rr = 0; rr < 4; ++rr) {
            const int m = mb + rr * rstride;
            if (m < M) {
                const int b = m >= SEQ ? 1 : 0;
                float ss = 0.f;
#pragma unroll
                for (int j = 0; j < 4; ++j) { const float4 v = vv[rr][j]; ss += v.x * v.x + v.y * v.y + v.z * v.z + v.w * v.w; }
                ss = wave_sum(ss);
                const float rstd = rsqrtf(ss * (1.f / 1024.f) + 1e-6f);
#pragma unroll
                for (int j = 0; j < 4; ++j) {
                    const int col = 4 * (lane + 64 * j); const float4 v = vv[rr][j];
                    const float4 w1 = *(const float4*)(p.norm2_w + col), sc = *(const float4*)(mod + b * 6144 + 4096 + col), sh = *(const float4*)(mod + b * 6144 + 3072 + col);
                    u32x2 o;
                    o.x = pk2(v.x * rstd * w1.x * (1.f + sc.x) + sh.x, v.y * rstd * w1.y * (1.f + sc.y) + sh.y);
                    o.y = pk2(v.z * rstd * w1.z * (1.f + sc.z) + sh.z, v.w * rstd * w1.w * (1.f + sc.w) + sh.w);
                    *(u32x2*)(U2 + (size_t)m * D + col) = o;
                }
            }
        }
    }
}

constexpr size_t WS_SELI = 400 * MiB;
constexpr size_t WS_SELG = 416 * MiB;
constexpr size_t WS_SC = 64 * MiB;
DEV unsigned f2ord(float f) { const unsigned u = __float_as_uint(f); return (u & 0x80000000u) ? ~u : (u | 0x80000000u); }
DEV float ord2f(unsigned k) { return __uint_as_float((k & 0x80000000u) ? (k ^ 0x80000000u) : ~k); }
DEV unsigned umax_(unsigned a, unsigned b) { return a > b ? a : b; }

DEV void stage_gemm_q(const Params& p, char* lds, int vb, int nvb) {
    pg8::Gemm g{(const bf16_t*)(p.ws + WS_PG), (const bf16_t*)(p.ws + WS_WQ), M, 2048, 1024, 1024, 1024};
    pg8::StaticOrder S; S.init(M, 2048, nvb, vb);
    pg8::EpiF32 E{(float*)(p.ws + WS_SC), 2048};
    pg8::gemm_phase<pg8::EpiF32, pg8::StaticOrder, true, true>((PG8_LAS unsigned char*)lds, g, S, E);
}

DEV unsigned umin_(unsigned a, unsigned b) { return a < b ? a : b; }
template <int N> DEV void bitonic_sort_desc(unsigned (&a)[N]) {
#pragma unroll
    for (int k = 2; k <= N; k <<= 1)
#pragma unroll
        for (int j = k >> 1; j > 0; j >>= 1)
#pragma unroll
            for (int i = 0; i < N; ++i) { const int l = i ^ j; if (l > i) { const unsigned x = a[i], y = a[l]; const bool dsc = (i & k) == 0; a[i] = dsc ? umax_(x, y) : umin_(x, y); a[l] = dsc ? umin_(x, y) : umax_(x, y); } }
}
template <int N> DEV void bitonic_merge_desc(unsigned (&a)[N]) {
#pragma unroll
    for (int j = N >> 1; j > 0; j >>= 1)
#pragma unroll
        for (int i = 0; i < N; ++i) { const int l = i ^ j; if (l > i) { const unsigned x = a[i], y = a[l]; a[i] = umax_(x, y); a[l] = umin_(x, y); } }
}
template <bool X16> DEV void merge_top16_xlane(unsigned (&x)[16], int lane) {
    unsigned m[16];
#pragma unroll
    for (int i = 0; i < 16; ++i) {
        unsigned pv;
        if (X16) { auto r = __builtin_amdgcn_permlane16_swap(x[15 - i], x[15 - i], false, false); pv = (lane & 16) ? r[0] : r[1]; }
        else { auto r = __builtin_amdgcn_permlane32_swap(x[15 - i], x[15 - i], false, false); pv = (lane & 32) ? r[0] : r[1]; }
        m[i] = umax_(x[i], pv);
    }
    bitonic_merge_desc<16>(m);
#pragma unroll
    for (int i = 0; i < 16; ++i) x[i] = m[i];
}

DEV void stage_q_topk(const Params& p, char* lds, int vb, int nvb) {
    const int tid = threadIdx.x, lane = tid & 63, wave = __builtin_amdgcn_readfirstlane(tid >> 6), fr = lane & 15, fq = lane >> 4;
    unsigned* tops = (unsigned*)lds;
    unsigned char* ptab = (unsigned char*)(lds + 16384);
    const float* SC = (const float*)(p.ws + WS_SC);
    int* SELI = (int*)(p.ws + WS_SELI); float* SELG = (float*)(p.ws + WS_SELG);
    __syncthreads();
    if (tid < 64) { int cnt = 0; unsigned char v = 0xff; for (int i = 0; i < 16; ++i) for (int j = 0; j < 16 / (i + 1); ++j) { if (cnt == tid) v = (unsigned char)(i | (j << 4)); ++cnt; } ptab[tid] = v; }
    __syncthreads();
    for (int item = vb; item < 2048; item += nvb) {
        const int mt = item >> 3, h = item & 7, m0 = mt * 128;
        const float* srow = SC + (size_t)(m0 + 16 * wave + fr) * 2048 + h * 256 + 4 * fq;
        f32x4 sv[2][8];
#pragma unroll
        for (int pp = 0; pp < 2; ++pp)
#pragma unroll
            for (int t = 0; t < 8; ++t) sv[pp][t] = *(const f32x4*)(srow + pp * 128 + 16 * t);
        unsigned* tp = tops + (16 * wave + fr) * 32;
#pragma unroll
        for (int pp = 0; pp < 2; ++pp) {
            unsigned lo[16], hi[16];
#pragma unroll
            for (int t = 0; t < 4; ++t)
#pragma unroll
                for (int r = 0; r < 4; ++r) {
                    lo[4 * t + r] = (f2ord(sv[pp][t][r]) & ~127u) | (127u - (unsigned)(16 * t + 4 * fq + r));
                    hi[4 * t + r] = (f2ord(sv[pp][t + 4][r]) & ~127u) | (127u - (unsigned)(16 * (t + 4) + 4 * fq + r));
                }
            bitonic_sort_desc<16>(lo); bitonic_sort_desc<16>(hi);
#pragma unroll
            for (int i = 0; i < 16; ++i) lo[i] = umax_(lo[i], hi[15 - i]);
            bitonic_merge_desc<16>(lo);
            merge_top16_xlane<true>(lo, lane); merge_top16_xlane<false>(lo, lane);
            if (fq == 0) {
#pragma unroll
                for (int q = 0; q < 4; ++q) *(u32x4*)(tp + pp * 16 + 4 * q) = (u32x4){lo[4 * q], lo[4 * q + 1], lo[4 * q + 2], lo[4 * q + 3]};
            }
        }
        wave_lds_sync();
        unsigned ck[16];
#pragma unroll
        for (int sl = 0; sl < 13; ++sl) {
            const unsigned pr = ptab[4 * sl + fq]; const unsigned i = pr & 15u, j = pr >> 4;
            const float sum = ord2f(tp[i] & ~127u) + ord2f(tp[16 + (j & 15u)] & ~127u);
            ck[sl] = pr != 0xffu ? ((f2ord(sum) & ~255u) | (255u - (i * 16u + j))) : 0u;
        }
        ck[13] = 0u; ck[14] = 0u; ck[15] = 0u;
        bitonic_sort_desc<16>(ck);
        merge_top16_xlane<true>(ck, lane); merge_top16_xlane<false>(ck, lane);
        const float v0 = ord2f(ck[0] & ~255u);
        float ex[16], sm = 0.f;
#pragma unroll
        for (int r = 0; r < 16; ++r) { ex[r] = __expf(ord2f(ck[r] & ~255u) - v0); sm += ex[r]; }
        const float rs = 1.f / sm;
        int oi[4]; float og[4];
#pragma unroll
        for (int q = 0; q < 4; ++q) {
            const unsigned w = fq == 0 ? ck[q] : (fq == 1 ? ck[4 + q] : (fq == 2 ? ck[8 + q] : ck[12 + q]));
            const float e = fq == 0 ? ex[q] : (fq == 1 ? ex[4 + q] : (fq == 2 ? ex[8 + q] : ex[12 + q]));
            const unsigned flat = 255u - (w & 255u); const unsigned ia = flat >> 4, jb = flat & 15u;
            oi[q] = (int)((127u - (tp[ia] & 127u)) * 128u + (127u - (tp[16 + jb] & 127u)));
            og[q] = e * rs;
        }
        const size_t so = (size_t)(m0 + 16 * wave + fr) * 128 + h * 16 + 4 * fq;
        *(int4*)(SELI + so) = make_int4(oi[0], oi[1], oi[2], oi[3]);
        *(float4*)(SELG + so) = make_float4(og[0], og[1], og[2], og[3]);
        wave_lds_sync();
    }
}

DEV float dpp_row_sum(float v) {
    v += __int_as_float(__builtin_amdgcn_update_dpp(0, __float_as_int(v), 0xB1, 0xF, 0xF, true));
    v += __int_as_float(__builtin_amdgcn_update_dpp(0, __float_as_int(v), 0x4E, 0xF, 0xF, true));
    v += __int_as_float(__builtin_amdgcn_update_dpp(0, __float_as_int(v), 0x141, 0xF, 0xF, true));
    v += __int_as_float(__builtin_amdgcn_update_dpp(0, __float_as_int(v), 0x140, 0xF, 0xF, true));
    return v;
}
DEV int dpp_row_isum(int v) {
    v += __builtin_amdgcn_update_dpp(0, v, 0xB1, 0xF, 0xF, true); v += __builtin_amdgcn_update_dpp(0, v, 0x4E, 0xF, 0xF, true);
    v += __builtin_amdgcn_update_dpp(0, v, 0x141, 0xF, 0xF, true); v += __builtin_amdgcn_update_dpp(0, v, 0x140, 0xF, 0xF, true);
    return v;
}
DEV float dpp_row_max(float v) {
    v = fmaxf(v, __int_as_float(__builtin_amdgcn_update_dpp(0, __float_as_int(v), 0xB1, 0xF, 0xF, true))); v = fmaxf(v, __int_as_float(__builtin_amdgcn_update_dpp(0, __float_as_int(v), 0x4E, 0xF, 0xF, true)));
    v = fmaxf(v, __int_as_float(__builtin_amdgcn_update_dpp(0, __float_as_int(v), 0x141, 0xF, 0xF, true))); v = fmaxf(v, __int_as_float(__builtin_amdgcn_update_dpp(0, __float_as_int(v), 0x140, 0xF, 0xF, true)));
    return v;
}
DEV float gelu_as(float v) {
    const float av = fabsf(v), t = __builtin_amdgcn_rcpf(av * 0.2316418882f + 1.0f);
    float q = t * 0.5307027145f + (-0.7265760135f); q = q * t + 0.7107068705f; q = q * t + (-0.142248368f); q = q * t + 0.127414796f; q = q * t;
    const float e = __builtin_amdgcn_exp2f(v * v * (-0.72134752044f));
    const float m = v * (q * e);
    return v < 0.f ? m : v - m;
}
constexpr int NBIN = 16;
constexpr int GW_IDX = 0, GW_GATE = 1024, GW_SU = 3072, GW_SV = 5120, GW_W = 7168, GW_WQ = 9216, GW_BYTES = 9728;
DEV void g_sort_token(const int* SELI, const float* SELG, const float* SU, const float* SV, int tkn, char* wl, int j, int lane, int msk) {
    const int i0 = SELI[(size_t)tkn * 128 + lane] & msk, i1 = SELI[(size_t)tkn * 128 + 64 + lane] & msk;
    const float g0 = SELG[(size_t)tkn * 128 + lane], g1 = SELG[(size_t)tkn * 128 + 64 + lane];
    const float su0 = SU[i0], su1 = SU[i1], sv0 = SV[i0], sv1 = SV[i1];
    const int s0 = i0 >> 10, s1 = i1 >> 10;
    const unsigned long long lt = (1ull << lane) - 1ull;
    int base = 0, p0 = 0, p1 = 0;
#pragma unroll
    for (int s = 0; s < NBIN; ++s) {
        const unsigned long long m0 = __ballot(s0 == s), m1 = __ballot(s1 == s);
        const int c0 = __popcll(m0), c1 = __popcll(m1);
        if (s0 == s) p0 = base + __popcll(m0 & lt);
        if (s1 == s) p1 = base + c0 + __popcll(m1 & lt);
        base += c0 + c1;
    }
    unsigned short* li = (unsigned short*)(wl + GW_IDX) + j * 128; float* lg = (float*)(wl + GW_GATE) + j * 128; float* lsu = (float*)(wl + GW_SU) + j * 128; float* lsv = (float*)(wl + GW_SV) + j * 128;
    li[p0] = (unsigned short)i0; lg[p0] = g0; lsu[p0] = su0; lsv[p0] = sv0;
    li[p1] = (unsigned short)i1; lg[p1] = g1; lsu[p1] = su1; lsv[p1] = sv1;
}
DEV void r_load(u32x4 (&d)[4], const unsigned char* T, int id, int c) {
    const u32x4* q = (const u32x4*)(T + (size_t)id * 1024) + c;
#pragma unroll
    for (int k = 0; k < 4; ++k) d[k] = q[16 * k];
}
DEV int r_dotq(const u32x4 (&u)[4], const unsigned (&xq)[16]) {
    int s0 = 0, s1 = 0, s2 = 0, s3 = 0;
#pragma unroll
    for (int k = 0; k < 4; ++k) {
        s0 = __builtin_amdgcn_sdot4((int)u[k][0], (int)xq[4 * k], s0, false); s1 = __builtin_amdgcn_sdot4((int)u[k][1], (int)xq[4 * k + 1], s1, false);
        s2 = __builtin_amdgcn_sdot4((int)u[k][2], (int)xq[4 * k + 2], s2, false); s3 = __builtin_amdgcn_sdot4((int)u[k][3], (int)xq[4 * k + 3], s3, false);
    }
    return (s0 + s1) + (s2 + s3);
}
DEV float r_weight(int part, float sx, const char* wl, int r, int e) {
    const float d = (float)dpp_row_isum(part) * (((const float*)(wl + GW_SU))[r * 128 + e] * sx);
    return ((const float*)(wl + GW_GATE))[r * 128 + e] * gelu_as(d) * ((const float*)(wl + GW_SV))[r * 128 + e];
}
DEV void r_vaccq(const u32x4 (&v0)[4], const u32x4 (&v1)[4], const u32x4 (&v2)[4], const u32x4 (&v3)[4], unsigned wpk, int (&acc)[64]) {
#pragma unroll
    for (int k = 0; k < 4; ++k)
#pragma unroll
        for (int w = 0; w < 4; ++w) {
            const unsigned r0 = v0[k][w], r1 = v1[k][w], r2 = v2[k][w], r3 = v3[k][w];
            const unsigned p0 = __builtin_amdgcn_perm(r1, r0, 0x05010400u), p1 = __builtin_amdgcn_perm(r1, r0, 0x07030602u);
            const unsigned q0 = __builtin_amdgcn_perm(r3, r2, 0x05010400u), q1 = __builtin_amdgcn_perm(r3, r2, 0x07030602u);
            const unsigned t0 = __builtin_amdgcn_perm(q0, p0, 0x05040100u), t1 = __builtin_amdgcn_perm(q0, p0, 0x07060302u);
            const unsigned t2 = __builtin_amdgcn_perm(q1, p1, 0x05040100u), t3 = __builtin_amdgcn_perm(q1, p1, 0x07060302u);
            const int o = 16 * k + 4 * w;
            acc[o] = __builtin_amdgcn_sdot4((int)t0, (int)wpk, acc[o], false); acc[o + 1] = __builtin_amdgcn_sdot4((int)t1, (int)wpk, acc[o + 1], false);
            acc[o + 2] = __builtin_amdgcn_sdot4((int)t2, (int)wpk, acc[o + 2], false); acc[o + 3] = __builtin_amdgcn_sdot4((int)t3, (int)wpk, acc[o + 3], false);
        }
}
#define SB_() __builtin_amdgcn_sched_barrier(0)

DEV void stage_peer_gather(const Params& p, char* lds, int slot, int nslots, bool dry = false, int msk = 0x3fff) {
    const int tid = threadIdx.x, lane = tid & 63, wave = __builtin_amdgcn_readfirstlane(tid >> 6), r = lane >> 4, c = lane & 15;
    const bf16_t* U2 = (const bf16_t*)(p.ws + WS_PG);
    const unsigned char* TU = p.ws + WS_TU; const unsigned char* TV = p.ws + WS_TV;
    const float* SU = (const float*)(p.ws + WS_ISU); const float* SV = (const float*)(p.ws + WS_ISV);
    const int* SELI = (const int*)(p.ws + WS_SELI); const float* SELG = (const float*)(p.ws + WS_SELG);
    const float* mod = (const float*)(p.ws + WS_MOD);
    char* wl = lds + wave * GW_BYTES;
    const unsigned short* myi = (const unsigned short*)(wl + GW_IDX) + r * 128;
    float* lw = (float*)(wl + GW_W) + r * 128; unsigned* lwq = (unsigned*)(wl + GW_WQ) + r * 32;
    const int tpb = M / nslots;
    __syncthreads();
    for (int g0 = 0; g0 < tpb; g0 += 32) {
        const int tbase = slot * tpb + g0 + 4 * wave;
#pragma unroll
        for (int j = 0; j < 4; ++j) g_sort_token(SELI, SELG, SU, SV, tbase + j, wl, j, lane, msk);
        const int tkn = tbase + r;
        unsigned xq[16]; float sx;
        {
            const bf16_t* xr = U2 + (size_t)tkn * D + 16 * c;
            u32x4 t[8]; float amax = 0.f;
#pragma unroll
            for (int k = 0; k < 8; ++k) { t[k] = *(const u32x4*)(xr + 256 * (k >> 1) + 8 * (k & 1));
#pragma unroll
                for (int i = 0; i < 4; ++i) amax = fmaxf(amax, fmaxf(fabsf(bflo(t[k][i])), fabsf(bfhi(t[k][i])))); }
            amax = dpp_row_max(amax);
            const float inv = amax > 0.f ? 127.f / amax : 0.f; sx = amax > 0.f ? amax * (1.f / 127.f) : 1.f;
#pragma unroll
            for (int k = 0; k < 8; ++k)
#pragma unroll
                for (int h2 = 0; h2 < 2; ++h2) {
                    const unsigned a = t[k][2 * h2], b = t[k][2 * h2 + 1];
                    const unsigned wv = ((unsigned)__float2int_rn(bflo(a) * inv) & 0xffu) | (((unsigned)__float2int_rn(bfhi(a) * inv) & 0xffu) << 8) | (((unsigned)__float2int_rn(bflo(b) * inv) & 0xffu) << 16) | ((unsigned)__float2int_rn(bfhi(b) * inv) << 24);
                    xq[2 * k + h2] = wv;
                }
        }
        wave_lds_sync();
        float wmax = 0.f;
        {
            u32x4 ua[4], ub[4], uc[4], ud[4];
            r_load(ua, TU, (int)myi[0], c); r_load(ub, TU, (int)myi[1], c); r_load(uc, TU, (int)myi[2], c); r_load(ud, TU, (int)myi[3], c);
            for (int e = 0; e < 128; e += 4) {
                SB_(); const int pa = r_dotq(ua, xq); SB_(); r_load(ua, TU, (int)myi[e + 4 < 128 ? e + 4 : 127], c); SB_();
                const int pb = r_dotq(ub, xq); SB_(); r_load(ub, TU, (int)myi[e + 5 < 128 ? e + 5 : 127], c); SB_();
                const int pc = r_dotq(uc, xq); SB_(); r_load(uc, TU, (int)myi[e + 6 < 128 ? e + 6 : 127], c); SB_();
                const int pd = r_dotq(ud, xq); SB_(); r_load(ud, TU, (int)myi[e + 7 < 128 ? e + 7 : 127], c); SB_();
                const float w0 = r_weight(pa, sx, wl, r, e), w1 = r_weight(pb, sx, wl, r, e + 1), w2 = r_weight(pc, sx, wl, r, e + 2), w3 = r_weight(pd, sx, wl, r, e + 3);
                wmax = fmaxf(fmaxf(wmax, fmaxf(fabsf(w0), fabsf(w1))), fmaxf(fabsf(w2), fabsf(w3)));
                if (c == 0) *(f32x4*)(lw + e) = (f32x4){w0, w1, w2, w3};
            }
        }
        const float T = wmax > 0.f ? wmax * (1.f / 127.f) : 1.f, invT = wmax > 0.f ? 127.f / wmax : 0.f;
        wave_lds_sync();
#pragma unroll
        for (int h2 = 0; h2 < 2; ++h2) {
            const int gg = c + 16 * h2; const f32x4 wv = *(const f32x4*)(lw + 4 * gg);
            lwq[gg] = ((unsigned)__float2int_rn(wv[0] * invT) & 0xffu) | (((unsigned)__float2int_rn(wv[1] * invT) & 0xffu) << 8) | (((unsigned)__float2int_rn(wv[2] * invT) & 0xffu) << 16) | ((unsigned)__float2int_rn(wv[3] * invT) << 24);
        }
        wave_lds_sync();
        int acc[64];
#pragma unroll
        for (int i = 0; i < 64; ++i) acc[i] = 0;
        {
            u32x4 a0[4], a1[4], a2[4], a3[4], b0[4], b1[4], b2[4], b3[4];
            r_load(a0, TV, (int)myi[0], c); r_load(a1, TV, (int)myi[1], c); r_load(a2, TV, (int)myi[2], c); r_load(a3, TV, (int)myi[3], c);
            r_load(b0, TV, (int)myi[4], c); r_load(b1, TV, (int)myi[5], c); r_load(b2, TV, (int)myi[6], c); r_load(b3, TV, (int)myi[7], c);
            for (int g = 0; g < 32; g += 2) {
                const int n2 = g + 2 < 32 ? 4 * (g + 2) : 124, n3 = g + 3 < 32 ? 4 * (g + 3) : 124;
                SB_(); r_vaccq(a0, a1, a2, a3, lwq[g], acc); SB_();
                r_load(a0, TV, (int)myi[n2], c); r_load(a1, TV, (int)myi[n2 + 1], c); r_load(a2, TV, (int)myi[n2 + 2], c); r_load(a3, TV, (int)myi[n2 + 3], c); SB_();
                r_vaccq(b0, b1, b2, b3, lwq[g + 1], acc); SB_();
                r_load(b0, TV, (int)myi[n3], c); r_load(b1, TV, (int)myi[n3 + 1], c); r_load(b2, TV, (int)myi[n3 + 2], c); r_load(b3, TV, (int)myi[n3 + 3], c); SB_();
            }
        }
        const int b = tkn >= SEQ ? 1 : 0;
        float* hr = p.out + (size_t)tkn * D + 16 * c;
        const float* g2p = mod + b * 6144 + 5120 + 16 * c;
        float y[64]; float ss = 0.f;
#pragma unroll
        for (int q = 0; q < 16; ++q) {
            const int eo = 256 * (q >> 2) + 4 * (q & 3);
            const float4 hv = *(const float4*)(hr + eo); const float4 g2 = *(const float4*)(g2p + eo);
            y[4 * q] = hv.x + g2.x * (T * (float)acc[4 * q]); y[4 * q + 1] = hv.y + g2.y * (T * (float)acc[4 * q + 1]);
            y[4 * q + 2] = hv.z + g2.z * (T * (float)acc[4 * q + 2]); y[4 * q + 3] = hv.w + g2.w * (T * (float)acc[4 * q + 3]);
            ss += y[4 * q] * y[4 * q] + y[4 * q + 1] * y[4 * q + 1] + y[4 * q + 2] * y[4 * q + 2] + y[4 * q + 3] * y[4 * q + 3];
        }
        ss = dpp_row_sum(ss);
        const float rstd = rsqrtf(ss * (1.f / 1024.f) + 1e-6f);
        float4 nwv[16];
#pragma unroll
        for (int q = 0; q < 16; ++q) nwv[q] = *(const float4*)(p.normf_w + 16 * c + 256 * (q >> 2) + 4 * (q & 3));
        if (!dry || rstd == 123.456f)
#pragma unroll
        for (int q = 0; q < 16; ++q) {
            const int eo = 256 * (q >> 2) + 4 * (q & 3);
            const float4 nw = nwv[q];
            float4 o; o.x = y[4 * q] * rstd * nw.x; o.y = y[4 * q + 1] * rstd * nw.y; o.z = y[4 * q + 2] * rstd * nw.z; o.w = y[4 * q + 3] * rstd * nw.w;
            *(float4*)(hr + eo) = o;
        }
        wave_lds_sync();
    }
}

#define LAS __attribute__((address_space(3)))
#define XB_TMO      128
#define XB_XCNT(j)  (256  + 64 * (j))
#define XB_XSUB(j)  (1280 + 64 * (j))
#define XB_XGEN(j)  (2304 + 64 * (j))
#define XB_TOP      3328
#define XB_TOPGEN   3392
#define XCD_BAR_WORDS 3456
#define XB_SPIN_CAP (1u << 18)

__device__ __forceinline__ unsigned xb_ld(unsigned* p)              { return __hip_atomic_load(p, __ATOMIC_RELAXED, __HIP_MEMORY_SCOPE_AGENT); }
__device__ __forceinline__ unsigned xb_add(unsigned* p, unsigned v) { return __hip_atomic_fetch_add(p, v, __ATOMIC_RELAXED, __HIP_MEMORY_SCOPE_AGENT); }
__device__ __forceinline__ unsigned xb_xcc_id() { return (unsigned)__builtin_amdgcn_s_getreg((3 << 11) | 20) & 0xFu; }
#define XB_SPIN(cond, bar) do { unsigned _sp = 0; while (cond) { __builtin_amdgcn_s_sleep(1); \
    if ((++_sp & 255u) == 0u) { if (xb_ld(&(bar)[XB_TMO])) break; if (_sp > XB_SPIN_CAP) { atomicAdd(&(bar)[XB_TMO], 1u); break; } } } } while (0)

struct XcdBarrier {
    unsigned* bar; unsigned x;
    volatile LAS unsigned* st;
};

__device__ __forceinline__ XcdBarrier xcd_barrier_post(unsigned* bar, volatile LAS unsigned* st) {
    XcdBarrier b; b.bar = bar; b.x = xb_xcc_id(); b.st = st;
    if (threadIdx.x == 0) (void)xb_add(&bar[XB_XCNT(b.x)], 1u);
    return b;
}
__device__ __forceinline__ void xcd_barrier_complete(unsigned* bar, unsigned x, unsigned& nloc, unsigned& nx) {
    const unsigned G = gridDim.x * gridDim.y * gridDim.z;
    unsigned sum, cnt, mine, sp = 0u;
    for (;;) {
        sum = 0u; cnt = 0u; mine = 0u;
#pragma unroll
        for (unsigned j = 0; j < 16; ++j) { const unsigned c = xb_ld(&bar[XB_XCNT(j)]); sum += c; cnt += (c > 0u) ? 1u : 0u; mine = (j == x) ? c : mine; }
        if (sum == G) break;
        __builtin_amdgcn_s_sleep(1);
        if ((++sp & 255u) == 0u) { if (xb_ld(&bar[XB_TMO])) break; if (sp > XB_SPIN_CAP) { atomicAdd(&bar[XB_TMO], 1u); break; } }
    }
    nloc = mine > 0u ? mine : 1u; nx = cnt > 0u ? cnt : 1u;
}

__device__ __forceinline__ void xcd_barrier(const XcdBarrier& b) {
    asm volatile("s_waitcnt vmcnt(0)" ::: "memory");
    __syncthreads();
    if (threadIdx.x == 0) {
        unsigned* bar = b.bar;
        __builtin_amdgcn_s_waitcnt(0);
        unsigned nloc = b.st[0], nx = b.st[1];
        if (nloc == 0u) { xcd_barrier_complete(bar, b.x, nloc, nx); b.st[0] = nloc; b.st[1] = nx; }
        const unsigned old = xb_add(&bar[XB_XSUB(b.x)], 1u);
        const unsigned gen = old / nloc;
        if (old + 1u == (gen + 1u) * nloc) {
            __builtin_amdgcn_fence(__ATOMIC_RELEASE, "agent");
            asm volatile("s_waitcnt vmcnt(0)" ::: "memory");
            const unsigned og = xb_add(&bar[XB_TOP], 1u);
            const unsigned tg = og / nx;
            if (og + 1u == (tg + 1u) * nx) xb_add(&bar[XB_TOPGEN], 1u);
            else XB_SPIN(xb_ld(&bar[XB_TOPGEN]) == tg, bar);
            __builtin_amdgcn_fence(__ATOMIC_ACQUIRE, "agent");
            xb_add(&bar[XB_XGEN(b.x)], 1u);
            asm volatile("s_waitcnt vmcnt(0)" ::: "memory");
        } else {
            XB_SPIN(xb_ld(&bar[XB_XGEN(b.x)]) == gen, bar);
            __builtin_amdgcn_fence(__ATOMIC_ACQUIRE, "agent");
            asm volatile("s_waitcnt vmcnt(0)" ::: "memory");
        }
    }
    __syncthreads();
}

namespace cg = cooperative_groups;
constexpr int LDS_BYTES = 151552;
constexpr int CW_RANK = XCD_BAR_WORDS;

constexpr int LDS_TOTAL = LDS_BYTES + 64;

__global__ void __launch_bounds__(512) k_mega(Params p) {
    extern __shared__ __attribute__((aligned(16))) char lds[];
    const int vb = blockIdx.x, nvb = gridDim.x;
    volatile LAS unsigned* bst = (volatile LAS unsigned*)((LAS char*)lds + LDS_BYTES);
    if (threadIdx.x < 16) bst[threadIdx.x] = 0u;
    __syncthreads();
    XcdBarrier bar = xcd_barrier_post((unsigned*)p.ws, bst);
    if (threadIdx.x == 0) bst[2] = xb_add((unsigned*)p.ws + CW_RANK + 64 * bar.x, 1u);
#define GRID_BAR() xcd_barrier(bar)
    stage_prep(p, lds, vb, nvb);        GRID_BAR();
    stage_norm1(p, lds, vb, nvb);       GRID_BAR();
    stage_gemm_in(p, lds, vb, nvb);     GRID_BAR();
    stage_attn(p, lds, vb, nvb);
    stage_mstate(p, lds, vb, nvb);      GRID_BAR();
    stage_mscan(p, lds, vb, nvb);       GRID_BAR();
    stage_mout(p, lds, vb, nvb);        GRID_BAR();
    stage_gemm_merge(p, lds, vb, nvb);  GRID_BAR();
    stage_gemm_out(p, lds, vb, nvb);    GRID_BAR();
    stage_norm2(p, lds, vb, nvb);       GRID_BAR();
    stage_gemm_q(p, lds, vb, nvb);      GRID_BAR();
    stage_q_topk(p, lds, vb, nvb);      GRID_BAR();
    if (threadIdx.x == 0) { unsigned base = 0u; for (unsigned j = 0; j < bar.x; ++j) base += xb_ld((unsigned*)p.ws + XB_XCNT(j)); bst[3] = base + bst[2]; }
    __syncthreads();
    const int slot = (int)bst[3];
#ifdef XPG
    stage_peer_gather(p, lds, slot < nvb ? slot : vb, nvb, p.ws != nullptr, XPG == 1 ? 0x3fff : 0x3e1f);
#endif
    stage_peer_gather(p, lds, slot < nvb ? slot : vb, nvb);
}

extern "C" void kernel_launch(void* const* d_in, const int* in_sizes, int n_in, void* d_out, int out_size, void* d_ws, size_t ws_size, hipStream_t stream) {
    if (n_in != 20 || ws_size < WS_END) { fprintf(stderr, "kernel_launch: unexpected n_in %d or ws_size %zu\n", n_in, ws_size); return; }
    static int grid_blocks = 0;
    if (!grid_blocks) {
        int dev = 0, cus = 0, per_cu = 0;
        (void)hipGetDevice(&dev);
        (void)hipDeviceGetAttribute(&cus, hipDeviceAttributeMultiprocessorCount, dev);
        (void)hipFuncSetAttribute((const void*)k_mega, hipFuncAttributeMaxDynamicSharedMemorySize, LDS_TOTAL);
        (void)hipOccupancyMaxActiveBlocksPerMultiprocessor(&per_cu, (const void*)k_mega, 512, LDS_TOTAL);
        if (per_cu < 1) { fprintf(stderr, "kernel_launch: occupancy query says %d blocks per CU\n", per_cu); per_cu = 1; }
        grid_blocks = cus * 1;
    }
    Params p{};
    p.x = (const float*)d_in[0]; p.c = (const float*)d_in[1]; p.w_ada = (const float*)d_in[2]; p.b_ada = (const float*)d_in[3]; p.norm1_w = (const float*)d_in[4];
    p.w_in = (const float*)d_in[5]; p.conv_w = (const float*)d_in[6]; p.sinks = (const float*)d_in[7]; p.i_bias = (const float*)d_in[8]; p.f_bias = (const float*)d_in[9];
    p.mnorm_w = (const float*)d_in[10]; p.w_a = (const float*)d_in[11]; p.w_b = (const float*)d_in[12]; p.w_out = (const float*)d_in[13]; p.norm2_w = (const float*)d_in[14];
    p.w_q = (const float*)d_in[15]; p.sub_keys = (const float*)d_in[16]; p.peer_u = (const float*)d_in[17]; p.peer_v = (const float*)d_in[18]; p.normf_w = (const float*)d_in[19];
    p.out = (float*)d_out; p.ws = (unsigned char*)d_ws;
    (void)hipMemsetAsync(d_ws, 0, 32768, stream);
    void* args[] = {&p};
    hipError_t e = hipLaunchCooperativeKernel((const void*)k_mega, dim3(grid_blocks), dim3(512), args, LDS_TOTAL, stream);
    if (e != hipSuccess) fprintf(stderr, "cooperative launch failed: %s (grid %d)\n", hipGetErrorString(e), grid_blocks);
}
```

```cpp
#include <hip/hip_runtime.h>
#include <hip/hip_cooperative_groups.h>
#include <stdint.h>
#include <stdio.h>

#define DEV __device__ __forceinline__
typedef unsigned short bf16_t;
typedef short bf16x8 __attribute__((ext_vector_type(8)));
typedef float f32x4 __attribute__((ext_vector_type(4)));
typedef unsigned u32x4 __attribute__((ext_vector_type(4)));
typedef unsigned u32x2 __attribute__((ext_vector_type(2)));

constexpr int BATCH = 2, SEQ = 16384, M = BATCH * SEQ, D = 1024;
constexpr int NTH = 512, NW = 8;
constexpr int LPA = 768, LPM = 2048, LPG = 2048;

struct Params {
    const float *x, *c, *w_ada, *b_ada, *norm1_w, *w_in, *conv_w, *sinks, *i_bias, *f_bias, *mnorm_w, *w_a, *w_b, *w_out, *norm2_w, *w_q, *sub_keys, *peer_u, *peer_v, *normf_w;
    float* out; unsigned char* ws;
};

constexpr size_t MiB = 1u << 20;
constexpr size_t WS_MOD = 1 * MiB;
constexpr size_t WS_IPRE = 2 * MiB;
constexpr size_t WS_FPRE = 2 * MiB + 512 * 1024;
constexpr size_t WS_CHG = 3 * MiB;
constexpr size_t WS_NLOC = 4 * MiB;
constexpr size_t WS_NST = 4 * MiB + 512 * 1024;
constexpr size_t WS_ROPE = 5 * MiB;
constexpr size_t WS_WIN = 10 * MiB;
constexpr size_t WS_WA = 20 * MiB;
constexpr size_t WS_WB = 21 * MiB;
constexpr size_t WS_WOUT = 22 * MiB;
constexpr size_t WS_WQ = 24 * MiB;
constexpr size_t WS_SK = 28 * MiB;
constexpr size_t WS_ISU = 29 * MiB;
constexpr size_t WS_ISV = 29 * MiB + 65536;
constexpr size_t WS_TU = 32 * MiB;
constexpr size_t WS_TV = 48 * MiB;
constexpr size_t WS_UB = 96 * MiB;
constexpr size_t WS_PA = 160 * MiB;
constexpr size_t WS_PM = 208 * MiB;
constexpr size_t WS_PG = 336 * MiB;
constexpr size_t WS_CST = 464 * MiB;
constexpr size_t WS_AT = 64 * MiB;
constexpr size_t WS_ML = 96 * MiB;
constexpr size_t WS_MG = 208 * MiB;
constexpr size_t WS_END = 496 * MiB;

DEV unsigned f2bf(float f) { unsigned u = __float_as_uint(f); return (u + 0x7fffu + ((u >> 16) & 1u)) >> 16; }
DEV unsigned pk2(float lo, float hi) { return f2bf(lo) | (f2bf(hi) << 16); }
DEV float bflo(unsigned u) { return __uint_as_float(u << 16); }
DEV float bfhi(unsigned u) { return __uint_as_float(u & 0xffff0000u); }
DEV float bf2f(bf16_t h) { return __uint_as_float(((unsigned)h) << 16); }
DEV float wave_sum(float v) {
#pragma unroll
    for (int o = 32; o > 0; o >>= 1) v += __shfl_xor(v, o);
    return v;
}
DEV float wave_max(float v) {
#pragma unroll
    for (int o = 32; o > 0; o >>= 1) v = fmaxf(v, __shfl_xor(v, o));
    return v;
}
DEV float sigmoidf_(float v) { return __builtin_amdgcn_rcpf(1.f + __expf(-v)); }
DEV f32x4 mfma16(bf16x8 a, bf16x8 b, f32x4 c) { return __builtin_amdgcn_mfma_f32_16x16x32_bf16(a, b, c, 0, 0, 0); }
DEV void wave_lds_sync() { __builtin_amdgcn_fence(__ATOMIC_ACQ_REL, "wavefront"); __builtin_amdgcn_wave_barrier(); }

DEV void transpose_item(const float* W, int ldw, int k0, int nsrc0, bf16_t* WT, int ldt, int ndst0, float* scr, int lane, int kdst_off = 0) {
#pragma unroll 8
    for (int i = 0; i < 32; ++i) { const int kk = 2 * i + (lane >> 5); scr[kk * 33 + (lane & 31)] = W[(size_t)(k0 + kk) * ldw + nsrc0 + (lane & 31)]; }
    wave_lds_sync();
    const int c = lane & 7;
#pragma unroll
    for (int j = 0; j < 4; ++j) {
        const int n = (lane >> 3) + 8 * j; const float* s = scr + (8 * c) * 33 + n;
        u32x4 o; o.x = pk2(s[0 * 33], s[1 * 33]); o.y = pk2(s[2 * 33], s[3 * 33]); o.z = pk2(s[4 * 33], s[5 * 33]); o.w = pk2(s[6 * 33], s[7 * 33]);
        *(u32x4*)(WT + (size_t)(ndst0 + n) * ldt + k0 + kdst_off + 8 * c) = o;
    }
    wave_lds_sync();
}

DEV void stage_prep(const Params& p, char* lds, int vb, int nvb) {
    const int tid = threadIdx.x, lane = tid & 63, wave = __builtin_amdgcn_readfirstlane(tid >> 6);
    float* mod = (float*)(p.ws + WS_MOD);
    float* s_act = (float*)lds;
    float* s_red = (float*)(lds + 8192);
    for (int i = tid; i < 2048; i += NTH) { const float v = p.c[i]; s_act[i] = v / (1.f + expf(-v)); }
    __syncthreads();
    for (int item = vb; item < 192; item += nvb) {
        const int kg = tid >> 5, cl = tid & 31, col = item * 32 + cl;
        float s0 = 0.f, s1 = 0.f;
        for (int k = kg; k < 1024; k += 16) { const float w = p.w_ada[(size_t)k * 6144 + col]; s0 += s_act[k] * w; s1 += s_act[1024 + k] * w; }
        s_red[(kg * 32 + cl) * 2] = s0; s_red[(kg * 32 + cl) * 2 + 1] = s1;
        __syncthreads();
        if (tid < 64) { const int b = tid >> 5, c2 = tid & 31; float s = 0.f; for (int g = 0; g < 16; ++g) s += s_red[(g * 32 + c2) * 2 + b]; mod[b * 6144 + item * 32 + c2] = s + p.b_ada[item * 32 + c2]; }
        __syncthreads();
    }
    float* scr = (float*)(lds + 16384 + wave * 8448);
    const int gw = vb * NW + wave, ngw = nvb * NW;
    bf16_t* Wt_in = (bf16_t*)(p.ws + WS_WIN); bf16_t* Wt_a = (bf16_t*)(p.ws + WS_WA); bf16_t* Wt_b = (bf16_t*)(p.ws + WS_WB);
    bf16_t* Wt_out = (bf16_t*)(p.ws + WS_WOUT); bf16_t* Wt_q = (bf16_t*)(p.ws + WS_WQ);
    for (int it = gw; it < 3456; it += ngw) {
        int r = it;
        if (r < 2432) { const int kb = r / 152, nb = r % 152; transpose_item(p.w_in, 4872, kb * 64, nb * 32 + (nb >= 88 ? 8 : 0), Wt_in, 1024, nb * 32, scr, lane); continue; } r -= 2432;
        if (r < 256) { const int kb = r / 32, nb = r % 32; transpose_item(p.w_a, 1024, kb * 64, nb * 32, Wt_a, 1024, nb * 32, scr, lane, 0); continue; } r -= 256;
        if (r < 256) { const int kb = r / 32, nb = r % 32; transpose_item(p.w_b, 1024, kb * 64, nb * 32, Wt_a, 1024, nb * 32, scr, lane, 512); continue; } r -= 256;
        { const int kb = r / 32, nb = r % 32; transpose_item(p.w_out, 1024, kb * 64, nb * 32, Wt_out, 1024, nb * 32, scr, lane); }
    }
    {
        float* WL = (float*)lds;
        float* KL = (float*)(lds + 33792);
        for (int item = vb; item < 256; item += nvb) {
            const int hp = item >> 4, k0 = (item & 15) * 64, pidx = hp & 1;
            __syncthreads();
            for (int i = tid; i < 64 * 32; i += NTH) { const int kk = i >> 5, d4 = i & 31; *(float4*)(WL + kk * 132 + 4 * d4) = *(const float4*)(p.w_q + (size_t)(k0 + kk) * 2048 + hp * 128 + 4 * d4); }
            for (int i = tid; i < 128 * 32; i += NTH) ((float4*)KL)[i] = ((const float4*)(p.sub_keys + (size_t)pidx * 16384))[i];
            __syncthreads();
            const int kk = tid & 63, n0 = (tid >> 6) * 16;
            float acc[16];
#pragma unroll
            for (int j = 0; j < 16; ++j) acc[j] = 0.f;
            for (int d4 = 0; d4 < 32; ++d4) {
                const float4 w = *(const float4*)(WL + kk * 132 + 4 * d4);
#pragma unroll
                for (int j = 0; j < 16; ++j) { const float4 kv = *(const float4*)(KL + (n0 + j) * 128 + 4 * d4); acc[j] += w.x * kv.x + w.y * kv.y + w.z * kv.z + w.w * kv.w; }
            }
#pragma unroll
            for (int j = 0; j < 16; ++j) Wt_q[(size_t)(hp * 128 + n0 + j) * 1024 + k0 + kk] = (bf16_t)f2bf(acc[j]);
        }
        __syncthreads();
    }
    const size_t gt = (size_t)vb * NTH + tid, ngt = (size_t)nvb * NTH;
    for (int rowb = gw; rowb < 32768; rowb += 4 * ngw) {
        float4 aa[4][4];
#pragma unroll
        for (int rr = 0; rr < 4; ++rr) { const int row = rowb + rr * ngw < 32768 ? rowb + rr * ngw : rowb; const float4* src = (const float4*)((row >= 16384 ? p.peer_v : p.peer_u) + (size_t)(row & 16383) * D) + 4 * lane;
#pragma unroll
            for (int i = 0; i < 4; ++i) aa[rr][i] = src[i]; }
#pragma unroll
        for (int rr = 0; rr < 4; ++rr) {
            const int row = rowb + rr * ngw;
            if (row < 32768) {
                const bool isv = row >= 16384; const int r = row & 16383;
                float mx = 0.f;
#pragma unroll
                for (int i = 0; i < 4; ++i) mx = fmaxf(mx, fmaxf(fmaxf(fabsf(aa[rr][i].x), fabsf(aa[rr][i].y)), fmaxf(fabsf(aa[rr][i].z), fabsf(aa[rr][i].w))));
                mx = wave_max(mx);
                const float inv = mx > 0.f ? 127.f / mx : 0.f, sc = mx > 0.f ? mx * (1.f / 127.f) : 1.f;
                u32x4 w;
#pragma unroll
                for (int i = 0; i < 4; ++i) w[i] = ((unsigned)__float2int_rn(aa[rr][i].x * inv) & 0xffu) | (((unsigned)__float2int_rn(aa[rr][i].y * inv) & 0xffu) << 8) | (((unsigned)__float2int_rn(aa[rr][i].z * inv) & 0xffu) << 16) | ((unsigned)__float2int_rn(aa[rr][i].w * inv) << 24);
                ((u32x4*)(p.ws + (isv ? WS_TV : WS_TU) + (size_t)r * 1024))[lane] = w;
                if (lane == 0) ((float*)(p.ws + (isv ? WS_ISV : WS_ISU)))[r] = sc;
            }
        }
    }
    for (size_t g = gt; g < 4096; g += ngt) {
        const float4 a = ((const float4*)p.sub_keys)[2 * g], b = ((const float4*)p.sub_keys)[2 * g + 1];
        u32x4 w; w.x = pk2(a.x, a.y); w.y = pk2(a.z, a.w); w.z = pk2(b.x, b.y); w.w = pk2(b.z, b.w);
        ((u32x4*)(p.ws + WS_SK))[g] = w;
    }
    float2* rope = (float2*)(p.ws + WS_ROPE);
    for (size_t e = gt; e < 16384 * 32; e += ngt) {
        const int pos = (int)(e >> 5), i = (int)(e & 31);
        const float inv = (float)exp2(-(double)i * (13.287712379549449 / 32.0));
        const float ang = (float)pos * inv;
        const double a = (double)ang; const double n = rint(a * 0.15915494309189535); const double r = a - n * 6.283185307179586;
        float s, c; sincosf((float)r, &s, &c);
        rope[e] = make_float2(c, s);
    }
}

DEV void stage_norm1(const Params& p, char* lds, int vb, int nvb) {
    const int tid = threadIdx.x, lane = tid & 63, wave = __builtin_amdgcn_readfirstlane(tid >> 6);
    float* wg = (float*)lds;
    for (int i = tid; i < 8192; i += NTH) { const int cc = i >> 10, k = i & 1023; wg[i] = p.w_in[(size_t)k * 4872 + 2816 + cc]; }
    __syncthreads();
    const float* mod = (const float*)(p.ws + WS_MOD);
    bf16_t* ub = (bf16_t*)(p.ws + WS_UB);
    float* ipre = (float*)(p.ws + WS_IPRE); float* fpre = (float*)(p.ws + WS_FPRE);
    const int rstride = nvb * NW;
    for (int mb = vb * NW + wave; mb < M; mb += 2 * rstride) {
        float4 vv[2][4];
#pragma unroll
        for (int rr = 0; rr < 2; ++rr) { const int mr = mb + rr * rstride < M ? mb + rr * rstride : mb; const float4* xr = (const float4*)(p.x + (size_t)mr * D);
#pragma unroll
            for (int j = 0; j < 4; ++j) vv[rr][j] = xr[lane + 64 * j]; }
#pragma unroll
        for (int rr = 0; rr < 2; ++rr) {
        const int m = mb + rr * rstride;
        if (m < M) {
        const int b = m >= SEQ ? 1 : 0;
        float4 v[4]; float ss = 0.f;
#pragma unroll
        for (int j = 0; j < 4; ++j) { v[j] = vv[rr][j]; ss += v[j].x * v[j].x + v[j].y * v[j].y + v[j].z * v[j].z + v[j].w * v[j].w; }
        ss = wave_sum(ss);
        const float rstd = rsqrtf(ss * (1.f / 1024.f) + 1e-6f);
        float ga[8];
#pragma unroll
        for (int cc = 0; cc < 8; ++cc) ga[cc] = 0.f;
#pragma unroll
        for (int j = 0; j < 4; ++j) {
            const int col = 4 * (lane + 64 * j);
            const float4 w1 = *(const float4*)(p.norm1_w + col), sc = *(const float4*)(mod + b * 6144 + 1024 + col), sh = *(const float4*)(mod + b * 6144 + col);
            float4 u;
            u.x = v[j].x * rstd * w1.x * (1.f + sc.x) + sh.x; u.y = v[j].y * rstd * w1.y * (1.f + sc.y) + sh.y;
            u.z = v[j].z * rstd * w1.z * (1.f + sc.z) + sh.z; u.w = v[j].w * rstd * w1.w * (1.f + sc.w) + sh.w;
            u32x2 o; o.x = pk2(u.x, u.y); o.y = pk2(u.z, u.w);
            *(u32x2*)(ub + (size_t)m * D + col) = o;
#pragma unroll
            for (int cc = 0; cc < 8; ++cc) { const float4 g = *(const float4*)(wg + cc * 1024 + col); ga[cc] += u.x * g.x + u.y * g.y + u.z * g.z + u.w * g.w; }
        }
        {
            const bool h32 = (lane & 32) != 0, h16 = (lane & 16) != 0, h8 = (lane & 8) != 0;
            float k4[4], k2[2];
#pragma unroll
            for (int i = 0; i < 4; ++i) k4[i] = (h32 ? ga[4 + i] : ga[i]) + __shfl_xor(h32 ? ga[i] : ga[4 + i], 32);
#pragma unroll
            for (int i = 0; i < 2; ++i) k2[i] = (h16 ? k4[2 + i] : k4[i]) + __shfl_xor(h16 ? k4[i] : k4[2 + i], 16);
            float k1 = (h8 ? k2[1] : k2[0]) + __shfl_xor(h8 ? k2[0] : k2[1], 8);
            k1 += __shfl_xor(k1, 4); k1 += __shfl_xor(k1, 2); k1 += __shfl_xor(k1, 1);
            const int cc = (lane >> 3) & 7;
            if ((lane & 7) == 0) { if (cc < 4) ipre[(size_t)m * 4 + cc] = k1 + p.i_bias[cc]; else fpre[(size_t)m * 4 + cc - 4] = k1 + p.f_bias[cc - 4]; }
        }
        }
        }
    }
}

namespace pg8 {
#define PG8_LAS __attribute__((address_space(3)))
typedef unsigned short bf16_t;
typedef short bf16x8 __attribute__((ext_vector_type(8)));
typedef float f32x4 __attribute__((ext_vector_type(4)));
typedef unsigned u32x4 __attribute__((ext_vector_type(4)));
constexpr int BM = 256, BK = 64, HALF = 128, HTB = HALF * BK * 2  , STAGE_BYTES = 8 * HTB, NXCD = 8, WGM = 8;

__host__ __device__ __forceinline__ int lds_byte(int r, int c) { const int st = (r >> 4) * 2 + (c >> 5), rr = r & 15, cc = c & 31, ob = rr * 64 + cc * 2; return st * 1024 + (ob ^ (((ob >> 9) & 1) << 5)); }
__host__ __device__ __forceinline__ void stage_rc(int b, int& R, int& C) { const int st = b / 1024, sb = b % 1024, swz = sb ^ (((sb >> 9) & 1) << 5); R = (st >> 1) * 16 + swz / 64; C = (st & 1) * 32 + (swz % 64) / 2; }
__host__ __device__ __forceinline__ int perm32(int rho) { const int n = rho >> 4, i = rho & 15; return 8 * (i >> 2) + 4 * n + (i & 3); }

struct Unit { int pm, pn; };
struct Gemm { const bf16_t* A; const bf16_t* Bt; int M, N, K, lda, ldb; const bf16_t* A2; };

struct StaticOrder {
    int nM, nN, nwg, G, c;
    __host__ __device__ void init(int M, int N, int G_, int c_) { nM = M / BM; nN = N / BM; nwg = nM * nN; G = G_; c = c_; }
    __host__ __device__ bool next(int i, Unit& u) const {
        const long L = (long)i * G + c; if (L >= nwg) return false;
        int wgid = (int)L; { const int q = nwg / NXCD, r = nwg % NXCD, xcd = wgid % NXCD, off = wgid / NXCD; wgid = (xcd < r ? xcd * (q + 1) : r * (q + 1) + (xcd - r) * q) + off; }
        const int nig = WGM * nN, gid = wgid / nig, fm = gid * WGM, gsz = (nM - fm) < WGM ? (nM - fm) : WGM;
        u.pm = fm + ((wgid % nig) % gsz); u.pn = (wgid % nig) / gsz; return true;
    }
    __device__ __forceinline__ void a_ready(const Unit&) const {}
    __device__ __forceinline__ void done(const Unit&) const {}
};

__device__ __forceinline__ unsigned cvt_pk_bf16(float lo, float hi) { unsigned r; asm volatile("v_cvt_pk_bf16_f32 %0, %1, %2" : "=v"(r) : "v"(lo), "v"(hi)); return r; }
__device__ __forceinline__ float sg_(float v) { return __builtin_amdgcn_rcpf(1.f + __expf(-v)); }
struct EpiIn {
    static constexpr bool PERM = true, AFTER_DRAIN = false, HAS_MID = false;
    bf16_t *PA, *PM, *PG;
    __device__ __forceinline__ void operator()(const f32x4 (&acc)[2][2][4][2], const Unit& u, int wr, int wc, int fr, int fq) const {
        const int colt = u.pn * BM; bf16_t* base; int ldc, cb;
        if (colt < 768) { base = PA; ldc = 768; cb = colt; } else if (colt < 2816) { base = PM; ldc = 2048; cb = colt - 768; } else { base = PG; ldc = 2048; cb = colt - 2816; }
        const int row0 = u.pm * BM + wr * 64 + fr, col0 = cb + wc * 32 + 8 * fq;
#pragma unroll
        for (int ai = 0; ai < 2; ++ai)
#pragma unroll
            for (int m = 0; m < 4; ++m) { bf16_t* rowp = base + (size_t)(row0 + ai * HALF + m * 16) * ldc + col0;
#pragma unroll
                for (int bj = 0; bj < 2; ++bj) { const f32x4 v0 = acc[ai][bj][m][0], v1 = acc[ai][bj][m][1];
                    u32x4 w; w.x = cvt_pk_bf16(v0[0], v0[1]); w.y = cvt_pk_bf16(v0[2], v0[3]); w.z = cvt_pk_bf16(v1[0], v1[1]); w.w = cvt_pk_bf16(v1[2], v1[3]);
                    *(u32x4*)(rowp + bj * HALF) = w; } }
    }
};
struct EpiMerge {
    static constexpr bool PERM = true, AFTER_DRAIN = false, HAS_MID = false;
    const bf16_t* G; bf16_t* MG; int second;
    __device__ __forceinline__ void operator()(const f32x4 (&acc)[2][2][4][2], const Unit& u, int wr, int wc, int fr, int fq) const {
        const int row0 = u.pm * BM + wr * 64 + fr, col0 = u.pn * BM + wc * 32 + 8 * fq;
#pragma unroll
        for (int bj = 0; bj < 2; ++bj)
#pragma unroll
        for (int ai = 0; ai < 2; ++ai) {
            const int col = col0 + bj * HALF;
            u32x4 gv[4], tv[4];
#pragma unroll
            for (int m = 0; m < 4; ++m) { const size_t row = (size_t)(row0 + ai * HALF + m * 16); gv[m] = *(const u32x4*)(G + row * 2048 + col); tv[m] = second ? *(const u32x4*)(MG + row * 1024 + col) : (u32x4){0u, 0u, 0u, 0u}; }
#pragma unroll
            for (int m = 0; m < 4; ++m) { const size_t row = (size_t)(row0 + ai * HALF + m * 16);
                const f32x4 v0 = acc[ai][bj][m][0], v1 = acc[ai][bj][m][1]; const u32x4 g = gv[m], t = tv[m];
                float r[8];
                r[0] = sg_(__uint_as_float(g.x << 16)) * v0[0] + __uint_as_float(t.x << 16); r[1] = sg_(__uint_as_float(g.x & 0xffff0000u)) * v0[1] + __uint_as_float(t.x & 0xffff0000u);
                r[2] = sg_(__uint_as_float(g.y << 16)) * v0[2] + __uint_as_float(t.y << 16); r[3] = sg_(__uint_as_float(g.y & 0xffff0000u)) * v0[3] + __uint_as_float(t.y & 0xffff0000u);
                r[4] = sg_(__uint_as_float(g.z << 16)) * v1[0] + __uint_as_float(t.z << 16); r[5] = sg_(__uint_as_float(g.z & 0xffff0000u)) * v1[1] + __uint_as_float(t.z & 0xffff0000u);
                r[6] = sg_(__uint_as_float(g.w << 16)) * v1[2] + __uint_as_float(t.w << 16); r[7] = sg_(__uint_as_float(g.w & 0xffff0000u)) * v1[3] + __uint_as_float(t.w & 0xffff0000u);
                u32x4 w; w.x = cvt_pk_bf16(r[0], r[1]); w.y = cvt_pk_bf16(r[2], r[3]); w.z = cvt_pk_bf16(r[4], r[5]); w.w = cvt_pk_bf16(r[6], r[7]);
                *(u32x4*)(MG + row * 1024 + col) = w; }
        }
    }
};
struct EpiMergeF {
    static constexpr bool PERM = true, AFTER_DRAIN = false, HAS_MID = true;
    const bf16_t* G; bf16_t* MG;
    static __device__ __forceinline__ float em_(float v) { return __expf(-fminf(fmaxf(v, -30.f), 30.f)); }
    __device__ __forceinline__ void mid(f32x4 (&acc)[2][2][4][2], const Unit& u, int wr, int wc, int fr, int fq) const {
        int row0 = u.pm * BM + wr * 64 + fr; const int col0 = u.pn * BM + wc * 32 + 8 * fq;
        asm volatile("" : "+v"(row0));
#pragma unroll
        for (int bj = 0; bj < 2; ++bj)
#pragma unroll
        for (int ai = 0; ai < 2; ++ai)
        {
            const int col = col0 + bj * HALF;
            u32x4 av[4], bv[4];
#pragma unroll
            for (int m = 0; m < 4; ++m) { const size_t row = (size_t)(row0 + ai * HALF + m * 16); av[m] = *(const u32x4*)(G + row * 2048 + col); bv[m] = *(const u32x4*)(G + row * 2048 + 1024 + col); }
#pragma unroll
            for (int m = 0; m < 4; ++m) {
                f32x4 r0, r1;
                r0[0] = (1.f + em_(__uint_as_float(bv[m][0] << 16))) * __builtin_amdgcn_rcpf(1.f + em_(__uint_as_float(av[m][0] << 16)));
                r0[1] = (1.f + em_(__uint_as_float(bv[m][0] & 0xffff0000u))) * __builtin_amdgcn_rcpf(1.f + em_(__uint_as_float(av[m][0] & 0xffff0000u)));
                r0[2] = (1.f + em_(__uint_as_float(bv[m][1] << 16))) * __builtin_amdgcn_rcpf(1.f + em_(__uint_as_float(av[m][1] << 16)));
                r0[3] = (1.f + em_(__uint_as_float(bv[m][1] & 0xffff0000u))) * __builtin_amdgcn_rcpf(1.f + em_(__uint_as_float(av[m][1] & 0xffff0000u)));
                r1[0] = (1.f + em_(__uint_as_float(bv[m][2] << 16))) * __builtin_amdgcn_rcpf(1.f + em_(__uint_as_float(av[m][2] << 16)));
                r1[1] = (1.f + em_(__uint_as_float(bv[m][2] & 0xffff0000u))) * __builtin_amdgcn_rcpf(1.f + em_(__uint_as_float(av[m][2] & 0xffff0000u)));
                r1[2] = (1.f + em_(__uint_as_float(bv[m][3] << 16))) * __builtin_amdgcn_rcpf(1.f + em_(__uint_as_float(av[m][3] << 16)));
                r1[3] = (1.f + em_(__uint_as_float(bv[m][3] & 0xffff0000u))) * __builtin_amdgcn_rcpf(1.f + em_(__uint_as_float(av[m][3] & 0xffff0000u)));
                acc[ai][bj][m][0] = acc[ai][bj][m][0] * r0; acc[ai][bj][m][1] = acc[ai][bj][m][1] * r1;
            }
            __builtin_amdgcn_sched_barrier(0);
        }
    }
    __device__ __forceinline__ void operator()(const f32x4 (&acc)[2][2][4][2], const Unit& u, int wr, int wc, int fr, int fq) const {
        const int row0 = u.pm * BM + wr * 64 + fr, col0 = u.pn * BM + wc * 32 + 8 * fq;
#pragma unroll
        for (int bj = 0; bj < 2; ++bj)
#pragma unroll
        for (int ai = 0; ai < 2; ++ai) {
            const int col = col0 + bj * HALF;
            u32x4 bv[4];
#pragma unroll
            for (int m = 0; m < 4; ++m) bv[m] = *(const u32x4*)(G + (size_t)(row0 + ai * HALF + m * 16) * 2048 + 1024 + col);
#pragma unroll
            for (int m = 0; m < 4; ++m) { const f32x4 v0 = acc[ai][bj][m][0], v1 = acc[ai][bj][m][1]; const u32x4 g = bv[m];
                float r[8];
                r[0] = v0[0] * __builtin_amdgcn_rcpf(1.f + em_(__uint_as_float(g.x << 16))); r[1] = v0[1] * __builtin_amdgcn_rcpf(1.f + em_(__uint_as_float(g.x & 0xffff0000u)));
                r[2] = v0[2] * __builtin_amdgcn_rcpf(1.f + em_(__uint_as_float(g.y << 16))); r[3] = v0[3] * __builtin_amdgcn_rcpf(1.f + em_(__uint_as_float(g.y & 0xffff0000u)));
                r[4] = v1[0] * __builtin_amdgcn_rcpf(1.f + em_(__uint_as_float(g.z << 16))); r[5] = v1[1] * __builtin_amdgcn_rcpf(1.f + em_(__uint_as_float(g.z & 0xffff0000u)));
                r[6] = v1[2] * __builtin_amdgcn_rcpf(1.f + em_(__uint_as_float(g.w << 16))); r[7] = v1[3] * __builtin_amdgcn_rcpf(1.f + em_(__uint_as_float(g.w & 0xffff0000u)));
                u32x4 w; w.x = cvt_pk_bf16(r[0], r[1]); w.y = cvt_pk_bf16(r[2], r[3]); w.z = cvt_pk_bf16(r[4], r[5]); w.w = cvt_pk_bf16(r[6], r[7]);
                *(u32x4*)(MG + (size_t)(row0 + ai * HALF + m * 16) * 1024 + col) = w; }
        }
    }
};
struct EpiF32 {
    static constexpr bool PERM = true, AFTER_DRAIN = false, HAS_MID = false;
    float* O; int ldc;
    __device__ __forceinline__ void operator()(const f32x4 (&acc)[2][2][4][2], const Unit& u, int wr, int wc, int fr, int fq) const {
        const int row0 = u.pm * BM + wr * 64 + fr, col0 = u.pn * BM + wc * 32 + 8 * fq;
#pragma unroll
        for (int ai = 0; ai < 2; ++ai)
#pragma unroll
            for (int m = 0; m < 4; ++m) { float* rowp = O + (size_t)(row0 + ai * HALF + m * 16) * ldc + col0;
#pragma unroll
                for (int bj = 0; bj < 2; ++bj) { *(f32x4*)(rowp + bj * HALF) = acc[ai][bj][m][0]; *(f32x4*)(rowp + bj * HALF + 4) = acc[ai][bj][m][1]; } }
    }
};
struct EpiOut {
    static constexpr bool PERM = true, AFTER_DRAIN = false, HAS_MID = false;
    const float* x; const float* g1; float* out; int seq;
    __device__ __forceinline__ void operator()(const f32x4 (&acc)[2][2][4][2], const Unit& u, int wr, int wc, int fr, int fq) const {
        const int row0 = u.pm * BM + wr * 64 + fr, col0 = u.pn * BM + wc * 32 + 8 * fq;
        const float* gp = g1 + (u.pm * BM >= seq ? 6144 : 0);
#pragma unroll
        for (int bj = 0; bj < 2; ++bj) { const int col = col0 + bj * HALF; const f32x4 ga = *(const f32x4*)(gp + col), gb = *(const f32x4*)(gp + col + 4);
#pragma unroll
            for (int ai = 0; ai < 2; ++ai) {
                f32x4 xa[4], xb[4];
#pragma unroll
                for (int m = 0; m < 4; ++m) { const size_t off = (size_t)(row0 + ai * HALF + m * 16) * 1024 + col; xa[m] = *(const f32x4*)(x + off); xb[m] = *(const f32x4*)(x + off + 4); }
#pragma unroll
                for (int m = 0; m < 4; ++m) { const size_t off = (size_t)(row0 + ai * HALF + m * 16) * 1024 + col;
                    *(f32x4*)(out + off) = xa[m] + ga * acc[ai][bj][m][0]; *(f32x4*)(out + off + 4) = xb[m] + gb * acc[ai][bj][m][1]; } } }
    }
};

template <class Epi, class Sched, bool ALIGN_EPI = false, bool SP2 = false>
__device__ __forceinline__ void gemm_phase(PG8_LAS unsigned char* lds, const Gemm g, const Sched& S, const Epi& E) {
    const int tid = threadIdx.x, wid = __builtin_amdgcn_readfirstlane(tid >> 6), lane = tid & 63, wr = wid >> 2, wc = wid & 3, fr = lane & 15, fq = lane >> 4;
    const int K = g.K, nt = K / BK;
    unsigned voffA[2], voffB[2];
#pragma unroll
    for (int i = 0; i < 2; ++i) { int R, C; stage_rc(tid * 16 + i * 8192, R, C); const int Rb = Epi::PERM ? ((R & ~31) + perm32(R & 31)) : R;
        voffA[i] = (unsigned)(R * g.lda + C) * 2u; voffB[i] = (unsigned)(Rb * g.ldb + C) * 2u; }
    const size_t kstep = (size_t)(BK * 2);
    const size_t hstepA = (size_t)HALF * g.lda * 2, hstepB = (size_t)HALF * g.ldb * 2;
    const size_t tstepA = 2 * hstepA, tstepB = 2 * hstepB;
    const unsigned ldsw = (unsigned)wid * 1024u;
    const int aoff = lds_byte(wr * 64 + fr, fq * 8), boff = lds_byte(wc * 32 + fr, fq * 8);
#define PG8_SA(b, h) (((b) * 2 + (h)) * HTB)
#define PG8_SB(b, h) ((4 + (b) * 2 + (h)) * HTB)
#define PG8_STAGE(bufoff, gbase, voff) do { _Pragma("unroll") for (int _i = 0; _i < 2; ++_i) \
        __builtin_amdgcn_global_load_lds((const unsigned*)((const char*)(gbase) + (voff)[_i]), (PG8_LAS unsigned*)(lds + (bufoff) + ldsw + _i * 8192), 16, 0, 0); } while (0)
#define PG8_LDA(dst, b, h) do { _Pragma("unroll") for (int m = 0; m < 4; ++m) _Pragma("unroll") for (int k = 0; k < 2; ++k) dst[m][k] = *(const PG8_LAS bf16x8*)(lds + PG8_SA(b, h) + aoff + m * 2048 + k * 1024); } while (0)
#define PG8_LDB(dst, b, h) do { _Pragma("unroll") for (int n = 0; n < 2; ++n) _Pragma("unroll") for (int k = 0; k < 2; ++k) dst[n][k] = *(const PG8_LAS bf16x8*)(lds + PG8_SB(b, h) + boff + n * 2048 + k * 1024); } while (0)
#define PG8_MMA(ai, bj, At, Bt) do { __builtin_amdgcn_s_setprio(1); _Pragma("unroll") for (int m = 0; m < 4; ++m) _Pragma("unroll") for (int n = 0; n < 2; ++n) _Pragma("unroll") for (int k = 0; k < 2; ++k) \
        acc[ai][bj][m][n] = __builtin_amdgcn_mfma_f32_16x16x32_bf16(Bt[n][k], At[m][k], acc[ai][bj][m][n], 0, 0, 0); __builtin_amdgcn_s_setprio(0); } while (0)
#define PG8_WAIT_V(n) asm volatile("s_waitcnt vmcnt(" #n ")" ::: "memory")
#define PG8_WAIT_L(n) asm volatile("s_waitcnt lgkmcnt(" #n ")" ::: "memory")
#define PG8_BAR __builtin_amdgcn_s_barrier()
#define PG8_SCHED __builtin_amdgcn_sched_barrier(0)
    Unit cur, nxt; int ui = 0;
    if (!S.next(0, cur)) return;
    f32x4 acc[2][2][4][2];
#pragma unroll
    for (int a = 0; a < 2; ++a)
#pragma unroll
        for (int b = 0; b < 2; ++b)
#pragma unroll
            for (int m = 0; m < 4; ++m)
#pragma unroll
                for (int n = 0; n < 2; ++n) acc[a][b][m][n] = (f32x4){0.f, 0.f, 0.f, 0.f};
    bf16x8 At[4][2], B0[2][2], B1[2][2];
    const char* cA = (const char*)g.A + (size_t)cur.pm * tstepA; const char* cB = (const char*)g.Bt + (size_t)cur.pn * tstepB;
    const char* cA2 = g.A2 ? (const char*)g.A2 + (size_t)cur.pm * tstepA : nullptr;
    S.a_ready(cur);
    if constexpr (SP2) {
        PG8_STAGE(PG8_SB(0, 0), cB, voffB); PG8_STAGE(PG8_SB(0, 1), cB + hstepB, voffB); PG8_STAGE(PG8_SA(0, 0), cA, voffA); PG8_STAGE(PG8_SA(0, 1), cA + hstepA, voffA);
        if (wr == 1) PG8_BAR;
        PG8_WAIT_V(2); PG8_BAR;
        PG8_STAGE(PG8_SB(1, 0), cB + kstep, voffB); PG8_STAGE(PG8_SA(1, 0), cA + kstep, voffA); PG8_STAGE(PG8_SB(1, 1), cB + hstepB + kstep, voffB);
        PG8_WAIT_V(6); PG8_BAR;
    } else {
        PG8_STAGE(PG8_SB(0, 0), cB, voffB); PG8_STAGE(PG8_SA(0, 0), cA, voffA); PG8_STAGE(PG8_SB(0, 1), cB + hstepB, voffB); PG8_STAGE(PG8_SA(0, 1), cA + hstepA, voffA);
        if (wr == 1) PG8_BAR;
        PG8_WAIT_V(4); PG8_BAR;
        PG8_STAGE(PG8_SB(1, 0), cB + kstep, voffB); PG8_STAGE(PG8_SA(1, 0), cA + kstep, voffA); PG8_STAGE(PG8_SB(1, 1), cB + hstepB + kstep, voffB);
        PG8_WAIT_V(6); PG8_BAR;
    }
    for (;;) {
        const bool has_next = S.next(ui + 1, nxt);
        const char* nA = has_next ? (const char*)g.A + (size_t)nxt.pm * tstepA : cA; const char* nB = has_next ? (const char*)g.Bt + (size_t)nxt.pn * tstepB : cB;
        const int tspan = Epi::HAS_MID ? (nt >> 1) : nt;
        for (int tb = 0; tb < nt; tb += tspan) {
        if constexpr (Epi::HAS_MID) { if (tb != 0) E.mid(acc, cur, wr, wc, fr, fq); }
        for (int t = tb; t < tb + tspan; t += 2) {
            const bool last = (t == nt - 2);
            const int hk = nt >> 1;
            const char* bA1 = (cA2 && t + 1 >= hk) ? cA2 - (size_t)hk * kstep : cA; const char* bA2 = (cA2 && t + 2 >= hk) ? cA2 - (size_t)hk * kstep : cA;
            const char* a1 = bA1 + (size_t)(t + 1) * kstep;
            const char* a2 = last ? nA : bA2 + (size_t)(t + 2) * kstep; const char* b2 = last ? nB : cB + (size_t)(t + 2) * kstep;
            const char* a3 = a2 + kstep; const char* b3 = b2 + kstep;
            if (last && has_next) S.a_ready(nxt);
            if constexpr (SP2) {
            PG8_LDB(B0, 0, 0); PG8_LDB(B1, 0, 1); PG8_SCHED; PG8_LDA(At, 0, 0); PG8_STAGE(PG8_SA(1, 1), a1 + hstepA, voffA);
            PG8_WAIT_V(8); PG8_WAIT_L(0); PG8_BAR; PG8_MMA(0, 0, At, B0); PG8_MMA(0, 1, At, B1); PG8_BAR; PG8_SCHED;
            PG8_LDA(At, 0, 1); PG8_STAGE(PG8_SB(0, 0), b2, voffB); PG8_STAGE(PG8_SB(0, 1), b2 + hstepB, voffB); PG8_STAGE(PG8_SA(0, 0), a2, voffA);
            PG8_WAIT_V(8); PG8_WAIT_L(0); PG8_BAR; PG8_MMA(1, 0, At, B0); PG8_MMA(1, 1, At, B1); PG8_BAR; PG8_SCHED;
            PG8_LDB(B0, 1, 0); PG8_LDB(B1, 1, 1); PG8_SCHED; PG8_LDA(At, 1, 0); PG8_STAGE(PG8_SA(0, 1), a2 + hstepA, voffA);
            PG8_WAIT_V(8); PG8_WAIT_L(0); PG8_BAR; PG8_MMA(0, 0, At, B0); PG8_MMA(0, 1, At, B1); PG8_BAR; PG8_SCHED;
            PG8_LDA(At, 1, 1); PG8_STAGE(PG8_SB(1, 0), b3, voffB); PG8_STAGE(PG8_SB(1, 1), b3 + hstepB, voffB); PG8_STAGE(PG8_SA(1, 0), a3, voffA);
            PG8_WAIT_V(8); PG8_WAIT_L(0); PG8_BAR; PG8_MMA(1, 0, At, B0); PG8_MMA(1, 1, At, B1); PG8_BAR; PG8_SCHED;
            } else {
            PG8_LDB(B0, 0, 0); PG8_SCHED; PG8_LDA(At, 0, 0); PG8_STAGE(PG8_SA(1, 1), a1 + hstepA, voffA);
            PG8_WAIT_L(8); PG8_BAR; PG8_WAIT_L(0); PG8_MMA(0, 0, At, B0); PG8_BAR; PG8_SCHED;
            PG8_LDB(B1, 0, 1); PG8_STAGE(PG8_SB(0, 0), b2, voffB);
            PG8_BAR; PG8_WAIT_L(0); PG8_MMA(0, 1, At, B1); PG8_BAR;
            PG8_LDA(At, 0, 1); PG8_STAGE(PG8_SA(0, 0), a2, voffA);
            PG8_BAR; PG8_WAIT_L(0); PG8_MMA(1, 0, At, B0); PG8_BAR; PG8_SCHED;
            PG8_STAGE(PG8_SB(0, 1), b2 + hstepB, voffB);
            PG8_WAIT_V(6); PG8_BAR; PG8_MMA(1, 1, At, B1); PG8_BAR;
            PG8_LDB(B0, 1, 0); PG8_SCHED; PG8_LDA(At, 1, 0); PG8_STAGE(PG8_SA(0, 1), a2 + hstepA, voffA);
            PG8_WAIT_L(8); PG8_BAR; PG8_WAIT_L(0); PG8_MMA(0, 0, At, B0); PG8_BAR; PG8_SCHED;
            PG8_LDB(B1, 1, 1); PG8_STAGE(PG8_SB(1, 0), b3, voffB);
            PG8_BAR; PG8_WAIT_L(0); PG8_MMA(0, 1, At, B1); PG8_BAR;
            PG8_LDA(At, 1, 1); PG8_STAGE(PG8_SA(1, 0), a3, voffA);
            PG8_BAR; PG8_WAIT_L(0); PG8_MMA(1, 0, At, B0); PG8_BAR; PG8_SCHED;
            PG8_STAGE(PG8_SB(1, 1), b3 + hstepB, voffB);
            PG8_WAIT_V(6); PG8_BAR; PG8_MMA(1, 1, At, B1); PG8_BAR;
            }
        }
        }
        if constexpr (ALIGN_EPI) { if (wr == 0) PG8_BAR; }
        if constexpr (!Epi::AFTER_DRAIN) { E(acc, cur, wr, wc, fr, fq); S.done(cur); }
        if (!has_next) break;
#pragma unroll
        for (int a = 0; a < 2; ++a)
#pragma unroll
            for (int b = 0; b < 2; ++b)
#pragma unroll
                for (int m = 0; m < 4; ++m)
#pragma unroll
                    for (int n = 0; n < 2; ++n) acc[a][b][m][n] = (f32x4){0.f, 0.f, 0.f, 0.f};
        cur = nxt; cA = nA; cB = nB; ++ui; cA2 = g.A2 ? (const char*)g.A2 + (size_t)cur.pm * tstepA : nullptr;
        if constexpr (ALIGN_EPI) { if (wr == 1) PG8_BAR; }
    }
    PG8_WAIT_V(0);
    if constexpr (!ALIGN_EPI) { if (wr == 0) PG8_BAR; }
    PG8_BAR;
    if constexpr (Epi::AFTER_DRAIN) { E.fused(acc, cur, wr, wc, fr, fq, lds, wid, lane); S.done(cur); }
#undef PG8_SA
#undef PG8_SB
#undef PG8_STAGE
#undef PG8_LDA
#undef PG8_LDB
#undef PG8_MMA
#undef PG8_WAIT_V
#undef PG8_WAIT_L
#undef PG8_BAR
#undef PG8_SCHED
}
}

DEV void stage_gemm_in(const Params& p, char* lds, int vb, int nvb) {
    pg8::Gemm g{(const bf16_t*)(p.ws + WS_UB), (const bf16_t*)(p.ws + WS_WIN), M, 4864, 1024, 1024, 1024};
    pg8::StaticOrder S; S.init(M, 4864, nvb, vb);
    pg8::EpiIn E{(bf16_t*)(p.ws + WS_PA), (bf16_t*)(p.ws + WS_PM), (bf16_t*)(p.ws + WS_PG)};
    pg8::gemm_phase<pg8::EpiIn, pg8::StaticOrder, true, true>((PG8_LAS unsigned char*)lds, g, S, E);
}
DEV void stage_gemm_merge(const Params& p, char* lds, int vb, int nvb) {
    pg8::Gemm g{(const bf16_t*)(p.ws + WS_AT), (const bf16_t*)(p.ws + WS_WA), M, 1024, 1024, 512, 1024, (const bf16_t*)(p.ws + WS_ML)};
    pg8::StaticOrder S; S.init(M, 1024, nvb, vb);
    pg8::EpiMergeF E{(const bf16_t*)(p.ws + WS_PG), (bf16_t*)(p.ws + WS_MG)};
    pg8::gemm_phase<pg8::EpiMergeF, pg8::StaticOrder, true, true>((PG8_LAS unsigned char*)lds, g, S, E);
}
DEV void stage_gemm_out(const Params& p, char* lds, int vb, int nvb) {
    pg8::Gemm g{(const bf16_t*)(p.ws + WS_MG), (const bf16_t*)(p.ws + WS_WOUT), M, 1024, 1024, 1024, 1024};
    pg8::StaticOrder S; S.init(M, 1024, nvb, vb);
    pg8::EpiOut E{p.x, (const float*)(p.ws + WS_MOD) + 2048, p.out, SEQ};
    pg8::gemm_phase<pg8::EpiOut, pg8::StaticOrder, true, true>((PG8_LAS unsigned char*)lds, g, S, E);
}

DEV void rope8(u32x4 x1, u32x4 x2, const float4* rp, float scale, u32x4& o1, u32x4& o2) {
#pragma unroll
    for (int w = 0; w < 4; ++w) {
        const float4 cs = rp[w];
        const float a0 = bflo(x1[w]), a1 = bfhi(x1[w]), b0 = bflo(x2[w]), b1 = bfhi(x2[w]);
        o1[w] = pk2((a0 * cs.x - b0 * cs.y) * scale, (a1 * cs.z - b1 * cs.w) * scale);
        o2[w] = pk2((b0 * cs.x + a0 * cs.y) * scale, (b1 * cs.z + a1 * cs.w) * scale);
    }
}

DEV void stage_attn(const Params& p, char* lds, int vb, int nvb) {
    const int tid = threadIdx.x, lane = tid & 63, wave = __builtin_amdgcn_readfirstlane(tid >> 6), fr = lane & 15, fq = lane >> 4;
    char* Ks = lds;
    char* VT = lds + 32768;
    char* Qs = lds + 70656;
    char* Ps = lds + 87040;
    bf16_t* PA = (bf16_t*)(p.ws + WS_PA);
    const float2* rope = (const float2*)(p.ws + WS_ROPE);
    for (int unit = vb; unit < 512; unit += nvb) {
        const int kvh = unit & 1, n = (unit >> 1) & 127, b = unit >> 8;
        __syncthreads();
        for (int task = tid; task < 1024; task += NTH) {
            const int ki = task >> 2, cp = task & 3, pos = 128 * (n - 1) + ki;
            u32x4 o1, o2;
            {
                const int pc = pos < 0 ? 0 : pos;
                const bf16_t* src = PA + (size_t)(b * SEQ + pc) * LPA + 512 + kvh * 64 + cp * 8;
                const u32x4 x1 = *(const u32x4*)src, x2 = *(const u32x4*)(src + 32);
                rope8(x1, x2, (const float4*)(rope + (size_t)pc * 32 + cp * 8), 1.0f, o1, o2);
                if (pos < 0) { o1 = (u32x4){0u, 0u, 0u, 0u}; o2 = o1; }
            }
            const int sw = ki & 7;
            *(u32x4*)(Ks + ki * 128 + ((cp ^ sw) << 4)) = o1;
            *(u32x4*)(Ks + ki * 128 + (((cp + 4) ^ sw) << 4)) = o2;
        }
        for (int task = tid; task < 2048; task += NTH) {
            const int ki = task >> 3, c = task & 7, pos = 128 * (n - 1) + ki;
            u32x4 x = *(const u32x4*)(PA + (size_t)(b * SEQ + (pos < 0 ? 0 : pos)) * LPA + 640 + kvh * 64 + c * 8);
            if (pos < 0) x = (u32x4){0u, 0u, 0u, 0u};
#pragma unroll
            for (int e = 0; e < 8; ++e) *(bf16_t*)(VT + (c * 8 + e) * 592 + ki * 2) = (bf16_t)((e & 1) ? (x[e >> 1] >> 16) : (x[e >> 1] & 0xffffu));
        }
        for (int i = tid; i < 64 * 40; i += NTH) { const int d = i / 40, kk = 256 + i % 40; *(bf16_t*)(VT + d * 592 + kk * 2) = 0; }
        for (int i = tid; i < 2048; i += NTH) { const int w = i >> 8, r = (i >> 4) & 15, kk = 144 + (i & 15); *(bf16_t*)(Ps + w * 5376 + r * 336 + kk * 2) = 0; }
        for (int j = 0; j < 4; ++j) {
            const int hq = kvh * 4 + j;
            {
                const int qi = tid >> 2, cp = tid & 3, pos = 128 * n + qi;
                const bf16_t* src = PA + (size_t)(b * SEQ + pos) * LPA + hq * 64 + cp * 8;
                const u32x4 x1 = *(const u32x4*)src, x2 = *(const u32x4*)(src + 32);
                u32x4 o1, o2;
                rope8(x1, x2, (const float4*)(rope + (size_t)pos * 32 + cp * 8), 0.125f, o1, o2);
                const int sw = qi & 7;
                *(u32x4*)(Qs + qi * 128 + ((cp ^ sw) << 4)) = o1;
                *(u32x4*)(Qs + qi * 128 + (((cp + 4) ^ sw) << 4)) = o2;
            }
            __syncthreads();
            f32x4 s[9];
            const int sw = fr & 7;
            bf16x8 qf[2];
#pragma unroll
            for (int ks = 0; ks < 2; ++ks) qf[ks] = *(const bf16x8*)(Qs + (16 * wave + fr) * 128 + (((fq + 4 * ks) ^ sw) << 4));
#pragma unroll
            for (int t = 0; t < 9; ++t) {
                s[t] = (f32x4){0.f, 0.f, 0.f, 0.f};
#pragma unroll
                for (int ks = 0; ks < 2; ++ks) { const bf16x8 kf = *(const bf16x8*)(Ks + (16 * (wave + t) + fr) * 128 + (((fq + 4 * ks) ^ sw) << 4)); s[t] = mfma16(kf, qf[ks], s[t]); }
            }
            const float sink = p.sinks[hq];
            float mx = sink;
#pragma unroll
            for (int t = 0; t < 9; ++t)
#pragma unroll
                for (int r = 0; r < 4; ++r) {
                    const int dd = 16 * t + 4 * fq + r - fr, ki = 16 * (wave + t) + 4 * fq + r;
                    const bool ok = (dd >= 1) && (dd <= 128) && (n > 0 || ki >= 128);
                    const float v = ok ? s[t][r] : -INFINITY;
                    s[t][r] = v; mx = fmaxf(mx, v);
                }
            mx = fmaxf(mx, __shfl_xor(mx, 16)); mx = fmaxf(mx, __shfl_xor(mx, 32));
            float sum = 0.f;
#pragma unroll
            for (int t = 0; t < 9; ++t)
#pragma unroll
                for (int r = 0; r < 4; ++r) { const float pv = __expf(s[t][r] - mx); s[t][r] = pv; sum += pv; }
            sum += __shfl_xor(sum, 16); sum += __shfl_xor(sum, 32);
            const float inv = 1.f / (sum + __expf(sink - mx));
            char* Pw = Ps + wave * 5376 + fr * 336;
#pragma unroll
            for (int t = 0; t < 9; ++t) { u32x2 o; o.x = pk2(s[t][0], s[t][1]); o.y = pk2(s[t][2], s[t][3]); *(u32x2*)(Pw + (16 * t + 4 * fq) * 2) = o; }
            __syncthreads();
            f32x4 o[4];
#pragma unroll
            for (int di = 0; di < 4; ++di) o[di] = (f32x4){0.f, 0.f, 0.f, 0.f};
#pragma unroll
            for (int ks = 0; ks < 5; ++ks) {
                const bf16x8 pf = *(const bf16x8*)(Pw + (32 * ks + 8 * fq) * 2);
#pragma unroll
                for (int di = 0; di < 4; ++di) { const bf16x8 vf = *(const bf16x8*)(VT + (16 * di + fr) * 592 + (16 * wave + 32 * ks + 8 * fq) * 2); o[di] = mfma16(vf, pf, o[di]); }
            }
            bf16_t* dst = (bf16_t*)(p.ws + WS_AT) + (size_t)(b * SEQ + 128 * n + 16 * wave + fr) * 512 + hq * 64 + 4 * fq;
#pragma unroll
            for (int di = 0; di < 4; ++di) { u32x2 w; w.x = pk2(o[di][0] * inv, o[di][1] * inv); w.y = pk2(o[di][2] * inv, o[di][3] * inv); *(u32x2*)(dst + 16 * di) = w; }
            __syncthreads();
        }
    }
}

DEV float logsigf(float x) { return fminf(x, 0.f) - log1pf(expf(-fabsf(x))); }

DEV void chunk_gates(const float* ipre, const float* fpre, int rowbase, int h, float* gs, int lane) {
    const int l0 = 2 * lane;
    const float i0 = ipre[(size_t)(rowbase + l0) * 4 + h], i1 = ipre[(size_t)(rowbase + l0 + 1) * 4 + h];
    const float lf0 = logsigf(fpre[(size_t)(rowbase + l0) * 4 + h]), lf1 = logsigf(fpre[(size_t)(rowbase + l0 + 1) * 4 + h]);
    const float pair = lf0 + lf1;
    float sc = pair;
#pragma unroll
    for (int o = 1; o < 64; o <<= 1) { const float t = __shfl_up(sc, o); if (lane >= o) sc += t; }
    const float b0 = (sc - pair) + lf0, b1 = b0 + lf1;
    const float g = __shfl(sc, 63);
    const float a0 = g - b0 + i0, a1 = g - b1 + i1;
    const float mloc = wave_max(fmaxf(a0, a1));
    const float ib0 = i0 - b0, ib1 = i1 - b1;
    float scm = fmaxf(ib0, ib1);
#pragma unroll
    for (int o = 1; o < 64; o <<= 1) { const float t = __shfl_up(scm, o); if (lane >= o) scm = fmaxf(scm, t); }
    float ex = __shfl_up(scm, 1); if (lane == 0) ex = -INFINITY;
    const float pm0 = fmaxf(ex, ib0), pm1 = fmaxf(pm0, ib1);
    gs[l0] = b0; gs[l0 + 1] = b1; gs[128 + l0] = ib0; gs[128 + l0 + 1] = ib1; gs[256 + l0] = a0; gs[256 + l0 + 1] = a1; gs[384 + l0] = pm0; gs[384 + l0 + 1] = pm1;
    if (lane == 0) { gs[512] = g; gs[513] = mloc; }
}

DEV void conv8(const bf16_t* PM, const float* cw, int b, int t, int pmcol, int cch, float (&out)[8]) {
#pragma unroll
    for (int e = 0; e < 8; ++e) out[e] = 0.f;
#pragma unroll
    for (int j = 0; j < 4; ++j) {
        const int tt = t - 3 + j; const int tc = tt < 0 ? 0 : tt; const float z = tt < 0 ? 0.f : 1.f;
        const u32x4 x = *(const u32x4*)(PM + (size_t)(b * SEQ + tc) * LPM + pmcol);
        float4 w0 = *(const float4*)(cw + j * 1024 + cch), w1 = *(const float4*)(cw + j * 1024 + cch + 4);
        w0.x *= z; w0.y *= z; w0.z *= z; w0.w *= z; w1.x *= z; w1.y *= z; w1.z *= z; w1.w *= z;
        out[0] += bflo(x[0]) * w0.x; out[1] += bfhi(x[0]) * w0.y; out[2] += bflo(x[1]) * w0.z; out[3] += bfhi(x[1]) * w0.w;
        out[4] += bflo(x[2]) * w1.x; out[5] += bfhi(x[2]) * w1.y; out[6] += bflo(x[3]) * w1.z; out[7] += bfhi(x[3]) * w1.w;
    }
}

DEV void conv8r(const u32x4 (&r)[4], const float* cwl, int ch8, int t, float (&out)[8]) {
#pragma unroll
    for (int e = 0; e < 8; ++e) out[e] = 0.f;
#pragma unroll
    for (int j = 0; j < 4; ++j) {
        const float z = (t - 3 + j) < 0 ? 0.f : 1.f;
        const float4 w0 = *(const float4*)(cwl + j * 128 + ch8), w1 = *(const float4*)(cwl + j * 128 + ch8 + 4);
        out[0] += bflo(r[j][0]) * (w0.x * z); out[1] += bfhi(r[j][0]) * (w0.y * z); out[2] += bflo(r[j][1]) * (w0.z * z); out[3] += bfhi(r[j][1]) * (w0.w * z);
        out[4] += bflo(r[j][2]) * (w1.x * z); out[5] += bfhi(r[j][2]) * (w1.y * z); out[6] += bflo(r[j][3]) * (w1.z * z); out[7] += bfhi(r[j][3]) * (w1.w * z);
    }
}
DEV float siluf_(float y) { return y * __builtin_amdgcn_rcpf(1.f + __expf(-y)); }

DEV void stage_mstate(const Params& p, char* lds, int vb, int nvb) {
    const int tid = threadIdx.x, lane = tid & 63, wave = __builtin_amdgcn_readfirstlane(tid >> 6), fr = lane & 15, fq = lane >> 4;
    char* KT = lds;
    char* VT = lds + 34816;
    float* gs = (float*)(lds + 69632); float* s_cw = (float*)(lds + 73728);
    const bf16_t* PM = (const bf16_t*)(p.ws + WS_PM);
    const float* ipre = (const float*)(p.ws + WS_IPRE); const float* fpre = (const float*)(p.ws + WS_FPRE);
    float* UT = (float*)(p.ws + WS_UB); float* NLOC = (float*)(p.ws + WS_NLOC);
    float* G = (float*)(p.ws + WS_CHG); float* MLOC = G + 1024;
    for (int unit = vb; unit < 1024; unit += nvb) {
        const int c = unit & 127, h = (unit >> 7) & 3, b = unit >> 9;
        const int rowbase = b * SEQ + c * 128;
        __syncthreads();
        if (wave == 0) chunk_gates(ipre, fpre, rowbase, h, gs, lane);
        else if (tid >= 64 && tid < 192) { const int d = tid - 64;
#pragma unroll
            for (int j = 0; j < 4; ++j) s_cw[j * 128 + d] = p.conv_w[j * 1024 + 512 + h * 128 + d]; }
        __syncthreads();
        const float mloc = gs[513];
        for (int task = tid; task < 2048; task += NTH) {
            const int l = task >> 4, ch = task & 15, t = c * 128 + l;
            u32x4 rk[4];
#pragma unroll
            for (int j = 0; j < 4; ++j) { const int tc = t - 3 + j < 0 ? 0 : t - 3 + j; rk[j] = *(const u32x4*)(PM + (size_t)(b * SEQ + tc) * LPM + 512 + h * 128 + ch * 8); }
            const u32x4 x = *(const u32x4*)(PM + (size_t)(rowbase + l) * LPM + 1024 + h * 128 + ch * 8);
            float v8[8]; conv8r(rk, s_cw, ch * 8, t, v8);
            const float wgt = __expf(gs[256 + l] - mloc) * 0.08838834764831845f;
#pragma unroll
            for (int e = 0; e < 8; ++e) *(bf16_t*)(KT + (ch * 8 + e) * 272 + l * 2) = (bf16_t)f2bf(siluf_(v8[e]) * wgt);
#pragma unroll
            for (int e = 0; e < 8; ++e) *(bf16_t*)(VT + (ch * 8 + e) * 272 + l * 2) = (bf16_t)((e & 1) ? (x[e >> 1] >> 16) : (x[e >> 1] & 0xffffu));
        }
        __syncthreads();
        f32x4 acc[8];
#pragma unroll
        for (int t = 0; t < 8; ++t) acc[t] = (f32x4){0.f, 0.f, 0.f, 0.f};
#pragma unroll
        for (int ks = 0; ks < 4; ++ks) {
            const bf16x8 vf = *(const bf16x8*)(VT + (16 * wave + fr) * 272 + (32 * ks + 8 * fq) * 2);
#pragma unroll
            for (int t = 0; t < 8; ++t) { const bf16x8 kf = *(const bf16x8*)(KT + (16 * t + fr) * 272 + (32 * ks + 8 * fq) * 2); acc[t] = mfma16(kf, vf, acc[t]); }
        }
        float* UTu = UT + (size_t)unit * 16384 + (16 * wave + fr) * 128 + 4 * fq;
#pragma unroll
        for (int t = 0; t < 8; ++t) *(f32x4*)(UTu + 16 * t) = acc[t];
        if (tid < 128) { float s = 0.f; for (int l = 0; l < 128; ++l) s += bf2f(*(const bf16_t*)(KT + tid * 272 + l * 2)); NLOC[unit * 128 + tid] = s; }
        if (tid == 0) { G[unit] = gs[512]; MLOC[unit] = mloc; }
    }
}

DEV void stage_mscan(const Params& p, char* lds, int vb, int nvb) {
    const int tid = threadIdx.x;
    float* s_dec = (float*)lds; float* s_scl = s_dec + 128;
    const float* UT = (const float*)(p.ws + WS_UB); const float* NLOC = (const float*)(p.ws + WS_NLOC);
    const float* G = (const float*)(p.ws + WS_CHG); const float* MLOC = G + 1024; float* MST = (float*)(p.ws + WS_CHG) + 2048;
    bf16_t* CST = (bf16_t*)(p.ws + WS_CST); float* NST = (float*)(p.ws + WS_NST);
    for (int item = vb; item < 256; item += nvb) {
        const int bh = item >> 5, part = item & 31;
        __syncthreads();
        float* s_g = s_dec + 256; float* s_ml = s_dec + 384; float* s_m = s_dec + 512;
        if (tid < 128) { s_g[tid] = G[bh * 128 + tid]; s_ml[tid] = MLOC[bh * 128 + tid]; }
        __syncthreads();
        if (tid == 0) { float m = 0.f; for (int c = 0; c < 128; ++c) { s_m[c] = m; m = fmaxf(s_g[c] + m, s_ml[c]); } s_m[128] = m; }
        __syncthreads();
        if (tid < 128) { const float m = s_m[tid], mn = s_m[tid + 1]; s_dec[tid] = expf(s_g[tid] + m - mn); s_scl[tid] = expf(s_ml[tid] - mn); if (part == 0) MST[bh * 128 + tid] = m; }
        __syncthreads();
        const int e = part * 512 + tid;
        float C = 0.f;
        const float* up = UT + (size_t)bh * 128 * 16384 + e; bf16_t* cp = CST + (size_t)bh * 128 * 16384 + e;
        for (int c = 0; c < 128; c += 32) {
            float uu[32];
#pragma unroll
            for (int i = 0; i < 32; ++i) uu[i] = up[(size_t)(c + i) * 16384];
#pragma unroll
            for (int i = 0; i < 32; ++i) { cp[(size_t)(c + i) * 16384] = (bf16_t)f2bf(C); C = s_dec[c + i] * C + s_scl[c + i] * uu[i]; }
        }
        if (part == 0 && tid < 128) { float nn = 0.f; for (int c = 0; c < 128; ++c) { NST[(bh * 128 + c) * 128 + tid] = nn; nn = s_dec[c] * nn + s_scl[c] * NLOC[(bh * 128 + c) * 128 + tid]; } }
    }
}

DEV void stage_mout(const Params& p, char* lds, int vb, int nvb) {
    const int tid = threadIdx.x, lane = tid & 63, wave = __builtin_amdgcn_readfirstlane(tid >> 6), fr = lane & 15, fq = lane >> 4;
    char* Qs = lds; char* Ks = lds + 34816; char* VT = lds + 69632; char* CT = lds + 104448;
    float* gs = (float*)(lds + 139264); float* s_nst = gs + 520; float* s_mo = gs + 648; float* s_wi = gs + 776; float* s_cw = (float*)(lds + 143360);
    bf16_t* PM = (bf16_t*)(p.ws + WS_PM);
    const float* ipre = (const float*)(p.ws + WS_IPRE); const float* fpre = (const float*)(p.ws + WS_FPRE);
    const float* MST = (const float*)(p.ws + WS_CHG) + 2048; const float* NST = (const float*)(p.ws + WS_NST);
    const bf16_t* CST = (const bf16_t*)(p.ws + WS_CST);
    for (int unit = vb; unit < 1024; unit += nvb) {
        const int c = unit & 127, h = (unit >> 7) & 3, b = unit >> 9;
        const int rowbase = b * SEQ + c * 128;
        __syncthreads();
        if (tid < 256) { const int d = tid & 127, kq = tid >> 7;
#pragma unroll
            for (int j = 0; j < 4; ++j) s_cw[kq * 512 + j * 128 + d] = p.conv_w[j * 1024 + kq * 512 + h * 128 + d]; }
        __syncthreads();
        if (wave == 0) chunk_gates(ipre, fpre, rowbase, h, gs, lane);
        for (int task = tid; task < 2048; task += NTH) {
            const int l = task >> 4, ch = task & 15, t = c * 128 + l;
            u32x4 rq[4], rk[4];
#pragma unroll
            for (int j = 0; j < 4; ++j) { const int tc = t - 3 + j < 0 ? 0 : t - 3 + j; const bf16_t* rp = PM + (size_t)(b * SEQ + tc) * LPM + h * 128 + ch * 8; rq[j] = *(const u32x4*)rp; rk[j] = *(const u32x4*)(rp + 512); }
            const u32x4 x = *(const u32x4*)(PM + (size_t)(rowbase + l) * LPM + 1024 + h * 128 + ch * 8);
            const u32x4 cst = *(const u32x4*)(CST + (size_t)unit * 16384 + l * 128 + ch * 8);
            float v8[8]; u32x4 o;
            conv8r(rq, s_cw, ch * 8, t, v8);
            o.x = pk2(siluf_(v8[0]), siluf_(v8[1])); o.y = pk2(siluf_(v8[2]), siluf_(v8[3])); o.z = pk2(siluf_(v8[4]), siluf_(v8[5])); o.w = pk2(siluf_(v8[6]), siluf_(v8[7]));
            *(u32x4*)(Qs + l * 272 + ch * 16) = o;
            conv8r(rk, s_cw + 512, ch * 8, t, v8);
            const float sc = 0.08838834764831845f;
            o.x = pk2(siluf_(v8[0]) * sc, siluf_(v8[1]) * sc); o.y = pk2(siluf_(v8[2]) * sc, siluf_(v8[3]) * sc); o.z = pk2(siluf_(v8[4]) * sc, siluf_(v8[5]) * sc); o.w = pk2(siluf_(v8[6]) * sc, siluf_(v8[7]) * sc);
            *(u32x4*)(Ks + l * 272 + ch * 16) = o;
#pragma unroll
            for (int e = 0; e < 8; ++e) *(bf16_t*)(VT + (ch * 8 + e) * 272 + l * 2) = (bf16_t)((e & 1) ? (x[e >> 1] >> 16) : (x[e >> 1] & 0xffffu));
            *(u32x4*)(CT + l * 272 + ch * 16) = cst;
        }
        if (tid < 128) s_nst[tid] = NST[unit * 128 + tid];
        __syncthreads();
        if (tid < 128) { const float mst = MST[unit]; const float bc = gs[tid]; const float mo = bc + fmaxf(mst, gs[384 + tid]); s_mo[tid] = mo; s_wi[tid] = __expf(bc + mst - mo); }
        __syncthreads();
        const int l = 16 * wave + fr;
        f32x4 s[8];
        bf16x8 qf[4];
#pragma unroll
        for (int ks = 0; ks < 4; ++ks) qf[ks] = *(const bf16x8*)(Qs + l * 272 + (32 * ks + 8 * fq) * 2);
#pragma unroll
        for (int t = 0; t < 8; ++t) {
            s[t] = (f32x4){0.f, 0.f, 0.f, 0.f};
            if (t <= wave) {
#pragma unroll
                for (int ks = 0; ks < 4; ++ks) { const bf16x8 kf = *(const bf16x8*)(Ks + (16 * t + fr) * 272 + (32 * ks + 8 * fq) * 2); s[t] = mfma16(kf, qf[ks], s[t]); }
            }
        }
        const float bl = gs[l], mol = s_mo[l];
        float dsum = 0.f;
#pragma unroll
        for (int t = 0; t < 8; ++t)
#pragma unroll
            for (int r = 0; r < 4; ++r) {
                const int si = 16 * t + 4 * fq + r; float wv = 0.f;
                if (t <= wave && si <= l) wv = __expf(bl + gs[128 + si] - mol) * s[t][r];
                s[t][r] = wv; dsum += wv;
            }
        dsum += __shfl_xor(dsum, 16); dsum += __shfl_xor(dsum, 32);
        float qn = 0.f;
        {
            const char* qrow = Qs + l * 272 + fq * 64;
#pragma unroll
            for (int i = 0; i < 4; ++i) {
                const u32x4 x = *(const u32x4*)(qrow + 16 * i); const float* nn = s_nst + fq * 32 + 8 * i;
                qn += bflo(x[0]) * nn[0] + bfhi(x[0]) * nn[1] + bflo(x[1]) * nn[2] + bfhi(x[1]) * nn[3] + bflo(x[2]) * nn[4] + bfhi(x[2]) * nn[5] + bflo(x[3]) * nn[6] + bfhi(x[3]) * nn[7];
            }
        }
        qn += __shfl_xor(qn, 16); qn += __shfl_xor(qn, 32);
        __syncthreads();
#pragma unroll
        for (int t = 0; t < 8; ++t)
            if (t <= wave + 1) { u32x2 o; o.x = pk2(s[t][0], s[t][1]); o.y = pk2(s[t][2], s[t][3]); *(u32x2*)(Ks + l * 272 + (16 * t + 4 * fq) * 2) = o; }
        __syncthreads();
        f32x4 acc[8];
#pragma unroll
        for (int t = 0; t < 8; ++t) acc[t] = (f32x4){0.f, 0.f, 0.f, 0.f};
#pragma unroll
        for (int ks = 0; ks < 4; ++ks)
#pragma unroll
            for (int t = 0; t < 8; ++t) { const bf16x8 cf = *(const bf16x8*)(CT + (16 * t + fr) * 272 + (32 * ks + 8 * fq) * 2); acc[t] = mfma16(cf, qf[ks], acc[t]); }
        const float wi = s_wi[l];
#pragma unroll
        for (int t = 0; t < 8; ++t) acc[t] = acc[t] * wi;
        const int nks = (wave + 2) >> 1;
#pragma unroll
        for (int ks = 0; ks < 4; ++ks)
            if (ks < nks) {
                const bf16x8 wf = *(const bf16x8*)(Ks + l * 272 + (32 * ks + 8 * fq) * 2);
#pragma unroll
                for (int t = 0; t < 8; ++t) { const bf16x8 vf = *(const bf16x8*)(VT + (16 * t + fr) * 272 + (32 * ks + 8 * fq) * 2); acc[t] = mfma16(vf, wf, acc[t]); }
            }
        const float den = dsum + wi * qn;
        const float invd = 1.f / fmaxf(fabsf(den), __expf(-mol));
        bf16_t* mop = PM + (size_t)(rowbase + l) * LPM + 1536 + h * 128 + 4 * fq;
        float ssq = 0.f;
        u32x2 g2v[8]; float4 nwv[8];
#pragma unroll
        for (int t = 0; t < 8; ++t) { g2v[t] = *(const u32x2*)(mop + 16 * t); nwv[t] = *(const float4*)(p.mnorm_w + h * 128 + 16 * t + 4 * fq); }
#pragma unroll
        for (int t = 0; t < 8; ++t) {
            const u32x2 g2 = g2v[t];
            const float gg[4] = {bflo(g2.x), bfhi(g2.x), bflo(g2.y), bfhi(g2.y)};
#pragma unroll
            for (int r = 0; r < 4; ++r) { const float hv = acc[t][r] * invd * sigmoidf_(gg[r]); acc[t][r] = hv; ssq += hv * hv; }
        }
        ssq += __shfl_xor(ssq, 16); ssq += __shfl_xor(ssq, 32);
        const float rn = rsqrtf(ssq * (1.f / 128.f) + 1e-6f);
#pragma unroll
        for (int t = 0; t < 8; ++t) {
            const float4 nw = nwv[t];
            u32x2 o; o.x = pk2(acc[t][0] * rn * nw.x, acc[t][1] * rn * nw.y); o.y = pk2(acc[t][2] * rn * nw.z, acc[t][3] * rn * nw.w);
            *(u32x2*)((bf16_t*)(p.ws + WS_ML) + (size_t)(rowbase + l) * 512 + h * 128 + 4 * fq + 16 * t) = o;
        }
    }
}

DEV void stage_norm2(const Params& p, char* lds, int vb, int nvb) {
    const int tid = threadIdx.x, lane = tid & 63, wave = __builtin_amdgcn_readfirstlane(tid >> 6);
    const float* mod = (const float*)(p.ws + WS_MOD);
    bf16_t* U2 = (bf16_t*)(p.ws + WS_PG);
    const int rstride = nvb * NW;
    for (int mb = vb * NW + wave; mb < M; mb += 4 * rstride) {
        float4 vv[4][4];
#pragma unroll
        for (int rr = 0; rr < 4; ++rr) { const int mr = mb + rr * rstride < M ? mb + rr * rstride : mb; const float4* xr = (const float4*)(p.out + (size_t)mr * D);
#pragma unroll
            for (int j = 0; j < 4; ++j) vv[rr][j] = xr[lane + 64 * j]; }
#pragma unroll
        for (int rr = 0; rr < 4; ++rr) {
            const int m = mb + rr * rstride;
            if (m < M) {
                const int b = m >= SEQ ? 1 : 0;
                float ss = 0.f;
#pragma unroll
                for (int j = 0; j < 4; ++j) { const float4 v = vv[rr][j]; ss += v.x * v.x + v.y * v.y + v.z * v.z + v.w * v.w; }
                ss = wave_sum(ss);
                const float rstd = rsqrtf(ss * (1.f / 1024.f) + 1e-6f);
#pragma unroll
                for (int j = 0; j < 4; ++j) {
                    const int col = 4 * (lane + 64 * j); const float4 v = vv[rr][j];
                    const float4 w1 = *(const float4*)(p.norm2_w + col), sc = *(const float4*)(mod + b * 6144 + 4096 + col), sh = *(const float4*)(mod + b * 6144 + 3072 + col);
                    u32x2 o;
                    o.x = pk2(v.x * rstd * w1.x * (1.f + sc.x) + sh.x, v.y * rstd * w1.y * (1.f + sc.y) + sh.y);
                    o.y = pk2(v.z * rstd * w1.z * (1.f + sc.z) + sh.z, v.w * rstd * w1.w * (1.f + sc.w) + sh.w);
                    *(u32x2*)(U2 + (size_t)m * D + col) = o;
                }
            }
        }
    }
}

constexpr size_t WS_SELI = 400 * MiB;
constexpr size_t WS_SELG = 416 * MiB;
constexpr size_t WS_SC = 64 * MiB;
DEV unsigned f2ord(float f) { const unsigned u = __float_as_uint(f); return (u & 0x80000000u) ? ~u : (u | 0x80000000u); }
DEV float ord2f(unsigned k) { return __uint_as_float((k & 0x80000000u) ? (k ^ 0x80000000u) : ~k); }
DEV unsigned umax_(unsigned a, unsigned b) { return a > b ? a : b; }

DEV void stage_gemm_q(const Params& p, char* lds, int vb, int nvb) {
    pg8::Gemm g{(const bf16_t*)(p.ws + WS_PG), (const bf16_t*)(p.ws + WS_WQ), M, 2048, 1024, 1024, 1024};
    pg8::StaticOrder S; S.init(M, 2048, nvb, vb);
    pg8::EpiF32 E{(float*)(p.ws + WS_SC), 2048};
    pg8::gemm_phase<pg8::EpiF32, pg8::StaticOrder, true, true>((PG8_LAS unsigned char*)lds, g, S, E);
}

DEV unsigned umin_(unsigned a, unsigned b) { return a < b ? a : b; }
template <int N> DEV void bitonic_sort_desc(unsigned (&a)[N]) {
#pragma unroll
    for (int k = 2; k <= N; k <<= 1)
#pragma unroll
        for (int j = k >> 1; j > 0; j >>= 1)
#pragma unroll
            for (int i = 0; i < N; ++i) { const int l = i ^ j; if (l > i) { const unsigned x = a[i], y = a[l]; const bool dsc = (i & k) == 0; a[i] = dsc ? umax_(x, y) : umin_(x, y); a[l] = dsc ? umin_(x, y) : umax_(x, y); } }
}
template <int N> DEV void bitonic_merge_desc(unsigned (&a)[N]) {
#pragma unroll
    for (int j = N >> 1; j > 0; j >>= 1)
#pragma unroll
        for (int i = 0; i < N; ++i) { const int l = i ^ j; if (l > i) { const unsigned x = a[i], y = a[l]; a[i] = umax_(x, y); a[l] = umin_(x, y); } }
}
template <bool X16> DEV void merge_top16_xlane(unsigned (&x)[16], int lane) {
    unsigned m[16];
#pragma unroll
    for (int i = 0; i < 16; ++i) {
        unsigned pv;
        if (X16) { auto r = __builtin_amdgcn_permlane16_swap(x[15 - i], x[15 - i], false, false); pv = (lane & 16) ? r[0] : r[1]; }
        else { auto r = __builtin_amdgcn_permlane32_swap(x[15 - i], x[15 - i], false, false); pv = (lane & 32) ? r[0] : r[1]; }
        m[i] = umax_(x[i], pv);
    }
    bitonic_merge_desc<16>(m);
#pragma unroll
    for (int i = 0; i < 16; ++i) x[i] = m[i];
}

DEV void stage_q_topk(const Params& p, char* lds, int vb, int nvb) {
    const int tid = threadIdx.x, lane = tid & 63, wave = __builtin_amdgcn_readfirstlane(tid >> 6), fr = lane & 15, fq = lane >> 4;
    unsigned* tops = (unsigned*)lds;
    unsigned char* ptab = (unsigned char*)(lds + 16384);
    const float* SC = (const float*)(p.ws + WS_SC);
    int* SELI = (int*)(p.ws + WS_SELI); float* SELG = (float*)(p.ws + WS_SELG);
    __syncthreads();
    if (tid < 64) { int cnt = 0; unsigned char v = 0xff; for (int i = 0; i < 16; ++i) for (int j = 0; j < 16 / (i + 1); ++j) { if (cnt == tid) v = (unsigned char)(i | (j << 4)); ++cnt; } ptab[tid] = v; }
    __syncthreads();
    for (int item = vb; item < 2048; item += nvb) {
        const int mt = item >> 3, h = item & 7, m0 = mt * 128;
        const float* srow = SC + (size_t)(m0 + 16 * wave + fr) * 2048 + h * 256 + 4 * fq;
        f32x4 sv[2][8];
#pragma unroll
        for (int pp = 0; pp < 2; ++pp)
#pragma unroll
            for (int t = 0; t < 8; ++t) sv[pp][t] = *(const f32x4*)(srow + pp * 128 + 16 * t);
        unsigned* tp = tops + (16 * wave + fr) * 32;
#pragma unroll
        for (int pp = 0; pp < 2; ++pp) {
            unsigned lo[16], hi[16];
#pragma unroll
            for (int t = 0; t < 4; ++t)
#pragma unroll
                for (int r = 0; r < 4; ++r) {
                    lo[4 * t + r] = (f2ord(sv[pp][t][r]) & ~127u) | (127u - (unsigned)(16 * t + 4 * fq + r));
                    hi[4 * t + r] = (f2ord(sv[pp][t + 4][r]) & ~127u) | (127u - (unsigned)(16 * (t + 4) + 4 * fq + r));
                }
            bitonic_sort_desc<16>(lo); bitonic_sort_desc<16>(hi);
#pragma unroll
            for (int i = 0; i < 16; ++i) lo[i] = umax_(lo[i], hi[15 - i]);
            bitonic_merge_desc<16>(lo);
            merge_top16_xlane<true>(lo, lane); merge_top16_xlane<false>(lo, lane);
            if (fq == 0) {
#pragma unroll
                for (int q = 0; q < 4; ++q) *(u32x4*)(tp + pp * 16 + 4 * q) = (u32x4){lo[4 * q], lo[4 * q + 1], lo[4 * q + 2], lo[4 * q + 3]};
            }
        }
        wave_lds_sync();
        unsigned ck[16];
#pragma unroll
        for (int sl = 0; sl < 13; ++sl) {
            const unsigned pr = ptab[4 * sl + fq]; const unsigned i = pr & 15u, j = pr >> 4;
            const float sum = ord2f(tp[i] & ~127u) + ord2f(tp[16 + (j & 15u)] & ~127u);
            ck[sl] = pr != 0xffu ? ((f2ord(sum) & ~255u) | (255u - (i * 16u + j))) : 0u;
        }
        ck[13] = 0u; ck[14] = 0u; ck[15] = 0u;
        bitonic_sort_desc<16>(ck);
        merge_top16_xlane<true>(ck, lane); merge_top16_xlane<false>(ck, lane);
        const float v0 = ord2f(ck[0] & ~255u);
        float ex[16], sm = 0.f;
#pragma unroll
        for (int r = 0; r < 16; ++r) { ex[r] = __expf(ord2f(ck[r] & ~255u) - v0); sm += ex[r]; }
        const float rs = 1.f / sm;
        int oi[4]; float og[4];
#pragma unroll
        for (int q = 0; q < 4; ++q) {
            const unsigned w = fq == 0 ? ck[q] : (fq == 1 ? ck[4 + q] : (fq == 2 ? ck[8 + q] : ck[12 + q]));
            const float e = fq == 0 ? ex[q] : (fq == 1 ? ex[4 + q] : (fq == 2 ? ex[8 + q] : ex[12 + q]));
            const unsigned flat = 255u - (w & 255u); const unsigned ia = flat >> 4, jb = flat & 15u;
            oi[q] = (int)((127u - (tp[ia] & 127u)) * 128u + (127u - (tp[16 + jb] & 127u)));
            og[q] = e * rs;
        }
        const size_t so = (size_t)(m0 + 16 * wave + fr) * 128 + h * 16 + 4 * fq;
        *(int4*)(SELI + so) = make_int4(oi[0], oi[1], oi[2], oi[3]);
        *(float4*)(SELG + so) = make_float4(og[0], og[1], og[2], og[3]);
        wave_lds_sync();
    }
}

DEV float dpp_row_sum(float v) {
    v += __int_as_float(__builtin_amdgcn_update_dpp(0, __float_as_int(v), 0xB1, 0xF, 0xF, true));
    v += __int_as_float(__builtin_amdgcn_update_dpp(0, __float_as_int(v), 0x4E, 0xF, 0xF, true));
    v += __int_as_float(__builtin_amdgcn_update_dpp(0, __float_as_int(v), 0x141, 0xF, 0xF, true));
    v += __int_as_float(__builtin_amdgcn_update_dpp(0, __float_as_int(v), 0x140, 0xF, 0xF, true));
    return v;
}
DEV int dpp_row_isum(int v) {
    v += __builtin_amdgcn_update_dpp(0, v, 0xB1, 0xF, 0xF, true); v += __builtin_amdgcn_update_dpp(0, v, 0x4E, 0xF, 0xF, true);
    v += __builtin_amdgcn_update_dpp(0, v, 0x141, 0xF, 0xF, true); v += __builtin_amdgcn_update_dpp(0, v, 0x140, 0xF, 0xF, true);
    return v;
}
DEV float dpp_row_max(float v) {
    v = fmaxf(v, __int_as_float(__builtin_amdgcn_update_dpp(0, __float_as_int(v), 0xB1, 0xF, 0xF, true))); v = fmaxf(v, __int_as_float(__builtin_amdgcn_update_dpp(0, __float_as_int(v), 0x4E, 0xF, 0xF, true)));
    v = fmaxf(v, __int_as_float(__builtin_amdgcn_update_dpp(0, __float_as_int(v), 0x141, 0xF, 0xF, true))); v = fmaxf(v, __int_as_float(__builtin_amdgcn_update_dpp(0, __float_as_int(v), 0x140, 0xF, 0xF, true)));
    return v;
}
DEV float gelu_as(float v) {
    const float av = fabsf(v), t = __builtin_amdgcn_rcpf(av * 0.2316418882f + 1.0f);
    float q = t * 0.5307027145f + (-0.7265760135f); q = q * t + 0.7107068705f; q = q * t + (-0.142248368f); q = q * t + 0.127414796f; q = q * t;
    const float e = __builtin_amdgcn_exp2f(v * v * (-0.72134752044f));
    const float m = v * (q * e);
    return v < 0.f ? m : v - m;
}
constexpr int NBIN = 16;
constexpr int GW_IDX = 0, GW_GATE = 1024, GW_SU = 3072, GW_SV = 5120, GW_W = 7168, GW_WQ = 9216, GW_BYTES = 9728;
DEV void g_sort_token(const int* SELI, const float* SELG, const float* SU, const float* SV, int tkn, char* wl, int j, int lane, int msk) {
    const int i0 = SELI[(size_t)tkn * 128 + lane] & msk, i1 = SELI[(size_t)tkn * 128 + 64 + lane] & msk;
    const float g0 = SELG[(size_t)tkn * 128 + lane], g1 = SELG[(size_t)tkn * 128 + 64 + lane];
    const float su0 = SU[i0], su1 = SU[i1], sv0 = SV[i0], sv1 = SV[i1];
    const int s0 = i0 >> 10, s1 = i1 >> 10;
    const unsigned long long lt = (1ull << lane) - 1ull;
    int base = 0, p0 = 0, p1 = 0;
#pragma unroll
    for (int s = 0; s < NBIN; ++s) {
        const unsigned long long m0 = __ballot(s0 == s), m1 = __ballot(s1 == s);
        const int c0 = __popcll(m0), c1 = __popcll(m1);
        if (s0 == s) p0 = base + __popcll(m0 & lt);
        if (s1 == s) p1 = base + c0 + __popcll(m1 & lt);
        base += c0 + c1;
    }
    unsigned short* li = (unsigned short*)(wl + GW_IDX) + j * 128; float* lg = (float*)(wl + GW_GATE) + j * 128; float* lsu = (float*)(wl + GW_SU) + j * 128; float* lsv = (float*)(wl + GW_SV) + j * 128;
    li[p0] = (unsigned short)i0; lg[p0] = g0; lsu[p0] = su0; lsv[p0] = sv0;
    li[p1] = (unsigned short)i1; lg[p1] = g1; lsu[p1] = su1; lsv[p1] = sv1;
}
DEV void r_load(u32x4 (&d)[4], const unsigned char* T, int id, int c) {
    const u32x4* q = (const u32x4*)(T + (size_t)id * 1024) + c;
#pragma unroll
    for (int k = 0; k < 4; ++k) d[k] = q[16 * k];
}
DEV int r_dotq(const u32x4 (&u)[4], const unsigned (&xq)[16]) {
    int s0 = 0, s1 = 0, s2 = 0, s3 = 0;
#pragma unroll
    for (int k = 0; k < 4; ++k) {
        s0 = __builtin_amdgcn_sdot4((int)u[k][0], (int)xq[4 * k], s0, false); s1 = __builtin_amdgcn_sdot4((int)u[k][1], (int)xq[4 * k + 1], s1, false);
        s2 = __builtin_amdgcn_sdot4((int)u[k][2], (int)xq[4 * k + 2], s2, false); s3 = __builtin_amdgcn_sdot4((int)u[k][3], (int)xq[4 * k + 3], s3, false);
    }
    return (s0 + s1) + (s2 + s3);
}
DEV float r_weight(int part, float sx, const char* wl, int r, int e) {
    const float d = (float)dpp_row_isum(part) * (((const float*)(wl + GW_SU))[r * 128 + e] * sx);
    return ((const float*)(wl + GW_GATE))[r * 128 + e] * gelu_as(d) * ((const float*)(wl + GW_SV))[r * 128 + e];
}
DEV void r_vaccq(const u32x4 (&v0)[4], const u32x4 (&v1)[4], const u32x4 (&v2)[4], const u32x4 (&v3)[4], unsigned wpk, int (&acc)[64]) {
#pragma unroll
    for (int k = 0; k < 4; ++k)
#pragma unroll
        for (int w = 0; w < 4; ++w) {
            const unsigned r0 = v0[k][w], r1 = v1[k][w], r2 = v2[k][w], r3 = v3[k][w];
            const unsigned p0 = __builtin_amdgcn_perm(r1, r0, 0x05010400u), p1 = __builtin_amdgcn_perm(r1, r0, 0x07030602u);
            const unsigned q0 = __builtin_amdgcn_perm(r3, r2, 0x05010400u), q1 = __builtin_amdgcn_perm(r3, r2, 0x07030602u);
            const unsigned t0 = __builtin_amdgcn_perm(q0, p0, 0x05040100u), t1 = __builtin_amdgcn_perm(q0, p0, 0x07060302u);
            const unsigned t2 = __builtin_amdgcn_perm(q1, p1, 0x05040100u), t3 = __builtin_amdgcn_perm(q1, p1, 0x07060302u);
            const int o = 16 * k + 4 * w;
            acc[o] = __builtin_amdgcn_sdot4((int)t0, (int)wpk, acc[o], false); acc[o + 1] = __builtin_amdgcn_sdot4((int)t1, (int)wpk, acc[o + 1], false);
            acc[o + 2] = __builtin_amdgcn_sdot4((int)t2, (int)wpk, acc[o + 2], false); acc[o + 3] = __builtin_amdgcn_sdot4((int)t3, (int)wpk, acc[o + 3], false);
        }
}
DEV void r_load2(u32x4 (&d)[2], const unsigned char* T, int id, int c, int hh) {
    const u32x4* q = (const u32x4*)(T + (size_t)id * 1024) + c + 32 * hh;
    d[0] = q[0]; d[1] = q[16];
}
template <int HH> DEV void r_vaccq2(const u32x4 (&v0)[2], const u32x4 (&v1)[2], const u32x4 (&v2)[2], const u32x4 (&v3)[2], unsigned wpk, int (&acc)[64]) {
#pragma unroll
    for (int kk = 0; kk < 2; ++kk)
#pragma unroll
        for (int w = 0; w < 4; ++w) {
            const unsigned r0 = v0[kk][w], r1 = v1[kk][w], r2 = v2[kk][w], r3 = v3[kk][w];
            const unsigned p0 = __builtin_amdgcn_perm(r1, r0, 0x05010400u), p1 = __builtin_amdgcn_perm(r1, r0, 0x07030602u);
            const unsigned q0 = __builtin_amdgcn_perm(r3, r2, 0x05010400u), q1 = __builtin_amdgcn_perm(r3, r2, 0x07030602u);
            const unsigned t0 = __builtin_amdgcn_perm(q0, p0, 0x05040100u), t1 = __builtin_amdgcn_perm(q0, p0, 0x07060302u);
            const unsigned t2 = __builtin_amdgcn_perm(q1, p1, 0x05040100u), t3 = __builtin_amdgcn_perm(q1, p1, 0x07060302u);
            const int o = 16 * (2 * HH + kk) + 4 * w;
            acc[o] = __builtin_amdgcn_sdot4((int)t0, (int)wpk, acc[o], false); acc[o + 1] = __builtin_amdgcn_sdot4((int)t1, (int)wpk, acc[o + 1], false);
            acc[o + 2] = __builtin_amdgcn_sdot4((int)t2, (int)wpk, acc[o + 2], false); acc[o + 3] = __builtin_amdgcn_sdot4((int)t3, (int)wpk, acc[o + 3], false);
        }
}
struct VB4 { u32x4 e0[2], e1[2], e2[2], e3[2]; };
DEV void vb_load(VB4& b, const unsigned char* TV, const unsigned short* myi, int g, int c, int hh) {
    const int e = g < 32 ? 4 * g : 124;
    r_load2(b.e0, TV, (int)myi[e], c, hh); r_load2(b.e1, TV, (int)myi[e + 1], c, hh); r_load2(b.e2, TV, (int)myi[e + 2], c, hh); r_load2(b.e3, TV, (int)myi[e + 3], c, hh);
}
template <int HH> DEV void pass2_half(const unsigned char* TV, const unsigned short* myi, const unsigned* lwq, int c, int (&acc)[64]) {
    VB4 ba, bb, bc, bd;
    vb_load(ba, TV, myi, 0, c, HH); vb_load(bb, TV, myi, 1, c, HH); vb_load(bc, TV, myi, 2, c, HH); vb_load(bd, TV, myi, 3, c, HH);
    for (int g = 0; g < 32; g += 4) {
        __builtin_amdgcn_sched_barrier(0); r_vaccq2<HH>(ba.e0, ba.e1, ba.e2, ba.e3, lwq[g], acc);     __builtin_amdgcn_sched_barrier(0); vb_load(ba, TV, myi, g + 4, c, HH);
        __builtin_amdgcn_sched_barrier(0); r_vaccq2<HH>(bb.e0, bb.e1, bb.e2, bb.e3, lwq[g + 1], acc); __builtin_amdgcn_sched_barrier(0); vb_load(bb, TV, myi, g + 5, c, HH);
        __builtin_amdgcn_sched_barrier(0); r_vaccq2<HH>(bc.e0, bc.e1, bc.e2, bc.e3, lwq[g + 2], acc); __builtin_amdgcn_sched_barrier(0); vb_load(bc, TV, myi, g + 6, c, HH);
        __builtin_amdgcn_sched_barrier(0); r_vaccq2<HH>(bd.e0, bd.e1, bd.e2, bd.e3, lwq[g + 3], acc); __builtin_amdgcn_sched_barrier(0); vb_load(bd, TV, myi, g + 7, c, HH);
        __builtin_amdgcn_sched_barrier(0);
    }
}
#define SB_() __builtin_amdgcn_sched_barrier(0)

DEV void stage_peer_gather(const Params& p, char* lds, int slot, int nslots, bool dry = false, int msk = 0x3fff) {
    const int tid = threadIdx.x, lane = tid & 63, wave = __builtin_amdgcn_readfirstlane(tid >> 6), r = lane >> 4, c = lane & 15;
    const bf16_t* U2 = (const bf16_t*)(p.ws + WS_PG);
    const unsigned char* TU = p.ws + WS_TU; const unsigned char* TV = p.ws + WS_TV;
    const float* SU = (const float*)(p.ws + WS_ISU); const float* SV = (const float*)(p.ws + WS_ISV);
    const int* SELI = (const int*)(p.ws + WS_SELI); const float* SELG = (const float*)(p.ws + WS_SELG);
    const float* mod = (const float*)(p.ws + WS_MOD);
    char* wl = lds + wave * GW_BYTES;
    const unsigned short* myi = (const unsigned short*)(wl + GW_IDX) + r * 128;
    float* lw = (float*)(wl + GW_W) + r * 128; unsigned* lwq = (unsigned*)(wl + GW_WQ) + r * 32;
    const int tpb = M / nslots;
    __syncthreads();
    for (int g0 = 0; g0 < tpb; g0 += 32) {
        __syncthreads();
        const int tbase = slot * tpb + g0 + 4 * wave;
#pragma unroll
        for (int j = 0; j < 4; ++j) g_sort_token(SELI, SELG, SU, SV, tbase + j, wl, j, lane, msk);
        const int tkn = tbase + r;
        unsigned xq[16]; float sx;
        {
            const bf16_t* xr = U2 + (size_t)tkn * D + 16 * c;
            u32x4 t[8]; float amax = 0.f;
#pragma unroll
            for (int k = 0; k < 8; ++k) { t[k] = *(const u32x4*)(xr + 256 * (k >> 1) + 8 * (k & 1));
#pragma unroll
                for (int i = 0; i < 4; ++i) amax = fmaxf(amax, fmaxf(fabsf(bflo(t[k][i])), fabsf(bfhi(t[k][i])))); }
            amax = dpp_row_max(amax);
            const float inv = amax > 0.f ? 127.f / amax : 0.f; sx = amax > 0.f ? amax * (1.f / 127.f) : 1.f;
#pragma unroll
            for (int k = 0; k < 8; ++k)
#pragma unroll
                for (int h2 = 0; h2 < 2; ++h2) {
                    const unsigned a = t[k][2 * h2], b = t[k][2 * h2 + 1];
                    const unsigned wv = ((unsigned)__float2int_rn(bflo(a) * inv) & 0xffu) | (((unsigned)__float2int_rn(bfhi(a) * inv) & 0xffu) << 8) | (((unsigned)__float2int_rn(bflo(b) * inv) & 0xffu) << 16) | ((unsigned)__float2int_rn(bfhi(b) * inv) << 24);
                    xq[2 * k + h2] = wv;
                }
        }
        wave_lds_sync();
        float wmax = 0.f;
        {
            u32x4 ua[4], ub[4], uc[4], ud[4];
            r_load(ua, TU, (int)myi[0], c); r_load(ub, TU, (int)myi[1], c); r_load(uc, TU, (int)myi[2], c); r_load(ud, TU, (int)myi[3], c);
            for (int e = 0; e < 128; e += 4) {
                SB_(); const int pa = r_dotq(ua, xq); SB_(); r_load(ua, TU, (int)myi[e + 4 < 128 ? e + 4 : 127], c); SB_();
                const int pb = r_dotq(ub, xq); SB_(); r_load(ub, TU, (int)myi[e + 5 < 128 ? e + 5 : 127], c); SB_();
                const int pc = r_dotq(uc, xq); SB_(); r_load(uc, TU, (int)myi[e + 6 < 128 ? e + 6 : 127], c); SB_();
                const int pd = r_dotq(ud, xq); SB_(); r_load(ud, TU, (int)myi[e + 7 < 128 ? e + 7 : 127], c); SB_();
                const float w0 = r_weight(pa, sx, wl, r, e), w1 = r_weight(pb, sx, wl, r, e + 1), w2 = r_weight(pc, sx, wl, r, e + 2), w3 = r_weight(pd, sx, wl, r, e + 3);
                wmax = fmaxf(fmaxf(wmax, fmaxf(fabsf(w0), fabsf(w1))), fmaxf(fabsf(w2), fabsf(w3)));
                if (c == 0) *(f32x4*)(lw + e) = (f32x4){w0, w1, w2, w3};
            }
        }
        __syncthreads();
        const float T = wmax > 0.f ? wmax * (1.f / 127.f) : 1.f, invT = wmax > 0.f ? 127.f / wmax : 0.f;
        wave_lds_sync();
#pragma unroll
        for (int h2 = 0; h2 < 2; ++h2) {
            const int gg = c + 16 * h2; const f32x4 wv = *(const f32x4*)(lw + 4 * gg);
            lwq[gg] = ((unsigned)__float2int_rn(wv[0] * invT) & 0xffu) | (((unsigned)__float2int_rn(wv[1] * invT) & 0xffu) << 8) | (((unsigned)__float2int_rn(wv[2] * invT) & 0xffu) << 16) | ((unsigned)__float2int_rn(wv[3] * invT) << 24);
        }
        wave_lds_sync();
        int acc[64];
#pragma unroll
        for (int i = 0; i < 64; ++i) acc[i] = 0;
        pass2_half<0>(TV, myi, lwq, c, acc);
        pass2_half<1>(TV, myi, lwq, c, acc);
        const int b = tkn >= SEQ ? 1 : 0;
        float* hr = p.out + (size_t)tkn * D + 16 * c;
        const float* g2p = mod + b * 6144 + 5120 + 16 * c;
        float y[64]; float ss = 0.f;
#pragma unroll
        for (int q = 0; q < 16; ++q) {
            const int eo = 256 * (q >> 2) + 4 * (q & 3);
            const float4 hv = *(const float4*)(hr + eo); const float4 g2 = *(const float4*)(g2p + eo);
            y[4 * q] = hv.x + g2.x * (T * (float)acc[4 * q]); y[4 * q + 1] = hv.y + g2.y * (T * (float)acc[4 * q + 1]);
            y[4 * q + 2] = hv.z + g2.z * (T * (float)acc[4 * q + 2]); y[4 * q + 3] = hv.w + g2.w * (T * (float)acc[4 * q + 3]);
            ss += y[4 * q] * y[4 * q] + y[4 * q + 1] * y[4 * q + 1] + y[4 * q + 2] * y[4 * q + 2] + y[4 * q + 3] * y[4 * q + 3];
        }
        ss = dpp_row_sum(ss);
        const float rstd = rsqrtf(ss * (1.f / 1024.f) + 1e-6f);
        float4 nwv[16];
#pragma unroll
        for (int q = 0; q < 16; ++q) nwv[q] = *(const float4*)(p.normf_w + 16 * c + 256 * (q >> 2) + 4 * (q & 3));
        if (!dry || rstd == 123.456f)
#pragma unroll
        for (int q = 0; q < 16; ++q) {
            const int eo = 256 * (q >> 2) + 4 * (q & 3);
            const float4 nw = nwv[q];
            float4 o; o.x = y[4 * q] * rstd * nw.x; o.y = y[4 * q + 1] * rstd * nw.y; o.z = y[4 * q + 2] * rstd * nw.z; o.w = y[4 * q + 3] * rstd * nw.w;
            *(float4*)(hr + eo) = o;
        }
        wave_lds_sync();
    }
}

#define LAS __attribute__((address_space(3)))
#define XB_TMO      128
#define XB_XCNT(j)  (256  + 64 * (j))
#define XB_XSUB(j)  (1280 + 64 * (j))
#define XB_XGEN(j)  (2304 + 64 * (j))
#define XB_TOP      3328
#define XB_TOPGEN   3392
#define XCD_BAR_WORDS 3456
#define XB_SPIN_CAP (1u << 18)

__device__ __forceinline__ unsigned xb_ld(unsigned* p)              { return __hip_atomic_load(p, __ATOMIC_RELAXED, __HIP_MEMORY_SCOPE_AGENT); }
__device__ __forceinline__ unsigned xb_add(unsigned* p, unsigned v) { return __hip_atomic_fetch_add(p, v, __ATOMIC_RELAXED, __HIP_MEMORY_SCOPE_AGENT); }
__device__ __forceinline__ unsigned xb_xcc_id() { return (unsigned)__builtin_amdgcn_s_getreg((3 << 11) | 20) & 0xFu; }
#define XB_SPIN(cond, bar) do { unsigned _sp = 0; while (cond) { __builtin_amdgcn_s_sleep(1); \
    if ((++_sp & 255u) == 0u) { if (xb_ld(&(bar)[XB_TMO])) break; if (_sp > XB_SPIN_CAP) { atomicAdd(&(bar)[XB_TMO], 1u); break; } } } } while (0)

struct XcdBarrier {
    unsigned* bar; unsigned x;
    volatile LAS unsigned* st;
};

__device__ __forceinline__ XcdBarrier xcd_barrier_post(unsigned* bar, volatile LAS unsigned* st) {
    XcdBarrier b; b.bar = bar; b.x = xb_xcc_id(); b.st = st;
    if (threadIdx.x == 0) (void)xb_add(&bar[XB_XCNT(b.x)], 1u);
    return b;
}
__device__ __forceinline__ void xcd_barrier_complete(unsigned* bar, unsigned x, unsigned& nloc, unsigned& nx) {
    const unsigned G = gridDim.x * gridDim.y * gridDim.z;
    unsigned sum, cnt, mine, sp = 0u;
    for (;;) {
        sum = 0u; cnt = 0u; mine = 0u;
#pragma unroll
        for (unsigned j = 0; j < 16; ++j) { const unsigned c = xb_ld(&bar[XB_XCNT(j)]); sum += c; cnt += (c > 0u) ? 1u : 0u; mine = (j == x) ? c : mine; }
        if (sum == G) break;
        __builtin_amdgcn_s_sleep(1);
        if ((++sp & 255u) == 0u) { if (xb_ld(&bar[XB_TMO])) break; if (sp > XB_SPIN_CAP) { atomicAdd(&bar[XB_TMO], 1u); break; } }
    }
    nloc = mine > 0u ? mine : 1u; nx = cnt > 0u ? cnt : 1u;
}

__device__ __forceinline__ void xcd_barrier(const XcdBarrier& b) {
    asm volatile("s_waitcnt vmcnt(0)" ::: "memory");
    __syncthreads();
    if (threadIdx.x == 0) {
        unsigned* bar = b.bar;
        __builtin_amdgcn_s_waitcnt(0);
        unsigned nloc = b.st[0], nx = b.st[1];
        if (nloc == 0u) { xcd_barrier_complete(bar, b.x, nloc, nx); b.st[0] = nloc; b.st[1] = nx; }
        const unsigned old = xb_add(&bar[XB_XSUB(b.x)], 1u);
        const unsigned gen = old / nloc;
        if (old + 1u == (gen + 1u) * nloc) {
            __builtin_amdgcn_fence(__ATOMIC_RELEASE, "agent");
            asm volatile("s_waitcnt vmcnt(0)" ::: "memory");
            const unsigned og = xb_add(&bar[XB_TOP], 1u);
            const unsigned tg = og / nx;
            if (og + 1u == (tg + 1u) * nx) xb_add(&bar[XB_TOPGEN], 1u);
            else XB_SPIN(xb_ld(&bar[XB_TOPGEN]) == tg, bar);
            __builtin_amdgcn_fence(__ATOMIC_ACQUIRE, "agent");
            xb_add(&bar[XB_XGEN(b.x)], 1u);
            asm volatile("s_waitcnt vmcnt(0)" ::: "memory");
        } else {
            XB_SPIN(xb_ld(&bar[XB_XGEN(b.x)]) == gen, bar);
            __builtin_amdgcn_fence(__ATOMIC_ACQUIRE, "agent");
            asm volatile("s_waitcnt vmcnt(0)" ::: "memory");
        }
    }
    __syncthreads();
}

namespace cg = cooperative_groups;
constexpr int LDS_BYTES = 151552;
constexpr int CW_RANK = XCD_BAR_WORDS;

constexpr int LDS_TOTAL = LDS_BYTES + 64;

__global__ void __launch_bounds__(512) k_mega(Params p) {
    extern __shared__ __attribute__((aligned(16))) char lds[];
    const int vb = blockIdx.x, nvb = gridDim.x;
    volatile LAS unsigned* bst = (volatile LAS unsigned*)((LAS char*)lds + LDS_BYTES);
    if (threadIdx.x < 16) bst[threadIdx.x] = 0u;
    __syncthreads();
    XcdBarrier bar = xcd_barrier_post((unsigned*)p.ws, bst);
    if (threadIdx.x == 0) bst[2] = xb_add((unsigned*)p.ws + CW_RANK + 64 * bar.x, 1u);
#define GRID_BAR() xcd_barrier(bar)
    stage_prep(p, lds, vb, nvb);        GRID_BAR();
    stage_norm1(p, lds, vb, nvb);       GRID_BAR();
    stage_gemm_in(p, lds, vb, nvb);     GRID_BAR();
    stage_attn(p, lds, vb, nvb);
    stage_mstate(p, lds, vb, nvb);      GRID_BAR();
    stage_mscan(p, lds, vb, nvb);       GRID_BAR();
    stage_mout(p, lds, vb, nvb);        GRID_BAR();
    stage_gemm_merge(p, lds, vb, nvb);  GRID_BAR();
    stage_gemm_out(p, lds, vb, nvb);    GRID_BAR();
    stage_norm2(p, lds, vb, nvb);       GRID_BAR();
    stage_gemm_q(p, lds, vb, nvb);      GRID_BAR();
    stage_q_topk(p, lds, vb, nvb);      GRID_BAR();
    if (threadIdx.x == 0) { unsigned base = 0u; for (unsigned j = 0; j < bar.x; ++j) base += xb_ld((unsigned*)p.ws + XB_XCNT(j)); bst[3] = base + bst[2]; }
    __syncthreads();
    const int slot = (int)bst[3];
#ifdef XPG
    stage_peer_gather(p, lds, slot < nvb ? slot : vb, nvb, p.ws != nullptr, XPG == 1 ? 0x3fff : 0x3e1f);
#endif
    stage_peer_gather(p, lds, slot < nvb ? slot : vb, nvb);
}

extern "C" void kernel_launch(void* const* d_in, const int* in_sizes, int n_in, void* d_out, int out_size, void* d_ws, size_t ws_size, hipStream_t stream) {
    if (n_in != 20 || ws_size < WS_END) { fprintf(stderr, "kernel_launch: unexpected n_in %d or ws_size %zu\n", n_in, ws_size); return; }
    static int grid_blocks = 0;
    if (!grid_blocks) {
        int dev = 0, cus = 0, per_cu = 0;
        (void)hipGetDevice(&dev);
        (void)hipDeviceGetAttribute(&cus, hipDeviceAttributeMultiprocessorCount, dev);
        (void)hipFuncSetAttribute((const void*)k_mega, hipFuncAttributeMaxDynamicSharedMemorySize, LDS_TOTAL);
        (void)hipOccupancyMaxActiveBlocksPerMultiprocessor(&per_cu, (const void*)k_mega, 512, LDS_TOTAL);
        if (per_cu < 1) { fprintf(stderr, "kernel_launch: occupancy query says %d blocks per CU\n", per_cu); per_cu = 1; }
        grid_blocks = cus * 1;
    }
    Params p{};
    p.x = (const float*)d_in[0]; p.c = (const float*)d_in[1]; p.w_ada = (const float*)d_in[2]; p.b_ada = (const float*)d_in[3]; p.norm1_w = (const float*)d_in[4];
    p.w_in = (const float*)d_in[5]; p.conv_w = (const float*)d_in[6]; p.sinks = (const float*)d_in[7]; p.i_bias = (const float*)d_in[8]; p.f_bias = (const float*)d_in[9];
    p.mnorm_w = (const float*)d_in[10]; p.w_a = (const float*)d_in[11]; p.w_b = (const float*)d_in[12]; p.w_out = (const float*)d_in[13]; p.norm2_w = (const float*)d_in[14];
    p.w_q = (const float*)d_in[15]; p.sub_keys = (const float*)d_in[16]; p.peer_u = (const float*)d_in[17]; p.peer_v = (const float*)d_in[18]; p.normf_w = (const float*)d_in[19];
    p.out = (float*)d_out; p.ws = (unsigned char*)d_ws;
    (void)hipMemsetAsync(d_ws, 0, 32768, stream);
    void* args[] = {&p};
    hipError_t e = hipLaunchCooperativeKernel((const void*)k_mega, dim3(grid_blocks), dim3(512), args, LDS_TOTAL, stream);
    if (e != hipSuccess) fprintf(stderr, "cooperative launch failed: %s (grid %d)\n", hipGetErrorString(e), grid_blocks);
}
```

```cpp
#include <hip/hip_runtime.h>
#include <hip/hip_cooperative_groups.h>
#include <stdint.h>
#include <stdio.h>

#define DEV __device__ __forceinline__
typedef unsigned short bf16_t;
typedef short bf16x8 __attribute__((ext_vector_type(8)));
typedef float f32x4 __attribute__((ext_vector_type(4)));
typedef unsigned u32x4 __attribute__((ext_vector_type(4)));
typedef unsigned u32x2 __attribute__((ext_vector_type(2)));

constexpr int BATCH = 2, SEQ = 16384, M = BATCH * SEQ, D = 1024;
constexpr int NTH = 512, NW = 8;
constexpr int LPA = 768, LPM = 2048, LPG = 2048;

struct Params {
    const float *x, *c, *w_ada, *b_ada, *norm1_w, *w_in, *conv_w, *sinks, *i_bias, *f_bias, *mnorm_w, *w_a, *w_b, *w_out, *norm2_w, *w_q, *sub_keys, *peer_u, *peer_v, *normf_w;
    float* out; unsigned char* ws;
};

constexpr size_t MiB = 1u << 20;
constexpr size_t WS_MOD = 1 * MiB;
constexpr size_t WS_IPRE = 2 * MiB;
constexpr size_t WS_FPRE = 2 * MiB + 512 * 1024;
constexpr size_t WS_CHG = 3 * MiB;
constexpr size_t WS_NLOC = 4 * MiB;
constexpr size_t WS_NST = 4 * MiB + 512 * 1024;
constexpr size_t WS_ROPE = 5 * MiB;
constexpr size_t WS_WIN = 10 * MiB;
constexpr size_t WS_WA = 20 * MiB;
constexpr size_t WS_WB = 21 * MiB;
constexpr size_t WS_WOUT = 22 * MiB;
constexpr size_t WS_WQ = 24 * MiB;
constexpr size_t WS_SK = 28 * MiB;
constexpr size_t WS_ISU = 29 * MiB;
constexpr size_t WS_ISV = 29 * MiB + 65536;
constexpr size_t WS_TU = 32 * MiB;
constexpr size_t WS_TV = 48 * MiB;
constexpr size_t WS_UB = 96 * MiB;
constexpr size_t WS_PA = 160 * MiB;
constexpr size_t WS_PM = 208 * MiB;
constexpr size_t WS_PG = 336 * MiB;
constexpr size_t WS_CST = 464 * MiB;
constexpr size_t WS_AT = 64 * MiB;
constexpr size_t WS_ML = 96 * MiB;
constexpr size_t WS_MG = 208 * MiB;
constexpr size_t WS_END = 496 * MiB;

DEV unsigned f2bf(float f) { unsigned u = __float_as_uint(f); return (u + 0x7fffu + ((u >> 16) & 1u)) >> 16; }
DEV unsigned pk2(float lo, float hi) { return f2bf(lo) | (f2bf(hi) << 16); }
DEV float bflo(unsigned u) { return __uint_as_float(u << 16); }
DEV float bfhi(unsigned u) { return __uint_as_float(u & 0xffff0000u); }
DEV float bf2f(bf16_t h) { return __uint_as_float(((unsigned)h) << 16); }
DEV float wave_sum(float v) {
#pragma unroll
    for (int o = 32; o > 0; o >>= 1) v += __shfl_xor(v, o);
    return v;
}
DEV float wave_max(float v) {
#pragma unroll
    for (int o = 32; o > 0; o >>= 1) v = fmaxf(v, __shfl_xor(v, o));
    return v;
}
DEV float sigmoidf_(float v) { return __builtin_amdgcn_rcpf(1.f + __expf(-v)); }
DEV f32x4 mfma16(bf16x8 a, bf16x8 b, f32x4 c) { return __builtin_amdgcn_mfma_f32_16x16x32_bf16(a, b, c, 0, 0, 0); }
DEV void wave_lds_sync() { __builtin_amdgcn_fence(__ATOMIC_ACQ_REL, "wavefront"); __builtin_amdgcn_wave_barrier(); }

DEV void transpose_item(const float* W, int ldw, int k0, int nsrc0, bf16_t* WT, int ldt, int ndst0, float* scr, int lane, int kdst_off = 0) {
#pragma unroll 8
    for (int i = 0; i < 32; ++i) { const int kk = 2 * i + (lane >> 5); scr[kk * 33 + (lane & 31)] = W[(size_t)(k0 + kk) * ldw + nsrc0 + (lane & 31)]; }
    wave_lds_sync();
    const int c = lane & 7;
#pragma unroll
    for (int j = 0; j < 4; ++j) {
        const int n = (lane >> 3) + 8 * j; const float* s = scr + (8 * c) * 33 + n;
        u32x4 o; o.x = pk2(s[0 * 33], s[1 * 33]); o.y = pk2(s[2 * 33], s[3 * 33]); o.z = pk2(s[4 * 33], s[5 * 33]); o.w = pk2(s[6 * 33], s[7 * 33]);
        *(u32x4*)(WT + (size_t)(ndst0 + n) * ldt + k0 + kdst_off + 8 * c) = o;
    }
    wave_lds_sync();
}

DEV void stage_prep(const Params& p, char* lds, int vb, int nvb) {
    const int tid = threadIdx.x, lane = tid & 63, wave = __builtin_amdgcn_readfirstlane(tid >> 6);
    float* mod = (float*)(p.ws + WS_MOD);
    float* s_act = (float*)lds;
    float* s_red = (float*)(lds + 8192);
    for (int i = tid; i < 2048; i += NTH) { const float v = p.c[i]; s_act[i] = v / (1.f + expf(-v)); }
    __syncthreads();
    for (int item = vb; item < 192; item += nvb) {
        const int kg = tid >> 5, cl = tid & 31, col = item * 32 + cl;
        float s0 = 0.f, s1 = 0.f;
        for (int k = kg; k < 1024; k += 16) { const float w = p.w_ada[(size_t)k * 6144 + col]; s0 += s_act[k] * w; s1 += s_act[1024 + k] * w; }
        s_red[(kg * 32 + cl) * 2] = s0; s_red[(kg * 32 + cl) * 2 + 1] = s1;
        __syncthreads();
        if (tid < 64) { const int b = tid >> 5, c2 = tid & 31; float s = 0.f; for (int g = 0; g < 16; ++g) s += s_red[(g * 32 + c2) * 2 + b]; mod[b * 6144 + item * 32 + c2] = s + p.b_ada[item * 32 + c2]; }
        __syncthreads();
    }
    float* scr = (float*)(lds + 16384 + wave * 8448);
    const int gw = vb * NW + wave, ngw = nvb * NW;
    bf16_t* Wt_in = (bf16_t*)(p.ws + WS_WIN); bf16_t* Wt_a = (bf16_t*)(p.ws + WS_WA); bf16_t* Wt_b = (bf16_t*)(p.ws + WS_WB);
    bf16_t* Wt_out = (bf16_t*)(p.ws + WS_WOUT); bf16_t* Wt_q = (bf16_t*)(p.ws + WS_WQ);
    for (int it = gw; it < 3456; it += ngw) {
        int r = it;
        if (r < 2432) { const int kb = r / 152, nb = r % 152; transpose_item(p.w_in, 4872, kb * 64, nb * 32 + (nb >= 88 ? 8 : 0), Wt_in, 1024, nb * 32, scr, lane); continue; } r -= 2432;
        if (r < 256) { const int kb = r / 32, nb = r % 32; transpose_item(p.w_a, 1024, kb * 64, nb * 32, Wt_a, 1024, nb * 32, scr, lane, 0); continue; } r -= 256;
        if (r < 256) { const int kb = r / 32, nb = r % 32; transpose_item(p.w_b, 1024, kb * 64, nb * 32, Wt_a, 1024, nb * 32, scr, lane, 512); continue; } r -= 256;
        { const int kb = r / 32, nb = r % 32; transpose_item(p.w_out, 1024, kb * 64, nb * 32, Wt_out, 1024, nb * 32, scr, lane); }
    }
    {
        float* WL = (float*)lds;
        float* KL = (float*)(lds + 33792);
        for (int item = vb; item < 256; item += nvb) {
            const int hp = item >> 4, k0 = (item & 15) * 64, pidx = hp & 1;
            __syncthreads();
            for (int i = tid; i < 64 * 32; i += NTH) { const int kk = i >> 5, d4 = i & 31; *(float4*)(WL + kk * 132 + 4 * d4) = *(const float4*)(p.w_q + (size_t)(k0 + kk) * 2048 + hp * 128 + 4 * d4); }
            for (int i = tid; i < 128 * 32; i += NTH) ((float4*)KL)[i] = ((const float4*)(p.sub_keys + (size_t)pidx * 16384))[i];
            __syncthreads();
            const int kk = tid & 63, n0 = (tid >> 6) * 16;
            float acc[16];
#pragma unroll
            for (int j = 0; j < 16; ++j) acc[j] = 0.f;
            for (int d4 = 0; d4 < 32; ++d4) {
                const float4 w = *(const float4*)(WL + kk * 132 + 4 * d4);
#pragma unroll
                for (int j = 0; j < 16; ++j) { const float4 kv = *(const float4*)(KL + (n0 + j) * 128 + 4 * d4); acc[j] += w.x * kv.x + w.y * kv.y + w.z * kv.z + w.w * kv.w; }
            }
#pragma unroll
            for (int j = 0; j < 16; ++j) Wt_q[(size_t)(hp * 128 + n0 + j) * 1024 + k0 + kk] = (bf16_t)f2bf(acc[j]);
        }
        __syncthreads();
    }
    const size_t gt = (size_t)vb * NTH + tid, ngt = (size_t)nvb * NTH;
    for (int rowb = gw; rowb < 32768; rowb += 4 * ngw) {
        float4 aa[4][4];
#pragma unroll
        for (int rr = 0; rr < 4; ++rr) { const int row = rowb + rr * ngw < 32768 ? rowb + rr * ngw : rowb; const float4* src = (const float4*)((row >= 16384 ? p.peer_v : p.peer_u) + (size_t)(row & 16383) * D) + lane;
#pragma unroll
            for (int i = 0; i < 4; ++i) aa[rr][i] = src[64 * i]; }
#pragma unroll
        for (int rr = 0; rr < 4; ++rr) {
            const int row = rowb + rr * ngw;
            if (row < 32768) {
                const bool isv = row >= 16384; const int r = row & 16383;
                float mx = 0.f;
#pragma unroll
                for (int i = 0; i < 4; ++i) mx = fmaxf(mx, fmaxf(fmaxf(fabsf(aa[rr][i].x), fabsf(aa[rr][i].y)), fmaxf(fabsf(aa[rr][i].z), fabsf(aa[rr][i].w))));
                mx = wave_max(mx);
                const float inv = mx > 0.f ? 127.f / mx : 0.f, sc = mx > 0.f ? mx * (1.f / 127.f) : 1.f;
                unsigned* dst = (unsigned*)(p.ws + (isv ? WS_TV : WS_TU) + (size_t)r * 1024) + lane;
#pragma unroll
                for (int i = 0; i < 4; ++i) dst[64 * i] = ((unsigned)__float2int_rn(aa[rr][i].x * inv) & 0xffu) | (((unsigned)__float2int_rn(aa[rr][i].y * inv) & 0xffu) << 8) | (((unsigned)__float2int_rn(aa[rr][i].z * inv) & 0xffu) << 16) | ((unsigned)__float2int_rn(aa[rr][i].w * inv) << 24);
                if (lane == 0) ((float*)(p.ws + (isv ? WS_ISV : WS_ISU)))[r] = sc;
            }
        }
    }
    for (size_t g = gt; g < 4096; g += ngt) {
        const float4 a = ((const float4*)p.sub_keys)[2 * g], b = ((const float4*)p.sub_keys)[2 * g + 1];
        u32x4 w; w.x = pk2(a.x, a.y); w.y = pk2(a.z, a.w); w.z = pk2(b.x, b.y); w.w = pk2(b.z, b.w);
        ((u32x4*)(p.ws + WS_SK))[g] = w;
    }
    float2* rope = (float2*)(p.ws + WS_ROPE);
    for (size_t e = gt; e < 16384 * 32; e += ngt) {
        const int pos = (int)(e >> 5), i = (int)(e & 31);
        const float inv = (float)exp2(-(double)i * (13.287712379549449 / 32.0));
        const float ang = (float)pos * inv;
        const double a = (double)ang; const double n = rint(a * 0.15915494309189535); const double r = a - n * 6.283185307179586;
        float s, c; sincosf((float)r, &s, &c);
        rope[e] = make_float2(c, s);
    }
}

DEV void stage_norm1(const Params& p, char* lds, int vb, int nvb) {
    const int tid = threadIdx.x, lane = tid & 63, wave = __builtin_amdgcn_readfirstlane(tid >> 6);
    float* wg = (float*)lds;
    for (int i = tid; i < 8192; i += NTH) { const int cc = i >> 10, k = i & 1023; wg[i] = p.w_in[(size_t)k * 4872 + 2816 + cc]; }
    __syncthreads();
    const float* mod = (const float*)(p.ws + WS_MOD);
    bf16_t* ub = (bf16_t*)(p.ws + WS_UB);
    float* ipre = (float*)(p.ws + WS_IPRE); float* fpre = (float*)(p.ws + WS_FPRE);
    const int rstride = nvb * NW;
    for (int mb = vb * NW + wave; mb < M; mb += 2 * rstride) {
        float4 vv[2][4];
#pragma unroll
        for (int rr = 0; rr < 2; ++rr) { const int mr = mb + rr * rstride < M ? mb + rr * rstride : mb; const float4* xr = (const float4*)(p.x + (size_t)mr * D);
#pragma unroll
            for (int j = 0; j < 4; ++j) vv[rr][j] = xr[lane + 64 * j]; }
#pragma unroll
        for (int rr = 0; rr < 2; ++rr) {
        const int m = mb + rr * rstride;
        if (m < M) {
        const int b = m >= SEQ ? 1 : 0;
        float4 v[4]; float ss = 0.f;
#pragma unroll
        for (int j = 0; j < 4; ++j) { v[j] = vv[rr][j]; ss += v[j].x * v[j].x + v[j].y * v[j].y + v[j].z * v[j].z + v[j].w * v[j].w; }
        ss = wave_sum(ss);
        const float rstd = rsqrtf(ss * (1.f / 1024.f) + 1e-6f);
        float ga[8];
#pragma unroll
        for (int cc = 0; cc < 8; ++cc) ga[cc] = 0.f;
#pragma unroll
        for (int j = 0; j < 4; ++j) {
            const int col = 4 * (lane + 64 * j);
            const float4 w1 = *(const float4*)(p.norm1_w + col), sc = *(const float4*)(mod + b * 6144 + 1024 + col), sh = *(const float4*)(mod + b * 6144 + col);
            float4 u;
            u.x = v[j].x * rstd * w1.x * (1.f + sc.x) + sh.x; u.y = v[j].y * rstd * w1.y * (1.f + sc.y) + sh.y;
            u.z = v[j].z * rstd * w1.z * (1.f + sc.z) + sh.z; u.w = v[j].w * rstd * w1.w * (1.f + sc.w) + sh.w;
            u32x2 o; o.x = pk2(u.x, u.y); o.y = pk2(u.z, u.w);
            *(u32x2*)(ub + (size_t)m * D + col) = o;
#pragma unroll
            for (int cc = 0; cc < 8; ++cc) { const float4 g = *(const float4*)(wg + cc * 1024 + col); ga[cc] += u.x * g.x + u.y * g.y + u.z * g.z + u.w * g.w; }
        }
        {
            const bool h32 = (lane & 32) != 0, h16 = (lane & 16) != 0, h8 = (lane & 8) != 0;
            float k4[4], k2[2];
#pragma unroll
            for (int i = 0; i < 4; ++i) k4[i] = (h32 ? ga[4 + i] : ga[i]) + __shfl_xor(h32 ? ga[i] : ga[4 + i], 32);
#pragma unroll
            for (int i = 0; i < 2; ++i) k2[i] = (h16 ? k4[2 + i] : k4[i]) + __shfl_xor(h16 ? k4[i] : k4[2 + i], 16);
            float k1 = (h8 ? k2[1] : k2[0]) + __shfl_xor(h8 ? k2[0] : k2[1], 8);
            k1 += __shfl_xor(k1, 4); k1 += __shfl_xor(k1, 2); k1 += __shfl_xor(k1, 1);
            const int cc = (lane >> 3) & 7;
            if ((lane & 7) == 0) { if (cc < 4) ipre[(size_t)m * 4 + cc] = k1 + p.i_bias[cc]; else fpre[(size_t)m * 4 + cc - 4] = k1 + p.f_bias[cc - 4]; }
        }
        }
        }
    }
}

namespace pg8 {
#define PG8_LAS __attribute__((address_space(3)))
typedef unsigned short bf16_t;
typedef short bf16x8 __attribute__((ext_vector_type(8)));
typedef float f32x4 __attribute__((ext_vector_type(4)));
typedef unsigned u32x4 __attribute__((ext_vector_type(4)));
constexpr int BM = 256, BK = 64, HALF = 128, HTB = HALF * BK * 2  , STAGE_BYTES = 8 * HTB, NXCD = 8, WGM = 8;

__host__ __device__ __forceinline__ int lds_byte(int r, int c) { const int st = (r >> 4) * 2 + (c >> 5), rr = r & 15, cc = c & 31, ob = rr * 64 + cc * 2; return st * 1024 + (ob ^ (((ob >> 9) & 1) << 5)); }
__host__ __device__ __forceinline__ void stage_rc(int b, int& R, int& C) { const int st = b / 1024, sb = b % 1024, swz = sb ^ (((sb >> 9) & 1) << 5); R = (st >> 1) * 16 + swz / 64; C = (st & 1) * 32 + (swz % 64) / 2; }
__host__ __device__ __forceinline__ int perm32(int rho) { const int n = rho >> 4, i = rho & 15; return 8 * (i >> 2) + 4 * n + (i & 3); }

struct Unit { int pm, pn; };
struct Gemm { const bf16_t* A; const bf16_t* Bt; int M, N, K, lda, ldb; const bf16_t* A2; };

struct StaticOrder {
    int nM, nN, nwg, G, c;
    __host__ __device__ void init(int M, int N, int G_, int c_) { nM = M / BM; nN = N / BM; nwg = nM * nN; G = G_; c = c_; }
    __host__ __device__ bool next(int i, Unit& u) const {
        const long L = (long)i * G + c; if (L >= nwg) return false;
        int wgid = (int)L; { const int q = nwg / NXCD, r = nwg % NXCD, xcd = wgid % NXCD, off = wgid / NXCD; wgid = (xcd < r ? xcd * (q + 1) : r * (q + 1) + (xcd - r) * q) + off; }
        const int nig = WGM * nN, gid = wgid / nig, fm = gid * WGM, gsz = (nM - fm) < WGM ? (nM - fm) : WGM;
        u.pm = fm + ((wgid % nig) % gsz); u.pn = (wgid % nig) / gsz; return true;
    }
    __device__ __forceinline__ void a_ready(const Unit&) const {}
    __device__ __forceinline__ void done(const Unit&) const {}
};

__device__ __forceinline__ unsigned cvt_pk_bf16(float lo, float hi) { unsigned r; asm volatile("v_cvt_pk_bf16_f32 %0, %1, %2" : "=v"(r) : "v"(lo), "v"(hi)); return r; }
__device__ __forceinline__ float sg_(float v) { return __builtin_amdgcn_rcpf(1.f + __expf(-v)); }
struct EpiIn {
    static constexpr bool PERM = true, AFTER_DRAIN = false, HAS_MID = false;
    bf16_t *PA, *PM, *PG;
    __device__ __forceinline__ void operator()(const f32x4 (&acc)[2][2][4][2], const Unit& u, int wr, int wc, int fr, int fq) const {
        const int colt = u.pn * BM; bf16_t* base; int ldc, cb;
        if (colt < 768) { base = PA; ldc = 768; cb = colt; } else if (colt < 2816) { base = PM; ldc = 2048; cb = colt - 768; } else { base = PG; ldc = 2048; cb = colt - 2816; }
        const int row0 = u.pm * BM + wr * 64 + fr, col0 = cb + wc * 32 + 8 * fq;
#pragma unroll
        for (int ai = 0; ai < 2; ++ai)
#pragma unroll
            for (int m = 0; m < 4; ++m) { bf16_t* rowp = base + (size_t)(row0 + ai * HALF + m * 16) * ldc + col0;
#pragma unroll
                for (int bj = 0; bj < 2; ++bj) { const f32x4 v0 = acc[ai][bj][m][0], v1 = acc[ai][bj][m][1];
                    u32x4 w; w.x = cvt_pk_bf16(v0[0], v0[1]); w.y = cvt_pk_bf16(v0[2], v0[3]); w.z = cvt_pk_bf16(v1[0], v1[1]); w.w = cvt_pk_bf16(v1[2], v1[3]);
                    *(u32x4*)(rowp + bj * HALF) = w; } }
    }
};
struct EpiMerge {
    static constexpr bool PERM = true, AFTER_DRAIN = false, HAS_MID = false;
    const bf16_t* G; bf16_t* MG; int second;
    __device__ __forceinline__ void operator()(const f32x4 (&acc)[2][2][4][2], const Unit& u, int wr, int wc, int fr, int fq) const {
        const int row0 = u.pm * BM + wr * 64 + fr, col0 = u.pn * BM + wc * 32 + 8 * fq;
#pragma unroll
        for (int bj = 0; bj < 2; ++bj)
#pragma unroll
        for (int ai = 0; ai < 2; ++ai) {
            const int col = col0 + bj * HALF;
            u32x4 gv[4], tv[4];
#pragma unroll
            for (int m = 0; m < 4; ++m) { const size_t row = (size_t)(row0 + ai * HALF + m * 16); gv[m] = *(const u32x4*)(G + row * 2048 + col); tv[m] = second ? *(const u32x4*)(MG + row * 1024 + col) : (u32x4){0u, 0u, 0u, 0u}; }
#pragma unroll
            for (int m = 0; m < 4; ++m) { const size_t row = (size_t)(row0 + ai * HALF + m * 16);
                const f32x4 v0 = acc[ai][bj][m][0], v1 = acc[ai][bj][m][1]; const u32x4 g = gv[m], t = tv[m];
                float r[8];
                r[0] = sg_(__uint_as_float(g.x << 16)) * v0[0] + __uint_as_float(t.x << 16); r[1] = sg_(__uint_as_float(g.x & 0xffff0000u)) * v0[1] + __uint_as_float(t.x & 0xffff0000u);
                r[2] = sg_(__uint_as_float(g.y << 16)) * v0[2] + __uint_as_float(t.y << 16); r[3] = sg_(__uint_as_float(g.y & 0xffff0000u)) * v0[3] + __uint_as_float(t.y & 0xffff0000u);
                r[4] = sg_(__uint_as_float(g.z << 16)) * v1[0] + __uint_as_float(t.z << 16); r[5] = sg_(__uint_as_float(g.z & 0xffff0000u)) * v1[1] + __uint_as_float(t.z & 0xffff0000u);
                r[6] = sg_(__uint_as_float(g.w << 16)) * v1[2] + __uint_as_float(t.w << 16); r[7] = sg_(__uint_as_float(g.w & 0xffff0000u)) * v1[3] + __uint_as_float(t.w & 0xffff0000u);
                u32x4 w; w.x = cvt_pk_bf16(r[0], r[1]); w.y = cvt_pk_bf16(r[2], r[3]); w.z = cvt_pk_bf16(r[4], r[5]); w.w = cvt_pk_bf16(r[6], r[7]);
                *(u32x4*)(MG + row * 1024 + col) = w; }
        }
    }
};
struct EpiMergeF {
    static constexpr bool PERM = true, AFTER_DRAIN = false, HAS_MID = true;
    const bf16_t* G; bf16_t* MG;
    static __device__ __forceinline__ float em_(float v) { return __expf(-fminf(fmaxf(v, -30.f), 30.f)); }
    __device__ __forceinline__ void mid(f32x4 (&acc)[2][2][4][2], const Unit& u, int wr, int wc, int fr, int fq) const {
        int row0 = u.pm * BM + wr * 64 + fr; const int col0 = u.pn * BM + wc * 32 + 8 * fq;
        asm volatile("" : "+v"(row0));
#pragma unroll
        for (int bj = 0; bj < 2; ++bj)
#pragma unroll
        for (int ai = 0; ai < 2; ++ai)
        {
            const int col = col0 + bj * HALF;
            u32x4 av[4], bv[4];
#pragma unroll
            for (int m = 0; m < 4; ++m) { const size_t row = (size_t)(row0 + ai * HALF + m * 16); av[m] = *(const u32x4*)(G + row * 2048 + col); bv[m] = *(const u32x4*)(G + row * 2048 + 1024 + col); }
#pragma unroll
            for (int m = 0; m < 4; ++m) {
                f32x4 r0, r1;
                r0[0] = (1.f + em_(__uint_as_float(bv[m][0] << 16))) * __builtin_amdgcn_rcpf(1.f + em_(__uint_as_float(av[m][0] << 16)));
                r0[1] = (1.f + em_(__uint_as_float(bv[m][0] & 0xffff0000u))) * __builtin_amdgcn_rcpf(1.f + em_(__uint_as_float(av[m][0] & 0xffff0000u)));
                r0[2] = (1.f + em_(__uint_as_float(bv[m][1] << 16))) * __builtin_amdgcn_rcpf(1.f + em_(__uint_as_float(av[m][1] << 16)));
                r0[3] = (1.f + em_(__uint_as_float(bv[m][1] & 0xffff0000u))) * __builtin_amdgcn_rcpf(1.f + em_(__uint_as_float(av[m][1] & 0xffff0000u)));
                r1[0] = (1.f + em_(__uint_as_float(bv[m][2] << 16))) * __builtin_amdgcn_rcpf(1.f + em_(__uint_as_float(av[m][2] << 16)));
                r1[1] = (1.f + em_(__uint_as_float(bv[m][2] & 0xffff0000u))) * __builtin_amdgcn_rcpf(1.f + em_(__uint_as_float(av[m][2] & 0xffff0000u)));
                r1[2] = (1.f + em_(__uint_as_float(bv[m][3] << 16))) * __builtin_amdgcn_rcpf(1.f + em_(__uint_as_float(av[m][3] << 16)));
                r1[3] = (1.f + em_(__uint_as_float(bv[m][3] & 0xffff0000u))) * __builtin_amdgcn_rcpf(1.f + em_(__uint_as_float(av[m][3] & 0xffff0000u)));
                acc[ai][bj][m][0] = acc[ai][bj][m][0] * r0; acc[ai][bj][m][1] = acc[ai][bj][m][1] * r1;
            }
            __builtin_amdgcn_sched_barrier(0);
        }
    }
    __device__ __forceinline__ void operator()(const f32x4 (&acc)[2][2][4][2], const Unit& u, int wr, int wc, int fr, int fq) const {
        const int row0 = u.pm * BM + wr * 64 + fr, col0 = u.pn * BM + wc * 32 + 8 * fq;
#pragma unroll
        for (int bj = 0; bj < 2; ++bj)
#pragma unroll
        for (int ai = 0; ai < 2; ++ai) {
            const int col = col0 + bj * HALF;
            u32x4 bv[4];
#pragma unroll
            for (int m = 0; m < 4; ++m) bv[m] = *(const u32x4*)(G + (size_t)(row0 + ai * HALF + m * 16) * 2048 + 1024 + col);
#pragma unroll
            for (int m = 0; m < 4; ++m) { const f32x4 v0 = acc[ai][bj][m][0], v1 = acc[ai][bj][m][1]; const u32x4 g = bv[m];
                float r[8];
                r[0] = v0[0] * __builtin_amdgcn_rcpf(1.f + em_(__uint_as_float(g.x << 16))); r[1] = v0[1] * __builtin_amdgcn_rcpf(1.f + em_(__uint_as_float(g.x & 0xffff0000u)));
                r[2] = v0[2] * __builtin_amdgcn_rcpf(1.f + em_(__uint_as_float(g.y << 16))); r[3] = v0[3] * __builtin_amdgcn_rcpf(1.f + em_(__uint_as_float(g.y & 0xffff0000u)));
                r[4] = v1[0] * __builtin_amdgcn_rcpf(1.f + em_(__uint_as_float(g.z << 16))); r[5] = v1[1] * __builtin_amdgcn_rcpf(1.f + em_(__uint_as_float(g.z & 0xffff0000u)));
                r[6] = v1[2] * __builtin_amdgcn_rcpf(1.f + em_(__uint_as_float(g.w << 16))); r[7] = v1[3] * __builtin_amdgcn_rcpf(1.f + em_(__uint_as_float(g.w & 0xffff0000u)));
                u32x4 w; w.x = cvt_pk_bf16(r[0], r[1]); w.y = cvt_pk_bf16(r[2], r[3]); w.z = cvt_pk_bf16(r[4], r[5]); w.w = cvt_pk_bf16(r[6], r[7]);
                *(u32x4*)(MG + (size_t)(row0 + ai * HALF + m * 16) * 1024 + col) = w; }
        }
    }
};
struct EpiF32 {
    static constexpr bool PERM = true, AFTER_DRAIN = false, HAS_MID = false;
    float* O; int ldc;
    __device__ __forceinline__ void operator()(const f32x4 (&acc)[2][2][4][2], const Unit& u, int wr, int wc, int fr, int fq) const {
        const int row0 = u.pm * BM + wr * 64 + fr, col0 = u.pn * BM + wc * 32 + 8 * fq;
#pragma unroll
        for (int ai = 0; ai < 2; ++ai)
#pragma unroll
            for (int m = 0; m < 4; ++m) { float* rowp = O + (size_t)(row0 + ai * HALF + m * 16) * ldc + col0;
#pragma unroll
                for (int bj = 0; bj < 2; ++bj) { *(f32x4*)(rowp + bj * HALF) = acc[ai][bj][m][0]; *(f32x4*)(rowp + bj * HALF + 4) = acc[ai][bj][m][1]; } }
    }
};
struct EpiOut {
    static constexpr bool PERM = true, AFTER_DRAIN = false, HAS_MID = false;
    const float* x; const float* g1; float* out; int seq;
    __device__ __forceinline__ void operator()(const f32x4 (&acc)[2][2][4][2], const Unit& u, int wr, int wc, int fr, int fq) const {
        const int row0 = u.pm * BM + wr * 64 + fr, col0 = u.pn * BM + wc * 32 + 8 * fq;
        const float* gp = g1 + (u.pm * BM >= seq ? 6144 : 0);
#pragma unroll
        for (int bj = 0; bj < 2; ++bj) { const int col = col0 + bj * HALF; const f32x4 ga = *(const f32x4*)(gp + col), gb = *(const f32x4*)(gp + col + 4);
#pragma unroll
            for (int ai = 0; ai < 2; ++ai) {
                f32x4 xa[4], xb[4];
#pragma unroll
                for (int m = 0; m < 4; ++m) { const size_t off = (size_t)(row0 + ai * HALF + m * 16) * 1024 + col; xa[m] = *(const f32x4*)(x + off); xb[m] = *(const f32x4*)(x + off + 4); }
#pragma unroll
                for (int m = 0; m < 4; ++m) { const size_t off = (size_t)(row0 + ai * HALF + m * 16) * 1024 + col;
                    *(f32x4*)(out + off) = xa[m] + ga * acc[ai][bj][m][0]; *(f32x4*)(out + off + 4) = xb[m] + gb * acc[ai][bj][m][1]; } } }
    }
};

template <class Epi, class Sched, bool ALIGN_EPI = false, bool SP2 = false>
__device__ __forceinline__ void gemm_phase(PG8_LAS unsigned char* lds, const Gemm g, const Sched& S, const Epi& E) {
    const int tid = threadIdx.x, wid = __builtin_amdgcn_readfirstlane(tid >> 6), lane = tid & 63, wr = wid >> 2, wc = wid & 3, fr = lane & 15, fq = lane >> 4;
    const int K = g.K, nt = K / BK;
    unsigned voffA[2], voffB[2];
#pragma unroll
    for (int i = 0; i < 2; ++i) { int R, C; stage_rc(tid * 16 + i * 8192, R, C); const int Rb = Epi::PERM ? ((R & ~31) + perm32(R & 31)) : R;
        voffA[i] = (unsigned)(R * g.lda + C) * 2u; voffB[i] = (unsigned)(Rb * g.ldb + C) * 2u; }
    const size_t kstep = (size_t)(BK * 2);
    const size_t hstepA = (size_t)HALF * g.lda * 2, hstepB = (size_t)HALF * g.ldb * 2;
    const size_t tstepA = 2 * hstepA, tstepB = 2 * hstepB;
    const unsigned ldsw = (unsigned)wid * 1024u;
    const int aoff = lds_byte(wr * 64 + fr, fq * 8), boff = lds_byte(wc * 32 + fr, fq * 8);
#define PG8_SA(b, h) (((b) * 2 + (h)) * HTB)
#define PG8_SB(b, h) ((4 + (b) * 2 + (h)) * HTB)
#define PG8_STAGE(bufoff, gbase, voff) do { _Pragma("unroll") for (int _i = 0; _i < 2; ++_i) \
        __builtin_amdgcn_global_load_lds((const unsigned*)((const char*)(gbase) + (voff)[_i]), (PG8_LAS unsigned*)(lds + (bufoff) + ldsw + _i * 8192), 16, 0, 0); } while (0)
#define PG8_LDA(dst, b, h) do { _Pragma("unroll") for (int m = 0; m < 4; ++m) _Pragma("unroll") for (int k = 0; k < 2; ++k) dst[m][k] = *(const PG8_LAS bf16x8*)(lds + PG8_SA(b, h) + aoff + m * 2048 + k * 1024); } while (0)
#define PG8_LDB(dst, b, h) do { _Pragma("unroll") for (int n = 0; n < 2; ++n) _Pragma("unroll") for (int k = 0; k < 2; ++k) dst[n][k] = *(const PG8_LAS bf16x8*)(lds + PG8_SB(b, h) + boff + n * 2048 + k * 1024); } while (0)
#define PG8_MMA(ai, bj, At, Bt) do { __builtin_amdgcn_s_setprio(1); _Pragma("unroll") for (int m = 0; m < 4; ++m) _Pragma("unroll") for (int n = 0; n < 2; ++n) _Pragma("unroll") for (int k = 0; k < 2; ++k) \
        acc[ai][bj][m][n] = __builtin_amdgcn_mfma_f32_16x16x32_bf16(Bt[n][k], At[m][k], acc[ai][bj][m][n], 0, 0, 0); __builtin_amdgcn_s_setprio(0); } while (0)
#define PG8_WAIT_V(n) asm volatile("s_waitcnt vmcnt(" #n ")" ::: "memory")
#define PG8_WAIT_L(n) asm volatile("s_waitcnt lgkmcnt(" #n ")" ::: "memory")
#define PG8_BAR __builtin_amdgcn_s_barrier()
#define PG8_SCHED __builtin_amdgcn_sched_barrier(0)
    Unit cur, nxt; int ui = 0;
    if (!S.next(0, cur)) return;
    f32x4 acc[2][2][4][2];
#pragma unroll
    for (int a = 0; a < 2; ++a)
#pragma unroll
        for (int b = 0; b < 2; ++b)
#pragma unroll
            for (int m = 0; m < 4; ++m)
#pragma unroll
                for (int n = 0; n < 2; ++n) acc[a][b][m][n] = (f32x4){0.f, 0.f, 0.f, 0.f};
    bf16x8 At[4][2], B0[2][2], B1[2][2];
    const char* cA = (const char*)g.A + (size_t)cur.pm * tstepA; const char* cB = (const char*)g.Bt + (size_t)cur.pn * tstepB;
    const char* cA2 = g.A2 ? (const char*)g.A2 + (size_t)cur.pm * tstepA : nullptr;
    S.a_ready(cur);
    if constexpr (SP2) {
        PG8_STAGE(PG8_SB(0, 0), cB, voffB); PG8_STAGE(PG8_SB(0, 1), cB + hstepB, voffB); PG8_STAGE(PG8_SA(0, 0), cA, voffA); PG8_STAGE(PG8_SA(0, 1), cA + hstepA, voffA);
        if (wr == 1) PG8_BAR;
        PG8_WAIT_V(2); PG8_BAR;
        PG8_STAGE(PG8_SB(1, 0), cB + kstep, voffB); PG8_STAGE(PG8_SA(1, 0), cA + kstep, voffA); PG8_STAGE(PG8_SB(1, 1), cB + hstepB + kstep, voffB);
        PG8_WAIT_V(6); PG8_BAR;
    } else {
        PG8_STAGE(PG8_SB(0, 0), cB, voffB); PG8_STAGE(PG8_SA(0, 0), cA, voffA); PG8_STAGE(PG8_SB(0, 1), cB + hstepB, voffB); PG8_STAGE(PG8_SA(0, 1), cA + hstepA, voffA);
        if (wr == 1) PG8_BAR;
        PG8_WAIT_V(4); PG8_BAR;
        PG8_STAGE(PG8_SB(1, 0), cB + kstep, voffB); PG8_STAGE(PG8_SA(1, 0), cA + kstep, voffA); PG8_STAGE(PG8_SB(1, 1), cB + hstepB + kstep, voffB);
        PG8_WAIT_V(6); PG8_BAR;
    }
    for (;;) {
        const bool has_next = S.next(ui + 1, nxt);
        const char* nA = has_next ? (const char*)g.A + (size_t)nxt.pm * tstepA : cA; const char* nB = has_next ? (const char*)g.Bt + (size_t)nxt.pn * tstepB : cB;
        const int tspan = Epi::HAS_MID ? (nt >> 1) : nt;
        for (int tb = 0; tb < nt; tb += tspan) {
        if constexpr (Epi::HAS_MID) { if (tb != 0) E.mid(acc, cur, wr, wc, fr, fq); }
        for (int t = tb; t < tb + tspan; t += 2) {
            const bool last = (t == nt - 2);
            const int hk = nt >> 1;
            const char* bA1 = (cA2 && t + 1 >= hk) ? cA2 - (size_t)hk * kstep : cA; const char* bA2 = (cA2 && t + 2 >= hk) ? cA2 - (size_t)hk * kstep : cA;
            const char* a1 = bA1 + (size_t)(t + 1) * kstep;
            const char* a2 = last ? nA : bA2 + (size_t)(t + 2) * kstep; const char* b2 = last ? nB : cB + (size_t)(t + 2) * kstep;
            const char* a3 = a2 + kstep; const char* b3 = b2 + kstep;
            if (last && has_next) S.a_ready(nxt);
            if constexpr (SP2) {
            PG8_LDB(B0, 0, 0); PG8_LDB(B1, 0, 1); PG8_SCHED; PG8_LDA(At, 0, 0); PG8_STAGE(PG8_SA(1, 1), a1 + hstepA, voffA);
            PG8_WAIT_V(8); PG8_WAIT_L(0); PG8_BAR; PG8_MMA(0, 0, At, B0); PG8_MMA(0, 1, At, B1); PG8_BAR; PG8_SCHED;
            PG8_LDA(At, 0, 1); PG8_STAGE(PG8_SB(0, 0), b2, voffB); PG8_STAGE(PG8_SB(0, 1), b2 + hstepB, voffB); PG8_STAGE(PG8_SA(0, 0), a2, voffA);
            PG8_WAIT_V(8); PG8_WAIT_L(0); PG8_BAR; PG8_MMA(1, 0, At, B0); PG8_MMA(1, 1, At, B1); PG8_BAR; PG8_SCHED;
            PG8_LDB(B0, 1, 0); PG8_LDB(B1, 1, 1); PG8_SCHED; PG8_LDA(At, 1, 0); PG8_STAGE(PG8_SA(0, 1), a2 + hstepA, voffA);
            PG8_WAIT_V(8); PG8_WAIT_L(0); PG8_BAR; PG8_MMA(0, 0, At, B0); PG8_MMA(0, 1, At, B1); PG8_BAR; PG8_SCHED;
            PG8_LDA(At, 1, 1); PG8_STAGE(PG8_SB(1, 0), b3, voffB); PG8_STAGE(PG8_SB(1, 1), b3 + hstepB, voffB); PG8_STAGE(PG8_SA(1, 0), a3, voffA);
            PG8_WAIT_V(8); PG8_WAIT_L(0); PG8_BAR; PG8_MMA(1, 0, At, B0); PG8_MMA(1, 1, At, B1); PG8_BAR; PG8_SCHED;
            } else {
            PG8_LDB(B0, 0, 0); PG8_SCHED; PG8_LDA(At, 0, 0); PG8_STAGE(PG8_SA(1, 1), a1 + hstepA, voffA);
            PG8_WAIT_L(8); PG8_BAR; PG8_WAIT_L(0); PG8_MMA(0, 0, At, B0); PG8_BAR; PG8_SCHED;
            PG8_LDB(B1, 0, 1); PG8_STAGE(PG8_SB(0, 0), b2, voffB);
            PG8_BAR; PG8_WAIT_L(0); PG8_MMA(0, 1, At, B1); PG8_BAR;
            PG8_LDA(At, 0, 1); PG8_STAGE(PG8_SA(0, 0), a2, voffA);
            PG8_BAR; PG8_WAIT_L(0); PG8_MMA(1, 0, At, B0); PG8_BAR; PG8_SCHED;
            PG8_STAGE(PG8_SB(0, 1), b2 + hstepB, voffB);
            PG8_WAIT_V(6); PG8_BAR; PG8_MMA(1, 1, At, B1); PG8_BAR;
            PG8_LDB(B0, 1, 0); PG8_SCHED; PG8_LDA(At, 1, 0); PG8_STAGE(PG8_SA(0, 1), a2 + hstepA, voffA);
            PG8_WAIT_L(8); PG8_BAR; PG8_WAIT_L(0); PG8_MMA(0, 0, At, B0); PG8_BAR; PG8_SCHED;
            PG8_LDB(B1, 1, 1); PG8_STAGE(PG8_SB(1, 0), b3, voffB);
            PG8_BAR; PG8_WAIT_L(0); PG8_MMA(0, 1, At, B1); PG8_BAR;
            PG8_LDA(At, 1, 1); PG8_STAGE(PG8_SA(1, 0), a3, voffA);
            PG8_BAR; PG8_WAIT_L(0); PG8_MMA(1, 0, At, B0); PG8_BAR; PG8_SCHED;
            PG8_STAGE(PG8_SB(1, 1), b3 + hstepB, voffB);
            PG8_WAIT_V(6); PG8_BAR; PG8_MMA(1, 1, At, B1); PG8_BAR;
            }
        }
        }
        if constexpr (ALIGN_EPI) { if (wr == 0) PG8_BAR; }
        if constexpr (!Epi::AFTER_DRAIN) { E(acc, cur, wr, wc, fr, fq); S.done(cur); }
        if (!has_next) break;
#pragma unroll
        for (int a = 0; a < 2; ++a)
#pragma unroll
            for (int b = 0; b < 2; ++b)
#pragma unroll
                for (int m = 0; m < 4; ++m)
#pragma unroll
                    for (int n = 0; n < 2; ++n) acc[a][b][m][n] = (f32x4){0.f, 0.f, 0.f, 0.f};
        cur = nxt; cA = nA; cB = nB; ++ui; cA2 = g.A2 ? (const char*)g.A2 + (size_t)cur.pm * tstepA : nullptr;
        if constexpr (ALIGN_EPI) { if (wr == 1) PG8_BAR; }
    }
    PG8_WAIT_V(0);
    if constexpr (!ALIGN_EPI) { if (wr == 0) PG8_BAR; }
    PG8_BAR;
    if constexpr (Epi::AFTER_DRAIN) { E.fused(acc, cur, wr, wc, fr, fq, lds, wid, lane); S.done(cur); }
#undef PG8_SA
#undef PG8_SB
#undef PG8_STAGE
#undef PG8_LDA
#undef PG8_LDB
#undef PG8_MMA
#undef PG8_WAIT_V
#undef PG8_WAIT_L
#undef PG8_BAR
#undef PG8_SCHED
}
}

DEV void stage_gemm_in(const Params& p, char* lds, int vb, int nvb) {
    pg8::Gemm g{(const bf16_t*)(p.ws + WS_UB), (const bf16_t*)(p.ws + WS_WIN), M, 4864, 1024, 1024, 1024};
    pg8::StaticOrder S; S.init(M, 4864, nvb, vb);
    pg8::EpiIn E{(bf16_t*)(p.ws + WS_PA), (bf16_t*)(p.ws + WS_PM), (bf16_t*)(p.ws + WS_PG)};
    pg8::gemm_phase<pg8::EpiIn, pg8::StaticOrder, true, true>((PG8_LAS unsigned char*)lds, g, S, E);
}
DEV void stage_gemm_merge(const Params& p, char* lds, int vb, int nvb) {
    pg8::Gemm g{(const bf16_t*)(p.ws + WS_AT), (const bf16_t*)(p.ws + WS_WA), M, 1024, 1024, 512, 1024, (const bf16_t*)(p.ws + WS_ML)};
    pg8::StaticOrder S; S.init(M, 1024, nvb, vb);
    pg8::EpiMergeF E{(const bf16_t*)(p.ws + WS_PG), (bf16_t*)(p.ws + WS_MG)};
    pg8::gemm_phase<pg8::EpiMergeF, pg8::StaticOrder, true, true>((PG8_LAS unsigned char*)lds, g, S, E);
}
DEV void stage_gemm_out(const Params& p, char* lds, int vb, int nvb) {
    pg8::Gemm g{(const bf16_t*)(p.ws + WS_MG), (const bf16_t*)(p.ws + WS_WOUT), M, 1024, 1024, 1024, 1024};
    pg8::StaticOrder S; S.init(M, 1024, nvb, vb);
    pg8::EpiOut E{p.x, (const float*)(p.ws + WS_MOD) + 2048, p.out, SEQ};
    pg8::gemm_phase<pg8::EpiOut, pg8::StaticOrder, true, true>((PG8_LAS unsigned char*)lds, g, S, E);
}

DEV void rope8(u32x4 x1, u32x4 x2, const float4* rp, float scale, u32x4& o1, u32x4& o2) {
#pragma unroll
    for (int w = 0; w < 4; ++w) {
        const float4 cs = rp[w];
        const float a0 = bflo(x1[w]), a1 = bfhi(x1[w]), b0 = bflo(x2[w]), b1 = bfhi(x2[w]);
        o1[w] = pk2((a0 * cs.x - b0 * cs.y) * scale, (a1 * cs.z - b1 * cs.w) * scale);
        o2[w] = pk2((b0 * cs.x + a0 * cs.y) * scale, (b1 * cs.z + a1 * cs.w) * scale);
    }
}

DEV void stage_attn(const Params& p, char* lds, int vb, int nvb) {
    const int tid = threadIdx.x, lane = tid & 63, wave = __builtin_amdgcn_readfirstlane(tid >> 6), fr = lane & 15, fq = lane >> 4;
    char* Ks = lds;
    char* VT = lds + 32768;
    char* Qs = lds + 70656;
    char* Ps = lds + 87040;
    bf16_t* PA = (bf16_t*)(p.ws + WS_PA);
    const float2* rope = (const float2*)(p.ws + WS_ROPE);
    for (int unit = vb; unit < 512; unit += nvb) {
        const int kvh = unit & 1, n = (unit >> 1) & 127, b = unit >> 8;
        __syncthreads();
        for (int task = tid; task < 1024; task += NTH) {
            const int ki = task >> 2, cp = task & 3, pos = 128 * (n - 1) + ki;
            u32x4 o1, o2;
            {
                const int pc = pos < 0 ? 0 : pos;
                const bf16_t* src = PA + (size_t)(b * SEQ + pc) * LPA + 512 + kvh * 64 + cp * 8;
                const u32x4 x1 = *(const u32x4*)src, x2 = *(const u32x4*)(src + 32);
                rope8(x1, x2, (const float4*)(rope + (size_t)pc * 32 + cp * 8), 1.0f, o1, o2);
                if (pos < 0) { o1 = (u32x4){0u, 0u, 0u, 0u}; o2 = o1; }
            }
            const int sw = ki & 7;
            *(u32x4*)(Ks + ki * 128 + ((cp ^ sw) << 4)) = o1;
            *(u32x4*)(Ks + ki * 128 + (((cp + 4) ^ sw) << 4)) = o2;
        }
        for (int task = tid; task < 2048; task += NTH) {
            const int ki = task >> 3, c = task & 7, pos = 128 * (n - 1) + ki;
            u32x4 x = *(const u32x4*)(PA + (size_t)(b * SEQ + (pos < 0 ? 0 : pos)) * LPA + 640 + kvh * 64 + c * 8);
            if (pos < 0) x = (u32x4){0u, 0u, 0u, 0u};
#pragma unroll
            for (int e = 0; e < 8; ++e) *(bf16_t*)(VT + (c * 8 + e) * 592 + ki * 2) = (bf16_t)((e & 1) ? (x[e >> 1] >> 16) : (x[e >> 1] & 0xffffu));
        }
        for (int i = tid; i < 64 * 40; i += NTH) { const int d = i / 40, kk = 256 + i % 40; *(bf16_t*)(VT + d * 592 + kk * 2) = 0; }
        for (int i = tid; i < 2048; i += NTH) { const int w = i >> 8, r = (i >> 4) & 15, kk = 144 + (i & 15); *(bf16_t*)(Ps + w * 5376 + r * 336 + kk * 2) = 0; }
        for (int j = 0; j < 4; ++j) {
            const int hq = kvh * 4 + j;
            {
                const int qi = tid >> 2, cp = tid & 3, pos = 128 * n + qi;
                const bf16_t* src = PA + (size_t)(b * SEQ + pos) * LPA + hq * 64 + cp * 8;
                const u32x4 x1 = *(const u32x4*)src, x2 = *(const u32x4*)(src + 32);
                u32x4 o1, o2;
                rope8(x1, x2, (const float4*)(rope + (size_t)pos * 32 + cp * 8), 0.125f, o1, o2);
                const int sw = qi & 7;
                *(u32x4*)(Qs + qi * 128 + ((cp ^ sw) << 4)) = o1;
                *(u32x4*)(Qs + qi * 128 + (((cp + 4) ^ sw) << 4)) = o2;
            }
            __syncthreads();
            f32x4 s[9];
            const int sw = fr & 7;
            bf16x8 qf[2];
#pragma unroll
            for (int ks = 0; ks < 2; ++ks) qf[ks] = *(const bf16x8*)(Qs + (16 * wave + fr) * 128 + (((fq + 4 * ks) ^ sw) << 4));
#pragma unroll
            for (int t = 0; t < 9; ++t) {
                s[t] = (f32x4){0.f, 0.f, 0.f, 0.f};
#pragma unroll
                for (int ks = 0; ks < 2; ++ks) { const bf16x8 kf = *(const bf16x8*)(Ks + (16 * (wave + t) + fr) * 128 + (((fq + 4 * ks) ^ sw) << 4)); s[t] = mfma16(kf, qf[ks], s[t]); }
            }
            const float sink = p.sinks[hq];
            float mx = sink;
#pragma unroll
            for (int t = 0; t < 9; ++t)
#pragma unroll
                for (int r = 0; r < 4; ++r) {
                    const int dd = 16 * t + 4 * fq + r - fr, ki = 16 * (wave + t) + 4 * fq + r;
                    const bool ok = (dd >= 1) && (dd <= 128) && (n > 0 || ki >= 128);
                    const float v = ok ? s[t][r] : -INFINITY;
                    s[t][r] = v; mx = fmaxf(mx, v);
                }
            mx = fmaxf(mx, __shfl_xor(mx, 16)); mx = fmaxf(mx, __shfl_xor(mx, 32));
            float sum = 0.f;
#pragma unroll
            for (int t = 0; t < 9; ++t)
#pragma unroll
                for (int r = 0; r < 4; ++r) { const float pv = __expf(s[t][r] - mx); s[t][r] = pv; sum += pv; }
            sum += __shfl_xor(sum, 16); sum += __shfl_xor(sum, 32);
            const float inv = 1.f / (sum + __expf(sink - mx));
            char* Pw = Ps + wave * 5376 + fr * 336;
#pragma unroll
            for (int t = 0; t < 9; ++t) { u32x2 o; o.x = pk2(s[t][0], s[t][1]); o.y = pk2(s[t][2], s[t][3]); *(u32x2*)(Pw + (16 * t + 4 * fq) * 2) = o; }
            __syncthreads();
            f32x4 o[4];
#pragma unroll
            for (int di = 0; di < 4; ++di) o[di] = (f32x4){0.f, 0.f, 0.f, 0.f};
#pragma unroll
            for (int ks = 0; ks < 5; ++ks) {
                const bf16x8 pf = *(const bf16x8*)(Pw + (32 * ks + 8 * fq) * 2);
#pragma unroll
                for (int di = 0; di < 4; ++di) { const bf16x8 vf = *(const bf16x8*)(VT + (16 * di + fr) * 592 + (16 * wave + 32 * ks + 8 * fq) * 2); o[di] = mfma16(vf, pf, o[di]); }
            }
            bf16_t* dst = (bf16_t*)(p.ws + WS_AT) + (size_t)(b * SEQ + 128 * n + 16 * wave + fr) * 512 + hq * 64 + 4 * fq;
#pragma unroll
            for (int di = 0; di < 4; ++di) { u32x2 w; w.x = pk2(o[di][0] * inv, o[di][1] * inv); w.y = pk2(o[di][2] * inv, o[di][3] * inv); *(u32x2*)(dst + 16 * di) = w; }
            __syncthreads();
        }
    }
}

DEV float logsigf(float x) { return fminf(x, 0.f) - log1pf(expf(-fabsf(x))); }

DEV void chunk_gates(const float* ipre, const float* fpre, int rowbase, int h, float* gs, int lane) {
    const int l0 = 2 * lane;
    const float i0 = ipre[(size_t)(rowbase + l0) * 4 + h], i1 = ipre[(size_t)(rowbase + l0 + 1) * 4 + h];
    const float lf0 = logsigf(fpre[(size_t)(rowbase + l0) * 4 + h]), lf1 = logsigf(fpre[(size_t)(rowbase + l0 + 1) * 4 + h]);
    const float pair = lf0 + lf1;
    float sc = pair;
#pragma unroll
    for (int o = 1; o < 64; o <<= 1) { const float t = __shfl_up(sc, o); if (lane >= o) sc += t; }
    const float b0 = (sc - pair) + lf0, b1 = b0 + lf1;
    const float g = __shfl(sc, 63);
    const float a0 = g - b0 + i0, a1 = g - b1 + i1;
    const float mloc = wave_max(fmaxf(a0, a1));
    const float ib0 = i0 - b0, ib1 = i1 - b1;
    float scm = fmaxf(ib0, ib1);
#pragma unroll
    for (int o = 1; o < 64; o <<= 1) { const float t = __shfl_up(scm, o); if (lane >= o) scm = fmaxf(scm, t); }
    float ex = __shfl_up(scm, 1); if (lane == 0) ex = -INFINITY;
    const float pm0 = fmaxf(ex, ib0), pm1 = fmaxf(pm0, ib1);
    gs[l0] = b0; gs[l0 + 1] = b1; gs[128 + l0] = ib0; gs[128 + l0 + 1] = ib1; gs[256 + l0] = a0; gs[256 + l0 + 1] = a1; gs[384 + l0] = pm0; gs[384 + l0 + 1] = pm1;
    if (lane == 0) { gs[512] = g; gs[513] = mloc; }
}

DEV void conv8(const bf16_t* PM, const float* cw, int b, int t, int pmcol, int cch, float (&out)[8]) {
#pragma unroll
    for (int e = 0; e < 8; ++e) out[e] = 0.f;
#pragma unroll
    for (int j = 0; j < 4; ++j) {
        const int tt = t - 3 + j; const int tc = tt < 0 ? 0 : tt; const float z = tt < 0 ? 0.f : 1.f;
        const u32x4 x = *(const u32x4*)(PM + (size_t)(b * SEQ + tc) * LPM + pmcol);
        float4 w0 = *(const float4*)(cw + j * 1024 + cch), w1 = *(const float4*)(cw + j * 1024 + cch + 4);
        w0.x *= z; w0.y *= z; w0.z *= z; w0.w *= z; w1.x *= z; w1.y *= z; w1.z *= z; w1.w *= z;
        out[0] += bflo(x[0]) * w0.x; out[1] += bfhi(x[0]) * w0.y; out[2] += bflo(x[1]) * w0.z; out[3] += bfhi(x[1]) * w0.w;
        out[4] += bflo(x[2]) * w1.x; out[5] += bfhi(x[2]) * w1.y; out[6] += bflo(x[3]) * w1.z; out[7] += bfhi(x[3]) * w1.w;
    }
}

DEV void conv8r(const u32x4 (&r)[4], const float* cwl, int ch8, int t, float (&out)[8]) {
#pragma unroll
    for (int e = 0; e < 8; ++e) out[e] = 0.f;
#pragma unroll
    for (int j = 0; j < 4; ++j) {
        const float z = (t - 3 + j) < 0 ? 0.f : 1.f;
        const float4 w0 = *(const float4*)(cwl + j * 128 + ch8), w1 = *(const float4*)(cwl + j * 128 + ch8 + 4);
        out[0] += bflo(r[j][0]) * (w0.x * z); out[1] += bfhi(r[j][0]) * (w0.y * z); out[2] += bflo(r[j][1]) * (w0.z * z); out[3] += bfhi(r[j][1]) * (w0.w * z);
        out[4] += bflo(r[j][2]) * (w1.x * z); out[5] += bfhi(r[j][2]) * (w1.y * z); out[6] += bflo(r[j][3]) * (w1.z * z); out[7] += bfhi(r[j][3]) * (w1.w * z);
    }
}
DEV float siluf_(float y) { return y * __builtin_amdgcn_rcpf(1.f + __expf(-y)); }

DEV void stage_mstate(const Params& p, char* lds, int vb, int nvb) {
    const int tid = threadIdx.x, lane = tid & 63, wave = __builtin_amdgcn_readfirstlane(tid >> 6), fr = lane & 15, fq = lane >> 4;
    char* KT = lds;
    char* VT = lds + 34816;
    float* gs = (float*)(lds + 69632); float* s_cw = (float*)(lds + 73728);
    const bf16_t* PM = (const bf16_t*)(p.ws + WS_PM);
    const float* ipre = (const float*)(p.ws + WS_IPRE); const float* fpre = (const float*)(p.ws + WS_FPRE);
    float* UT = (float*)(p.ws + WS_UB); float* NLOC = (float*)(p.ws + WS_NLOC);
    float* G = (float*)(p.ws + WS_CHG); float* MLOC = G + 1024;
    for (int unit = vb; unit < 1024; unit += nvb) {
        const int c = unit & 127, h = (unit >> 7) & 3, b = unit >> 9;
        const int rowbase = b * SEQ + c * 128;
        __syncthreads();
        if (wave == 0) chunk_gates(ipre, fpre, rowbase, h, gs, lane);
        else if (tid >= 64 && tid < 192) { const int d = tid - 64;
#pragma unroll
            for (int j = 0; j < 4; ++j) s_cw[j * 128 + d] = p.conv_w[j * 1024 + 512 + h * 128 + d]; }
        __syncthreads();
        const float mloc = gs[513];
        for (int task = tid; task < 2048; task += NTH) {
            const int l = task >> 4, ch = task & 15, t = c * 128 + l;
            u32x4 rk[4];
#pragma unroll
            for (int j = 0; j < 4; ++j) { const int tc = t - 3 + j < 0 ? 0 : t - 3 + j; rk[j] = *(const u32x4*)(PM + (size_t)(b * SEQ + tc) * LPM + 512 + h * 128 + ch * 8); }
            const u32x4 x = *(const u32x4*)(PM + (size_t)(rowbase + l) * LPM + 1024 + h * 128 + ch * 8);
            float v8[8]; conv8r(rk, s_cw, ch * 8, t, v8);
            const float wgt = __expf(gs[256 + l] - mloc) * 0.08838834764831845f;
#pragma unroll
            for (int e = 0; e < 8; ++e) *(bf16_t*)(KT + (ch * 8 + e) * 272 + l * 2) = (bf16_t)f2bf(siluf_(v8[e]) * wgt);
#pragma unroll
            for (int e = 0; e < 8; ++e) *(bf16_t*)(VT + (ch * 8 + e) * 272 + l * 2) = (bf16_t)((e & 1) ? (x[e >> 1] >> 16) : (x[e >> 1] & 0xffffu));
        }
        __syncthreads();
        f32x4 acc[8];
#pragma unroll
        for (int t = 0; t < 8; ++t) acc[t] = (f32x4){0.f, 0.f, 0.f, 0.f};
#pragma unroll
        for (int ks = 0; ks < 4; ++ks) {
            const bf16x8 vf = *(const bf16x8*)(VT + (16 * wave + fr) * 272 + (32 * ks + 8 * fq) * 2);
#pragma unroll
            for (int t = 0; t < 8; ++t) { const bf16x8 kf = *(const bf16x8*)(KT + (16 * t + fr) * 272 + (32 * ks + 8 * fq) * 2); acc[t] = mfma16(kf, vf, acc[t]); }
        }
        float* UTu = UT + (size_t)unit * 16384 + (16 * wave + fr) * 128 + 4 * fq;
#pragma unroll
        for (int t = 0; t < 8; ++t) *(f32x4*)(UTu + 16 * t) = acc[t];
        if (tid < 128) { float s = 0.f; for (int l = 0; l < 128; ++l) s += bf2f(*(const bf16_t*)(KT + tid * 272 + l * 2)); NLOC[unit * 128 + tid] = s; }
        if (tid == 0) { G[unit] = gs[512]; MLOC[unit] = mloc; }
    }
}

DEV void stage_mscan(const Params& p, char* lds, int vb, int nvb) {
    const int tid = threadIdx.x;
    float* s_dec = (float*)lds; float* s_scl = s_dec + 128;
    const float* UT = (const float*)(p.ws + WS_UB); const float* NLOC = (const float*)(p.ws + WS_NLOC);
    const float* G = (const float*)(p.ws + WS_CHG); const float* MLOC = G + 1024; float* MST = (float*)(p.ws + WS_CHG) + 2048;
    bf16_t* CST = (bf16_t*)(p.ws + WS_CST); float* NST = (float*)(p.ws + WS_NST);
    for (int item = vb; item < 256; item += nvb) {
        const int bh = item >> 5, part = item & 31;
        __syncthreads();
        float* s_g = s_dec + 256; float* s_ml = s_dec + 384; float* s_m = s_dec + 512;
        if (tid < 128) { s_g[tid] = G[bh * 128 + tid]; s_ml[tid] = MLOC[bh * 128 + tid]; }
        __syncthreads();
        if (tid == 0) { float m = 0.f; for (int c = 0; c < 128; ++c) { s_m[c] = m; m = fmaxf(s_g[c] + m, s_ml[c]); } s_m[128] = m; }
        __syncthreads();
        if (tid < 128) { const float m = s_m[tid], mn = s_m[tid + 1]; s_dec[tid] = expf(s_g[tid] + m - mn); s_scl[tid] = expf(s_ml[tid] - mn); if (part == 0) MST[bh * 128 + tid] = m; }
        __syncthreads();
        const int e = part * 512 + tid;
        float C = 0.f;
        const float* up = UT + (size_t)bh * 128 * 16384 + e; bf16_t* cp = CST + (size_t)bh * 128 * 16384 + e;
        for (int c = 0; c < 128; c += 32) {
            float uu[32];
#pragma unroll
            for (int i = 0; i < 32; ++i) uu[i] = up[(size_t)(c + i) * 16384];
#pragma unroll
            for (int i = 0; i < 32; ++i) { cp[(size_t)(c + i) * 16384] = (bf16_t)f2bf(C); C = s_dec[c + i] * C + s_scl[c + i] * uu[i]; }
        }
        if (part == 0 && tid < 128) {
            float nn = 0.f;
            for (int c = 0; c < 128; c += 32) {
                float nv[32];
#pragma unroll
                for (int i = 0; i < 32; ++i) nv[i] = NLOC[(bh * 128 + c + i) * 128 + tid];
#pragma unroll
                for (int i = 0; i < 32; ++i) { NST[(bh * 128 + c + i) * 128 + tid] = nn; nn = s_dec[c + i] * nn + s_scl[c + i] * nv[i]; }
            }
        }
    }
}

DEV void stage_mout(const Params& p, char* lds, int vb, int nvb) {
    const int tid = threadIdx.x, lane = tid & 63, wave = __builtin_amdgcn_readfirstlane(tid >> 6), fr = lane & 15, fq = lane >> 4;
    char* Qs = lds; char* Ks = lds + 34816; char* VT = lds + 69632; char* CT = lds + 104448;
    float* gs = (float*)(lds + 139264); float* s_nst = gs + 520; float* s_mo = gs + 648; float* s_wi = gs + 776; float* s_cw = (float*)(lds + 143360);
    bf16_t* PM = (bf16_t*)(p.ws + WS_PM);
    const float* ipre = (const float*)(p.ws + WS_IPRE); const float* fpre = (const float*)(p.ws + WS_FPRE);
    const float* MST = (const float*)(p.ws + WS_CHG) + 2048; const float* NST = (const float*)(p.ws + WS_NST);
    const bf16_t* CST = (const bf16_t*)(p.ws + WS_CST);
    for (int unit = vb; unit < 1024; unit += nvb) {
        const int c = unit & 127, h = (unit >> 7) & 3, b = unit >> 9;
        const int rowbase = b * SEQ + c * 128;
        __syncthreads();
        if (tid < 256) { const int d = tid & 127, kq = tid >> 7;
#pragma unroll
            for (int j = 0; j < 4; ++j) s_cw[kq * 512 + j * 128 + d] = p.conv_w[j * 1024 + kq * 512 + h * 128 + d]; }
        __syncthreads();
        if (wave == 0) chunk_gates(ipre, fpre, rowbase, h, gs, lane);
        for (int task = tid; task < 2048; task += NTH) {
            const int l = task >> 4, ch = task & 15, t = c * 128 + l;
            u32x4 rq[4], rk[4];
#pragma unroll
            for (int j = 0; j < 4; ++j) { const int tc = t - 3 + j < 0 ? 0 : t - 3 + j; const bf16_t* rp = PM + (size_t)(b * SEQ + tc) * LPM + h * 128 + ch * 8; rq[j] = *(const u32x4*)rp; rk[j] = *(const u32x4*)(rp + 512); }
            const u32x4 x = *(const u32x4*)(PM + (size_t)(rowbase + l) * LPM + 1024 + h * 128 + ch * 8);
            const u32x4 cst = *(const u32x4*)(CST + (size_t)unit * 16384 + l * 128 + ch * 8);
            float v8[8]; u32x4 o;
            conv8r(rq, s_cw, ch * 8, t, v8);
            o.x = pk2(siluf_(v8[0]), siluf_(v8[1])); o.y = pk2(siluf_(v8[2]), siluf_(v8[3])); o.z = pk2(siluf_(v8[4]), siluf_(v8[5])); o.w = pk2(siluf_(v8[6]), siluf_(v8[7]));
            *(u32x4*)(Qs + l * 272 + ch * 16) = o;
            conv8r(rk, s_cw + 512, ch * 8, t, v8);
            const float sc = 0.08838834764831845f;
            o.x = pk2(siluf_(v8[0]) * sc, siluf_(v8[1]) * sc); o.y = pk2(siluf_(v8[2]) * sc, siluf_(v8[3]) * sc); o.z = pk2(siluf_(v8[4]) * sc, siluf_(v8[5]) * sc); o.w = pk2(siluf_(v8[6]) * sc, siluf_(v8[7]) * sc);
            *(u32x4*)(Ks + l * 272 + ch * 16) = o;
#pragma unroll
            for (int e = 0; e < 8; ++e) *(bf16_t*)(VT + (ch * 8 + e) * 272 + l * 2) = (bf16_t)((e & 1) ? (x[e >> 1] >> 16) : (x[e >> 1] & 0xffffu));
            *(u32x4*)(CT + l * 272 + ch * 16) = cst;
        }
        if (tid < 128) s_nst[tid] = NST[unit * 128 + tid];
        __syncthreads();
        if (tid < 128) { const float mst = MST[unit]; const float bc = gs[tid]; const float mo = bc + fmaxf(mst, gs[384 + tid]); s_mo[tid] = mo; s_wi[tid] = __expf(bc + mst - mo); }
        __syncthreads();
        const int l = 16 * wave + fr;
        f32x4 s[8];
        bf16x8 qf[4];
#pragma unroll
        for (int ks = 0; ks < 4; ++ks) qf[ks] = *(const bf16x8*)(Qs + l * 272 + (32 * ks + 8 * fq) * 2);
#pragma unroll
        for (int t = 0; t < 8; ++t) {
            s[t] = (f32x4){0.f, 0.f, 0.f, 0.f};
            if (t <= wave) {
#pragma unroll
                for (int ks = 0; ks < 4; ++ks) { const bf16x8 kf = *(const bf16x8*)(Ks + (16 * t + fr) * 272 + (32 * ks + 8 * fq) * 2); s[t] = mfma16(kf, qf[ks], s[t]); }
            }
        }
        const float bl = gs[l], mol = s_mo[l];
        float dsum = 0.f;
#pragma unroll
        for (int t = 0; t < 8; ++t)
#pragma unroll
            for (int r = 0; r < 4; ++r) {
                const int si = 16 * t + 4 * fq + r; float wv = 0.f;
                if (t <= wave && si <= l) wv = __expf(bl + gs[128 + si] - mol) * s[t][r];
                s[t][r] = wv; dsum += wv;
            }
        dsum += __shfl_xor(dsum, 16); dsum += __shfl_xor(dsum, 32);
        float qn = 0.f;
        {
            const char* qrow = Qs + l * 272 + fq * 64;
#pragma unroll
            for (int i = 0; i < 4; ++i) {
                const u32x4 x = *(const u32x4*)(qrow + 16 * i); const float* nn = s_nst + fq * 32 + 8 * i;
                qn += bflo(x[0]) * nn[0] + bfhi(x[0]) * nn[1] + bflo(x[1]) * nn[2] + bfhi(x[1]) * nn[3] + bflo(x[2]) * nn[4] + bfhi(x[2]) * nn[5] + bflo(x[3]) * nn[6] + bfhi(x[3]) * nn[7];
            }
        }
        qn += __shfl_xor(qn, 16); qn += __shfl_xor(qn, 32);
        __syncthreads();
#pragma unroll
        for (int t = 0; t < 8; ++t)
            if (t <= wave + 1) { u32x2 o; o.x = pk2(s[t][0], s[t][1]); o.y = pk2(s[t][2], s[t][3]); *(u32x2*)(Ks + l * 272 + (16 * t + 4 * fq) * 2) = o; }
        __syncthreads();
        f32x4 acc[8];
#pragma unroll
        for (int t = 0; t < 8; ++t) acc[t] = (f32x4){0.f, 0.f, 0.f, 0.f};
#pragma unroll
        for (int ks = 0; ks < 4; ++ks)
#pragma unroll
            for (int t = 0; t < 8; ++t) { const bf16x8 cf = *(const bf16x8*)(CT + (16 * t + fr) * 272 + (32 * ks + 8 * fq) * 2); acc[t] = mfma16(cf, qf[ks], acc[t]); }
        const float wi = s_wi[l];
#pragma unroll
        for (int t = 0; t < 8; ++t) acc[t] = acc[t] * wi;
        const int nks = (wave + 2) >> 1;
#pragma unroll
        for (int ks = 0; ks < 4; ++ks)
            if (ks < nks) {
                const bf16x8 wf = *(const bf16x8*)(Ks + l * 272 + (32 * ks + 8 * fq) * 2);
#pragma unroll
                for (int t = 0; t < 8; ++t) { const bf16x8 vf = *(const bf16x8*)(VT + (16 * t + fr) * 272 + (32 * ks + 8 * fq) * 2); acc[t] = mfma16(vf, wf, acc[t]); }
            }
        const float den = dsum + wi * qn;
        const float invd = 1.f / fmaxf(fabsf(den), __expf(-mol));
        bf16_t* mop = PM + (size_t)(rowbase + l) * LPM + 1536 + h * 128 + 4 * fq;
        float ssq = 0.f;
        u32x2 g2v[8]; float4 nwv[8];
#pragma unroll
        for (int t = 0; t < 8; ++t) { g2v[t] = *(const u32x2*)(mop + 16 * t); nwv[t] = *(const float4*)(p.mnorm_w + h * 128 + 16 * t + 4 * fq); }
#pragma unroll
        for (int t = 0; t < 8; ++t) {
            const u32x2 g2 = g2v[t];
            const float gg[4] = {bflo(g2.x), bfhi(g2.x), bflo(g2.y), bfhi(g2.y)};
#pragma unroll
            for (int r = 0; r < 4; ++r) { const float hv = acc[t][r] * invd * sigmoidf_(gg[r]); acc[t][r] = hv; ssq += hv * hv; }
        }
        ssq += __shfl_xor(ssq, 16); ssq += __shfl_xor(ssq, 32);
        const float rn = rsqrtf(ssq * (1.f / 128.f) + 1e-6f);
#pragma unroll
        for (int t = 0; t < 8; ++t) {
            const float4 nw = nwv[t];
            u32x2 o; o.x = pk2(acc[t][0] * rn * nw.x, acc[t][1] * rn * nw.y); o.y = pk2(acc[t][2] * rn * nw.z, acc[t][3] * rn * nw.w);
            *(u32x2*)((bf16_t*)(p.ws + WS_ML) + (size_t)(rowbase + l) * 512 + h * 128 + 4 * fq + 16 * t) = o;
        }
    }
}

DEV void stage_norm2(const Params& p, char* lds, int vb, int nvb) {
    const int tid = threadIdx.x, lane = tid & 63, wave = __builtin_amdgcn_readfirstlane(tid >> 6);
    const float* mod = (const float*)(p.ws + WS_MOD);
    bf16_t* U2 = (bf16_t*)(p.ws + WS_PG);
    const int rstride = nvb * NW;
    for (int mb = vb * NW + wave; mb < M; mb += 4 * rstride) {
        float4 vv[4][4];
#pragma unroll
        for (int rr = 0; rr < 4; ++rr) { const int mr = mb + rr * rstride < M ? mb + rr * rstride : mb; const float4* xr = (const float4*)(p.out + (size_t)mr * D);
#pragma unroll
            for (int j = 0; j < 4; ++j) vv[rr][j] = xr[lane + 64 * j]; }
#pragma unroll
        for (int rr = 0; rr < 4; ++rr) {
            const int m = mb + rr * rstride;
            if (m < M) {
                const int b = m >= SEQ ? 1 : 0;
                float ss = 0.f;
#pragma unroll
                for (int j = 0; j < 4; ++j) { const float4 v = vv[rr][j]; ss += v.x * v.x + v.y * v.y + v.z * v.z + v.w * v.w; }
                ss = wave_sum(ss);
                const float rstd = rsqrtf(ss * (1.f / 1024.f) + 1e-6f);
#pragma unroll
                for (int j = 0; j < 4; ++j) {
                    const int col = 4 * (lane + 64 * j); const float4 v = vv[rr][j];
                    const float4 w1 = *(const float4*)(p.norm2_w + col), sc = *(const float4*)(mod + b * 6144 + 4096 + col), sh = *(const float4*)(mod + b * 6144 + 3072 + col);
                    u32x2 o;
                    o.x = pk2(v.x * rstd * w1.x * (1.f + sc.x) + sh.x, v.y * rstd * w1.y * (1.f + sc.y) + sh.y);
                    o.y = pk2(v.z * rstd * w1.z * (1.f + sc.z) + sh.z, v.w * rstd * w1.w * (1.f + sc.w) + sh.w);
                    *(u32x2*)(U2 + (size_t)m * D + col) = o;
                }
            }
        }
    }
}

constexpr size_t WS_SELI = 400 * MiB;
constexpr size_t WS_SELG = 416 * MiB;
constexpr size_t WS_SC = 64 * MiB;
DEV unsigned f2ord(float f) { const unsigned u = __float_as_uint(f); return (u & 0x80000000u) ? ~u : (u | 0x80000000u); }
DEV float ord2f(unsigned k) { return __uint_as_float((k & 0x80000000u) ? (k ^ 0x80000000u) : ~k); }
DEV unsigned umax_(unsigned a, unsigned b) { return a > b ? a : b; }

DEV void stage_gemm_q(const Params& p, char* lds, int vb, int nvb) {
    pg8::Gemm g{(const bf16_t*)(p.ws + WS_PG), (const bf16_t*)(p.ws + WS_WQ), M, 2048, 1024, 1024, 1024};
    pg8::StaticOrder S; S.init(M, 2048, nvb, vb);
    pg8::EpiF32 E{(float*)(p.ws + WS_SC), 2048};
    pg8::gemm_phase<pg8::EpiF32, pg8::StaticOrder, true, true>((PG8_LAS unsigned char*)lds, g, S, E);
}

DEV unsigned umin_(unsigned a, unsigned b) { return a < b ? a : b; }
template <int N> DEV void bitonic_sort_desc(unsigned (&a)[N]) {
#pragma unroll
    for (int k = 2; k <= N; k <<= 1)
#pragma unroll
        for (int j = k >> 1; j > 0; j >>= 1)
#pragma unroll
            for (int i = 0; i < N; ++i) { const int l = i ^ j; if (l > i) { const unsigned x = a[i], y = a[l]; const bool dsc = (i & k) == 0; a[i] = dsc ? umax_(x, y) : umin_(x, y); a[l] = dsc ? umin_(x, y) : umax_(x, y); } }
}
template <int N> DEV void bitonic_merge_desc(unsigned (&a)[N]) {
#pragma unroll
    for (int j = N >> 1; j > 0; j >>= 1)
#pragma unroll
        for (int i = 0; i < N; ++i) { const int l = i ^ j; if (l > i) { const unsigned x = a[i], y = a[l]; a[i] = umax_(x, y); a[l] = umin_(x, y); } }
}
template <bool X16> DEV void merge_top16_xlane(unsigned (&x)[16], int lane) {
    unsigned m[16];
#pragma unroll
    for (int i = 0; i < 16; ++i) {
        unsigned pv;
        if (X16) { auto r = __builtin_amdgcn_permlane16_swap(x[15 - i], x[15 - i], false, false); pv = (lane & 16) ? r[0] : r[1]; }
        else { auto r = __builtin_amdgcn_permlane32_swap(x[15 - i], x[15 - i], false, false); pv = (lane & 32) ? r[0] : r[1]; }
        m[i] = umax_(x[i], pv);
    }
    bitonic_merge_desc<16>(m);
#pragma unroll
    for (int i = 0; i < 16; ++i) x[i] = m[i];
}

DEV void stage_q_topk(const Params& p, char* lds, int vb, int nvb) {
    const int tid = threadIdx.x, lane = tid & 63, wave = __builtin_amdgcn_readfirstlane(tid >> 6), fr = lane & 15, fq = lane >> 4;
    unsigned* tops = (unsigned*)lds;
    unsigned char* ptab = (unsigned char*)(lds + 16384);
    const float* SC = (const float*)(p.ws + WS_SC);
    int* SELI = (int*)(p.ws + WS_SELI); float* SELG = (float*)(p.ws + WS_SELG);
    __syncthreads();
    if (tid < 64) { int cnt = 0; unsigned char v = 0xff; for (int i = 0; i < 16; ++i) for (int j = 0; j < 16 / (i + 1); ++j) { if (cnt == tid) v = (unsigned char)(i | (j << 4)); ++cnt; } ptab[tid] = v; }
    __syncthreads();
    for (int item = vb; item < 2048; item += nvb) {
        const int mt = item >> 3, h = item & 7, m0 = mt * 128;
        const float* srow = SC + (size_t)(m0 + 16 * wave + fr) * 2048 + h * 256 + 4 * fq;
        f32x4 sv[2][8];
#pragma unroll
        for (int pp = 0; pp < 2; ++pp)
#pragma unroll
            for (int t = 0; t < 8; ++t) sv[pp][t] = *(const f32x4*)(srow + pp * 128 + 16 * t);
        unsigned* tp = tops + (16 * wave + fr) * 32;
#pragma unroll
        for (int pp = 0; pp < 2; ++pp) {
            unsigned lo[16], hi[16];
#pragma unroll
            for (int t = 0; t < 4; ++t)
#pragma unroll
                for (int r = 0; r < 4; ++r) {
                    lo[4 * t + r] = (f2ord(sv[pp][t][r]) & ~127u) | (127u - (unsigned)(16 * t + 4 * fq + r));
                    hi[4 * t + r] = (f2ord(sv[pp][t + 4][r]) & ~127u) | (127u - (unsigned)(16 * (t + 4) + 4 * fq + r));
                }
            bitonic_sort_desc<16>(lo); bitonic_sort_desc<16>(hi);
#pragma unroll
            for (int i = 0; i < 16; ++i) lo[i] = umax_(lo[i], hi[15 - i]);
            bitonic_merge_desc<16>(lo);
            merge_top16_xlane<true>(lo, lane); merge_top16_xlane<false>(lo, lane);
            if (fq == 0) {
#pragma unroll
                for (int q = 0; q < 4; ++q) *(u32x4*)(tp + pp * 16 + 4 * q) = (u32x4){lo[4 * q], lo[4 * q + 1], lo[4 * q + 2], lo[4 * q + 3]};
            }
        }
        wave_lds_sync();
        unsigned ck[16];
#pragma unroll
        for (int sl = 0; sl < 13; ++sl) {
            const unsigned pr = ptab[4 * sl + fq]; const unsigned i = pr & 15u, j = pr >> 4;
            const float sum = ord2f(tp[i] & ~127u) + ord2f(tp[16 + (j & 15u)] & ~127u);
            ck[sl] = pr != 0xffu ? ((f2ord(sum) & ~255u) | (255u - (i * 16u + j))) : 0u;
        }
        ck[13] = 0u; ck[14] = 0u; ck[15] = 0u;
        bitonic_sort_desc<16>(ck);
        merge_top16_xlane<true>(ck, lane); merge_top16_xlane<false>(ck, lane);
        const float v0 = ord2f(ck[0] & ~255u);
        float ex[16], sm = 0.f;
#pragma unroll
        for (int r = 0; r < 16; ++r) { ex[r] = __expf(ord2f(ck[r] & ~255u) - v0); sm += ex[r]; }
        const float rs = 1.f / sm;
        int oi[4]; float og[4];
#pragma unroll
        for (int q = 0; q < 4; ++q) {
            const unsigned w = fq == 0 ? ck[q] : (fq == 1 ? ck[4 + q] : (fq == 2 ? ck[8 + q] : ck[12 + q]));
            const float e = fq == 0 ? ex[q] : (fq == 1 ? ex[4 + q] : (fq == 2 ? ex[8 + q] : ex[12 + q]));
            const unsigned flat = 255u - (w & 255u); const unsigned ia = flat >> 4, jb = flat & 15u;
            oi[q] = (int)((127u - (tp[ia] & 127u)) * 128u + (127u - (tp[16 + jb] & 127u)));
            og[q] = e * rs;
        }
        const size_t so = (size_t)(m0 + 16 * wave + fr) * 128 + h * 16 + 4 * fq;
        *(int4*)(SELI + so) = make_int4(oi[0], oi[1], oi[2], oi[3]);
        *(float4*)(SELG + so) = make_float4(og[0], og[1], og[2], og[3]);
        wave_lds_sync();
    }
}

DEV float dpp_row_sum(float v) {
    v += __int_as_float(__builtin_amdgcn_update_dpp(0, __float_as_int(v), 0xB1, 0xF, 0xF, true));
    v += __int_as_float(__builtin_amdgcn_update_dpp(0, __float_as_int(v), 0x4E, 0xF, 0xF, true));
    v += __int_as_float(__builtin_amdgcn_update_dpp(0, __float_as_int(v), 0x141, 0xF, 0xF, true));
    v += __int_as_float(__builtin_amdgcn_update_dpp(0, __float_as_int(v), 0x140, 0xF, 0xF, true));
    return v;
}
DEV int dpp_row_isum(int v) {
    v += __builtin_amdgcn_update_dpp(0, v, 0xB1, 0xF, 0xF, true); v += __builtin_amdgcn_update_dpp(0, v, 0x4E, 0xF, 0xF, true);
    v += __builtin_amdgcn_update_dpp(0, v, 0x141, 0xF, 0xF, true); v += __builtin_amdgcn_update_dpp(0, v, 0x140, 0xF, 0xF, true);
    return v;
}
DEV float dpp_row_max(float v) {
    v = fmaxf(v, __int_as_float(__builtin_amdgcn_update_dpp(0, __float_as_int(v), 0xB1, 0xF, 0xF, true))); v = fmaxf(v, __int_as_float(__builtin_amdgcn_update_dpp(0, __float_as_int(v), 0x4E, 0xF, 0xF, true)));
    v = fmaxf(v, __int_as_float(__builtin_amdgcn_update_dpp(0, __float_as_int(v), 0x141, 0xF, 0xF, true))); v = fmaxf(v, __int_as_float(__builtin_amdgcn_update_dpp(0, __float_as_int(v), 0x140, 0xF, 0xF, true)));
    return v;
}
DEV float gelu_as(float v) {
    const float av = fabsf(v), t = __builtin_amdgcn_rcpf(av * 0.2316418882f + 1.0f);
    float q = t * 0.5307027145f + (-0.7265760135f); q = q * t + 0.7107068705f; q = q * t + (-0.142248368f); q = q * t + 0.127414796f; q = q * t;
    const float e = __builtin_amdgcn_exp2f(v * v * (-0.72134752044f));
    const float m = v * (q * e);
    return v < 0.f ? m : v - m;
}
constexpr int NBIN = 16;
constexpr int GW_IDX = 0, GW_GATE = 1024, GW_SU = 3072, GW_SV = 5120, GW_W = 7168, GW_WQ = 9216, GW_BYTES = 9728;
DEV void g_sort_token(const int* SELI, const float* SELG, const float* SU, const float* SV, int tkn, char* wl, int j, int lane, int msk) {
    const int i0 = SELI[(size_t)tkn * 128 + lane] & msk, i1 = SELI[(size_t)tkn * 128 + 64 + lane] & msk;
    const float g0 = SELG[(size_t)tkn * 128 + lane], g1 = SELG[(size_t)tkn * 128 + 64 + lane];
    const float su0 = SU[i0], su1 = SU[i1], sv0 = SV[i0], sv1 = SV[i1];
    const int s0 = i0 >> 10, s1 = i1 >> 10;
    const unsigned long long lt = (1ull << lane) - 1ull;
    int base = 0, p0 = 0, p1 = 0;
#pragma unroll
    for (int s = 0; s < NBIN; ++s) {
        const unsigned long long m0 = __ballot(s0 == s), m1 = __ballot(s1 == s);
        const int c0 = __popcll(m0), c1 = __popcll(m1);
        if (s0 == s) p0 = base + __popcll(m0 & lt);
        if (s1 == s) p1 = base + c0 + __popcll(m1 & lt);
        base += c0 + c1;
    }
    unsigned short* li = (unsigned short*)(wl + GW_IDX) + j * 128; float* lg = (float*)(wl + GW_GATE) + j * 128; float* lsu = (float*)(wl + GW_SU) + j * 128; float* lsv = (float*)(wl + GW_SV) + j * 128;
    li[p0] = (unsigned short)i0; lg[p0] = g0; lsu[p0] = su0; lsv[p0] = sv0;
    li[p1] = (unsigned short)i1; lg[p1] = g1; lsu[p1] = su1; lsv[p1] = sv1;
}
DEV void r_load(u32x4 (&d)[4], const unsigned char* T, int id, int c) {
    const u32x4* q = (const u32x4*)(T + (size_t)id * 1024) + c;
#pragma unroll
    for (int k = 0; k < 4; ++k) d[k] = q[16 * k];
}
DEV int r_dotq(const u32x4 (&u)[4], const unsigned (&xq)[16]) {
    int s0 = 0, s1 = 0, s2 = 0, s3 = 0;
#pragma unroll
    for (int k = 0; k < 4; ++k) {
        s0 = __builtin_amdgcn_sdot4((int)u[k][0], (int)xq[4 * k], s0, false); s1 = __builtin_amdgcn_sdot4((int)u[k][1], (int)xq[4 * k + 1], s1, false);
        s2 = __builtin_amdgcn_sdot4((int)u[k][2], (int)xq[4 * k + 2], s2, false); s3 = __builtin_amdgcn_sdot4((int)u[k][3], (int)xq[4 * k + 3], s3, false);
    }
    return (s0 + s1) + (s2 + s3);
}
DEV float r_weight(int part, float sx, const char* wl, int r, int e) {
    const float d = (float)dpp_row_isum(part) * (((const float*)(wl + GW_SU))[r * 128 + e] * sx);
    return ((const float*)(wl + GW_GATE))[r * 128 + e] * gelu_as(d) * ((const float*)(wl + GW_SV))[r * 128 + e];
}
DEV void r_vaccq(const u32x4 (&v0)[4], const u32x4 (&v1)[4], const u32x4 (&v2)[4], const u32x4 (&v3)[4], unsigned wpk, int (&acc)[64]) {
#pragma unroll
    for (int k = 0; k < 4; ++k)
#pragma unroll
        for (int w = 0; w < 4; ++w) {
            const unsigned r0 = v0[k][w], r1 = v1[k][w], r2 = v2[k][w], r3 = v3[k][w];
            const unsigned p0 = __builtin_amdgcn_perm(r1, r0, 0x05010400u), p1 = __builtin_amdgcn_perm(r1, r0, 0x07030602u);
            const unsigned q0 = __builtin_amdgcn_perm(r3, r2, 0x05010400u), q1 = __builtin_amdgcn_perm(r3, r2, 0x07030602u);
            const unsigned t0 = __builtin_amdgcn_perm(q0, p0, 0x05040100u), t1 = __builtin_amdgcn_perm(q0, p0, 0x07060302u);
            const unsigned t2 = __builtin_amdgcn_perm(q1, p1, 0x05040100u), t3 = __builtin_amdgcn_perm(q1, p1, 0x07060302u);
            const int o = 16 * k + 4 * w;
            acc[o] = __builtin_amdgcn_sdot4((int)t0, (int)wpk, acc[o], false); acc[o + 1] = __builtin_amdgcn_sdot4((int)t1, (int)wpk, acc[o + 1], false);
            acc[o + 2] = __builtin_amdgcn_sdot4((int)t2, (int)wpk, acc[o + 2], false); acc[o + 3] = __builtin_amdgcn_sdot4((int)t3, (int)wpk, acc[o + 3], false);
        }
}
DEV void r_load2(u32x4 (&d)[2], const unsigned char* T, int id, int c, int hh) {
    const u32x4* q = (const u32x4*)(T + (size_t)id * 1024) + c + 32 * hh;
    d[0] = q[0]; d[1] = q[16];
}
template <int HH> DEV void r_vaccq2(const u32x4 (&v0)[2], const u32x4 (&v1)[2], const u32x4 (&v2)[2], const u32x4 (&v3)[2], unsigned wpk, int (&acc)[64]) {
#pragma unroll
    for (int kk = 0; kk < 2; ++kk)
#pragma unroll
        for (int w = 0; w < 4; ++w) {
            const unsigned r0 = v0[kk][w], r1 = v1[kk][w], r2 = v2[kk][w], r3 = v3[kk][w];
            const unsigned p0 = __builtin_amdgcn_perm(r1, r0, 0x05010400u), p1 = __builtin_amdgcn_perm(r1, r0, 0x07030602u);
            const unsigned q0 = __builtin_amdgcn_perm(r3, r2, 0x05010400u), q1 = __builtin_amdgcn_perm(r3, r2, 0x07030602u);
            const unsigned t0 = __builtin_amdgcn_perm(q0, p0, 0x05040100u), t1 = __builtin_amdgcn_perm(q0, p0, 0x07060302u);
            const unsigned t2 = __builtin_amdgcn_perm(q1, p1, 0x05040100u), t3 = __builtin_amdgcn_perm(q1, p1, 0x07060302u);
            const int o = 16 * (2 * HH + kk) + 4 * w;
            acc[o] = __builtin_amdgcn_sdot4((int)t0, (int)wpk, acc[o], false); acc[o + 1] = __builtin_amdgcn_sdot4((int)t1, (int)wpk, acc[o + 1], false);
            acc[o + 2] = __builtin_amdgcn_sdot4((int)t2, (int)wpk, acc[o + 2], false); acc[o + 3] = __builtin_amdgcn_sdot4((int)t3, (int)wpk, acc[o + 3], false);
        }
}
struct VB4 { u32x4 e0[2], e1[2], e2[2], e3[2]; };
DEV void vb_load(VB4& b, const unsigned char* TV, const unsigned short* myi, int g, int c, int hh) {
    const int e = g < 32 ? 4 * g : 124;
    r_load2(b.e0, TV, (int)myi[e], c, hh); r_load2(b.e1, TV, (int)myi[e + 1], c, hh); r_load2(b.e2, TV, (int)myi[e + 2], c, hh); r_load2(b.e3, TV, (int)myi[e + 3], c, hh);
}
template <int HH> DEV void pass2_half(const unsigned char* TV, const unsigned short* myi, const unsigned* lwq, int c, int (&acc)[64]) {
    VB4 ba, bb, bc, bd;
    vb_load(ba, TV, myi, 0, c, HH); vb_load(bb, TV, myi, 1, c, HH); vb_load(bc, TV, myi, 2, c, HH); vb_load(bd, TV, myi, 3, c, HH);
    for (int g = 0; g < 32; g += 4) {
        __builtin_amdgcn_sched_barrier(0); r_vaccq2<HH>(ba.e0, ba.e1, ba.e2, ba.e3, lwq[g], acc);     __builtin_amdgcn_sched_barrier(0); vb_load(ba, TV, myi, g + 4, c, HH);
        __builtin_amdgcn_sched_barrier(0); r_vaccq2<HH>(bb.e0, bb.e1, bb.e2, bb.e3, lwq[g + 1], acc); __builtin_amdgcn_sched_barrier(0); vb_load(bb, TV, myi, g + 5, c, HH);
        __builtin_amdgcn_sched_barrier(0); r_vaccq2<HH>(bc.e0, bc.e1, bc.e2, bc.e3, lwq[g + 2], acc); __builtin_amdgcn_sched_barrier(0); vb_load(bc, TV, myi, g + 6, c, HH);
        __builtin_amdgcn_sched_barrier(0); r_vaccq2<HH>(bd.e0, bd.e1, bd.e2, bd.e3, lwq[g + 3], acc); __builtin_amdgcn_sched_barrier(0); vb_load(bd, TV, myi, g + 7, c, HH);
        __builtin_amdgcn_sched_barrier(0);
    }
}
#define SB_() __builtin_amdgcn_sched_barrier(0)

DEV void stage_peer_gather(const Params& p, char* lds, int slot, int nslots, bool dry = false, int msk = 0x3fff) {
    const int tid = threadIdx.x, lane = tid & 63, wave = __builtin_amdgcn_readfirstlane(tid >> 6), r = lane >> 4, c = lane & 15;
    const bf16_t* U2 = (const bf16_t*)(p.ws + WS_PG);
    const unsigned char* TU = p.ws + WS_TU; const unsigned char* TV = p.ws + WS_TV;
    const float* SU = (const float*)(p.ws + WS_ISU); const float* SV = (const float*)(p.ws + WS_ISV);
    const int* SELI = (const int*)(p.ws + WS_SELI); const float* SELG = (const float*)(p.ws + WS_SELG);
    const float* mod = (const float*)(p.ws + WS_MOD);
    char* wl = lds + wave * GW_BYTES;
    const unsigned short* myi = (const unsigned short*)(wl + GW_IDX) + r * 128;
    float* lw = (float*)(wl + GW_W) + r * 128; unsigned* lwq = (unsigned*)(wl + GW_WQ) + r * 32;
    const int tpb = M / nslots;
    __syncthreads();
    for (int g0 = 0; g0 < tpb; g0 += 32) {
        __syncthreads();
        const int tbase = slot * tpb + g0 + 4 * wave;
#pragma unroll
        for (int j = 0; j < 4; ++j) g_sort_token(SELI, SELG, SU, SV, tbase + j, wl, j, lane, msk);
        const int tkn = tbase + r;
        unsigned xq[16]; float sx;
        {
            const bf16_t* xr = U2 + (size_t)tkn * D + 16 * c;
            u32x4 t[8]; float amax = 0.f;
#pragma unroll
            for (int k = 0; k < 8; ++k) { t[k] = *(const u32x4*)(xr + 256 * (k >> 1) + 8 * (k & 1));
#pragma unroll
                for (int i = 0; i < 4; ++i) amax = fmaxf(amax, fmaxf(fabsf(bflo(t[k][i])), fabsf(bfhi(t[k][i])))); }
            amax = dpp_row_max(amax);
            const float inv = amax > 0.f ? 127.f / amax : 0.f; sx = amax > 0.f ? amax * (1.f / 127.f) : 1.f;
#pragma unroll
            for (int k = 0; k < 8; ++k)
#pragma unroll
                for (int h2 = 0; h2 < 2; ++h2) {
                    const unsigned a = t[k][2 * h2], b = t[k][2 * h2 + 1];
                    const unsigned wv = ((unsigned)__float2int_rn(bflo(a) * inv) & 0xffu) | (((unsigned)__float2int_rn(bfhi(a) * inv) & 0xffu) << 8) | (((unsigned)__float2int_rn(bflo(b) * inv) & 0xffu) << 16) | ((unsigned)__float2int_rn(bfhi(b) * inv) << 24);
                    xq[2 * k + h2] = wv;
                }
        }
        wave_lds_sync();
        float wmax = 0.f;
        {
            u32x4 ua[4], ub[4], uc[4], ud[4];
            r_load(ua, TU, (int)myi[0], c); r_load(ub, TU, (int)myi[1], c); r_load(uc, TU, (int)myi[2], c); r_load(ud, TU, (int)myi[3], c);
            for (int e = 0; e < 128; e += 4) {
                SB_(); const int pa = r_dotq(ua, xq); SB_(); r_load(ua, TU, (int)myi[e + 4 < 128 ? e + 4 : 127], c); SB_();
                const int pb = r_dotq(ub, xq); SB_(); r_load(ub, TU, (int)myi[e + 5 < 128 ? e + 5 : 127], c); SB_();
                const int pc = r_dotq(uc, xq); SB_(); r_load(uc, TU, (int)myi[e + 6 < 128 ? e + 6 : 127], c); SB_();
                const int pd = r_dotq(ud, xq); SB_(); r_load(ud, TU, (int)myi[e + 7 < 128 ? e + 7 : 127], c); SB_();
                const float w0 = r_weight(pa, sx, wl, r, e), w1 = r_weight(pb, sx, wl, r, e + 1), w2 = r_weight(pc, sx, wl, r, e + 2), w3 = r_weight(pd, sx, wl, r, e + 3);
                wmax = fmaxf(fmaxf(wmax, fmaxf(fabsf(w0), fabsf(w1))), fmaxf(fabsf(w2), fabsf(w3)));
                if (c == 0) *(f32x4*)(lw + e) = (f32x4){w0, w1, w2, w3};
            }
        }
        __syncthreads();
        const float T = wmax > 0.f ? wmax * (1.f / 127.f) : 1.f, invT = wmax > 0.f ? 127.f / wmax : 0.f;
        wave_lds_sync();
#pragma unroll
        for (int h2 = 0; h2 < 2; ++h2) {
            const int gg = c + 16 * h2; const f32x4 wv = *(const f32x4*)(lw + 4 * gg);
            lwq[gg] = ((unsigned)__float2int_rn(wv[0] * invT) & 0xffu) | (((unsigned)__float2int_rn(wv[1] * invT) & 0xffu) << 8) | (((unsigned)__float2int_rn(wv[2] * invT) & 0xffu) << 16) | ((unsigned)__float2int_rn(wv[3] * invT) << 24);
        }
        wave_lds_sync();
        int acc[64];
#pragma unroll
        for (int i = 0; i < 64; ++i) acc[i] = 0;
        pass2_half<0>(TV, myi, lwq, c, acc);
        pass2_half<1>(TV, myi, lwq, c, acc);
        const int b = tkn >= SEQ ? 1 : 0;
        float* hr = p.out + (size_t)tkn * D + 16 * c;
        const float* g2p = mod + b * 6144 + 5120 + 16 * c;
        float y[64]; float ss = 0.f;
#pragma unroll
        for (int q = 0; q < 16; ++q) {
            const int eo = 256 * (q >> 2) + 4 * (q & 3);
            const float4 hv = *(const float4*)(hr + eo); const float4 g2 = *(const float4*)(g2p + eo);
            y[4 * q] = hv.x + g2.x * (T * (float)acc[4 * q]); y[4 * q + 1] = hv.y + g2.y * (T * (float)acc[4 * q + 1]);
            y[4 * q + 2] = hv.z + g2.z * (T * (float)acc[4 * q + 2]); y[4 * q + 3] = hv.w + g2.w * (T * (float)acc[4 * q + 3]);
            ss += y[4 * q] * y[4 * q] + y[4 * q + 1] * y[4 * q + 1] + y[4 * q + 2] * y[4 * q + 2] + y[4 * q + 3] * y[4 * q + 3];
        }
        ss = dpp_row_sum(ss);
        const float rstd = rsqrtf(ss * (1.f / 1024.f) + 1e-6f);
        float4 nwv[16];
#pragma unroll
        for (int q = 0; q < 16; ++q) nwv[q] = *(const float4*)(p.normf_w + 16 * c + 256 * (q >> 2) + 4 * (q & 3));
        if (!dry || rstd == 123.456f)
#pragma unroll
        for (int q = 0; q < 16; ++q) {
            const int eo = 256 * (q >> 2) + 4 * (q & 3);
            const float4 nw = nwv[q];
            float4 o; o.x = y[4 * q] * rstd * nw.x; o.y = y[4 * q + 1] * rstd * nw.y; o.z = y[4 * q + 2] * rstd * nw.z; o.w = y[4 * q + 3] * rstd * nw.w;
            *(float4*)(hr + eo) = o;
        }
        wave_lds_sync();
    }
}

#define LAS __attribute__((address_space(3)))
#define XB_TMO      128
#define XB_XCNT(j)  (256  + 64 * (j))
#define XB_XSUB(j)  (1280 + 64 * (j))
#define XB_XGEN(j)  (2304 + 64 * (j))
#define XB_TOP      3328
#define XB_TOPGEN   3392
#define XCD_BAR_WORDS 3456
#define XB_SPIN_CAP (1u << 18)

__device__ __forceinline__ unsigned xb_ld(unsigned* p)              { return __hip_atomic_load(p, __ATOMIC_RELAXED, __HIP_MEMORY_SCOPE_AGENT); }
__device__ __forceinline__ unsigned xb_add(unsigned* p, unsigned v) { return __hip_atomic_fetch_add(p, v, __ATOMIC_RELAXED, __HIP_MEMORY_SCOPE_AGENT); }
__device__ __forceinline__ unsigned xb_xcc_id() { return (unsigned)__builtin_amdgcn_s_getreg((3 << 11) | 20) & 0xFu; }
#define XB_SPIN(cond, bar) do { unsigned _sp = 0; while (cond) { __builtin_amdgcn_s_sleep(1); \
    if ((++_sp & 255u) == 0u) { if (xb_ld(&(bar)[XB_TMO])) break; if (_sp > XB_SPIN_CAP) { atomicAdd(&(bar)[XB_TMO], 1u); break; } } } } while (0)

struct XcdBarrier {
    unsigned* bar; unsigned x;
    volatile LAS unsigned* st;
};

__device__ __forceinline__ XcdBarrier xcd_barrier_post(unsigned* bar, volatile LAS unsigned* st) {
    XcdBarrier b; b.bar = bar; b.x = xb_xcc_id(); b.st = st;
    if (threadIdx.x == 0) (void)xb_add(&bar[XB_XCNT(b.x)], 1u);
    return b;
}
__device__ __forceinline__ void xcd_barrier_complete(unsigned* bar, unsigned x, unsigned& nloc, unsigned& nx) {
    const unsigned G = gridDim.x * gridDim.y * gridDim.z;
    unsigned sum, cnt, mine, sp = 0u;
    for (;;) {
        sum = 0u; cnt = 0u; mine = 0u;
#pragma unroll
        for (unsigned j = 0; j < 16; ++j) { const unsigned c = xb_ld(&bar[XB_XCNT(j)]); sum += c; cnt += (c > 0u) ? 1u : 0u; mine = (j == x) ? c : mine; }
        if (sum == G) break;
        __builtin_amdgcn_s_sleep(1);
        if ((++sp & 255u) == 0u) { if (xb_ld(&bar[XB_TMO])) break; if (sp > XB_SPIN_CAP) { atomicAdd(&bar[XB_TMO], 1u); break; } }
    }
    nloc = mine > 0u ? mine : 1u; nx = cnt > 0u ? cnt : 1u;
}

__device__ __forceinline__ void xcd_barrier(const XcdBarrier& b) {
    asm volatile("s_waitcnt vmcnt(0)" ::: "memory");
    __syncthreads();
    if (threadIdx.x == 0) {
        unsigned* bar = b.bar;
        __builtin_amdgcn_s_waitcnt(0);
        unsigned nloc = b.st[0], nx = b.st[1];
        if (nloc == 0u) { xcd_barrier_complete(bar, b.x, nloc, nx); b.st[0] = nloc; b.st[1] = nx; }
        const unsigned old = xb_add(&bar[XB_XSUB(b.x)], 1u);
        const unsigned gen = old / nloc;
        if (old + 1u == (gen + 1u) * nloc) {
            __builtin_amdgcn_fence(__ATOMIC_RELEASE, "agent");
            asm volatile("s_waitcnt vmcnt(0)" ::: "memory");
            const unsigned og = xb_add(&bar[XB_TOP], 1u);
            const unsigned tg = og / nx;
            if (og + 1u == (tg + 1u) * nx) xb_add(&bar[XB_TOPGEN], 1u);
            else XB_SPIN(xb_ld(&bar[XB_TOPGEN]) == tg, bar);
            __builtin_amdgcn_fence(__ATOMIC_ACQUIRE, "agent");
            xb_add(&bar[XB_XGEN(b.x)], 1u);
            asm volatile("s_waitcnt vmcnt(0)" ::: "memory");
        } else {
            XB_SPIN(xb_ld(&bar[XB_XGEN(b.x)]) == gen, bar);
            __builtin_amdgcn_fence(__ATOMIC_ACQUIRE, "agent");
            asm volatile("s_waitcnt vmcnt(0)" ::: "memory");
        }
    }
    __syncthreads();
}

namespace cg = cooperative_groups;
constexpr int LDS_BYTES = 151552;
constexpr int CW_RANK = XCD_BAR_WORDS;

constexpr int LDS_TOTAL = LDS_BYTES + 64;

__global__ void __launch_bounds__(512) k_mega(Params p) {
    extern __shared__ __attribute__((aligned(16))) char lds[];
    const int vb = blockIdx.x, nvb = gridDim.x;
    volatile LAS unsigned* bst = (volatile LAS unsigned*)((LAS char*)lds + LDS_BYTES);
    if (threadIdx.x < 16) bst[threadIdx.x] = 0u;
    __syncthreads();
    XcdBarrier bar = xcd_barrier_post((unsigned*)p.ws, bst);
    if (threadIdx.x == 0) bst[2] = xb_add((unsigned*)p.ws + CW_RANK + 64 * bar.x, 1u);
#define GRID_BAR() xcd_barrier(bar)
    stage_prep(p, lds, vb, nvb);        GRID_BAR();
    stage_norm1(p, lds, vb, nvb);       GRID_BAR();
    stage_gemm_in(p, lds, vb, nvb);     GRID_BAR();
    stage_attn(p, lds, vb, nvb);
    stage_mstate(p, lds, vb, nvb);      GRID_BAR();
    stage_mscan(p, lds, vb, nvb);       GRID_BAR();
    stage_mout(p, lds, vb, nvb);        GRID_BAR();
    stage_gemm_merge(p, lds, vb, nvb);  GRID_BAR();
    stage_gemm_out(p, lds, vb, nvb);    GRID_BAR();
    stage_norm2(p, lds, vb, nvb);       GRID_BAR();
    stage_gemm_q(p, lds, vb, nvb);      GRID_BAR();
    stage_q_topk(p, lds, vb, nvb);      GRID_BAR();
    if (threadIdx.x == 0) { unsigned base = 0u; for (unsigned j = 0; j < bar.x; ++j) base += xb_ld((unsigned*)p.ws + XB_XCNT(j)); bst[3] = base + bst[2]; }
    __syncthreads();
    const int slot = (int)bst[3];
#ifdef XPG
    stage_peer_gather(p, lds, slot < nvb ? slot : vb, nvb, p.ws != nullptr, XPG == 1 ? 0x3fff : 0x3e1f);
#endif
    stage_peer_gather(p, lds, slot < nvb ? slot : vb, nvb);
}

extern "C" void kernel_launch(void* const* d_in, const int* in_sizes, int n_in, void* d_out, int out_size, void* d_ws, size_t ws_size, hipStream_t stream) {
    if (n_in != 20 || ws_size < WS_END) { fprintf(stderr, "kernel_launch: unexpected n_in %d or ws_size %zu\n", n_in, ws_size); return; }
    static int grid_blocks = 0;
    if (!grid_blocks) {
        int dev = 0, cus = 0, per_cu = 0;
        (void)hipGetDevice(&dev);
        (void)hipDeviceGetAttribute(&cus, hipDeviceAttributeMultiprocessorCount, dev);
        (void)hipFuncSetAttribute((const void*)k_mega, hipFuncAttributeMaxDynamicSharedMemorySize, LDS_TOTAL);
        (void)hipOccupancyMaxActiveBlocksPerMultiprocessor(&per_cu, (const void*)k_mega, 512, LDS_TOTAL);
        if (per_cu < 1) { fprintf(stderr, "kernel_launch: occupancy query says %d blocks per CU\n", per_cu); per_cu = 1; }
        grid_blocks = cus * 1;
    }
    Params p{};
    p.x = (const float*)d_in[0]; p.c = (const float*)d_in[1]; p.w_ada = (const float*)d_in[2]; p.b_ada = (const float*)d_in[3]; p.norm1_w = (const float*)d_in[4];
    p.w_in = (const float*)d_in[5]; p.conv_w = (const float*)d_in[6]; p.sinks = (const float*)d_in[7]; p.i_bias = (const float*)d_in[8]; p.f_bias = (const float*)d_in[9];
    p.mnorm_w = (const float*)d_in[10]; p.w_a = (const float*)d_in[11]; p.w_b = (const float*)d_in[12]; p.w_out = (const float*)d_in[13]; p.norm2_w = (const float*)d_in[14];
    p.w_q = (const float*)d_in[15]; p.sub_keys = (const float*)d_in[16]; p.peer_u = (const float*)d_in[17]; p.peer_v = (const float*)d_in[18]; p.normf_w = (const float*)d_in[19];
    p.out = (float*)d_out; p.ws = (unsigned char*)d_ws;
    (void)hipMemsetAsync(d_ws, 0, 32768, stream);
    void* args[] = {&p};
    hipError_t e = hipLaunchCooperativeKernel((const void*)k_mega, dim3(grid_blocks), dim3(512), args, LDS_TOTAL, stream);
    if (e != hipSuccess) fprintf(stderr, "cooperative launch failed: %s (grid %d)\n", hipGetErrorString(e), grid_blocks);
}
```

```cpp
#include <hip/hip_runtime.h>
#include <hip/hip_cooperative_groups.h>
#include <stdint.h>
#include <stdio.h>

#define DEV __device__ __forceinline__
typedef unsigned short bf16_t;
typedef short bf16x8 __attribute__((ext_vector_type(8)));
typedef float f32x4 __attribute__((ext_vector_type(4)));
typedef unsigned u32x4 __attribute__((ext_vector_type(4)));
typedef unsigned u32x2 __attribute__((ext_vector_type(2)));

constexpr int BATCH = 2, SEQ = 16384, M = BATCH * SEQ, D = 1024;
constexpr int NTH = 512, NW = 8;
constexpr int LPA = 768, LPM = 2048, LPG = 2048;

struct Params {
    const float *x, *c, *w_ada, *b_ada, *norm1_w, *w_in, *conv_w, *sinks, *i_bias, *f_bias, *mnorm_w, *w_a, *w_b, *w_out, *norm2_w, *w_q, *sub_keys, *peer_u, *peer_v, *normf_w;
    float* out; unsigned char* ws;
};

constexpr size_t MiB = 1u << 20;
constexpr size_t WS_MOD = 1 * MiB;
constexpr size_t WS_IPRE = 2 * MiB;
constexpr size_t WS_FPRE = 2 * MiB + 512 * 1024;
constexpr size_t WS_CHG = 3 * MiB;
constexpr size_t WS_NLOC = 4 * MiB;
constexpr size_t WS_NST = 4 * MiB + 512 * 1024;
constexpr size_t WS_ROPE = 5 * MiB;
constexpr size_t WS_WIN = 10 * MiB;
constexpr size_t WS_WA = 20 * MiB;
constexpr size_t WS_WB = 21 * MiB;
constexpr size_t WS_WOUT = 22 * MiB;
constexpr size_t WS_WQ = 24 * MiB;
constexpr size_t WS_SK = 28 * MiB;
constexpr size_t WS_ISU = 29 * MiB;
constexpr size_t WS_ISV = 29 * MiB + 65536;
constexpr size_t WS_TU = 32 * MiB;
constexpr size_t WS_TV = 48 * MiB;
constexpr size_t WS_UB = 96 * MiB;
constexpr size_t WS_PA = 160 * MiB;
constexpr size_t WS_PM = 208 * MiB;
constexpr size_t WS_PG = 336 * MiB;
constexpr size_t WS_CST = 464 * MiB;
constexpr size_t WS_AT = 64 * MiB;
constexpr size_t WS_ML = 96 * MiB;
constexpr size_t WS_MG = 208 * MiB;
constexpr size_t WS_END = 496 * MiB;

DEV unsigned f2bf(float f) { unsigned u = __float_as_uint(f); return (u + 0x7fffu + ((u >> 16) & 1u)) >> 16; }
DEV unsigned pk2(float lo, float hi) { return f2bf(lo) | (f2bf(hi) << 16); }
DEV float bflo(unsigned u) { return __uint_as_float(u << 16); }
DEV float bfhi(unsigned u) { return __uint_as_float(u & 0xffff0000u); }
DEV float bf2f(bf16_t h) { return __uint_as_float(((unsigned)h) << 16); }
DEV float wave_sum(float v) {
#pragma unroll
    for (int o = 32; o > 0; o >>= 1) v += __shfl_xor(v, o);
    return v;
}
DEV float wave_max(float v) {
#pragma unroll
    for (int o = 32; o > 0; o >>= 1) v = fmaxf(v, __shfl_xor(v, o));
    return v;
}
DEV float sigmoidf_(float v) { return __builtin_amdgcn_rcpf(1.f + __expf(-v)); }
DEV f32x4 mfma16(bf16x8 a, bf16x8 b, f32x4 c) { return __builtin_amdgcn_mfma_f32_16x16x32_bf16(a, b, c, 0, 0, 0); }
DEV void wave_lds_sync() { __builtin_amdgcn_fence(__ATOMIC_ACQ_REL, "wavefront"); __builtin_amdgcn_wave_barrier(); }

DEV void transpose_item(const float* W, int ldw, int k0, int nsrc0, bf16_t* WT, int ldt, int ndst0, float* scr, int lane, int kdst_off = 0) {
#pragma unroll 8
    for (int i = 0; i < 32; ++i) { const int kk = 2 * i + (lane >> 5); scr[kk * 33 + (lane & 31)] = W[(size_t)(k0 + kk) * ldw + nsrc0 + (lane & 31)]; }
    wave_lds_sync();
    const int c = lane & 7;
#pragma unroll
    for (int j = 0; j < 4; ++j) {
        const int n = (lane >> 3) + 8 * j; const float* s = scr + (8 * c) * 33 + n;
        u32x4 o; o.x = pk2(s[0 * 33], s[1 * 33]); o.y = pk2(s[2 * 33], s[3 * 33]); o.z = pk2(s[4 * 33], s[5 * 33]); o.w = pk2(s[6 * 33], s[7 * 33]);
        *(u32x4*)(WT + (size_t)(ndst0 + n) * ldt + k0 + kdst_off + 8 * c) = o;
    }
    wave_lds_sync();
}

DEV void stage_prep(const Params& p, char* lds, int vb, int nvb) {
    const int tid = threadIdx.x, lane = tid & 63, wave = __builtin_amdgcn_readfirstlane(tid >> 6);
    float* mod = (float*)(p.ws + WS_MOD);
    float* s_act = (float*)lds;
    float* s_red = (float*)(lds + 8192);
    for (int i = tid; i < 2048; i += NTH) { const float v = p.c[i]; s_act[i] = v / (1.f + expf(-v)); }
    __syncthreads();
    for (int item = vb; item < 192; item += nvb) {
        const int kg = tid >> 5, cl = tid & 31, col = item * 32 + cl;
        float s0 = 0.f, s1 = 0.f;
        for (int k = kg; k < 1024; k += 16) { const float w = p.w_ada[(size_t)k * 6144 + col]; s0 += s_act[k] * w; s1 += s_act[1024 + k] * w; }
        s_red[(kg * 32 + cl) * 2] = s0; s_red[(kg * 32 + cl) * 2 + 1] = s1;
        __syncthreads();
        if (tid < 64) { const int b = tid >> 5, c2 = tid & 31; float s = 0.f; for (int g = 0; g < 16; ++g) s += s_red[(g * 32 + c2) * 2 + b]; mod[b * 6144 + item * 32 + c2] = s + p.b_ada[item * 32 + c2]; }
        __syncthreads();
    }
    float* scr = (float*)(lds + 16384 + wave * 8448);
    const int gw = vb * NW + wave, ngw = nvb * NW;
    bf16_t* Wt_in = (bf16_t*)(p.ws + WS_WIN); bf16_t* Wt_a = (bf16_t*)(p.ws + WS_WA); bf16_t* Wt_b = (bf16_t*)(p.ws + WS_WB);
    bf16_t* Wt_out = (bf16_t*)(p.ws + WS_WOUT); bf16_t* Wt_q = (bf16_t*)(p.ws + WS_WQ);
    for (int it = gw; it < 3456; it += ngw) {
        int r = it;
        if (r < 2432) { const int kb = r / 152, nb = r % 152; transpose_item(p.w_in, 4872, kb * 64, nb * 32 + (nb >= 88 ? 8 : 0), Wt_in, 1024, nb * 32, scr, lane); continue; } r -= 2432;
        if (r < 256) { const int kb = r / 32, nb = r % 32; transpose_item(p.w_a, 1024, kb * 64, nb * 32, Wt_a, 1024, nb * 32, scr, lane, 0); continue; } r -= 256;
        if (r < 256) { const int kb = r / 32, nb = r % 32; transpose_item(p.w_b, 1024, kb * 64, nb * 32, Wt_a, 1024, nb * 32, scr, lane, 512); continue; } r -= 256;
        { const int kb = r / 32, nb = r % 32; transpose_item(p.w_out, 1024, kb * 64, nb * 32, Wt_out, 1024, nb * 32, scr, lane); }
    }
    {
        float* WL = (float*)lds;
        float* KL = (float*)(lds + 33792);
        for (int item = vb; item < 256; item += nvb) {
            const int hp = item >> 4, k0 = (item & 15) * 64, pidx = hp & 1;
            __syncthreads();
            for (int i = tid; i < 64 * 32; i += NTH) { const int kk = i >> 5, d4 = i & 31; *(float4*)(WL + kk * 132 + 4 * d4) = *(const float4*)(p.w_q + (size_t)(k0 + kk) * 2048 + hp * 128 + 4 * d4); }
            for (int i = tid; i < 128 * 32; i += NTH) ((float4*)KL)[i] = ((const float4*)(p.sub_keys + (size_t)pidx * 16384))[i];
            __syncthreads();
            const int kk = tid & 63, n0 = (tid >> 6) * 16;
            float acc[16];
#pragma unroll
            for (int j = 0; j < 16; ++j) acc[j] = 0.f;
            for (int d4 = 0; d4 < 32; ++d4) {
                const float4 w = *(const float4*)(WL + kk * 132 + 4 * d4);
#pragma unroll
                for (int j = 0; j < 16; ++j) { const float4 kv = *(const float4*)(KL + (n0 + j) * 128 + 4 * d4); acc[j] += w.x * kv.x + w.y * kv.y + w.z * kv.z + w.w * kv.w; }
            }
#pragma unroll
            for (int j = 0; j < 16; ++j) Wt_q[(size_t)(hp * 128 + n0 + j) * 1024 + k0 + kk] = (bf16_t)f2bf(acc[j]);
        }
        __syncthreads();
    }
    const size_t gt = (size_t)vb * NTH + tid, ngt = (size_t)nvb * NTH;
    for (int rowb = gw; rowb < 32768; rowb += 4 * ngw) {
        float4 aa[4][4];
#pragma unroll
        for (int rr = 0; rr < 4; ++rr) { const int row = rowb + rr * ngw < 32768 ? rowb + rr * ngw : rowb; const float4* src = (const float4*)((row >= 16384 ? p.peer_v : p.peer_u) + (size_t)(row & 16383) * D) + lane;
#pragma unroll
            for (int i = 0; i < 4; ++i) aa[rr][i] = src[64 * i]; }
#pragma unroll
        for (int rr = 0; rr < 4; ++rr) {
            const int row = rowb + rr * ngw;
            if (row < 32768) {
                const bool isv = row >= 16384; const int r = row & 16383;
                float mx = 0.f;
#pragma unroll
                for (int i = 0; i < 4; ++i) mx = fmaxf(mx, fmaxf(fmaxf(fabsf(aa[rr][i].x), fabsf(aa[rr][i].y)), fmaxf(fabsf(aa[rr][i].z), fabsf(aa[rr][i].w))));
                mx = wave_max(mx);
                const float inv = mx > 0.f ? 127.f / mx : 0.f, sc = mx > 0.f ? mx * (1.f / 127.f) : 1.f;
                unsigned* dst = (unsigned*)(p.ws + (isv ? WS_TV : WS_TU) + (size_t)r * 1024) + lane;
#pragma unroll
                for (int i = 0; i < 4; ++i) dst[64 * i] = ((unsigned)__float2int_rn(aa[rr][i].x * inv) & 0xffu) | (((unsigned)__float2int_rn(aa[rr][i].y * inv) & 0xffu) << 8) | (((unsigned)__float2int_rn(aa[rr][i].z * inv) & 0xffu) << 16) | ((unsigned)__float2int_rn(aa[rr][i].w * inv) << 24);
                if (lane == 0) ((float*)(p.ws + (isv ? WS_ISV : WS_ISU)))[r] = sc;
            }
        }
    }
    for (size_t g = gt; g < 4096; g += ngt) {
        const float4 a = ((const float4*)p.sub_keys)[2 * g], b = ((const float4*)p.sub_keys)[2 * g + 1];
        u32x4 w; w.x = pk2(a.x, a.y); w.y = pk2(a.z, a.w); w.z = pk2(b.x, b.y); w.w = pk2(b.z, b.w);
        ((u32x4*)(p.ws + WS_SK))[g] = w;
    }
    float2* rope = (float2*)(p.ws + WS_ROPE);
    for (size_t e = gt; e < 16384 * 32; e += ngt) {
        const int pos = (int)(e >> 5), i = (int)(e & 31);
        const float inv = (float)exp2(-(double)i * (13.287712379549449 / 32.0));
        const float ang = (float)pos * inv;
        const double a = (double)ang; const double n = rint(a * 0.15915494309189535); const double r = a - n * 6.283185307179586;
        float s, c; sincosf((float)r, &s, &c);
        rope[e] = make_float2(c, s);
    }
}

DEV void stage_norm1(const Params& p, char* lds, int vb, int nvb) {
    const int tid = threadIdx.x, lane = tid & 63, wave = __builtin_amdgcn_readfirstlane(tid >> 6);
    float* wg = (float*)lds;
    for (int i = tid; i < 8192; i += NTH) { const int cc = i >> 10, k = i & 1023; wg[i] = p.w_in[(size_t)k * 4872 + 2816 + cc]; }
    __syncthreads();
    const float* mod = (const float*)(p.ws + WS_MOD);
    bf16_t* ub = (bf16_t*)(p.ws + WS_UB);
    float* ipre = (float*)(p.ws + WS_IPRE); float* fpre = (float*)(p.ws + WS_FPRE);
    const int rstride = nvb * NW;
    for (int mb = vb * NW + wave; mb < M; mb += 2 * rstride) {
        float4 vv[2][4];
#pragma unroll
        for (int rr = 0; rr < 2; ++rr) { const int mr = mb + rr * rstride < M ? mb + rr * rstride : mb; const float4* xr = (const float4*)(p.x + (size_t)mr * D);
#pragma unroll
            for (int j = 0; j < 4; ++j) vv[rr][j] = xr[lane + 64 * j]; }
#pragma unroll
        for (int rr = 0; rr < 2; ++rr) {
        const int m = mb + rr * rstride;
        if (m < M) {
        const int b = m >= SEQ ? 1 : 0;
        float4 v[4]; float ss = 0.f;
#pragma unroll
        for (int j = 0; j < 4; ++j) { v[j] = vv[rr][j]; ss += v[j].x * v[j].x + v[j].y * v[j].y + v[j].z * v[j].z + v[j].w * v[j].w; }
        ss = wave_sum(ss);
        const float rstd = rsqrtf(ss * (1.f / 1024.f) + 1e-6f);
        float ga[8];
#pragma unroll
        for (int cc = 0; cc < 8; ++cc) ga[cc] = 0.f;
#pragma unroll
        for (int j = 0; j < 4; ++j) {
            const int col = 4 * (lane + 64 * j);
            const float4 w1 = *(const float4*)(p.norm1_w + col), sc = *(const float4*)(mod + b * 6144 + 1024 + col), sh = *(const float4*)(mod + b * 6144 + col);
            float4 u;
            u.x = v[j].x * rstd * w1.x * (1.f + sc.x) + sh.x; u.y = v[j].y * rstd * w1.y * (1.f + sc.y) + sh.y;
            u.z = v[j].z * rstd * w1.z * (1.f + sc.z) + sh.z; u.w = v[j].w * rstd * w1.w * (1.f + sc.w) + sh.w;
            u32x2 o; o.x = pk2(u.x, u.y); o.y = pk2(u.z, u.w);
            *(u32x2*)(ub + (size_t)m * D + col) = o;
#pragma unroll
            for (int cc = 0; cc < 8; ++cc) { const float4 g = *(const float4*)(wg + cc * 1024 + col); ga[cc] += u.x * g.x + u.y * g.y + u.z * g.z + u.w * g.w; }
        }
        {
            const bool h32 = (lane & 32) != 0, h16 = (lane & 16) != 0, h8 = (lane & 8) != 0;
            float k4[4], k2[2];
#pragma unroll
            for (int i = 0; i < 4; ++i) k4[i] = (h32 ? ga[4 + i] : ga[i]) + __shfl_xor(h32 ? ga[i] : ga[4 + i], 32);
#pragma unroll
            for (int i = 0; i < 2; ++i) k2[i] = (h16 ? k4[2 + i] : k4[i]) + __shfl_xor(h16 ? k4[i] : k4[2 + i], 16);
            float k1 = (h8 ? k2[1] : k2[0]) + __shfl_xor(h8 ? k2[0] : k2[1], 8);
            k1 += __shfl_xor(k1, 4); k1 += __shfl_xor(k1, 2); k1 += __shfl_xor(k1, 1);
            const int cc = (lane >> 3) & 7;
            if ((lane & 7) == 0) { if (cc < 4) ipre[(size_t)m * 4 + cc] = k1 + p.i_bias[cc]; else fpre[(size_t)m * 4 + cc - 4] = k1 + p.f_bias[cc - 4]; }
        }
        }
        }
    }
}

namespace pg8 {
#define PG8_LAS __attribute__((address_space(3)))
typedef unsigned short bf16_t;
typedef short bf16x8 __attribute__((ext_vector_type(8)));
typedef float f32x4 __attribute__((ext_vector_type(4)));
typedef unsigned u32x4 __attribute__((ext_vector_type(4)));
constexpr int BM = 256, BK = 64, HALF = 128, HTB = HALF * BK * 2  , STAGE_BYTES = 8 * HTB, NXCD = 8, WGM = 8;

__host__ __device__ __forceinline__ int lds_byte(int r, int c) { const int st = (r >> 4) * 2 + (c >> 5), rr = r & 15, cc = c & 31, ob = rr * 64 + cc * 2; return st * 1024 + (ob ^ (((ob >> 9) & 1) << 5)); }
__host__ __device__ __forceinline__ void stage_rc(int b, int& R, int& C) { const int st = b / 1024, sb = b % 1024, swz = sb ^ (((sb >> 9) & 1) << 5); R = (st >> 1) * 16 + swz / 64; C = (st & 1) * 32 + (swz % 64) / 2; }
__host__ __device__ __forceinline__ int perm32(int rho) { const int n = rho >> 4, i = rho & 15; return 8 * (i >> 2) + 4 * n + (i & 3); }

struct Unit { int pm, pn; };
struct Gemm { const bf16_t* A; const bf16_t* Bt; int M, N, K, lda, ldb; const bf16_t* A2; };

struct StaticOrder {
    int nM, nN, nwg, G, c;
    __host__ __device__ void init(int M, int N, int G_, int c_) { nM = M / BM; nN = N / BM; nwg = nM * nN; G = G_; c = c_; }
    __host__ __device__ bool next(int i, Unit& u) const {
        const long L = (long)i * G + c; if (L >= nwg) return false;
        int wgid = (int)L; { const int q = nwg / NXCD, r = nwg % NXCD, xcd = wgid % NXCD, off = wgid / NXCD; wgid = (xcd < r ? xcd * (q + 1) : r * (q + 1) + (xcd - r) * q) + off; }
        const int nig = WGM * nN, gid = wgid / nig, fm = gid * WGM, gsz = (nM - fm) < WGM ? (nM - fm) : WGM;
        u.pm = fm + ((wgid % nig) % gsz); u.pn = (wgid % nig) / gsz; return true;
    }
    __device__ __forceinline__ void a_ready(const Unit&) const {}
    __device__ __forceinline__ void done(const Unit&) const {}
};

__device__ __forceinline__ unsigned cvt_pk_bf16(float lo, float hi) { unsigned r; asm volatile("v_cvt_pk_bf16_f32 %0, %1, %2" : "=v"(r) : "v"(lo), "v"(hi)); return r; }
__device__ __forceinline__ float sg_(float v) { return __builtin_amdgcn_rcpf(1.f + __expf(-v)); }
struct EpiIn {
    static constexpr bool PERM = true, AFTER_DRAIN = false, HAS_MID = false;
    bf16_t *PA, *PM, *PG;
    __device__ __forceinline__ void operator()(const f32x4 (&acc)[2][2][4][2], const Unit& u, int wr, int wc, int fr, int fq) const {
        const int colt = u.pn * BM; bf16_t* base; int ldc, cb;
        if (colt < 768) { base = PA; ldc = 768; cb = colt; } else if (colt < 2816) { base = PM; ldc = 2048; cb = colt - 768; } else { base = PG; ldc = 2048; cb = colt - 2816; }
        const int row0 = u.pm * BM + wr * 64 + fr, col0 = cb + wc * 32 + 8 * fq;
#pragma unroll
        for (int ai = 0; ai < 2; ++ai)
#pragma unroll
            for (int m = 0; m < 4; ++m) { bf16_t* rowp = base + (size_t)(row0 + ai * HALF + m * 16) * ldc + col0;
#pragma unroll
                for (int bj = 0; bj < 2; ++bj) { const f32x4 v0 = acc[ai][bj][m][0], v1 = acc[ai][bj][m][1];
                    u32x4 w; w.x = cvt_pk_bf16(v0[0], v0[1]); w.y = cvt_pk_bf16(v0[2], v0[3]); w.z = cvt_pk_bf16(v1[0], v1[1]); w.w = cvt_pk_bf16(v1[2], v1[3]);
                    *(u32x4*)(rowp + bj * HALF) = w; } }
    }
};
struct EpiMerge {
    static constexpr bool PERM = true, AFTER_DRAIN = false, HAS_MID = false;
    const bf16_t* G; bf16_t* MG; int second;
    __device__ __forceinline__ void operator()(const f32x4 (&acc)[2][2][4][2], const Unit& u, int wr, int wc, int fr, int fq) const {
        const int row0 = u.pm * BM + wr * 64 + fr, col0 = u.pn * BM + wc * 32 + 8 * fq;
#pragma unroll
        for (int bj = 0; bj < 2; ++bj)
#pragma unroll
        for (int ai = 0; ai < 2; ++ai) {
            const int col = col0 + bj * HALF;
            u32x4 gv[4], tv[4];
#pragma unroll
            for (int m = 0; m < 4; ++m) { const size_t row = (size_t)(row0 + ai * HALF + m * 16); gv[m] = *(const u32x4*)(G + row * 2048 + col); tv[m] = second ? *(const u32x4*)(MG + row * 1024 + col) : (u32x4){0u, 0u, 0u, 0u}; }
#pragma unroll
            for (int m = 0; m < 4; ++m) { const size_t row = (size_t)(row0 + ai * HALF + m * 16);
                const f32x4 v0 = acc[ai][bj][m][0], v1 = acc[ai][bj][m][1]; const u32x4 g = gv[m], t = tv[m];
                float r[8];
                r[0] = sg_(__uint_as_float(g.x << 16)) * v0[0] + __uint_as_float(t.x << 16); r[1] = sg_(__uint_as_float(g.x & 0xffff0000u)) * v0[1] + __uint_as_float(t.x & 0xffff0000u);
                r[2] = sg_(__uint_as_float(g.y << 16)) * v0[2] + __uint_as_float(t.y << 16); r[3] = sg_(__uint_as_float(g.y & 0xffff0000u)) * v0[3] + __uint_as_float(t.y & 0xffff0000u);
                r[4] = sg_(__uint_as_float(g.z << 16)) * v1[0] + __uint_as_float(t.z << 16); r[5] = sg_(__uint_as_float(g.z & 0xffff0000u)) * v1[1] + __uint_as_float(t.z & 0xffff0000u);
                r[6] = sg_(__uint_as_float(g.w << 16)) * v1[2] + __uint_as_float(t.w << 16); r[7] = sg_(__uint_as_float(g.w & 0xffff0000u)) * v1[3] + __uint_as_float(t.w & 0xffff0000u);
                u32x4 w; w.x = cvt_pk_bf16(r[0], r[1]); w.y = cvt_pk_bf16(r[2], r[3]); w.z = cvt_pk_bf16(r[4], r[5]); w.w = cvt_pk_bf16(r[6], r[7]);
                *(u32x4*)(MG + row * 1024 + col) = w; }
        }
    }
};
struct EpiMergeF {
    static constexpr bool PERM = true, AFTER_DRAIN = false, HAS_MID = true;
    const bf16_t* G; bf16_t* MG;
    static __device__ __forceinline__ float em_(float v) { return __expf(-fminf(fmaxf(v, -30.f), 30.f)); }
    __device__ __forceinline__ void mid(f32x4 (&acc)[2][2][4][2], const Unit& u, int wr, int wc, int fr, int fq) const {
        int row0 = u.pm * BM + wr * 64 + fr; const int col0 = u.pn * BM + wc * 32 + 8 * fq;
        asm volatile("" : "+v"(row0));
#pragma unroll
        for (int bj = 0; bj < 2; ++bj)
#pragma unroll
        for (int ai = 0; ai < 2; ++ai)
        {
            const int col = col0 + bj * HALF;
            u32x4 av[4], bv[4];
#pragma unroll
            for (int m = 0; m < 4; ++m) { const size_t row = (size_t)(row0 + ai * HALF + m * 16); av[m] = *(const u32x4*)(G + row * 2048 + col); bv[m] = *(const u32x4*)(G + row * 2048 + 1024 + col); }
#pragma unroll
            for (int m = 0; m < 4; ++m) {
                f32x4 r0, r1;
                r0[0] = (1.f + em_(__uint_as_float(bv[m][0] << 16))) * __builtin_amdgcn_rcpf(1.f + em_(__uint_as_float(av[m][0] << 16)));
                r0[1] = (1.f + em_(__uint_as_float(bv[m][0] & 0xffff0000u))) * __builtin_amdgcn_rcpf(1.f + em_(__uint_as_float(av[m][0] & 0xffff0000u)));
                r0[2] = (1.f + em_(__uint_as_float(bv[m][1] << 16))) * __builtin_amdgcn_rcpf(1.f + em_(__uint_as_float(av[m][1] << 16)));
                r0[3] = (1.f + em_(__uint_as_float(bv[m][1] & 0xffff0000u))) * __builtin_amdgcn_rcpf(1.f + em_(__uint_as_float(av[m][1] & 0xffff0000u)));
                r1[0] = (1.f + em_(__uint_as_float(bv[m][2] << 16))) * __builtin_amdgcn_rcpf(1.f + em_(__uint_as_float(av[m][2] << 16)));
                r1[1] = (1.f + em_(__uint_as_float(bv[m][2] & 0xffff0000u))) * __builtin_amdgcn_rcpf(1.f + em_(__uint_as_float(av[m][2] & 0xffff0000u)));
                r1[2] = (1.f + em_(__uint_as_float(bv[m][3] << 16))) * __builtin_amdgcn_rcpf(1.f + em_(__uint_as_float(av[m][3] << 16)));
                r1[3] = (1.f + em_(__uint_as_float(bv[m][3] & 0xffff0000u))) * __builtin_amdgcn_rcpf(1.f + em_(__uint_as_float(av[m][3] & 0xffff0000u)));
                acc[ai][bj][m][0] = acc[ai][bj][m][0] * r0; acc[ai][bj][m][1] = acc[ai][bj][m][1] * r1;
            }
            __builtin_amdgcn_sched_barrier(0);
        }
    }
    __device__ __forceinline__ void operator()(const f32x4 (&acc)[2][2][4][2], const Unit& u, int wr, int wc, int fr, int fq) const {
        const int row0 = u.pm * BM + wr * 64 + fr, col0 = u.pn * BM + wc * 32 + 8 * fq;
#pragma unroll
        for (int bj = 0; bj < 2; ++bj)
#pragma unroll
        for (int ai = 0; ai < 2; ++ai) {
            const int col = col0 + bj * HALF;
            u32x4 bv[4];
#pragma unroll
            for (int m = 0; m < 4; ++m) bv[m] = *(const u32x4*)(G + (size_t)(row0 + ai * HALF + m * 16) * 2048 + 1024 + col);
#pragma unroll
            for (int m = 0; m < 4; ++m) { const f32x4 v0 = acc[ai][bj][m][0], v1 = acc[ai][bj][m][1]; const u32x4 g = bv[m];
                float r[8];
                r[0] = v0[0] * __builtin_amdgcn_rcpf(1.f + em_(__uint_as_float(g.x << 16))); r[1] = v0[1] * __builtin_amdgcn_rcpf(1.f + em_(__uint_as_float(g.x & 0xffff0000u)));
                r[2] = v0[2] * __builtin_amdgcn_rcpf(1.f + em_(__uint_as_float(g.y << 16))); r[3] = v0[3] * __builtin_amdgcn_rcpf(1.f + em_(__uint_as_float(g.y & 0xffff0000u)));
                r[4] = v1[0] * __builtin_amdgcn_rcpf(1.f + em_(__uint_as_float(g.z << 16))); r[5] = v1[1] * __builtin_amdgcn_rcpf(1.f + em_(__uint_as_float(g.z & 0xffff0000u)));
                r[6] = v1[2] * __builtin_amdgcn_rcpf(1.f + em_(__uint_as_float(g.w << 16))); r[7] = v1[3] * __builtin_amdgcn_rcpf(1.f + em_(__uint_as_float(g.w & 0xffff0000u)));
                u32x4 w; w.x = cvt_pk_bf16(r[0], r[1]); w.y = cvt_pk_bf16(r[2], r[3]); w.z = cvt_pk_bf16(r[4], r[5]); w.w = cvt_pk_bf16(r[6], r[7]);
                *(u32x4*)(MG + (size_t)(row0 + ai * HALF + m * 16) * 1024 + col) = w; }
        }
    }
};
struct EpiF32 {
    static constexpr bool PERM = true, AFTER_DRAIN = false, HAS_MID = false;
    float* O; int ldc;
    __device__ __forceinline__ void operator()(const f32x4 (&acc)[2][2][4][2], const Unit& u, int wr, int wc, int fr, int fq) const {
        const int row0 = u.pm * BM + wr * 64 + fr, col0 = u.pn * BM + wc * 32 + 8 * fq;
#pragma unroll
        for (int ai = 0; ai < 2; ++ai)
#pragma unroll
            for (int m = 0; m < 4; ++m) { float* rowp = O + (size_t)(row0 + ai * HALF + m * 16) * ldc + col0;
#pragma unroll
                for (int bj = 0; bj < 2; ++bj) { *(f32x4*)(rowp + bj * HALF) = acc[ai][bj][m][0]; *(f32x4*)(rowp + bj * HALF + 4) = acc[ai][bj][m][1]; } }
    }
};
struct EpiOut {
    static constexpr bool PERM = true, AFTER_DRAIN = false, HAS_MID = false;
    const float* x; const float* g1; float* out; int seq;
    __device__ __forceinline__ void operator()(const f32x4 (&acc)[2][2][4][2], const Unit& u, int wr, int wc, int fr, int fq) const {
        const int row0 = u.pm * BM + wr * 64 + fr, col0 = u.pn * BM + wc * 32 + 8 * fq;
        const float* gp = g1 + (u.pm * BM >= seq ? 6144 : 0);
#pragma unroll
        for (int bj = 0; bj < 2; ++bj) { const int col = col0 + bj * HALF; const f32x4 ga = *(const f32x4*)(gp + col), gb = *(const f32x4*)(gp + col + 4);
#pragma unroll
            for (int ai = 0; ai < 2; ++ai) {
                f32x4 xa[4], xb[4];
#pragma unroll
                for (int m = 0; m < 4; ++m) { const size_t off = (size_t)(row0 + ai * HALF + m * 16) * 1024 + col; xa[m] = *(const f32x4*)(x + off); xb[m] = *(const f32x4*)(x + off + 4); }
#pragma unroll
                for (int m = 0; m < 4; ++m) { const size_t off = (size_t)(row0 + ai * HALF + m * 16) * 1024 + col;
                    *(f32x4*)(out + off) = xa[m] + ga * acc[ai][bj][m][0]; *(f32x4*)(out + off + 4) = xb[m] + gb * acc[ai][bj][m][1]; } } }
    }
};

template <class Epi, class Sched, bool ALIGN_EPI = false, bool SP2 = false>
__device__ __forceinline__ void gemm_phase(PG8_LAS unsigned char* lds, const Gemm g, const Sched& S, const Epi& E) {
    const int tid = threadIdx.x, wid = __builtin_amdgcn_readfirstlane(tid >> 6), lane = tid & 63, wr = wid >> 2, wc = wid & 3, fr = lane & 15, fq = lane >> 4;
    const int K = g.K, nt = K / BK;
    unsigned voffA[2], voffB[2];
#pragma unroll
    for (int i = 0; i < 2; ++i) { int R, C; stage_rc(tid * 16 + i * 8192, R, C); const int Rb = Epi::PERM ? ((R & ~31) + perm32(R & 31)) : R;
        voffA[i] = (unsigned)(R * g.lda + C) * 2u; voffB[i] = (unsigned)(Rb * g.ldb + C) * 2u; }
    const size_t kstep = (size_t)(BK * 2);
    const size_t hstepA = (size_t)HALF * g.lda * 2, hstepB = (size_t)HALF * g.ldb * 2;
    const size_t tstepA = 2 * hstepA, tstepB = 2 * hstepB;
    const unsigned ldsw = (unsigned)wid * 1024u;
    const int aoff = lds_byte(wr * 64 + fr, fq * 8), boff = lds_byte(wc * 32 + fr, fq * 8);
#define PG8_SA(b, h) (((b) * 2 + (h)) * HTB)
#define PG8_SB(b, h) ((4 + (b) * 2 + (h)) * HTB)
#define PG8_STAGE(bufoff, gbase, voff) do { _Pragma("unroll") for (int _i = 0; _i < 2; ++_i) \
        __builtin_amdgcn_global_load_lds((const unsigned*)((const char*)(gbase) + (voff)[_i]), (PG8_LAS unsigned*)(lds + (bufoff) + ldsw + _i * 8192), 16, 0, 0); } while (0)
#define PG8_LDA(dst, b, h) do { _Pragma("unroll") for (int m = 0; m < 4; ++m) _Pragma("unroll") for (int k = 0; k < 2; ++k) dst[m][k] = *(const PG8_LAS bf16x8*)(lds + PG8_SA(b, h) + aoff + m * 2048 + k * 1024); } while (0)
#define PG8_LDB(dst, b, h) do { _Pragma("unroll") for (int n = 0; n < 2; ++n) _Pragma("unroll") for (int k = 0; k < 2; ++k) dst[n][k] = *(const PG8_LAS bf16x8*)(lds + PG8_SB(b, h) + boff + n * 2048 + k * 1024); } while (0)
#define PG8_MMA(ai, bj, At, Bt) do { __builtin_amdgcn_s_setprio(1); _Pragma("unroll") for (int m = 0; m < 4; ++m) _Pragma("unroll") for (int n = 0; n < 2; ++n) _Pragma("unroll") for (int k = 0; k < 2; ++k) \
        acc[ai][bj][m][n] = __builtin_amdgcn_mfma_f32_16x16x32_bf16(Bt[n][k], At[m][k], acc[ai][bj][m][n], 0, 0, 0); __builtin_amdgcn_s_setprio(0); } while (0)
#define PG8_WAIT_V(n) asm volatile("s_waitcnt vmcnt(" #n ")" ::: "memory")
#define PG8_WAIT_L(n) asm volatile("s_waitcnt lgkmcnt(" #n ")" ::: "memory")
#define PG8_BAR __builtin_amdgcn_s_barrier()
#define PG8_SCHED __builtin_amdgcn_sched_barrier(0)
    Unit cur, nxt; int ui = 0;
    if (!S.next(0, cur)) return;
    f32x4 acc[2][2][4][2];
#pragma unroll
    for (int a = 0; a < 2; ++a)
#pragma unroll
        for (int b = 0; b < 2; ++b)
#pragma unroll
            for (int m = 0; m < 4; ++m)
#pragma unroll
                for (int n = 0; n < 2; ++n) acc[a][b][m][n] = (f32x4){0.f, 0.f, 0.f, 0.f};
    bf16x8 At[4][2], B0[2][2], B1[2][2];
    const char* cA = (const char*)g.A + (size_t)cur.pm * tstepA; const char* cB = (const char*)g.Bt + (size_t)cur.pn * tstepB;
    const char* cA2 = g.A2 ? (const char*)g.A2 + (size_t)cur.pm * tstepA : nullptr;
    S.a_ready(cur);
    if constexpr (SP2) {
        PG8_STAGE(PG8_SB(0, 0), cB, voffB); PG8_STAGE(PG8_SB(0, 1), cB + hstepB, voffB); PG8_STAGE(PG8_SA(0, 0), cA, voffA); PG8_STAGE(PG8_SA(0, 1), cA + hstepA, voffA);
        if (wr == 1) PG8_BAR;
        PG8_WAIT_V(2); PG8_BAR;
        PG8_STAGE(PG8_SB(1, 0), cB + kstep, voffB); PG8_STAGE(PG8_SA(1, 0), cA + kstep, voffA); PG8_STAGE(PG8_SB(1, 1), cB + hstepB + kstep, voffB);
        PG8_WAIT_V(6); PG8_BAR;
    } else {
        PG8_STAGE(PG8_SB(0, 0), cB, voffB); PG8_STAGE(PG8_SA(0, 0), cA, voffA); PG8_STAGE(PG8_SB(0, 1), cB + hstepB, voffB); PG8_STAGE(PG8_SA(0, 1), cA + hstepA, voffA);
        if (wr == 1) PG8_BAR;
        PG8_WAIT_V(4); PG8_BAR;
        PG8_STAGE(PG8_SB(1, 0), cB + kstep, voffB); PG8_STAGE(PG8_SA(1, 0), cA + kstep, voffA); PG8_STAGE(PG8_SB(1, 1), cB + hstepB + kstep, voffB);
        PG8_WAIT_V(6); PG8_BAR;
    }
    for (;;) {
        const bool has_next = S.next(ui + 1, nxt);
        const char* nA = has_next ? (const char*)g.A + (size_t)nxt.pm * tstepA : cA; const char* nB = has_next ? (const char*)g.Bt + (size_t)nxt.pn * tstepB : cB;
        const int tspan = Epi::HAS_MID ? (nt >> 1) : nt;
        for (int tb = 0; tb < nt; tb += tspan) {
        if constexpr (Epi::HAS_MID) { if (tb != 0) E.mid(acc, cur, wr, wc, fr, fq); }
        for (int t = tb; t < tb + tspan; t += 2) {
            const bool last = (t == nt - 2);
            const int hk = nt >> 1;
            const char* bA1 = (cA2 && t + 1 >= hk) ? cA2 - (size_t)hk * kstep : cA; const char* bA2 = (cA2 && t + 2 >= hk) ? cA2 - (size_t)hk * kstep : cA;
            const char* a1 = bA1 + (size_t)(t + 1) * kstep;
            const char* a2 = last ? nA : bA2 + (size_t)(t + 2) * kstep; const char* b2 = last ? nB : cB + (size_t)(t + 2) * kstep;
            const char* a3 = a2 + kstep; const char* b3 = b2 + kstep;
            if (last && has_next) S.a_ready(nxt);
            if constexpr (SP2) {
            PG8_LDB(B0, 0, 0); PG8_LDB(B1, 0, 1); PG8_SCHED; PG8_LDA(At, 0, 0); PG8_STAGE(PG8_SA(1, 1), a1 + hstepA, voffA);
            PG8_WAIT_V(8); PG8_WAIT_L(0); PG8_BAR; PG8_MMA(0, 0, At, B0); PG8_MMA(0, 1, At, B1); PG8_BAR; PG8_SCHED;
            PG8_LDA(At, 0, 1); PG8_STAGE(PG8_SB(0, 0), b2, voffB); PG8_STAGE(PG8_SB(0, 1), b2 + hstepB, voffB); PG8_STAGE(PG8_SA(0, 0), a2, voffA);
            PG8_WAIT_V(8); PG8_WAIT_L(0); PG8_BAR; PG8_MMA(1, 0, At, B0); PG8_MMA(1, 1, At, B1); PG8_BAR; PG8_SCHED;
            PG8_LDB(B0, 1, 0); PG8_LDB(B1, 1, 1); PG8_SCHED; PG8_LDA(At, 1, 0); PG8_STAGE(PG8_SA(0, 1), a2 + hstepA, voffA);
            PG8_WAIT_V(8); PG8_WAIT_L(0); PG8_BAR; PG8_MMA(0, 0, At, B0); PG8_MMA(0, 1, At, B1); PG8_BAR; PG8_SCHED;
            PG8_LDA(At, 1, 1); PG8_STAGE(PG8_SB(1, 0), b3, voffB); PG8_STAGE(PG8_SB(1, 1), b3 + hstepB, voffB); PG8_STAGE(PG8_SA(1, 0), a3, voffA);
            PG8_WAIT_V(8); PG8_WAIT_L(0); PG8_BAR; PG8_MMA(1, 0, At, B0); PG8_MMA(1, 1, At, B1); PG8_BAR; PG8_SCHED;
            } else {
            PG8_LDB(B0, 0, 0); PG8_SCHED; PG8_LDA(At, 0, 0); PG8_STAGE(PG8_SA(1, 1), a1 + hstepA, voffA);
            PG8_WAIT_L(8); PG8_BAR; PG8_WAIT_L(0); PG8_MMA(0, 0, At, B0); PG8_BAR; PG8_SCHED;
            PG8_LDB(B1, 0, 1); PG8_STAGE(PG8_SB(0, 0), b2, voffB);
            PG8_BAR; PG8_WAIT_L(0); PG8_MMA(0, 1, At, B1); PG8_BAR;
            PG8_LDA(At, 0, 1); PG8_STAGE(PG8_SA(0, 0), a2, voffA);
            PG8_BAR; PG8_WAIT_L(0); PG8_MMA(1, 0, At, B0); PG8_BAR; PG8_SCHED;
            PG8_STAGE(PG8_SB(0, 1), b2 + hstepB, voffB);
            PG8_WAIT_V(6); PG8_BAR; PG8_MMA(1, 1, At, B1); PG8_BAR;
            PG8_LDB(B0, 1, 0); PG8_SCHED; PG8_LDA(At, 1, 0); PG8_STAGE(PG8_SA(0, 1), a2 + hstepA, voffA);
            PG8_WAIT_L(8); PG8_BAR; PG8_WAIT_L(0); PG8_MMA(0, 0, At, B0); PG8_BAR; PG8_SCHED;
            PG8_LDB(B1, 1, 1); PG8_STAGE(PG8_SB(1, 0), b3, voffB);
            PG8_BAR; PG8_WAIT_L(0); PG8_MMA(0, 1, At, B1); PG8_BAR;
            PG8_LDA(At, 1, 1); PG8_STAGE(PG8_SA(1, 0), a3, voffA);
            PG8_BAR; PG8_WAIT_L(0); PG8_MMA(1, 0, At, B0); PG8_BAR; PG8_SCHED;
            PG8_STAGE(PG8_SB(1, 1), b3 + hstepB, voffB);
            PG8_WAIT_V(6); PG8_BAR; PG8_MMA(1, 1, At, B1); PG8_BAR;
            }
        }
        }
        if constexpr (ALIGN_EPI) { if (wr == 0) PG8_BAR; }
        if constexpr (!Epi::AFTER_DRAIN) { E(acc, cur, wr, wc, fr, fq); S.done(cur); }
        if (!has_next) break;
#pragma unroll
        for (int a = 0; a < 2; ++a)
#pragma unroll
            for (int b = 0; b < 2; ++b)
#pragma unroll
                for (int m = 0; m < 4; ++m)
#pragma unroll
                    for (int n = 0; n < 2; ++n) acc[a][b][m][n] = (f32x4){0.f, 0.f, 0.f, 0.f};
        cur = nxt; cA = nA; cB = nB; ++ui; cA2 = g.A2 ? (const char*)g.A2 + (size_t)cur.pm * tstepA : nullptr;
        if constexpr (ALIGN_EPI) { if (wr == 1) PG8_BAR; }
    }
    PG8_WAIT_V(0);
    if constexpr (!ALIGN_EPI) { if (wr == 0) PG8_BAR; }
    PG8_BAR;
    if constexpr (Epi::AFTER_DRAIN) { E.fused(acc, cur, wr, wc, fr, fq, lds, wid, lane); S.done(cur); }
#undef PG8_SA
#undef PG8_SB
#undef PG8_STAGE
#undef PG8_LDA
#undef PG8_LDB
#undef PG8_MMA
#undef PG8_WAIT_V
#undef PG8_WAIT_L
#undef PG8_BAR
#undef PG8_SCHED
}
}

DEV void stage_gemm_in(const Params& p, char* lds, int vb, int nvb) {
    pg8::Gemm g{(const bf16_t*)(p.ws + WS_UB), (const bf16_t*)(p.ws + WS_WIN), M, 4864, 1024, 1024, 1024};
    pg8::StaticOrder S; S.init(M, 4864, nvb, vb);
    pg8::EpiIn E{(bf16_t*)(p.ws + WS_PA), (bf16_t*)(p.ws + WS_PM), (bf16_t*)(p.ws + WS_PG)};
    pg8::gemm_phase<pg8::EpiIn, pg8::StaticOrder, true, true>((PG8_LAS unsigned char*)lds, g, S, E);
}
DEV void stage_gemm_merge(const Params& p, char* lds, int vb, int nvb) {
    pg8::Gemm g{(const bf16_t*)(p.ws + WS_AT), (const bf16_t*)(p.ws + WS_WA), M, 1024, 1024, 512, 1024, (const bf16_t*)(p.ws + WS_ML)};
    pg8::StaticOrder S; S.init(M, 1024, nvb, vb);
    pg8::EpiMergeF E{(const bf16_t*)(p.ws + WS_PG), (bf16_t*)(p.ws + WS_MG)};
    pg8::gemm_phase<pg8::EpiMergeF, pg8::StaticOrder, true, true>((PG8_LAS unsigned char*)lds, g, S, E);
}
DEV void stage_gemm_out(const Params& p, char* lds, int vb, int nvb) {
    pg8::Gemm g{(const bf16_t*)(p.ws + WS_MG), (const bf16_t*)(p.ws + WS_WOUT), M, 1024, 1024, 1024, 1024};
    pg8::StaticOrder S; S.init(M, 1024, nvb, vb);
    pg8::EpiOut E{p.x, (const float*)(p.ws + WS_MOD) + 2048, p.out, SEQ};
    pg8::gemm_phase<pg8::EpiOut, pg8::StaticOrder, true, true>((PG8_LAS unsigned char*)lds, g, S, E);
}

DEV void rope8(u32x4 x1, u32x4 x2, const float4* rp, float scale, u32x4& o1, u32x4& o2) {
#pragma unroll
    for (int w = 0; w < 4; ++w) {
        const float4 cs = rp[w];
        const float a0 = bflo(x1[w]), a1 = bfhi(x1[w]), b0 = bflo(x2[w]), b1 = bfhi(x2[w]);
        o1[w] = pk2((a0 * cs.x - b0 * cs.y) * scale, (a1 * cs.z - b1 * cs.w) * scale);
        o2[w] = pk2((b0 * cs.x + a0 * cs.y) * scale, (b1 * cs.z + a1 * cs.w) * scale);
    }
}

DEV void stage_attn(const Params& p, char* lds, int vb, int nvb) {
    const int tid = threadIdx.x, lane = tid & 63, wave = __builtin_amdgcn_readfirstlane(tid >> 6), fr = lane & 15, fq = lane >> 4;
    char* Ks = lds;
    char* VT = lds + 32768;
    char* Qs = lds + 70656;
    char* Ps = lds + 87040;
    bf16_t* PA = (bf16_t*)(p.ws + WS_PA);
    const float2* rope = (const float2*)(p.ws + WS_ROPE);
    for (int unit = vb; unit < 512; unit += nvb) {
        const int kvh = unit & 1, n = (unit >> 1) & 127, b = unit >> 8;
        __syncthreads();
        for (int task = tid; task < 1024; task += NTH) {
            const int ki = task >> 2, cp = task & 3, pos = 128 * (n - 1) + ki;
            u32x4 o1, o2;
            {
                const int pc = pos < 0 ? 0 : pos;
                const bf16_t* src = PA + (size_t)(b * SEQ + pc) * LPA + 512 + kvh * 64 + cp * 8;
                const u32x4 x1 = *(const u32x4*)src, x2 = *(const u32x4*)(src + 32);
                rope8(x1, x2, (const float4*)(rope + (size_t)pc * 32 + cp * 8), 1.0f, o1, o2);
                if (pos < 0) { o1 = (u32x4){0u, 0u, 0u, 0u}; o2 = o1; }
            }
            const int sw = ki & 7;
            *(u32x4*)(Ks + ki * 128 + ((cp ^ sw) << 4)) = o1;
            *(u32x4*)(Ks + ki * 128 + (((cp + 4) ^ sw) << 4)) = o2;
        }
        for (int task = tid; task < 2048; task += NTH) {
            const int ki = task >> 3, c = task & 7, pos = 128 * (n - 1) + ki;
            u32x4 x = *(const u32x4*)(PA + (size_t)(b * SEQ + (pos < 0 ? 0 : pos)) * LPA + 640 + kvh * 64 + c * 8);
            if (pos < 0) x = (u32x4){0u, 0u, 0u, 0u};
#pragma unroll
            for (int e = 0; e < 8; ++e) *(bf16_t*)(VT + (c * 8 + e) * 592 + ki * 2) = (bf16_t)((e & 1) ? (x[e >> 1] >> 16) : (x[e >> 1] & 0xffffu));
        }
        for (int i = tid; i < 64 * 40; i += NTH) { const int d = i / 40, kk = 256 + i % 40; *(bf16_t*)(VT + d * 592 + kk * 2) = 0; }
        for (int i = tid; i < 2048; i += NTH) { const int w = i >> 8, r = (i >> 4) & 15, kk = 144 + (i & 15); *(bf16_t*)(Ps + w * 5376 + r * 336 + kk * 2) = 0; }
        for (int j = 0; j < 4; ++j) {
            const int hq = kvh * 4 + j;
            {
                const int qi = tid >> 2, cp = tid & 3, pos = 128 * n + qi;
                const bf16_t* src = PA + (size_t)(b * SEQ + pos) * LPA + hq * 64 + cp * 8;
                const u32x4 x1 = *(const u32x4*)src, x2 = *(const u32x4*)(src + 32);
                u32x4 o1, o2;
                rope8(x1, x2, (const float4*)(rope + (size_t)pos * 32 + cp * 8), 0.125f, o1, o2);
                const int sw = qi & 7;
                *(u32x4*)(Qs + qi * 128 + ((cp ^ sw) << 4)) = o1;
                *(u32x4*)(Qs + qi * 128 + (((cp + 4) ^ sw) << 4)) = o2;
            }
            __syncthreads();
            f32x4 s[9];
            const int sw = fr & 7;
            bf16x8 qf[2];
#pragma unroll
            for (int ks = 0; ks < 2; ++ks) qf[ks] = *(const bf16x8*)(Qs + (16 * wave + fr) * 128 + (((fq + 4 * ks) ^ sw) << 4));
#pragma unroll
            for (int t = 0; t < 9; ++t) {
                s[t] = (f32x4){0.f, 0.f, 0.f, 0.f};
#pragma unroll
                for (int ks = 0; ks < 2; ++ks) { const bf16x8 kf = *(const bf16x8*)(Ks + (16 * (wave + t) + fr) * 128 + (((fq + 4 * ks) ^ sw) << 4)); s[t] = mfma16(kf, qf[ks], s[t]); }
            }
            const float sink = p.sinks[hq];
            float mx = sink;
#pragma unroll
            for (int t = 0; t < 9; ++t)
#pragma unroll
                for (int r = 0; r < 4; ++r) {
                    const int dd = 16 * t + 4 * fq + r - fr, ki = 16 * (wave + t) + 4 * fq + r;
                    const bool ok = (dd >= 1) && (dd <= 128) && (n > 0 || ki >= 128);
                    const float v = ok ? s[t][r] : -INFINITY;
                    s[t][r] = v; mx = fmaxf(mx, v);
                }
            mx = fmaxf(mx, __shfl_xor(mx, 16)); mx = fmaxf(mx, __shfl_xor(mx, 32));
            float sum = 0.f;
#pragma unroll
            for (int t = 0; t < 9; ++t)
#pragma unroll
                for (int r = 0; r < 4; ++r) { const float pv = __expf(s[t][r] - mx); s[t][r] = pv; sum += pv; }
            sum += __shfl_xor(sum, 16); sum += __shfl_xor(sum, 32);
            const float inv = 1.f / (sum + __expf(sink - mx));
            char* Pw = Ps + wave * 5376 + fr * 336;
#pragma unroll
            for (int t = 0; t < 9; ++t) { u32x2 o; o.x = pk2(s[t][0], s[t][1]); o.y = pk2(s[t][2], s[t][3]); *(u32x2*)(Pw + (16 * t + 4 * fq) * 2) = o; }
            __syncthreads();
            f32x4 o[4];
#pragma unroll
            for (int di = 0; di < 4; ++di) o[di] = (f32x4){0.f, 0.f, 0.f, 0.f};
#pragma unroll
            for (int ks = 0; ks < 5; ++ks) {
                const bf16x8 pf = *(const bf16x8*)(Pw + (32 * ks + 8 * fq) * 2);
#pragma unroll
                for (int di = 0; di < 4; ++di) { const bf16x8 vf = *(const bf16x8*)(VT + (16 * di + fr) * 592 + (16 * wave + 32 * ks + 8 * fq) * 2); o[di] = mfma16(vf, pf, o[di]); }
            }
            bf16_t* dst = (bf16_t*)(p.ws + WS_AT) + (size_t)(b * SEQ + 128 * n + 16 * wave + fr) * 512 + hq * 64 + 4 * fq;
#pragma unroll
            for (int di = 0; di < 4; ++di) { u32x2 w; w.x = pk2(o[di][0] * inv, o[di][1] * inv); w.y = pk2(o[di][2] * inv, o[di][3] * inv); *(u32x2*)(dst + 16 * di) = w; }
            __syncthreads();
        }
    }
}

DEV float logsigf(float x) { return fminf(x, 0.f) - log1pf(expf(-fabsf(x))); }

DEV void chunk_gates(const float* ipre, const float* fpre, int rowbase, int h, float* gs, int lane) {
    const int l0 = 2 * lane;
    const float i0 = ipre[(size_t)(rowbase + l0) * 4 + h], i1 = ipre[(size_t)(rowbase + l0 + 1) * 4 + h];
    const float lf0 = logsigf(fpre[(size_t)(rowbase + l0) * 4 + h]), lf1 = logsigf(fpre[(size_t)(rowbase + l0 + 1) * 4 + h]);
    const float pair = lf0 + lf1;
    float sc = pair;
#pragma unroll
    for (int o = 1; o < 64; o <<= 1) { const float t = __shfl_up(sc, o); if (lane >= o) sc += t; }
    const float b0 = (sc - pair) + lf0, b1 = b0 + lf1;
    const float g = __shfl(sc, 63);
    const float a0 = g - b0 + i0, a1 = g - b1 + i1;
    const float mloc = wave_max(fmaxf(a0, a1));
    const float ib0 = i0 - b0, ib1 = i1 - b1;
    float scm = fmaxf(ib0, ib1);
#pragma unroll
    for (int o = 1; o < 64; o <<= 1) { const float t = __shfl_up(scm, o); if (lane >= o) scm = fmaxf(scm, t); }
    float ex = __shfl_up(scm, 1); if (lane == 0) ex = -INFINITY;
    const float pm0 = fmaxf(ex, ib0), pm1 = fmaxf(pm0, ib1);
    gs[l0] = b0; gs[l0 + 1] = b1; gs[128 + l0] = ib0; gs[128 + l0 + 1] = ib1; gs[256 + l0] = a0; gs[256 + l0 + 1] = a1; gs[384 + l0] = pm0; gs[384 + l0 + 1] = pm1;
    if (lane == 0) { gs[512] = g; gs[513] = mloc; }
}

DEV void conv8(const bf16_t* PM, const float* cw, int b, int t, int pmcol, int cch, float (&out)[8]) {
#pragma unroll
    for (int e = 0; e < 8; ++e) out[e] = 0.f;
#pragma unroll
    for (int j = 0; j < 4; ++j) {
        const int tt = t - 3 + j; const int tc = tt < 0 ? 0 : tt; const float z = tt < 0 ? 0.f : 1.f;
        const u32x4 x = *(const u32x4*)(PM + (size_t)(b * SEQ + tc) * LPM + pmcol);
        float4 w0 = *(const float4*)(cw + j * 1024 + cch), w1 = *(const float4*)(cw + j * 1024 + cch + 4);
        w0.x *= z; w0.y *= z; w0.z *= z; w0.w *= z; w1.x *= z; w1.y *= z; w1.z *= z; w1.w *= z;
        out[0] += bflo(x[0]) * w0.x; out[1] += bfhi(x[0]) * w0.y; out[2] += bflo(x[1]) * w0.z; out[3] += bfhi(x[1]) * w0.w;
        out[4] += bflo(x[2]) * w1.x; out[5] += bfhi(x[2]) * w1.y; out[6] += bflo(x[3]) * w1.z; out[7] += bfhi(x[3]) * w1.w;
    }
}

DEV void conv8r(const u32x4 (&r)[4], const float* cwl, int ch8, int t, float (&out)[8]) {
#pragma unroll
    for (int e = 0; e < 8; ++e) out[e] = 0.f;
#pragma unroll
    for (int j = 0; j < 4; ++j) {
        const float z = (t - 3 + j) < 0 ? 0.f : 1.f;
        const float4 w0 = *(const float4*)(cwl + j * 128 + ch8), w1 = *(const float4*)(cwl + j * 128 + ch8 + 4);
        out[0] += bflo(r[j][0]) * (w0.x * z); out[1] += bfhi(r[j][0]) * (w0.y * z); out[2] += bflo(r[j][1]) * (w0.z * z); out[3] += bfhi(r[j][1]) * (w0.w * z);
        out[4] += bflo(r[j][2]) * (w1.x * z); out[5] += bfhi(r[j][2]) * (w1.y * z); out[6] += bflo(r[j][3]) * (w1.z * z); out[7] += bfhi(r[j][3]) * (w1.w * z);
    }
}
DEV float siluf_(float y) { return y * __builtin_amdgcn_rcpf(1.f + __expf(-y)); }

DEV void stage_mstate(const Params& p, char* lds, int vb, int nvb) {
    const int tid = threadIdx.x, lane = tid & 63, wave = __builtin_amdgcn_readfirstlane(tid >> 6), fr = lane & 15, fq = lane >> 4;
    char* KT = lds;
    char* VT = lds + 34816;
    float* gs = (float*)(lds + 69632); float* s_cw = (float*)(lds + 73728);
    const bf16_t* PM = (const bf16_t*)(p.ws + WS_PM);
    const float* ipre = (const float*)(p.ws + WS_IPRE); const float* fpre = (const float*)(p.ws + WS_FPRE);
    float* UT = (float*)(p.ws + WS_UB); float* NLOC = (float*)(p.ws + WS_NLOC);
    float* G = (float*)(p.ws + WS_CHG); float* MLOC = G + 1024;
    for (int unit = vb; unit < 1024; unit += nvb) {
        const int c = unit & 127, h = (unit >> 7) & 3, b = unit >> 9;
        const int rowbase = b * SEQ + c * 128;
        __syncthreads();
        if (wave == 0) chunk_gates(ipre, fpre, rowbase, h, gs, lane);
        else if (tid >= 64 && tid < 192) { const int d = tid - 64;
#pragma unroll
            for (int j = 0; j < 4; ++j) s_cw[j * 128 + d] = p.conv_w[j * 1024 + 512 + h * 128 + d]; }
        __syncthreads();
        const float mloc = gs[513];
        for (int task0 = tid; task0 < 2048; task0 += 2 * NTH) {
            u32x4 rk[2][4], xv[2];
#pragma unroll
            for (int u2 = 0; u2 < 2; ++u2) {
                const int task = task0 + u2 * NTH, l = task >> 4, ch = task & 15, t = c * 128 + l;
#pragma unroll
                for (int j = 0; j < 4; ++j) { const int tc = t - 3 + j < 0 ? 0 : t - 3 + j; rk[u2][j] = *(const u32x4*)(PM + (size_t)(b * SEQ + tc) * LPM + 512 + h * 128 + ch * 8); }
                xv[u2] = *(const u32x4*)(PM + (size_t)(rowbase + l) * LPM + 1024 + h * 128 + ch * 8);
            }
#pragma unroll
            for (int u2 = 0; u2 < 2; ++u2) {
                const int task = task0 + u2 * NTH, l = task >> 4, ch = task & 15, t = c * 128 + l;
                float v8[8]; conv8r(rk[u2], s_cw, ch * 8, t, v8);
                const float wgt = __expf(gs[256 + l] - mloc) * 0.08838834764831845f;
#pragma unroll
                for (int e = 0; e < 8; ++e) *(bf16_t*)(KT + (ch * 8 + e) * 272 + l * 2) = (bf16_t)f2bf(siluf_(v8[e]) * wgt);
                const u32x4 x = xv[u2];
#pragma unroll
                for (int e = 0; e < 8; ++e) *(bf16_t*)(VT + (ch * 8 + e) * 272 + l * 2) = (bf16_t)((e & 1) ? (x[e >> 1] >> 16) : (x[e >> 1] & 0xffffu));
            }
        }
        __syncthreads();
        f32x4 acc[8];
#pragma unroll
        for (int t = 0; t < 8; ++t) acc[t] = (f32x4){0.f, 0.f, 0.f, 0.f};
#pragma unroll
        for (int ks = 0; ks < 4; ++ks) {
            const bf16x8 vf = *(const bf16x8*)(VT + (16 * wave + fr) * 272 + (32 * ks + 8 * fq) * 2);
#pragma unroll
            for (int t = 0; t < 8; ++t) { const bf16x8 kf = *(const bf16x8*)(KT + (16 * t + fr) * 272 + (32 * ks + 8 * fq) * 2); acc[t] = mfma16(kf, vf, acc[t]); }
        }
        float* UTu = UT + (size_t)unit * 16384 + (16 * wave + fr) * 128 + 4 * fq;
#pragma unroll
        for (int t = 0; t < 8; ++t) *(f32x4*)(UTu + 16 * t) = acc[t];
        if (tid < 128) { float s = 0.f; for (int l = 0; l < 128; ++l) s += bf2f(*(const bf16_t*)(KT + tid * 272 + l * 2)); NLOC[unit * 128 + tid] = s; }
        if (tid == 0) { G[unit] = gs[512]; MLOC[unit] = mloc; }
    }
}

DEV void stage_mscan(const Params& p, char* lds, int vb, int nvb) {
    const int tid = threadIdx.x;
    float* s_dec = (float*)lds; float* s_scl = s_dec + 128;
    const float* UT = (const float*)(p.ws + WS_UB); const float* NLOC = (const float*)(p.ws + WS_NLOC);
    const float* G = (const float*)(p.ws + WS_CHG); const float* MLOC = G + 1024; float* MST = (float*)(p.ws + WS_CHG) + 2048;
    bf16_t* CST = (bf16_t*)(p.ws + WS_CST); float* NST = (float*)(p.ws + WS_NST);
    for (int item = vb; item < 256; item += nvb) {
        const int bh = item >> 5, part = item & 31;
        __syncthreads();
        float* s_g = s_dec + 256; float* s_ml = s_dec + 384; float* s_m = s_dec + 512;
        if (tid < 128) { s_g[tid] = G[bh * 128 + tid]; s_ml[tid] = MLOC[bh * 128 + tid]; }
        __syncthreads();
        if (tid == 0) { float m = 0.f; for (int c = 0; c < 128; ++c) { s_m[c] = m; m = fmaxf(s_g[c] + m, s_ml[c]); } s_m[128] = m; }
        __syncthreads();
        if (tid < 128) { const float m = s_m[tid], mn = s_m[tid + 1]; s_dec[tid] = expf(s_g[tid] + m - mn); s_scl[tid] = expf(s_ml[tid] - mn); if (part == 0) MST[bh * 128 + tid] = m; }
        __syncthreads();
        const int e = part * 512 + tid;
        float C = 0.f;
        const float* up = UT + (size_t)bh * 128 * 16384 + e; bf16_t* cp = CST + (size_t)bh * 128 * 16384 + e;
        for (int c = 0; c < 128; c += 32) {
            float uu[32];
#pragma unroll
            for (int i = 0; i < 32; ++i) uu[i] = up[(size_t)(c + i) * 16384];
#pragma unroll
            for (int i = 0; i < 32; ++i) { cp[(size_t)(c + i) * 16384] = (bf16_t)f2bf(C); C = s_dec[c + i] * C + s_scl[c + i] * uu[i]; }
        }
        if (part == 0 && tid < 128) {
            float nn = 0.f;
            for (int c = 0; c < 128; c += 32) {
                float nv[32];
#pragma unroll
                for (int i = 0; i < 32; ++i) nv[i] = NLOC[(bh * 128 + c + i) * 128 + tid];
#pragma unroll
                for (int i = 0; i < 32; ++i) { NST[(bh * 128 + c + i) * 128 + tid] = nn; nn = s_dec[c + i] * nn + s_scl[c + i] * nv[i]; }
            }
        }
    }
}

DEV void stage_mout(const Params& p, char* lds, int vb, int nvb) {
    const int tid = threadIdx.x, lane = tid & 63, wave = __builtin_amdgcn_readfirstlane(tid >> 6), fr = lane & 15, fq = lane >> 4;
    char* Qs = lds; char* Ks = lds + 34816; char* VT = lds + 69632; char* CT = lds + 104448;
    float* gs = (float*)(lds + 139264); float* s_nst = gs + 520; float* s_mo = gs + 648; float* s_wi = gs + 776; float* s_cw = (float*)(lds + 143360);
    bf16_t* PM = (bf16_t*)(p.ws + WS_PM);
    const float* ipre = (const float*)(p.ws + WS_IPRE); const float* fpre = (const float*)(p.ws + WS_FPRE);
    const float* MST = (const float*)(p.ws + WS_CHG) + 2048; const float* NST = (const float*)(p.ws + WS_NST);
    const bf16_t* CST = (const bf16_t*)(p.ws + WS_CST);
    for (int unit = vb; unit < 1024; unit += nvb) {
        const int c = unit & 127, h = (unit >> 7) & 3, b = unit >> 9;
        const int rowbase = b * SEQ + c * 128;
        __syncthreads();
        if (tid < 256) { const int d = tid & 127, kq = tid >> 7;
#pragma unroll
            for (int j = 0; j < 4; ++j) s_cw[kq * 512 + j * 128 + d] = p.conv_w[j * 1024 + kq * 512 + h * 128 + d]; }
        __syncthreads();
        if (wave == 0) chunk_gates(ipre, fpre, rowbase, h, gs, lane);
        for (int task0 = tid; task0 < 2048; task0 += 2 * NTH) {
            u32x4 rq[2][4], rk[2][4], xv[2], cstv[2];
#pragma unroll
            for (int u2 = 0; u2 < 2; ++u2) {
                const int task = task0 + u2 * NTH, l = task >> 4, ch = task & 15, t = c * 128 + l;
#pragma unroll
                for (int j = 0; j < 4; ++j) { const int tc = t - 3 + j < 0 ? 0 : t - 3 + j; const bf16_t* rp = PM + (size_t)(b * SEQ + tc) * LPM + h * 128 + ch * 8; rq[u2][j] = *(const u32x4*)rp; rk[u2][j] = *(const u32x4*)(rp + 512); }
                xv[u2] = *(const u32x4*)(PM + (size_t)(rowbase + l) * LPM + 1024 + h * 128 + ch * 8);
                cstv[u2] = *(const u32x4*)(CST + (size_t)unit * 16384 + l * 128 + ch * 8);
            }
#pragma unroll
            for (int u2 = 0; u2 < 2; ++u2) {
                const int task = task0 + u2 * NTH, l = task >> 4, ch = task & 15, t = c * 128 + l;
                float v8[8]; u32x4 o;
                conv8r(rq[u2], s_cw, ch * 8, t, v8);
                o.x = pk2(siluf_(v8[0]), siluf_(v8[1])); o.y = pk2(siluf_(v8[2]), siluf_(v8[3])); o.z = pk2(siluf_(v8[4]), siluf_(v8[5])); o.w = pk2(siluf_(v8[6]), siluf_(v8[7]));
                *(u32x4*)(Qs + l * 272 + ch * 16) = o;
                conv8r(rk[u2], s_cw + 512, ch * 8, t, v8);
                const float sc = 0.08838834764831845f;
                o.x = pk2(siluf_(v8[0]) * sc, siluf_(v8[1]) * sc); o.y = pk2(siluf_(v8[2]) * sc, siluf_(v8[3]) * sc); o.z = pk2(siluf_(v8[4]) * sc, siluf_(v8[5]) * sc); o.w = pk2(siluf_(v8[6]) * sc, siluf_(v8[7]) * sc);
                *(u32x4*)(Ks + l * 272 + ch * 16) = o;
                const u32x4 x = xv[u2];
#pragma unroll
                for (int e = 0; e < 8; ++e) *(bf16_t*)(VT + (ch * 8 + e) * 272 + l * 2) = (bf16_t)((e & 1) ? (x[e >> 1] >> 16) : (x[e >> 1] & 0xffffu));
                *(u32x4*)(CT + l * 272 + ch * 16) = cstv[u2];
            }
        }
        if (tid < 128) s_nst[tid] = NST[unit * 128 + tid];
        __syncthreads();
        if (tid < 128) { const float mst = MST[unit]; const float bc = gs[tid]; const float mo = bc + fmaxf(mst, gs[384 + tid]); s_mo[tid] = mo; s_wi[tid] = __expf(bc + mst - mo); }
        __syncthreads();
        const int l = 16 * wave + fr;
        f32x4 s[8];
        bf16x8 qf[4];
#pragma unroll
        for (int ks = 0; ks < 4; ++ks) qf[ks] = *(const bf16x8*)(Qs + l * 272 + (32 * ks + 8 * fq) * 2);
#pragma unroll
        for (int t = 0; t < 8; ++t) {
            s[t] = (f32x4){0.f, 0.f, 0.f, 0.f};
            if (t <= wave) {
#pragma unroll
                for (int ks = 0; ks < 4; ++ks) { const bf16x8 kf = *(const bf16x8*)(Ks + (16 * t + fr) * 272 + (32 * ks + 8 * fq) * 2); s[t] = mfma16(kf, qf[ks], s[t]); }
            }
        }
        const float bl = gs[l], mol = s_mo[l];
        float dsum = 0.f;
#pragma unroll
        for (int t = 0; t < 8; ++t)
#pragma unroll
            for (int r = 0; r < 4; ++r) {
                const int si = 16 * t + 4 * fq + r; float wv = 0.f;
                if (t <= wave && si <= l) wv = __expf(bl + gs[128 + si] - mol) * s[t][r];
                s[t][r] = wv; dsum += wv;
            }
        dsum += __shfl_xor(dsum, 16); dsum += __shfl_xor(dsum, 32);
        float qn = 0.f;
        {
            const char* qrow = Qs + l * 272 + fq * 64;
#pragma unroll
            for (int i = 0; i < 4; ++i) {
                const u32x4 x = *(const u32x4*)(qrow + 16 * i); const float* nn = s_nst + fq * 32 + 8 * i;
                qn += bflo(x[0]) * nn[0] + bfhi(x[0]) * nn[1] + bflo(x[1]) * nn[2] + bfhi(x[1]) * nn[3] + bflo(x[2]) * nn[4] + bfhi(x[2]) * nn[5] + bflo(x[3]) * nn[6] + bfhi(x[3]) * nn[7];
            }
        }
        qn += __shfl_xor(qn, 16); qn += __shfl_xor(qn, 32);
        __syncthreads();
#pragma unroll
        for (int t = 0; t < 8; ++t)
            if (t <= wave + 1) { u32x2 o; o.x = pk2(s[t][0], s[t][1]); o.y = pk2(s[t][2], s[t][3]); *(u32x2*)(Ks + l * 272 + (16 * t + 4 * fq) * 2) = o; }
        __syncthreads();
        f32x4 acc[8];
#pragma unroll
        for (int t = 0; t < 8; ++t) acc[t] = (f32x4){0.f, 0.f, 0.f, 0.f};
#pragma unroll
        for (int ks = 0; ks < 4; ++ks)
#pragma unroll
            for (int t = 0; t < 8; ++t) { const bf16x8 cf = *(const bf16x8*)(CT + (16 * t + fr) * 272 + (32 * ks + 8 * fq) * 2); acc[t] = mfma16(cf, qf[ks], acc[t]); }
        const float wi = s_wi[l];
#pragma unroll
        for (int t = 0; t < 8; ++t) acc[t] = acc[t] * wi;
        const int nks = (wave + 2) >> 1;
#pragma unroll
        for (int ks = 0; ks < 4; ++ks)
            if (ks < nks) {
                const bf16x8 wf = *(const bf16x8*)(Ks + l * 272 + (32 * ks + 8 * fq) * 2);
#pragma unroll
                for (int t = 0; t < 8; ++t) { const bf16x8 vf = *(const bf16x8*)(VT + (16 * t + fr) * 272 + (32 * ks + 8 * fq) * 2); acc[t] = mfma16(vf, wf, acc[t]); }
            }
        const float den = dsum + wi * qn;
        const float invd = 1.f / fmaxf(fabsf(den), __expf(-mol));
        bf16_t* mop = PM + (size_t)(rowbase + l) * LPM + 1536 + h * 128 + 4 * fq;
        float ssq = 0.f;
        u32x2 g2v[8]; float4 nwv[8];
#pragma unroll
        for (int t = 0; t < 8; ++t) { g2v[t] = *(const u32x2*)(mop + 16 * t); nwv[t] = *(const float4*)(p.mnorm_w + h * 128 + 16 * t + 4 * fq); }
#pragma unroll
        for (int t = 0; t < 8; ++t) {
            const u32x2 g2 = g2v[t];
            const float gg[4] = {bflo(g2.x), bfhi(g2.x), bflo(g2.y), bfhi(g2.y)};
#pragma unroll
            for (int r = 0; r < 4; ++r) { const float hv = acc[t][r] * invd * sigmoidf_(gg[r]); acc[t][r] = hv; ssq += hv * hv; }
        }
        ssq += __shfl_xor(ssq, 16); ssq += __shfl_xor(ssq, 32);
        const float rn = rsqrtf(ssq * (1.f / 128.f) + 1e-6f);
#pragma unroll
        for (int t = 0; t < 8; ++t) {
            const float4 nw = nwv[t];
            u32x2 o; o.x = pk2(acc[t][0] * rn * nw.x, acc[t][1] * rn * nw.y); o.y = pk2(acc[t][2] * rn * nw.z, acc[t][3] * rn * nw.w);
            *(u32x2*)((bf16_t*)(p.ws + WS_ML) + (size_t)(rowbase + l) * 512 + h * 128 + 4 * fq + 16 * t) = o;
        }
    }
}

DEV void stage_norm2(const Params& p, char* lds, int vb, int nvb) {
    const int tid = threadIdx.x, lane = tid & 63, wave = __builtin_amdgcn_readfirstlane(tid >> 6);
    const float* mod = (const float*)(p.ws + WS_MOD);
    bf16_t* U2 = (bf16_t*)(p.ws + WS_PG);
    const int rstride = nvb * NW;
    for (int mb = vb * NW + wave; mb < M; mb += 4 * rstride) {
        float4 vv[4][4];
#pragma unroll
        for (int rr = 0; rr < 4; ++rr) { const int mr = mb + rr * rstride < M ? mb + rr * rstride : mb; const float4* xr = (const float4*)(p.out + (size_t)mr * D);
#pragma unroll
            for (int j = 0; j < 4; ++j) vv[rr][j] = xr[lane + 64 * j]; }
#pragma unroll
        for (int rr = 0; rr < 4; ++rr) {
            const int m = mb + rr * rstride;
            if (m < M) {
                const int b = m >= SEQ ? 1 : 0;
                float ss = 0.f;
#pragma unroll
                for (int j = 0; j < 4; ++j) { const float4 v = vv[rr][j]; ss += v.x * v.x + v.y * v.y + v.z * v.z + v.w * v.w; }
                ss = wave_sum(ss);
                const float rstd = rsqrtf(ss * (1.f / 1024.f) + 1e-6f);
#pragma unroll
                for (int j = 0; j < 4; ++j) {
                    const int col = 4 * (lane + 64 * j); const float4 v = vv[rr][j];
                    const float4 w1 = *(const float4*)(p.norm2_w + col), sc = *(const float4*)(mod + b * 6144 + 4096 + col), sh = *(const float4*)(mod + b * 6144 + 3072 + col);
                    u32x2 o;
                    o.x = pk2(v.x * rstd * w1.x * (1.f + sc.x) + sh.x, v.y * rstd * w1.y * (1.f + sc.y) + sh.y);
                    o.y = pk2(v.z * rstd * w1.z * (1.f + sc.z) + sh.z, v.w * rstd * w1.w * (1.f + sc.w) + sh.w);
                    *(u32x2*)(U2 + (size_t)m * D + col) = o;
                }
            }
        }
    }
}

constexpr size_t WS_SELI = 400 * MiB;
constexpr size_t WS_SELG = 416 * MiB;
constexpr size_t WS_SC = 64 * MiB;
DEV unsigned f2ord(float f) { const unsigned u = __float_as_uint(f); return (u & 0x80000000u) ? ~u : (u | 0x80000000u); }
DEV float ord2f(unsigned k) { return __uint_as_float((k & 0x80000000u) ? (k ^ 0x80000000u) : ~k); }
DEV unsigned umax_(unsigned a, unsigned b) { return a > b ? a : b; }

DEV void stage_gemm_q(const Params& p, char* lds, int vb, int nvb) {
    pg8::Gemm g{(const bf16_t*)(p.ws + WS_PG), (const bf16_t*)(p.ws + WS_WQ), M, 2048, 1024, 1024, 1024};
    pg8::StaticOrder S; S.init(M, 2048, nvb, vb);
    pg8::EpiF32 E{(float*)(p.ws + WS_SC), 2048};
    pg8::gemm_phase<pg8::EpiF32, pg8::StaticOrder, true, true>((PG8_LAS unsigned char*)lds, g, S, E);
}

DEV unsigned umin_(unsigned a, unsigned b) { return a < b ? a : b; }
template <int N> DEV void bitonic_sort_desc(unsigned (&a)[N]) {
#pragma unroll
    for (int k = 2; k <= N; k <<= 1)
#pragma unroll
        for (int j = k >> 1; j > 0; j >>= 1)
#pragma unroll
            for (int i = 0; i < N; ++i) { const int l = i ^ j; if (l > i) { const unsigned x = a[i], y = a[l]; const bool dsc = (i & k) == 0; a[i] = dsc ? umax_(x, y) : umin_(x, y); a[l] = dsc ? umin_(x, y) : umax_(x, y); } }
}
template <int N> DEV void bitonic_merge_desc(unsigned (&a)[N]) {
#pragma unroll
    for (int j = N >> 1; j > 0; j >>= 1)
#pragma unroll
        for (int i = 0; i < N; ++i) { const int l = i ^ j; if (l > i) { const unsigned x = a[i], y = a[l]; a[i] = umax_(x, y); a[l] = umin_(x, y); } }
}
template <bool X16> DEV void merge_top16_xlane(unsigned (&x)[16], int lane) {
    unsigned m[16];
#pragma unroll
    for (int i = 0; i < 16; ++i) {
        unsigned pv;
        if (X16) { auto r = __builtin_amdgcn_permlane16_swap(x[15 - i], x[15 - i], false, false); pv = (lane & 16) ? r[0] : r[1]; }
        else { auto r = __builtin_amdgcn_permlane32_swap(x[15 - i], x[15 - i], false, false); pv = (lane & 32) ? r[0] : r[1]; }
        m[i] = umax_(x[i], pv);
    }
    bitonic_merge_desc<16>(m);
#pragma unroll
    for (int i = 0; i < 16; ++i) x[i] = m[i];
}

DEV void stage_q_topk(const Params& p, char* lds, int vb, int nvb) {
    const int tid = threadIdx.x, lane = tid & 63, wave = __builtin_amdgcn_readfirstlane(tid >> 6), fr = lane & 15, fq = lane >> 4;
    unsigned* tops = (unsigned*)lds;
    unsigned char* ptab = (unsigned char*)(lds + 16384);
    const float* SC = (const float*)(p.ws + WS_SC);
    int* SELI = (int*)(p.ws + WS_SELI); float* SELG = (float*)(p.ws + WS_SELG);
    __syncthreads();
    if (tid < 64) { int cnt = 0; unsigned char v = 0xff; for (int i = 0; i < 16; ++i) for (int j = 0; j < 16 / (i + 1); ++j) { if (cnt == tid) v = (unsigned char)(i | (j << 4)); ++cnt; } ptab[tid] = v; }
    __syncthreads();
    pg8::StaticOrder SO; SO.init(M, 2048, nvb, vb);
    for (int it2 = 0;; ++it2) {
        pg8::Unit un; if (!SO.next(it2 >> 1, un)) break;
        const int mt = un.pm * 2 + (it2 & 1), h = un.pn, m0 = mt * 128;
        const float* srow = SC + (size_t)(m0 + 16 * wave + fr) * 2048 + h * 256 + 4 * fq;
        f32x4 sv[2][8];
#pragma unroll
        for (int pp = 0; pp < 2; ++pp)
#pragma unroll
            for (int t = 0; t < 8; ++t) sv[pp][t] = *(const f32x4*)(srow + pp * 128 + 16 * t);
        unsigned* tp = tops + (16 * wave + fr) * 32;
#pragma unroll
        for (int pp = 0; pp < 2; ++pp) {
            unsigned lo[16], hi[16];
#pragma unroll
            for (int t = 0; t < 4; ++t)
#pragma unroll
                for (int r = 0; r < 4; ++r) {
                    lo[4 * t + r] = (f2ord(sv[pp][t][r]) & ~127u) | (127u - (unsigned)(16 * t + 4 * fq + r));
                    hi[4 * t + r] = (f2ord(sv[pp][t + 4][r]) & ~127u) | (127u - (unsigned)(16 * (t + 4) + 4 * fq + r));
                }
            bitonic_sort_desc<16>(lo); bitonic_sort_desc<16>(hi);
#pragma unroll
            for (int i = 0; i < 16; ++i) lo[i] = umax_(lo[i], hi[15 - i]);
            bitonic_merge_desc<16>(lo);
            merge_top16_xlane<true>(lo, lane); merge_top16_xlane<false>(lo, lane);
            if (fq == 0) {
#pragma unroll
                for (int q = 0; q < 4; ++q) *(u32x4*)(tp + pp * 16 + 4 * q) = (u32x4){lo[4 * q], lo[4 * q + 1], lo[4 * q + 2], lo[4 * q + 3]};
            }
        }
        wave_lds_sync();
        unsigned ck[16];
#pragma unroll
        for (int sl = 0; sl < 13; ++sl) {
            const unsigned pr = ptab[4 * sl + fq]; const unsigned i = pr & 15u, j = pr >> 4;
            const float sum = ord2f(tp[i] & ~127u) + ord2f(tp[16 + (j & 15u)] & ~127u);
            ck[sl] = pr != 0xffu ? ((f2ord(sum) & ~255u) | (255u - (i * 16u + j))) : 0u;
        }
        ck[13] = 0u; ck[14] = 0u; ck[15] = 0u;
        bitonic_sort_desc<16>(ck);
        merge_top16_xlane<true>(ck, lane); merge_top16_xlane<false>(ck, lane);
        const float v0 = ord2f(ck[0] & ~255u);
        float ex[16], sm = 0.f;
#pragma unroll
        for (int r = 0; r < 16; ++r) { ex[r] = __expf(ord2f(ck[r] & ~255u) - v0); sm += ex[r]; }
        const float rs = 1.f / sm;
        int oi[4]; float og[4];
#pragma unroll
        for (int q = 0; q < 4; ++q) {
            const unsigned w = fq == 0 ? ck[q] : (fq == 1 ? ck[4 + q] : (fq == 2 ? ck[8 + q] : ck[12 + q]));
            const float e = fq == 0 ? ex[q] : (fq == 1 ? ex[4 + q] : (fq == 2 ? ex[8 + q] : ex[12 + q]));
            const unsigned flat = 255u - (w & 255u); const unsigned ia = flat >> 4, jb = flat & 15u;
            oi[q] = (int)((127u - (tp[ia] & 127u)) * 128u + (127u - (tp[16 + jb] & 127u)));
            og[q] = e * rs;
        }
        const size_t so = (size_t)(m0 + 16 * wave + fr) * 128 + h * 16 + 4 * fq;
        *(int4*)(SELI + so) = make_int4(oi[0], oi[1], oi[2], oi[3]);
        *(float4*)(SELG + so) = make_float4(og[0], og[1], og[2], og[3]);
        wave_lds_sync();
    }
}

DEV float dpp_row_sum(float v) {
    v += __int_as_float(__builtin_amdgcn_update_dpp(0, __float_as_int(v), 0xB1, 0xF, 0xF, true));
    v += __int_as_float(__builtin_amdgcn_update_dpp(0, __float_as_int(v), 0x4E, 0xF, 0xF, true));
    v += __int_as_float(__builtin_amdgcn_update_dpp(0, __float_as_int(v), 0x141, 0xF, 0xF, true));
    v += __int_as_float(__builtin_amdgcn_update_dpp(0, __float_as_int(v), 0x140, 0xF, 0xF, true));
    return v;
}
DEV int dpp_row_isum(int v) {
    v += __builtin_amdgcn_update_dpp(0, v, 0xB1, 0xF, 0xF, true); v += __builtin_amdgcn_update_dpp(0, v, 0x4E, 0xF, 0xF, true);
    v += __builtin_amdgcn_update_dpp(0, v, 0x141, 0xF, 0xF, true); v += __builtin_amdgcn_update_dpp(0, v, 0x140, 0xF, 0xF, true);
    return v;
}
DEV float dpp_row_max(float v) {
    v = fmaxf(v, __int_as_float(__builtin_amdgcn_update_dpp(0, __float_as_int(v), 0xB1, 0xF, 0xF, true))); v = fmaxf(v, __int_as_float(__builtin_amdgcn_update_dpp(0, __float_as_int(v), 0x4E, 0xF, 0xF, true)));
    v = fmaxf(v, __int_as_float(__builtin_amdgcn_update_dpp(0, __float_as_int(v), 0x141, 0xF, 0xF, true))); v = fmaxf(v, __int_as_float(__builtin_amdgcn_update_dpp(0, __float_as_int(v), 0x140, 0xF, 0xF, true)));
    return v;
}
DEV float gelu_as(float v) {
    const float av = fabsf(v), t = __builtin_amdgcn_rcpf(av * 0.2316418882f + 1.0f);
    float q = t * 0.5307027145f + (-0.7265760135f); q = q * t + 0.7107068705f; q = q * t + (-0.142248368f); q = q * t + 0.127414796f; q = q * t;
    const float e = __builtin_amdgcn_exp2f(v * v * (-0.72134752044f));
    const float m = v * (q * e);
    return v < 0.f ? m : v - m;
}
constexpr int NBIN = 16;
constexpr int GW_IDX = 0, GW_GATE = 1024, GW_SU = 3072, GW_SV = 5120, GW_W = 7168, GW_WQ = 9216, GW_BYTES = 9728;
DEV void g_sort_token(const int* SELI, const float* SELG, const float* SU, const float* SV, int tkn, char* wl, int j, int lane, int msk) {
    const int i0 = SELI[(size_t)tkn * 128 + lane] & msk, i1 = SELI[(size_t)tkn * 128 + 64 + lane] & msk;
    const float g0 = SELG[(size_t)tkn * 128 + lane], g1 = SELG[(size_t)tkn * 128 + 64 + lane];
    const float su0 = SU[i0], su1 = SU[i1], sv0 = SV[i0], sv1 = SV[i1];
    const int s0 = i0 >> 10, s1 = i1 >> 10;
    const unsigned long long lt = (1ull << lane) - 1ull;
    int base = 0, p0 = 0, p1 = 0;
#pragma unroll
    for (int s = 0; s < NBIN; ++s) {
        const unsigned long long m0 = __ballot(s0 == s), m1 = __ballot(s1 == s);
        const int c0 = __popcll(m0), c1 = __popcll(m1);
        if (s0 == s) p0 = base + __popcll(m0 & lt);
        if (s1 == s) p1 = base + c0 + __popcll(m1 & lt);
        base += c0 + c1;
    }
    unsigned short* li = (unsigned short*)(wl + GW_IDX) + j * 128; float* lg = (float*)(wl + GW_GATE) + j * 128; float* lsu = (float*)(wl + GW_SU) + j * 128; float* lsv = (float*)(wl + GW_SV) + j * 128;
    li[p0] = (unsigned short)i0; lg[p0] = g0; lsu[p0] = su0; lsv[p0] = sv0;
    li[p1] = (unsigned short)i1; lg[p1] = g1; lsu[p1] = su1; lsv[p1] = sv1;
}
DEV void r_load(u32x4 (&d)[4], const unsigned char* T, int id, int c) {
    const u32x4* q = (const u32x4*)(T + (size_t)id * 1024) + c;
#pragma unroll
    for (int k = 0; k < 4; ++k) d[k] = q[16 * k];
}
DEV int r_dotq(const u32x4 (&u)[4], const unsigned (&xq)[16]) {
    int s0 = 0, s1 = 0, s2 = 0, s3 = 0;
#pragma unroll
    for (int k = 0; k < 4; ++k) {
        s0 = __builtin_amdgcn_sdot4((int)u[k][0], (int)xq[4 * k], s0, false); s1 = __builtin_amdgcn_sdot4((int)u[k][1], (int)xq[4 * k + 1], s1, false);
        s2 = __builtin_amdgcn_sdot4((int)u[k][2], (int)xq[4 * k + 2], s2, false); s3 = __builtin_amdgcn_sdot4((int)u[k][3], (int)xq[4 * k + 3], s3, false);
    }
    return (s0 + s1) + (s2 + s3);
}
DEV float r_weight(int part, float sx, const char* wl, int r, int e) {
    const float d = (float)dpp_row_isum(part) * (((const float*)(wl + GW_SU))[r * 128 + e] * sx);
    return ((const float*)(wl + GW_GATE))[r * 128 + e] * gelu_as(d) * ((const float*)(wl + GW_SV))[r * 128 + e];
}
DEV void r_vaccq(const u32x4 (&v0)[4], const u32x4 (&v1)[4], const u32x4 (&v2)[4], const u32x4 (&v3)[4], unsigned wpk, int (&acc)[64]) {
#pragma unroll
    for (int k = 0; k < 4; ++k)
#pragma unroll
        for (int w = 0; w < 4; ++w) {
            const unsigned r0 = v0[k][w], r1 = v1[k][w], r2 = v2[k][w], r3 = v3[k][w];
            const unsigned p0 = __builtin_amdgcn_perm(r1, r0, 0x05010400u), p1 = __builtin_amdgcn_perm(r1, r0, 0x07030602u);
            const unsigned q0 = __builtin_amdgcn_perm(r3, r2, 0x05010400u), q1 = __builtin_amdgcn_perm(r3, r2, 0x07030602u);
            const unsigned t0 = __builtin_amdgcn_perm(q0, p0, 0x05040100u), t1 = __builtin_amdgcn_perm(q0, p0, 0x07060302u);
            const unsigned t2 = __builtin_amdgcn_perm(q1, p1, 0x05040100u), t3 = __builtin_amdgcn_perm(q1, p1, 0x07060302u);
            const int o = 16 * k + 4 * w;
            acc[o] = __builtin_amdgcn_sdot4((int)t0, (int)wpk, acc[o], false); acc[o + 1] = __builtin_amdgcn_sdot4((int)t1, (int)wpk, acc[o + 1], false);
            acc[o + 2] = __builtin_amdgcn_sdot4((int)t2, (int)wpk, acc[o + 2], false); acc[o + 3] = __builtin_amdgcn_sdot4((int)t3, (int)wpk, acc[o + 3], false);
        }
}
DEV void r_load2(u32x4 (&d)[2], const unsigned char* T, int id, int c, int hh) {
    const u32x4* q = (const u32x4*)(T + (size_t)id * 1024) + c + 32 * hh;
    d[0] = q[0]; d[1] = q[16];
}
template <int HH> DEV void r_vaccq2(const u32x4 (&v0)[2], const u32x4 (&v1)[2], const u32x4 (&v2)[2], const u32x4 (&v3)[2], unsigned wpk, int (&acc)[64]) {
#pragma unroll
    for (int kk = 0; kk < 2; ++kk)
#pragma unroll
        for (int w = 0; w < 4; ++w) {
            const unsigned r0 = v0[kk][w], r1 = v1[kk][w], r2 = v2[kk][w], r3 = v3[kk][w];
            const unsigned p0 = __builtin_amdgcn_perm(r1, r0, 0x05010400u), p1 = __builtin_amdgcn_perm(r1, r0, 0x07030602u);
            const unsigned q0 = __builtin_amdgcn_perm(r3, r2, 0x05010400u), q1 = __builtin_amdgcn_perm(r3, r2, 0x07030602u);
            const unsigned t0 = __builtin_amdgcn_perm(q0, p0, 0x05040100u), t1 = __builtin_amdgcn_perm(q0, p0, 0x07060302u);
            const unsigned t2 = __builtin_amdgcn_perm(q1, p1, 0x05040100u), t3 = __builtin_amdgcn_perm(q1, p1, 0x07060302u);
            const int o = 16 * (2 * HH + kk) + 4 * w;
            acc[o] = __builtin_amdgcn_sdot4((int)t0, (int)wpk, acc[o], false); acc[o + 1] = __builtin_amdgcn_sdot4((int)t1, (int)wpk, acc[o + 1], false);
            acc[o + 2] = __builtin_amdgcn_sdot4((int)t2, (int)wpk, acc[o + 2], false); acc[o + 3] = __builtin_amdgcn_sdot4((int)t3, (int)wpk, acc[o + 3], false);
        }
}
struct VB4 { u32x4 e0[2], e1[2], e2[2], e3[2]; };
DEV void vb_load(VB4& b, const unsigned char* TV, const unsigned short* myi, int g, int c, int hh) {
    const int e = g < 32 ? 4 * g : 124;
    r_load2(b.e0, TV, (int)myi[e], c, hh); r_load2(b.e1, TV, (int)myi[e + 1], c, hh); r_load2(b.e2, TV, (int)myi[e + 2], c, hh); r_load2(b.e3, TV, (int)myi[e + 3], c, hh);
}
template <int HH> DEV void pass2_half(const unsigned char* TV, const unsigned short* myi, const unsigned* lwq, int c, int (&acc)[64]) {
    VB4 ba, bb, bc, bd;
    vb_load(ba, TV, myi, 0, c, HH); vb_load(bb, TV, myi, 1, c, HH); vb_load(bc, TV, myi, 2, c, HH); vb_load(bd, TV, myi, 3, c, HH);
    for (int g = 0; g < 32; g += 4) {
        __builtin_amdgcn_sched_barrier(0); r_vaccq2<HH>(ba.e0, ba.e1, ba.e2, ba.e3, lwq[g], acc);     __builtin_amdgcn_sched_barrier(0); vb_load(ba, TV, myi, g + 4, c, HH);
        __builtin_amdgcn_sched_barrier(0); r_vaccq2<HH>(bb.e0, bb.e1, bb.e2, bb.e3, lwq[g + 1], acc); __builtin_amdgcn_sched_barrier(0); vb_load(bb, TV, myi, g + 5, c, HH);
        __builtin_amdgcn_sched_barrier(0); r_vaccq2<HH>(bc.e0, bc.e1, bc.e2, bc.e3, lwq[g + 2], acc); __builtin_amdgcn_sched_barrier(0); vb_load(bc, TV, myi, g + 6, c, HH);
        __builtin_amdgcn_sched_barrier(0); r_vaccq2<HH>(bd.e0, bd.e1, bd.e2, bd.e3, lwq[g + 3], acc); __builtin_amdgcn_sched_barrier(0); vb_load(bd, TV, myi, g + 7, c, HH);
        __builtin_amdgcn_sched_barrier(0);
    }
}
#define SB_() __builtin_amdgcn_sched_barrier(0)

DEV void stage_peer_gather(const Params& p, char* lds, int slot, int nslots, bool dry = false, int msk = 0x3fff) {
    const int tid = threadIdx.x, lane = tid & 63, wave = __builtin_amdgcn_readfirstlane(tid >> 6), r = lane >> 4, c = lane & 15;
    const bf16_t* U2 = (const bf16_t*)(p.ws + WS_PG);
    const unsigned char* TU = p.ws + WS_TU; const unsigned char* TV = p.ws + WS_TV;
    const float* SU = (const float*)(p.ws + WS_ISU); const float* SV = (const float*)(p.ws + WS_ISV);
    const int* SELI = (const int*)(p.ws + WS_SELI); const float* SELG = (const float*)(p.ws + WS_SELG);
    const float* mod = (const float*)(p.ws + WS_MOD);
    char* wl = lds + wave * GW_BYTES;
    const unsigned short* myi = (const unsigned short*)(wl + GW_IDX) + r * 128;
    float* lw = (float*)(wl + GW_W) + r * 128; unsigned* lwq = (unsigned*)(wl + GW_WQ) + r * 32;
    const int tpb = M / nslots;
    __syncthreads();
    for (int g0 = 0; g0 < tpb; g0 += 32) {
        __syncthreads();
        const int tbase = slot * tpb + g0 + 4 * wave;
#pragma unroll
        for (int j = 0; j < 4; ++j) g_sort_token(SELI, SELG, SU, SV, tbase + j, wl, j, lane, msk);
        const int tkn = tbase + r;
        unsigned xq[16]; float sx;
        {
            const bf16_t* xr = U2 + (size_t)tkn * D + 16 * c;
            u32x4 t[8]; float amax = 0.f;
#pragma unroll
            for (int k = 0; k < 8; ++k) { t[k] = *(const u32x4*)(xr + 256 * (k >> 1) + 8 * (k & 1));
#pragma unroll
                for (int i = 0; i < 4; ++i) amax = fmaxf(amax, fmaxf(fabsf(bflo(t[k][i])), fabsf(bfhi(t[k][i])))); }
            amax = dpp_row_max(amax);
            const float inv = amax > 0.f ? 127.f / amax : 0.f; sx = amax > 0.f ? amax * (1.f / 127.f) : 1.f;
#pragma unroll
            for (int k = 0; k < 8; ++k)
#pragma unroll
                for (int h2 = 0; h2 < 2; ++h2) {
                    const unsigned a = t[k][2 * h2], b = t[k][2 * h2 + 1];
                    const unsigned wv = ((unsigned)__float2int_rn(bflo(a) * inv) & 0xffu) | (((unsigned)__float2int_rn(bfhi(a) * inv) & 0xffu) << 8) | (((unsigned)__float2int_rn(bflo(b) * inv) & 0xffu) << 16) | ((unsigned)__float2int_rn(bfhi(b) * inv) << 24);
                    xq[2 * k + h2] = wv;
                }
        }
        wave_lds_sync();
        float wmax = 0.f;
        {
            u32x4 ua[4], ub[4], uc[4], ud[4];
            r_load(ua, TU, (int)myi[0], c); r_load(ub, TU, (int)myi[1], c); r_load(uc, TU, (int)myi[2], c); r_load(ud, TU, (int)myi[3], c);
            for (int e = 0; e < 128; e += 4) {
                SB_(); const int pa = r_dotq(ua, xq); SB_(); r_load(ua, TU, (int)myi[e + 4 < 128 ? e + 4 : 127], c); SB_();
                const int pb = r_dotq(ub, xq); SB_(); r_load(ub, TU, (int)myi[e + 5 < 128 ? e + 5 : 127], c); SB_();
                const int pc = r_dotq(uc, xq); SB_(); r_load(uc, TU, (int)myi[e + 6 < 128 ? e + 6 : 127], c); SB_();
                const int pd = r_dotq(ud, xq); SB_(); r_load(ud, TU, (int)myi[e + 7 < 128 ? e + 7 : 127], c); SB_();
                const float w0 = r_weight(pa, sx, wl, r, e), w1 = r_weight(pb, sx, wl, r, e + 1), w2 = r_weight(pc, sx, wl, r, e + 2), w3 = r_weight(pd, sx, wl, r, e + 3);
                wmax = fmaxf(fmaxf(wmax, fmaxf(fabsf(w0), fabsf(w1))), fmaxf(fabsf(w2), fabsf(w3)));
                if (c == 0) *(f32x4*)(lw + e) = (f32x4){w0, w1, w2, w3};
            }
        }
        __syncthreads();
        const float T = wmax > 0.f ? wmax * (1.f / 127.f) : 1.f, invT = wmax > 0.f ? 127.f / wmax : 0.f;
        wave_lds_sync();
#pragma unroll
        for (int h2 = 0; h2 < 2; ++h2) {
            const int gg = c + 16 * h2; const f32x4 wv = *(const f32x4*)(lw + 4 * gg);
            lwq[gg] = ((unsigned)__float2int_rn(wv[0] * invT) & 0xffu) | (((unsigned)__float2int_rn(wv[1] * invT) & 0xffu) << 8) | (((unsigned)__float2int_rn(wv[2] * invT) & 0xffu) << 16) | ((unsigned)__float2int_rn(wv[3] * invT) << 24);
        }
        wave_lds_sync();
        int acc[64];
#pragma unroll
        for (int i = 0; i < 64; ++i) acc[i] = 0;
        pass2_half<0>(TV, myi, lwq, c, acc);
        pass2_half<1>(TV, myi, lwq, c, acc);
        const int b = tkn >= SEQ ? 1 : 0;
        float* hr = p.out + (size_t)tkn * D + 16 * c;
        const float* g2p = mod + b * 6144 + 5120 + 16 * c;
        float y[64]; float ss = 0.f;
#pragma unroll
        for (int q = 0; q < 16; ++q) {
            const int eo = 256 * (q >> 2) + 4 * (q & 3);
            const float4 hv = *(const float4*)(hr + eo); const float4 g2 = *(const float4*)(g2p + eo);
            y[4 * q] = hv.x + g2.x * (T * (float)acc[4 * q]); y[4 * q + 1] = hv.y + g2.y * (T * (float)acc[4 * q + 1]);
            y[4 * q + 2] = hv.z + g2.z * (T * (float)acc[4 * q + 2]); y[4 * q + 3] = hv.w + g2.w * (T * (float)acc[4 * q + 3]);
            ss += y[4 * q] * y[4 * q] + y[4 * q + 1] * y[4 * q + 1] + y[4 * q + 2] * y[4 * q + 2] + y[4 * q + 3] * y[4 * q + 3];
        }
        ss = dpp_row_sum(ss);
        const float rstd = rsqrtf(ss * (1.f / 1024.f) + 1e-6f);
        float4 nwv[16];
#pragma unroll
        for (int q = 0; q < 16; ++q) nwv[q] = *(const float4*)(p.normf_w + 16 * c + 256 * (q >> 2) + 4 * (q & 3));
        if (!dry || rstd == 123.456f)
#pragma unroll
        for (int q = 0; q < 16; ++q) {
            const int eo = 256 * (q >> 2) + 4 * (q & 3);
            const float4 nw = nwv[q];
            float4 o; o.x = y[4 * q] * rstd * nw.x; o.y = y[4 * q + 1] * rstd * nw.y; o.z = y[4 * q + 2] * rstd * nw.z; o.w = y[4 * q + 3] * rstd * nw.w;
            *(float4*)(hr + eo) = o;
        }
        wave_lds_sync();
    }
}

#define LAS __attribute__((address_space(3)))
#define XB_TMO      128
#define XB_XCNT(j)  (256  + 64 * (j))
#define XB_XSUB(j)  (1280 + 64 * (j))
#define XB_XGEN(j)  (2304 + 64 * (j))
#define XB_TOP      3328
#define XB_TOPGEN   3392
#define XCD_BAR_WORDS 3456
#define XB_SPIN_CAP (1u << 18)

__device__ __forceinline__ unsigned xb_ld(unsigned* p)              { return __hip_atomic_load(p, __ATOMIC_RELAXED, __HIP_MEMORY_SCOPE_AGENT); }
__device__ __forceinline__ unsigned xb_add(unsigned* p, unsigned v) { return __hip_atomic_fetch_add(p, v, __ATOMIC_RELAXED, __HIP_MEMORY_SCOPE_AGENT); }
__device__ __forceinline__ unsigned xb_xcc_id() { return (unsigned)__builtin_amdgcn_s_getreg((3 << 11) | 20) & 0xFu; }
#define XB_SPIN(cond, bar) do { unsigned _sp = 0; while (cond) { __builtin_amdgcn_s_sleep(1); \
    if ((++_sp & 255u) == 0u) { if (xb_ld(&(bar)[XB_TMO])) break; if (_sp > XB_SPIN_CAP) { atomicAdd(&(bar)[XB_TMO], 1u); break; } } } } while (0)

struct XcdBarrier {
    unsigned* bar; unsigned x;
    volatile LAS unsigned* st;
};

__device__ __forceinline__ XcdBarrier xcd_barrier_post(unsigned* bar, volatile LAS unsigned* st) {
    XcdBarrier b; b.bar = bar; b.x = xb_xcc_id(); b.st = st;
    if (threadIdx.x == 0) (void)xb_add(&bar[XB_XCNT(b.x)], 1u);
    return b;
}
__device__ __forceinline__ void xcd_barrier_complete(unsigned* bar, unsigned x, unsigned& nloc, unsigned& nx) {
    const unsigned G = gridDim.x * gridDim.y * gridDim.z;
    unsigned sum, cnt, mine, sp = 0u;
    for (;;) {
        sum = 0u; cnt = 0u; mine = 0u;
#pragma unroll
        for (unsigned j = 0; j < 16; ++j) { const unsigned c = xb_ld(&bar[XB_XCNT(j)]); sum += c; cnt += (c > 0u) ? 1u : 0u; mine = (j == x) ? c : mine; }
        if (sum == G) break;
        __builtin_amdgcn_s_sleep(1);
        if ((++sp & 255u) == 0u) { if (xb_ld(&bar[XB_TMO])) break; if (sp > XB_SPIN_CAP) { atomicAdd(&bar[XB_TMO], 1u); break; } }
    }
    nloc = mine > 0u ? mine : 1u; nx = cnt > 0u ? cnt : 1u;
}

__device__ __forceinline__ void xcd_barrier(const XcdBarrier& b) {
    asm volatile("s_waitcnt vmcnt(0)" ::: "memory");
    __syncthreads();
    if (threadIdx.x == 0) {
        unsigned* bar = b.bar;
        __builtin_amdgcn_s_waitcnt(0);
        unsigned nloc = b.st[0], nx = b.st[1];
        if (nloc == 0u) { xcd_barrier_complete(bar, b.x, nloc, nx); b.st[0] = nloc; b.st[1] = nx; }
        const unsigned old = xb_add(&bar[XB_XSUB(b.x)], 1u);
        const unsigned gen = old / nloc;
        if (old + 1u == (gen + 1u) * nloc) {
            __builtin_amdgcn_fence(__ATOMIC_RELEASE, "agent");
            asm volatile("s_waitcnt vmcnt(0)" ::: "memory");
            const unsigned og = xb_add(&bar[XB_TOP], 1u);
            const unsigned tg = og / nx;
            if (og + 1u == (tg + 1u) * nx) xb_add(&bar[XB_TOPGEN], 1u);
            else XB_SPIN(xb_ld(&bar[XB_TOPGEN]) == tg, bar);
            __builtin_amdgcn_fence(__ATOMIC_ACQUIRE, "agent");
            xb_add(&bar[XB_XGEN(b.x)], 1u);
            asm volatile("s_waitcnt vmcnt(0)" ::: "memory");
        } else {
            XB_SPIN(xb_ld(&bar[XB_XGEN(b.x)]) == gen, bar);
            __builtin_amdgcn_fence(__ATOMIC_ACQUIRE, "agent");
            asm volatile("s_waitcnt vmcnt(0)" ::: "memory");
        }
    }
    __syncthreads();
}

namespace cg = cooperative_groups;
constexpr int LDS_BYTES = 151552;
constexpr int CW_RANK = XCD_BAR_WORDS;

constexpr int LDS_TOTAL = LDS_BYTES + 64;

__global__ void __launch_bounds__(512) k_mega(Params p) {
    extern __shared__ __attribute__((aligned(16))) char lds[];
    const int vb = blockIdx.x, nvb = gridDim.x;
    volatile LAS unsigned* bst = (volatile LAS unsigned*)((LAS char*)lds + LDS_BYTES);
    if (threadIdx.x < 16) bst[threadIdx.x] = 0u;
    __syncthreads();
    XcdBarrier bar = xcd_barrier_post((unsigned*)p.ws, bst);
    if (threadIdx.x == 0) bst[2] = xb_add((unsigned*)p.ws + CW_RANK + 64 * bar.x, 1u);
#define GRID_BAR() xcd_barrier(bar)
    stage_prep(p, lds, vb, nvb);        GRID_BAR();
    stage_norm1(p, lds, vb, nvb);       GRID_BAR();
    stage_gemm_in(p, lds, vb, nvb);     GRID_BAR();
    stage_attn(p, lds, vb, nvb);
    stage_mstate(p, lds, vb, nvb);      GRID_BAR();
    stage_mscan(p, lds, vb, nvb);       GRID_BAR();
    stage_mout(p, lds, vb, nvb);        GRID_BAR();
    stage_gemm_merge(p, lds, vb, nvb);  GRID_BAR();
    stage_gemm_out(p, lds, vb, nvb);    GRID_BAR();
    stage_norm2(p, lds, vb, nvb);       GRID_BAR();
    stage_gemm_q(p, lds, vb, nvb);      __syncthreads();
    stage_q_topk(p, lds, vb, nvb);      GRID_BAR();
    if (threadIdx.x == 0) { unsigned base = 0u; for (unsigned j = 0; j < bar.x; ++j) base += xb_ld((unsigned*)p.ws + XB_XCNT(j)); bst[3] = base + bst[2]; }
    __syncthreads();
    const int slot = (int)bst[3];
    stage_peer_gather(p, lds, slot < nvb ? slot : vb, nvb);
}

extern "C" void kernel_launch(void* const* d_in, const int* in_sizes, int n_in, void* d_out, int out_size, void* d_ws, size_t ws_size, hipStream_t stream) {
    if (n_in != 20 || ws_size < WS_END) { fprintf(stderr, "kernel_launch: unexpected n_in %d or ws_size %zu\n", n_in, ws_size); return; }
    static int grid_blocks = 0;
    if (!grid_blocks) {
        int dev = 0, cus = 0, per_cu = 0;
        (void)hipGetDevice(&dev);
        (void)hipDeviceGetAttribute(&cus, hipDeviceAttributeMultiprocessorCount, dev);
        (void)hipFuncSetAttribute((const void*)k_mega, hipFuncAttributeMaxDynamicSharedMemorySize, LDS_TOTAL);
        (void)hipOccupancyMaxActiveBlocksPerMultiprocessor(&per_cu, (const void*)k_mega, 512, LDS_TOTAL);
        if (per_cu < 1) { fprintf(stderr, "kernel_launch: occupancy query says %d blocks per CU\n", per_cu); per_cu = 1; }
        grid_blocks = cus * 1;
    }
    Params p{};
    p.x = (const float*)d_in[0]; p.c = (const float*)d_in[1]; p.w_ada = (const float*)d_in[2]; p.b_ada = (const float*)d_in[3]; p.norm1_w = (const float*)d_in[4];
    p.w_in = (const float*)d_in[5]; p.conv_w = (const float*)d_in[6]; p.sinks = (const float*)d_in[7]; p.i_bias = (const float*)d_in[8]; p.f_bias = (const float*)d_in[9];
    p.mnorm_w = (const float*)d_in[10]; p.w_a = (const float*)d_in[11]; p.w_b = (const float*)d_in[12]; p.w_out = (const float*)d_in[13]; p.norm2_w = (const float*)d_in[14];
    p.w_q = (const float*)d_in[15]; p.sub_keys = (const float*)d_in[16]; p.peer_u = (const float*)d_in[17]; p.peer_v = (const float*)d_in[18]; p.normf_w = (const float*)d_in[19];
    p.out = (float*)d_out; p.ws = (unsigned char*)d_ws;
    (void)hipMemsetAsync(d_ws, 0, 32768, stream);
    void* args[] = {&p};
    hipError_t e = hipLaunchCooperativeKernel((const void*)k_mega, dim3(grid_blocks), dim3(512), args, LDS_TOTAL, stream);
    if (e != hipSuccess) fprintf(stderr, "cooperative launch failed: %s (grid %d)\n", hipGetErrorString(e), grid_blocks);
}
```

```cpp
#include <hip/hip_runtime.h>
#include <hip/hip_cooperative_groups.h>
#include <stdint.h>
#include <stdio.h>

#define DEV __device__ __forceinline__
typedef unsigned short bf16_t;
typedef short bf16x8 __attribute__((ext_vector_type(8)));
typedef float f32x4 __attribute__((ext_vector_type(4)));
typedef unsigned u32x4 __attribute__((ext_vector_type(4)));
typedef unsigned u32x2 __attribute__((ext_vector_type(2)));

constexpr int BATCH = 2, SEQ = 16384, M = BATCH * SEQ, D = 1024;
constexpr int NTH = 512, NW = 8;
constexpr int LPA = 768, LPM = 2048, LPG = 2048;

struct Params {
    const float *x, *c, *w_ada, *b_ada, *norm1_w, *w_in, *conv_w, *sinks, *i_bias, *f_bias, *mnorm_w, *w_a, *w_b, *w_out, *norm2_w, *w_q, *sub_keys, *peer_u, *peer_v, *normf_w;
    float* out; unsigned char* ws;
};

constexpr size_t MiB = 1u << 20;
constexpr size_t WS_MOD = 1 * MiB;
constexpr size_t WS_IPRE = 2 * MiB;
constexpr size_t WS_FPRE = 2 * MiB + 512 * 1024;
constexpr size_t WS_CHG = 3 * MiB;
constexpr size_t WS_NLOC = 4 * MiB;
constexpr size_t WS_NST = 4 * MiB + 512 * 1024;
constexpr size_t WS_ROPE = 5 * MiB;
constexpr size_t WS_WIN = 10 * MiB;
constexpr size_t WS_WA = 20 * MiB;
constexpr size_t WS_WB = 21 * MiB;
constexpr size_t WS_WOUT = 22 * MiB;
constexpr size_t WS_WQ = 24 * MiB;
constexpr size_t WS_SK = 28 * MiB;
constexpr size_t WS_ISU = 29 * MiB;
constexpr size_t WS_ISV = 29 * MiB + 65536;
constexpr size_t WS_TU = 32 * MiB;
constexpr size_t WS_TV = 48 * MiB;
constexpr size_t WS_UB = 96 * MiB;
constexpr size_t WS_PA = 160 * MiB;
constexpr size_t WS_PM = 208 * MiB;
constexpr size_t WS_PG = 336 * MiB;
constexpr size_t WS_CST = 464 * MiB;
constexpr size_t WS_AT = 64 * MiB;
constexpr size_t WS_ML = 96 * MiB;
constexpr size_t WS_MG = 208 * MiB;
constexpr size_t WS_END = 496 * MiB;

DEV unsigned f2bf(float f) { unsigned u = __float_as_uint(f); return (u + 0x7fffu + ((u >> 16) & 1u)) >> 16; }
DEV unsigned pk2(float lo, float hi) { return f2bf(lo) | (f2bf(hi) << 16); }
DEV float bflo(unsigned u) { return __uint_as_float(u << 16); }
DEV float bfhi(unsigned u) { return __uint_as_float(u & 0xffff0000u); }
DEV float bf2f(bf16_t h) { return __uint_as_float(((unsigned)h) << 16); }
DEV float wave_sum(float v) {
#pragma unroll
    for (int o = 32; o > 0; o >>= 1) v += __shfl_xor(v, o);
    return v;
}
DEV float wave_max(float v) {
#pragma unroll
    for (int o = 32; o > 0; o >>= 1) v = fmaxf(v, __shfl_xor(v, o));
    return v;
}
DEV float sigmoidf_(float v) { return __builtin_amdgcn_rcpf(1.f + __expf(-v)); }
DEV f32x4 mfma16(bf16x8 a, bf16x8 b, f32x4 c) { return __builtin_amdgcn_mfma_f32_16x16x32_bf16(a, b, c, 0, 0, 0); }
DEV void wave_lds_sync() { __builtin_amdgcn_fence(__ATOMIC_ACQ_REL, "wavefront"); __builtin_amdgcn_wave_barrier(); }

DEV void transpose_item(const float* W, int ldw, int k0, int nsrc0, bf16_t* WT, int ldt, int ndst0, float* scr, int lane, int kdst_off = 0) {
#pragma unroll 8
    for (int i = 0; i < 32; ++i) { const int kk = 2 * i + (lane >> 5); scr[kk * 33 + (lane & 31)] = W[(size_t)(k0 + kk) * ldw + nsrc0 + (lane & 31)]; }
    wave_lds_sync();
    const int c = lane & 7;
#pragma unroll
    for (int j = 0; j < 4; ++j) {
        const int n = (lane >> 3) + 8 * j; const float* s = scr + (8 * c) * 33 + n;
        u32x4 o; o.x = pk2(s[0 * 33], s[1 * 33]); o.y = pk2(s[2 * 33], s[3 * 33]); o.z = pk2(s[4 * 33], s[5 * 33]); o.w = pk2(s[6 * 33], s[7 * 33]);
        *(u32x4*)(WT + (size_t)(ndst0 + n) * ldt + k0 + kdst_off + 8 * c) = o;
    }
    wave_lds_sync();
}

DEV void stage_prep(const Params& p, char* lds, int vb, int nvb) {
    const int tid = threadIdx.x, lane = tid & 63, wave = __builtin_amdgcn_readfirstlane(tid >> 6);
    float* mod = (float*)(p.ws + WS_MOD);
    float* s_act = (float*)lds;
    float* s_red = (float*)(lds + 8192);
    for (int i = tid; i < 2048; i += NTH) { const float v = p.c[i]; s_act[i] = v / (1.f + expf(-v)); }
    __syncthreads();
    for (int item = vb; item < 192; item += nvb) {
        const int kg = tid >> 5, cl = tid & 31, col = item * 32 + cl;
        float s0 = 0.f, s1 = 0.f;
        for (int k = kg; k < 1024; k += 16) { const float w = p.w_ada[(size_t)k * 6144 + col]; s0 += s_act[k] * w; s1 += s_act[1024 + k] * w; }
        s_red[(kg * 32 + cl) * 2] = s0; s_red[(kg * 32 + cl) * 2 + 1] = s1;
        __syncthreads();
        if (tid < 64) { const int b = tid >> 5, c2 = tid & 31; float s = 0.f; for (int g = 0; g < 16; ++g) s += s_red[(g * 32 + c2) * 2 + b]; mod[b * 6144 + item * 32 + c2] = s + p.b_ada[item * 32 + c2]; }
        __syncthreads();
    }
    float* scr = (float*)(lds + 16384 + wave * 8448);
    const int gw = vb * NW + wave, ngw = nvb * NW;
    bf16_t* Wt_in = (bf16_t*)(p.ws + WS_WIN); bf16_t* Wt_a = (bf16_t*)(p.ws + WS_WA); bf16_t* Wt_b = (bf16_t*)(p.ws + WS_WB);
    bf16_t* Wt_out = (bf16_t*)(p.ws + WS_WOUT); bf16_t* Wt_q = (bf16_t*)(p.ws + WS_WQ);
    for (int it = gw; it < 3456; it += ngw) {
        int r = it;
        if (r < 2432) { const int kb = r / 152, nb = r % 152; transpose_item(p.w_in, 4872, kb * 64, nb * 32 + (nb >= 88 ? 8 : 0), Wt_in, 1024, nb * 32, scr, lane); continue; } r -= 2432;
        if (r < 256) { const int kb = r / 32, nb = r % 32; transpose_item(p.w_a, 1024, kb * 64, nb * 32, Wt_a, 1024, nb * 32, scr, lane, 0); continue; } r -= 256;
        if (r < 256) { const int kb = r / 32, nb = r % 32; transpose_item(p.w_b, 1024, kb * 64, nb * 32, Wt_a, 1024, nb * 32, scr, lane, 512); continue; } r -= 256;
        { const int kb = r / 32, nb = r % 32; transpose_item(p.w_out, 1024, kb * 64, nb * 32, Wt_out, 1024, nb * 32, scr, lane); }
    }
    {
        float* WL = (float*)lds;
        float* KL = (float*)(lds + 33792);
        for (int item = vb; item < 256; item += nvb) {
            const int hp = item >> 4, k0 = (item & 15) * 64, pidx = hp & 1;
            __syncthreads();
            for (int i = tid; i < 64 * 32; i += NTH) { const int kk = i >> 5, d4 = i & 31; *(float4*)(WL + kk * 132 + 4 * d4) = *(const float4*)(p.w_q + (size_t)(k0 + kk) * 2048 + hp * 128 + 4 * d4); }
            for (int i = tid; i < 128 * 32; i += NTH) ((float4*)KL)[i] = ((const float4*)(p.sub_keys + (size_t)pidx * 16384))[i];
            __syncthreads();
            const int kk = tid & 63, n0 = (tid >> 6) * 16;
            float acc[16];
#pragma unroll
            for (int j = 0; j < 16; ++j) acc[j] = 0.f;
            for (int d4 = 0; d4 < 32; ++d4) {
                const float4 w = *(const float4*)(WL + kk * 132 + 4 * d4);
#pragma unroll
                for (int j = 0; j < 16; ++j) { const float4 kv = *(const float4*)(KL + (n0 + j) * 128 + 4 * d4); acc[j] += w.x * kv.x + w.y * kv.y + w.z * kv.z + w.w * kv.w; }
            }
#pragma unroll
            for (int j = 0; j < 16; ++j) Wt_q[(size_t)(hp * 128 + n0 + j) * 1024 + k0 + kk] = (bf16_t)f2bf(acc[j]);
        }
        __syncthreads();
    }
    const size_t gt = (size_t)vb * NTH + tid, ngt = (size_t)nvb * NTH;
    for (int rowb = gw; rowb < 32768; rowb += 4 * ngw) {
        float4 aa[4][4];
#pragma unroll
        for (int rr = 0; rr < 4; ++rr) { const int row = rowb + rr * ngw < 32768 ? rowb + rr * ngw : rowb; const float4* src = (const float4*)((row >= 16384 ? p.peer_v : p.peer_u) + (size_t)(row & 16383) * D) + lane;
#pragma unroll
            for (int i = 0; i < 4; ++i) aa[rr][i] = src[64 * i]; }
#pragma unroll
        for (int rr = 0; rr < 4; ++rr) {
            const int row = rowb + rr * ngw;
            if (row < 32768) {
                const bool isv = row >= 16384; const int r = row & 16383;
                float mx = 0.f;
#pragma unroll
                for (int i = 0; i < 4; ++i) mx = fmaxf(mx, fmaxf(fmaxf(fabsf(aa[rr][i].x), fabsf(aa[rr][i].y)), fmaxf(fabsf(aa[rr][i].z), fabsf(aa[rr][i].w))));
                mx = wave_max(mx);
                const float inv = mx > 0.f ? 127.f / mx : 0.f, sc = mx > 0.f ? mx * (1.f / 127.f) : 1.f;
                unsigned* dst = (unsigned*)(p.ws + (isv ? WS_TV : WS_TU) + (size_t)r * 1024) + lane;
#pragma unroll
                for (int i = 0; i < 4; ++i) dst[64 * i] = ((unsigned)__float2int_rn(aa[rr][i].x * inv) & 0xffu) | (((unsigned)__float2int_rn(aa[rr][i].y * inv) & 0xffu) << 8) | (((unsigned)__float2int_rn(aa[rr][i].z * inv) & 0xffu) << 16) | ((unsigned)__float2int_rn(aa[rr][i].w * inv) << 24);
                if (lane == 0) ((float*)(p.ws + (isv ? WS_ISV : WS_ISU)))[r] = sc;
            }
        }
    }
    for (size_t g = gt; g < 4096; g += ngt) {
        const float4 a = ((const float4*)p.sub_keys)[2 * g], b = ((const float4*)p.sub_keys)[2 * g + 1];
        u32x4 w; w.x = pk2(a.x, a.y); w.y = pk2(a.z, a.w); w.z = pk2(b.x, b.y); w.w = pk2(b.z, b.w);
        ((u32x4*)(p.ws + WS_SK))[g] = w;
    }
    float2* rope = (float2*)(p.ws + WS_ROPE);
    for (size_t e = gt; e < 16384 * 32; e += ngt) {
        const int pos = (int)(e >> 5), i = (int)(e & 31);
        const float inv = (float)exp2(-(double)i * (13.287712379549449 / 32.0));
        const float ang = (float)pos * inv;
        const double a = (double)ang; const double n = rint(a * 0.15915494309189535); const double r = a - n * 6.283185307179586;
        float s, c; sincosf((float)r, &s, &c);
        rope[e] = make_float2(c, s);
    }
}

DEV void stage_norm1(const Params& p, char* lds, int vb, int nvb) {
    const int tid = threadIdx.x, lane = tid & 63, wave = __builtin_amdgcn_readfirstlane(tid >> 6);
    float* wg = (float*)lds;
    for (int i = tid; i < 8192; i += NTH) { const int cc = i >> 10, k = i & 1023; wg[i] = p.w_in[(size_t)k * 4872 + 2816 + cc]; }
    __syncthreads();
    const float* mod = (const float*)(p.ws + WS_MOD);
    bf16_t* ub = (bf16_t*)(p.ws + WS_UB);
    float* ipre = (float*)(p.ws + WS_IPRE); float* fpre = (float*)(p.ws + WS_FPRE);
    const int rstride = nvb * NW;
    for (int mb = vb * NW + wave; mb < M; mb += 2 * rstride) {
        float4 vv[2][4];
#pragma unroll
        for (int rr = 0; rr < 2; ++rr) { const int mr = mb + rr * rstride < M ? mb + rr * rstride : mb; const float4* xr = (const float4*)(p.x + (size_t)mr * D);
#pragma unroll
            for (int j = 0; j < 4; ++j) vv[rr][j] = xr[lane + 64 * j]; }
#pragma unroll
        for (int rr = 0; rr < 2; ++rr) {
        const int m = mb + rr * rstride;
        if (m < M) {
        const int b = m >= SEQ ? 1 : 0;
        float4 v[4]; float ss = 0.f;
#pragma unroll
        for (int j = 0; j < 4; ++j) { v[j] = vv[rr][j]; ss += v[j].x * v[j].x + v[j].y * v[j].y + v[j].z * v[j].z + v[j].w * v[j].w; }
        ss = wave_sum(ss);
        const float rstd = rsqrtf(ss * (1.f / 1024.f) + 1e-6f);
        float ga[8];
#pragma unroll
        for (int cc = 0; cc < 8; ++cc) ga[cc] = 0.f;
#pragma unroll
        for (int j = 0; j < 4; ++j) {
            const int col = 4 * (lane + 64 * j);
            const float4 w1 = *(const float4*)(p.norm1_w + col), sc = *(const float4*)(mod + b * 6144 + 1024 + col), sh = *(const float4*)(mod + b * 6144 + col);
            float4 u;
            u.x = v[j].x * rstd * w1.x * (1.f + sc.x) + sh.x; u.y = v[j].y * rstd * w1.y * (1.f + sc.y) + sh.y;
            u.z = v[j].z * rstd * w1.z * (1.f + sc.z) + sh.z; u.w = v[j].w * rstd * w1.w * (1.f + sc.w) + sh.w;
            u32x2 o; o.x = pk2(u.x, u.y); o.y = pk2(u.z, u.w);
            *(u32x2*)(ub + (size_t)m * D + col) = o;
#pragma unroll
            for (int cc = 0; cc < 8; ++cc) { const float4 g = *(const float4*)(wg + cc * 1024 + col); ga[cc] += u.x * g.x + u.y * g.y + u.z * g.z + u.w * g.w; }
        }
        {
            const bool h32 = (lane & 32) != 0, h16 = (lane & 16) != 0, h8 = (lane & 8) != 0;
            float k4[4], k2[2];
#pragma unroll
            for (int i = 0; i < 4; ++i) k4[i] = (h32 ? ga[4 + i] : ga[i]) + __shfl_xor(h32 ? ga[i] : ga[4 + i], 32);
#pragma unroll
            for (int i = 0; i < 2; ++i) k2[i] = (h16 ? k4[2 + i] : k4[i]) + __shfl_xor(h16 ? k4[i] : k4[2 + i], 16);
            float k1 = (h8 ? k2[1] : k2[0]) + __shfl_xor(h8 ? k2[0] : k2[1], 8);
            k1 += __shfl_xor(k1, 4); k1 += __shfl_xor(k1, 2); k1 += __shfl_xor(k1, 1);
            const int cc = (lane >> 3) & 7;
            if ((lane & 7) == 0) { if (cc < 4) ipre[(size_t)m * 4 + cc] = k1 + p.i_bias[cc]; else fpre[(size_t)m * 4 + cc - 4] = k1 + p.f_bias[cc - 4]; }
        }
        }
        }
    }
}

namespace pg8 {
#define PG8_LAS __attribute__((address_space(3)))
typedef unsigned short bf16_t;
typedef short bf16x8 __attribute__((ext_vector_type(8)));
typedef float f32x4 __attribute__((ext_vector_type(4)));
typedef unsigned u32x4 __attribute__((ext_vector_type(4)));
constexpr int BM = 256, BK = 64, HALF = 128, HTB = HALF * BK * 2  , STAGE_BYTES = 8 * HTB, NXCD = 8, WGM = 8;

__host__ __device__ __forceinline__ int lds_byte(int r, int c) { const int st = (r >> 4) * 2 + (c >> 5), rr = r & 15, cc = c & 31, ob = rr * 64 + cc * 2; return st * 1024 + (ob ^ (((ob >> 9) & 1) << 5)); }
__host__ __device__ __forceinline__ void stage_rc(int b, int& R, int& C) { const int st = b / 1024, sb = b % 1024, swz = sb ^ (((sb >> 9) & 1) << 5); R = (st >> 1) * 16 + swz / 64; C = (st & 1) * 32 + (swz % 64) / 2; }
__host__ __device__ __forceinline__ int perm32(int rho) { const int n = rho >> 4, i = rho & 15; return 8 * (i >> 2) + 4 * n + (i & 3); }

struct Unit { int pm, pn; };
struct Gemm { const bf16_t* A; const bf16_t* Bt; int M, N, K, lda, ldb; const bf16_t* A2; };

struct StaticOrder {
    int nM, nN, nwg, G, c;
    __host__ __device__ void init(int M, int N, int G_, int c_) { nM = M / BM; nN = N / BM; nwg = nM * nN; G = G_; c = c_; }
    __host__ __device__ bool next(int i, Unit& u) const {
        const long L = (long)i * G + c; if (L >= nwg) return false;
        int wgid = (int)L; { const int q = nwg / NXCD, r = nwg % NXCD, xcd = wgid % NXCD, off = wgid / NXCD; wgid = (xcd < r ? xcd * (q + 1) : r * (q + 1) + (xcd - r) * q) + off; }
        const int nig = WGM * nN, gid = wgid / nig, fm = gid * WGM, gsz = (nM - fm) < WGM ? (nM - fm) : WGM;
        u.pm = fm + ((wgid % nig) % gsz); u.pn = (wgid % nig) / gsz; return true;
    }
    __device__ __forceinline__ void a_ready(const Unit&) const {}
    __device__ __forceinline__ void done(const Unit&) const {}
};

__device__ __forceinline__ unsigned cvt_pk_bf16(float lo, float hi) { unsigned r; asm volatile("v_cvt_pk_bf16_f32 %0, %1, %2" : "=v"(r) : "v"(lo), "v"(hi)); return r; }
__device__ __forceinline__ float sg_(float v) { return __builtin_amdgcn_rcpf(1.f + __expf(-v)); }
struct EpiIn {
    static constexpr bool PERM = true, AFTER_DRAIN = false, HAS_MID = false;
    bf16_t *PA, *PM, *PG;
    __device__ __forceinline__ void operator()(const f32x4 (&acc)[2][2][4][2], const Unit& u, int wr, int wc, int fr, int fq) const {
        const int colt = u.pn * BM; bf16_t* base; int ldc, cb;
        if (colt < 768) { base = PA; ldc = 768; cb = colt; } else if (colt < 2816) { base = PM; ldc = 2048; cb = colt - 768; } else { base = PG; ldc = 2048; cb = colt - 2816; }
        const int row0 = u.pm * BM + wr * 64 + fr, col0 = cb + wc * 32 + 8 * fq;
#pragma unroll
        for (int ai = 0; ai < 2; ++ai)
#pragma unroll
            for (int m = 0; m < 4; ++m) { bf16_t* rowp = base + (size_t)(row0 + ai * HALF + m * 16) * ldc + col0;
#pragma unroll
                for (int bj = 0; bj < 2; ++bj) { const f32x4 v0 = acc[ai][bj][m][0], v1 = acc[ai][bj][m][1];
                    u32x4 w; w.x = cvt_pk_bf16(v0[0], v0[1]); w.y = cvt_pk_bf16(v0[2], v0[3]); w.z = cvt_pk_bf16(v1[0], v1[1]); w.w = cvt_pk_bf16(v1[2], v1[3]);
                    *(u32x4*)(rowp + bj * HALF) = w; } }
    }
};
struct EpiMerge {
    static constexpr bool PERM = true, AFTER_DRAIN = false, HAS_MID = false;
    const bf16_t* G; bf16_t* MG; int second;
    __device__ __forceinline__ void operator()(const f32x4 (&acc)[2][2][4][2], const Unit& u, int wr, int wc, int fr, int fq) const {
        const int row0 = u.pm * BM + wr * 64 + fr, col0 = u.pn * BM + wc * 32 + 8 * fq;
#pragma unroll
        for (int bj = 0; bj < 2; ++bj)
#pragma unroll
        for (int ai = 0; ai < 2; ++ai) {
            const int col = col0 + bj * HALF;
            u32x4 gv[4], tv[4];
#pragma unroll
            for (int m = 0; m < 4; ++m) { const size_t row = (size_t)(row0 + ai * HALF + m * 16); gv[m] = *(const u32x4*)(G + row * 2048 + col); tv[m] = second ? *(const u32x4*)(MG + row * 1024 + col) : (u32x4){0u, 0u, 0u, 0u}; }
#pragma unroll
            for (int m = 0; m < 4; ++m) { const size_t row = (size_t)(row0 + ai * HALF + m * 16);
                const f32x4 v0 = acc[ai][bj][m][0], v1 = acc[ai][bj][m][1]; const u32x4 g = gv[m], t = tv[m];
                float r[8];
                r[0] = sg_(__uint_as_float(g.x << 16)) * v0[0] + __uint_as_float(t.x << 16); r[1] = sg_(__uint_as_float(g.x & 0xffff0000u)) * v0[1] + __uint_as_float(t.x & 0xffff0000u);
                r[2] = sg_(__uint_as_float(g.y << 16)) * v0[2] + __uint_as_float(t.y << 16); r[3] = sg_(__uint_as_float(g.y & 0xffff0000u)) * v0[3] + __uint_as_float(t.y & 0xffff0000u);
                r[4] = sg_(__uint_as_float(g.z << 16)) * v1[0] + __uint_as_float(t.z << 16); r[5] = sg_(__uint_as_float(g.z & 0xffff0000u)) * v1[1] + __uint_as_float(t.z & 0xffff0000u);
                r[6] = sg_(__uint_as_float(g.w << 16)) * v1[2] + __uint_as_float(t.w << 16); r[7] = sg_(__uint_as_float(g.w & 0xffff0000u)) * v1[3] + __uint_as_float(t.w & 0xffff0000u);
                u32x4 w; w.x = cvt_pk_bf16(r[0], r[1]); w.y = cvt_pk_bf16(r[2], r[3]); w.z = cvt_pk_bf16(r[4], r[5]); w.w = cvt_pk_bf16(r[6], r[7]);
                *(u32x4*)(MG + row * 1024 + col) = w; }
        }
    }
};
struct EpiMergeF {
    static constexpr bool PERM = true, AFTER_DRAIN = false, HAS_MID = true;
    const bf16_t* G; bf16_t* MG;
    static __device__ __forceinline__ float em_(float v) { return __expf(-fminf(fmaxf(v, -30.f), 30.f)); }
    __device__ __forceinline__ void mid(f32x4 (&acc)[2][2][4][2], const Unit& u, int wr, int wc, int fr, int fq) const {
        int row0 = u.pm * BM + wr * 64 + fr; const int col0 = u.pn * BM + wc * 32 + 8 * fq;
        asm volatile("" : "+v"(row0));
#pragma unroll
        for (int bj = 0; bj < 2; ++bj)
#pragma unroll
        for (int ai = 0; ai < 2; ++ai)
        {
            const int col = col0 + bj * HALF;
            u32x4 av[4], bv[4];
#pragma unroll
            for (int m = 0; m < 4; ++m) { const size_t row = (size_t)(row0 + ai * HALF + m * 16); av[m] = *(const u32x4*)(G + row * 2048 + col); bv[m] = *(const u32x4*)(G + row * 2048 + 1024 + col); }
#pragma unroll
            for (int m = 0; m < 4; ++m) {
                f32x4 r0, r1;
                r0[0] = (1.f + em_(__uint_as_float(bv[m][0] << 16))) * __builtin_amdgcn_rcpf(1.f + em_(__uint_as_float(av[m][0] << 16)));
                r0[1] = (1.f + em_(__uint_as_float(bv[m][0] & 0xffff0000u))) * __builtin_amdgcn_rcpf(1.f + em_(__uint_as_float(av[m][0] & 0xffff0000u)));
                r0[2] = (1.f + em_(__uint_as_float(bv[m][1] << 16))) * __builtin_amdgcn_rcpf(1.f + em_(__uint_as_float(av[m][1] << 16)));
                r0[3] = (1.f + em_(__uint_as_float(bv[m][1] & 0xffff0000u))) * __builtin_amdgcn_rcpf(1.f + em_(__uint_as_float(av[m][1] & 0xffff0000u)));
                r1[0] = (1.f + em_(__uint_as_float(bv[m][2] << 16))) * __builtin_amdgcn_rcpf(1.f + em_(__uint_as_float(av[m][2] << 16)));
                r1[1] = (1.f + em_(__uint_as_float(bv[m][2] & 0xffff0000u))) * __builtin_amdgcn_rcpf(1.f + em_(__uint_as_float(av[m][2] & 0xffff0000u)));
                r1[2] = (1.f + em_(__uint_as_float(bv[m][3] << 16))) * __builtin_amdgcn_rcpf(1.f + em_(__uint_as_float(av[m][3] << 16)));
                r1[3] = (1.f + em_(__uint_as_float(bv[m][3] & 0xffff0000u))) * __builtin_amdgcn_rcpf(1.f + em_(__uint_as_float(av[m][3] & 0xffff0000u)));
                acc[ai][bj][m][0] = acc[ai][bj][m][0] * r0; acc[ai][bj][m][1] = acc[ai][bj][m][1] * r1;
            }
            __builtin_amdgcn_sched_barrier(0);
        }
    }
    __device__ __forceinline__ void operator()(const f32x4 (&acc)[2][2][4][2], const Unit& u, int wr, int wc, int fr, int fq) const {
        const int row0 = u.pm * BM + wr * 64 + fr, col0 = u.pn * BM + wc * 32 + 8 * fq;
#pragma unroll
        for (int bj = 0; bj < 2; ++bj)
#pragma unroll
        for (int ai = 0; ai < 2; ++ai) {
            const int col = col0 + bj * HALF;
            u32x4 bv[4];
#pragma unroll
            for (int m = 0; m < 4; ++m) bv[m] = *(const u32x4*)(G + (size_t)(row0 + ai * HALF + m * 16) * 2048 + 1024 + col);
#pragma unroll
            for (int m = 0; m < 4; ++m) { const f32x4 v0 = acc[ai][bj][m][0], v1 = acc[ai][bj][m][1]; const u32x4 g = bv[m];
                float r[8];
                r[0] = v0[0] * __builtin_amdgcn_rcpf(1.f + em_(__uint_as_float(g.x << 16))); r[1] = v0[1] * __builtin_amdgcn_rcpf(1.f + em_(__uint_as_float(g.x & 0xffff0000u)));
                r[2] = v0[2] * __builtin_amdgcn_rcpf(1.f + em_(__uint_as_float(g.y << 16))); r[3] = v0[3] * __builtin_amdgcn_rcpf(1.f + em_(__uint_as_float(g.y & 0xffff0000u)));
                r[4] = v1[0] * __builtin_amdgcn_rcpf(1.f + em_(__uint_as_float(g.z << 16))); r[5] = v1[1] * __builtin_amdgcn_rcpf(1.f + em_(__uint_as_float(g.z & 0xffff0000u)));
                r[6] = v1[2] * __builtin_amdgcn_rcpf(1.f + em_(__uint_as_float(g.w << 16))); r[7] = v1[3] * __builtin_amdgcn_rcpf(1.f + em_(__uint_as_float(g.w & 0xffff0000u)));
                u32x4 w; w.x = cvt_pk_bf16(r[0], r[1]); w.y = cvt_pk_bf16(r[2], r[3]); w.z = cvt_pk_bf16(r[4], r[5]); w.w = cvt_pk_bf16(r[6], r[7]);
                *(u32x4*)(MG + (size_t)(row0 + ai * HALF + m * 16) * 1024 + col) = w; }
        }
    }
};
struct EpiF32 {
    static constexpr bool PERM = true, AFTER_DRAIN = false, HAS_MID = false;
    float* O; int ldc;
    __device__ __forceinline__ void operator()(const f32x4 (&acc)[2][2][4][2], const Unit& u, int wr, int wc, int fr, int fq) const {
        const int row0 = u.pm * BM + wr * 64 + fr, col0 = u.pn * BM + wc * 32 + 8 * fq;
#pragma unroll
        for (int ai = 0; ai < 2; ++ai)
#pragma unroll
            for (int m = 0; m < 4; ++m) { float* rowp = O + (size_t)(row0 + ai * HALF + m * 16) * ldc + col0;
#pragma unroll
                for (int bj = 0; bj < 2; ++bj) { *(f32x4*)(rowp + bj * HALF) = acc[ai][bj][m][0]; *(f32x4*)(rowp + bj * HALF + 4) = acc[ai][bj][m][1]; } }
    }
};
struct EpiOut {
    static constexpr bool PERM = true, AFTER_DRAIN = false, HAS_MID = false;
    const float* x; const float* g1; float* out; int seq;
    __device__ __forceinline__ void operator()(const f32x4 (&acc)[2][2][4][2], const Unit& u, int wr, int wc, int fr, int fq) const {
        const int row0 = u.pm * BM + wr * 64 + fr, col0 = u.pn * BM + wc * 32 + 8 * fq;
        const float* gp = g1 + (u.pm * BM >= seq ? 6144 : 0);
#pragma unroll
        for (int bj = 0; bj < 2; ++bj) { const int col = col0 + bj * HALF; const f32x4 ga = *(const f32x4*)(gp + col), gb = *(const f32x4*)(gp + col + 4);
#pragma unroll
            for (int ai = 0; ai < 2; ++ai) {
                f32x4 xa[4], xb[4];
#pragma unroll
                for (int m = 0; m < 4; ++m) { const size_t off = (size_t)(row0 + ai * HALF + m * 16) * 1024 + col; xa[m] = *(const f32x4*)(x + off); xb[m] = *(const f32x4*)(x + off + 4); }
#pragma unroll
                for (int m = 0; m < 4; ++m) { const size_t off = (size_t)(row0 + ai * HALF + m * 16) * 1024 + col;
                    *(f32x4*)(out + off) = xa[m] + ga * acc[ai][bj][m][0]; *(f32x4*)(out + off + 4) = xb[m] + gb * acc[ai][bj][m][1]; } } }
    }
};

template <class Epi, class Sched, bool ALIGN_EPI = false, bool SP2 = false>
__device__ __forceinline__ void gemm_phase(PG8_LAS unsigned char* lds, const Gemm g, const Sched& S, const Epi& E) {
    const int tid = threadIdx.x, wid = __builtin_amdgcn_readfirstlane(tid >> 6), lane = tid & 63, wr = wid >> 2, wc = wid & 3, fr = lane & 15, fq = lane >> 4;
    const int K = g.K, nt = K / BK;
    unsigned voffA[2], voffB[2];
#pragma unroll
    for (int i = 0; i < 2; ++i) { int R, C; stage_rc(tid * 16 + i * 8192, R, C); const int Rb = Epi::PERM ? ((R & ~31) + perm32(R & 31)) : R;
        voffA[i] = (unsigned)(R * g.lda + C) * 2u; voffB[i] = (unsigned)(Rb * g.ldb + C) * 2u; }
    const size_t kstep = (size_t)(BK * 2);
    const size_t hstepA = (size_t)HALF * g.lda * 2, hstepB = (size_t)HALF * g.ldb * 2;
    const size_t tstepA = 2 * hstepA, tstepB = 2 * hstepB;
    const unsigned ldsw = (unsigned)wid * 1024u;
    const int aoff = lds_byte(wr * 64 + fr, fq * 8), boff = lds_byte(wc * 32 + fr, fq * 8);
#define PG8_SA(b, h) (((b) * 2 + (h)) * HTB)
#define PG8_SB(b, h) ((4 + (b) * 2 + (h)) * HTB)
#define PG8_STAGE(bufoff, gbase, voff) do { _Pragma("unroll") for (int _i = 0; _i < 2; ++_i) \
        __builtin_amdgcn_global_load_lds((const unsigned*)((const char*)(gbase) + (voff)[_i]), (PG8_LAS unsigned*)(lds + (bufoff) + ldsw + _i * 8192), 16, 0, 0); } while (0)
#define PG8_LDA(dst, b, h) do { _Pragma("unroll") for (int m = 0; m < 4; ++m) _Pragma("unroll") for (int k = 0; k < 2; ++k) dst[m][k] = *(const PG8_LAS bf16x8*)(lds + PG8_SA(b, h) + aoff + m * 2048 + k * 1024); } while (0)
#define PG8_LDB(dst, b, h) do { _Pragma("unroll") for (int n = 0; n < 2; ++n) _Pragma("unroll") for (int k = 0; k < 2; ++k) dst[n][k] = *(const PG8_LAS bf16x8*)(lds + PG8_SB(b, h) + boff + n * 2048 + k * 1024); } while (0)
#define PG8_MMA(ai, bj, At, Bt) do { __builtin_amdgcn_s_setprio(1); _Pragma("unroll") for (int m = 0; m < 4; ++m) _Pragma("unroll") for (int n = 0; n < 2; ++n) _Pragma("unroll") for (int k = 0; k < 2; ++k) \
        acc[ai][bj][m][n] = __builtin_amdgcn_mfma_f32_16x16x32_bf16(Bt[n][k], At[m][k], acc[ai][bj][m][n], 0, 0, 0); __builtin_amdgcn_s_setprio(0); } while (0)
#define PG8_WAIT_V(n) asm volatile("s_waitcnt vmcnt(" #n ")" ::: "memory")
#define PG8_WAIT_L(n) asm volatile("s_waitcnt lgkmcnt(" #n ")" ::: "memory")
#define PG8_BAR __builtin_amdgcn_s_barrier()
#define PG8_SCHED __builtin_amdgcn_sched_barrier(0)
    Unit cur, nxt; int ui = 0;
    if (!S.next(0, cur)) return;
    f32x4 acc[2][2][4][2];
#pragma unroll
    for (int a = 0; a < 2; ++a)
#pragma unroll
        for (int b = 0; b < 2; ++b)
#pragma unroll
            for (int m = 0; m < 4; ++m)
#pragma unroll
                for (int n = 0; n < 2; ++n) acc[a][b][m][n] = (f32x4){0.f, 0.f, 0.f, 0.f};
    bf16x8 At[4][2], B0[2][2], B1[2][2];
    const char* cA = (const char*)g.A + (size_t)cur.pm * tstepA; const char* cB = (const char*)g.Bt + (size_t)cur.pn * tstepB;
    const char* cA2 = g.A2 ? (const char*)g.A2 + (size_t)cur.pm * tstepA : nullptr;
    S.a_ready(cur);
    if constexpr (SP2) {
        PG8_STAGE(PG8_SB(0, 0), cB, voffB); PG8_STAGE(PG8_SB(0, 1), cB + hstepB, voffB); PG8_STAGE(PG8_SA(0, 0), cA, voffA); PG8_STAGE(PG8_SA(0, 1), cA + hstepA, voffA);
        if (wr == 1) PG8_BAR;
        PG8_WAIT_V(2); PG8_BAR;
        PG8_STAGE(PG8_SB(1, 0), cB + kstep, voffB); PG8_STAGE(PG8_SA(1, 0), cA + kstep, voffA); PG8_STAGE(PG8_SB(1, 1), cB + hstepB + kstep, voffB);
        PG8_WAIT_V(6); PG8_BAR;
    } else {
        PG8_STAGE(PG8_SB(0, 0), cB, voffB); PG8_STAGE(PG8_SA(0, 0), cA, voffA); PG8_STAGE(PG8_SB(0, 1), cB + hstepB, voffB); PG8_STAGE(PG8_SA(0, 1), cA + hstepA, voffA);
        if (wr == 1) PG8_BAR;
        PG8_WAIT_V(4); PG8_BAR;
        PG8_STAGE(PG8_SB(1, 0), cB + kstep, voffB); PG8_STAGE(PG8_SA(1, 0), cA + kstep, voffA); PG8_STAGE(PG8_SB(1, 1), cB + hstepB + kstep, voffB);
        PG8_WAIT_V(6); PG8_BAR;
    }
    for (;;) {
        const bool has_next = S.next(ui + 1, nxt);
        const char* nA = has_next ? (const char*)g.A + (size_t)nxt.pm * tstepA : cA; const char* nB = has_next ? (const char*)g.Bt + (size_t)nxt.pn * tstepB : cB;
        const int tspan = Epi::HAS_MID ? (nt >> 1) : nt;
        for (int tb = 0; tb < nt; tb += tspan) {
        if constexpr (Epi::HAS_MID) { if (tb != 0) E.mid(acc, cur, wr, wc, fr, fq); }
        for (int t = tb; t < tb + tspan; t += 2) {
            const bool last = (t == nt - 2);
            const int hk = nt >> 1;
            const char* bA1 = (cA2 && t + 1 >= hk) ? cA2 - (size_t)hk * kstep : cA; const char* bA2 = (cA2 && t + 2 >= hk) ? cA2 - (size_t)hk * kstep : cA;
            const char* a1 = bA1 + (size_t)(t + 1) * kstep;
            const char* a2 = last ? nA : bA2 + (size_t)(t + 2) * kstep; const char* b2 = last ? nB : cB + (size_t)(t + 2) * kstep;
            const char* a3 = a2 + kstep; const char* b3 = b2 + kstep;
            if (last && has_next) S.a_ready(nxt);
            if constexpr (SP2) {
            PG8_LDB(B0, 0, 0); PG8_LDB(B1, 0, 1); PG8_SCHED; PG8_LDA(At, 0, 0); PG8_STAGE(PG8_SA(1, 1), a1 + hstepA, voffA);
            PG8_WAIT_V(8); PG8_WAIT_L(0); PG8_BAR; PG8_MMA(0, 0, At, B0); PG8_MMA(0, 1, At, B1); PG8_BAR; PG8_SCHED;
            PG8_LDA(At, 0, 1); PG8_STAGE(PG8_SB(0, 0), b2, voffB); PG8_STAGE(PG8_SB(0, 1), b2 + hstepB, voffB); PG8_STAGE(PG8_SA(0, 0), a2, voffA);
            PG8_WAIT_V(8); PG8_WAIT_L(0); PG8_BAR; PG8_MMA(1, 0, At, B0); PG8_MMA(1, 1, At, B1); PG8_BAR; PG8_SCHED;
            PG8_LDB(B0, 1, 0); PG8_LDB(B1, 1, 1); PG8_SCHED; PG8_LDA(At, 1, 0); PG8_STAGE(PG8_SA(0, 1), a2 + hstepA, voffA);
            PG8_WAIT_V(8); PG8_WAIT_L(0); PG8_BAR; PG8_MMA(0, 0, At, B0); PG8_MMA(0, 1, At, B1); PG8_BAR; PG8_SCHED;
            PG8_LDA(At, 1, 1); PG8_STAGE(PG8_SB(1, 0), b3, voffB); PG8_STAGE(PG8_SB(1, 1), b3 + hstepB, voffB); PG8_STAGE(PG8_SA(1, 0), a3, voffA);
            PG8_WAIT_V(8); PG8_WAIT_L(0); PG8_BAR; PG8_MMA(1, 0, At, B0); PG8_MMA(1, 1, At, B1); PG8_BAR; PG8_SCHED;
            } else {
            PG8_LDB(B0, 0, 0); PG8_SCHED; PG8_LDA(At, 0, 0); PG8_STAGE(PG8_SA(1, 1), a1 + hstepA, voffA);
            PG8_WAIT_L(8); PG8_BAR; PG8_WAIT_L(0); PG8_MMA(0, 0, At, B0); PG8_BAR; PG8_SCHED;
            PG8_LDB(B1, 0, 1); PG8_STAGE(PG8_SB(0, 0), b2, voffB);
            PG8_BAR; PG8_WAIT_L(0); PG8_MMA(0, 1, At, B1); PG8_BAR;
            PG8_LDA(At, 0, 1); PG8_STAGE(PG8_SA(0, 0), a2, voffA);
            PG8_BAR; PG8_WAIT_L(0); PG8_MMA(1, 0, At, B0); PG8_BAR; PG8_SCHED;
            PG8_STAGE(PG8_SB(0, 1), b2 + hstepB, voffB);
            PG8_WAIT_V(6); PG8_BAR; PG8_MMA(1, 1, At, B1); PG8_BAR;
            PG8_LDB(B0, 1, 0); PG8_SCHED; PG8_LDA(At, 1, 0); PG8_STAGE(PG8_SA(0, 1), a2 + hstepA, voffA);
            PG8_WAIT_L(8); PG8_BAR; PG8_WAIT_L(0); PG8_MMA(0, 0, At, B0); PG8_BAR; PG8_SCHED;
            PG8_LDB(B1, 1, 1); PG8_STAGE(PG8_SB(1, 0), b3, voffB);
            PG8_BAR; PG8_WAIT_L(0); PG8_MMA(0, 1, At, B1); PG8_BAR;
            PG8_LDA(At, 1, 1); PG8_STAGE(PG8_SA(1, 0), a3, voffA);
            PG8_BAR; PG8_WAIT_L(0); PG8_MMA(1, 0, At, B0); PG8_BAR; PG8_SCHED;
            PG8_STAGE(PG8_SB(1, 1), b3 + hstepB, voffB);
            PG8_WAIT_V(6); PG8_BAR; PG8_MMA(1, 1, At, B1); PG8_BAR;
            }
        }
        }
        if constexpr (ALIGN_EPI) { if (wr == 0) PG8_BAR; }
        if constexpr (!Epi::AFTER_DRAIN) { E(acc, cur, wr, wc, fr, fq); S.done(cur); }
        if (!has_next) break;
#pragma unroll
        for (int a = 0; a < 2; ++a)
#pragma unroll
            for (int b = 0; b < 2; ++b)
#pragma unroll
                for (int m = 0; m < 4; ++m)
#pragma unroll
                    for (int n = 0; n < 2; ++n) acc[a][b][m][n] = (f32x4){0.f, 0.f, 0.f, 0.f};
        cur = nxt; cA = nA; cB = nB; ++ui; cA2 = g.A2 ? (const char*)g.A2 + (size_t)cur.pm * tstepA : nullptr;
        if constexpr (ALIGN_EPI) { if (wr == 1) PG8_BAR; }
    }
    PG8_WAIT_V(0);
    if constexpr (!ALIGN_EPI) { if (wr == 0) PG8_BAR; }
    PG8_BAR;
    if constexpr (Epi::AFTER_DRAIN) { E.fused(acc, cur, wr, wc, fr, fq, lds, wid, lane); S.done(cur); }
#undef PG8_SA
#undef PG8_SB
#undef PG8_STAGE
#undef PG8_LDA
#undef PG8_LDB
#undef PG8_MMA
#undef PG8_WAIT_V
#undef PG8_WAIT_L
#undef PG8_BAR
#undef PG8_SCHED
}
}

DEV void stage_gemm_in(const Params& p, char* lds, int vb, int nvb) {
    pg8::Gemm g{(const bf16_t*)(p.ws + WS_UB), (const bf16_t*)(p.ws + WS_WIN), M, 4864, 1024, 1024, 1024};
    pg8::StaticOrder S; S.init(M, 4864, nvb, vb);
    pg8::EpiIn E{(bf16_t*)(p.ws + WS_PA), (bf16_t*)(p.ws + WS_PM), (bf16_t*)(p.ws + WS_PG)};
    pg8::gemm_phase<pg8::EpiIn, pg8::StaticOrder, true, true>((PG8_LAS unsigned char*)lds, g, S, E);
}
DEV void stage_gemm_merge(const Params& p, char* lds, int vb, int nvb) {
    pg8::Gemm g{(const bf16_t*)(p.ws + WS_AT), (const bf16_t*)(p.ws + WS_WA), M, 1024, 1024, 512, 1024, (const bf16_t*)(p.ws + WS_ML)};
    pg8::StaticOrder S; S.init(M, 1024, nvb, vb);
    pg8::EpiMergeF E{(const bf16_t*)(p.ws + WS_PG), (bf16_t*)(p.ws + WS_MG)};
    pg8::gemm_phase<pg8::EpiMergeF, pg8::StaticOrder, true, true>((PG8_LAS unsigned char*)lds, g, S, E);
}
DEV void stage_gemm_out(const Params& p, char* lds, int vb, int nvb) {
    pg8::Gemm g{(const bf16_t*)(p.ws + WS_MG), (const bf16_t*)(p.ws + WS_WOUT), M, 1024, 1024, 1024, 1024};
    pg8::StaticOrder S; S.init(M, 1024, nvb, vb);
    pg8::EpiOut E{p.x, (const float*)(p.ws + WS_MOD) + 2048, p.out, SEQ};
    pg8::gemm_phase<pg8::EpiOut, pg8::StaticOrder, true, true>((PG8_LAS unsigned char*)lds, g, S, E);
}

DEV void rope8(u32x4 x1, u32x4 x2, const float4* rp, float scale, u32x4& o1, u32x4& o2) {
#pragma unroll
    for (int w = 0; w < 4; ++w) {
        const float4 cs = rp[w];
        const float a0 = bflo(x1[w]), a1 = bfhi(x1[w]), b0 = bflo(x2[w]), b1 = bfhi(x2[w]);
        o1[w] = pk2((a0 * cs.x - b0 * cs.y) * scale, (a1 * cs.z - b1 * cs.w) * scale);
        o2[w] = pk2((b0 * cs.x + a0 * cs.y) * scale, (b1 * cs.z + a1 * cs.w) * scale);
    }
}

DEV void stage_attn(const Params& p, char* lds, int vb, int nvb) {
    const int tid = threadIdx.x, lane = tid & 63, wave = __builtin_amdgcn_readfirstlane(tid >> 6), fr = lane & 15, fq = lane >> 4;
    char* Ks = lds;
    char* VT = lds + 32768;
    char* Qs = lds + 70656;
    char* Ps = lds + 87040;
    bf16_t* PA = (bf16_t*)(p.ws + WS_PA);
    const float2* rope = (const float2*)(p.ws + WS_ROPE);
    for (int unit = vb; unit < 512; unit += nvb) {
        const int kvh = unit & 1, n = (unit >> 1) & 127, b = unit >> 8;
        __syncthreads();
        for (int task = tid; task < 1024; task += NTH) {
            const int ki = task >> 2, cp = task & 3, pos = 128 * (n - 1) + ki;
            u32x4 o1, o2;
            {
                const int pc = pos < 0 ? 0 : pos;
                const bf16_t* src = PA + (size_t)(b * SEQ + pc) * LPA + 512 + kvh * 64 + cp * 8;
                const u32x4 x1 = *(const u32x4*)src, x2 = *(const u32x4*)(src + 32);
                rope8(x1, x2, (const float4*)(rope + (size_t)pc * 32 + cp * 8), 1.0f, o1, o2);
                if (pos < 0) { o1 = (u32x4){0u, 0u, 0u, 0u}; o2 = o1; }
            }
            const int sw = ki & 7;
            *(u32x4*)(Ks + ki * 128 + ((cp ^ sw) << 4)) = o1;
            *(u32x4*)(Ks + ki * 128 + (((cp + 4) ^ sw) << 4)) = o2;
        }
        for (int task = tid; task < 2048; task += NTH) {
            const int ki = task >> 3, c = task & 7, pos = 128 * (n - 1) + ki;
            u32x4 x = *(const u32x4*)(PA + (size_t)(b * SEQ + (pos < 0 ? 0 : pos)) * LPA + 640 + kvh * 64 + c * 8);
            if (pos < 0) x = (u32x4){0u, 0u, 0u, 0u};
#pragma unroll
            for (int e = 0; e < 8; ++e) *(bf16_t*)(VT + (c * 8 + e) * 592 + ki * 2) = (bf16_t)((e & 1) ? (x[e >> 1] >> 16) : (x[e >> 1] & 0xffffu));
        }
        for (int i = tid; i < 64 * 40; i += NTH) { const int d = i / 40, kk = 256 + i % 40; *(bf16_t*)(VT + d * 592 + kk * 2) = 0; }
        for (int i = tid; i < 2048; i += NTH) { const int w = i >> 8, r = (i >> 4) & 15, kk = 144 + (i & 15); *(bf16_t*)(Ps + w * 5376 + r * 336 + kk * 2) = 0; }
        for (int j = 0; j < 4; ++j) {
            const int hq = kvh * 4 + j;
            {
                const int qi = tid >> 2, cp = tid & 3, pos = 128 * n + qi;
                const bf16_t* src = PA + (size_t)(b * SEQ + pos) * LPA + hq * 64 + cp * 8;
                const u32x4 x1 = *(const u32x4*)src, x2 = *(const u32x4*)(src + 32);
                u32x4 o1, o2;
                rope8(x1, x2, (const float4*)(rope + (size_t)pos * 32 + cp * 8), 0.125f, o1, o2);
                const int sw = qi & 7;
                *(u32x4*)(Qs + qi * 128 + ((cp ^ sw) << 4)) = o1;
                *(u32x4*)(Qs + qi * 128 + (((cp + 4) ^ sw) << 4)) = o2;
            }
            __syncthreads();
            f32x4 s[9];
            const int sw = fr & 7;
            bf16x8 qf[2];
#pragma unroll
            for (int ks = 0; ks < 2; ++ks) qf[ks] = *(const bf16x8*)(Qs + (16 * wave + fr) * 128 + (((fq + 4 * ks) ^ sw) << 4));
#pragma unroll
            for (int t = 0; t < 9; ++t) {
                s[t] = (f32x4){0.f, 0.f, 0.f, 0.f};
#pragma unroll
                for (int ks = 0; ks < 2; ++ks) { const bf16x8 kf = *(const bf16x8*)(Ks + (16 * (wave + t) + fr) * 128 + (((fq + 4 * ks) ^ sw) << 4)); s[t] = mfma16(kf, qf[ks], s[t]); }
            }
            const float sink = p.sinks[hq];
            float mx = sink;
#pragma unroll
            for (int t = 0; t < 9; ++t)
#pragma unroll
                for (int r = 0; r < 4; ++r) {
                    const int dd = 16 * t + 4 * fq + r - fr, ki = 16 * (wave + t) + 4 * fq + r;
                    const bool ok = (dd >= 1) && (dd <= 128) && (n > 0 || ki >= 128);
                    const float v = ok ? s[t][r] : -INFINITY;
                    s[t][r] = v; mx = fmaxf(mx, v);
                }
            mx = fmaxf(mx, __shfl_xor(mx, 16)); mx = fmaxf(mx, __shfl_xor(mx, 32));
            float sum = 0.f;
#pragma unroll
            for (int t = 0; t < 9; ++t)
#pragma unroll
                for (int r = 0; r < 4; ++r) { const float pv = __expf(s[t][r] - mx); s[t][r] = pv; sum += pv; }
            sum += __shfl_xor(sum, 16); sum += __shfl_xor(sum, 32);
            const float inv = 1.f / (sum + __expf(sink - mx));
            char* Pw = Ps + wave * 5376 + fr * 336;
#pragma unroll
            for (int t = 0; t < 9; ++t) { u32x2 o; o.x = pk2(s[t][0], s[t][1]); o.y = pk2(s[t][2], s[t][3]); *(u32x2*)(Pw + (16 * t + 4 * fq) * 2) = o; }
            __syncthreads();
            f32x4 o[4];
#pragma unroll
            for (int di = 0; di < 4; ++di) o[di] = (f32x4){0.f, 0.f, 0.f, 0.f};
#pragma unroll
            for (int ks = 0; ks < 5; ++ks) {
                const bf16x8 pf = *(const bf16x8*)(Pw + (32 * ks + 8 * fq) * 2);
#pragma unroll
                for (int di = 0; di < 4; ++di) { const bf16x8 vf = *(const bf16x8*)(VT + (16 * di + fr) * 592 + (16 * wave + 32 * ks + 8 * fq) * 2); o[di] = mfma16(vf, pf, o[di]); }
            }
            bf16_t* dst = (bf16_t*)(p.ws + WS_AT) + (size_t)(b * SEQ + 128 * n + 16 * wave + fr) * 512 + hq * 64 + 4 * fq;
#pragma unroll
            for (int di = 0; di < 4; ++di) { u32x2 w; w.x = pk2(o[di][0] * inv, o[di][1] * inv); w.y = pk2(o[di][2] * inv, o[di][3] * inv); *(u32x2*)(dst + 16 * di) = w; }
            __syncthreads();
        }
    }
}

DEV float logsigf(float x) { return fminf(x, 0.f) - log1pf(expf(-fabsf(x))); }

DEV void chunk_gates(const float* ipre, const float* fpre, int rowbase, int h, float* gs, int lane) {
    const int l0 = 2 * lane;
    const float i0 = ipre[(size_t)(rowbase + l0) * 4 + h], i1 = ipre[(size_t)(rowbase + l0 + 1) * 4 + h];
    const float lf0 = logsigf(fpre[(size_t)(rowbase + l0) * 4 + h]), lf1 = logsigf(fpre[(size_t)(rowbase + l0 + 1) * 4 + h]);
    const float pair = lf0 + lf1;
    float sc = pair;
#pragma unroll
    for (int o = 1; o < 64; o <<= 1) { const float t = __shfl_up(sc, o); if (lane >= o) sc += t; }
    const float b0 = (sc - pair) + lf0, b1 = b0 + lf1;
    const float g = __shfl(sc, 63);
    const float a0 = g - b0 + i0, a1 = g - b1 + i1;
    const float mloc = wave_max(fmaxf(a0, a1));
    const float ib0 = i0 - b0, ib1 = i1 - b1;
    float scm = fmaxf(ib0, ib1);
#pragma unroll
    for (int o = 1; o < 64; o <<= 1) { const float t = __shfl_up(scm, o); if (lane >= o) scm = fmaxf(scm, t); }
    float ex = __shfl_up(scm, 1); if (lane == 0) ex = -INFINITY;
    const float pm0 = fmaxf(ex, ib0), pm1 = fmaxf(pm0, ib1);
    gs[l0] = b0; gs[l0 + 1] = b1; gs[128 + l0] = ib0; gs[128 + l0 + 1] = ib1; gs[256 + l0] = a0; gs[256 + l0 + 1] = a1; gs[384 + l0] = pm0; gs[384 + l0 + 1] = pm1;
    if (lane == 0) { gs[512] = g; gs[513] = mloc; }
}

DEV void conv8(const bf16_t* PM, const float* cw, int b, int t, int pmcol, int cch, float (&out)[8]) {
#pragma unroll
    for (int e = 0; e < 8; ++e) out[e] = 0.f;
#pragma unroll
    for (int j = 0; j < 4; ++j) {
        const int tt = t - 3 + j; const int tc = tt < 0 ? 0 : tt; const float z = tt < 0 ? 0.f : 1.f;
        const u32x4 x = *(const u32x4*)(PM + (size_t)(b * SEQ + tc) * LPM + pmcol);
        float4 w0 = *(const float4*)(cw + j * 1024 + cch), w1 = *(const float4*)(cw + j * 1024 + cch + 4);
        w0.x *= z; w0.y *= z; w0.z *= z; w0.w *= z; w1.x *= z; w1.y *= z; w1.z *= z; w1.w *= z;
        out[0] += bflo(x[0]) * w0.x; out[1] += bfhi(x[0]) * w0.y; out[2] += bflo(x[1]) * w0.z; out[3] += bfhi(x[1]) * w0.w;
        out[4] += bflo(x[2]) * w1.x; out[5] += bfhi(x[2]) * w1.y; out[6] += bflo(x[3]) * w1.z; out[7] += bfhi(x[3]) * w1.w;
    }
}

DEV void conv8r(const u32x4 (&r)[4], const float* cwl, int ch8, int t, float (&out)[8]) {
#pragma unroll
    for (int e = 0; e < 8; ++e) out[e] = 0.f;
#pragma unroll
    for (int j = 0; j < 4; ++j) {
        const float z = (t - 3 + j) < 0 ? 0.f : 1.f;
        const float4 w0 = *(const float4*)(cwl + j * 128 + ch8), w1 = *(const float4*)(cwl + j * 128 + ch8 + 4);
        out[0] += bflo(r[j][0]) * (w0.x * z); out[1] += bfhi(r[j][0]) * (w0.y * z); out[2] += bflo(r[j][1]) * (w0.z * z); out[3] += bfhi(r[j][1]) * (w0.w * z);
        out[4] += bflo(r[j][2]) * (w1.x * z); out[5] += bfhi(r[j][2]) * (w1.y * z); out[6] += bflo(r[j][3]) * (w1.z * z); out[7] += bfhi(r[j][3]) * (w1.w * z);
    }
}
DEV float siluf_(float y) { return y * __builtin_amdgcn_rcpf(1.f + __expf(-y)); }

DEV void stage_mstate(const Params& p, char* lds, int vb, int nvb) {
    const int tid = threadIdx.x, lane = tid & 63, wave = __builtin_amdgcn_readfirstlane(tid >> 6), fr = lane & 15, fq = lane >> 4;
    char* KT = lds;
    char* VT = lds + 34816;
    float* gs = (float*)(lds + 69632); float* s_cw = (float*)(lds + 73728);
    const bf16_t* PM = (const bf16_t*)(p.ws + WS_PM);
    const float* ipre = (const float*)(p.ws + WS_IPRE); const float* fpre = (const float*)(p.ws + WS_FPRE);
    float* UT = (float*)(p.ws + WS_UB); float* NLOC = (float*)(p.ws + WS_NLOC);
    float* G = (float*)(p.ws + WS_CHG); float* MLOC = G + 1024;
    for (int unit = vb; unit < 1024; unit += nvb) {
        const int c = unit & 127, h = (unit >> 7) & 3, b = unit >> 9;
        const int rowbase = b * SEQ + c * 128;
        __syncthreads();
        if (wave == 0) chunk_gates(ipre, fpre, rowbase, h, gs, lane);
        else if (tid >= 64 && tid < 192) { const int d = tid - 64;
#pragma unroll
            for (int j = 0; j < 4; ++j) s_cw[j * 128 + d] = p.conv_w[j * 1024 + 512 + h * 128 + d]; }
        __syncthreads();
        const float mloc = gs[513];
        for (int task0 = tid; task0 < 2048; task0 += 2 * NTH) {
            u32x4 rk[2][4], xv[2];
#pragma unroll
            for (int u2 = 0; u2 < 2; ++u2) {
                const int task = task0 + u2 * NTH, l = task >> 4, ch = task & 15, t = c * 128 + l;
#pragma unroll
                for (int j = 0; j < 4; ++j) { const int tc = t - 3 + j < 0 ? 0 : t - 3 + j; rk[u2][j] = *(const u32x4*)(PM + (size_t)(b * SEQ + tc) * LPM + 512 + h * 128 + ch * 8); }
                xv[u2] = *(const u32x4*)(PM + (size_t)(rowbase + l) * LPM + 1024 + h * 128 + ch * 8);
            }
#pragma unroll
            for (int u2 = 0; u2 < 2; ++u2) {
                const int task = task0 + u2 * NTH, l = task >> 4, ch = task & 15, t = c * 128 + l;
                float v8[8]; conv8r(rk[u2], s_cw, ch * 8, t, v8);
                const float wgt = __expf(gs[256 + l] - mloc) * 0.08838834764831845f;
#pragma unroll
                for (int e = 0; e < 8; ++e) *(bf16_t*)(KT + (ch * 8 + e) * 272 + l * 2) = (bf16_t)f2bf(siluf_(v8[e]) * wgt);
                const u32x4 x = xv[u2];
#pragma unroll
                for (int e = 0; e < 8; ++e) *(bf16_t*)(VT + (ch * 8 + e) * 272 + l * 2) = (bf16_t)((e & 1) ? (x[e >> 1] >> 16) : (x[e >> 1] & 0xffffu));
            }
        }
        __syncthreads();
        f32x4 acc[8];
#pragma unroll
        for (int t = 0; t < 8; ++t) acc[t] = (f32x4){0.f, 0.f, 0.f, 0.f};
#pragma unroll
        for (int ks = 0; ks < 4; ++ks) {
            const bf16x8 vf = *(const bf16x8*)(VT + (16 * wave + fr) * 272 + (32 * ks + 8 * fq) * 2);
#pragma unroll
            for (int t = 0; t < 8; ++t) { const bf16x8 kf = *(const bf16x8*)(KT + (16 * t + fr) * 272 + (32 * ks + 8 * fq) * 2); acc[t] = mfma16(kf, vf, acc[t]); }
        }
        float* UTu = UT + (size_t)unit * 16384 + (16 * wave + fr) * 128 + 4 * fq;
#pragma unroll
        for (int t = 0; t < 8; ++t) *(f32x4*)(UTu + 16 * t) = acc[t];
        if (tid < 128) { float s = 0.f; for (int l = 0; l < 128; ++l) s += bf2f(*(const bf16_t*)(KT + tid * 272 + l * 2)); NLOC[unit * 128 + tid] = s; }
        if (tid == 0) { G[unit] = gs[512]; MLOC[unit] = mloc; }
    }
}

DEV void stage_mscan(const Params& p, char* lds, int vb, int nvb) {
    const int tid = threadIdx.x;
    float* s_dec = (float*)lds; float* s_scl = s_dec + 128;
    const float* UT = (const float*)(p.ws + WS_UB); const float* NLOC = (const float*)(p.ws + WS_NLOC);
    const float* G = (const float*)(p.ws + WS_CHG); const float* MLOC = G + 1024; float* MST = (float*)(p.ws + WS_CHG) + 2048;
    bf16_t* CST = (bf16_t*)(p.ws + WS_CST); float* NST = (float*)(p.ws + WS_NST);
    for (int item = vb; item < 256; item += nvb) {
        const int bh = item >> 5, part = item & 31;
        __syncthreads();
        float* s_g = s_dec + 256; float* s_ml = s_dec + 384; float* s_m = s_dec + 512;
        if (tid < 128) { s_g[tid] = G[bh * 128 + tid]; s_ml[tid] = MLOC[bh * 128 + tid]; }
        __syncthreads();
        if (tid == 0) { float m = 0.f; for (int c = 0; c < 128; ++c) { s_m[c] = m; m = fmaxf(s_g[c] + m, s_ml[c]); } s_m[128] = m; }
        __syncthreads();
        if (tid < 128) { const float m = s_m[tid], mn = s_m[tid + 1]; s_dec[tid] = expf(s_g[tid] + m - mn); s_scl[tid] = expf(s_ml[tid] - mn); if (part == 0) MST[bh * 128 + tid] = m; }
        __syncthreads();
        const int e = part * 512 + tid;
        float C = 0.f;
        const float* up = UT + (size_t)bh * 128 * 16384 + e; bf16_t* cp = CST + (size_t)bh * 128 * 16384 + e;
        for (int c = 0; c < 128; c += 32) {
            float uu[32];
#pragma unroll
            for (int i = 0; i < 32; ++i) uu[i] = up[(size_t)(c + i) * 16384];
#pragma unroll
            for (int i = 0; i < 32; ++i) { cp[(size_t)(c + i) * 16384] = (bf16_t)f2bf(C); C = s_dec[c + i] * C + s_scl[c + i] * uu[i]; }
        }
        if (part == 0 && tid < 128) {
            float nn = 0.f;
            for (int c = 0; c < 128; c += 32) {
                float nv[32];
#pragma unroll
                for (int i = 0; i < 32; ++i) nv[i] = NLOC[(bh * 128 + c + i) * 128 + tid];
#pragma unroll
                for (int i = 0; i < 32; ++i) { NST[(bh * 128 + c + i) * 128 + tid] = nn; nn = s_dec[c + i] * nn + s_scl[c + i] * nv[i]; }
            }
        }
    }
}

DEV void stage_mout(const Params& p, char* lds, int vb, int nvb) {
    const int tid = threadIdx.x, lane = tid & 63, wave = __builtin_amdgcn_readfirstlane(tid >> 6), fr = lane & 15, fq = lane >> 4;
    char* Qs = lds; char* Ks = lds + 34816; char* VT = lds + 69632; char* CT = lds + 104448;
    float* gs = (float*)(lds + 139264); float* s_nst = gs + 520; float* s_mo = gs + 648; float* s_wi = gs + 776; float* s_cw = (float*)(lds + 143360);
    bf16_t* PM = (bf16_t*)(p.ws + WS_PM);
    const float* ipre = (const float*)(p.ws + WS_IPRE); const float* fpre = (const float*)(p.ws + WS_FPRE);
    const float* MST = (const float*)(p.ws + WS_CHG) + 2048; const float* NST = (const float*)(p.ws + WS_NST);
    const bf16_t* CST = (const bf16_t*)(p.ws + WS_CST);
    for (int unit = vb; unit < 1024; unit += nvb) {
        const int c = unit & 127, h = (unit >> 7) & 3, b = unit >> 9;
        const int rowbase = b * SEQ + c * 128;
        __syncthreads();
        if (tid < 256) { const int d = tid & 127, kq = tid >> 7;
#pragma unroll
            for (int j = 0; j < 4; ++j) s_cw[kq * 512 + j * 128 + d] = p.conv_w[j * 1024 + kq * 512 + h * 128 + d]; }
        __syncthreads();
        if (wave == 0) chunk_gates(ipre, fpre, rowbase, h, gs, lane);
        for (int task0 = tid; task0 < 2048; task0 += 2 * NTH) {
            u32x4 rq[2][4], rk[2][4], xv[2], cstv[2];
#pragma unroll
            for (int u2 = 0; u2 < 2; ++u2) {
                const int task = task0 + u2 * NTH, l = task >> 4, ch = task & 15, t = c * 128 + l;
#pragma unroll
                for (int j = 0; j < 4; ++j) { const int tc = t - 3 + j < 0 ? 0 : t - 3 + j; const bf16_t* rp = PM + (size_t)(b * SEQ + tc) * LPM + h * 128 + ch * 8; rq[u2][j] = *(const u32x4*)rp; rk[u2][j] = *(const u32x4*)(rp + 512); }
                xv[u2] = *(const u32x4*)(PM + (size_t)(rowbase + l) * LPM + 1024 + h * 128 + ch * 8);
                cstv[u2] = *(const u32x4*)(CST + (size_t)unit * 16384 + l * 128 + ch * 8);
            }
#pragma unroll
            for (int u2 = 0; u2 < 2; ++u2) {
                const int task = task0 + u2 * NTH, l = task >> 4, ch = task & 15, t = c * 128 + l;
                float v8[8]; u32x4 o;
                conv8r(rq[u2], s_cw, ch * 8, t, v8);
                o.x = pk2(siluf_(v8[0]), siluf_(v8[1])); o.y = pk2(siluf_(v8[2]), siluf_(v8[3])); o.z = pk2(siluf_(v8[4]), siluf_(v8[5])); o.w = pk2(siluf_(v8[6]), siluf_(v8[7]));
                *(u32x4*)(Qs + l * 272 + ch * 16) = o;
                conv8r(rk[u2], s_cw + 512, ch * 8, t, v8);
                const float sc = 0.08838834764831845f;
                o.x = pk2(siluf_(v8[0]) * sc, siluf_(v8[1]) * sc); o.y = pk2(siluf_(v8[2]) * sc, siluf_(v8[3]) * sc); o.z = pk2(siluf_(v8[4]) * sc, siluf_(v8[5]) * sc); o.w = pk2(siluf_(v8[6]) * sc, siluf_(v8[7]) * sc);
                *(u32x4*)(Ks + l * 272 + ch * 16) = o;
                const u32x4 x = xv[u2];
#pragma unroll
                for (int e = 0; e < 8; ++e) *(bf16_t*)(VT + (ch * 8 + e) * 272 + l * 2) = (bf16_t)((e & 1) ? (x[e >> 1] >> 16) : (x[e >> 1] & 0xffffu));
                *(u32x4*)(CT + l * 272 + ch * 16) = cstv[u2];
            }
        }
        if (tid < 128) s_nst[tid] = NST[unit * 128 + tid];
        __syncthreads();
        if (tid < 128) { const float mst = MST[unit]; const float bc = gs[tid]; const float mo = bc + fmaxf(mst, gs[384 + tid]); s_mo[tid] = mo; s_wi[tid] = __expf(bc + mst - mo); }
        __syncthreads();
        const int l = 16 * wave + fr;
        f32x4 s[8];
        bf16x8 qf[4];
#pragma unroll
        for (int ks = 0; ks < 4; ++ks) qf[ks] = *(const bf16x8*)(Qs + l * 272 + (32 * ks + 8 * fq) * 2);
#pragma unroll
        for (int t = 0; t < 8; ++t) {
            s[t] = (f32x4){0.f, 0.f, 0.f, 0.f};
            if (t <= wave) {
#pragma unroll
                for (int ks = 0; ks < 4; ++ks) { const bf16x8 kf = *(const bf16x8*)(Ks + (16 * t + fr) * 272 + (32 * ks + 8 * fq) * 2); s[t] = mfma16(kf, qf[ks], s[t]); }
            }
        }
        const float bl = gs[l], mol = s_mo[l];
        float dsum = 0.f;
#pragma unroll
        for (int t = 0; t < 8; ++t)
#pragma unroll
            for (int r = 0; r < 4; ++r) {
                const int si = 16 * t + 4 * fq + r; float wv = 0.f;
                if (t <= wave && si <= l) wv = __expf(bl + gs[128 + si] - mol) * s[t][r];
                s[t][r] = wv; dsum += wv;
            }
        dsum += __shfl_xor(dsum, 16); dsum += __shfl_xor(dsum, 32);
        float qn = 0.f;
        {
            const char* qrow = Qs + l * 272 + fq * 64;
#pragma unroll
            for (int i = 0; i < 4; ++i) {
                const u32x4 x = *(const u32x4*)(qrow + 16 * i); const float* nn = s_nst + fq * 32 + 8 * i;
                qn += bflo(x[0]) * nn[0] + bfhi(x[0]) * nn[1] + bflo(x[1]) * nn[2] + bfhi(x[1]) * nn[3] + bflo(x[2]) * nn[4] + bfhi(x[2]) * nn[5] + bflo(x[3]) * nn[6] + bfhi(x[3]) * nn[7];
            }
        }
        qn += __shfl_xor(qn, 16); qn += __shfl_xor(qn, 32);
        __syncthreads();
#pragma unroll
        for (int t = 0; t < 8; ++t)
            if (t <= wave + 1) { u32x2 o; o.x = pk2(s[t][0], s[t][1]); o.y = pk2(s[t][2], s[t][3]); *(u32x2*)(Ks + l * 272 + (16 * t + 4 * fq) * 2) = o; }
        __syncthreads();
        f32x4 acc[8];
#pragma unroll
        for (int t = 0; t < 8; ++t) acc[t] = (f32x4){0.f, 0.f, 0.f, 0.f};
#pragma unroll
        for (int ks = 0; ks < 4; ++ks)
#pragma unroll
            for (int t = 0; t < 8; ++t) { const bf16x8 cf = *(const bf16x8*)(CT + (16 * t + fr) * 272 + (32 * ks + 8 * fq) * 2); acc[t] = mfma16(cf, qf[ks], acc[t]); }
        const float wi = s_wi[l];
#pragma unroll
        for (int t = 0; t < 8; ++t) acc[t] = acc[t] * wi;
        const int nks = (wave + 2) >> 1;
#pragma unroll
        for (int ks = 0; ks < 4; ++ks)
            if (ks < nks) {
                const bf16x8 wf = *(const bf16x8*)(Ks + l * 272 + (32 * ks + 8 * fq) * 2);
#pragma unroll
                for (int t = 0; t < 8; ++t) { const bf16x8 vf = *(const bf16x8*)(VT + (16 * t + fr) * 272 + (32 * ks + 8 * fq) * 2); acc[t] = mfma16(vf, wf, acc[t]); }
            }
        const float den = dsum + wi * qn;
        const float invd = 1.f / fmaxf(fabsf(den), __expf(-mol));
        bf16_t* mop = PM + (size_t)(rowbase + l) * LPM + 1536 + h * 128 + 4 * fq;
        float ssq = 0.f;
        u32x2 g2v[8]; float4 nwv[8];
#pragma unroll
        for (int t = 0; t < 8; ++t) { g2v[t] = *(const u32x2*)(mop + 16 * t); nwv[t] = *(const float4*)(p.mnorm_w + h * 128 + 16 * t + 4 * fq); }
#pragma unroll
        for (int t = 0; t < 8; ++t) {
            const u32x2 g2 = g2v[t];
            const float gg[4] = {bflo(g2.x), bfhi(g2.x), bflo(g2.y), bfhi(g2.y)};
#pragma unroll
            for (int r = 0; r < 4; ++r) { const float hv = acc[t][r] * invd * sigmoidf_(gg[r]); acc[t][r] = hv; ssq += hv * hv; }
        }
        ssq += __shfl_xor(ssq, 16); ssq += __shfl_xor(ssq, 32);
        const float rn = rsqrtf(ssq * (1.f / 128.f) + 1e-6f);
#pragma unroll
        for (int t = 0; t < 8; ++t) {
            const float4 nw = nwv[t];
            u32x2 o; o.x = pk2(acc[t][0] * rn * nw.x, acc[t][1] * rn * nw.y); o.y = pk2(acc[t][2] * rn * nw.z, acc[t][3] * rn * nw.w);
            *(u32x2*)((bf16_t*)(p.ws + WS_ML) + (size_t)(rowbase + l) * 512 + h * 128 + 4 * fq + 16 * t) = o;
        }
    }
}

DEV void stage_norm2(const Params& p, char* lds, int vb, int nvb) {
    const int tid = threadIdx.x, lane = tid & 63, wave = __builtin_amdgcn_readfirstlane(tid >> 6);
    const float* mod = (const float*)(p.ws + WS_MOD);
    bf16_t* U2 = (bf16_t*)(p.ws + WS_PG);
    const int rstride = nvb * NW;
    for (int mb = vb * NW + wave; mb < M; mb += 4 * rstride) {
        float4 vv[4][4];
#pragma unroll
        for (int rr = 0; rr < 4; ++rr) { const int mr = mb + rr * rstride < M ? mb + rr * rstride : mb; const float4* xr = (const float4*)(p.out + (size_t)mr * D);
#pragma unroll
            for (int j = 0; j < 4; ++j) vv[rr][j] = xr[lane + 64 * j]; }
#pragma unroll
        for (int rr = 0; rr < 4; ++rr) {
            const int m = mb + rr * rstride;
            if (m < M) {
                const int b = m >= SEQ ? 1 : 0;
                float ss = 0.f;
#pragma unroll
                for (int j = 0; j < 4; ++j) { const float4 v = vv[rr][j]; ss += v.x * v.x + v.y * v.y + v.z * v.z + v.w * v.w; }
                ss = wave_sum(ss);
                const float rstd = rsqrtf(ss * (1.f / 1024.f) + 1e-6f);
#pragma unroll
                for (int j = 0; j < 4; ++j) {
                    const int col = 4 * (lane + 64 * j); const float4 v = vv[rr][j];
                    const float4 w1 = *(const float4*)(p.norm2_w + col), sc = *(const float4*)(mod + b * 6144 + 4096 + col), sh = *(const float4*)(mod + b * 6144 + 3072 + col);
                    u32x2 o;
                    o.x = pk2(v.x * rstd * w1.x * (1.f + sc.x) + sh.x, v.y * rstd * w1.y * (1.f + sc.y) + sh.y);
                    o.y = pk2(v.z * rstd * w1.z * (1.f + sc.z) + sh.z, v.w * rstd * w1.w * (1.f + sc.w) + sh.w);
                    *(u32x2*)(U2 + (size_t)m * D + col) = o;
                }
            }
        }
    }
}

constexpr size_t WS_SELI = 400 * MiB;
constexpr size_t WS_SELG = 416 * MiB;
constexpr size_t WS_SC = 64 * MiB;
DEV unsigned f2ord(float f) { const unsigned u = __float_as_uint(f); return (u & 0x80000000u) ? ~u : (u | 0x80000000u); }
DEV float ord2f(unsigned k) { return __uint_as_float((k & 0x80000000u) ? (k ^ 0x80000000u) : ~k); }
DEV unsigned umax_(unsigned a, unsigned b) { return a > b ? a : b; }

DEV void stage_gemm_q(const Params& p, char* lds, int vb, int nvb) {
    pg8::Gemm g{(const bf16_t*)(p.ws + WS_PG), (const bf16_t*)(p.ws + WS_WQ), M, 2048, 1024, 1024, 1024};
    pg8::StaticOrder S; S.init(M, 2048, nvb, vb);
    pg8::EpiF32 E{(float*)(p.ws + WS_SC), 2048};
    pg8::gemm_phase<pg8::EpiF32, pg8::StaticOrder, true, true>((PG8_LAS unsigned char*)lds, g, S, E);
}

DEV unsigned umin_(unsigned a, unsigned b) { return a < b ? a : b; }
template <int N> DEV void bitonic_sort_desc(unsigned (&a)[N]) {
#pragma unroll
    for (int k = 2; k <= N; k <<= 1)
#pragma unroll
        for (int j = k >> 1; j > 0; j >>= 1)
#pragma unroll
            for (int i = 0; i < N; ++i) { const int l = i ^ j; if (l > i) { const unsigned x = a[i], y = a[l]; const bool dsc = (i & k) == 0; a[i] = dsc ? umax_(x, y) : umin_(x, y); a[l] = dsc ? umin_(x, y) : umax_(x, y); } }
}
template <int N> DEV void bitonic_merge_desc(unsigned (&a)[N]) {
#pragma unroll
    for (int j = N >> 1; j > 0; j >>= 1)
#pragma unroll
        for (int i = 0; i < N; ++i) { const int l = i ^ j; if (l > i) { const unsigned x = a[i], y = a[l]; a[i] = umax_(x, y); a[l] = umin_(x, y); } }
}
template <bool X16> DEV void merge_top16_xlane(unsigned (&x)[16], int lane) {
    unsigned m[16];
#pragma unroll
    for (int i = 0; i < 16; ++i) {
        unsigned pv;
        if (X16) { auto r = __builtin_amdgcn_permlane16_swap(x[15 - i], x[15 - i], false, false); pv = (lane & 16) ? r[0] : r[1]; }
        else { auto r = __builtin_amdgcn_permlane32_swap(x[15 - i], x[15 - i], false, false); pv = (lane & 32) ? r[0] : r[1]; }
        m[i] = umax_(x[i], pv);
    }
    bitonic_merge_desc<16>(m);
#pragma unroll
    for (int i = 0; i < 16; ++i) x[i] = m[i];
}

DEV void stage_q_topk(const Params& p, char* lds, int vb, int nvb) {
    const int tid = threadIdx.x, lane = tid & 63, wave = __builtin_amdgcn_readfirstlane(tid >> 6), fr = lane & 15, fq = lane >> 4;
    unsigned* tops = (unsigned*)lds;
    unsigned char* ptab = (unsigned char*)(lds + 16384);
    const float* SC = (const float*)(p.ws + WS_SC);
    int* SELI = (int*)(p.ws + WS_SELI); float* SELG = (float*)(p.ws + WS_SELG);
    __syncthreads();
    if (tid < 64) { int cnt = 0; unsigned char v = 0xff; for (int i = 0; i < 16; ++i) for (int j = 0; j < 16 / (i + 1); ++j) { if (cnt == tid) v = (unsigned char)(i | (j << 4)); ++cnt; } ptab[tid] = v; }
    __syncthreads();
    pg8::StaticOrder SO; SO.init(M, 2048, nvb, vb);
    for (int it2 = 0;; ++it2) {
        pg8::Unit un; if (!SO.next(it2 >> 1, un)) break;
        const int mt = un.pm * 2 + (it2 & 1), h = un.pn, m0 = mt * 128;
        const float* srow = SC + (size_t)(m0 + 16 * wave + fr) * 2048 + h * 256 + 4 * fq;
        f32x4 sv[2][8];
#pragma unroll
        for (int pp = 0; pp < 2; ++pp)
#pragma unroll
            for (int t = 0; t < 8; ++t) sv[pp][t] = *(const f32x4*)(srow + pp * 128 + 16 * t);
        unsigned* tp = tops + (16 * wave + fr) * 32;
#pragma unroll
        for (int pp = 0; pp < 2; ++pp) {
            unsigned lo[16], hi[16];
#pragma unroll
            for (int t = 0; t < 4; ++t)
#pragma unroll
                for (int r = 0; r < 4; ++r) {
                    lo[4 * t + r] = (f2ord(sv[pp][t][r]) & ~127u) | (127u - (unsigned)(16 * t + 4 * fq + r));
                    hi[4 * t + r] = (f2ord(sv[pp][t + 4][r]) & ~127u) | (127u - (unsigned)(16 * (t + 4) + 4 * fq + r));
                }
            bitonic_sort_desc<16>(lo); bitonic_sort_desc<16>(hi);
#pragma unroll
            for (int i = 0; i < 16; ++i) lo[i] = umax_(lo[i], hi[15 - i]);
            bitonic_merge_desc<16>(lo);
            merge_top16_xlane<true>(lo, lane); merge_top16_xlane<false>(lo, lane);
            if (fq == 0) {
#pragma unroll
                for (int q = 0; q < 4; ++q) *(u32x4*)(tp + pp * 16 + 4 * q) = (u32x4){lo[4 * q], lo[4 * q + 1], lo[4 * q + 2], lo[4 * q + 3]};
            }
        }
        wave_lds_sync();
        unsigned ck[16];
#pragma unroll
        for (int sl = 0; sl < 13; ++sl) {
            const unsigned pr = ptab[4 * sl + fq]; const unsigned i = pr & 15u, j = pr >> 4;
            const float sum = ord2f(tp[i] & ~127u) + ord2f(tp[16 + (j & 15u)] & ~127u);
            ck[sl] = pr != 0xffu ? ((f2ord(sum) & ~255u) | (255u - (i * 16u + j))) : 0u;
        }
        ck[13] = 0u; ck[14] = 0u; ck[15] = 0u;
        bitonic_sort_desc<16>(ck);
        merge_top16_xlane<true>(ck, lane); merge_top16_xlane<false>(ck, lane);
        const float v0 = ord2f(ck[0] & ~255u);
        float ex[16], sm = 0.f;
#pragma unroll
        for (int r = 0; r < 16; ++r) { ex[r] = __expf(ord2f(ck[r] & ~255u) - v0); sm += ex[r]; }
        const float rs = 1.f / sm;
        int oi[4]; float og[4];
#pragma unroll
        for (int q = 0; q < 4; ++q) {
            const unsigned w = fq == 0 ? ck[q] : (fq == 1 ? ck[4 + q] : (fq == 2 ? ck[8 + q] : ck[12 + q]));
            const float e = fq == 0 ? ex[q] : (fq == 1 ? ex[4 + q] : (fq == 2 ? ex[8 + q] : ex[12 + q]));
            const unsigned flat = 255u - (w & 255u); const unsigned ia = flat >> 4, jb = flat & 15u;
            oi[q] = (int)((127u - (tp[ia] & 127u)) * 128u + (127u - (tp[16 + jb] & 127u)));
            og[q] = e * rs;
        }
        const size_t so = (size_t)(m0 + 16 * wave + fr) * 128 + h * 16 + 4 * fq;
        *(int4*)(SELI + so) = make_int4(oi[0], oi[1], oi[2], oi[3]);
        *(float4*)(SELG + so) = make_float4(og[0], og[1], og[2], og[3]);
        wave_lds_sync();
    }
}

DEV float dpp_row_sum(float v) {
    v += __int_as_float(__builtin_amdgcn_update_dpp(0, __float_as_int(v), 0xB1, 0xF, 0xF, true));
    v += __int_as_float(__builtin_amdgcn_update_dpp(0, __float_as_int(v), 0x4E, 0xF, 0xF, true));
    v += __int_as_float(__builtin_amdgcn_update_dpp(0, __float_as_int(v), 0x141, 0xF, 0xF, true));
    v += __int_as_float(__builtin_amdgcn_update_dpp(0, __float_as_int(v), 0x140, 0xF, 0xF, true));
    return v;
}
DEV int dpp_row_isum(int v) {
    v += __builtin_amdgcn_update_dpp(0, v, 0xB1, 0xF, 0xF, true); v += __builtin_amdgcn_update_dpp(0, v, 0x4E, 0xF, 0xF, true);
    v += __builtin_amdgcn_update_dpp(0, v, 0x141, 0xF, 0xF, true); v += __builtin_amdgcn_update_dpp(0, v, 0x140, 0xF, 0xF, true);
    return v;
}
DEV float dpp_row_max(float v) {
    v = fmaxf(v, __int_as_float(__builtin_amdgcn_update_dpp(0, __float_as_int(v), 0xB1, 0xF, 0xF, true))); v = fmaxf(v, __int_as_float(__builtin_amdgcn_update_dpp(0, __float_as_int(v), 0x4E, 0xF, 0xF, true)));
    v = fmaxf(v, __int_as_float(__builtin_amdgcn_update_dpp(0, __float_as_int(v), 0x141, 0xF, 0xF, true))); v = fmaxf(v, __int_as_float(__builtin_amdgcn_update_dpp(0, __float_as_int(v), 0x140, 0xF, 0xF, true)));
    return v;
}
DEV float gelu_as(float v) {
    const float av = fabsf(v), t = __builtin_amdgcn_rcpf(av * 0.2316418882f + 1.0f);
    float q = t * 0.5307027145f + (-0.7265760135f); q = q * t + 0.7107068705f; q = q * t + (-0.142248368f); q = q * t + 0.127414796f; q = q * t;
    const float e = __builtin_amdgcn_exp2f(v * v * (-0.72134752044f));
    const float m = v * (q * e);
    return v < 0.f ? m : v - m;
}
constexpr int NBIN = 16;
constexpr int GW_IDX = 0, GW_GATE = 1024, GW_SU = 3072, GW_SV = 5120, GW_W = 7168, GW_WQ = 9216, GW_BYTES = 9728;
DEV void g_sort_token(const int* SELI, const float* SELG, const float* SU, const float* SV, int tkn, char* wl, int j, int lane, int msk) {
    const int i0 = SELI[(size_t)tkn * 128 + lane] & msk, i1 = SELI[(size_t)tkn * 128 + 64 + lane] & msk;
    const float g0 = SELG[(size_t)tkn * 128 + lane], g1 = SELG[(size_t)tkn * 128 + 64 + lane];
    const float su0 = SU[i0], su1 = SU[i1], sv0 = SV[i0], sv1 = SV[i1];
    const int s0 = i0 >> 10, s1 = i1 >> 10;
    const unsigned long long lt = (1ull << lane) - 1ull;
    int base = 0, p0 = 0, p1 = 0;
#pragma unroll
    for (int s = 0; s < NBIN; ++s) {
        const unsigned long long m0 = __ballot(s0 == s), m1 = __ballot(s1 == s);
        const int c0 = __popcll(m0), c1 = __popcll(m1);
        if (s0 == s) p0 = base + __popcll(m0 & lt);
        if (s1 == s) p1 = base + c0 + __popcll(m1 & lt);
        base += c0 + c1;
    }
    unsigned short* li = (unsigned short*)(wl + GW_IDX) + j * 128; float* lg = (float*)(wl + GW_GATE) + j * 128; float* lsu = (float*)(wl + GW_SU) + j * 128; float* lsv = (float*)(wl + GW_SV) + j * 128;
    li[p0] = (unsigned short)i0; lg[p0] = g0; lsu[p0] = su0; lsv[p0] = sv0;
    li[p1] = (unsigned short)i1; lg[p1] = g1; lsu[p1] = su1; lsv[p1] = sv1;
}
DEV void r_load(u32x4 (&d)[4], const unsigned char* T, int id, int c) {
    const u32x4* q = (const u32x4*)(T + (size_t)id * 1024) + c;
#pragma unroll
    for (int k = 0; k < 4; ++k) d[k] = q[16 * k];
}
DEV int r_dotq(const u32x4 (&u)[4], const unsigned (&xq)[16]) {
    int s0 = 0, s1 = 0, s2 = 0, s3 = 0;
#pragma unroll
    for (int k = 0; k < 4; ++k) {
        s0 = __builtin_amdgcn_sdot4((int)u[k][0], (int)xq[4 * k], s0, false); s1 = __builtin_amdgcn_sdot4((int)u[k][1], (int)xq[4 * k + 1], s1, false);
        s2 = __builtin_amdgcn_sdot4((int)u[k][2], (int)xq[4 * k + 2], s2, false); s3 = __builtin_amdgcn_sdot4((int)u[k][3], (int)xq[4 * k + 3], s3, false);
    }
    return (s0 + s1) + (s2 + s3);
}
DEV float r_weight(int part, float sx, const char* wl, int r, int e) {
    const float d = (float)dpp_row_isum(part) * (((const float*)(wl + GW_SU))[r * 128 + e] * sx);
    return ((const float*)(wl + GW_GATE))[r * 128 + e] * gelu_as(d) * ((const float*)(wl + GW_SV))[r * 128 + e];
}
DEV void r_vaccq(const u32x4 (&v0)[4], const u32x4 (&v1)[4], const u32x4 (&v2)[4], const u32x4 (&v3)[4], unsigned wpk, int (&acc)[64]) {
#pragma unroll
    for (int k = 0; k < 4; ++k)
#pragma unroll
        for (int w = 0; w < 4; ++w) {
            const unsigned r0 = v0[k][w], r1 = v1[k][w], r2 = v2[k][w], r3 = v3[k][w];
            const unsigned p0 = __builtin_amdgcn_perm(r1, r0, 0x05010400u), p1 = __builtin_amdgcn_perm(r1, r0, 0x07030602u);
            const unsigned q0 = __builtin_amdgcn_perm(r3, r2, 0x05010400u), q1 = __builtin_amdgcn_perm(r3, r2, 0x07030602u);
            const unsigned t0 = __builtin_amdgcn_perm(q0, p0, 0x05040100u), t1 = __builtin_amdgcn_perm(q0, p0, 0x07060302u);
            const unsigned t2 = __builtin_amdgcn_perm(q1, p1, 0x05040100u), t3 = __builtin_amdgcn_perm(q1, p1, 0x07060302u);
            const int o = 16 * k + 4 * w;
            acc[o] = __builtin_amdgcn_sdot4((int)t0, (int)wpk, acc[o], false); acc[o + 1] = __builtin_amdgcn_sdot4((int)t1, (int)wpk, acc[o + 1], false);
            acc[o + 2] = __builtin_amdgcn_sdot4((int)t2, (int)wpk, acc[o + 2], false); acc[o + 3] = __builtin_amdgcn_sdot4((int)t3, (int)wpk, acc[o + 3], false);
        }
}
DEV void r_load2(u32x4 (&d)[2], const unsigned char* T, int id, int c, int hh) {
    const u32x4* q = (const u32x4*)(T + (size_t)id * 1024) + c + 32 * hh;
    d[0] = q[0]; d[1] = q[16];
}
template <int HH> DEV void r_vaccq2(const u32x4 (&v0)[2], const u32x4 (&v1)[2], const u32x4 (&v2)[2], const u32x4 (&v3)[2], unsigned wpk, int (&acc)[64]) {
#pragma unroll
    for (int kk = 0; kk < 2; ++kk)
#pragma unroll
        for (int w = 0; w < 4; ++w) {
            const unsigned r0 = v0[kk][w], r1 = v1[kk][w], r2 = v2[kk][w], r3 = v3[kk][w];
            const unsigned p0 = __builtin_amdgcn_perm(r1, r0, 0x05010400u), p1 = __builtin_amdgcn_perm(r1, r0, 0x07030602u);
            const unsigned q0 = __builtin_amdgcn_perm(r3, r2, 0x05010400u), q1 = __builtin_amdgcn_perm(r3, r2, 0x07030602u);
            const unsigned t0 = __builtin_amdgcn_perm(q0, p0, 0x05040100u), t1 = __builtin_amdgcn_perm(q0, p0, 0x07060302u);
            const unsigned t2 = __builtin_amdgcn_perm(q1, p1, 0x05040100u), t3 = __builtin_amdgcn_perm(q1, p1, 0x07060302u);
            const int o = 16 * (2 * HH + kk) + 4 * w;
            acc[o] = __builtin_amdgcn_sdot4((int)t0, (int)wpk, acc[o], false); acc[o + 1] = __builtin_amdgcn_sdot4((int)t1, (int)wpk, acc[o + 1], false);
            acc[o + 2] = __builtin_amdgcn_sdot4((int)t2, (int)wpk, acc[o + 2], false); acc[o + 3] = __builtin_amdgcn_sdot4((int)t3, (int)wpk, acc[o + 3], false);
        }
}
struct VB4 { u32x4 e0[2], e1[2], e2[2], e3[2]; };
DEV void vb_load(VB4& b, const unsigned char* TV, const unsigned short* myi, int g, int c, int hh) {
    const int e = g < 32 ? 4 * g : 124;
    r_load2(b.e0, TV, (int)myi[e], c, hh); r_load2(b.e1, TV, (int)myi[e + 1], c, hh); r_load2(b.e2, TV, (int)myi[e + 2], c, hh); r_load2(b.e3, TV, (int)myi[e + 3], c, hh);
}
template <int HH> DEV void pass2_half(const unsigned char* TV, const unsigned short* myi, const unsigned* lwq, int c, int (&acc)[64]) {
    VB4 ba, bb, bc, bd;
    vb_load(ba, TV, myi, 0, c, HH); vb_load(bb, TV, myi, 1, c, HH); vb_load(bc, TV, myi, 2, c, HH); vb_load(bd, TV, myi, 3, c, HH);
    for (int g = 0; g < 32; g += 4) {
        __builtin_amdgcn_sched_barrier(0); r_vaccq2<HH>(ba.e0, ba.e1, ba.e2, ba.e3, lwq[g], acc);     __builtin_amdgcn_sched_barrier(0); vb_load(ba, TV, myi, g + 4, c, HH);
        __builtin_amdgcn_sched_barrier(0); r_vaccq2<HH>(bb.e0, bb.e1, bb.e2, bb.e3, lwq[g + 1], acc); __builtin_amdgcn_sched_barrier(0); vb_load(bb, TV, myi, g + 5, c, HH);
        __builtin_amdgcn_sched_barrier(0); r_vaccq2<HH>(bc.e0, bc.e1, bc.e2, bc.e3, lwq[g + 2], acc); __builtin_amdgcn_sched_barrier(0); vb_load(bc, TV, myi, g + 6, c, HH);
        __builtin_amdgcn_sched_barrier(0); r_vaccq2<HH>(bd.e0, bd.e1, bd.e2, bd.e3, lwq[g + 3], acc); __builtin_amdgcn_sched_barrier(0); vb_load(bd, TV, myi, g + 7, c, HH);
        __builtin_amdgcn_sched_barrier(0);
    }
}
#define SB_() __builtin_amdgcn_sched_barrier(0)

DEV void stage_peer_gather(const Params& p, char* lds, int slot, int nslots, bool dry = false, int msk = 0x3fff) {
    const int tid = threadIdx.x, lane = tid & 63, wave = __builtin_amdgcn_readfirstlane(tid >> 6), r = lane >> 4, c = lane & 15;
    const bf16_t* U2 = (const bf16_t*)(p.ws + WS_PG);
    const unsigned char* TU = p.ws + WS_TU; const unsigned char* TV = p.ws + WS_TV;
    const float* SU = (const float*)(p.ws + WS_ISU); const float* SV = (const float*)(p.ws + WS_ISV);
    const int* SELI = (const int*)(p.ws + WS_SELI); const float* SELG = (const float*)(p.ws + WS_SELG);
    const float* mod = (const float*)(p.ws + WS_MOD);
    char* wl = lds + wave * GW_BYTES;
    const unsigned short* myi = (const unsigned short*)(wl + GW_IDX) + r * 128;
    float* lw = (float*)(wl + GW_W) + r * 128; unsigned* lwq = (unsigned*)(wl + GW_WQ) + r * 32;
    const int tpb = M / nslots;
    __syncthreads();
    for (int g0 = 0; g0 < tpb; g0 += 32) {
        __syncthreads();
        const int tbase = slot * tpb + g0 + 4 * wave;
#pragma unroll
        for (int j = 0; j < 4; ++j) g_sort_token(SELI, SELG, SU, SV, tbase + j, wl, j, lane, msk);
        const int tkn = tbase + r;
        unsigned xq[16]; float sx;
        {
            const bf16_t* xr = U2 + (size_t)tkn * D + 16 * c;
            u32x4 t[8]; float amax = 0.f;
#pragma unroll
            for (int k = 0; k < 8; ++k) { t[k] = *(const u32x4*)(xr + 256 * (k >> 1) + 8 * (k & 1));
#pragma unroll
                for (int i = 0; i < 4; ++i) amax = fmaxf(amax, fmaxf(fabsf(bflo(t[k][i])), fabsf(bfhi(t[k][i])))); }
            amax = dpp_row_max(amax);
            const float inv = amax > 0.f ? 127.f / amax : 0.f; sx = amax > 0.f ? amax * (1.f / 127.f) : 1.f;
#pragma unroll
            for (int k = 0; k < 8; ++k)
#pragma unroll
                for (int h2 = 0; h2 < 2; ++h2) {
                    const unsigned a = t[k][2 * h2], b = t[k][2 * h2 + 1];
                    const unsigned wv = ((unsigned)__float2int_rn(bflo(a) * inv) & 0xffu) | (((unsigned)__float2int_rn(bfhi(a) * inv) & 0xffu) << 8) | (((unsigned)__float2int_rn(bflo(b) * inv) & 0xffu) << 16) | ((unsigned)__float2int_rn(bfhi(b) * inv) << 24);
                    xq[2 * k + h2] = wv;
                }
        }
        wave_lds_sync();
        float wmax = 0.f;
#define P1H_DOT(buf, HH) (__builtin_amdgcn_sdot4((int)buf[0][0], (int)xq[8 * HH + 0], __builtin_amdgcn_sdot4((int)buf[0][2], (int)xq[8 * HH + 2], __builtin_amdgcn_sdot4((int)buf[1][0], (int)xq[8 * HH + 4], __builtin_amdgcn_sdot4((int)buf[1][2], (int)xq[8 * HH + 6], 0, false), false), false), false) \
                        + __builtin_amdgcn_sdot4((int)buf[0][1], (int)xq[8 * HH + 1], __builtin_amdgcn_sdot4((int)buf[0][3], (int)xq[8 * HH + 3], __builtin_amdgcn_sdot4((int)buf[1][1], (int)xq[8 * HH + 5], __builtin_amdgcn_sdot4((int)buf[1][3], (int)xq[8 * HH + 7], 0, false), false), false), false))
#define P1H_STEP(buf, off, HH) SB_(); const int pt##off = P1H_DOT(buf, HH); SB_(); r_load2(buf, TU, (int)myi[e + 8 + off < 128 ? e + 8 + off : 127], c, HH);
        {
            int* lp = (int*)lw;
            u32x4 h0[2], h1[2], h2[2], h3[2], h4[2], h5[2], h6[2], h7[2];
            r_load2(h0, TU, (int)myi[0], c, 0); r_load2(h1, TU, (int)myi[1], c, 0); r_load2(h2, TU, (int)myi[2], c, 0); r_load2(h3, TU, (int)myi[3], c, 0);
            r_load2(h4, TU, (int)myi[4], c, 0); r_load2(h5, TU, (int)myi[5], c, 0); r_load2(h6, TU, (int)myi[6], c, 0); r_load2(h7, TU, (int)myi[7], c, 0);
            for (int e = 0; e < 128; e += 8) {
                P1H_STEP(h0, 0, 0) P1H_STEP(h1, 1, 0) P1H_STEP(h2, 2, 0) P1H_STEP(h3, 3, 0) P1H_STEP(h4, 4, 0) P1H_STEP(h5, 5, 0) P1H_STEP(h6, 6, 0) P1H_STEP(h7, 7, 0)
                SB_();
                const int s0 = dpp_row_isum(pt0), s1 = dpp_row_isum(pt1), s2 = dpp_row_isum(pt2), s3 = dpp_row_isum(pt3), s4 = dpp_row_isum(pt4), s5 = dpp_row_isum(pt5), s6 = dpp_row_isum(pt6), s7 = dpp_row_isum(pt7);
                if (c == 0) { *(u32x4*)(lp + e) = (u32x4){(unsigned)s0, (unsigned)s1, (unsigned)s2, (unsigned)s3}; *(u32x4*)(lp + e + 4) = (u32x4){(unsigned)s4, (unsigned)s5, (unsigned)s6, (unsigned)s7}; }
            }
            wave_lds_sync();
            r_load2(h0, TU, (int)myi[0], c, 1); r_load2(h1, TU, (int)myi[1], c, 1); r_load2(h2, TU, (int)myi[2], c, 1); r_load2(h3, TU, (int)myi[3], c, 1);
            r_load2(h4, TU, (int)myi[4], c, 1); r_load2(h5, TU, (int)myi[5], c, 1); r_load2(h6, TU, (int)myi[6], c, 1); r_load2(h7, TU, (int)myi[7], c, 1);
            for (int e = 0; e < 128; e += 8) {
                P1H_STEP(h0, 0, 1) P1H_STEP(h1, 1, 1) P1H_STEP(h2, 2, 1) P1H_STEP(h3, 3, 1) P1H_STEP(h4, 4, 1) P1H_STEP(h5, 5, 1) P1H_STEP(h6, 6, 1) P1H_STEP(h7, 7, 1)
                SB_();
                const u32x4 pa = *(const u32x4*)(lp + e), pb = *(const u32x4*)(lp + e + 4);
                const float w0 = r_weight(pt0 + (c == 0 ? (int)pa[0] : 0), sx, wl, r, e), w1 = r_weight(pt1 + (c == 0 ? (int)pa[1] : 0), sx, wl, r, e + 1), w2 = r_weight(pt2 + (c == 0 ? (int)pa[2] : 0), sx, wl, r, e + 2), w3 = r_weight(pt3 + (c == 0 ? (int)pa[3] : 0), sx, wl, r, e + 3);
                const float w4 = r_weight(pt4 + (c == 0 ? (int)pb[0] : 0), sx, wl, r, e + 4), w5 = r_weight(pt5 + (c == 0 ? (int)pb[1] : 0), sx, wl, r, e + 5), w6 = r_weight(pt6 + (c == 0 ? (int)pb[2] : 0), sx, wl, r, e + 6), w7 = r_weight(pt7 + (c == 0 ? (int)pb[3] : 0), sx, wl, r, e + 7);
                wmax = fmaxf(fmaxf(wmax, fmaxf(fabsf(w0), fabsf(w1))), fmaxf(fabsf(w2), fabsf(w3)));
                wmax = fmaxf(fmaxf(wmax, fmaxf(fabsf(w4), fabsf(w5))), fmaxf(fabsf(w6), fabsf(w7)));
                if (c == 0) { *(f32x4*)(lw + e) = (f32x4){w0, w1, w2, w3}; *(f32x4*)(lw + e + 4) = (f32x4){w4, w5, w6, w7}; }
            }
        }
#undef P1H_STEP
#undef P1H_DOT
        __syncthreads();
        const float T = wmax > 0.f ? wmax * (1.f / 127.f) : 1.f, invT = wmax > 0.f ? 127.f / wmax : 0.f;
        wave_lds_sync();
#pragma unroll
        for (int h2 = 0; h2 < 2; ++h2) {
            const int gg = c + 16 * h2; const f32x4 wv = *(const f32x4*)(lw + 4 * gg);
            lwq[gg] = ((unsigned)__float2int_rn(wv[0] * invT) & 0xffu) | (((unsigned)__float2int_rn(wv[1] * invT) & 0xffu) << 8) | (((unsigned)__float2int_rn(wv[2] * invT) & 0xffu) << 16) | ((unsigned)__float2int_rn(wv[3] * invT) << 24);
        }
        wave_lds_sync();
        int acc[64];
#pragma unroll
        for (int i = 0; i < 64; ++i) acc[i] = 0;
        pass2_half<0>(TV, myi, lwq, c, acc);
        pass2_half<1>(TV, myi, lwq, c, acc);
        const int b = tkn >= SEQ ? 1 : 0;
        float* hr = p.out + (size_t)tkn * D + 16 * c;
        const float* g2p = mod + b * 6144 + 5120 + 16 * c;
        float y[64]; float ss = 0.f;
#pragma unroll
        for (int q = 0; q < 16; ++q) {
            const int eo = 256 * (q >> 2) + 4 * (q & 3);
            const float4 hv = *(const float4*)(hr + eo); const float4 g2 = *(const float4*)(g2p + eo);
            y[4 * q] = hv.x + g2.x * (T * (float)acc[4 * q]); y[4 * q + 1] = hv.y + g2.y * (T * (float)acc[4 * q + 1]);
            y[4 * q + 2] = hv.z + g2.z * (T * (float)acc[4 * q + 2]); y[4 * q + 3] = hv.w + g2.w * (T * (float)acc[4 * q + 3]);
            ss += y[4 * q] * y[4 * q] + y[4 * q + 1] * y[4 * q + 1] + y[4 * q + 2] * y[4 * q + 2] + y[4 * q + 3] * y[4 * q + 3];
        }
        ss = dpp_row_sum(ss);
        const float rstd = rsqrtf(ss * (1.f / 1024.f) + 1e-6f);
        float4 nwv[16];
#pragma unroll
        for (int q = 0; q < 16; ++q) nwv[q] = *(const float4*)(p.normf_w + 16 * c + 256 * (q >> 2) + 4 * (q & 3));
        if (!dry || rstd == 123.456f)
#pragma unroll
        for (int q = 0; q < 16; ++q) {
            const int eo = 256 * (q >> 2) + 4 * (q & 3);
            const float4 nw = nwv[q];
            float4 o; o.x = y[4 * q] * rstd * nw.x; o.y = y[4 * q + 1] * rstd * nw.y; o.z = y[4 * q + 2] * rstd * nw.z; o.w = y[4 * q + 3] * rstd * nw.w;
            *(float4*)(hr + eo) = o;
        }
        wave_lds_sync();
    }
}

#define LAS __attribute__((address_space(3)))
#define XB_TMO      128
#define XB_XCNT(j)  (256  + 64 * (j))
#define XB_XSUB(j)  (1280 + 64 * (j))
#define XB_XGEN(j)  (2304 + 64 * (j))
#define XB_TOP      3328
#define XB_TOPGEN   3392
#define XCD_BAR_WORDS 3456
#define XB_SPIN_CAP (1u << 18)

__device__ __forceinline__ unsigned xb_ld(unsigned* p)              { return __hip_atomic_load(p, __ATOMIC_RELAXED, __HIP_MEMORY_SCOPE_AGENT); }
__device__ __forceinline__ unsigned xb_add(unsigned* p, unsigned v) { return __hip_atomic_fetch_add(p, v, __ATOMIC_RELAXED, __HIP_MEMORY_SCOPE_AGENT); }
__device__ __forceinline__ unsigned xb_xcc_id() { return (unsigned)__builtin_amdgcn_s_getreg((3 << 11) | 20) & 0xFu; }
#define XB_SPIN(cond, bar) do { unsigned _sp = 0; while (cond) { __builtin_amdgcn_s_sleep(1); \
    if ((++_sp & 255u) == 0u) { if (xb_ld(&(bar)[XB_TMO])) break; if (_sp > XB_SPIN_CAP) { atomicAdd(&(bar)[XB_TMO], 1u); break; } } } } while (0)

struct XcdBarrier {
    unsigned* bar; unsigned x;
    volatile LAS unsigned* st;
};

__device__ __forceinline__ XcdBarrier xcd_barrier_post(unsigned* bar, volatile LAS unsigned* st) {
    XcdBarrier b; b.bar = bar; b.x = xb_xcc_id(); b.st = st;
    if (threadIdx.x == 0) (void)xb_add(&bar[XB_XCNT(b.x)], 1u);
    return b;
}
__device__ __forceinline__ void xcd_barrier_complete(unsigned* bar, unsigned x, unsigned& nloc, unsigned& nx) {
    const unsigned G = gridDim.x * gridDim.y * gridDim.z;
    unsigned sum, cnt, mine, sp = 0u;
    for (;;) {
        sum = 0u; cnt = 0u; mine = 0u;
#pragma unroll
        for (unsigned j = 0; j < 16; ++j) { const unsigned c = xb_ld(&bar[XB_XCNT(j)]); sum += c; cnt += (c > 0u) ? 1u : 0u; mine = (j == x) ? c : mine; }
        if (sum == G) break;
        __builtin_amdgcn_s_sleep(1);
        if ((++sp & 255u) == 0u) { if (xb_ld(&bar[XB_TMO])) break; if (sp > XB_SPIN_CAP) { atomicAdd(&bar[XB_TMO], 1u); break; } }
    }
    nloc = mine > 0u ? mine : 1u; nx = cnt > 0u ? cnt : 1u;
}

__device__ __forceinline__ void xcd_barrier(const XcdBarrier& b) {
    asm volatile("s_waitcnt vmcnt(0)" ::: "memory");
    __syncthreads();
    if (threadIdx.x == 0) {
        unsigned* bar = b.bar;
        __builtin_amdgcn_s_waitcnt(0);
        unsigned nloc = b.st[0], nx = b.st[1];
        if (nloc == 0u) { xcd_barrier_complete(bar, b.x, nloc, nx); b.st[0] = nloc; b.st[1] = nx; }
        const unsigned old = xb_add(&bar[XB_XSUB(b.x)], 1u);
        const unsigned gen = old / nloc;
        if (old + 1u == (gen + 1u) * nloc) {
            __builtin_amdgcn_fence(__ATOMIC_RELEASE, "agent");
            asm volatile("s_waitcnt vmcnt(0)" ::: "memory");
            const unsigned og = xb_add(&bar[XB_TOP], 1u);
            const unsigned tg = og / nx;
            if (og + 1u == (tg + 1u) * nx) xb_add(&bar[XB_TOPGEN], 1u);
            else XB_SPIN(xb_ld(&bar[XB_TOPGEN]) == tg, bar);
            __builtin_amdgcn_fence(__ATOMIC_ACQUIRE, "agent");
            xb_add(&bar[XB_XGEN(b.x)], 1u);
            asm volatile("s_waitcnt vmcnt(0)" ::: "memory");
        } else {
            XB_SPIN(xb_ld(&bar[XB_XGEN(b.x)]) == gen, bar);
            __builtin_amdgcn_fence(__ATOMIC_ACQUIRE, "agent");
            asm volatile("s_waitcnt vmcnt(0)" ::: "memory");
        }
    }
    __syncthreads();
}

namespace cg = cooperative_groups;
constexpr int LDS_BYTES = 151552;
constexpr int CW_RANK = XCD_BAR_WORDS;

constexpr int LDS_TOTAL = LDS_BYTES + 64;

__global__ void __launch_bounds__(512) k_mega(Params p) {
    extern __shared__ __attribute__((aligned(16))) char lds[];
    const int vb = blockIdx.x, nvb = gridDim.x;
    volatile LAS unsigned* bst = (volatile LAS unsigned*)((LAS char*)lds + LDS_BYTES);
    if (threadIdx.x < 16) bst[threadIdx.x] = 0u;
    __syncthreads();
    XcdBarrier bar = xcd_barrier_post((unsigned*)p.ws, bst);
    if (threadIdx.x == 0) bst[2] = xb_add((unsigned*)p.ws + CW_RANK + 64 * bar.x, 1u);
#define GRID_BAR() xcd_barrier(bar)
    stage_prep(p, lds, vb, nvb);        GRID_BAR();
    stage_norm1(p, lds, vb, nvb);       GRID_BAR();
    stage_gemm_in(p, lds, vb, nvb);     GRID_BAR();
    stage_attn(p, lds, vb, nvb);
    stage_mstate(p, lds, vb, nvb);      GRID_BAR();
    stage_mscan(p, lds, vb, nvb);       GRID_BAR();
    stage_mout(p, lds, vb, nvb);        GRID_BAR();
    stage_gemm_merge(p, lds, vb, nvb);  GRID_BAR();
    stage_gemm_out(p, lds, vb, nvb);    GRID_BAR();
    stage_norm2(p, lds, vb, nvb);       GRID_BAR();
    stage_gemm_q(p, lds, vb, nvb);      __syncthreads();
    stage_q_topk(p, lds, vb, nvb);      GRID_BAR();
    if (threadIdx.x == 0) { unsigned base = 0u; for (unsigned j = 0; j < bar.x; ++j) base += xb_ld((unsigned*)p.ws + XB_XCNT(j)); bst[3] = base + bst[2]; }
    __syncthreads();
    const int slot = (int)bst[3];
    stage_peer_gather(p, lds, slot < nvb ? slot : vb, nvb);
}

extern "C" void kernel_launch(void* const* d_in, const int* in_sizes, int n_in, void* d_out, int out_size, void* d_ws, size_t ws_size, hipStream_t stream) {
    if (n_in != 20 || ws_size < WS_END) { fprintf(stderr, "kernel_launch: unexpected n_in %d or ws_size %zu\n", n_in, ws_size); return; }
    static int grid_blocks = 0;
    if (!grid_blocks) {
        int dev = 0, cus = 0, per_cu = 0;
        (void)hipGetDevice(&dev);
        (void)hipDeviceGetAttribute(&cus, hipDeviceAttributeMultiprocessorCount, dev);
        (void)hipFuncSetAttribute((const void*)k_mega, hipFuncAttributeMaxDynamicSharedMemorySize, LDS_TOTAL);
        (void)hipOccupancyMaxActiveBlocksPerMultiprocessor(&per_cu, (const void*)k_mega, 512, LDS_TOTAL);
        if (per_cu < 1) { fprintf(stderr, "kernel_launch: occupancy query says %d blocks per CU\n", per_cu); per_cu = 1; }
        grid_blocks = cus * 1;
    }
    Params p{};
    p.x = (const float*)d_in[0]; p.c = (const float*)d_in[1]; p.w_ada = (const float*)d_in[2]; p.b_ada = (const float*)d_in[3]; p.norm1_w = (const float*)d_in[4];
    p.w_in = (const float*)d_in[5]; p.conv_w = (const float*)d_in[6]; p.sinks = (const float*)d_in[7]; p.i_bias = (const float*)d_in[8]; p.f_bias = (const float*)d_in[9];
    p.mnorm_w = (const float*)d_in[10]; p.w_a = (const float*)d_in[11]; p.w_b = (const float*)d_in[12]; p.w_out = (const float*)d_in[13]; p.norm2_w = (const float*)d_in[14];
    p.w_q = (const float*)d_in[15]; p.sub_keys = (const float*)d_in[16]; p.peer_u = (const float*)d_in[17]; p.peer_v = (const float*)d_in[18]; p.normf_w = (const float*)d_in[19];
    p.out = (float*)d_out; p.ws = (unsigned char*)d_ws;
    (void)hipMemsetAsync(d_ws, 0, 32768, stream);
    void* args[] = {&p};
    hipError_t e = hipLaunchCooperativeKernel((const void*)k_mega, dim3(grid_blocks), dim3(512), args, LDS_TOTAL, stream);
    if (e != hipSuccess) fprintf(stderr, "cooperative launch failed: %s (grid %d)\n", hipGetErrorString(e), grid_blocks);
}
```

```cpp
#include <hip/hip_runtime.h>
#include <hip/hip_cooperative_groups.h>
#include <stdint.h>
#include <stdio.h>

#define DEV __device__ __forceinline__
typedef unsigned short bf16_t;
typedef short bf16x8 __attribute__((ext_vector_type(8)));
typedef float f32x4 __attribute__((ext_vector_type(4)));
typedef unsigned u32x4 __attribute__((ext_vector_type(4)));
typedef unsigned u32x2 __attribute__((ext_vector_type(2)));

constexpr int BATCH = 2, SEQ = 16384, M = BATCH * SEQ, D = 1024;
constexpr int NTH = 512, NW = 8;
constexpr int LPA = 768, LPM = 2048, LPG = 2048;

struct Params {
    const float *x, *c, *w_ada, *b_ada, *norm1_w, *w_in, *conv_w, *sinks, *i_bias, *f_bias, *mnorm_w, *w_a, *w_b, *w_out, *norm2_w, *w_q, *sub_keys, *peer_u, *peer_v, *normf_w;
    float* out; unsigned char* ws;
};

constexpr size_t MiB = 1u << 20;
constexpr size_t WS_MOD = 1 * MiB;
constexpr size_t WS_IPRE = 2 * MiB;
constexpr size_t WS_FPRE = 2 * MiB + 512 * 1024;
constexpr size_t WS_CHG = 3 * MiB;
constexpr size_t WS_NLOC = 4 * MiB;
constexpr size_t WS_NST = 4 * MiB + 512 * 1024;
constexpr size_t WS_ROPE = 5 * MiB;
constexpr size_t WS_WIN = 10 * MiB;
constexpr size_t WS_WA = 20 * MiB;
constexpr size_t WS_WB = 21 * MiB;
constexpr size_t WS_WOUT = 22 * MiB;
constexpr size_t WS_WQ = 24 * MiB;
constexpr size_t WS_SK = 28 * MiB;
constexpr size_t WS_ISU = 29 * MiB;
constexpr size_t WS_ISV = 29 * MiB + 65536;
constexpr size_t WS_TU = 32 * MiB;
constexpr size_t WS_TV = 48 * MiB;
constexpr size_t WS_UB = 96 * MiB;
constexpr size_t WS_PA = 160 * MiB;
constexpr size_t WS_PM = 208 * MiB;
constexpr size_t WS_PG = 336 * MiB;
constexpr size_t WS_CST = 464 * MiB;
constexpr size_t WS_AT = 64 * MiB;
constexpr size_t WS_ML = 96 * MiB;
constexpr size_t WS_MG = 208 * MiB;
constexpr size_t WS_END = 496 * MiB;

DEV unsigned f2bf(float f) { unsigned u = __float_as_uint(f); return (u + 0x7fffu + ((u >> 16) & 1u)) >> 16; }
DEV unsigned pk2(float lo, float hi) { return f2bf(lo) | (f2bf(hi) << 16); }
DEV float bflo(unsigned u) { return __uint_as_float(u << 16); }
DEV float bfhi(unsigned u) { return __uint_as_float(u & 0xffff0000u); }
DEV float bf2f(bf16_t h) { return __uint_as_float(((unsigned)h) << 16); }
DEV float wave_sum(float v) {
#pragma unroll
    for (int o = 32; o > 0; o >>= 1) v += __shfl_xor(v, o);
    return v;
}
DEV float wave_max(float v) {
#pragma unroll
    for (int o = 32; o > 0; o >>= 1) v = fmaxf(v, __shfl_xor(v, o));
    return v;
}
DEV float sigmoidf_(float v) { return __builtin_amdgcn_rcpf(1.f + __expf(-v)); }
DEV f32x4 mfma16(bf16x8 a, bf16x8 b, f32x4 c) { return __builtin_amdgcn_mfma_f32_16x16x32_bf16(a, b, c, 0, 0, 0); }
DEV void wave_lds_sync() { __builtin_amdgcn_fence(__ATOMIC_ACQ_REL, "wavefront"); __builtin_amdgcn_wave_barrier(); }

DEV void transpose_item(const float* W, int ldw, int k0, int nsrc0, bf16_t* WT, int ldt, int ndst0, float* scr, int lane, int kdst_off = 0) {
#pragma unroll 8
    for (int i = 0; i < 32; ++i) { const int kk = 2 * i + (lane >> 5); scr[kk * 33 + (lane & 31)] = W[(size_t)(k0 + kk) * ldw + nsrc0 + (lane & 31)]; }
    wave_lds_sync();
    const int c = lane & 7;
#pragma unroll
    for (int j = 0; j < 4; ++j) {
        const int n = (lane >> 3) + 8 * j; const float* s = scr + (8 * c) * 33 + n;
        u32x4 o; o.x = pk2(s[0 * 33], s[1 * 33]); o.y = pk2(s[2 * 33], s[3 * 33]); o.z = pk2(s[4 * 33], s[5 * 33]); o.w = pk2(s[6 * 33], s[7 * 33]);
        *(u32x4*)(WT + (size_t)(ndst0 + n) * ldt + k0 + kdst_off + 8 * c) = o;
    }
    wave_lds_sync();
}

DEV void stage_prep(const Params& p, char* lds, int vb, int nvb) {
    const int tid = threadIdx.x, lane = tid & 63, wave = __builtin_amdgcn_readfirstlane(tid >> 6);
    float* mod = (float*)(p.ws + WS_MOD);
    float* s_act = (float*)lds;
    float* s_red = (float*)(lds + 8192);
    for (int i = tid; i < 2048; i += NTH) { const float v = p.c[i]; s_act[i] = v / (1.f + expf(-v)); }
    __syncthreads();
    for (int item = vb; item < 192; item += nvb) {
        const int kg = tid >> 5, cl = tid & 31, col = item * 32 + cl;
        float s0 = 0.f, s1 = 0.f;
        for (int k = kg; k < 1024; k += 16) { const float w = p.w_ada[(size_t)k * 6144 + col]; s0 += s_act[k] * w; s1 += s_act[1024 + k] * w; }
        s_red[(kg * 32 + cl) * 2] = s0; s_red[(kg * 32 + cl) * 2 + 1] = s1;
        __syncthreads();
        if (tid < 64) { const int b = tid >> 5, c2 = tid & 31; float s = 0.f; for (int g = 0; g < 16; ++g) s += s_red[(g * 32 + c2) * 2 + b]; mod[b * 6144 + item * 32 + c2] = s + p.b_ada[item * 32 + c2]; }
        __syncthreads();
    }
    float* scr = (float*)(lds + 16384 + wave * 8448);
    const int gw = vb * NW + wave, ngw = nvb * NW;
    bf16_t* Wt_in = (bf16_t*)(p.ws + WS_WIN); bf16_t* Wt_a = (bf16_t*)(p.ws + WS_WA); bf16_t* Wt_b = (bf16_t*)(p.ws + WS_WB);
    bf16_t* Wt_out = (bf16_t*)(p.ws + WS_WOUT); bf16_t* Wt_q = (bf16_t*)(p.ws + WS_WQ);
    for (int it = gw; it < 3456; it += ngw) {
        int r = it;
        if (r < 2432) { const int kb = r / 152, nb = r % 152; transpose_item(p.w_in, 4872, kb * 64, nb * 32 + (nb >= 88 ? 8 : 0), Wt_in, 1024, nb * 32, scr, lane); continue; } r -= 2432;
        if (r < 256) { const int kb = r / 32, nb = r % 32; transpose_item(p.w_a, 1024, kb * 64, nb * 32, Wt_a, 1024, nb * 32, scr, lane, 0); continue; } r -= 256;
        if (r < 256) { const int kb = r / 32, nb = r % 32; transpose_item(p.w_b, 1024, kb * 64, nb * 32, Wt_a, 1024, nb * 32, scr, lane, 512); continue; } r -= 256;
        { const int kb = r / 32, nb = r % 32; transpose_item(p.w_out, 1024, kb * 64, nb * 32, Wt_out, 1024, nb * 32, scr, lane); }
    }
    {
        float* WL = (float*)lds;
        float* KL = (float*)(lds + 33792);
        for (int item = vb; item < 256; item += nvb) {
            const int hp = item >> 4, k0 = (item & 15) * 64, pidx = hp & 1;
            __syncthreads();
            for (int i = tid; i < 64 * 32; i += NTH) { const int kk = i >> 5, d4 = i & 31; *(float4*)(WL + kk * 132 + 4 * d4) = *(const float4*)(p.w_q + (size_t)(k0 + kk) * 2048 + hp * 128 + 4 * d4); }
            for (int i = tid; i < 128 * 32; i += NTH) ((float4*)KL)[i] = ((const float4*)(p.sub_keys + (size_t)pidx * 16384))[i];
            __syncthreads();
            const int kk = tid & 63, n0 = (tid >> 6) * 16;
            float acc[16];
#pragma unroll
            for (int j = 0; j < 16; ++j) acc[j] = 0.f;
            for (int d4 = 0; d4 < 32; ++d4) {
                const float4 w = *(const float4*)(WL + kk * 132 + 4 * d4);
#pragma unroll
                for (int j = 0; j < 16; ++j) { const float4 kv = *(const float4*)(KL + (n0 + j) * 128 + 4 * d4); acc[j] += w.x * kv.x + w.y * kv.y + w.z * kv.z + w.w * kv.w; }
            }
#pragma unroll
            for (int j = 0; j < 16; ++j) Wt_q[(size_t)(hp * 128 + n0 + j) * 1024 + k0 + kk] = (bf16_t)f2bf(acc[j]);
        }
        __syncthreads();
    }
    const size_t gt = (size_t)vb * NTH + tid, ngt = (size_t)nvb * NTH;
    for (int rowb = gw; rowb < 32768; rowb += 4 * ngw) {
        float4 aa[4][4];
#pragma unroll
        for (int rr = 0; rr < 4; ++rr) { const int row = rowb + rr * ngw < 32768 ? rowb + rr * ngw : rowb; const float4* src = (const float4*)((row >= 16384 ? p.peer_v : p.peer_u) + (size_t)(row & 16383) * D) + lane;
#pragma unroll
            for (int i = 0; i < 4; ++i) aa[rr][i] = src[64 * i]; }
#pragma unroll
        for (int rr = 0; rr < 4; ++rr) {
            const int row = rowb + rr * ngw;
            if (row < 32768) {
                const bool isv = row >= 16384; const int r = row & 16383;
                float mx = 0.f;
#pragma unroll
                for (int i = 0; i < 4; ++i) mx = fmaxf(mx, fmaxf(fmaxf(fabsf(aa[rr][i].x), fabsf(aa[rr][i].y)), fmaxf(fabsf(aa[rr][i].z), fabsf(aa[rr][i].w))));
                mx = wave_max(mx);
                const float inv = mx > 0.f ? 127.f / mx : 0.f, sc = mx > 0.f ? mx * (1.f / 127.f) : 1.f;
                unsigned* dst = (unsigned*)(p.ws + (isv ? WS_TV : WS_TU) + (size_t)r * 1024) + lane;
#pragma unroll
                for (int i = 0; i < 4; ++i) dst[64 * i] = ((unsigned)__float2int_rn(aa[rr][i].x * inv) & 0xffu) | (((unsigned)__float2int_rn(aa[rr][i].y * inv) & 0xffu) << 8) | (((unsigned)__float2int_rn(aa[rr][i].z * inv) & 0xffu) << 16) | ((unsigned)__float2int_rn(aa[rr][i].w * inv) << 24);
                if (lane == 0) ((float*)(p.ws + (isv ? WS_ISV : WS_ISU)))[r] = sc;
            }
        }
    }
    for (size_t g = gt; g < 4096; g += ngt) {
        const float4 a = ((const float4*)p.sub_keys)[2 * g], b = ((const float4*)p.sub_keys)[2 * g + 1];
        u32x4 w; w.x = pk2(a.x, a.y); w.y = pk2(a.z, a.w); w.z = pk2(b.x, b.y); w.w = pk2(b.z, b.w);
        ((u32x4*)(p.ws + WS_SK))[g] = w;
    }
    float2* rope = (float2*)(p.ws + WS_ROPE);
    for (size_t e = gt; e < 16384 * 32; e += ngt) {
        const int pos = (int)(e >> 5), i = (int)(e & 31);
        const float inv = (float)exp2(-(double)i * (13.287712379549449 / 32.0));
        const float ang = (float)pos * inv;
        const double a = (double)ang; const double n = rint(a * 0.15915494309189535); const double r = a - n * 6.283185307179586;
        float s, c; sincosf((float)r, &s, &c);
        rope[e] = make_float2(c, s);
    }
}

DEV void stage_norm1(const Params& p, char* lds, int vb, int nvb) {
    const int tid = threadIdx.x, lane = tid & 63, wave = __builtin_amdgcn_readfirstlane(tid >> 6);
    float* wg = (float*)lds;
    for (int i = tid; i < 8192; i += NTH) { const int cc = i >> 10, k = i & 1023; wg[i] = p.w_in[(size_t)k * 4872 + 2816 + cc]; }
    __syncthreads();
    const float* mod = (const float*)(p.ws + WS_MOD);
    bf16_t* ub = (bf16_t*)(p.ws + WS_UB);
    float* ipre = (float*)(p.ws + WS_IPRE); float* fpre = (float*)(p.ws + WS_FPRE);
    const int rstride = nvb * NW;
    for (int mb = vb * NW + wave; mb < M; mb += 2 * rstride) {
        float4 vv[2][4];
#pragma unroll
        for (int rr = 0; rr < 2; ++rr) { const int mr = mb + rr * rstride < M ? mb + rr * rstride : mb; const float4* xr = (const float4*)(p.x + (size_t)mr * D);
#pragma unroll
            for (int j = 0; j < 4; ++j) vv[rr][j] = xr[lane + 64 * j]; }
#pragma unroll
        for (int rr = 0; rr < 2; ++rr) {
        const int m = mb + rr * rstride;
        if (m < M) {
        const int b = m >= SEQ ? 1 : 0;
        float4 v[4]; float ss = 0.f;
#pragma unroll
        for (int j = 0; j < 4; ++j) { v[j] = vv[rr][j]; ss += v[j].x * v[j].x + v[j].y * v[j].y + v[j].z * v[j].z + v[j].w * v[j].w; }
        ss = wave_sum(ss);
        const float rstd = rsqrtf(ss * (1.f / 1024.f) + 1e-6f);
        float ga[8];
#pragma unroll
        for (int cc = 0; cc < 8; ++cc) ga[cc] = 0.f;
#pragma unroll
        for (int j = 0; j < 4; ++j) {
            const int col = 4 * (lane + 64 * j);
            const float4 w1 = *(const float4*)(p.norm1_w + col), sc = *(const float4*)(mod + b * 6144 + 1024 + col), sh = *(const float4*)(mod + b * 6144 + col);
            float4 u;
            u.x = v[j].x * rstd * w1.x * (1.f + sc.x) + sh.x; u.y = v[j].y * rstd * w1.y * (1.f + sc.y) + sh.y;
            u.z = v[j].z * rstd * w1.z * (1.f + sc.z) + sh.z; u.w = v[j].w * rstd * w1.w * (1.f + sc.w) + sh.w;
            u32x2 o; o.x = pk2(u.x, u.y); o.y = pk2(u.z, u.w);
            *(u32x2*)(ub + (size_t)m * D + col) = o;
#pragma unroll
            for (int cc = 0; cc < 8; ++cc) { const float4 g = *(const float4*)(wg + cc * 1024 + col); ga[cc] += u.x * g.x + u.y * g.y + u.z * g.z + u.w * g.w; }
        }
        {
            const bool h32 = (lane & 32) != 0, h16 = (lane & 16) != 0, h8 = (lane & 8) != 0;
            float k4[4], k2[2];
#pragma unroll
            for (int i = 0; i < 4; ++i) k4[i] = (h32 ? ga[4 + i] : ga[i]) + __shfl_xor(h32 ? ga[i] : ga[4 + i], 32);
#pragma unroll
            for (int i = 0; i < 2; ++i) k2[i] = (h16 ? k4[2 + i] : k4[i]) + __shfl_xor(h16 ? k4[i] : k4[2 + i], 16);
            float k1 = (h8 ? k2[1] : k2[0]) + __shfl_xor(h8 ? k2[0] : k2[1], 8);
            k1 += __shfl_xor(k1, 4); k1 += __shfl_xor(k1, 2); k1 += __shfl_xor(k1, 1);
            const int cc = (lane >> 3) & 7;
            if ((lane & 7) == 0) { if (cc < 4) ipre[(size_t)m * 4 + cc] = k1 + p.i_bias[cc]; else fpre[(size_t)m * 4 + cc - 4] = k1 + p.f_bias[cc - 4]; }
        }
        }
        }
    }
}

namespace pg8 {
#define PG8_LAS __attribute__((address_space(3)))
typedef unsigned short bf16_t;
typedef short bf16x8 __attribute__((ext_vector_type(8)));
typedef float f32x4 __attribute__((ext_vector_type(4)));
typedef unsigned u32x4 __attribute__((ext_vector_type(4)));
constexpr int BM = 256, BK = 64, HALF = 128, HTB = HALF * BK * 2  , STAGE_BYTES = 8 * HTB, NXCD = 8, WGM = 8;

__host__ __device__ __forceinline__ int lds_byte(int r, int c) { const int st = (r >> 4) * 2 + (c >> 5), rr = r & 15, cc = c & 31, ob = rr * 64 + cc * 2; return st * 1024 + (ob ^ (((ob >> 9) & 1) << 5)); }
__host__ __device__ __forceinline__ void stage_rc(int b, int& R, int& C) { const int st = b / 1024, sb = b % 1024, swz = sb ^ (((sb >> 9) & 1) << 5); R = (st >> 1) * 16 + swz / 64; C = (st & 1) * 32 + (swz % 64) / 2; }
__host__ __device__ __forceinline__ int perm32(int rho) { const int n = rho >> 4, i = rho & 15; return 8 * (i >> 2) + 4 * n + (i & 3); }

struct Unit { int pm, pn; };
struct Gemm { const bf16_t* A; const bf16_t* Bt; int M, N, K, lda, ldb; const bf16_t* A2; };

struct StaticOrder {
    int nM, nN, nwg, G, c;
    __host__ __device__ void init(int M, int N, int G_, int c_) { nM = M / BM; nN = N / BM; nwg = nM * nN; G = G_; c = c_; }
    __host__ __device__ bool next(int i, Unit& u) const {
        const long L = (long)i * G + c; if (L >= nwg) return false;
        int wgid = (int)L; { const int q = nwg / NXCD, r = nwg % NXCD, xcd = wgid % NXCD, off = wgid / NXCD; wgid = (xcd < r ? xcd * (q + 1) : r * (q + 1) + (xcd - r) * q) + off; }
        const int nig = WGM * nN, gid = wgid / nig, fm = gid * WGM, gsz = (nM - fm) < WGM ? (nM - fm) : WGM;
        u.pm = fm + ((wgid % nig) % gsz); u.pn = (wgid % nig) / gsz; return true;
    }
    __device__ __forceinline__ void a_ready(const Unit&) const {}
    __device__ __forceinline__ void done(const Unit&) const {}
};

__device__ __forceinline__ unsigned cvt_pk_bf16(float lo, float hi) { unsigned r; asm volatile("v_cvt_pk_bf16_f32 %0, %1, %2" : "=v"(r) : "v"(lo), "v"(hi)); return r; }
__device__ __forceinline__ float sg_(float v) { return __builtin_amdgcn_rcpf(1.f + __expf(-v)); }
struct EpiIn {
    static constexpr bool PERM = true, AFTER_DRAIN = false, HAS_MID = false;
    bf16_t *PA, *PM, *PG;
    __device__ __forceinline__ void operator()(const f32x4 (&acc)[2][2][4][2], const Unit& u, int wr, int wc, int fr, int fq) const {
        const int colt = u.pn * BM; bf16_t* base; int ldc, cb;
        if (colt < 768) { base = PA; ldc = 768; cb = colt; } else if (colt < 2816) { base = PM; ldc = 2048; cb = colt - 768; } else { base = PG; ldc = 2048; cb = colt - 2816; }
        const int row0 = u.pm * BM + wr * 64 + fr, col0 = cb + wc * 32 + 8 * fq;
#pragma unroll
        for (int ai = 0; ai < 2; ++ai)
#pragma unroll
            for (int m = 0; m < 4; ++m) { bf16_t* rowp = base + (size_t)(row0 + ai * HALF + m * 16) * ldc + col0;
#pragma unroll
                for (int bj = 0; bj < 2; ++bj) { const f32x4 v0 = acc[ai][bj][m][0], v1 = acc[ai][bj][m][1];
                    u32x4 w; w.x = cvt_pk_bf16(v0[0], v0[1]); w.y = cvt_pk_bf16(v0[2], v0[3]); w.z = cvt_pk_bf16(v1[0], v1[1]); w.w = cvt_pk_bf16(v1[2], v1[3]);
                    *(u32x4*)(rowp + bj * HALF) = w; } }
    }
};
struct EpiMerge {
    static constexpr bool PERM = true, AFTER_DRAIN = false, HAS_MID = false;
    const bf16_t* G; bf16_t* MG; int second;
    __device__ __forceinline__ void operator()(const f32x4 (&acc)[2][2][4][2], const Unit& u, int wr, int wc, int fr, int fq) const {
        const int row0 = u.pm * BM + wr * 64 + fr, col0 = u.pn * BM + wc * 32 + 8 * fq;
#pragma unroll
        for (int bj = 0; bj < 2; ++bj)
#pragma unroll
        for (int ai = 0; ai < 2; ++ai) {
            const int col = col0 + bj * HALF;
            u32x4 gv[4], tv[4];
#pragma unroll
            for (int m = 0; m < 4; ++m) { const size_t row = (size_t)(row0 + ai * HALF + m * 16); gv[m] = *(const u32x4*)(G + row * 2048 + col); tv[m] = second ? *(const u32x4*)(MG + row * 1024 + col) : (u32x4){0u, 0u, 0u, 0u}; }
#pragma unroll
            for (int m = 0; m < 4; ++m) { const size_t row = (size_t)(row0 + ai * HALF + m * 16);
                const f32x4 v0 = acc[ai][bj][m][0], v1 = acc[ai][bj][m][1]; const u32x4 g = gv[m], t = tv[m];
                float r[8];
                r[0] = sg_(__uint_as_float(g.x << 16)) * v0[0] + __uint_as_float(t.x << 16); r[1] = sg_(__uint_as_float(g.x & 0xffff0000u)) * v0[1] + __uint_as_float(t.x & 0xffff0000u);
                r[2] = sg_(__uint_as_float(g.y << 16)) * v0[2] + __uint_as_float(t.y << 16); r[3] = sg_(__uint_as_float(g.y & 0xffff0000u)) * v0[3] + __uint_as_float(t.y & 0xffff0000u);
                r[4] = sg_(__uint_as_float(g.z << 16)) * v1[0] + __uint_as_float(t.z << 16); r[5] = sg_(__uint_as_float(g.z & 0xffff0000u)) * v1[1] + __uint_as_float(t.z & 0xffff0000u);
                r[6] = sg_(__uint_as_float(g.w << 16)) * v1[2] + __uint_as_float(t.w << 16); r[7] = sg_(__uint_as_float(g.w & 0xffff0000u)) * v1[3] + __uint_as_float(t.w & 0xffff0000u);
                u32x4 w; w.x = cvt_pk_bf16(r[0], r[1]); w.y = cvt_pk_bf16(r[2], r[3]); w.z = cvt_pk_bf16(r[4], r[5]); w.w = cvt_pk_bf16(r[6], r[7]);
                *(u32x4*)(MG + row * 1024 + col) = w; }
        }
    }
};
struct EpiMergeF {
    static constexpr bool PERM = true, AFTER_DRAIN = false, HAS_MID = true;
    const bf16_t* G; bf16_t* MG;
    static __device__ __forceinline__ float em_(float v) { return __expf(-fminf(fmaxf(v, -30.f), 30.f)); }
    __device__ __forceinline__ void mid(f32x4 (&acc)[2][2][4][2], const Unit& u, int wr, int wc, int fr, int fq) const {
        int row0 = u.pm * BM + wr * 64 + fr; const int col0 = u.pn * BM + wc * 32 + 8 * fq;
        asm volatile("" : "+v"(row0));
#pragma unroll
        for (int bj = 0; bj < 2; ++bj)
#pragma unroll
        for (int ai = 0; ai < 2; ++ai)
        {
            const int col = col0 + bj * HALF;
            u32x4 av[4], bv[4];
#pragma unroll
            for (int m = 0; m < 4; ++m) { const size_t row = (size_t)(row0 + ai * HALF + m * 16); av[m] = *(const u32x4*)(G + row * 2048 + col); bv[m] = *(const u32x4*)(G + row * 2048 + 1024 + col); }
#pragma unroll
            for (int m = 0; m < 4; ++m) {
                f32x4 r0, r1;
                r0[0] = (1.f + em_(__uint_as_float(bv[m][0] << 16))) * __builtin_amdgcn_rcpf(1.f + em_(__uint_as_float(av[m][0] << 16)));
                r0[1] = (1.f + em_(__uint_as_float(bv[m][0] & 0xffff0000u))) * __builtin_amdgcn_rcpf(1.f + em_(__uint_as_float(av[m][0] & 0xffff0000u)));
                r0[2] = (1.f + em_(__uint_as_float(bv[m][1] << 16))) * __builtin_amdgcn_rcpf(1.f + em_(__uint_as_float(av[m][1] << 16)));
                r0[3] = (1.f + em_(__uint_as_float(bv[m][1] & 0xffff0000u))) * __builtin_amdgcn_rcpf(1.f + em_(__uint_as_float(av[m][1] & 0xffff0000u)));
                r1[0] = (1.f + em_(__uint_as_float(bv[m][2] << 16))) * __builtin_amdgcn_rcpf(1.f + em_(__uint_as_float(av[m][2] << 16)));
                r1[1] = (1.f + em_(__uint_as_float(bv[m][2] & 0xffff0000u))) * __builtin_amdgcn_rcpf(1.f + em_(__uint_as_float(av[m][2] & 0xffff0000u)));
                r1[2] = (1.f + em_(__uint_as_float(bv[m][3] << 16))) * __builtin_amdgcn_rcpf(1.f + em_(__uint_as_float(av[m][3] << 16)));
                r1[3] = (1.f + em_(__uint_as_float(bv[m][3] & 0xffff0000u))) * __builtin_amdgcn_rcpf(1.f + em_(__uint_as_float(av[m][3] & 0xffff0000u)));
                acc[ai][bj][m][0] = acc[ai][bj][m][0] * r0; acc[ai][bj][m][1] = acc[ai][bj][m][1] * r1;
            }
            __builtin_amdgcn_sched_barrier(0);
        }
    }
    __device__ __forceinline__ void operator()(const f32x4 (&acc)[2][2][4][2], const Unit& u, int wr, int wc, int fr, int fq) const {
        const int row0 = u.pm * BM + wr * 64 + fr, col0 = u.pn * BM + wc * 32 + 8 * fq;
#pragma unroll
        for (int bj = 0; bj < 2; ++bj)
#pragma unroll
        for (int ai = 0; ai < 2; ++ai) {
            const int col = col0 + bj * HALF;
            u32x4 bv[4];
#pragma unroll
            for (int m = 0; m < 4; ++m) bv[m] = *(const u32x4*)(G + (size_t)(row0 + ai * HALF + m * 16) * 2048 + 1024 + col);
#pragma unroll
            for (int m = 0; m < 4; ++m) { const f32x4 v0 = acc[ai][bj][m][0], v1 = acc[ai][bj][m][1]; const u32x4 g = bv[m];
                float r[8];
                r[0] = v0[0] * __builtin_amdgcn_rcpf(1.f + em_(__uint_as_float(g.x << 16))); r[1] = v0[1] * __builtin_amdgcn_rcpf(1.f + em_(__uint_as_float(g.x & 0xffff0000u)));
                r[2] = v0[2] * __builtin_amdgcn_rcpf(1.f + em_(__uint_as_float(g.y << 16))); r[3] = v0[3] * __builtin_amdgcn_rcpf(1.f + em_(__uint_as_float(g.y & 0xffff0000u)));
                r[4] = v1[0] * __builtin_amdgcn_rcpf(1.f + em_(__uint_as_float(g.z << 16))); r[5] = v1[1] * __builtin_amdgcn_rcpf(1.f + em_(__uint_as_float(g.z & 0xffff0000u)));
                r[6] = v1[2] * __builtin_amdgcn_rcpf(1.f + em_(__uint_as_float(g.w << 16))); r[7] = v1[3] * __builtin_amdgcn_rcpf(1.f + em_(__uint_as_float(g.w & 0xffff0000u)));
                u32x4 w; w.x = cvt_pk_bf16(r[0], r[1]); w.y = cvt_pk_bf16(r[2], r[3]); w.z = cvt_pk_bf16(r[4], r[5]); w.w = cvt_pk_bf16(r[6], r[7]);
                *(u32x4*)(MG + (size_t)(row0 + ai * HALF + m * 16) * 1024 + col) = w; }
        }
    }
};
struct EpiF32 {
    static constexpr bool PERM = false, AFTER_DRAIN = false, HAS_MID = false;
    float* O; int ldc;
    __device__ __forceinline__ void operator()(const f32x4 (&acc)[2][2][4][2], const Unit& u, int wr, int wc, int fr, int fq) const {
        const int row0 = u.pm * BM + wr * 64 + fr, col0 = u.pn * BM + wc * 32 + 4 * fq;
#pragma unroll
        for (int ai = 0; ai < 2; ++ai)
#pragma unroll
            for (int m = 0; m < 4; ++m) { float* rowp = O + (size_t)(row0 + ai * HALF + m * 16) * ldc + col0;
#pragma unroll
                for (int bj = 0; bj < 2; ++bj) { *(f32x4*)(rowp + bj * HALF) = acc[ai][bj][m][0]; *(f32x4*)(rowp + bj * HALF + 16) = acc[ai][bj][m][1]; } }
    }
};
struct EpiOut {
    static constexpr bool PERM = false, AFTER_DRAIN = false, HAS_MID = false;
    const float* x; const float* g1; float* out; int seq;
    __device__ __forceinline__ void operator()(const f32x4 (&acc)[2][2][4][2], const Unit& u, int wr, int wc, int fr, int fq) const {
        const int row0 = u.pm * BM + wr * 64 + fr, col0 = u.pn * BM + wc * 32 + 4 * fq;
        const float* gp = g1 + (u.pm * BM >= seq ? 6144 : 0);
#pragma unroll
        for (int bj = 0; bj < 2; ++bj) { const int col = col0 + bj * HALF; const f32x4 ga = *(const f32x4*)(gp + col), gb = *(const f32x4*)(gp + col + 16);
#pragma unroll
            for (int ai = 0; ai < 2; ++ai) {
                f32x4 xa[4], xb[4];
#pragma unroll
                for (int m = 0; m < 4; ++m) { const size_t off = (size_t)(row0 + ai * HALF + m * 16) * 1024 + col; xa[m] = *(const f32x4*)(x + off); xb[m] = *(const f32x4*)(x + off + 16); }
#pragma unroll
                for (int m = 0; m < 4; ++m) { const size_t off = (size_t)(row0 + ai * HALF + m * 16) * 1024 + col;
                    *(f32x4*)(out + off) = xa[m] + ga * acc[ai][bj][m][0]; *(f32x4*)(out + off + 16) = xb[m] + gb * acc[ai][bj][m][1]; } } }
    }
};

template <class Epi, class Sched, bool ALIGN_EPI = false, bool SP2 = false>
__device__ __forceinline__ void gemm_phase(PG8_LAS unsigned char* lds, const Gemm g, const Sched& S, const Epi& E) {
    const int tid = threadIdx.x, wid = __builtin_amdgcn_readfirstlane(tid >> 6), lane = tid & 63, wr = wid >> 2, wc = wid & 3, fr = lane & 15, fq = lane >> 4;
    const int K = g.K, nt = K / BK;
    unsigned voffA[2], voffB[2];
#pragma unroll
    for (int i = 0; i < 2; ++i) { int R, C; stage_rc(tid * 16 + i * 8192, R, C); const int Rb = Epi::PERM ? ((R & ~31) + perm32(R & 31)) : R;
        voffA[i] = (unsigned)(R * g.lda + C) * 2u; voffB[i] = (unsigned)(Rb * g.ldb + C) * 2u; }
    const size_t kstep = (size_t)(BK * 2);
    const size_t hstepA = (size_t)HALF * g.lda * 2, hstepB = (size_t)HALF * g.ldb * 2;
    const size_t tstepA = 2 * hstepA, tstepB = 2 * hstepB;
    const unsigned ldsw = (unsigned)wid * 1024u;
    const int aoff = lds_byte(wr * 64 + fr, fq * 8), boff = lds_byte(wc * 32 + fr, fq * 8);
#define PG8_SA(b, h) (((b) * 2 + (h)) * HTB)
#define PG8_SB(b, h) ((4 + (b) * 2 + (h)) * HTB)
#define PG8_STAGE(bufoff, gbase, voff) do { _Pragma("unroll") for (int _i = 0; _i < 2; ++_i) \
        __builtin_amdgcn_global_load_lds((const unsigned*)((const char*)(gbase) + (voff)[_i]), (PG8_LAS unsigned*)(lds + (bufoff) + ldsw + _i * 8192), 16, 0, 0); } while (0)
#define PG8_LDA(dst, b, h) do { _Pragma("unroll") for (int m = 0; m < 4; ++m) _Pragma("unroll") for (int k = 0; k < 2; ++k) dst[m][k] = *(const PG8_LAS bf16x8*)(lds + PG8_SA(b, h) + aoff + m * 2048 + k * 1024); } while (0)
#define PG8_LDB(dst, b, h) do { _Pragma("unroll") for (int n = 0; n < 2; ++n) _Pragma("unroll") for (int k = 0; k < 2; ++k) dst[n][k] = *(const PG8_LAS bf16x8*)(lds + PG8_SB(b, h) + boff + n * 2048 + k * 1024); } while (0)
#define PG8_MMA(ai, bj, At, Bt) do { __builtin_amdgcn_s_setprio(1); _Pragma("unroll") for (int m = 0; m < 4; ++m) _Pragma("unroll") for (int n = 0; n < 2; ++n) _Pragma("unroll") for (int k = 0; k < 2; ++k) \
        acc[ai][bj][m][n] = __builtin_amdgcn_mfma_f32_16x16x32_bf16(Bt[n][k], At[m][k], acc[ai][bj][m][n], 0, 0, 0); __builtin_amdgcn_s_setprio(0); } while (0)
#define PG8_WAIT_V(n) asm volatile("s_waitcnt vmcnt(" #n ")" ::: "memory")
#define PG8_WAIT_L(n) asm volatile("s_waitcnt lgkmcnt(" #n ")" ::: "memory")
#define PG8_BAR __builtin_amdgcn_s_barrier()
#define PG8_SCHED __builtin_amdgcn_sched_barrier(0)
    Unit cur, nxt; int ui = 0;
    if (!S.next(0, cur)) return;
    f32x4 acc[2][2][4][2];
#pragma unroll
    for (int a = 0; a < 2; ++a)
#pragma unroll
        for (int b = 0; b < 2; ++b)
#pragma unroll
            for (int m = 0; m < 4; ++m)
#pragma unroll
                for (int n = 0; n < 2; ++n) acc[a][b][m][n] = (f32x4){0.f, 0.f, 0.f, 0.f};
    bf16x8 At[4][2], B0[2][2], B1[2][2];
    const char* cA = (const char*)g.A + (size_t)cur.pm * tstepA; const char* cB = (const char*)g.Bt + (size_t)cur.pn * tstepB;
    const char* cA2 = g.A2 ? (const char*)g.A2 + (size_t)cur.pm * tstepA : nullptr;
    S.a_ready(cur);
    if constexpr (SP2) {
        PG8_STAGE(PG8_SB(0, 0), cB, voffB); PG8_STAGE(PG8_SB(0, 1), cB + hstepB, voffB); PG8_STAGE(PG8_SA(0, 0), cA, voffA); PG8_STAGE(PG8_SA(0, 1), cA + hstepA, voffA);
        if (wr == 1) PG8_BAR;
        PG8_WAIT_V(2); PG8_BAR;
        PG8_STAGE(PG8_SB(1, 0), cB + kstep, voffB); PG8_STAGE(PG8_SA(1, 0), cA + kstep, voffA); PG8_STAGE(PG8_SB(1, 1), cB + hstepB + kstep, voffB);
        PG8_WAIT_V(6); PG8_BAR;
    } else {
        PG8_STAGE(PG8_SB(0, 0), cB, voffB); PG8_STAGE(PG8_SA(0, 0), cA, voffA); PG8_STAGE(PG8_SB(0, 1), cB + hstepB, voffB); PG8_STAGE(PG8_SA(0, 1), cA + hstepA, voffA);
        if (wr == 1) PG8_BAR;
        PG8_WAIT_V(4); PG8_BAR;
        PG8_STAGE(PG8_SB(1, 0), cB + kstep, voffB); PG8_STAGE(PG8_SA(1, 0), cA + kstep, voffA); PG8_STAGE(PG8_SB(1, 1), cB + hstepB + kstep, voffB);
        PG8_WAIT_V(6); PG8_BAR;
    }
    for (;;) {
        const bool has_next = S.next(ui + 1, nxt);
        const char* nA = has_next ? (const char*)g.A + (size_t)nxt.pm * tstepA : cA; const char* nB = has_next ? (const char*)g.Bt + (size_t)nxt.pn * tstepB : cB;
        const int tspan = Epi::HAS_MID ? (nt >> 1) : nt;
        for (int tb = 0; tb < nt; tb += tspan) {
        if constexpr (Epi::HAS_MID) { if (tb != 0) E.mid(acc, cur, wr, wc, fr, fq); }
        for (int t = tb; t < tb + tspan; t += 2) {
            const bool last = (t == nt - 2);
            const int hk = nt >> 1;
            const char* bA1 = (cA2 && t + 1 >= hk) ? cA2 - (size_t)hk * kstep : cA; const char* bA2 = (cA2 && t + 2 >= hk) ? cA2 - (size_t)hk * kstep : cA;
            const char* a1 = bA1 + (size_t)(t + 1) * kstep;
            const char* a2 = last ? nA : bA2 + (size_t)(t + 2) * kstep; const char* b2 = last ? nB : cB + (size_t)(t + 2) * kstep;
            const char* a3 = a2 + kstep; const char* b3 = b2 + kstep;
            if (last && has_next) S.a_ready(nxt);
            if constexpr (SP2) {
            PG8_LDB(B0, 0, 0); PG8_LDB(B1, 0, 1); PG8_SCHED; PG8_LDA(At, 0, 0); PG8_STAGE(PG8_SA(1, 1), a1 + hstepA, voffA);
            PG8_WAIT_V(8); PG8_WAIT_L(0); PG8_BAR; PG8_MMA(0, 0, At, B0); PG8_MMA(0, 1, At, B1); PG8_BAR; PG8_SCHED;
            PG8_LDA(At, 0, 1); PG8_STAGE(PG8_SB(0, 0), b2, voffB); PG8_STAGE(PG8_SB(0, 1), b2 + hstepB, voffB); PG8_STAGE(PG8_SA(0, 0), a2, voffA);
            PG8_WAIT_V(8); PG8_WAIT_L(0); PG8_BAR; PG8_MMA(1, 0, At, B0); PG8_MMA(1, 1, At, B1); PG8_BAR; PG8_SCHED;
            PG8_LDB(B0, 1, 0); PG8_LDB(B1, 1, 1); PG8_SCHED; PG8_LDA(At, 1, 0); PG8_STAGE(PG8_SA(0, 1), a2 + hstepA, voffA);
            PG8_WAIT_V(8); PG8_WAIT_L(0); PG8_BAR; PG8_MMA(0, 0, At, B0); PG8_MMA(0, 1, At, B1); PG8_BAR; PG8_SCHED;
            PG8_LDA(At, 1, 1); PG8_STAGE(PG8_SB(1, 0), b3, voffB); PG8_STAGE(PG8_SB(1, 1), b3 + hstepB, voffB); PG8_STAGE(PG8_SA(1, 0), a3, voffA);
            PG8_WAIT_V(8); PG8_WAIT_L(0); PG8_BAR; PG8_MMA(1, 0, At, B0); PG8_MMA(1, 1, At, B1); PG8_BAR; PG8_SCHED;
            } else {
            PG8_LDB(B0, 0, 0); PG8_SCHED; PG8_LDA(At, 0, 0); PG8_STAGE(PG8_SA(1, 1), a1 + hstepA, voffA);
            PG8_WAIT_L(8); PG8_BAR; PG8_WAIT_L(0); PG8_MMA(0, 0, At, B0); PG8_BAR; PG8_SCHED;
            PG8_LDB(B1, 0, 1); PG8_STAGE(PG8_SB(0, 0), b2, voffB);
            PG8_BAR; PG8_WAIT_L(0); PG8_MMA(0, 1, At, B1); PG8_BAR;
            PG8_LDA(At, 0, 1); PG8_STAGE(PG8_SA(0, 0), a2, voffA);
            PG8_BAR; PG8_WAIT_L(0); PG8_MMA(1, 0, At, B0); PG8_BAR; PG8_SCHED;
            PG8_STAGE(PG8_SB(0, 1), b2 + hstepB, voffB);
            PG8_WAIT_V(6); PG8_BAR; PG8_MMA(1, 1, At, B1); PG8_BAR;
            PG8_LDB(B0, 1, 0); PG8_SCHED; PG8_LDA(At, 1, 0); PG8_STAGE(PG8_SA(0, 1), a2 + hstepA, voffA);
            PG8_WAIT_L(8); PG8_BAR; PG8_WAIT_L(0); PG8_MMA(0, 0, At, B0); PG8_BAR; PG8_SCHED;
            PG8_LDB(B1, 1, 1); PG8_STAGE(PG8_SB(1, 0), b3, voffB);
            PG8_BAR; PG8_WAIT_L(0); PG8_MMA(0, 1, At, B1); PG8_BAR;
            PG8_LDA(At, 1, 1); PG8_STAGE(PG8_SA(1, 0), a3, voffA);
            PG8_BAR; PG8_WAIT_L(0); PG8_MMA(1, 0, At, B0); PG8_BAR; PG8_SCHED;
            PG8_STAGE(PG8_SB(1, 1), b3 + hstepB, voffB);
            PG8_WAIT_V(6); PG8_BAR; PG8_MMA(1, 1, At, B1); PG8_BAR;
            }
        }
        }
        if constexpr (ALIGN_EPI) { if (wr == 0) PG8_BAR; }
        if constexpr (!Epi::AFTER_DRAIN) { E(acc, cur, wr, wc, fr, fq); S.done(cur); }
        if (!has_next) break;
#pragma unroll
        for (int a = 0; a < 2; ++a)
#pragma unroll
            for (int b = 0; b < 2; ++b)
#pragma unroll
                for (int m = 0; m < 4; ++m)
#pragma unroll
                    for (int n = 0; n < 2; ++n) acc[a][b][m][n] = (f32x4){0.f, 0.f, 0.f, 0.f};
        cur = nxt; cA = nA; cB = nB; ++ui; cA2 = g.A2 ? (const char*)g.A2 + (size_t)cur.pm * tstepA : nullptr;
        if constexpr (ALIGN_EPI) { if (wr == 1) PG8_BAR; }
    }
    PG8_WAIT_V(0);
    if constexpr (!ALIGN_EPI) { if (wr == 0) PG8_BAR; }
    PG8_BAR;
    if constexpr (Epi::AFTER_DRAIN) { E.fused(acc, cur, wr, wc, fr, fq, lds, wid, lane); S.done(cur); }
#undef PG8_SA
#undef PG8_SB
#undef PG8_STAGE
#undef PG8_LDA
#undef PG8_LDB
#undef PG8_MMA
#undef PG8_WAIT_V
#undef PG8_WAIT_L
#undef PG8_BAR
#undef PG8_SCHED
}
}

DEV void stage_gemm_in(const Params& p, char* lds, int vb, int nvb) {
    pg8::Gemm g{(const bf16_t*)(p.ws + WS_UB), (const bf16_t*)(p.ws + WS_WIN), M, 4864, 1024, 1024, 1024};
    pg8::StaticOrder S; S.init(M, 4864, nvb, vb);
    pg8::EpiIn E{(bf16_t*)(p.ws + WS_PA), (bf16_t*)(p.ws + WS_PM), (bf16_t*)(p.ws + WS_PG)};
    pg8::gemm_phase<pg8::EpiIn, pg8::StaticOrder, true, true>((PG8_LAS unsigned char*)lds, g, S, E);
}
DEV void stage_gemm_merge(const Params& p, char* lds, int vb, int nvb) {
    pg8::Gemm g{(const bf16_t*)(p.ws + WS_AT), (const bf16_t*)(p.ws + WS_WA), M, 1024, 1024, 512, 1024, (const bf16_t*)(p.ws + WS_ML)};
    pg8::StaticOrder S; S.init(M, 1024, nvb, vb);
    pg8::EpiMergeF E{(const bf16_t*)(p.ws + WS_PG), (bf16_t*)(p.ws + WS_MG)};
    pg8::gemm_phase<pg8::EpiMergeF, pg8::StaticOrder, true, true>((PG8_LAS unsigned char*)lds, g, S, E);
}
DEV void stage_gemm_out(const Params& p, char* lds, int vb, int nvb) {
    pg8::Gemm g{(const bf16_t*)(p.ws + WS_MG), (const bf16_t*)(p.ws + WS_WOUT), M, 1024, 1024, 1024, 1024};
    pg8::StaticOrder S; S.init(M, 1024, nvb, vb);
    pg8::EpiOut E{p.x, (const float*)(p.ws + WS_MOD) + 2048, p.out, SEQ};
    pg8::gemm_phase<pg8::EpiOut, pg8::StaticOrder, true, true>((PG8_LAS unsigned char*)lds, g, S, E);
}

DEV void rope8(u32x4 x1, u32x4 x2, const float4* rp, float scale, u32x4& o1, u32x4& o2) {
#pragma unroll
    for (int w = 0; w < 4; ++w) {
        const float4 cs = rp[w];
        const float a0 = bflo(x1[w]), a1 = bfhi(x1[w]), b0 = bflo(x2[w]), b1 = bfhi(x2[w]);
        o1[w] = pk2((a0 * cs.x - b0 * cs.y) * scale, (a1 * cs.z - b1 * cs.w) * scale);
        o2[w] = pk2((b0 * cs.x + a0 * cs.y) * scale, (b1 * cs.z + a1 * cs.w) * scale);
    }
}

DEV void stage_attn(const Params& p, char* lds, int vb, int nvb) {
    const int tid = threadIdx.x, lane = tid & 63, wave = __builtin_amdgcn_readfirstlane(tid >> 6), fr = lane & 15, fq = lane >> 4;
    char* Ks = lds;
    char* VT = lds + 32768;
    char* Qs = lds + 70656;
    char* Ps = lds + 87040;
    bf16_t* PA = (bf16_t*)(p.ws + WS_PA);
    const float2* rope = (const float2*)(p.ws + WS_ROPE);
    for (int unit = vb; unit < 512; unit += nvb) {
        const int kvh = unit & 1, n = (unit >> 1) & 127, b = unit >> 8;
        __syncthreads();
        for (int task = tid; task < 1024; task += NTH) {
            const int ki = task >> 2, cp = task & 3, pos = 128 * (n - 1) + ki;
            u32x4 o1, o2;
            {
                const int pc = pos < 0 ? 0 : pos;
                const bf16_t* src = PA + (size_t)(b * SEQ + pc) * LPA + 512 + kvh * 64 + cp * 8;
                const u32x4 x1 = *(const u32x4*)src, x2 = *(const u32x4*)(src + 32);
                rope8(x1, x2, (const float4*)(rope + (size_t)pc * 32 + cp * 8), 1.0f, o1, o2);
                if (pos < 0) { o1 = (u32x4){0u, 0u, 0u, 0u}; o2 = o1; }
            }
            const int sw = ki & 7;
            *(u32x4*)(Ks + ki * 128 + ((cp ^ sw) << 4)) = o1;
            *(u32x4*)(Ks + ki * 128 + (((cp + 4) ^ sw) << 4)) = o2;
        }
        for (int task = tid; task < 2048; task += NTH) {
            const int ki = task >> 3, c = task & 7, pos = 128 * (n - 1) + ki;
            u32x4 x = *(const u32x4*)(PA + (size_t)(b * SEQ + (pos < 0 ? 0 : pos)) * LPA + 640 + kvh * 64 + c * 8);
            if (pos < 0) x = (u32x4){0u, 0u, 0u, 0u};
#pragma unroll
            for (int e = 0; e < 8; ++e) *(bf16_t*)(VT + (c * 8 + e) * 592 + ki * 2) = (bf16_t)((e & 1) ? (x[e >> 1] >> 16) : (x[e >> 1] & 0xffffu));
        }
        for (int i = tid; i < 64 * 40; i += NTH) { const int d = i / 40, kk = 256 + i % 40; *(bf16_t*)(VT + d * 592 + kk * 2) = 0; }
        for (int i = tid; i < 2048; i += NTH) { const int w = i >> 8, r = (i >> 4) & 15, kk = 144 + (i & 15); *(bf16_t*)(Ps + w * 5376 + r * 336 + kk * 2) = 0; }
        for (int j = 0; j < 4; ++j) {
            const int hq = kvh * 4 + j;
            {
                const int qi = tid >> 2, cp = tid & 3, pos = 128 * n + qi;
                const bf16_t* src = PA + (size_t)(b * SEQ + pos) * LPA + hq * 64 + cp * 8;
                const u32x4 x1 = *(const u32x4*)src, x2 = *(const u32x4*)(src + 32);
                u32x4 o1, o2;
                rope8(x1, x2, (const float4*)(rope + (size_t)pos * 32 + cp * 8), 0.125f, o1, o2);
                const int sw = qi & 7;
                *(u32x4*)(Qs + qi * 128 + ((cp ^ sw) << 4)) = o1;
                *(u32x4*)(Qs + qi * 128 + (((cp + 4) ^ sw) << 4)) = o2;
            }
            __syncthreads();
            f32x4 s[9];
            const int sw = fr & 7;
            bf16x8 qf[2];
#pragma unroll
            for (int ks = 0; ks < 2; ++ks) qf[ks] = *(const bf16x8*)(Qs + (16 * wave + fr) * 128 + (((fq + 4 * ks) ^ sw) << 4));
#pragma unroll
            for (int t = 0; t < 9; ++t) {
                s[t] = (f32x4){0.f, 0.f, 0.f, 0.f};
#pragma unroll
                for (int ks = 0; ks < 2; ++ks) { const bf16x8 kf = *(const bf16x8*)(Ks + (16 * (wave + t) + fr) * 128 + (((fq + 4 * ks) ^ sw) << 4)); s[t] = mfma16(kf, qf[ks], s[t]); }
            }
            const float sink = p.sinks[hq];
            float mx = sink;
#pragma unroll
            for (int t = 0; t < 9; ++t)
#pragma unroll
                for (int r = 0; r < 4; ++r) {
                    const int dd = 16 * t + 4 * fq + r - fr, ki = 16 * (wave + t) + 4 * fq + r;
                    const bool ok = (dd >= 1) && (dd <= 128) && (n > 0 || ki >= 128);
                    const float v = ok ? s[t][r] : -INFINITY;
                    s[t][r] = v; mx = fmaxf(mx, v);
                }
            mx = fmaxf(mx, __shfl_xor(mx, 16)); mx = fmaxf(mx, __shfl_xor(mx, 32));
            float sum = 0.f;
#pragma unroll
            for (int t = 0; t < 9; ++t)
#pragma unroll
                for (int r = 0; r < 4; ++r) { const float pv = __expf(s[t][r] - mx); s[t][r] = pv; sum += pv; }
            sum += __shfl_xor(sum, 16); sum += __shfl_xor(sum, 32);
            const float inv = 1.f / (sum + __expf(sink - mx));
            char* Pw = Ps + wave * 5376 + fr * 336;
#pragma unroll
            for (int t = 0; t < 9; ++t) { u32x2 o; o.x = pk2(s[t][0], s[t][1]); o.y = pk2(s[t][2], s[t][3]); *(u32x2*)(Pw + (16 * t + 4 * fq) * 2) = o; }
            __syncthreads();
            f32x4 o[4];
#pragma unroll
            for (int di = 0; di < 4; ++di) o[di] = (f32x4){0.f, 0.f, 0.f, 0.f};
#pragma unroll
            for (int ks = 0; ks < 5; ++ks) {
                const bf16x8 pf = *(const bf16x8*)(Pw + (32 * ks + 8 * fq) * 2);
#pragma unroll
                for (int di = 0; di < 4; ++di) { const bf16x8 vf = *(const bf16x8*)(VT + (16 * di + fr) * 592 + (16 * wave + 32 * ks + 8 * fq) * 2); o[di] = mfma16(vf, pf, o[di]); }
            }
            bf16_t* dst = (bf16_t*)(p.ws + WS_AT) + (size_t)(b * SEQ + 128 * n + 16 * wave + fr) * 512 + hq * 64 + 4 * fq;
#pragma unroll
            for (int di = 0; di < 4; ++di) { u32x2 w; w.x = pk2(o[di][0] * inv, o[di][1] * inv); w.y = pk2(o[di][2] * inv, o[di][3] * inv); *(u32x2*)(dst + 16 * di) = w; }
            __syncthreads();
        }
    }
}

DEV float logsigf(float x) { return fminf(x, 0.f) - log1pf(expf(-fabsf(x))); }

DEV void chunk_gates(const float* ipre, const float* fpre, int rowbase, int h, float* gs, int lane) {
    const int l0 = 2 * lane;
    const float i0 = ipre[(size_t)(rowbase + l0) * 4 + h], i1 = ipre[(size_t)(rowbase + l0 + 1) * 4 + h];
    const float lf0 = logsigf(fpre[(size_t)(rowbase + l0) * 4 + h]), lf1 = logsigf(fpre[(size_t)(rowbase + l0 + 1) * 4 + h]);
    const float pair = lf0 + lf1;
    float sc = pair;
#pragma unroll
    for (int o = 1; o < 64; o <<= 1) { const float t = __shfl_up(sc, o); if (lane >= o) sc += t; }
    const float b0 = (sc - pair) + lf0, b1 = b0 + lf1;
    const float g = __shfl(sc, 63);
    const float a0 = g - b0 + i0, a1 = g - b1 + i1;
    const float mloc = wave_max(fmaxf(a0, a1));
    const float ib0 = i0 - b0, ib1 = i1 - b1;
    float scm = fmaxf(ib0, ib1);
#pragma unroll
    for (int o = 1; o < 64; o <<= 1) { const float t = __shfl_up(scm, o); if (lane >= o) scm = fmaxf(scm, t); }
    float ex = __shfl_up(scm, 1); if (lane == 0) ex = -INFINITY;
    const float pm0 = fmaxf(ex, ib0), pm1 = fmaxf(pm0, ib1);
    gs[l0] = b0; gs[l0 + 1] = b1; gs[128 + l0] = ib0; gs[128 + l0 + 1] = ib1; gs[256 + l0] = a0; gs[256 + l0 + 1] = a1; gs[384 + l0] = pm0; gs[384 + l0 + 1] = pm1;
    if (lane == 0) { gs[512] = g; gs[513] = mloc; }
}

DEV void conv8(const bf16_t* PM, const float* cw, int b, int t, int pmcol, int cch, float (&out)[8]) {
#pragma unroll
    for (int e = 0; e < 8; ++e) out[e] = 0.f;
#pragma unroll
    for (int j = 0; j < 4; ++j) {
        const int tt = t - 3 + j; const int tc = tt < 0 ? 0 : tt; const float z = tt < 0 ? 0.f : 1.f;
        const u32x4 x = *(const u32x4*)(PM + (size_t)(b * SEQ + tc) * LPM + pmcol);
        float4 w0 = *(const float4*)(cw + j * 1024 + cch), w1 = *(const float4*)(cw + j * 1024 + cch + 4);
        w0.x *= z; w0.y *= z; w0.z *= z; w0.w *= z; w1.x *= z; w1.y *= z; w1.z *= z; w1.w *= z;
        out[0] += bflo(x[0]) * w0.x; out[1] += bfhi(x[0]) * w0.y; out[2] += bflo(x[1]) * w0.z; out[3] += bfhi(x[1]) * w0.w;
        out[4] += bflo(x[2]) * w1.x; out[5] += bfhi(x[2]) * w1.y; out[6] += bflo(x[3]) * w1.z; out[7] += bfhi(x[3]) * w1.w;
    }
}

DEV void conv8r(const u32x4 (&r)[4], const float* cwl, int ch8, int t, float (&out)[8]) {
#pragma unroll
    for (int e = 0; e < 8; ++e) out[e] = 0.f;
#pragma unroll
    for (int j = 0; j < 4; ++j) {
        const float z = (t - 3 + j) < 0 ? 0.f : 1.f;
        const float4 w0 = *(const float4*)(cwl + j * 128 + ch8), w1 = *(const float4*)(cwl + j * 128 + ch8 + 4);
        out[0] += bflo(r[j][0]) * (w0.x * z); out[1] += bfhi(r[j][0]) * (w0.y * z); out[2] += bflo(r[j][1]) * (w0.z * z); out[3] += bfhi(r[j][1]) * (w0.w * z);
        out[4] += bflo(r[j][2]) * (w1.x * z); out[5] += bfhi(r[j][2]) * (w1.y * z); out[6] += bflo(r[j][3]) * (w1.z * z); out[7] += bfhi(r[j][3]) * (w1.w * z);
    }
}
DEV float siluf_(float y) { return y * __builtin_amdgcn_rcpf(1.f + __expf(-y)); }

DEV void stage_mstate(const Params& p, char* lds, int vb, int nvb) {
    const int tid = threadIdx.x, lane = tid & 63, wave = __builtin_amdgcn_readfirstlane(tid >> 6), fr = lane & 15, fq = lane >> 4;
    char* KT = lds;
    char* VT = lds + 34816;
    float* gs = (float*)(lds + 69632); float* s_cw = (float*)(lds + 73728);
    const bf16_t* PM = (const bf16_t*)(p.ws + WS_PM);
    const float* ipre = (const float*)(p.ws + WS_IPRE); const float* fpre = (const float*)(p.ws + WS_FPRE);
    float* UT = (float*)(p.ws + WS_UB); float* NLOC = (float*)(p.ws + WS_NLOC);
    float* G = (float*)(p.ws + WS_CHG); float* MLOC = G + 1024;
    for (int unit = vb; unit < 1024; unit += nvb) {
        const int c = unit & 127, h = (unit >> 7) & 3, b = unit >> 9;
        const int rowbase = b * SEQ + c * 128;
        __syncthreads();
        if (wave == 0) chunk_gates(ipre, fpre, rowbase, h, gs, lane);
        else if (tid >= 64 && tid < 192) { const int d = tid - 64;
#pragma unroll
            for (int j = 0; j < 4; ++j) s_cw[j * 128 + d] = p.conv_w[j * 1024 + 512 + h * 128 + d]; }
        __syncthreads();
        const float mloc = gs[513];
        for (int task0 = tid; task0 < 2048; task0 += 2 * NTH) {
            u32x4 rk[2][4], xv[2];
#pragma unroll
            for (int u2 = 0; u2 < 2; ++u2) {
                const int task = task0 + u2 * NTH, l = task >> 4, ch = task & 15, t = c * 128 + l;
#pragma unroll
                for (int j = 0; j < 4; ++j) { const int tc = t - 3 + j < 0 ? 0 : t - 3 + j; rk[u2][j] = *(const u32x4*)(PM + (size_t)(b * SEQ + tc) * LPM + 512 + h * 128 + ch * 8); }
                xv[u2] = *(const u32x4*)(PM + (size_t)(rowbase + l) * LPM + 1024 + h * 128 + ch * 8);
            }
#pragma unroll
            for (int u2 = 0; u2 < 2; ++u2) {
                const int task = task0 + u2 * NTH, l = task >> 4, ch = task & 15, t = c * 128 + l;
                float v8[8]; conv8r(rk[u2], s_cw, ch * 8, t, v8);
                const float wgt = __expf(gs[256 + l] - mloc) * 0.08838834764831845f;
#pragma unroll
                for (int e = 0; e < 8; ++e) *(bf16_t*)(KT + (ch * 8 + e) * 272 + l * 2) = (bf16_t)f2bf(siluf_(v8[e]) * wgt);
                const u32x4 x = xv[u2];
#pragma unroll
                for (int e = 0; e < 8; ++e) *(bf16_t*)(VT + (ch * 8 + e) * 272 + l * 2) = (bf16_t)((e & 1) ? (x[e >> 1] >> 16) : (x[e >> 1] & 0xffffu));
            }
        }
        __syncthreads();
        f32x4 acc[8];
#pragma unroll
        for (int t = 0; t < 8; ++t) acc[t] = (f32x4){0.f, 0.f, 0.f, 0.f};
#pragma unroll
        for (int ks = 0; ks < 4; ++ks) {
            const bf16x8 vf = *(const bf16x8*)(VT + (16 * wave + fr) * 272 + (32 * ks + 8 * fq) * 2);
#pragma unroll
            for (int t = 0; t < 8; ++t) { const bf16x8 kf = *(const bf16x8*)(KT + (16 * t + fr) * 272 + (32 * ks + 8 * fq) * 2); acc[t] = mfma16(kf, vf, acc[t]); }
        }
        float* UTu = UT + (size_t)unit * 16384 + (16 * wave + fr) * 128 + 4 * fq;
#pragma unroll
        for (int t = 0; t < 8; ++t) *(f32x4*)(UTu + 16 * t) = acc[t];
        if (tid < 128) { float s = 0.f; for (int l = 0; l < 128; ++l) s += bf2f(*(const bf16_t*)(KT + tid * 272 + l * 2)); NLOC[unit * 128 + tid] = s; }
        if (tid == 0) { G[unit] = gs[512]; MLOC[unit] = mloc; }
    }
}

DEV void stage_mscan(const Params& p, char* lds, int vb, int nvb) {
    const int tid = threadIdx.x;
    float* s_dec = (float*)lds; float* s_scl = s_dec + 128;
    const float* UT = (const float*)(p.ws + WS_UB); const float* NLOC = (const float*)(p.ws + WS_NLOC);
    const float* G = (const float*)(p.ws + WS_CHG); const float* MLOC = G + 1024; float* MST = (float*)(p.ws + WS_CHG) + 2048;
    bf16_t* CST = (bf16_t*)(p.ws + WS_CST); float* NST = (float*)(p.ws + WS_NST);
    for (int item = vb; item < 256; item += nvb) {
        const int bh = item >> 5, part = item & 31;
        __syncthreads();
        float* s_g = s_dec + 256; float* s_ml = s_dec + 384; float* s_m = s_dec + 512;
        if (tid < 128) { s_g[tid] = G[bh * 128 + tid]; s_ml[tid] = MLOC[bh * 128 + tid]; }
        __syncthreads();
        if (tid == 0) { float m = 0.f; for (int c = 0; c < 128; ++c) { s_m[c] = m; m = fmaxf(s_g[c] + m, s_ml[c]); } s_m[128] = m; }
        __syncthreads();
        if (tid < 128) { const float m = s_m[tid], mn = s_m[tid + 1]; s_dec[tid] = expf(s_g[tid] + m - mn); s_scl[tid] = expf(s_ml[tid] - mn); if (part == 0) MST[bh * 128 + tid] = m; }
        __syncthreads();
        const int e = part * 512 + tid;
        float C = 0.f;
        const float* up = UT + (size_t)bh * 128 * 16384 + e; bf16_t* cp = CST + (size_t)bh * 128 * 16384 + e;
        for (int c = 0; c < 128; c += 32) {
            float uu[32];
#pragma unroll
            for (int i = 0; i < 32; ++i) uu[i] = up[(size_t)(c + i) * 16384];
#pragma unroll
            for (int i = 0; i < 32; ++i) { cp[(size_t)(c + i) * 16384] = (bf16_t)f2bf(C); C = s_dec[c + i] * C + s_scl[c + i] * uu[i]; }
        }
        if (part == 0 && tid < 128) {
            float nn = 0.f;
            for (int c = 0; c < 128; c += 32) {
                float nv[32];
#pragma unroll
                for (int i = 0; i < 32; ++i) nv[i] = NLOC[(bh * 128 + c + i) * 128 + tid];
#pragma unroll
                for (int i = 0; i < 32; ++i) { NST[(bh * 128 + c + i) * 128 + tid] = nn; nn = s_dec[c + i] * nn + s_scl[c + i] * nv[i]; }
            }
        }
    }
}

DEV void stage_mout(const Params& p, char* lds, int vb, int nvb) {
    const int tid = threadIdx.x, lane = tid & 63, wave = __builtin_amdgcn_readfirstlane(tid >> 6), fr = lane & 15, fq = lane >> 4;
    char* Qs = lds; char* Ks = lds + 34816; char* VT = lds + 69632; char* CT = lds + 104448;
    float* gs = (float*)(lds + 139264); float* s_nst = gs + 520; float* s_mo = gs + 648; float* s_wi = gs + 776; float* s_cw = (float*)(lds + 143360);
    bf16_t* PM = (bf16_t*)(p.ws + WS_PM);
    const float* ipre = (const float*)(p.ws + WS_IPRE); const float* fpre = (const float*)(p.ws + WS_FPRE);
    const float* MST = (const float*)(p.ws + WS_CHG) + 2048; const float* NST = (const float*)(p.ws + WS_NST);
    const bf16_t* CST = (const bf16_t*)(p.ws + WS_CST);
    for (int unit = vb; unit < 1024; unit += nvb) {
        const int c = unit & 127, h = (unit >> 7) & 3, b = unit >> 9;
        const int rowbase = b * SEQ + c * 128;
        __syncthreads();
        if (tid < 256) { const int d = tid & 127, kq = tid >> 7;
#pragma unroll
            for (int j = 0; j < 4; ++j) s_cw[kq * 512 + j * 128 + d] = p.conv_w[j * 1024 + kq * 512 + h * 128 + d]; }
        __syncthreads();
        if (wave == 0) chunk_gates(ipre, fpre, rowbase, h, gs, lane);
        for (int task0 = tid; task0 < 2048; task0 += 2 * NTH) {
            u32x4 rq[2][4], rk[2][4], xv[2], cstv[2];
#pragma unroll
            for (int u2 = 0; u2 < 2; ++u2) {
                const int task = task0 + u2 * NTH, l = task >> 4, ch = task & 15, t = c * 128 + l;
#pragma unroll
                for (int j = 0; j < 4; ++j) { const int tc = t - 3 + j < 0 ? 0 : t - 3 + j; const bf16_t* rp = PM + (size_t)(b * SEQ + tc) * LPM + h * 128 + ch * 8; rq[u2][j] = *(const u32x4*)rp; rk[u2][j] = *(const u32x4*)(rp + 512); }
                xv[u2] = *(const u32x4*)(PM + (size_t)(rowbase + l) * LPM + 1024 + h * 128 + ch * 8);
                cstv[u2] = *(const u32x4*)(CST + (size_t)unit * 16384 + l * 128 + ch * 8);
            }
#pragma unroll
            for (int u2 = 0; u2 < 2; ++u2) {
                const int task = task0 + u2 * NTH, l = task >> 4, ch = task & 15, t = c * 128 + l;
                float v8[8]; u32x4 o;
                conv8r(rq[u2], s_cw, ch * 8, t, v8);
                o.x = pk2(siluf_(v8[0]), siluf_(v8[1])); o.y = pk2(siluf_(v8[2]), siluf_(v8[3])); o.z = pk2(siluf_(v8[4]), siluf_(v8[5])); o.w = pk2(siluf_(v8[6]), siluf_(v8[7]));
                *(u32x4*)(Qs + l * 272 + ch * 16) = o;
                conv8r(rk[u2], s_cw + 512, ch * 8, t, v8);
                const float sc = 0.08838834764831845f;
                o.x = pk2(siluf_(v8[0]) * sc, siluf_(v8[1]) * sc); o.y = pk2(siluf_(v8[2]) * sc, siluf_(v8[3]) * sc); o.z = pk2(siluf_(v8[4]) * sc, siluf_(v8[5]) * sc); o.w = pk2(siluf_(v8[6]) * sc, siluf_(v8[7]) * sc);
                *(u32x4*)(Ks + l * 272 + ch * 16) = o;
                const u32x4 x = xv[u2];
#pragma unroll
                for (int e = 0; e < 8; ++e) *(bf16_t*)(VT + (ch * 8 + e) * 272 + l * 2) = (bf16_t)((e & 1) ? (x[e >> 1] >> 16) : (x[e >> 1] & 0xffffu));
                *(u32x4*)(CT + l * 272 + ch * 16) = cstv[u2];
            }
        }
        if (tid < 128) s_nst[tid] = NST[unit * 128 + tid];
        __syncthreads();
        if (tid < 128) { const float mst = MST[unit]; const float bc = gs[tid]; const float mo = bc + fmaxf(mst, gs[384 + tid]); s_mo[tid] = mo; s_wi[tid] = __expf(bc + mst - mo); }
        __syncthreads();
        const int l = 16 * wave + fr;
        f32x4 s[8];
        bf16x8 qf[4];
#pragma unroll
        for (int ks = 0; ks < 4; ++ks) qf[ks] = *(const bf16x8*)(Qs + l * 272 + (32 * ks + 8 * fq) * 2);
#pragma unroll
        for (int t = 0; t < 8; ++t) {
            s[t] = (f32x4){0.f, 0.f, 0.f, 0.f};
            if (t <= wave) {
#pragma unroll
                for (int ks = 0; ks < 4; ++ks) { const bf16x8 kf = *(const bf16x8*)(Ks + (16 * t + fr) * 272 + (32 * ks + 8 * fq) * 2); s[t] = mfma16(kf, qf[ks], s[t]); }
            }
        }
        const float bl = gs[l], mol = s_mo[l];
        float dsum = 0.f;
#pragma unroll
        for (int t = 0; t < 8; ++t)
#pragma unroll
            for (int r = 0; r < 4; ++r) {
                const int si = 16 * t + 4 * fq + r; float wv = 0.f;
                if (t <= wave && si <= l) wv = __expf(bl + gs[128 + si] - mol) * s[t][r];
                s[t][r] = wv; dsum += wv;
            }
        dsum += __shfl_xor(dsum, 16); dsum += __shfl_xor(dsum, 32);
        float qn = 0.f;
        {
            const char* qrow = Qs + l * 272 + fq * 64;
#pragma unroll
            for (int i = 0; i < 4; ++i) {
                const u32x4 x = *(const u32x4*)(qrow + 16 * i); const float* nn = s_nst + fq * 32 + 8 * i;
                qn += bflo(x[0]) * nn[0] + bfhi(x[0]) * nn[1] + bflo(x[1]) * nn[2] + bfhi(x[1]) * nn[3] + bflo(x[2]) * nn[4] + bfhi(x[2]) * nn[5] + bflo(x[3]) * nn[6] + bfhi(x[3]) * nn[7];
            }
        }
        qn += __shfl_xor(qn, 16); qn += __shfl_xor(qn, 32);
        __syncthreads();
#pragma unroll
        for (int t = 0; t < 8; ++t)
            if (t <= wave + 1) { u32x2 o; o.x = pk2(s[t][0], s[t][1]); o.y = pk2(s[t][2], s[t][3]); *(u32x2*)(Ks + l * 272 + (16 * t + 4 * fq) * 2) = o; }
        __syncthreads();
        f32x4 acc[8];
#pragma unroll
        for (int t = 0; t < 8; ++t) acc[t] = (f32x4){0.f, 0.f, 0.f, 0.f};
#pragma unroll
        for (int ks = 0; ks < 4; ++ks)
#pragma unroll
            for (int t = 0; t < 8; ++t) { const bf16x8 cf = *(const bf16x8*)(CT + (16 * t + fr) * 272 + (32 * ks + 8 * fq) * 2); acc[t] = mfma16(cf, qf[ks], acc[t]); }
        const float wi = s_wi[l];
#pragma unroll
        for (int t = 0; t < 8; ++t) acc[t] = acc[t] * wi;
        const int nks = (wave + 2) >> 1;
#pragma unroll
        for (int ks = 0; ks < 4; ++ks)
            if (ks < nks) {
                const bf16x8 wf = *(const bf16x8*)(Ks + l * 272 + (32 * ks + 8 * fq) * 2);
#pragma unroll
                for (int t = 0; t < 8; ++t) { const bf16x8 vf = *(const bf16x8*)(VT + (16 * t + fr) * 272 + (32 * ks + 8 * fq) * 2); acc[t] = mfma16(vf, wf, acc[t]); }
            }
        const float den = dsum + wi * qn;
        const float invd = 1.f / fmaxf(fabsf(den), __expf(-mol));
        bf16_t* mop = PM + (size_t)(rowbase + l) * LPM + 1536 + h * 128 + 4 * fq;
        float ssq = 0.f;
        u32x2 g2v[8]; float4 nwv[8];
#pragma unroll
        for (int t = 0; t < 8; ++t) { g2v[t] = *(const u32x2*)(mop + 16 * t); nwv[t] = *(const float4*)(p.mnorm_w + h * 128 + 16 * t + 4 * fq); }
#pragma unroll
        for (int t = 0; t < 8; ++t) {
            const u32x2 g2 = g2v[t];
            const float gg[4] = {bflo(g2.x), bfhi(g2.x), bflo(g2.y), bfhi(g2.y)};
#pragma unroll
            for (int r = 0; r < 4; ++r) { const float hv = acc[t][r] * invd * sigmoidf_(gg[r]); acc[t][r] = hv; ssq += hv * hv; }
        }
        ssq += __shfl_xor(ssq, 16); ssq += __shfl_xor(ssq, 32);
        const float rn = rsqrtf(ssq * (1.f / 128.f) + 1e-6f);
#pragma unroll
        for (int t = 0; t < 8; ++t) {
            const float4 nw = nwv[t];
            u32x2 o; o.x = pk2(acc[t][0] * rn * nw.x, acc[t][1] * rn * nw.y); o.y = pk2(acc[t][2] * rn * nw.z, acc[t][3] * rn * nw.w);
            *(u32x2*)((bf16_t*)(p.ws + WS_ML) + (size_t)(rowbase + l) * 512 + h * 128 + 4 * fq + 16 * t) = o;
        }
    }
}

DEV void stage_norm2(const Params& p, char* lds, int vb, int nvb) {
    const int tid = threadIdx.x, lane = tid & 63, wave = __builtin_amdgcn_readfirstlane(tid >> 6);
    const float* mod = (const float*)(p.ws + WS_MOD);
    bf16_t* U2 = (bf16_t*)(p.ws + WS_PG);
    const int rstride = nvb * NW;
    for (int mb = vb * NW + wave; mb < M; mb += 4 * rstride) {
        float4 vv[4][4];
#pragma unroll
        for (int rr = 0; rr < 4; ++rr) { const int mr = mb + rr * rstride < M ? mb + rr * rstride : mb; const float4* xr = (const float4*)(p.out + (size_t)mr * D);
#pragma unroll
            for (int j = 0; j < 4; ++j) vv[rr][j] = xr[lane + 64 * j]; }
#pragma unroll
        for (int rr = 0; rr < 4; ++rr) {
            const int m = mb + rr * rstride;
            if (m < M) {
                const int b = m >= SEQ ? 1 : 0;
                float ss = 0.f;
#pragma unroll
                for (int j = 0; j < 4; ++j) { const float4 v = vv[rr][j]; ss += v.x * v.x + v.y * v.y + v.z * v.z + v.w * v.w; }
                ss = wave_sum(ss);
                const float rstd = rsqrtf(ss * (1.f / 1024.f) + 1e-6f);
#pragma unroll
                for (int j = 0; j < 4; ++j) {
                    const int col = 4 * (lane + 64 * j); const float4 v = vv[rr][j];
                    const float4 w1 = *(const float4*)(p.norm2_w + col), sc = *(const float4*)(mod + b * 6144 + 4096 + col), sh = *(const float4*)(mod + b * 6144 + 3072 + col);
                    u32x2 o;
                    o.x = pk2(v.x * rstd * w1.x * (1.f + sc.x) + sh.x, v.y * rstd * w1.y * (1.f + sc.y) + sh.y);
                    o.y = pk2(v.z * rstd * w1.z * (1.f + sc.z) + sh.z, v.w * rstd * w1.w * (1.f + sc.w) + sh.w);
                    *(u32x2*)(U2 + (size_t)m * D + col) = o;
                }
            }
        }
    }
}

constexpr size_t WS_SELI = 400 * MiB;
constexpr size_t WS_SELG = 416 * MiB;
constexpr size_t WS_SC = 64 * MiB;
DEV unsigned f2ord(float f) { const unsigned u = __float_as_uint(f); return (u & 0x80000000u) ? ~u : (u | 0x80000000u); }
DEV float ord2f(unsigned k) { return __uint_as_float((k & 0x80000000u) ? (k ^ 0x80000000u) : ~k); }
DEV unsigned umax_(unsigned a, unsigned b) { return a > b ? a : b; }

DEV void stage_gemm_q(const Params& p, char* lds, int vb, int nvb) {
    pg8::Gemm g{(const bf16_t*)(p.ws + WS_PG), (const bf16_t*)(p.ws + WS_WQ), M, 2048, 1024, 1024, 1024};
    pg8::StaticOrder S; S.init(M, 2048, nvb, vb);
    pg8::EpiF32 E{(float*)(p.ws + WS_SC), 2048};
    pg8::gemm_phase<pg8::EpiF32, pg8::StaticOrder, true, true>((PG8_LAS unsigned char*)lds, g, S, E);
}

DEV unsigned umin_(unsigned a, unsigned b) { return a < b ? a : b; }
template <int N> DEV void bitonic_sort_desc(unsigned (&a)[N]) {
#pragma unroll
    for (int k = 2; k <= N; k <<= 1)
#pragma unroll
        for (int j = k >> 1; j > 0; j >>= 1)
#pragma unroll
            for (int i = 0; i < N; ++i) { const int l = i ^ j; if (l > i) { const unsigned x = a[i], y = a[l]; const bool dsc = (i & k) == 0; a[i] = dsc ? umax_(x, y) : umin_(x, y); a[l] = dsc ? umin_(x, y) : umax_(x, y); } }
}
template <int N> DEV void bitonic_merge_desc(unsigned (&a)[N]) {
#pragma unroll
    for (int j = N >> 1; j > 0; j >>= 1)
#pragma unroll
        for (int i = 0; i < N; ++i) { const int l = i ^ j; if (l > i) { const unsigned x = a[i], y = a[l]; a[i] = umax_(x, y); a[l] = umin_(x, y); } }
}
template <bool X16> DEV void merge_top16_xlane(unsigned (&x)[16], int lane) {
    unsigned m[16];
#pragma unroll
    for (int i = 0; i < 16; ++i) {
        unsigned pv;
        if (X16) { auto r = __builtin_amdgcn_permlane16_swap(x[15 - i], x[15 - i], false, false); pv = (lane & 16) ? r[0] : r[1]; }
        else { auto r = __builtin_amdgcn_permlane32_swap(x[15 - i], x[15 - i], false, false); pv = (lane & 32) ? r[0] : r[1]; }
        m[i] = umax_(x[i], pv);
    }
    bitonic_merge_desc<16>(m);
#pragma unroll
    for (int i = 0; i < 16; ++i) x[i] = m[i];
}

DEV void stage_q_topk(const Params& p, char* lds, int vb, int nvb) {
    const int tid = threadIdx.x, lane = tid & 63, wave = __builtin_amdgcn_readfirstlane(tid >> 6), fr = lane & 15, fq = lane >> 4;
    unsigned* tops = (unsigned*)lds;
    unsigned char* ptab = (unsigned char*)(lds + 16384);
    const float* SC = (const float*)(p.ws + WS_SC);
    int* SELI = (int*)(p.ws + WS_SELI); float* SELG = (float*)(p.ws + WS_SELG);
    __syncthreads();
    if (tid < 64) { int cnt = 0; unsigned char v = 0xff; for (int i = 0; i < 16; ++i) for (int j = 0; j < 16 / (i + 1); ++j) { if (cnt == tid) v = (unsigned char)(i | (j << 4)); ++cnt; } ptab[tid] = v; }
    __syncthreads();
    pg8::StaticOrder SO; SO.init(M, 2048, nvb, vb);
    for (int it2 = 0;; ++it2) {
        pg8::Unit un; if (!SO.next(it2 >> 1, un)) break;
        const int mt = un.pm * 2 + (it2 & 1), h = un.pn, m0 = mt * 128;
        const float* srow = SC + (size_t)(m0 + 16 * wave + fr) * 2048 + h * 256 + 4 * fq;
        f32x4 sv[2][8];
#pragma unroll
        for (int pp = 0; pp < 2; ++pp)
#pragma unroll
            for (int t = 0; t < 8; ++t) sv[pp][t] = *(const f32x4*)(srow + pp * 128 + 16 * t);
        unsigned* tp = tops + (16 * wave + fr) * 32;
#pragma unroll
        for (int pp = 0; pp < 2; ++pp) {
            unsigned lo[16], hi[16];
#pragma unroll
            for (int t = 0; t < 4; ++t)
#pragma unroll
                for (int r = 0; r < 4; ++r) {
                    lo[4 * t + r] = (f2ord(sv[pp][t][r]) & ~127u) | (127u - (unsigned)(16 * t + 4 * fq + r));
                    hi[4 * t + r] = (f2ord(sv[pp][t + 4][r]) & ~127u) | (127u - (unsigned)(16 * (t + 4) + 4 * fq + r));
                }
            bitonic_sort_desc<16>(lo); bitonic_sort_desc<16>(hi);
#pragma unroll
            for (int i = 0; i < 16; ++i) lo[i] = umax_(lo[i], hi[15 - i]);
            bitonic_merge_desc<16>(lo);
            merge_top16_xlane<true>(lo, lane); merge_top16_xlane<false>(lo, lane);
            if (fq == 0) {
#pragma unroll
                for (int q = 0; q < 4; ++q) *(u32x4*)(tp + pp * 16 + 4 * q) = (u32x4){lo[4 * q], lo[4 * q + 1], lo[4 * q + 2], lo[4 * q + 3]};
            }
        }
        wave_lds_sync();
        unsigned ck[16];
#pragma unroll
        for (int sl = 0; sl < 13; ++sl) {
            const unsigned pr = ptab[4 * sl + fq]; const unsigned i = pr & 15u, j = pr >> 4;
            const float sum = ord2f(tp[i] & ~127u) + ord2f(tp[16 + (j & 15u)] & ~127u);
            ck[sl] = pr != 0xffu ? ((f2ord(sum) & ~255u) | (255u - (i * 16u + j))) : 0u;
        }
        ck[13] = 0u; ck[14] = 0u; ck[15] = 0u;
        bitonic_sort_desc<16>(ck);
        merge_top16_xlane<true>(ck, lane); merge_top16_xlane<false>(ck, lane);
        const float v0 = ord2f(ck[0] & ~255u);
        float ex[16], sm = 0.f;
#pragma unroll
        for (int r = 0; r < 16; ++r) { ex[r] = __expf(ord2f(ck[r] & ~255u) - v0); sm += ex[r]; }
        const float rs = 1.f / sm;
        int oi[4]; float og[4];
#pragma unroll
        for (int q = 0; q < 4; ++q) {
            const unsigned w = fq == 0 ? ck[q] : (fq == 1 ? ck[4 + q] : (fq == 2 ? ck[8 + q] : ck[12 + q]));
            const float e = fq == 0 ? ex[q] : (fq == 1 ? ex[4 + q] : (fq == 2 ? ex[8 + q] : ex[12 + q]));
            const unsigned flat = 255u - (w & 255u); const unsigned ia = flat >> 4, jb = flat & 15u;
            oi[q] = (int)((127u - (tp[ia] & 127u)) * 128u + (127u - (tp[16 + jb] & 127u)));
            og[q] = e * rs;
        }
        const size_t so = (size_t)(m0 + 16 * wave + fr) * 128 + h * 16 + 4 * fq;
        *(int4*)(SELI + so) = make_int4(oi[0], oi[1], oi[2], oi[3]);
        *(float4*)(SELG + so) = make_float4(og[0], og[1], og[2], og[3]);
        wave_lds_sync();
    }
}

DEV float dpp_row_sum(float v) {
    v += __int_as_float(__builtin_amdgcn_update_dpp(0, __float_as_int(v), 0xB1, 0xF, 0xF, true));
    v += __int_as_float(__builtin_amdgcn_update_dpp(0, __float_as_int(v), 0x4E, 0xF, 0xF, true));
    v += __int_as_float(__builtin_amdgcn_update_dpp(0, __float_as_int(v), 0x141, 0xF, 0xF, true));
    v += __int_as_float(__builtin_amdgcn_update_dpp(0, __float_as_int(v), 0x140, 0xF, 0xF, true));
    return v;
}
DEV int dpp_row_isum(int v) {
    v += __builtin_amdgcn_update_dpp(0, v, 0xB1, 0xF, 0xF, true); v += __builtin_amdgcn_update_dpp(0, v, 0x4E, 0xF, 0xF, true);
    v += __builtin_amdgcn_update_dpp(0, v, 0x141, 0xF, 0xF, true); v += __builtin_amdgcn_update_dpp(0, v, 0x140, 0xF, 0xF, true);
    return v;
}
DEV float dpp_row_max(float v) {
    v = fmaxf(v, __int_as_float(__builtin_amdgcn_update_dpp(0, __float_as_int(v), 0xB1, 0xF, 0xF, true))); v = fmaxf(v, __int_as_float(__builtin_amdgcn_update_dpp(0, __float_as_int(v), 0x4E, 0xF, 0xF, true)));
    v = fmaxf(v, __int_as_float(__builtin_amdgcn_update_dpp(0, __float_as_int(v), 0x141, 0xF, 0xF, true))); v = fmaxf(v, __int_as_float(__builtin_amdgcn_update_dpp(0, __float_as_int(v), 0x140, 0xF, 0xF, true)));
    return v;
}
DEV float gelu_as(float v) {
    const float av = fabsf(v), t = __builtin_amdgcn_rcpf(av * 0.2316418882f + 1.0f);
    float q = t * 0.5307027145f + (-0.7265760135f); q = q * t + 0.7107068705f; q = q * t + (-0.142248368f); q = q * t + 0.127414796f; q = q * t;
    const float e = __builtin_amdgcn_exp2f(v * v * (-0.72134752044f));
    const float m = v * (q * e);
    return v < 0.f ? m : v - m;
}
constexpr int NBIN = 16;
constexpr int GW_IDX = 0, GW_GATE = 1024, GW_SU = 3072, GW_SV = 5120, GW_W = 7168, GW_WQ = 9216, GW_BYTES = 9728;
DEV void g_sort_token(const int* SELI, const float* SELG, const float* SU, const float* SV, int tkn, char* wl, int j, int lane, int msk) {
    const int i0 = SELI[(size_t)tkn * 128 + lane] & msk, i1 = SELI[(size_t)tkn * 128 + 64 + lane] & msk;
    const float g0 = SELG[(size_t)tkn * 128 + lane], g1 = SELG[(size_t)tkn * 128 + 64 + lane];
    const float su0 = SU[i0], su1 = SU[i1], sv0 = SV[i0], sv1 = SV[i1];
    const int s0 = i0 >> 10, s1 = i1 >> 10;
    const unsigned long long lt = (1ull << lane) - 1ull;
    int base = 0, p0 = 0, p1 = 0;
#pragma unroll
    for (int s = 0; s < NBIN; ++s) {
        const unsigned long long m0 = __ballot(s0 == s), m1 = __ballot(s1 == s);
        const int c0 = __popcll(m0), c1 = __popcll(m1);
        if (s0 == s) p0 = base + __popcll(m0 & lt);
        if (s1 == s) p1 = base + c0 + __popcll(m1 & lt);
        base += c0 + c1;
    }
    unsigned short* li = (unsigned short*)(wl + GW_IDX) + j * 128; float* lg = (float*)(wl + GW_GATE) + j * 128; float* lsu = (float*)(wl + GW_SU) + j * 128; float* lsv = (float*)(wl + GW_SV) + j * 128;
    li[p0] = (unsigned short)i0; lg[p0] = g0; lsu[p0] = su0; lsv[p0] = sv0;
    li[p1] = (unsigned short)i1; lg[p1] = g1; lsu[p1] = su1; lsv[p1] = sv1;
}
DEV void r_load(u32x4 (&d)[4], const unsigned char* T, int id, int c) {
    const u32x4* q = (const u32x4*)(T + (size_t)id * 1024) + c;
#pragma unroll
    for (int k = 0; k < 4; ++k) d[k] = q[16 * k];
}
DEV int r_dotq(const u32x4 (&u)[4], const unsigned (&xq)[16]) {
    int s0 = 0, s1 = 0, s2 = 0, s3 = 0;
#pragma unroll
    for (int k = 0; k < 4; ++k) {
        s0 = __builtin_amdgcn_sdot4((int)u[k][0], (int)xq[4 * k], s0, false); s1 = __builtin_amdgcn_sdot4((int)u[k][1], (int)xq[4 * k + 1], s1, false);
        s2 = __builtin_amdgcn_sdot4((int)u[k][2], (int)xq[4 * k + 2], s2, false); s3 = __builtin_amdgcn_sdot4((int)u[k][3], (int)xq[4 * k + 3], s3, false);
    }
    return (s0 + s1) + (s2 + s3);
}
DEV float r_weight(int part, float sx, const char* wl, int r, int e) {
    const float d = (float)dpp_row_isum(part) * (((const float*)(wl + GW_SU))[r * 128 + e] * sx);
    return ((const float*)(wl + GW_GATE))[r * 128 + e] * gelu_as(d) * ((const float*)(wl + GW_SV))[r * 128 + e];
}
DEV void r_vaccq(const u32x4 (&v0)[4], const u32x4 (&v1)[4], const u32x4 (&v2)[4], const u32x4 (&v3)[4], unsigned wpk, int (&acc)[64]) {
#pragma unroll
    for (int k = 0; k < 4; ++k)
#pragma unroll
        for (int w = 0; w < 4; ++w) {
            const unsigned r0 = v0[k][w], r1 = v1[k][w], r2 = v2[k][w], r3 = v3[k][w];
            const unsigned p0 = __builtin_amdgcn_perm(r1, r0, 0x05010400u), p1 = __builtin_amdgcn_perm(r1, r0, 0x07030602u);
            const unsigned q0 = __builtin_amdgcn_perm(r3, r2, 0x05010400u), q1 = __builtin_amdgcn_perm(r3, r2, 0x07030602u);
            const unsigned t0 = __builtin_amdgcn_perm(q0, p0, 0x05040100u), t1 = __builtin_amdgcn_perm(q0, p0, 0x07060302u);
            const unsigned t2 = __builtin_amdgcn_perm(q1, p1, 0x05040100u), t3 = __builtin_amdgcn_perm(q1, p1, 0x07060302u);
            const int o = 16 * k + 4 * w;
            acc[o] = __builtin_amdgcn_sdot4((int)t0, (int)wpk, acc[o], false); acc[o + 1] = __builtin_amdgcn_sdot4((int)t1, (int)wpk, acc[o + 1], false);
            acc[o + 2] = __builtin_amdgcn_sdot4((int)t2, (int)wpk, acc[o + 2], false); acc[o + 3] = __builtin_amdgcn_sdot4((int)t3, (int)wpk, acc[o + 3], false);
        }
}
DEV void r_load2(u32x4 (&d)[2], const unsigned char* T, int id, int c, int hh) {
    const u32x4* q = (const u32x4*)(T + (size_t)id * 1024) + c + 32 * hh;
    d[0] = q[0]; d[1] = q[16];
}
template <int HH> DEV void r_vaccq2(const u32x4 (&v0)[2], const u32x4 (&v1)[2], const u32x4 (&v2)[2], const u32x4 (&v3)[2], unsigned wpk, int (&acc)[64]) {
#pragma unroll
    for (int kk = 0; kk < 2; ++kk)
#pragma unroll
        for (int w = 0; w < 4; ++w) {
            const unsigned r0 = v0[kk][w], r1 = v1[kk][w], r2 = v2[kk][w], r3 = v3[kk][w];
            const unsigned p0 = __builtin_amdgcn_perm(r1, r0, 0x05010400u), p1 = __builtin_amdgcn_perm(r1, r0, 0x07030602u);
            const unsigned q0 = __builtin_amdgcn_perm(r3, r2, 0x05010400u), q1 = __builtin_amdgcn_perm(r3, r2, 0x07030602u);
            const unsigned t0 = __builtin_amdgcn_perm(q0, p0, 0x05040100u), t1 = __builtin_amdgcn_perm(q0, p0, 0x07060302u);
            const unsigned t2 = __builtin_amdgcn_perm(q1, p1, 0x05040100u), t3 = __builtin_amdgcn_perm(q1, p1, 0x07060302u);
            const int o = 16 * (2 * HH + kk) + 4 * w;
            acc[o] = __builtin_amdgcn_sdot4((int)t0, (int)wpk, acc[o], false); acc[o + 1] = __builtin_amdgcn_sdot4((int)t1, (int)wpk, acc[o + 1], false);
            acc[o + 2] = __builtin_amdgcn_sdot4((int)t2, (int)wpk, acc[o + 2], false); acc[o + 3] = __builtin_amdgcn_sdot4((int)t3, (int)wpk, acc[o + 3], false);
        }
}
struct VB4 { u32x4 e0[2], e1[2], e2[2], e3[2]; };
DEV void vb_load(VB4& b, const unsigned char* TV, const unsigned short* myi, int g, int c, int hh) {
    const int e = g < 32 ? 4 * g : 124;
    r_load2(b.e0, TV, (int)myi[e], c, hh); r_load2(b.e1, TV, (int)myi[e + 1], c, hh); r_load2(b.e2, TV, (int)myi[e + 2], c, hh); r_load2(b.e3, TV, (int)myi[e + 3], c, hh);
}
template <int HH> DEV void pass2_half(const unsigned char* TV, const unsigned short* myi, const unsigned* lwq, int c, int (&acc)[64]) {
    VB4 ba, bb, bc, bd;
    vb_load(ba, TV, myi, 0, c, HH); vb_load(bb, TV, myi, 1, c, HH); vb_load(bc, TV, myi, 2, c, HH); vb_load(bd, TV, myi, 3, c, HH);
    for (int g = 0; g < 32; g += 4) {
        __builtin_amdgcn_sched_barrier(0); r_vaccq2<HH>(ba.e0, ba.e1, ba.e2, ba.e3, lwq[g], acc);     __builtin_amdgcn_sched_barrier(0); vb_load(ba, TV, myi, g + 4, c, HH);
        __builtin_amdgcn_sched_barrier(0); r_vaccq2<HH>(bb.e0, bb.e1, bb.e2, bb.e3, lwq[g + 1], acc); __builtin_amdgcn_sched_barrier(0); vb_load(bb, TV, myi, g + 5, c, HH);
        __builtin_amdgcn_sched_barrier(0); r_vaccq2<HH>(bc.e0, bc.e1, bc.e2, bc.e3, lwq[g + 2], acc); __builtin_amdgcn_sched_barrier(0); vb_load(bc, TV, myi, g + 6, c, HH);
        __builtin_amdgcn_sched_barrier(0); r_vaccq2<HH>(bd.e0, bd.e1, bd.e2, bd.e3, lwq[g + 3], acc); __builtin_amdgcn_sched_barrier(0); vb_load(bd, TV, myi, g + 7, c, HH);
        __builtin_amdgcn_sched_barrier(0);
    }
}
#define SB_() __builtin_amdgcn_sched_barrier(0)

DEV void stage_peer_gather(const Params& p, char* lds, int slot, int nslots, bool dry = false, int msk = 0x3fff) {
    const int tid = threadIdx.x, lane = tid & 63, wave = __builtin_amdgcn_readfirstlane(tid >> 6), r = lane >> 4, c = lane & 15;
    const bf16_t* U2 = (const bf16_t*)(p.ws + WS_PG);
    const unsigned char* TU = p.ws + WS_TU; const unsigned char* TV = p.ws + WS_TV;
    const float* SU = (const float*)(p.ws + WS_ISU); const float* SV = (const float*)(p.ws + WS_ISV);
    const int* SELI = (const int*)(p.ws + WS_SELI); const float* SELG = (const float*)(p.ws + WS_SELG);
    const float* mod = (const float*)(p.ws + WS_MOD);
    char* wl = lds + wave * GW_BYTES;
    const unsigned short* myi = (const unsigned short*)(wl + GW_IDX) + r * 128;
    float* lw = (float*)(wl + GW_W) + r * 128; unsigned* lwq = (unsigned*)(wl + GW_WQ) + r * 32;
    const int tpb = M / nslots;
    __syncthreads();
    for (int g0 = 0; g0 < tpb; g0 += 32) {
        __syncthreads();
        const int tbase = slot * tpb + g0 + 4 * wave;
#pragma unroll
        for (int j = 0; j < 4; ++j) g_sort_token(SELI, SELG, SU, SV, tbase + j, wl, j, lane, msk);
        const int tkn = tbase + r;
        unsigned xq[16]; float sx;
        {
            const bf16_t* xr = U2 + (size_t)tkn * D + 16 * c;
            u32x4 t[8]; float amax = 0.f;
#pragma unroll
            for (int k = 0; k < 8; ++k) { t[k] = *(const u32x4*)(xr + 256 * (k >> 1) + 8 * (k & 1));
#pragma unroll
                for (int i = 0; i < 4; ++i) amax = fmaxf(amax, fmaxf(fabsf(bflo(t[k][i])), fabsf(bfhi(t[k][i])))); }
            amax = dpp_row_max(amax);
            const float inv = amax > 0.f ? 127.f / amax : 0.f; sx = amax > 0.f ? amax * (1.f / 127.f) : 1.f;
#pragma unroll
            for (int k = 0; k < 8; ++k)
#pragma unroll
                for (int h2 = 0; h2 < 2; ++h2) {
                    const unsigned a = t[k][2 * h2], b = t[k][2 * h2 + 1];
                    const unsigned wv = ((unsigned)__float2int_rn(bflo(a) * inv) & 0xffu) | (((unsigned)__float2int_rn(bfhi(a) * inv) & 0xffu) << 8) | (((unsigned)__float2int_rn(bflo(b) * inv) & 0xffu) << 16) | ((unsigned)__float2int_rn(bfhi(b) * inv) << 24);
                    xq[2 * k + h2] = wv;
                }
        }
        wave_lds_sync();
        float wmax = 0.f;
#define P1H_DOT(buf, HH) (__builtin_amdgcn_sdot4((int)buf[0][0], (int)xq[8 * HH + 0], __builtin_amdgcn_sdot4((int)buf[0][2], (int)xq[8 * HH + 2], __builtin_amdgcn_sdot4((int)buf[1][0], (int)xq[8 * HH + 4], __builtin_amdgcn_sdot4((int)buf[1][2], (int)xq[8 * HH + 6], 0, false), false), false), false) \
                        + __builtin_amdgcn_sdot4((int)buf[0][1], (int)xq[8 * HH + 1], __builtin_amdgcn_sdot4((int)buf[0][3], (int)xq[8 * HH + 3], __builtin_amdgcn_sdot4((int)buf[1][1], (int)xq[8 * HH + 5], __builtin_amdgcn_sdot4((int)buf[1][3], (int)xq[8 * HH + 7], 0, false), false), false), false))
#define P1H_STEP(buf, off, HH) SB_(); const int pt##off = P1H_DOT(buf, HH); SB_(); r_load2(buf, TU, (int)myi[e + 8 + off < 128 ? e + 8 + off : 127], c, HH);
        {
            int* lp = (int*)lw;
            u32x4 h0[2], h1[2], h2[2], h3[2], h4[2], h5[2], h6[2], h7[2];
            r_load2(h0, TU, (int)myi[0], c, 0); r_load2(h1, TU, (int)myi[1], c, 0); r_load2(h2, TU, (int)myi[2], c, 0); r_load2(h3, TU, (int)myi[3], c, 0);
            r_load2(h4, TU, (int)myi[4], c, 0); r_load2(h5, TU, (int)myi[5], c, 0); r_load2(h6, TU, (int)myi[6], c, 0); r_load2(h7, TU, (int)myi[7], c, 0);
            for (int e = 0; e < 128; e += 8) {
                P1H_STEP(h0, 0, 0) P1H_STEP(h1, 1, 0) P1H_STEP(h2, 2, 0) P1H_STEP(h3, 3, 0) P1H_STEP(h4, 4, 0) P1H_STEP(h5, 5, 0) P1H_STEP(h6, 6, 0) P1H_STEP(h7, 7, 0)
                SB_();
                const int s0 = dpp_row_isum(pt0), s1 = dpp_row_isum(pt1), s2 = dpp_row_isum(pt2), s3 = dpp_row_isum(pt3), s4 = dpp_row_isum(pt4), s5 = dpp_row_isum(pt5), s6 = dpp_row_isum(pt6), s7 = dpp_row_isum(pt7);
                if (c == 0) { *(u32x4*)(lp + e) = (u32x4){(unsigned)s0, (unsigned)s1, (unsigned)s2, (unsigned)s3}; *(u32x4*)(lp + e + 4) = (u32x4){(unsigned)s4, (unsigned)s5, (unsigned)s6, (unsigned)s7}; }
            }
            wave_lds_sync();
            r_load2(h0, TU, (int)myi[0], c, 1); r_load2(h1, TU, (int)myi[1], c, 1); r_load2(h2, TU, (int)myi[2], c, 1); r_load2(h3, TU, (int)myi[3], c, 1);
            r_load2(h4, TU, (int)myi[4], c, 1); r_load2(h5, TU, (int)myi[5], c, 1); r_load2(h6, TU, (int)myi[6], c, 1); r_load2(h7, TU, (int)myi[7], c, 1);
            for (int e = 0; e < 128; e += 8) {
                P1H_STEP(h0, 0, 1) P1H_STEP(h1, 1, 1) P1H_STEP(h2, 2, 1) P1H_STEP(h3, 3, 1) P1H_STEP(h4, 4, 1) P1H_STEP(h5, 5, 1) P1H_STEP(h6, 6, 1) P1H_STEP(h7, 7, 1)
                SB_();
                const u32x4 pa = *(const u32x4*)(lp + e), pb = *(const u32x4*)(lp + e + 4);
                const float w0 = r_weight(pt0 + (c == 0 ? (int)pa[0] : 0), sx, wl, r, e), w1 = r_weight(pt1 + (c == 0 ? (int)pa[1] : 0), sx, wl, r, e + 1), w2 = r_weight(pt2 + (c == 0 ? (int)pa[2] : 0), sx, wl, r, e + 2), w3 = r_weight(pt3 + (c == 0 ? (int)pa[3] : 0), sx, wl, r, e + 3);
                const float w4 = r_weight(pt4 + (c == 0 ? (int)pb[0] : 0), sx, wl, r, e + 4), w5 = r_weight(pt5 + (c == 0 ? (int)pb[1] : 0), sx, wl, r, e + 5), w6 = r_weight(pt6 + (c == 0 ? (int)pb[2] : 0), sx, wl, r, e + 6), w7 = r_weight(pt7 + (c == 0 ? (int)pb[3] : 0), sx, wl, r, e + 7);
                wmax = fmaxf(fmaxf(wmax, fmaxf(fabsf(w0), fabsf(w1))), fmaxf(fabsf(w2), fabsf(w3)));
                wmax = fmaxf(fmaxf(wmax, fmaxf(fabsf(w4), fabsf(w5))), fmaxf(fabsf(w6), fabsf(w7)));
                if (c == 0) { *(f32x4*)(lw + e) = (f32x4){w0, w1, w2, w3}; *(f32x4*)(lw + e + 4) = (f32x4){w4, w5, w6, w7}; }
            }
        }
#undef P1H_STEP
#undef P1H_DOT
        __syncthreads();
        const float T = wmax > 0.f ? wmax * (1.f / 127.f) : 1.f, invT = wmax > 0.f ? 127.f / wmax : 0.f;
        wave_lds_sync();
#pragma unroll
        for (int h2 = 0; h2 < 2; ++h2) {
            const int gg = c + 16 * h2; const f32x4 wv = *(const f32x4*)(lw + 4 * gg);
            lwq[gg] = ((unsigned)__float2int_rn(wv[0] * invT) & 0xffu) | (((unsigned)__float2int_rn(wv[1] * invT) & 0xffu) << 8) | (((unsigned)__float2int_rn(wv[2] * invT) & 0xffu) << 16) | ((unsigned)__float2int_rn(wv[3] * invT) << 24);
        }
        wave_lds_sync();
        int acc[64];
#pragma unroll
        for (int i = 0; i < 64; ++i) acc[i] = 0;
        pass2_half<0>(TV, myi, lwq, c, acc);
        pass2_half<1>(TV, myi, lwq, c, acc);
        const int b = tkn >= SEQ ? 1 : 0;
        float* hr = p.out + (size_t)tkn * D + 16 * c;
        const float* g2p = mod + b * 6144 + 5120 + 16 * c;
        float y[64]; float ss = 0.f;
#pragma unroll
        for (int q = 0; q < 16; ++q) {
            const int eo = 256 * (q >> 2) + 4 * (q & 3);
            const float4 hv = *(const float4*)(hr + eo); const float4 g2 = *(const float4*)(g2p + eo);
            y[4 * q] = hv.x + g2.x * (T * (float)acc[4 * q]); y[4 * q + 1] = hv.y + g2.y * (T * (float)acc[4 * q + 1]);
            y[4 * q + 2] = hv.z + g2.z * (T * (float)acc[4 * q + 2]); y[4 * q + 3] = hv.w + g2.w * (T * (float)acc[4 * q + 3]);
            ss += y[4 * q] * y[4 * q] + y[4 * q + 1] * y[4 * q + 1] + y[4 * q + 2] * y[4 * q + 2] + y[4 * q + 3] * y[4 * q + 3];
        }
        ss = dpp_row_sum(ss);
        const float rstd = rsqrtf(ss * (1.f / 1024.f) + 1e-6f);
        float4 nwv[16];
#pragma unroll
        for (int q = 0; q < 16; ++q) nwv[q] = *(const float4*)(p.normf_w + 16 * c + 256 * (q >> 2) + 4 * (q & 3));
        if (!dry || rstd == 123.456f)
#pragma unroll
        for (int q = 0; q < 16; ++q) {
            const int eo = 256 * (q >> 2) + 4 * (q & 3);
            const float4 nw = nwv[q];
            float4 o; o.x = y[4 * q] * rstd * nw.x; o.y = y[4 * q + 1] * rstd * nw.y; o.z = y[4 * q + 2] * rstd * nw.z; o.w = y[4 * q + 3] * rstd * nw.w;
            *(float4*)(hr + eo) = o;
        }
        wave_lds_sync();
    }
}

#define LAS __attribute__((address_space(3)))
#define XB_TMO      128
#define XB_XCNT(j)  (256  + 64 * (j))
#define XB_XSUB(j)  (1280 + 64 * (j))
#define XB_XGEN(j)  (2304 + 64 * (j))
#define XB_TOP      3328
#define XB_TOPGEN   3392
#define XCD_BAR_WORDS 3456
#define XB_SPIN_CAP (1u << 18)

__device__ __forceinline__ unsigned xb_ld(unsigned* p)              { return __hip_atomic_load(p, __ATOMIC_RELAXED, __HIP_MEMORY_SCOPE_AGENT); }
__device__ __forceinline__ unsigned xb_add(unsigned* p, unsigned v) { return __hip_atomic_fetch_add(p, v, __ATOMIC_RELAXED, __HIP_MEMORY_SCOPE_AGENT); }
__device__ __forceinline__ unsigned xb_xcc_id() { return (unsigned)__builtin_amdgcn_s_getreg((3 << 11) | 20) & 0xFu; }
#define XB_SPIN(cond, bar) do { unsigned _sp = 0; while (cond) { __builtin_amdgcn_s_sleep(1); \
    if ((++_sp & 255u) == 0u) { if (xb_ld(&(bar)[XB_TMO])) break; if (_sp > XB_SPIN_CAP) { atomicAdd(&(bar)[XB_TMO], 1u); break; } } } } while (0)

struct XcdBarrier {
    unsigned* bar; unsigned x;
    volatile LAS unsigned* st;
};

__device__ __forceinline__ XcdBarrier xcd_barrier_post(unsigned* bar, volatile LAS unsigned* st) {
    XcdBarrier b; b.bar = bar; b.x = xb_xcc_id(); b.st = st;
    if (threadIdx.x == 0) (void)xb_add(&bar[XB_XCNT(b.x)], 1u);
    return b;
}
__device__ __forceinline__ void xcd_barrier_complete(unsigned* bar, unsigned x, unsigned& nloc, unsigned& nx) {
    const unsigned G = gridDim.x * gridDim.y * gridDim.z;
    unsigned sum, cnt, mine, sp = 0u;
    for (;;) {
        sum = 0u; cnt = 0u; mine = 0u;
#pragma unroll
        for (unsigned j = 0; j < 16; ++j) { const unsigned c = xb_ld(&bar[XB_XCNT(j)]); sum += c; cnt += (c > 0u) ? 1u : 0u; mine = (j == x) ? c : mine; }
        if (sum == G) break;
        __builtin_amdgcn_s_sleep(1);
        if ((++sp & 255u) == 0u) { if (xb_ld(&bar[XB_TMO])) break; if (sp > XB_SPIN_CAP) { atomicAdd(&bar[XB_TMO], 1u); break; } }
    }
    nloc = mine > 0u ? mine : 1u; nx = cnt > 0u ? cnt : 1u;
}

__device__ __forceinline__ void xcd_barrier(const XcdBarrier& b) {
    asm volatile("s_waitcnt vmcnt(0)" ::: "memory");
    __syncthreads();
    if (threadIdx.x == 0) {
        unsigned* bar = b.bar;
        __builtin_amdgcn_s_waitcnt(0);
        unsigned nloc = b.st[0], nx = b.st[1];
        if (nloc == 0u) { xcd_barrier_complete(bar, b.x, nloc, nx); b.st[0] = nloc; b.st[1] = nx; }
        const unsigned old = xb_add(&bar[XB_XSUB(b.x)], 1u);
        const unsigned gen = old / nloc;
        if (old + 1u == (gen + 1u) * nloc) {
            __builtin_amdgcn_fence(__ATOMIC_RELEASE, "agent");
            asm volatile("s_waitcnt vmcnt(0)" ::: "memory");
            const unsigned og = xb_add(&bar[XB_TOP], 1u);
            const unsigned tg = og / nx;
            if (og + 1u == (tg + 1u) * nx) xb_add(&bar[XB_TOPGEN], 1u);
            else XB_SPIN(xb_ld(&bar[XB_TOPGEN]) == tg, bar);
            __builtin_amdgcn_fence(__ATOMIC_ACQUIRE, "agent");
            xb_add(&bar[XB_XGEN(b.x)], 1u);
            asm volatile("s_waitcnt vmcnt(0)" ::: "memory");
        } else {
            XB_SPIN(xb_ld(&bar[XB_XGEN(b.x)]) == gen, bar);
            __builtin_amdgcn_fence(__ATOMIC_ACQUIRE, "agent");
            asm volatile("s_waitcnt vmcnt(0)" ::: "memory");
        }
    }
    __syncthreads();
}

namespace cg = cooperative_groups;
constexpr int LDS_BYTES = 151552;
constexpr int CW_RANK = XCD_BAR_WORDS;

constexpr int LDS_TOTAL = LDS_BYTES + 64;

__global__ void __launch_bounds__(512) k_mega(Params p) {
    extern __shared__ __attribute__((aligned(16))) char lds[];
    const int vb = blockIdx.x, nvb = gridDim.x;
    volatile LAS unsigned* bst = (volatile LAS unsigned*)((LAS char*)lds + LDS_BYTES);
    if (threadIdx.x < 16) bst[threadIdx.x] = 0u;
    __syncthreads();
    XcdBarrier bar = xcd_barrier_post((unsigned*)p.ws, bst);
    if (threadIdx.x == 0) bst[2] = xb_add((unsigned*)p.ws + CW_RANK + 64 * bar.x, 1u);
#define GRID_BAR() xcd_barrier(bar)
    stage_prep(p, lds, vb, nvb);        GRID_BAR();
    stage_norm1(p, lds, vb, nvb);       GRID_BAR();
    stage_gemm_in(p, lds, vb, nvb);     GRID_BAR();
    stage_attn(p, lds, vb, nvb);
    stage_mstate(p, lds, vb, nvb);      GRID_BAR();
    stage_mscan(p, lds, vb, nvb);       GRID_BAR();
    stage_mout(p, lds, vb, nvb);        GRID_BAR();
    stage_gemm_merge(p, lds, vb, nvb);  GRID_BAR();
    stage_gemm_out(p, lds, vb, nvb);    GRID_BAR();
    stage_norm2(p, lds, vb, nvb);       GRID_BAR();
    stage_gemm_q(p, lds, vb, nvb);      __syncthreads();
    stage_q_topk(p, lds, vb, nvb);      GRID_BAR();
    if (threadIdx.x == 0) { unsigned base = 0u; for (unsigned j = 0; j < bar.x; ++j) base += xb_ld((unsigned*)p.ws + XB_XCNT(j)); bst[3] = base + bst[2]; }
    __syncthreads();
    const int slot = (int)bst[3];
    stage_peer_gather(p, lds, slot < nvb ? slot : vb, nvb);
}

extern "C" void kernel_launch(void* const* d_in, const int* in_sizes, int n_in, void* d_out, int out_size, void* d_ws, size_t ws_size, hipStream_t stream) {
    if (n_in != 20 || ws_size < WS_END) { fprintf(stderr, "kernel_launch: unexpected n_in %d or ws_size %zu\n", n_in, ws_size); return; }
    static int grid_blocks = 0;
    if (!grid_blocks) {
        int dev = 0, cus = 0, per_cu = 0;
        (void)hipGetDevice(&dev);
        (void)hipDeviceGetAttribute(&cus, hipDeviceAttributeMultiprocessorCount, dev);
        (void)hipFuncSetAttribute((const void*)k_mega, hipFuncAttributeMaxDynamicSharedMemorySize, LDS_TOTAL);
        (void)hipOccupancyMaxActiveBlocksPerMultiprocessor(&per_cu, (const void*)k_mega, 512, LDS_TOTAL);
        if (per_cu < 1) { fprintf(stderr, "kernel_launch: occupancy query says %d blocks per CU\n", per_cu); per_cu = 1; }
        grid_blocks = cus * 1;
    }
    Params p{};
    p.x = (const float*)d_in[0]; p.c = (const float*)d_in[1]; p.w_ada = (const float*)d_in[2]; p.b_ada = (const float*)d_in[3]; p.norm1_w = (const float*)d_in[4];
    p.w_in = (const float*)d_in[5]; p.conv_w = (const float*)d_in[6]; p.sinks = (const float*)d_in[7]; p.i_bias = (const float*)d_in[8]; p.f_bias = (const float*)d_in[9];
    p.mnorm_w = (const float*)d_in[10]; p.w_a = (const float*)d_in[11]; p.w_b = (const float*)d_in[12]; p.w_out = (const float*)d_in[13]; p.norm2_w = (const float*)d_in[14];
    p.w_q = (const float*)d_in[15]; p.sub_keys = (const float*)d_in[16]; p.peer_u = (const float*)d_in[17]; p.peer_v = (const float*)d_in[18]; p.normf_w = (const float*)d_in[19];
    p.out = (float*)d_out; p.ws = (unsigned char*)d_ws;
    (void)hipMemsetAsync(d_ws, 0, 32768, stream);
    void* args[] = {&p};
    hipError_t e = hipLaunchCooperativeKernel((const void*)k_mega, dim3(grid_blocks), dim3(512), args, LDS_TOTAL, stream);
    if (e != hipSuccess) fprintf(stderr, "cooperative launch failed: %s (grid %d)\n", hipGetErrorString(e), grid_blocks);
}
```

```cpp
#include <hip/hip_runtime.h>
#include <hip/hip_cooperative_groups.h>
#include <stdint.h>
#include <stdio.h>

#define DEV __device__ __forceinline__
typedef unsigned short bf16_t;
typedef short bf16x8 __attribute__((ext_vector_type(8)));
typedef float f32x4 __attribute__((ext_vector_type(4)));
typedef unsigned u32x4 __attribute__((ext_vector_type(4)));
typedef unsigned u32x2 __attribute__((ext_vector_type(2)));

constexpr int BATCH = 2, SEQ = 16384, M = BATCH * SEQ, D = 1024;
constexpr int NTH = 512, NW = 8;
constexpr int LPA = 768, LPM = 2048, LPG = 2048;

struct Params {
    const float *x, *c, *w_ada, *b_ada, *norm1_w, *w_in, *conv_w, *sinks, *i_bias, *f_bias, *mnorm_w, *w_a, *w_b, *w_out, *norm2_w, *w_q, *sub_keys, *peer_u, *peer_v, *normf_w;
    float* out; unsigned char* ws;
};

constexpr size_t MiB = 1u << 20;
constexpr size_t WS_MOD = 1 * MiB;
constexpr size_t WS_IPRE = 2 * MiB;
constexpr size_t WS_FPRE = 2 * MiB + 512 * 1024;
constexpr size_t WS_CHG = 3 * MiB;
constexpr size_t WS_NLOC = 4 * MiB;
constexpr size_t WS_NST = 4 * MiB + 512 * 1024;
constexpr size_t WS_ROPE = 5 * MiB;
constexpr size_t WS_WIN = 10 * MiB;
constexpr size_t WS_WA = 20 * MiB;
constexpr size_t WS_WB = 21 * MiB;
constexpr size_t WS_WOUT = 22 * MiB;
constexpr size_t WS_WQ = 24 * MiB;
constexpr size_t WS_SK = 28 * MiB;
constexpr size_t WS_ISU = 29 * MiB;
constexpr size_t WS_ISV = 29 * MiB + 65536;
constexpr size_t WS_TU = 32 * MiB;
constexpr size_t WS_TV = 48 * MiB;
constexpr size_t WS_UB = 96 * MiB;
constexpr size_t WS_PA = 160 * MiB;
constexpr size_t WS_PM = 208 * MiB;
constexpr size_t WS_PG = 336 * MiB;
constexpr size_t WS_CST = 464 * MiB;
constexpr size_t WS_AT = 64 * MiB;
constexpr size_t WS_ML = 96 * MiB;
constexpr size_t WS_MG = 208 * MiB;
constexpr size_t WS_END = 496 * MiB;

DEV unsigned f2bf(float f) { unsigned u = __float_as_uint(f); return (u + 0x7fffu + ((u >> 16) & 1u)) >> 16; }
DEV unsigned pk2(float lo, float hi) { return f2bf(lo) | (f2bf(hi) << 16); }
DEV float bflo(unsigned u) { return __uint_as_float(u << 16); }
DEV float bfhi(unsigned u) { return __uint_as_float(u & 0xffff0000u); }
DEV float bf2f(bf16_t h) { return __uint_as_float(((unsigned)h) << 16); }
DEV float wave_sum(float v) {
#pragma unroll
    for (int o = 32; o > 0; o >>= 1) v += __shfl_xor(v, o);
    return v;
}
DEV float wave_max(float v) {
#pragma unroll
    for (int o = 32; o > 0; o >>= 1) v = fmaxf(v, __shfl_xor(v, o));
    return v;
}
DEV float sigmoidf_(float v) { return __builtin_amdgcn_rcpf(1.f + __expf(-v)); }
DEV f32x4 mfma16(bf16x8 a, bf16x8 b, f32x4 c) { return __builtin_amdgcn_mfma_f32_16x16x32_bf16(a, b, c, 0, 0, 0); }
DEV void wave_lds_sync() { __builtin_amdgcn_fence(__ATOMIC_ACQ_REL, "wavefront"); __builtin_amdgcn_wave_barrier(); }

DEV void transpose_item(const float* W, int ldw, int k0, int nsrc0, bf16_t* WT, int ldt, int ndst0, float* scr, int lane, int kdst_off = 0) {
#pragma unroll 8
    for (int i = 0; i < 32; ++i) { const int kk = 2 * i + (lane >> 5); scr[kk * 33 + (lane & 31)] = W[(size_t)(k0 + kk) * ldw + nsrc0 + (lane & 31)]; }
    wave_lds_sync();
    const int c = lane & 7;
#pragma unroll
    for (int j = 0; j < 4; ++j) {
        const int n = (lane >> 3) + 8 * j; const float* s = scr + (8 * c) * 33 + n;
        u32x4 o; o.x = pk2(s[0 * 33], s[1 * 33]); o.y = pk2(s[2 * 33], s[3 * 33]); o.z = pk2(s[4 * 33], s[5 * 33]); o.w = pk2(s[6 * 33], s[7 * 33]);
        *(u32x4*)(WT + (size_t)(ndst0 + n) * ldt + k0 + kdst_off + 8 * c) = o;
    }
    wave_lds_sync();
}

DEV void stage_prep(const Params& p, char* lds, int vb, int nvb) {
    const int tid = threadIdx.x, lane = tid & 63, wave = __builtin_amdgcn_readfirstlane(tid >> 6);
    float* mod = (float*)(p.ws + WS_MOD);
    float* s_act = (float*)lds;
    float* s_red = (float*)(lds + 8192);
    for (int i = tid; i < 2048; i += NTH) { const float v = p.c[i]; s_act[i] = v / (1.f + expf(-v)); }
    __syncthreads();
    for (int item = vb; item < 192; item += nvb) {
        const int kg = tid >> 5, cl = tid & 31, col = item * 32 + cl;
        float s0 = 0.f, s1 = 0.f;
        for (int k = kg; k < 1024; k += 16) { const float w = p.w_ada[(size_t)k * 6144 + col]; s0 += s_act[k] * w; s1 += s_act[1024 + k] * w; }
        s_red[(kg * 32 + cl) * 2] = s0; s_red[(kg * 32 + cl) * 2 + 1] = s1;
        __syncthreads();
        if (tid < 64) { const int b = tid >> 5, c2 = tid & 31; float s = 0.f; for (int g = 0; g < 16; ++g) s += s_red[(g * 32 + c2) * 2 + b]; mod[b * 6144 + item * 32 + c2] = s + p.b_ada[item * 32 + c2]; }
        __syncthreads();
    }
    float* scr = (float*)(lds + 16384 + wave * 8448);
    const int gw = vb * NW + wave, ngw = nvb * NW;
    bf16_t* Wt_in = (bf16_t*)(p.ws + WS_WIN); bf16_t* Wt_a = (bf16_t*)(p.ws + WS_WA); bf16_t* Wt_b = (bf16_t*)(p.ws + WS_WB);
    bf16_t* Wt_out = (bf16_t*)(p.ws + WS_WOUT); bf16_t* Wt_q = (bf16_t*)(p.ws + WS_WQ);
    for (int it = gw; it < 3456; it += ngw) {
        int r = it;
        if (r < 2432) { const int kb = r / 152, nb = r % 152; transpose_item(p.w_in, 4872, kb * 64, nb * 32 + (nb >= 88 ? 8 : 0), Wt_in, 1024, nb * 32, scr, lane); continue; } r -= 2432;
        if (r < 256) { const int kb = r / 32, nb = r % 32; transpose_item(p.w_a, 1024, kb * 64, nb * 32, Wt_a, 1024, nb * 32, scr, lane, 0); continue; } r -= 256;
        if (r < 256) { const int kb = r / 32, nb = r % 32; transpose_item(p.w_b, 1024, kb * 64, nb * 32, Wt_a, 1024, nb * 32, scr, lane, 512); continue; } r -= 256;
        { const int kb = r / 32, nb = r % 32; transpose_item(p.w_out, 1024, kb * 64, nb * 32, Wt_out, 1024, nb * 32, scr, lane); }
    }
    {
        float* WL = (float*)lds;
        float* KL = (float*)(lds + 33792);
        for (int item = vb; item < 256; item += nvb) {
            const int hp = item >> 4, k0 = (item & 15) * 64, pidx = hp & 1;
            __syncthreads();
            for (int i = tid; i < 64 * 32; i += NTH) { const int kk = i >> 5, d4 = i & 31; *(float4*)(WL + kk * 132 + 4 * d4) = *(const float4*)(p.w_q + (size_t)(k0 + kk) * 2048 + hp * 128 + 4 * d4); }
            for (int i = tid; i < 128 * 32; i += NTH) ((float4*)KL)[i] = ((const float4*)(p.sub_keys + (size_t)pidx * 16384))[i];
            __syncthreads();
            const int kk = tid & 63, n0 = (tid >> 6) * 16;
            float acc[16];
#pragma unroll
            for (int j = 0; j < 16; ++j) acc[j] = 0.f;
            for (int d4 = 0; d4 < 32; ++d4) {
                const float4 w = *(const float4*)(WL + kk * 132 + 4 * d4);
#pragma unroll
                for (int j = 0; j < 16; ++j) { const float4 kv = *(const float4*)(KL + (n0 + j) * 128 + 4 * d4); acc[j] += w.x * kv.x + w.y * kv.y + w.z * kv.z + w.w * kv.w; }
            }
#pragma unroll
            for (int j = 0; j < 16; ++j) Wt_q[(size_t)(hp * 128 + n0 + j) * 1024 + k0 + kk] = (bf16_t)f2bf(acc[j]);
        }
        __syncthreads();
    }
    const size_t gt = (size_t)vb * NTH + tid, ngt = (size_t)nvb * NTH;
    for (int rowb = gw; rowb < 32768; rowb += 4 * ngw) {
        float4 aa[4][4];
#pragma unroll
        for (int rr = 0; rr < 4; ++rr) { const int row = rowb + rr * ngw < 32768 ? rowb + rr * ngw : rowb; const float4* src = (const float4*)((row >= 16384 ? p.peer_v : p.peer_u) + (size_t)(row & 16383) * D) + lane;
#pragma unroll
            for (int i = 0; i < 4; ++i) aa[rr][i] = src[64 * i]; }
#pragma unroll
        for (int rr = 0; rr < 4; ++rr) {
            const int row = rowb + rr * ngw;
            if (row < 32768) {
                const bool isv = row >= 16384; const int r = row & 16383;
                float mx = 0.f;
#pragma unroll
                for (int i = 0; i < 4; ++i) mx = fmaxf(mx, fmaxf(fmaxf(fabsf(aa[rr][i].x), fabsf(aa[rr][i].y)), fmaxf(fabsf(aa[rr][i].z), fabsf(aa[rr][i].w))));
                mx = wave_max(mx);
                const float inv = mx > 0.f ? 127.f / mx : 0.f, sc = mx > 0.f ? mx * (1.f / 127.f) : 1.f;
                unsigned* dst = (unsigned*)(p.ws + (isv ? WS_TV : WS_TU) + (size_t)r * 1024) + lane;
#pragma unroll
                for (int i = 0; i < 4; ++i) dst[64 * i] = ((unsigned)__float2int_rn(aa[rr][i].x * inv) & 0xffu) | (((unsigned)__float2int_rn(aa[rr][i].y * inv) & 0xffu) << 8) | (((unsigned)__float2int_rn(aa[rr][i].z * inv) & 0xffu) << 16) | ((unsigned)__float2int_rn(aa[rr][i].w * inv) << 24);
                if (lane == 0) ((float*)(p.ws + (isv ? WS_ISV : WS_ISU)))[r] = sc;
            }
        }
    }
    for (size_t g = gt; g < 4096; g += ngt) {
        const float4 a = ((const float4*)p.sub_keys)[2 * g], b = ((const float4*)p.sub_keys)[2 * g + 1];
        u32x4 w; w.x = pk2(a.x, a.y); w.y = pk2(a.z, a.w); w.z = pk2(b.x, b.y); w.w = pk2(b.z, b.w);
        ((u32x4*)(p.ws + WS_SK))[g] = w;
    }
    float2* rope = (float2*)(p.ws + WS_ROPE);
    for (size_t e = gt; e < 16384 * 32; e += ngt) {
        const int pos = (int)(e >> 5), i = (int)(e & 31);
        const float inv = (float)exp2(-(double)i * (13.287712379549449 / 32.0));
        const float ang = (float)pos * inv;
        const double a = (double)ang; const double n = rint(a * 0.15915494309189535); const double r = a - n * 6.283185307179586;
        float s, c; sincosf((float)r, &s, &c);
        rope[e] = make_float2(c, s);
    }
}

DEV void stage_norm1(const Params& p, char* lds, int vb, int nvb) {
    const int tid = threadIdx.x, lane = tid & 63, wave = __builtin_amdgcn_readfirstlane(tid >> 6);
    float* wg = (float*)lds;
    for (int i = tid; i < 8192; i += NTH) { const int cc = i >> 10, k = i & 1023; wg[i] = p.w_in[(size_t)k * 4872 + 2816 + cc]; }
    __syncthreads();
    const float* mod = (const float*)(p.ws + WS_MOD);
    bf16_t* ub = (bf16_t*)(p.ws + WS_UB);
    float* ipre = (float*)(p.ws + WS_IPRE); float* fpre = (float*)(p.ws + WS_FPRE);
    const int rstride = nvb * NW;
    for (int mb = vb * NW + wave; mb < M; mb += 2 * rstride) {
        float4 vv[2][4];
#pragma unroll
        for (int rr = 0; rr < 2; ++rr) { const int mr = mb + rr * rstride < M ? mb + rr * rstride : mb; const float4* xr = (const float4*)(p.x + (size_t)mr * D);
#pragma unroll
            for (int j = 0; j < 4; ++j) vv[rr][j] = xr[lane + 64 * j]; }
#pragma unroll
        for (int rr = 0; rr < 2; ++rr) {
        const int m = mb + rr * rstride;
        if (m < M) {
        const int b = m >= SEQ ? 1 : 0;
        float4 v[4]; float ss = 0.f;
#pragma unroll
        for (int j = 0; j < 4; ++j) { v[j] = vv[rr][j]; ss += v[j].x * v[j].x + v[j].y * v[j].y + v[j].z * v[j].z + v[j].w * v[j].w; }
        ss = wave_sum(ss);
        const float rstd = rsqrtf(ss * (1.f / 1024.f) + 1e-6f);
        float ga[8];
#pragma unroll
        for (int cc = 0; cc < 8; ++cc) ga[cc] = 0.f;
#pragma unroll
        for (int j = 0; j < 4; ++j) {
            const int col = 4 * (lane + 64 * j);
            const float4 w1 = *(const float4*)(p.norm1_w + col), sc = *(const float4*)(mod + b * 6144 + 1024 + col), sh = *(const float4*)(mod + b * 6144 + col);
            float4 u;
            u.x = v[j].x * rstd * w1.x * (1.f + sc.x) + sh.x; u.y = v[j].y * rstd * w1.y * (1.f + sc.y) + sh.y;
            u.z = v[j].z * rstd * w1.z * (1.f + sc.z) + sh.z; u.w = v[j].w * rstd * w1.w * (1.f + sc.w) + sh.w;
            u32x2 o; o.x = pk2(u.x, u.y); o.y = pk2(u.z, u.w);
            *(u32x2*)(ub + (size_t)m * D + col) = o;
#pragma unroll
            for (int cc = 0; cc < 8; ++cc) { const float4 g = *(const float4*)(wg + cc * 1024 + col); ga[cc] += u.x * g.x + u.y * g.y + u.z * g.z + u.w * g.w; }
        }
        {
            const bool h32 = (lane & 32) != 0, h16 = (lane & 16) != 0, h8 = (lane & 8) != 0;
            float k4[4], k2[2];
#pragma unroll
            for (int i = 0; i < 4; ++i) k4[i] = (h32 ? ga[4 + i] : ga[i]) + __shfl_xor(h32 ? ga[i] : ga[4 + i], 32);
#pragma unroll
            for (int i = 0; i < 2; ++i) k2[i] = (h16 ? k4[2 + i] : k4[i]) + __shfl_xor(h16 ? k4[i] : k4[2 + i], 16);
            float k1 = (h8 ? k2[1] : k2[0]) + __shfl_xor(h8 ? k2[0] : k2[1], 8);
            k1 += __shfl_xor(k1, 4); k1 += __shfl_xor(k1, 2); k1 += __shfl_xor(k1, 1);
            const int cc = (lane >> 3) & 7;
            if ((lane & 7) == 0) { if (cc < 4) ipre[(size_t)m * 4 + cc] = k1 + p.i_bias[cc]; else fpre[(size_t)m * 4 + cc - 4] = k1 + p.f_bias[cc - 4]; }
        }
        }
        }
    }
}

namespace pg8 {
#define PG8_LAS __attribute__((address_space(3)))
typedef unsigned short bf16_t;
typedef short bf16x8 __attribute__((ext_vector_type(8)));
typedef float f32x4 __attribute__((ext_vector_type(4)));
typedef unsigned u32x4 __attribute__((ext_vector_type(4)));
constexpr int BM = 256, BK = 64, HALF = 128, HTB = HALF * BK * 2  , STAGE_BYTES = 8 * HTB, NXCD = 8, WGM = 8;

__host__ __device__ __forceinline__ int lds_byte(int r, int c) { const int st = (r >> 4) * 2 + (c >> 5), rr = r & 15, cc = c & 31, ob = rr * 64 + cc * 2; return st * 1024 + (ob ^ (((ob >> 9) & 1) << 5)); }
__host__ __device__ __forceinline__ void stage_rc(int b, int& R, int& C) { const int st = b / 1024, sb = b % 1024, swz = sb ^ (((sb >> 9) & 1) << 5); R = (st >> 1) * 16 + swz / 64; C = (st & 1) * 32 + (swz % 64) / 2; }
__host__ __device__ __forceinline__ int perm32(int rho) { const int n = rho >> 4, i = rho & 15; return 8 * (i >> 2) + 4 * n + (i & 3); }

struct Unit { int pm, pn; };
struct Gemm { const bf16_t* A; const bf16_t* Bt; int M, N, K, lda, ldb; const bf16_t* A2; };

struct StaticOrder {
    int nM, nN, nwg, G, c;
    __host__ __device__ void init(int M, int N, int G_, int c_) { nM = M / BM; nN = N / BM; nwg = nM * nN; G = G_; c = c_; }
    __host__ __device__ bool next(int i, Unit& u) const {
        const long L = (long)i * G + c; if (L >= nwg) return false;
        int wgid = (int)L; { const int q = nwg / NXCD, r = nwg % NXCD, xcd = wgid % NXCD, off = wgid / NXCD; wgid = (xcd < r ? xcd * (q + 1) : r * (q + 1) + (xcd - r) * q) + off; }
        const int nig = WGM * nN, gid = wgid / nig, fm = gid * WGM, gsz = (nM - fm) < WGM ? (nM - fm) : WGM;
        u.pm = fm + ((wgid % nig) % gsz); u.pn = (wgid % nig) / gsz; return true;
    }
    __device__ __forceinline__ void a_ready(const Unit&) const {}
    __device__ __forceinline__ void done(const Unit&) const {}
};

__device__ __forceinline__ unsigned cvt_pk_bf16(float lo, float hi) { unsigned r; asm volatile("v_cvt_pk_bf16_f32 %0, %1, %2" : "=v"(r) : "v"(lo), "v"(hi)); return r; }
__device__ __forceinline__ float sg_(float v) { return __builtin_amdgcn_rcpf(1.f + __expf(-v)); }
struct EpiIn {
    static constexpr bool PERM = true, AFTER_DRAIN = false, HAS_MID = false;
    bf16_t *PA, *PM, *PG;
    __device__ __forceinline__ void operator()(const f32x4 (&acc)[2][2][4][2], const Unit& u, int wr, int wc, int fr, int fq) const {
        const int colt = u.pn * BM; bf16_t* base; int ldc, cb;
        if (colt < 768) { base = PA; ldc = 768; cb = colt; } else if (colt < 2816) { base = PM; ldc = 2048; cb = colt - 768; } else { base = PG; ldc = 2048; cb = colt - 2816; }
        const int row0 = u.pm * BM + wr * 64 + fr, col0 = cb + wc * 32 + 8 * fq;
#pragma unroll
        for (int ai = 0; ai < 2; ++ai)
#pragma unroll
            for (int m = 0; m < 4; ++m) { bf16_t* rowp = base + (size_t)(row0 + ai * HALF + m * 16) * ldc + col0;
#pragma unroll
                for (int bj = 0; bj < 2; ++bj) { const f32x4 v0 = acc[ai][bj][m][0], v1 = acc[ai][bj][m][1];
                    u32x4 w; w.x = cvt_pk_bf16(v0[0], v0[1]); w.y = cvt_pk_bf16(v0[2], v0[3]); w.z = cvt_pk_bf16(v1[0], v1[1]); w.w = cvt_pk_bf16(v1[2], v1[3]);
                    *(u32x4*)(rowp + bj * HALF) = w; } }
    }
};
struct EpiMerge {
    static constexpr bool PERM = true, AFTER_DRAIN = false, HAS_MID = false;
    const bf16_t* G; bf16_t* MG; int second;
    __device__ __forceinline__ void operator()(const f32x4 (&acc)[2][2][4][2], const Unit& u, int wr, int wc, int fr, int fq) const {
        const int row0 = u.pm * BM + wr * 64 + fr, col0 = u.pn * BM + wc * 32 + 8 * fq;
#pragma unroll
        for (int bj = 0; bj < 2; ++bj)
#pragma unroll
        for (int ai = 0; ai < 2; ++ai) {
            const int col = col0 + bj * HALF;
            u32x4 gv[4], tv[4];
#pragma unroll
            for (int m = 0; m < 4; ++m) { const size_t row = (size_t)(row0 + ai * HALF + m * 16); gv[m] = *(const u32x4*)(G + row * 2048 + col); tv[m] = second ? *(const u32x4*)(MG + row * 1024 + col) : (u32x4){0u, 0u, 0u, 0u}; }
#pragma unroll
            for (int m = 0; m < 4; ++m) { const size_t row = (size_t)(row0 + ai * HALF + m * 16);
                const f32x4 v0 = acc[ai][bj][m][0], v1 = acc[ai][bj][m][1]; const u32x4 g = gv[m], t = tv[m];
                float r[8];
                r[0] = sg_(__uint_as_float(g.x << 16)) * v0[0] + __uint_as_float(t.x << 16); r[1] = sg_(__uint_as_float(g.x & 0xffff0000u)) * v0[1] + __uint_as_float(t.x & 0xffff0000u);
                r[2] = sg_(__uint_as_float(g.y << 16)) * v0[2] + __uint_as_float(t.y << 16); r[3] = sg_(__uint_as_float(g.y & 0xffff0000u)) * v0[3] + __uint_as_float(t.y & 0xffff0000u);
                r[4] = sg_(__uint_as_float(g.z << 16)) * v1[0] + __uint_as_float(t.z << 16); r[5] = sg_(__uint_as_float(g.z & 0xffff0000u)) * v1[1] + __uint_as_float(t.z & 0xffff0000u);
                r[6] = sg_(__uint_as_float(g.w << 16)) * v1[2] + __uint_as_float(t.w << 16); r[7] = sg_(__uint_as_float(g.w & 0xffff0000u)) * v1[3] + __uint_as_float(t.w & 0xffff0000u);
                u32x4 w; w.x = cvt_pk_bf16(r[0], r[1]); w.y = cvt_pk_bf16(r[2], r[3]); w.z = cvt_pk_bf16(r[4], r[5]); w.w = cvt_pk_bf16(r[6], r[7]);
                *(u32x4*)(MG + row * 1024 + col) = w; }
        }
    }
};
struct EpiMergeF {
    static constexpr bool PERM = true, AFTER_DRAIN = false, HAS_MID = true;
    const bf16_t* G; bf16_t* MG;
    static __device__ __forceinline__ float em_(float v) { return __expf(-fminf(fmaxf(v, -30.f), 30.f)); }
    __device__ __forceinline__ void mid(f32x4 (&acc)[2][2][4][2], const Unit& u, int wr, int wc, int fr, int fq) const {
        int row0 = u.pm * BM + wr * 64 + fr; const int col0 = u.pn * BM + wc * 32 + 8 * fq;
        asm volatile("" : "+v"(row0));
#pragma unroll
        for (int bj = 0; bj < 2; ++bj)
#pragma unroll
        for (int ai = 0; ai < 2; ++ai)
        {
            const int col = col0 + bj * HALF;
            u32x4 av[4], bv[4];
#pragma unroll
            for (int m = 0; m < 4; ++m) { const size_t row = (size_t)(row0 + ai * HALF + m * 16); av[m] = *(const u32x4*)(G + row * 2048 + col); bv[m] = *(const u32x4*)(G + row * 2048 + 1024 + col); }
#pragma unroll
            for (int m = 0; m < 4; ++m) {
                f32x4 r0, r1;
                r0[0] = (1.f + em_(__uint_as_float(bv[m][0] << 16))) * __builtin_amdgcn_rcpf(1.f + em_(__uint_as_float(av[m][0] << 16)));
                r0[1] = (1.f + em_(__uint_as_float(bv[m][0] & 0xffff0000u))) * __builtin_amdgcn_rcpf(1.f + em_(__uint_as_float(av[m][0] & 0xffff0000u)));
                r0[2] = (1.f + em_(__uint_as_float(bv[m][1] << 16))) * __builtin_amdgcn_rcpf(1.f + em_(__uint_as_float(av[m][1] << 16)));
                r0[3] = (1.f + em_(__uint_as_float(bv[m][1] & 0xffff0000u))) * __builtin_amdgcn_rcpf(1.f + em_(__uint_as_float(av[m][1] & 0xffff0000u)));
                r1[0] = (1.f + em_(__uint_as_float(bv[m][2] << 16))) * __builtin_amdgcn_rcpf(1.f + em_(__uint_as_float(av[m][2] << 16)));
                r1[1] = (1.f + em_(__uint_as_float(bv[m][2] & 0xffff0000u))) * __builtin_amdgcn_rcpf(1.f + em_(__uint_as_float(av[m][2] & 0xffff0000u)));
                r1[2] = (1.f + em_(__uint_as_float(bv[m][3] << 16))) * __builtin_amdgcn_rcpf(1.f + em_(__uint_as_float(av[m][3] << 16)));
                r1[3] = (1.f + em_(__uint_as_float(bv[m][3] & 0xffff0000u))) * __builtin_amdgcn_rcpf(1.f + em_(__uint_as_float(av[m][3] & 0xffff0000u)));
                acc[ai][bj][m][0] = acc[ai][bj][m][0] * r0; acc[ai][bj][m][1] = acc[ai][bj][m][1] * r1;
            }
            __builtin_amdgcn_sched_barrier(0);
        }
    }
    __device__ __forceinline__ void operator()(const f32x4 (&acc)[2][2][4][2], const Unit& u, int wr, int wc, int fr, int fq) const {
        const int row0 = u.pm * BM + wr * 64 + fr, col0 = u.pn * BM + wc * 32 + 8 * fq;
#pragma unroll
        for (int bj = 0; bj < 2; ++bj)
#pragma unroll
        for (int ai = 0; ai < 2; ++ai) {
            const int col = col0 + bj * HALF;
            u32x4 bv[4];
#pragma unroll
            for (int m = 0; m < 4; ++m) bv[m] = *(const u32x4*)(G + (size_t)(row0 + ai * HALF + m * 16) * 2048 + 1024 + col);
#pragma unroll
            for (int m = 0; m < 4; ++m) { const f32x4 v0 = acc[ai][bj][m][0], v1 = acc[ai][bj][m][1]; const u32x4 g = bv[m];
                float r[8];
                r[0] = v0[0] * __builtin_amdgcn_rcpf(1.f + em_(__uint_as_float(g.x << 16))); r[1] = v0[1] * __builtin_amdgcn_rcpf(1.f + em_(__uint_as_float(g.x & 0xffff0000u)));
                r[2] = v0[2] * __builtin_amdgcn_rcpf(1.f + em_(__uint_as_float(g.y << 16))); r[3] = v0[3] * __builtin_amdgcn_rcpf(1.f + em_(__uint_as_float(g.y & 0xffff0000u)));
                r[4] = v1[0] * __builtin_amdgcn_rcpf(1.f + em_(__uint_as_float(g.z << 16))); r[5] = v1[1] * __builtin_amdgcn_rcpf(1.f + em_(__uint_as_float(g.z & 0xffff0000u)));
                r[6] = v1[2] * __builtin_amdgcn_rcpf(1.f + em_(__uint_as_float(g.w << 16))); r[7] = v1[3] * __builtin_amdgcn_rcpf(1.f + em_(__uint_as_float(g.w & 0xffff0000u)));
                u32x4 w; w.x = cvt_pk_bf16(r[0], r[1]); w.y = cvt_pk_bf16(r[2], r[3]); w.z = cvt_pk_bf16(r[4], r[5]); w.w = cvt_pk_bf16(r[6], r[7]);
                *(u32x4*)(MG + (size_t)(row0 + ai * HALF + m * 16) * 1024 + col) = w; }
        }
    }
};
struct EpiF32 {
    static constexpr bool PERM = false, AFTER_DRAIN = false, HAS_MID = false;
    float* O; int ldc;
    __device__ __forceinline__ void operator()(const f32x4 (&acc)[2][2][4][2], const Unit& u, int wr, int wc, int fr, int fq) const {
        const int row0 = u.pm * BM + wr * 64 + fr, col0 = u.pn * BM + wc * 32 + 4 * fq;
#pragma unroll
        for (int ai = 0; ai < 2; ++ai)
#pragma unroll
            for (int m = 0; m < 4; ++m) { float* rowp = O + (size_t)(row0 + ai * HALF + m * 16) * ldc + col0;
#pragma unroll
                for (int bj = 0; bj < 2; ++bj) { *(f32x4*)(rowp + bj * HALF) = acc[ai][bj][m][0]; *(f32x4*)(rowp + bj * HALF + 16) = acc[ai][bj][m][1]; } }
    }
};
struct EpiOut {
    static constexpr bool PERM = false, AFTER_DRAIN = false, HAS_MID = false;
    const float* x; const float* g1; float* out; int seq;
    __device__ __forceinline__ void operator()(const f32x4 (&acc)[2][2][4][2], const Unit& u, int wr, int wc, int fr, int fq) const {
        const int row0 = u.pm * BM + wr * 64 + fr, col0 = u.pn * BM + wc * 32 + 4 * fq;
        const float* gp = g1 + (u.pm * BM >= seq ? 6144 : 0);
#pragma unroll
        for (int bj = 0; bj < 2; ++bj) { const int col = col0 + bj * HALF; const f32x4 ga = *(const f32x4*)(gp + col), gb = *(const f32x4*)(gp + col + 16);
#pragma unroll
            for (int ai = 0; ai < 2; ++ai) {
                f32x4 xa[4], xb[4];
#pragma unroll
                for (int m = 0; m < 4; ++m) { const size_t off = (size_t)(row0 + ai * HALF + m * 16) * 1024 + col; xa[m] = *(const f32x4*)(x + off); xb[m] = *(const f32x4*)(x + off + 16); }
#pragma unroll
                for (int m = 0; m < 4; ++m) { const size_t off = (size_t)(row0 + ai * HALF + m * 16) * 1024 + col;
                    *(f32x4*)(out + off) = xa[m] + ga * acc[ai][bj][m][0]; *(f32x4*)(out + off + 16) = xb[m] + gb * acc[ai][bj][m][1]; } } }
    }
};

template <class Epi, class Sched, bool ALIGN_EPI = false, bool SP2 = false>
__device__ __forceinline__ void gemm_phase(PG8_LAS unsigned char* lds, const Gemm g, const Sched& S, const Epi& E) {
    const int tid = threadIdx.x, wid = __builtin_amdgcn_readfirstlane(tid >> 6), lane = tid & 63, wr = wid >> 2, wc = wid & 3, fr = lane & 15, fq = lane >> 4;
    const int K = g.K, nt = K / BK;
    unsigned voffA[2], voffB[2];
#pragma unroll
    for (int i = 0; i < 2; ++i) { int R, C; stage_rc(tid * 16 + i * 8192, R, C); const int Rb = Epi::PERM ? ((R & ~31) + perm32(R & 31)) : R;
        voffA[i] = (unsigned)(R * g.lda + C) * 2u; voffB[i] = (unsigned)(Rb * g.ldb + C) * 2u; }
    const size_t kstep = (size_t)(BK * 2);
    const size_t hstepA = (size_t)HALF * g.lda * 2, hstepB = (size_t)HALF * g.ldb * 2;
    const size_t tstepA = 2 * hstepA, tstepB = 2 * hstepB;
    const unsigned ldsw = (unsigned)wid * 1024u;
    const int aoff = lds_byte(wr * 64 + fr, fq * 8), boff = lds_byte(wc * 32 + fr, fq * 8);
#define PG8_SA(b, h) (((b) * 2 + (h)) * HTB)
#define PG8_SB(b, h) ((4 + (b) * 2 + (h)) * HTB)
#define PG8_STAGE(bufoff, gbase, voff) do { _Pragma("unroll") for (int _i = 0; _i < 2; ++_i) \
        __builtin_amdgcn_global_load_lds((const unsigned*)((const char*)(gbase) + (voff)[_i]), (PG8_LAS unsigned*)(lds + (bufoff) + ldsw + _i * 8192), 16, 0, 0); } while (0)
#define PG8_LDA(dst, b, h) do { _Pragma("unroll") for (int m = 0; m < 4; ++m) _Pragma("unroll") for (int k = 0; k < 2; ++k) dst[m][k] = *(const PG8_LAS bf16x8*)(lds + PG8_SA(b, h) + aoff + m * 2048 + k * 1024); } while (0)
#define PG8_LDB(dst, b, h) do { _Pragma("unroll") for (int n = 0; n < 2; ++n) _Pragma("unroll") for (int k = 0; k < 2; ++k) dst[n][k] = *(const PG8_LAS bf16x8*)(lds + PG8_SB(b, h) + boff + n * 2048 + k * 1024); } while (0)
#define PG8_MMA(ai, bj, At, Bt) do { __builtin_amdgcn_s_setprio(1); _Pragma("unroll") for (int m = 0; m < 4; ++m) _Pragma("unroll") for (int n = 0; n < 2; ++n) _Pragma("unroll") for (int k = 0; k < 2; ++k) \
        acc[ai][bj][m][n] = __builtin_amdgcn_mfma_f32_16x16x32_bf16(Bt[n][k], At[m][k], acc[ai][bj][m][n], 0, 0, 0); __builtin_amdgcn_s_setprio(0); } while (0)
#define PG8_WAIT_V(n) asm volatile("s_waitcnt vmcnt(" #n ")" ::: "memory")
#define PG8_WAIT_L(n) asm volatile("s_waitcnt lgkmcnt(" #n ")" ::: "memory")
#define PG8_BAR __builtin_amdgcn_s_barrier()
#define PG8_SCHED __builtin_amdgcn_sched_barrier(0)
    Unit cur, nxt; int ui = 0;
    if (!S.next(0, cur)) return;
    f32x4 acc[2][2][4][2];
#pragma unroll
    for (int a = 0; a < 2; ++a)
#pragma unroll
        for (int b = 0; b < 2; ++b)
#pragma unroll
            for (int m = 0; m < 4; ++m)
#pragma unroll
                for (int n = 0; n < 2; ++n) acc[a][b][m][n] = (f32x4){0.f, 0.f, 0.f, 0.f};
    bf16x8 At[4][2], B0[2][2], B1[2][2];
    const char* cA = (const char*)g.A + (size_t)cur.pm * tstepA; const char* cB = (const char*)g.Bt + (size_t)cur.pn * tstepB;
    const char* cA2 = g.A2 ? (const char*)g.A2 + (size_t)cur.pm * tstepA : nullptr;
    S.a_ready(cur);
    if constexpr (SP2) {
        PG8_STAGE(PG8_SB(0, 0), cB, voffB); PG8_STAGE(PG8_SB(0, 1), cB + hstepB, voffB); PG8_STAGE(PG8_SA(0, 0), cA, voffA); PG8_STAGE(PG8_SA(0, 1), cA + hstepA, voffA);
        if (wr == 1) PG8_BAR;
        PG8_WAIT_V(2); PG8_BAR;
        PG8_STAGE(PG8_SB(1, 0), cB + kstep, voffB); PG8_STAGE(PG8_SA(1, 0), cA + kstep, voffA); PG8_STAGE(PG8_SB(1, 1), cB + hstepB + kstep, voffB);
        PG8_WAIT_V(6); PG8_BAR;
    } else {
        PG8_STAGE(PG8_SB(0, 0), cB, voffB); PG8_STAGE(PG8_SA(0, 0), cA, voffA); PG8_STAGE(PG8_SB(0, 1), cB + hstepB, voffB); PG8_STAGE(PG8_SA(0, 1), cA + hstepA, voffA);
        if (wr == 1) PG8_BAR;
        PG8_WAIT_V(4); PG8_BAR;
        PG8_STAGE(PG8_SB(1, 0), cB + kstep, voffB); PG8_STAGE(PG8_SA(1, 0), cA + kstep, voffA); PG8_STAGE(PG8_SB(1, 1), cB + hstepB + kstep, voffB);
        PG8_WAIT_V(6); PG8_BAR;
    }
    for (;;) {
        const bool has_next = S.next(ui + 1, nxt);
        const char* nA = has_next ? (const char*)g.A + (size_t)nxt.pm * tstepA : cA; const char* nB = has_next ? (const char*)g.Bt + (size_t)nxt.pn * tstepB : cB;
        const int tspan = Epi::HAS_MID ? (nt >> 1) : nt;
        for (int tb = 0; tb < nt; tb += tspan) {
        if constexpr (Epi::HAS_MID) { if (tb != 0) E.mid(acc, cur, wr, wc, fr, fq); }
        for (int t = tb; t < tb + tspan; t += 2) {
            const bool last = (t == nt - 2);
            const int hk = nt >> 1;
            const char* bA1 = (cA2 && t + 1 >= hk) ? cA2 - (size_t)hk * kstep : cA; const char* bA2 = (cA2 && t + 2 >= hk) ? cA2 - (size_t)hk * kstep : cA;
            const char* a1 = bA1 + (size_t)(t + 1) * kstep;
            const char* a2 = last ? nA : bA2 + (size_t)(t + 2) * kstep; const char* b2 = last ? nB : cB + (size_t)(t + 2) * kstep;
            const char* a3 = a2 + kstep; const char* b3 = b2 + kstep;
            if (last && has_next) S.a_ready(nxt);
            if constexpr (SP2) {
            PG8_LDB(B0, 0, 0); PG8_LDB(B1, 0, 1); PG8_SCHED; PG8_LDA(At, 0, 0); PG8_STAGE(PG8_SA(1, 1), a1 + hstepA, voffA);
            PG8_WAIT_V(8); PG8_WAIT_L(0); PG8_BAR; PG8_MMA(0, 0, At, B0); PG8_MMA(0, 1, At, B1); PG8_BAR; PG8_SCHED;
            PG8_LDA(At, 0, 1); PG8_STAGE(PG8_SB(0, 0), b2, voffB); PG8_STAGE(PG8_SB(0, 1), b2 + hstepB, voffB); PG8_STAGE(PG8_SA(0, 0), a2, voffA);
            PG8_WAIT_V(8); PG8_WAIT_L(0); PG8_BAR; PG8_MMA(1, 0, At, B0); PG8_MMA(1, 1, At, B1); PG8_BAR; PG8_SCHED;
            PG8_LDB(B0, 1, 0); PG8_LDB(B1, 1, 1); PG8_SCHED; PG8_LDA(At, 1, 0); PG8_STAGE(PG8_SA(0, 1), a2 + hstepA, voffA);
            PG8_WAIT_V(8); PG8_WAIT_L(0); PG8_BAR; PG8_MMA(0, 0, At, B0); PG8_MMA(0, 1, At, B1); PG8_BAR; PG8_SCHED;
            PG8_LDA(At, 1, 1); PG8_STAGE(PG8_SB(1, 0), b3, voffB); PG8_STAGE(PG8_SB(1, 1), b3 + hstepB, voffB); PG8_STAGE(PG8_SA(1, 0), a3, voffA);
            PG8_WAIT_V(8); PG8_WAIT_L(0); PG8_BAR; PG8_MMA(1, 0, At, B0); PG8_MMA(1, 1, At, B1); PG8_BAR; PG8_SCHED;
            } else {
            PG8_LDB(B0, 0, 0); PG8_SCHED; PG8_LDA(At, 0, 0); PG8_STAGE(PG8_SA(1, 1), a1 + hstepA, voffA);
            PG8_WAIT_L(8); PG8_BAR; PG8_WAIT_L(0); PG8_MMA(0, 0, At, B0); PG8_BAR; PG8_SCHED;
            PG8_LDB(B1, 0, 1); PG8_STAGE(PG8_SB(0, 0), b2, voffB);
            PG8_BAR; PG8_WAIT_L(0); PG8_MMA(0, 1, At, B1); PG8_BAR;
            PG8_LDA(At, 0, 1); PG8_STAGE(PG8_SA(0, 0), a2, voffA);
            PG8_BAR; PG8_WAIT_L(0); PG8_MMA(1, 0, At, B0); PG8_BAR; PG8_SCHED;
            PG8_STAGE(PG8_SB(0, 1), b2 + hstepB, voffB);
            PG8_WAIT_V(6); PG8_BAR; PG8_MMA(1, 1, At, B1); PG8_BAR;
            PG8_LDB(B0, 1, 0); PG8_SCHED; PG8_LDA(At, 1, 0); PG8_STAGE(PG8_SA(0, 1), a2 + hstepA, voffA);
            PG8_WAIT_L(8); PG8_BAR; PG8_WAIT_L(0); PG8_MMA(0, 0, At, B0); PG8_BAR; PG8_SCHED;
            PG8_LDB(B1, 1, 1); PG8_STAGE(PG8_SB(1, 0), b3, voffB);
            PG8_BAR; PG8_WAIT_L(0); PG8_MMA(0, 1, At, B1); PG8_BAR;
            PG8_LDA(At, 1, 1); PG8_STAGE(PG8_SA(1, 0), a3, voffA);
            PG8_BAR; PG8_WAIT_L(0); PG8_MMA(1, 0, At, B0); PG8_BAR; PG8_SCHED;
            PG8_STAGE(PG8_SB(1, 1), b3 + hstepB, voffB);
            PG8_WAIT_V(6); PG8_BAR; PG8_MMA(1, 1, At, B1); PG8_BAR;
            }
        }
        }
        if constexpr (ALIGN_EPI) { if (wr == 0) PG8_BAR; }
        if constexpr (!Epi::AFTER_DRAIN) { E(acc, cur, wr, wc, fr, fq); S.done(cur); }
        if (!has_next) break;
#pragma unroll
        for (int a = 0; a < 2; ++a)
#pragma unroll
            for (int b = 0; b < 2; ++b)
#pragma unroll
                for (int m = 0; m < 4; ++m)
#pragma unroll
                    for (int n = 0; n < 2; ++n) acc[a][b][m][n] = (f32x4){0.f, 0.f, 0.f, 0.f};
        cur = nxt; cA = nA; cB = nB; ++ui; cA2 = g.A2 ? (const char*)g.A2 + (size_t)cur.pm * tstepA : nullptr;
        if constexpr (ALIGN_EPI) { if (wr == 1) PG8_BAR; }
    }
    PG8_WAIT_V(0);
    if constexpr (!ALIGN_EPI) { if (wr == 0) PG8_BAR; }
    PG8_BAR;
    if constexpr (Epi::AFTER_DRAIN) { E.fused(acc, cur, wr, wc, fr, fq, lds, wid, lane); S.done(cur); }
#undef PG8_SA
#undef PG8_SB
#undef PG8_STAGE
#undef PG8_LDA
#undef PG8_LDB
#undef PG8_MMA
#undef PG8_WAIT_V
#undef PG8_WAIT_L
#undef PG8_BAR
#undef PG8_SCHED
}
}

DEV void stage_gemm_in(const Params& p, char* lds, int vb, int nvb) {
    pg8::Gemm g{(const bf16_t*)(p.ws + WS_UB), (const bf16_t*)(p.ws + WS_WIN), M, 4864, 1024, 1024, 1024};
    pg8::StaticOrder S; S.init(M, 4864, nvb, vb);
    pg8::EpiIn E{(bf16_t*)(p.ws + WS_PA), (bf16_t*)(p.ws + WS_PM), (bf16_t*)(p.ws + WS_PG)};
    pg8::gemm_phase<pg8::EpiIn, pg8::StaticOrder, true, true>((PG8_LAS unsigned char*)lds, g, S, E);
}
DEV void stage_gemm_merge(const Params& p, char* lds, int vb, int nvb) {
    pg8::Gemm g{(const bf16_t*)(p.ws + WS_AT), (const bf16_t*)(p.ws + WS_WA), M, 1024, 1024, 512, 1024, (const bf16_t*)(p.ws + WS_ML)};
    pg8::StaticOrder S; S.init(M, 1024, nvb, vb);
    pg8::EpiMergeF E{(const bf16_t*)(p.ws + WS_PG), (bf16_t*)(p.ws + WS_MG)};
    pg8::gemm_phase<pg8::EpiMergeF, pg8::StaticOrder, true, true>((PG8_LAS unsigned char*)lds, g, S, E);
}
DEV void stage_gemm_out(const Params& p, char* lds, int vb, int nvb) {
    pg8::Gemm g{(const bf16_t*)(p.ws + WS_MG), (const bf16_t*)(p.ws + WS_WOUT), M, 1024, 1024, 1024, 1024};
    pg8::StaticOrder S; S.init(M, 1024, nvb, vb);
    pg8::EpiOut E{p.x, (const float*)(p.ws + WS_MOD) + 2048, p.out, SEQ};
    pg8::gemm_phase<pg8::EpiOut, pg8::StaticOrder, true, true>((PG8_LAS unsigned char*)lds, g, S, E);
}

DEV void rope8(u32x4 x1, u32x4 x2, const float4* rp, float scale, u32x4& o1, u32x4& o2) {
#pragma unroll
    for (int w = 0; w < 4; ++w) {
        const float4 cs = rp[w];
        const float a0 = bflo(x1[w]), a1 = bfhi(x1[w]), b0 = bflo(x2[w]), b1 = bfhi(x2[w]);
        o1[w] = pk2((a0 * cs.x - b0 * cs.y) * scale, (a1 * cs.z - b1 * cs.w) * scale);
        o2[w] = pk2((b0 * cs.x + a0 * cs.y) * scale, (b1 * cs.z + a1 * cs.w) * scale);
    }
}

DEV void stage_attn(const Params& p, char* lds, int vb, int nvb) {
    const int tid = threadIdx.x, lane = tid & 63, wave = __builtin_amdgcn_readfirstlane(tid >> 6), fr = lane & 15, fq = lane >> 4;
    char* Ks = lds;
    char* VT = lds + 32768;
    char* Qs = lds + 70656;
    char* Ps = lds + 87040;
    bf16_t* PA = (bf16_t*)(p.ws + WS_PA);
    const float2* rope = (const float2*)(p.ws + WS_ROPE);
    for (int unit = vb; unit < 512; unit += nvb) {
        const int kvh = unit & 1, n = (unit >> 1) & 127, b = unit >> 8;
        __syncthreads();
        for (int task = tid; task < 1024; task += NTH) {
            const int ki = task >> 2, cp = task & 3, pos = 128 * (n - 1) + ki;
            u32x4 o1, o2;
            {
                const int pc = pos < 0 ? 0 : pos;
                const bf16_t* src = PA + (size_t)(b * SEQ + pc) * LPA + 512 + kvh * 64 + cp * 8;
                const u32x4 x1 = *(const u32x4*)src, x2 = *(const u32x4*)(src + 32);
                rope8(x1, x2, (const float4*)(rope + (size_t)pc * 32 + cp * 8), 1.0f, o1, o2);
                if (pos < 0) { o1 = (u32x4){0u, 0u, 0u, 0u}; o2 = o1; }
            }
            const int sw = ki & 7;
            *(u32x4*)(Ks + ki * 128 + ((cp ^ sw) << 4)) = o1;
            *(u32x4*)(Ks + ki * 128 + (((cp + 4) ^ sw) << 4)) = o2;
        }
        for (int task = tid; task < 2048; task += NTH) {
            const int ki = task >> 3, c = task & 7, pos = 128 * (n - 1) + ki;
            u32x4 x = *(const u32x4*)(PA + (size_t)(b * SEQ + (pos < 0 ? 0 : pos)) * LPA + 640 + kvh * 64 + c * 8);
            if (pos < 0) x = (u32x4){0u, 0u, 0u, 0u};
#pragma unroll
            for (int e = 0; e < 8; ++e) *(bf16_t*)(VT + (c * 8 + e) * 592 + ki * 2) = (bf16_t)((e & 1) ? (x[e >> 1] >> 16) : (x[e >> 1] & 0xffffu));
        }
        for (int i = tid; i < 64 * 40; i += NTH) { const int d = i / 40, kk = 256 + i % 40; *(bf16_t*)(VT + d * 592 + kk * 2) = 0; }
        for (int i = tid; i < 2048; i += NTH) { const int w = i >> 8, r = (i >> 4) & 15, kk = 144 + (i & 15); *(bf16_t*)(Ps + w * 5376 + r * 336 + kk * 2) = 0; }
        for (int j = 0; j < 4; ++j) {
            const int hq = kvh * 4 + j;
            {
                const int qi = tid >> 2, cp = tid & 3, pos = 128 * n + qi;
                const bf16_t* src = PA + (size_t)(b * SEQ + pos) * LPA + hq * 64 + cp * 8;
                const u32x4 x1 = *(const u32x4*)src, x2 = *(const u32x4*)(src + 32);
                u32x4 o1, o2;
                rope8(x1, x2, (const float4*)(rope + (size_t)pos * 32 + cp * 8), 0.125f, o1, o2);
                const int sw = qi & 7;
                *(u32x4*)(Qs + qi * 128 + ((cp ^ sw) << 4)) = o1;
                *(u32x4*)(Qs + qi * 128 + (((cp + 4) ^ sw) << 4)) = o2;
            }
            __syncthreads();
            f32x4 s[9];
            const int sw = fr & 7;
            bf16x8 qf[2];
#pragma unroll
            for (int ks = 0; ks < 2; ++ks) qf[ks] = *(const bf16x8*)(Qs + (16 * wave + fr) * 128 + (((fq + 4 * ks) ^ sw) << 4));
#pragma unroll
            for (int t = 0; t < 9; ++t) {
                s[t] = (f32x4){0.f, 0.f, 0.f, 0.f};
#pragma unroll
                for (int ks = 0; ks < 2; ++ks) { const bf16x8 kf = *(const bf16x8*)(Ks + (16 * (wave + t) + fr) * 128 + (((fq + 4 * ks) ^ sw) << 4)); s[t] = mfma16(kf, qf[ks], s[t]); }
            }
            const float sink = p.sinks[hq];
            float mx = sink;
#pragma unroll
            for (int t = 0; t < 9; ++t)
#pragma unroll
                for (int r = 0; r < 4; ++r) {
                    const int dd = 16 * t + 4 * fq + r - fr, ki = 16 * (wave + t) + 4 * fq + r;
                    const bool ok = (dd >= 1) && (dd <= 128) && (n > 0 || ki >= 128);
                    const float v = ok ? s[t][r] : -INFINITY;
                    s[t][r] = v; mx = fmaxf(mx, v);
                }
            mx = fmaxf(mx, __shfl_xor(mx, 16)); mx = fmaxf(mx, __shfl_xor(mx, 32));
            float sum = 0.f;
#pragma unroll
            for (int t = 0; t < 9; ++t)
#pragma unroll
                for (int r = 0; r < 4; ++r) { const float pv = __expf(s[t][r] - mx); s[t][r] = pv; sum += pv; }
            sum += __shfl_xor(sum, 16); sum += __shfl_xor(sum, 32);
            const float inv = 1.f / (sum + __expf(sink - mx));
            char* Pw = Ps + wave * 5376 + fr * 336;
#pragma unroll
            for (int t = 0; t < 9; ++t) { u32x2 o; o.x = pk2(s[t][0], s[t][1]); o.y = pk2(s[t][2], s[t][3]); *(u32x2*)(Pw + (16 * t + 4 * fq) * 2) = o; }
            __syncthreads();
            f32x4 o[4];
#pragma unroll
            for (int di = 0; di < 4; ++di) o[di] = (f32x4){0.f, 0.f, 0.f, 0.f};
#pragma unroll
            for (int ks = 0; ks < 5; ++ks) {
                const bf16x8 pf = *(const bf16x8*)(Pw + (32 * ks + 8 * fq) * 2);
#pragma unroll
                for (int di = 0; di < 4; ++di) { const bf16x8 vf = *(const bf16x8*)(VT + (16 * di + fr) * 592 + (16 * wave + 32 * ks + 8 * fq) * 2); o[di] = mfma16(vf, pf, o[di]); }
            }
            bf16_t* dst = (bf16_t*)(p.ws + WS_AT) + (size_t)(b * SEQ + 128 * n + 16 * wave + fr) * 512 + hq * 64 + 4 * fq;
#pragma unroll
            for (int di = 0; di < 4; ++di) { u32x2 w; w.x = pk2(o[di][0] * inv, o[di][1] * inv); w.y = pk2(o[di][2] * inv, o[di][3] * inv); *(u32x2*)(dst + 16 * di) = w; }
            __syncthreads();
        }
    }
}

DEV float logsigf(float x) { return fminf(x, 0.f) - log1pf(expf(-fabsf(x))); }

DEV void chunk_gates(const float* ipre, const float* fpre, int rowbase, int h, float* gs, int lane) {
    const int l0 = 2 * lane;
    const float i0 = ipre[(size_t)(rowbase + l0) * 4 + h], i1 = ipre[(size_t)(rowbase + l0 + 1) * 4 + h];
    const float lf0 = logsigf(fpre[(size_t)(rowbase + l0) * 4 + h]), lf1 = logsigf(fpre[(size_t)(rowbase + l0 + 1) * 4 + h]);
    const float pair = lf0 + lf1;
    float sc = pair;
#pragma unroll
    for (int o = 1; o < 64; o <<= 1) { const float t = __shfl_up(sc, o); if (lane >= o) sc += t; }
    const float b0 = (sc - pair) + lf0, b1 = b0 + lf1;
    const float g = __shfl(sc, 63);
    const float a0 = g - b0 + i0, a1 = g - b1 + i1;
    const float mloc = wave_max(fmaxf(a0, a1));
    const float ib0 = i0 - b0, ib1 = i1 - b1;
    float scm = fmaxf(ib0, ib1);
#pragma unroll
    for (int o = 1; o < 64; o <<= 1) { const float t = __shfl_up(scm, o); if (lane >= o) scm = fmaxf(scm, t); }
    float ex = __shfl_up(scm, 1); if (lane == 0) ex = -INFINITY;
    const float pm0 = fmaxf(ex, ib0), pm1 = fmaxf(pm0, ib1);
    gs[l0] = b0; gs[l0 + 1] = b1; gs[128 + l0] = ib0; gs[128 + l0 + 1] = ib1; gs[256 + l0] = a0; gs[256 + l0 + 1] = a1; gs[384 + l0] = pm0; gs[384 + l0 + 1] = pm1;
    if (lane == 0) { gs[512] = g; gs[513] = mloc; }
}

DEV void conv8(const bf16_t* PM, const float* cw, int b, int t, int pmcol, int cch, float (&out)[8]) {
#pragma unroll
    for (int e = 0; e < 8; ++e) out[e] = 0.f;
#pragma unroll
    for (int j = 0; j < 4; ++j) {
        const int tt = t - 3 + j; const int tc = tt < 0 ? 0 : tt; const float z = tt < 0 ? 0.f : 1.f;
        const u32x4 x = *(const u32x4*)(PM + (size_t)(b * SEQ + tc) * LPM + pmcol);
        float4 w0 = *(const float4*)(cw + j * 1024 + cch), w1 = *(const float4*)(cw + j * 1024 + cch + 4);
        w0.x *= z; w0.y *= z; w0.z *= z; w0.w *= z; w1.x *= z; w1.y *= z; w1.z *= z; w1.w *= z;
        out[0] += bflo(x[0]) * w0.x; out[1] += bfhi(x[0]) * w0.y; out[2] += bflo(x[1]) * w0.z; out[3] += bfhi(x[1]) * w0.w;
        out[4] += bflo(x[2]) * w1.x; out[5] += bfhi(x[2]) * w1.y; out[6] += bflo(x[3]) * w1.z; out[7] += bfhi(x[3]) * w1.w;
    }
}

DEV void conv8r(const u32x4 (&r)[4], const float* cwl, int ch8, int t, float (&out)[8]) {
#pragma unroll
    for (int e = 0; e < 8; ++e) out[e] = 0.f;
#pragma unroll
    for (int j = 0; j < 4; ++j) {
        const float z = (t - 3 + j) < 0 ? 0.f : 1.f;
        const float4 w0 = *(const float4*)(cwl + j * 128 + ch8), w1 = *(const float4*)(cwl + j * 128 + ch8 + 4);
        out[0] += bflo(r[j][0]) * (w0.x * z); out[1] += bfhi(r[j][0]) * (w0.y * z); out[2] += bflo(r[j][1]) * (w0.z * z); out[3] += bfhi(r[j][1]) * (w0.w * z);
        out[4] += bflo(r[j][2]) * (w1.x * z); out[5] += bfhi(r[j][2]) * (w1.y * z); out[6] += bflo(r[j][3]) * (w1.z * z); out[7] += bfhi(r[j][3]) * (w1.w * z);
    }
}
DEV float siluf_(float y) { return y * __builtin_amdgcn_rcpf(1.f + __expf(-y)); }

DEV void stage_mstate(const Params& p, char* lds, int vb, int nvb) {
    const int tid = threadIdx.x, lane = tid & 63, wave = __builtin_amdgcn_readfirstlane(tid >> 6), fr = lane & 15, fq = lane >> 4;
    char* KT = lds;
    char* VT = lds + 34816;
    float* gs = (float*)(lds + 69632); float* s_cw = (float*)(lds + 73728);
    const bf16_t* PM = (const bf16_t*)(p.ws + WS_PM);
    const float* ipre = (const float*)(p.ws + WS_IPRE); const float* fpre = (const float*)(p.ws + WS_FPRE);
    float* UT = (float*)(p.ws + WS_UB); float* NLOC = (float*)(p.ws + WS_NLOC);
    float* G = (float*)(p.ws + WS_CHG); float* MLOC = G + 1024;
    for (int unit = vb; unit < 1024; unit += nvb) {
        const int c = unit & 127, h = (unit >> 7) & 3, b = unit >> 9;
        const int rowbase = b * SEQ + c * 128;
        __syncthreads();
        if (wave == 0) chunk_gates(ipre, fpre, rowbase, h, gs, lane);
        else if (tid >= 64 && tid < 192) { const int d = tid - 64;
#pragma unroll
            for (int j = 0; j < 4; ++j) s_cw[j * 128 + d] = p.conv_w[j * 1024 + 512 + h * 128 + d]; }
        __syncthreads();
        const float mloc = gs[513];
        for (int task0 = tid; task0 < 2048; task0 += 2 * NTH) {
            u32x4 rk[2][4], xv[2];
#pragma unroll
            for (int u2 = 0; u2 < 2; ++u2) {
                const int task = task0 + u2 * NTH, l = task >> 4, ch = task & 15, t = c * 128 + l;
#pragma unroll
                for (int j = 0; j < 4; ++j) { const int tc = t - 3 + j < 0 ? 0 : t - 3 + j; rk[u2][j] = *(const u32x4*)(PM + (size_t)(b * SEQ + tc) * LPM + 512 + h * 128 + ch * 8); }
                xv[u2] = *(const u32x4*)(PM + (size_t)(rowbase + l) * LPM + 1024 + h * 128 + ch * 8);
            }
#pragma unroll
            for (int u2 = 0; u2 < 2; ++u2) {
                const int task = task0 + u2 * NTH, l = task >> 4, ch = task & 15, t = c * 128 + l;
                float v8[8]; conv8r(rk[u2], s_cw, ch * 8, t, v8);
                const float wgt = __expf(gs[256 + l] - mloc) * 0.08838834764831845f;
#pragma unroll
                for (int e = 0; e < 8; ++e) *(bf16_t*)(KT + (ch * 8 + e) * 272 + l * 2) = (bf16_t)f2bf(siluf_(v8[e]) * wgt);
                const u32x4 x = xv[u2];
#pragma unroll
                for (int e = 0; e < 8; ++e) *(bf16_t*)(VT + (ch * 8 + e) * 272 + l * 2) = (bf16_t)((e & 1) ? (x[e >> 1] >> 16) : (x[e >> 1] & 0xffffu));
            }
        }
        __syncthreads();
        f32x4 acc[8];
#pragma unroll
        for (int t = 0; t < 8; ++t) acc[t] = (f32x4){0.f, 0.f, 0.f, 0.f};
#pragma unroll
        for (int ks = 0; ks < 4; ++ks) {
            const bf16x8 vf = *(const bf16x8*)(VT + (16 * wave + fr) * 272 + (32 * ks + 8 * fq) * 2);
#pragma unroll
            for (int t = 0; t < 8; ++t) { const bf16x8 kf = *(const bf16x8*)(KT + (16 * t + fr) * 272 + (32 * ks + 8 * fq) * 2); acc[t] = mfma16(kf, vf, acc[t]); }
        }
        float* UTu = UT + (size_t)unit * 16384 + (16 * wave + fr) * 128 + 4 * fq;
#pragma unroll
        for (int t = 0; t < 8; ++t) *(f32x4*)(UTu + 16 * t) = acc[t];
        if (tid < 128) { float s = 0.f; for (int l = 0; l < 128; ++l) s += bf2f(*(const bf16_t*)(KT + tid * 272 + l * 2)); NLOC[unit * 128 + tid] = s; }
        if (tid == 0) { G[unit] = gs[512]; MLOC[unit] = mloc; }
    }
}

DEV void stage_mscan(const Params& p, char* lds, int vb, int nvb) {
    const int tid = threadIdx.x;
    float* s_dec = (float*)lds; float* s_scl = s_dec + 128;
    const float* UT = (const float*)(p.ws + WS_UB); const float* NLOC = (const float*)(p.ws + WS_NLOC);
    const float* G = (const float*)(p.ws + WS_CHG); const float* MLOC = G + 1024; float* MST = (float*)(p.ws + WS_CHG) + 2048;
    bf16_t* CST = (bf16_t*)(p.ws + WS_CST); float* NST = (float*)(p.ws + WS_NST);
    for (int item = vb; item < 256; item += nvb) {
        const int bh = item >> 5, part = item & 31;
        __syncthreads();
        float* s_g = s_dec + 256; float* s_ml = s_dec + 384; float* s_m = s_dec + 512;
        if (tid < 128) { s_g[tid] = G[bh * 128 + tid]; s_ml[tid] = MLOC[bh * 128 + tid]; }
        __syncthreads();
        if (tid == 0) { float m = 0.f; for (int c = 0; c < 128; ++c) { s_m[c] = m; m = fmaxf(s_g[c] + m, s_ml[c]); } s_m[128] = m; }
        __syncthreads();
        if (tid < 128) { const float m = s_m[tid], mn = s_m[tid + 1]; s_dec[tid] = expf(s_g[tid] + m - mn); s_scl[tid] = expf(s_ml[tid] - mn); if (part == 0) MST[bh * 128 + tid] = m; }
        __syncthreads();
        const int e = part * 512 + tid;
        float C = 0.f;
        const float* up = UT + (size_t)bh * 128 * 16384 + e; bf16_t* cp = CST + (size_t)bh * 128 * 16384 + e;
        for (int c = 0; c < 128; c += 32) {
            float uu[32];
#pragma unroll
            for (int i = 0; i < 32; ++i) uu[i] = up[(size_t)(c + i) * 16384];
#pragma unroll
            for (int i = 0; i < 32; ++i) { cp[(size_t)(c + i) * 16384] = (bf16_t)f2bf(C); C = s_dec[c + i] * C + s_scl[c + i] * uu[i]; }
        }
        if (part == 0 && tid < 128) {
            float nn = 0.f;
            for (int c = 0; c < 128; c += 32) {
                float nv[32];
#pragma unroll
                for (int i = 0; i < 32; ++i) nv[i] = NLOC[(bh * 128 + c + i) * 128 + tid];
#pragma unroll
                for (int i = 0; i < 32; ++i) { NST[(bh * 128 + c + i) * 128 + tid] = nn; nn = s_dec[c + i] * nn + s_scl[c + i] * nv[i]; }
            }
        }
    }
}

DEV void stage_mout(const Params& p, char* lds, int vb, int nvb) {
    const int tid = threadIdx.x, lane = tid & 63, wave = __builtin_amdgcn_readfirstlane(tid >> 6), fr = lane & 15, fq = lane >> 4;
    char* Qs = lds; char* Ks = lds + 34816; char* VT = lds + 69632; char* CT = lds + 104448;
    float* gs = (float*)(lds + 139264); float* s_nst = gs + 520; float* s_mo = gs + 648; float* s_wi = gs + 776; float* s_cw = (float*)(lds + 143360);
    bf16_t* PM = (bf16_t*)(p.ws + WS_PM);
    const float* ipre = (const float*)(p.ws + WS_IPRE); const float* fpre = (const float*)(p.ws + WS_FPRE);
    const float* MST = (const float*)(p.ws + WS_CHG) + 2048; const float* NST = (const float*)(p.ws + WS_NST);
    const bf16_t* CST = (const bf16_t*)(p.ws + WS_CST);
    for (int unit = vb; unit < 1024; unit += nvb) {
        const int c = unit & 127, h = (unit >> 7) & 3, b = unit >> 9;
        const int rowbase = b * SEQ + c * 128;
        __syncthreads();
        if (tid < 256) { const int d = tid & 127, kq = tid >> 7;
#pragma unroll
            for (int j = 0; j < 4; ++j) s_cw[kq * 512 + j * 128 + d] = p.conv_w[j * 1024 + kq * 512 + h * 128 + d]; }
        __syncthreads();
        if (wave == 0) chunk_gates(ipre, fpre, rowbase, h, gs, lane);
        for (int task0 = tid; task0 < 2048; task0 += 2 * NTH) {
            u32x4 rq[2][4], rk[2][4], xv[2], cstv[2];
#pragma unroll
            for (int u2 = 0; u2 < 2; ++u2) {
                const int task = task0 + u2 * NTH, l = task >> 4, ch = task & 15, t = c * 128 + l;
#pragma unroll
                for (int j = 0; j < 4; ++j) { const int tc = t - 3 + j < 0 ? 0 : t - 3 + j; const bf16_t* rp = PM + (size_t)(b * SEQ + tc) * LPM + h * 128 + ch * 8; rq[u2][j] = *(const u32x4*)rp; rk[u2][j] = *(const u32x4*)(rp + 512); }
                xv[u2] = *(const u32x4*)(PM + (size_t)(rowbase + l) * LPM + 1024 + h * 128 + ch * 8);
                cstv[u2] = *(const u32x4*)(CST + (size_t)unit * 16384 + l * 128 + ch * 8);
            }
#pragma unroll
            for (int u2 = 0; u2 < 2; ++u2) {
                const int task = task0 + u2 * NTH, l = task >> 4, ch = task & 15, t = c * 128 + l;
                float v8[8]; u32x4 o;
                conv8r(rq[u2], s_cw, ch * 8, t, v8);
                o.x = pk2(siluf_(v8[0]), siluf_(v8[1])); o.y = pk2(siluf_(v8[2]), siluf_(v8[3])); o.z = pk2(siluf_(v8[4]), siluf_(v8[5])); o.w = pk2(siluf_(v8[6]), siluf_(v8[7]));
                *(u32x4*)(Qs + l * 272 + ch * 16) = o;
                conv8r(rk[u2], s_cw + 512, ch * 8, t, v8);
                const float sc = 0.08838834764831845f;
                o.x = pk2(siluf_(v8[0]) * sc, siluf_(v8[1]) * sc); o.y = pk2(siluf_(v8[2]) * sc, siluf_(v8[3]) * sc); o.z = pk2(siluf_(v8[4]) * sc, siluf_(v8[5]) * sc); o.w = pk2(siluf_(v8[6]) * sc, siluf_(v8[7]) * sc);
                *(u32x4*)(Ks + l * 272 + ch * 16) = o;
                const u32x4 x = xv[u2];
#pragma unroll
                for (int e = 0; e < 8; ++e) *(bf16_t*)(VT + (ch * 8 + e) * 272 + l * 2) = (bf16_t)((e & 1) ? (x[e >> 1] >> 16) : (x[e >> 1] & 0xffffu));
                *(u32x4*)(CT + l * 272 + ch * 16) = cstv[u2];
            }
        }
        if (tid < 128) s_nst[tid] = NST[unit * 128 + tid];
        __syncthreads();
        if (tid < 128) { const float mst = MST[unit]; const float bc = gs[tid]; const float mo = bc + fmaxf(mst, gs[384 + tid]); s_mo[tid] = mo; s_wi[tid] = __expf(bc + mst - mo); }
        __syncthreads();
        const int l = 16 * wave + fr;
        f32x4 s[8];
        bf16x8 qf[4];
#pragma unroll
        for (int ks = 0; ks < 4; ++ks) qf[ks] = *(const bf16x8*)(Qs + l * 272 + (32 * ks + 8 * fq) * 2);
#pragma unroll
        for (int t = 0; t < 8; ++t) {
            s[t] = (f32x4){0.f, 0.f, 0.f, 0.f};
            if (t <= wave) {
#pragma unroll
                for (int ks = 0; ks < 4; ++ks) { const bf16x8 kf = *(const bf16x8*)(Ks + (16 * t + fr) * 272 + (32 * ks + 8 * fq) * 2); s[t] = mfma16(kf, qf[ks], s[t]); }
            }
        }
        const float bl = gs[l], mol = s_mo[l];
        float dsum = 0.f;
#pragma unroll
        for (int t = 0; t < 8; ++t)
#pragma unroll
            for (int r = 0; r < 4; ++r) {
                const int si = 16 * t + 4 * fq + r; float wv = 0.f;
                if (t <= wave && si <= l) wv = __expf(bl + gs[128 + si] - mol) * s[t][r];
                s[t][r] = wv; dsum += wv;
            }
        dsum += __shfl_xor(dsum, 16); dsum += __shfl_xor(dsum, 32);
        float qn = 0.f;
        {
            const char* qrow = Qs + l * 272 + fq * 64;
#pragma unroll
            for (int i = 0; i < 4; ++i) {
                const u32x4 x = *(const u32x4*)(qrow + 16 * i); const float* nn = s_nst + fq * 32 + 8 * i;
                qn += bflo(x[0]) * nn[0] + bfhi(x[0]) * nn[1] + bflo(x[1]) * nn[2] + bfhi(x[1]) * nn[3] + bflo(x[2]) * nn[4] + bfhi(x[2]) * nn[5] + bflo(x[3]) * nn[6] + bfhi(x[3]) * nn[7];
            }
        }
        qn += __shfl_xor(qn, 16); qn += __shfl_xor(qn, 32);
        __syncthreads();
#pragma unroll
        for (int t = 0; t < 8; ++t)
            if (t <= wave + 1) { u32x2 o; o.x = pk2(s[t][0], s[t][1]); o.y = pk2(s[t][2], s[t][3]); *(u32x2*)(Ks + l * 272 + (16 * t + 4 * fq) * 2) = o; }
        __syncthreads();
        f32x4 acc[8];
#pragma unroll
        for (int t = 0; t < 8; ++t) acc[t] = (f32x4){0.f, 0.f, 0.f, 0.f};
#pragma unroll
        for (int ks = 0; ks < 4; ++ks)
#pragma unroll
            for (int t = 0; t < 8; ++t) { const bf16x8 cf = *(const bf16x8*)(CT + (16 * t + fr) * 272 + (32 * ks + 8 * fq) * 2); acc[t] = mfma16(cf, qf[ks], acc[t]); }
        const float wi = s_wi[l];
#pragma unroll
        for (int t = 0; t < 8; ++t) acc[t] = acc[t] * wi;
        const int nks = (wave + 2) >> 1;
#pragma unroll
        for (int ks = 0; ks < 4; ++ks)
            if (ks < nks) {
                const bf16x8 wf = *(const bf16x8*)(Ks + l * 272 + (32 * ks + 8 * fq) * 2);
#pragma unroll
                for (int t = 0; t < 8; ++t) { const bf16x8 vf = *(const bf16x8*)(VT + (16 * t + fr) * 272 + (32 * ks + 8 * fq) * 2); acc[t] = mfma16(vf, wf, acc[t]); }
            }
        const float den = dsum + wi * qn;
        const float invd = 1.f / fmaxf(fabsf(den), __expf(-mol));
        bf16_t* mop = PM + (size_t)(rowbase + l) * LPM + 1536 + h * 128 + 4 * fq;
        float ssq = 0.f;
        u32x2 g2v[8]; float4 nwv[8];
#pragma unroll
        for (int t = 0; t < 8; ++t) { g2v[t] = *(const u32x2*)(mop + 16 * t); nwv[t] = *(const float4*)(p.mnorm_w + h * 128 + 16 * t + 4 * fq); }
#pragma unroll
        for (int t = 0; t < 8; ++t) {
            const u32x2 g2 = g2v[t];
            const float gg[4] = {bflo(g2.x), bfhi(g2.x), bflo(g2.y), bfhi(g2.y)};
#pragma unroll
            for (int r = 0; r < 4; ++r) { const float hv = acc[t][r] * invd * sigmoidf_(gg[r]); acc[t][r] = hv; ssq += hv * hv; }
        }
        ssq += __shfl_xor(ssq, 16); ssq += __shfl_xor(ssq, 32);
        const float rn = rsqrtf(ssq * (1.f / 128.f) + 1e-6f);
#pragma unroll
        for (int t = 0; t < 8; ++t) {
            const float4 nw = nwv[t];
            u32x2 o; o.x = pk2(acc[t][0] * rn * nw.x, acc[t][1] * rn * nw.y); o.y = pk2(acc[t][2] * rn * nw.z, acc[t][3] * rn * nw.w);
            *(u32x2*)((bf16_t*)(p.ws + WS_ML) + (size_t)(rowbase + l) * 512 + h * 128 + 4 * fq + 16 * t) = o;
        }
    }
}

DEV void stage_norm2(const Params& p, char* lds, int vb, int nvb) {
    const int tid = threadIdx.x, lane = tid & 63, wave = __builtin_amdgcn_readfirstlane(tid >> 6);
    const float* mod = (const float*)(p.ws + WS_MOD);
    bf16_t* U2 = (bf16_t*)(p.ws + WS_PG);
    const int rstride = nvb * NW;
    for (int mb = vb * NW + wave; mb < M; mb += 4 * rstride) {
        float4 vv[4][4];
#pragma unroll
        for (int rr = 0; rr < 4; ++rr) { const int mr = mb + rr * rstride < M ? mb + rr * rstride : mb; const float4* xr = (const float4*)(p.out + (size_t)mr * D);
#pragma unroll
            for (int j = 0; j < 4; ++j) vv[rr][j] = xr[lane + 64 * j]; }
#pragma unroll
        for (int rr = 0; rr < 4; ++rr) {
            const int m = mb + rr * rstride;
            if (m < M) {
                const int b = m >= SEQ ? 1 : 0;
                float ss = 0.f;
#pragma unroll
                for (int j = 0; j < 4; ++j) { const float4 v = vv[rr][j]; ss += v.x * v.x + v.y * v.y + v.z * v.z + v.w * v.w; }
                ss = wave_sum(ss);
                const float rstd = rsqrtf(ss * (1.f / 1024.f) + 1e-6f);
#pragma unroll
                for (int j = 0; j < 4; ++j) {
                    const int col = 4 * (lane + 64 * j); const float4 v = vv[rr][j];
                    const float4 w1 = *(const float4*)(p.norm2_w + col), sc = *(const float4*)(mod + b * 6144 + 4096 + col), sh = *(const float4*)(mod + b * 6144 + 3072 + col);
                    u32x2 o;
                    o.x = pk2(v.x * rstd * w1.x * (1.f + sc.x) + sh.x, v.y * rstd * w1.y * (1.f + sc.y) + sh.y);
                    o.y = pk2(v.z * rstd * w1.z * (1.f + sc.z) + sh.z, v.w * rstd * w1.w * (1.f + sc.w) + sh.w);
                    *(u32x2*)(U2 + (size_t)m * D + col) = o;
                }
            }
        }
    }
}

constexpr size_t WS_SELI = 400 * MiB;
constexpr size_t WS_SELG = 416 * MiB;
constexpr size_t WS_SC = 64 * MiB;
DEV unsigned f2ord(float f) { const unsigned u = __float_as_uint(f); return (u & 0x80000000u) ? ~u : (u | 0x80000000u); }
DEV float ord2f(unsigned k) { return __uint_as_float((k & 0x80000000u) ? (k ^ 0x80000000u) : ~k); }
DEV unsigned umax_(unsigned a, unsigned b) { return a > b ? a : b; }

DEV void stage_gemm_q(const Params& p, char* lds, int vb, int nvb) {
    pg8::Gemm g{(const bf16_t*)(p.ws + WS_PG), (const bf16_t*)(p.ws + WS_WQ), M, 2048, 1024, 1024, 1024};
    pg8::StaticOrder S; S.init(M, 2048, nvb, vb);
    pg8::EpiF32 E{(float*)(p.ws + WS_SC), 2048};
    pg8::gemm_phase<pg8::EpiF32, pg8::StaticOrder, true, true>((PG8_LAS unsigned char*)lds, g, S, E);
}

DEV unsigned umin_(unsigned a, unsigned b) { return a < b ? a : b; }
template <int N> DEV void bitonic_sort_desc(unsigned (&a)[N]) {
#pragma unroll
    for (int k = 2; k <= N; k <<= 1)
#pragma unroll
        for (int j = k >> 1; j > 0; j >>= 1)
#pragma unroll
            for (int i = 0; i < N; ++i) { const int l = i ^ j; if (l > i) { const unsigned x = a[i], y = a[l]; const bool dsc = (i & k) == 0; a[i] = dsc ? umax_(x, y) : umin_(x, y); a[l] = dsc ? umin_(x, y) : umax_(x, y); } }
}
template <int N> DEV void bitonic_merge_desc(unsigned (&a)[N]) {
#pragma unroll
    for (int j = N >> 1; j > 0; j >>= 1)
#pragma unroll
        for (int i = 0; i < N; ++i) { const int l = i ^ j; if (l > i) { const unsigned x = a[i], y = a[l]; a[i] = umax_(x, y); a[l] = umin_(x, y); } }
}
template <bool X16> DEV void merge_top16_xlane(unsigned (&x)[16], int lane) {
    unsigned m[16];
#pragma unroll
    for (int i = 0; i < 16; ++i) {
        unsigned pv;
        if (X16) { auto r = __builtin_amdgcn_permlane16_swap(x[15 - i], x[15 - i], false, false); pv = (lane & 16) ? r[0] : r[1]; }
        else { auto r = __builtin_amdgcn_permlane32_swap(x[15 - i], x[15 - i], false, false); pv = (lane & 32) ? r[0] : r[1]; }
        m[i] = umax_(x[i], pv);
    }
    bitonic_merge_desc<16>(m);
#pragma unroll
    for (int i = 0; i < 16; ++i) x[i] = m[i];
}

DEV void stage_q_topk(const Params& p, char* lds, int vb, int nvb) {
    const int tid = threadIdx.x, lane = tid & 63, wave = __builtin_amdgcn_readfirstlane(tid >> 6), fr = lane & 15, fq = lane >> 4;
    unsigned* tops = (unsigned*)lds;
    unsigned char* ptab = (unsigned char*)(lds + 16384);
    const float* SC = (const float*)(p.ws + WS_SC);
    int* SELI = (int*)(p.ws + WS_SELI); float* SELG = (float*)(p.ws + WS_SELG);
    __syncthreads();
    if (tid < 64) { int cnt = 0; unsigned char v = 0xff; for (int i = 0; i < 16; ++i) for (int j = 0; j < 16 / (i + 1); ++j) { if (cnt == tid) v = (unsigned char)(i | (j << 4)); ++cnt; } ptab[tid] = v; }
    __syncthreads();
    pg8::StaticOrder SO; SO.init(M, 2048, nvb, vb);
    for (int it2 = 0;; ++it2) {
        pg8::Unit un; if (!SO.next(it2 >> 1, un)) break;
        const int mt = un.pm * 2 + (it2 & 1), h = un.pn, m0 = mt * 128;
        const float* srow = SC + (size_t)(m0 + 16 * wave + fr) * 2048 + h * 256 + 4 * fq;
        f32x4 sv[2][8];
#pragma unroll
        for (int pp = 0; pp < 2; ++pp)
#pragma unroll
            for (int t = 0; t < 8; ++t) sv[pp][t] = *(const f32x4*)(srow + pp * 128 + 16 * t);
        unsigned* tp = tops + (16 * wave + fr) * 32;
#pragma unroll
        for (int pp = 0; pp < 2; ++pp) {
            unsigned lo[16], hi[16];
#pragma unroll
            for (int t = 0; t < 4; ++t)
#pragma unroll
                for (int r = 0; r < 4; ++r) {
                    lo[4 * t + r] = (f2ord(sv[pp][t][r]) & ~127u) | (127u - (unsigned)(16 * t + 4 * fq + r));
                    hi[4 * t + r] = (f2ord(sv[pp][t + 4][r]) & ~127u) | (127u - (unsigned)(16 * (t + 4) + 4 * fq + r));
                }
            bitonic_sort_desc<16>(lo); bitonic_sort_desc<16>(hi);
#pragma unroll
            for (int i = 0; i < 16; ++i) lo[i] = umax_(lo[i], hi[15 - i]);
            bitonic_merge_desc<16>(lo);
            merge_top16_xlane<true>(lo, lane); merge_top16_xlane<false>(lo, lane);
            if (fq == 0) {
#pragma unroll
                for (int q = 0; q < 4; ++q) *(u32x4*)(tp + pp * 16 + 4 * q) = (u32x4){lo[4 * q], lo[4 * q + 1], lo[4 * q + 2], lo[4 * q + 3]};
            }
        }
        wave_lds_sync();
        unsigned ck[16];
#pragma unroll
        for (int sl = 0; sl < 13; ++sl) {
            const unsigned pr = ptab[4 * sl + fq]; const unsigned i = pr & 15u, j = pr >> 4;
            const float sum = ord2f(tp[i] & ~127u) + ord2f(tp[16 + (j & 15u)] & ~127u);
            ck[sl] = pr != 0xffu ? ((f2ord(sum) & ~255u) | (255u - (i * 16u + j))) : 0u;
        }
        ck[13] = 0u; ck[14] = 0u; ck[15] = 0u;
        bitonic_sort_desc<16>(ck);
        merge_top16_xlane<true>(ck, lane); merge_top16_xlane<false>(ck, lane);
        const float v0 = ord2f(ck[0] & ~255u);
        float ex[16], sm = 0.f;
#pragma unroll
        for (int r = 0; r < 16; ++r) { ex[r] = __expf(ord2f(ck[r] & ~255u) - v0); sm += ex[r]; }
        const float rs = 1.f / sm;
        int oi[4]; float og[4];
#pragma unroll
        for (int q = 0; q < 4; ++q) {
            const unsigned w = fq == 0 ? ck[q] : (fq == 1 ? ck[4 + q] : (fq == 2 ? ck[8 + q] : ck[12 + q]));
            const float e = fq == 0 ? ex[q] : (fq == 1 ? ex[4 + q] : (fq == 2 ? ex[8 + q] : ex[12 + q]));
            const unsigned flat = 255u - (w & 255u); const unsigned ia = flat >> 4, jb = flat & 15u;
            oi[q] = (int)((127u - (tp[ia] & 127u)) * 128u + (127u - (tp[16 + jb] & 127u)));
            og[q] = e * rs;
        }
        const size_t so = (size_t)(m0 + 16 * wave + fr) * 128 + h * 16 + 4 * fq;
        *(int4*)(SELI + so) = make_int4(oi[0], oi[1], oi[2], oi[3]);
        *(float4*)(SELG + so) = make_float4(og[0], og[1], og[2], og[3]);
        wave_lds_sync();
    }
}

DEV float dpp_row_sum(float v) {
    v += __int_as_float(__builtin_amdgcn_update_dpp(0, __float_as_int(v), 0xB1, 0xF, 0xF, true));
    v += __int_as_float(__builtin_amdgcn_update_dpp(0, __float_as_int(v), 0x4E, 0xF, 0xF, true));
    v += __int_as_float(__builtin_amdgcn_update_dpp(0, __float_as_int(v), 0x141, 0xF, 0xF, true));
    v += __int_as_float(__builtin_amdgcn_update_dpp(0, __float_as_int(v), 0x140, 0xF, 0xF, true));
    return v;
}
DEV int dpp_row_isum(int v) {
    v += __builtin_amdgcn_update_dpp(0, v, 0xB1, 0xF, 0xF, true); v += __builtin_amdgcn_update_dpp(0, v, 0x4E, 0xF, 0xF, true);
    v += __builtin_amdgcn_update_dpp(0, v, 0x141, 0xF, 0xF, true); v += __builtin_amdgcn_update_dpp(0, v, 0x140, 0xF, 0xF, true);
    return v;
}
DEV float dpp_row_max(float v) {
    v = fmaxf(v, __int_as_float(__builtin_amdgcn_update_dpp(0, __float_as_int(v), 0xB1, 0xF, 0xF, true))); v = fmaxf(v, __int_as_float(__builtin_amdgcn_update_dpp(0, __float_as_int(v), 0x4E, 0xF, 0xF, true)));
    v = fmaxf(v, __int_as_float(__builtin_amdgcn_update_dpp(0, __float_as_int(v), 0x141, 0xF, 0xF, true))); v = fmaxf(v, __int_as_float(__builtin_amdgcn_update_dpp(0, __float_as_int(v), 0x140, 0xF, 0xF, true)));
    return v;
}
DEV float gelu_as(float v) {
    const float av = fabsf(v), t = __builtin_amdgcn_rcpf(av * 0.2316418882f + 1.0f);
    float q = t * 0.5307027145f + (-0.7265760135f); q = q * t + 0.7107068705f; q = q * t + (-0.142248368f); q = q * t + 0.127414796f; q = q * t;
    const float e = __builtin_amdgcn_exp2f(v * v * (-0.72134752044f));
    const float m = v * (q * e);
    return v < 0.f ? m : v - m;
}
constexpr int NBIN = 16;
constexpr int GW_IDX = 0, GW_GATE = 1024, GW_SU = 3072, GW_SV = 5120, GW_W = 7168, GW_WQ = 9216, GW_BYTES = 9728;
DEV void g_sort_token(const int* SELI, const float* SELG, const float* SU, const float* SV, int tkn, char* wl, int j, int lane, int msk) {
    const int i0 = SELI[(size_t)tkn * 128 + lane] & msk, i1 = SELI[(size_t)tkn * 128 + 64 + lane] & msk;
    const float g0 = SELG[(size_t)tkn * 128 + lane], g1 = SELG[(size_t)tkn * 128 + 64 + lane];
    const float su0 = SU[i0], su1 = SU[i1], sv0 = SV[i0], sv1 = SV[i1];
    const int s0 = i0 >> 10, s1 = i1 >> 10;
    const unsigned long long lt = (1ull << lane) - 1ull;
    int base = 0, p0 = 0, p1 = 0;
#pragma unroll
    for (int s = 0; s < NBIN; ++s) {
        const unsigned long long m0 = __ballot(s0 == s), m1 = __ballot(s1 == s);
        const int c0 = __popcll(m0), c1 = __popcll(m1);
        if (s0 == s) p0 = base + __popcll(m0 & lt);
        if (s1 == s) p1 = base + c0 + __popcll(m1 & lt);
        base += c0 + c1;
    }
    unsigned short* li = (unsigned short*)(wl + GW_IDX) + j * 128; float* lg = (float*)(wl + GW_GATE) + j * 128; float* lsu = (float*)(wl + GW_SU) + j * 128; float* lsv = (float*)(wl + GW_SV) + j * 128;
    li[p0] = (unsigned short)i0; lg[p0] = g0; lsu[p0] = su0; lsv[p0] = sv0;
    li[p1] = (unsigned short)i1; lg[p1] = g1; lsu[p1] = su1; lsv[p1] = sv1;
}
DEV void r_load(u32x4 (&d)[4], const unsigned char* T, int id, int c) {
    const u32x4* q = (const u32x4*)(T + (size_t)id * 1024) + c;
#pragma unroll
    for (int k = 0; k < 4; ++k) d[k] = q[16 * k];
}
DEV int r_dotq(const u32x4 (&u)[4], const unsigned (&xq)[16]) {
    int s0 = 0, s1 = 0, s2 = 0, s3 = 0;
#pragma unroll
    for (int k = 0; k < 4; ++k) {
        s0 = __builtin_amdgcn_sdot4((int)u[k][0], (int)xq[4 * k], s0, false); s1 = __builtin_amdgcn_sdot4((int)u[k][1], (int)xq[4 * k + 1], s1, false);
        s2 = __builtin_amdgcn_sdot4((int)u[k][2], (int)xq[4 * k + 2], s2, false); s3 = __builtin_amdgcn_sdot4((int)u[k][3], (int)xq[4 * k + 3], s3, false);
    }
    return (s0 + s1) + (s2 + s3);
}
DEV float r_weight(int part, float sx, const char* wl, int r, int e) {
    const float d = (float)dpp_row_isum(part) * (((const float*)(wl + GW_SU))[r * 128 + e] * sx);
    return ((const float*)(wl + GW_GATE))[r * 128 + e] * gelu_as(d) * ((const float*)(wl + GW_SV))[r * 128 + e];
}
DEV void r_vaccq(const u32x4 (&v0)[4], const u32x4 (&v1)[4], const u32x4 (&v2)[4], const u32x4 (&v3)[4], unsigned wpk, int (&acc)[64]) {
#pragma unroll
    for (int k = 0; k < 4; ++k)
#pragma unroll
        for (int w = 0; w < 4; ++w) {
            const unsigned r0 = v0[k][w], r1 = v1[k][w], r2 = v2[k][w], r3 = v3[k][w];
            const unsigned p0 = __builtin_amdgcn_perm(r1, r0, 0x05010400u), p1 = __builtin_amdgcn_perm(r1, r0, 0x07030602u);
            const unsigned q0 = __builtin_amdgcn_perm(r3, r2, 0x05010400u), q1 = __builtin_amdgcn_perm(r3, r2, 0x07030602u);
            const unsigned t0 = __builtin_amdgcn_perm(q0, p0, 0x05040100u), t1 = __builtin_amdgcn_perm(q0, p0, 0x07060302u);
            const unsigned t2 = __builtin_amdgcn_perm(q1, p1, 0x05040100u), t3 = __builtin_amdgcn_perm(q1, p1, 0x07060302u);
            const int o = 16 * k + 4 * w;
            acc[o] = __builtin_amdgcn_sdot4((int)t0, (int)wpk, acc[o], false); acc[o + 1] = __builtin_amdgcn_sdot4((int)t1, (int)wpk, acc[o + 1], false);
            acc[o + 2] = __builtin_amdgcn_sdot4((int)t2, (int)wpk, acc[o + 2], false); acc[o + 3] = __builtin_amdgcn_sdot4((int)t3, (int)wpk, acc[o + 3], false);
        }
}
DEV void r_load2(u32x4 (&d)[2], const unsigned char* T, int id, int c, int hh) {
    const u32x4* q = (const u32x4*)(T + (size_t)id * 1024) + c + 32 * hh;
    d[0] = q[0]; d[1] = q[16];
}
template <int HH> DEV void r_vaccq2(const u32x4 (&v0)[2], const u32x4 (&v1)[2], const u32x4 (&v2)[2], const u32x4 (&v3)[2], unsigned wpk, int (&acc)[64]) {
#pragma unroll
    for (int kk = 0; kk < 2; ++kk)
#pragma unroll
        for (int w = 0; w < 4; ++w) {
            const unsigned r0 = v0[kk][w], r1 = v1[kk][w], r2 = v2[kk][w], r3 = v3[kk][w];
            const unsigned p0 = __builtin_amdgcn_perm(r1, r0, 0x05010400u), p1 = __builtin_amdgcn_perm(r1, r0, 0x07030602u);
            const unsigned q0 = __builtin_amdgcn_perm(r3, r2, 0x05010400u), q1 = __builtin_amdgcn_perm(r3, r2, 0x07030602u);
            const unsigned t0 = __builtin_amdgcn_perm(q0, p0, 0x05040100u), t1 = __builtin_amdgcn_perm(q0, p0, 0x07060302u);
            const unsigned t2 = __builtin_amdgcn_perm(q1, p1, 0x05040100u), t3 = __builtin_amdgcn_perm(q1, p1, 0x07060302u);
            const int o = 16 * (2 * HH + kk) + 4 * w;
            acc[o] = __builtin_amdgcn_sdot4((int)t0, (int)wpk, acc[o], false); acc[o + 1] = __builtin_amdgcn_sdot4((int)t1, (int)wpk, acc[o + 1], false);
            acc[o + 2] = __builtin_amdgcn_sdot4((int)t2, (int)wpk, acc[o + 2], false); acc[o + 3] = __builtin_amdgcn_sdot4((int)t3, (int)wpk, acc[o + 3], false);
        }
}
struct VB4 { u32x4 e0[2], e1[2], e2[2], e3[2]; };
DEV void vb_load(VB4& b, const unsigned char* TV, const unsigned short* myi, int g, int c, int hh) {
    const int e = g < 32 ? 4 * g : 124;
    r_load2(b.e0, TV, (int)myi[e], c, hh); r_load2(b.e1, TV, (int)myi[e + 1], c, hh); r_load2(b.e2, TV, (int)myi[e + 2], c, hh); r_load2(b.e3, TV, (int)myi[e + 3], c, hh);
}
template <int HH> DEV void pass2_half(const unsigned char* TV, const unsigned short* myi, const unsigned* lwq, int c, int (&acc)[64]) {
    VB4 ba, bb, bc, bd;
    vb_load(ba, TV, myi, 0, c, HH); vb_load(bb, TV, myi, 1, c, HH); vb_load(bc, TV, myi, 2, c, HH); vb_load(bd, TV, myi, 3, c, HH);
    for (int g = 0; g < 32; g += 4) {
        __builtin_amdgcn_sched_barrier(0); r_vaccq2<HH>(ba.e0, ba.e1, ba.e2, ba.e3, lwq[g], acc);     __builtin_amdgcn_sched_barrier(0); vb_load(ba, TV, myi, g + 4, c, HH);
        __builtin_amdgcn_sched_barrier(0); r_vaccq2<HH>(bb.e0, bb.e1, bb.e2, bb.e3, lwq[g + 1], acc); __builtin_amdgcn_sched_barrier(0); vb_load(bb, TV, myi, g + 5, c, HH);
        __builtin_amdgcn_sched_barrier(0); r_vaccq2<HH>(bc.e0, bc.e1, bc.e2, bc.e3, lwq[g + 2], acc); __builtin_amdgcn_sched_barrier(0); vb_load(bc, TV, myi, g + 6, c, HH);
        __builtin_amdgcn_sched_barrier(0); r_vaccq2<HH>(bd.e0, bd.e1, bd.e2, bd.e3, lwq[g + 3], acc); __builtin_amdgcn_sched_barrier(0); vb_load(bd, TV, myi, g + 7, c, HH);
        __builtin_amdgcn_sched_barrier(0);
    }
}
#define SB_() __builtin_amdgcn_sched_barrier(0)

DEV void stage_peer_gather(const Params& p, char* lds, int slot, int nslots, bool dry = false, int msk = 0x3fff) {
    const int tid = threadIdx.x, lane = tid & 63, wave = __builtin_amdgcn_readfirstlane(tid >> 6), r = lane >> 4, c = lane & 15;
    const bf16_t* U2 = (const bf16_t*)(p.ws + WS_PG);
    const unsigned char* TU = p.ws + WS_TU; const unsigned char* TV = p.ws + WS_TV;
    const float* SU = (const float*)(p.ws + WS_ISU); const float* SV = (const float*)(p.ws + WS_ISV);
    const int* SELI = (const int*)(p.ws + WS_SELI); const float* SELG = (const float*)(p.ws + WS_SELG);
    const float* mod = (const float*)(p.ws + WS_MOD);
    char* wl = lds + wave * GW_BYTES;
    const unsigned short* myi = (const unsigned short*)(wl + GW_IDX) + r * 128;
    float* lw = (float*)(wl + GW_W) + r * 128; unsigned* lwq = (unsigned*)(wl + GW_WQ) + r * 32;
    const int tpb = M / nslots;
    __syncthreads();
    for (int g0 = 0; g0 < tpb; g0 += 32) {
        __syncthreads();
        const int tbase = slot * tpb + g0 + 4 * wave;
#pragma unroll
        for (int j = 0; j < 4; ++j) g_sort_token(SELI, SELG, SU, SV, tbase + j, wl, j, lane, msk);
        const int tkn = tbase + r;
        unsigned xq[16]; float sx;
        {
            const bf16_t* xr = U2 + (size_t)tkn * D + 16 * c;
            u32x4 t[8]; float amax = 0.f;
#pragma unroll
            for (int k = 0; k < 8; ++k) { t[k] = *(const u32x4*)(xr + 256 * (k >> 1) + 8 * (k & 1));
#pragma unroll
                for (int i = 0; i < 4; ++i) amax = fmaxf(amax, fmaxf(fabsf(bflo(t[k][i])), fabsf(bfhi(t[k][i])))); }
            amax = dpp_row_max(amax);
            const float inv = amax > 0.f ? 127.f / amax : 0.f; sx = amax > 0.f ? amax * (1.f / 127.f) : 1.f;
#pragma unroll
            for (int k = 0; k < 8; ++k)
#pragma unroll
                for (int h2 = 0; h2 < 2; ++h2) {
                    const unsigned a = t[k][2 * h2], b = t[k][2 * h2 + 1];
                    const unsigned wv = ((unsigned)__float2int_rn(bflo(a) * inv) & 0xffu) | (((unsigned)__float2int_rn(bfhi(a) * inv) & 0xffu) << 8) | (((unsigned)__float2int_rn(bflo(b) * inv) & 0xffu) << 16) | ((unsigned)__float2int_rn(bfhi(b) * inv) << 24);
                    xq[2 * k + h2] = wv;
                }
        }
        wave_lds_sync();
        float wmax = 0.f;
#define P1H_DOT(buf, HH) (__builtin_amdgcn_sdot4((int)buf[0][0], (int)xq[8 * HH + 0], __builtin_amdgcn_sdot4((int)buf[0][2], (int)xq[8 * HH + 2], __builtin_amdgcn_sdot4((int)buf[1][0], (int)xq[8 * HH + 4], __builtin_amdgcn_sdot4((int)buf[1][2], (int)xq[8 * HH + 6], 0, false), false), false), false) \
                        + __builtin_amdgcn_sdot4((int)buf[0][1], (int)xq[8 * HH + 1], __builtin_amdgcn_sdot4((int)buf[0][3], (int)xq[8 * HH + 3], __builtin_amdgcn_sdot4((int)buf[1][1], (int)xq[8 * HH + 5], __builtin_amdgcn_sdot4((int)buf[1][3], (int)xq[8 * HH + 7], 0, false), false), false), false))
#define P1H_STEP(buf, off, HH) SB_(); const int pt##off = P1H_DOT(buf, HH); SB_(); r_load2(buf, TU, (int)myi[e + 8 + off < 128 ? e + 8 + off : 127], c, HH);
        {
            int* lp = (int*)lw; const int c7 = c & 7;
            u32x4 h0[2], h1[2], h2[2], h3[2], h4[2], h5[2], h6[2], h7[2];
            r_load2(h0, TU, (int)myi[0], c, 0); r_load2(h1, TU, (int)myi[1], c, 0); r_load2(h2, TU, (int)myi[2], c, 0); r_load2(h3, TU, (int)myi[3], c, 0);
            r_load2(h4, TU, (int)myi[4], c, 0); r_load2(h5, TU, (int)myi[5], c, 0); r_load2(h6, TU, (int)myi[6], c, 0); r_load2(h7, TU, (int)myi[7], c, 0);
            for (int e = 0; e < 128; e += 8) {
                P1H_STEP(h0, 0, 0) P1H_STEP(h1, 1, 0) P1H_STEP(h2, 2, 0) P1H_STEP(h3, 3, 0) P1H_STEP(h4, 4, 0) P1H_STEP(h5, 5, 0) P1H_STEP(h6, 6, 0) P1H_STEP(h7, 7, 0)
                SB_();
                const int s0 = dpp_row_isum(pt0), s1 = dpp_row_isum(pt1), s2 = dpp_row_isum(pt2), s3 = dpp_row_isum(pt3), s4 = dpp_row_isum(pt4), s5 = dpp_row_isum(pt5), s6 = dpp_row_isum(pt6), s7 = dpp_row_isum(pt7);
                if (c == 0) { *(u32x4*)(lp + e) = (u32x4){(unsigned)s0, (unsigned)s1, (unsigned)s2, (unsigned)s3}; *(u32x4*)(lp + e + 4) = (u32x4){(unsigned)s4, (unsigned)s5, (unsigned)s6, (unsigned)s7}; }
            }
            wave_lds_sync();
            r_load2(h0, TU, (int)myi[0], c, 1); r_load2(h1, TU, (int)myi[1], c, 1); r_load2(h2, TU, (int)myi[2], c, 1); r_load2(h3, TU, (int)myi[3], c, 1);
            r_load2(h4, TU, (int)myi[4], c, 1); r_load2(h5, TU, (int)myi[5], c, 1); r_load2(h6, TU, (int)myi[6], c, 1); r_load2(h7, TU, (int)myi[7], c, 1);
            for (int e = 0; e < 128; e += 8) {
                P1H_STEP(h0, 0, 1) P1H_STEP(h1, 1, 1) P1H_STEP(h2, 2, 1) P1H_STEP(h3, 3, 1) P1H_STEP(h4, 4, 1) P1H_STEP(h5, 5, 1) P1H_STEP(h6, 6, 1) P1H_STEP(h7, 7, 1)
                SB_();
                const int s0 = dpp_row_isum(pt0), s1 = dpp_row_isum(pt1), s2 = dpp_row_isum(pt2), s3 = dpp_row_isum(pt3), s4 = dpp_row_isum(pt4), s5 = dpp_row_isum(pt5), s6 = dpp_row_isum(pt6), s7 = dpp_row_isum(pt7);
                int sel = s0; sel = c7 == 1 ? s1 : sel; sel = c7 == 2 ? s2 : sel; sel = c7 == 3 ? s3 : sel; sel = c7 == 4 ? s4 : sel; sel = c7 == 5 ? s5 : sel; sel = c7 == 6 ? s6 : sel; sel = c7 == 7 ? s7 : sel;
                const int ie = r * 128 + e + c7;
                const float dd = (float)(sel + lp[e + c7]) * (((const float*)(wl + GW_SU))[ie] * sx);
                const float wv = ((const float*)(wl + GW_GATE))[ie] * gelu_as(dd) * ((const float*)(wl + GW_SV))[ie];
                wmax = fmaxf(wmax, fabsf(wv));
                lw[e + c7] = wv;
            }
            wmax = dpp_row_max(wmax);
        }
#undef P1H_STEP
#undef P1H_DOT
        __syncthreads();
        const float T = wmax > 0.f ? wmax * (1.f / 127.f) : 1.f, invT = wmax > 0.f ? 127.f / wmax : 0.f;
        wave_lds_sync();
#pragma unroll
        for (int h2 = 0; h2 < 2; ++h2) {
            const int gg = c + 16 * h2; const f32x4 wv = *(const f32x4*)(lw + 4 * gg);
            lwq[gg] = ((unsigned)__float2int_rn(wv[0] * invT) & 0xffu) | (((unsigned)__float2int_rn(wv[1] * invT) & 0xffu) << 8) | (((unsigned)__float2int_rn(wv[2] * invT) & 0xffu) << 16) | ((unsigned)__float2int_rn(wv[3] * invT) << 24);
        }
        wave_lds_sync();
        int acc[64];
#pragma unroll
        for (int i = 0; i < 64; ++i) acc[i] = 0;
        pass2_half<0>(TV, myi, lwq, c, acc);
        pass2_half<1>(TV, myi, lwq, c, acc);
        const int b = tkn >= SEQ ? 1 : 0;
        float* hr = p.out + (size_t)tkn * D + 16 * c;
        const float* g2p = mod + b * 6144 + 5120 + 16 * c;
        float y[64]; float ss = 0.f;
#pragma unroll
        for (int q = 0; q < 16; ++q) {
            const int eo = 256 * (q >> 2) + 4 * (q & 3);
            const float4 hv = *(const float4*)(hr + eo); const float4 g2 = *(const float4*)(g2p + eo);
            y[4 * q] = hv.x + g2.x * (T * (float)acc[4 * q]); y[4 * q + 1] = hv.y + g2.y * (T * (float)acc[4 * q + 1]);
            y[4 * q + 2] = hv.z + g2.z * (T * (float)acc[4 * q + 2]); y[4 * q + 3] = hv.w + g2.w * (T * (float)acc[4 * q + 3]);
            ss += y[4 * q] * y[4 * q] + y[4 * q + 1] * y[4 * q + 1] + y[4 * q + 2] * y[4 * q + 2] + y[4 * q + 3] * y[4 * q + 3];
        }
        ss = dpp_row_sum(ss);
        const float rstd = rsqrtf(ss * (1.f / 1024.f) + 1e-6f);
        float4 nwv[16];
#pragma unroll
        for (int q = 0; q < 16; ++q) nwv[q] = *(const float4*)(p.normf_w + 16 * c + 256 * (q >> 2) + 4 * (q & 3));
        if (!dry || rstd == 123.456f)
#pragma unroll
        for (int q = 0; q < 16; ++q) {
            const int eo = 256 * (q >> 2) + 4 * (q & 3);
            const float4 nw = nwv[q];
            float4 o; o.x = y[4 * q] * rstd * nw.x; o.y = y[4 * q + 1] * rstd * nw.y; o.z = y[4 * q + 2] * rstd * nw.z; o.w = y[4 * q + 3] * rstd * nw.w;
            *(float4*)(hr + eo) = o;
        }
        wave_lds_sync();
    }
}

#define LAS __attribute__((address_space(3)))
#define XB_TMO      128
#define XB_XCNT(j)  (256  + 64 * (j))
#define XB_XSUB(j)  (1280 + 64 * (j))
#define XB_XGEN(j)  (2304 + 64 * (j))
#define XB_TOP      3328
#define XB_TOPGEN   3392
#define XCD_BAR_WORDS 3456
#define XB_SPIN_CAP (1u << 18)

__device__ __forceinline__ unsigned xb_ld(unsigned* p)              { return __hip_atomic_load(p, __ATOMIC_RELAXED, __HIP_MEMORY_SCOPE_AGENT); }
__device__ __forceinline__ unsigned xb_add(unsigned* p, unsigned v) { return __hip_atomic_fetch_add(p, v, __ATOMIC_RELAXED, __HIP_MEMORY_SCOPE_AGENT); }
__device__ __forceinline__ unsigned xb_xcc_id() { return (unsigned)__builtin_amdgcn_s_getreg((3 << 11) | 20) & 0xFu; }
#define XB_SPIN(cond, bar) do { unsigned _sp = 0; while (cond) { __builtin_amdgcn_s_sleep(1); \
    if ((++_sp & 255u) == 0u) { if (xb_ld(&(bar)[XB_TMO])) break; if (_sp > XB_SPIN_CAP) { atomicAdd(&(bar)[XB_TMO], 1u); break; } } } } while (0)

struct XcdBarrier {
    unsigned* bar; unsigned x;
    volatile LAS unsigned* st;
};

__device__ __forceinline__ XcdBarrier xcd_barrier_post(unsigned* bar, volatile LAS unsigned* st) {
    XcdBarrier b; b.bar = bar; b.x = xb_xcc_id(); b.st = st;
    if (threadIdx.x == 0) (void)xb_add(&bar[XB_XCNT(b.x)], 1u);
    return b;
}
__device__ __forceinline__ void xcd_barrier_complete(unsigned* bar, unsigned x, unsigned& nloc, unsigned& nx) {
    const unsigned G = gridDim.x * gridDim.y * gridDim.z;
    unsigned sum, cnt, mine, sp = 0u;
    for (;;) {
        sum = 0u; cnt = 0u; mine = 0u;
#pragma unroll
        for (unsigned j = 0; j < 16; ++j) { const unsigned c = xb_ld(&bar[XB_XCNT(j)]); sum += c; cnt += (c > 0u) ? 1u : 0u; mine = (j == x) ? c : mine; }
        if (sum == G) break;
        __builtin_amdgcn_s_sleep(1);
        if ((++sp & 255u) == 0u) { if (xb_ld(&bar[XB_TMO])) break; if (sp > XB_SPIN_CAP) { atomicAdd(&bar[XB_TMO], 1u); break; } }
    }
    nloc = mine > 0u ? mine : 1u; nx = cnt > 0u ? cnt : 1u;
}

__device__ __forceinline__ void xcd_barrier(const XcdBarrier& b) {
    asm volatile("s_waitcnt vmcnt(0)" ::: "memory");
    __syncthreads();
    if (threadIdx.x == 0) {
        unsigned* bar = b.bar;
        __builtin_amdgcn_s_waitcnt(0);
        unsigned nloc = b.st[0], nx = b.st[1];
        if (nloc == 0u) { xcd_barrier_complete(bar, b.x, nloc, nx); b.st[0] = nloc; b.st[1] = nx; }
        const unsigned old = xb_add(&bar[XB_XSUB(b.x)], 1u);
        const unsigned gen = old / nloc;
        if (old + 1u == (gen + 1u) * nloc) {
            __builtin_amdgcn_fence(__ATOMIC_RELEASE, "agent");
            asm volatile("s_waitcnt vmcnt(0)" ::: "memory");
            const unsigned og = xb_add(&bar[XB_TOP], 1u);
            const unsigned tg = og / nx;
            if (og + 1u == (tg + 1u) * nx) xb_add(&bar[XB_TOPGEN], 1u);
            else XB_SPIN(xb_ld(&bar[XB_TOPGEN]) == tg, bar);
            __builtin_amdgcn_fence(__ATOMIC_ACQUIRE, "agent");
            xb_add(&bar[XB_XGEN(b.x)], 1u);
            asm volatile("s_waitcnt vmcnt(0)" ::: "memory");
        } else {
            XB_SPIN(xb_ld(&bar[XB_XGEN(b.x)]) == gen, bar);
            __builtin_amdgcn_fence(__ATOMIC_ACQUIRE, "agent");
            asm volatile("s_waitcnt vmcnt(0)" ::: "memory");
        }
    }
    __syncthreads();
}

namespace cg = cooperative_groups;
constexpr int LDS_BYTES = 151552;
constexpr int CW_RANK = XCD_BAR_WORDS;

constexpr int LDS_TOTAL = LDS_BYTES + 64;

__global__ void __launch_bounds__(512) k_mega(Params p) {
    extern __shared__ __attribute__((aligned(16))) char lds[];
    const int vb = blockIdx.x, nvb = gridDim.x;
    volatile LAS unsigned* bst = (volatile LAS unsigned*)((LAS char*)lds + LDS_BYTES);
    if (threadIdx.x < 16) bst[threadIdx.x] = 0u;
    __syncthreads();
    XcdBarrier bar = xcd_barrier_post((unsigned*)p.ws, bst);
    if (threadIdx.x == 0) bst[2] = xb_add((unsigned*)p.ws + CW_RANK + 64 * bar.x, 1u);
#define GRID_BAR() xcd_barrier(bar)
    stage_prep(p, lds, vb, nvb);        GRID_BAR();
    stage_norm1(p, lds, vb, nvb);       GRID_BAR();
    stage_gemm_in(p, lds, vb, nvb);     GRID_BAR();
    stage_attn(p, lds, vb, nvb);
    stage_mstate(p, lds, vb, nvb);      GRID_BAR();
    stage_mscan(p, lds, vb, nvb);       GRID_BAR();
    stage_mout(p, lds, vb, nvb);        GRID_BAR();
    stage_gemm_merge(p, lds, vb, nvb);  GRID_BAR();
    stage_gemm_out(p, lds, vb, nvb);    GRID_BAR();
    stage_norm2(p, lds, vb, nvb);       GRID_BAR();
    stage_gemm_q(p, lds, vb, nvb);      __syncthreads();
    stage_q_topk(p, lds, vb, nvb);      GRID_BAR();
    if (threadIdx.x == 0) { unsigned base = 0u; for (unsigned j = 0; j < bar.x; ++j) base += xb_ld((unsigned*)p.ws + XB_XCNT(j)); bst[3] = base + bst[2]; }
    __syncthreads();
    const int slot = (int)bst[3];
    stage_peer_gather(p, lds, slot < nvb ? slot : vb, nvb);
}

extern "C" void kernel_launch(void* const* d_in, const int* in_sizes, int n_in, void* d_out, int out_size, void* d_ws, size_t ws_size, hipStream_t stream) {
    if (n_in != 20 || ws_size < WS_END) { fprintf(stderr, "kernel_launch: unexpected n_in %d or ws_size %zu\n", n_in, ws_size); return; }
    static int grid_blocks = 0;
    if (!grid_blocks) {
        int dev = 0, cus = 0, per_cu = 0;
        (void)hipGetDevice(&dev);
        (void)hipDeviceGetAttribute(&cus, hipDeviceAttributeMultiprocessorCount, dev);
        (void)hipFuncSetAttribute((const void*)k_mega, hipFuncAttributeMaxDynamicSharedMemorySize, LDS_TOTAL);
        (void)hipOccupancyMaxActiveBlocksPerMultiprocessor(&per_cu, (const void*)k_mega, 512, LDS_TOTAL);
        if (per_cu < 1) { fprintf(stderr, "kernel_launch: occupancy query says %d blocks per CU\n", per_cu); per_cu = 1; }
        grid_blocks = cus * 1;
    }
    Params p{};
    p.x = (const float*)d_in[0]; p.c = (const float*)d_in[1]; p.w_ada = (const float*)d_in[2]; p.b_ada = (const float*)d_in[3]; p.norm1_w = (const float*)d_in[4];
    p.w_in = (const float*)d_in[5]; p.conv_w = (const float*)d_in[6]; p.sinks = (const float*)d_in[7]; p.i_bias = (const float*)d_in[8]; p.f_bias = (const float*)d_in[9];
    p.mnorm_w = (const float*)d_in[10]; p.w_a = (const float*)d_in[11]; p.w_b = (const float*)d_in[12]; p.w_out = (const float*)d_in[13]; p.norm2_w = (const float*)d_in[14];
    p.w_q = (const float*)d_in[15]; p.sub_keys = (const float*)d_in[16]; p.peer_u = (const float*)d_in[17]; p.peer_v = (const float*)d_in[18]; p.normf_w = (const float*)d_in[19];
    p.out = (float*)d_out; p.ws = (unsigned char*)d_ws;
    (void)hipMemsetAsync(d_ws, 0, 32768, stream);
    void* args[] = {&p};
    hipError_t e = hipLaunchCooperativeKernel((const void*)k_mega, dim3(grid_blocks), dim3(512), args, LDS_TOTAL, stream);
    if (e != hipSuccess) fprintf(stderr, "cooperative launch failed: %s (grid %d)\n", hipGetErrorString(e), grid_blocks);
}
```
